# Optimizing an MI355X kernel written in HIP

```python
import math
import jax, jax.numpy as jnp
from jax import lax
import numpy as np

D_MODEL = 1024
BATCH = 2
SEQ = 8192
DEPTH = 2

GRID_W = 64
CTX_LEN = 256
EPS = 1e-6

D_LRU = 384
LRU_BLOCKS = 6
LRU_BLOCK_DIM = D_LRU // LRU_BLOCKS
LRU_CONV = 4
LRU_C = 8.0

MLA_HEADS = 6
MLA_NOPE = 64
MLA_ROPE = 32
MLA_V = 64
MLA_Q_RANK = 384
MLA_KV_RANK = 256
MLA_SCALE = (MLA_NOPE + MLA_ROPE) ** -0.5
ROPE_PAIRS = MLA_ROPE // 4
ROPE_THETA = 10000.0
ATTN_BLOCK = 128

D_HY = 256
HY_CONV = 3
HY_ORDER = 2
HY_BANDS = 8
HY_EMB = 1 + 2 * HY_BANDS
HY_FFN = 64

D_MIX = D_LRU + MLA_HEADS * MLA_V + D_HY
D_IN = 2 * D_LRU + MLA_Q_RANK + MLA_KV_RANK + MLA_ROPE + 3 * D_HY
IN_SPLITS = [D_LRU, 2 * D_LRU, 2 * D_LRU + MLA_Q_RANK,
             2 * D_LRU + MLA_Q_RANK + MLA_KV_RANK,
             2 * D_LRU + MLA_Q_RANK + MLA_KV_RANK + MLA_ROPE]

PEER_HEADS = 8
PEER_NKEYS = 128
PEER_EXPERTS = PEER_NKEYS * PEER_NKEYS
PEER_DQ = 256
PEER_TOPK = 16
PEER_BLOCK = 128

kernel_name = "hybrid_rglru_mla_hyena_peer_prefix_dit"

F32 = jnp.float32


def rmsnorm(x, g):
    xf = x.astype(F32)
    y = xf * lax.rsqrt(jnp.mean(xf * xf, axis=-1, keepdims=True) + EPS)
    return (y * g.astype(F32)).astype(x.dtype)


def depthwise_conv(x, w, b, pad_l, pad_r):
    y = lax.conv_general_dilated(
        x, w[:, None, :].astype(x.dtype), window_strides=(1,),
        padding=[(pad_l, pad_r)], dimension_numbers=('NWC', 'WIO', 'NWC'),
        feature_group_count=x.shape[-1])
    return y + b.astype(x.dtype)


def linear_scan(a, b, h0):
    b = b.at[:, 0].add(a[:, 0] * h0)

    def combine(e1, e2):
        a1, b1 = e1
        a2, b2 = e2
        return a1 * a2, a2 * b1 + b2

    _, h = lax.associative_scan(combine, (a, b), axis=1)
    return h


def rglru_coeffs(x, wr, br, wi, bi, lam):
    xb = x.reshape(x.shape[:-1] + (LRU_BLOCKS, LRU_BLOCK_DIM))
    r = jax.nn.sigmoid(jnp.einsum('blnd,nde->blne', xb, wr.astype(F32)).reshape(x.shape) + br.astype(F32))
    i = jax.nn.sigmoid(jnp.einsum('blnd,nde->blne', xb, wi.astype(F32)).reshape(x.shape) + bi.astype(F32))
    log_a = -LRU_C * r * jax.nn.softplus(-lam.astype(F32))
    a = jnp.exp(log_a)
    b = jnp.sqrt(-jnp.expm1(2.0 * log_a)) * (i * x)
    return a, b


def rglru_bidir(xx, xc, wr, br, wi, bi, lam):
    xx32, xc32 = xx.astype(F32), xc.astype(F32)
    h0 = jnp.zeros((xx.shape[0], D_LRU), F32)
    ys_x, ys_c = [], []
    for d in range(2):
        flip = (lambda t: t[:, ::-1]) if d == 1 else (lambda t: t)
        ac, bc = rglru_coeffs(flip(xc32), wr[d], br[d], wi[d], bi[d], lam[d])
        ax, bx = rglru_coeffs(flip(xx32), wr[d], br[d], wi[d], bi[d], lam[d])
        hc = linear_scan(ac, bc, h0)
        hx = linear_scan(ax, bx, hc[:, -1])
        ys_c.append(flip(hc))
        ys_x.append(flip(hx))
    return (ys_x[0] + ys_x[1]).astype(xx.dtype), (ys_c[0] + ys_c[1]).astype(xc.dtype)


def rope_axis(x, ang):
    n = x.shape[-1] // 2
    x1, x2 = x[..., :n], x[..., n:]
    cos, sin = jnp.cos(ang).astype(x.dtype), jnp.sin(ang).astype(x.dtype)
    return jnp.concatenate([x1 * cos - x2 * sin, x2 * cos + x1 * sin], axis=-1)


def rope_2d(x, ang_row, ang_col):
    h = MLA_ROPE // 2
    return jnp.concatenate([rope_axis(x[..., :h], ang_row), rope_axis(x[..., h:], ang_col)], axis=-1)


def mla_project(cq, ckv, kr, q_g, wqb, kv_g, wkvb, angles):
    B, L = cq.shape[:2]
    q = (rmsnorm(cq, q_g) @ wqb).reshape(B, L, MLA_HEADS, MLA_NOPE + MLA_ROPE)
    kv = (rmsnorm(ckv, kv_g) @ wkvb).reshape(B, L, MLA_HEADS, MLA_NOPE + MLA_V)
    q_nope, q_rope = q[..., :MLA_NOPE], q[..., MLA_NOPE:]
    k_nope, v = kv[..., :MLA_NOPE], kv[..., MLA_NOPE:]
    if angles is not None:
        ang_r, ang_c = angles
        q_rope = rope_2d(q_rope, ang_r[:, None, :], ang_c[:, None, :])
        kr = rope_2d(kr, ang_r, ang_c)
    k_rope = jnp.broadcast_to(kr[:, :, None, :], (B, L, MLA_HEADS, MLA_ROPE))
    q = jnp.concatenate([q_nope, q_rope], axis=-1)
    k = jnp.concatenate([k_nope, k_rope], axis=-1)
    return q, k, v


def attend(q, k, v):
    s = jnp.einsum('bqhd,bkhd->bhqk', q, k, preferred_element_type=F32) * MLA_SCALE
    p = jax.nn.softmax(s, axis=-1).astype(v.dtype)
    return jnp.einsum('bhqk,bkhd->bqhd', p, v)


def hyena_filter_spectra(L, w1, b1, w2, b2, w3, freq, decay):
    t = jnp.arange(L, dtype=F32) / L
    bands = jnp.linspace(1e-4, HY_BANDS - 1, HY_BANDS, dtype=F32)
    wpos = (2.0 * math.pi) * t[:, None] * bands[None, :]
    z = jnp.concatenate([t[:, None], jnp.cos(wpos), jnp.sin(wpos)], axis=-1)
    fr = freq.astype(F32)
    h = jnp.sin(fr * (z @ w1.astype(F32) + b1.astype(F32)))
    h = jnp.sin(fr * (h @ w2.astype(F32) + b2.astype(F32)))
    k = (h @ w3.astype(F32)).reshape(L, 2 * HY_ORDER, D_HY) * jnp.exp(-t[:, None, None] * decay.astype(F32))
    k = k * lax.rsqrt(jnp.sum(k * k, axis=0, keepdims=True) + EPS)
    k = k.reshape(L, HY_ORDER, 2, D_HY)
    kf, kb = k[:, :, 0], k[:, :, 1]
    k_circ = jnp.concatenate([kf, jnp.zeros((1, HY_ORDER, D_HY), F32), kb[:0:-1]], axis=0)
    return jnp.fft.rfft(k_circ, axis=0)


def fft_conv(z, kspec, skip):
    L = z.shape[1]
    z32 = z.astype(F32)
    zf = jnp.fft.rfft(z32, n=2 * L, axis=1)
    y = jnp.fft.irfft(zf * kspec[None], n=2 * L, axis=1)[:, :L]
    return (y + z32 * skip.astype(F32)).astype(z.dtype)


def hyena(u, conv_w, conv_b, w1, b1, w2, b2, w3, freq, decay, skip):
    L = u.shape[1]
    u = depthwise_conv(u, conv_w, conv_b, 1, 1)
    v, x1, x2 = jnp.split(u, 3, axis=-1)
    kspec = hyena_filter_spectra(L, w1, b1, w2, b2, w3, freq, decay)
    y = x1 * fft_conv(v, kspec[:, 0], skip[0])
    y = x2 * fft_conv(y, kspec[:, 1], skip[1])
    return y


def token_mixer(hx, hc, need_ctx, w_in, w_out,
                lru_conv_w, lru_conv_b, lru_wr, lru_br, lru_wi, lru_bi, lru_lambda,
                mla_q_norm_g, mla_wqb, mla_kv_norm_g, mla_wkvb,
                hy_conv_w, hy_conv_b, hy_f_w1, hy_f_b1, hy_f_w2, hy_f_b2, hy_f_w3,
                hy_f_freq, hy_decay, hy_skip):
    B, L, _ = hx.shape
    ROWS = L // GRID_W
    row = jnp.repeat(jnp.arange(ROWS, dtype=F32), GRID_W)
    col = jnp.tile(jnp.arange(GRID_W, dtype=F32), ROWS)
    inv_freq = ROPE_THETA ** (-jnp.arange(ROPE_PAIRS, dtype=F32) / ROPE_PAIRS)
    angles = (row[:, None] * inv_freq, col[:, None] * inv_freq)

    ux = jnp.split(hx @ w_in, IN_SPLITS, axis=-1)
    uc = jnp.split(hc @ w_in, IN_SPLITS, axis=-1)
    hy_args = (hy_conv_w, hy_conv_b, hy_f_w1, hy_f_b1, hy_f_w2, hy_f_b2, hy_f_w3, hy_f_freq, hy_decay, hy_skip)

    ax_in = depthwise_conv(ux[0], lru_conv_w, lru_conv_b, 2, 1)
    ac_in = depthwise_conv(uc[0], lru_conv_w, lru_conv_b, 2, 1)
    ra_x, ra_c = rglru_bidir(ax_in, ac_in, lru_wr, lru_br, lru_wi, lru_bi, lru_lambda)
    ya_x = ra_x * jax.nn.gelu(ux[1])

    qx, kx, vx = mla_project(ux[2], ux[3], ux[4], mla_q_norm_g, mla_wqb, mla_kv_norm_g, mla_wkvb, angles)
    qc, kc, vc = mla_project(uc[2], uc[3], uc[4], mla_q_norm_g, mla_wqb, mla_kv_norm_g, mla_wkvb, None)
    k_all = jnp.concatenate([kc, kx], axis=1)
    v_all = jnp.concatenate([vc, vx], axis=1)
    nb = L // ATTN_BLOCK
    q_blocks = jnp.moveaxis(qx.reshape(B, nb, ATTN_BLOCK, MLA_HEADS, MLA_NOPE + MLA_ROPE), 1, 0)
    o_blocks = lax.map(lambda qb: attend(qb, k_all, v_all), q_blocks)
    yb_x = jnp.moveaxis(o_blocks, 0, 1).reshape(B, L, MLA_HEADS * MLA_V)

    yc_x = hyena(ux[5], *hy_args)

    out_x = jnp.concatenate([ya_x, yb_x, yc_x], axis=-1) @ w_out
    if not need_ctx:
        return out_x, None

    Lc = hc.shape[1]
    ya_c = ra_c * jax.nn.gelu(uc[1])
    yb_c = attend(qc, kc, vc).reshape(B, Lc, MLA_HEADS * MLA_V)
    yc_c = hyena(uc[5], *hy_args)
    out_c = jnp.concatenate([ya_c, yb_c, yc_c], axis=-1) @ w_out
    return out_x, out_c


def peer(h, wq, keys, u_tab, v_tab):
    B, L, D = h.shape
    tokens = h.reshape(-1, PEER_BLOCK, D)
    half = PEER_DQ // 2

    def block(xb):
        T = xb.shape[0]
        q = (xb @ wq).reshape(T, PEER_HEADS, PEER_DQ)
        s1 = jnp.einsum('thd,kd->thk', q[..., :half], keys[0], preferred_element_type=F32)
        s2 = jnp.einsum('thd,kd->thk', q[..., half:], keys[1], preferred_element_type=F32)
        v1, i1 = lax.top_k(s1, PEER_TOPK)
        v2, i2 = lax.top_k(s2, PEER_TOPK)
        cand = (v1[..., :, None] + v2[..., None, :]).reshape(T, PEER_HEADS, PEER_TOPK * PEER_TOPK)
        cid = (i1[..., :, None] * PEER_NKEYS + i2[..., None, :]).reshape(T, PEER_HEADS, PEER_TOPK * PEER_TOPK)
        top_s, top_p = lax.top_k(cand, PEER_TOPK)
        eid = jnp.take_along_axis(cid, top_p, axis=-1)
        gate = jax.nn.softmax(top_s, axis=-1).astype(xb.dtype)
        act = jax.nn.gelu(jnp.einsum('td,thkd->thk', xb, u_tab[eid]))
        return jnp.einsum('thk,thkd->td', gate * act, v_tab[eid])

    return lax.map(block, tokens).reshape(B, L, D)


def setup_inputs(seed: int = 0) -> dict:
    keys = iter(jax.random.split(jax.random.key(seed), 64))

    def nrm(shape, scale):
        return jax.random.normal(next(keys), shape, F32) * scale

    D = D_MODEL
    lam_u = jax.random.uniform(next(keys), (DEPTH, 2, D_LRU), F32, minval=0.9, maxval=0.999)
    lam_a = lam_u ** (1.0 / LRU_C)
    return {
        "x": nrm((BATCH, SEQ, D), 1.0),
        "c": nrm((BATCH, D), 1.0),
        "ctx": nrm((BATCH, CTX_LEN, D), 1.0),
        "c_ctx": nrm((D,), 1.0),
        "w_mod": nrm((DEPTH, D, 6 * D), 0.5 * D ** -0.5),
        "b_mod": nrm((DEPTH, 6 * D), 0.02),
        "norm1_g": 1.0 + nrm((DEPTH, D), 0.05),
        "norm2_g": 1.0 + nrm((DEPTH, D), 0.05),
        "w_in": nrm((DEPTH, D, D_IN), D ** -0.5),
        "w_out": nrm((DEPTH, D_MIX, D), D_MIX ** -0.5),
        "lru_conv_w": nrm((DEPTH, LRU_CONV, D_LRU), LRU_CONV ** -0.5),
        "lru_conv_b": nrm((DEPTH, D_LRU), 0.02),
        "lru_wr": nrm((DEPTH, 2, LRU_BLOCKS, LRU_BLOCK_DIM, LRU_BLOCK_DIM), LRU_BLOCK_DIM ** -0.5),
        "lru_br": nrm((DEPTH, 2, D_LRU), 0.02),
        "lru_wi": nrm((DEPTH, 2, LRU_BLOCKS, LRU_BLOCK_DIM, LRU_BLOCK_DIM), LRU_BLOCK_DIM ** -0.5),
        "lru_bi": nrm((DEPTH, 2, D_LRU), 0.02),
        "lru_lambda": jnp.log(lam_a) - jnp.log1p(-lam_a),
        "mla_q_norm_g": 1.0 + nrm((DEPTH, MLA_Q_RANK), 0.05),
        "mla_wqb": nrm((DEPTH, MLA_Q_RANK, MLA_HEADS * (MLA_NOPE + MLA_ROPE)), MLA_Q_RANK ** -0.5),
        "mla_kv_norm_g": 1.0 + nrm((DEPTH, MLA_KV_RANK), 0.05),
        "mla_wkvb": nrm((DEPTH, MLA_KV_RANK, MLA_HEADS * (MLA_NOPE + MLA_V)), MLA_KV_RANK ** -0.5),
        "hy_conv_w": nrm((DEPTH, HY_CONV, 3 * D_HY), HY_CONV ** -0.5),
        "hy_conv_b": nrm((DEPTH, 3 * D_HY), 0.02),
        "hy_f_w1": nrm((DEPTH, HY_EMB, HY_FFN), HY_EMB ** -0.5),
        "hy_f_b1": nrm((DEPTH, HY_FFN), 0.1),
        "hy_f_w2": nrm((DEPTH, HY_FFN, HY_FFN), HY_FFN ** -0.5),
        "hy_f_b2": nrm((DEPTH, HY_FFN), 0.1),
        "hy_f_w3": nrm((DEPTH, HY_FFN, 2 * HY_ORDER * D_HY), HY_FFN ** -0.5),
        "hy_f_freq": 1.0 + nrm((DEPTH, HY_FFN), 0.1),
        "hy_decay": jax.random.uniform(next(keys), (DEPTH, 2 * HY_ORDER, D_HY), F32, minval=3.0, maxval=15.0),
        "hy_skip": nrm((DEPTH, HY_ORDER, D_HY), 0.5),
        "peer_wq": nrm((DEPTH, D, PEER_HEADS * PEER_DQ), D ** -0.5),
        "peer_keys": nrm((DEPTH, 2, PEER_NKEYS, PEER_DQ // 2), (PEER_DQ // 2) ** -0.5),
        "peer_u": nrm((DEPTH, PEER_EXPERTS, D), D ** -0.5),
        "peer_v": nrm((DEPTH, PEER_EXPERTS, D), 1.0),
        "final_g": 1.0 + nrm((D,), 0.05),
    }


def reference(x, c, ctx, c_ctx, w_mod, b_mod, norm1_g, norm2_g, w_in, w_out,
              lru_conv_w, lru_conv_b, lru_wr, lru_br, lru_wi, lru_bi, lru_lambda,
              mla_q_norm_g, mla_wqb, mla_kv_norm_g, mla_wkvb,
              hy_conv_w, hy_conv_b, hy_f_w1, hy_f_b1, hy_f_w2, hy_f_b2, hy_f_w3,
              hy_f_freq, hy_decay, hy_skip,
              peer_wq, peer_keys, peer_u, peer_v, final_g):
    for l in range(DEPTH):
        need_ctx = l < DEPTH - 1
        mod_x = jax.nn.silu(c) @ w_mod[l] + b_mod[l]
        mod_c = jax.nn.silu(c_ctx) @ w_mod[l] + b_mod[l]
        sh1, sc1, g1, sh2, sc2, g2 = jnp.split(mod_x[:, None, :], 6, axis=-1)
        csh1, csc1, cg1, csh2, csc2, cg2 = jnp.split(mod_c, 6, axis=-1)

        hx = rmsnorm(x, norm1_g[l]) * (1.0 + sc1) + sh1
        hc = rmsnorm(ctx, norm1_g[l]) * (1.0 + csc1) + csh1
        yx, yc = token_mixer(hx, hc, need_ctx, w_in[l], w_out[l],
                             lru_conv_w[l], lru_conv_b[l], lru_wr[l], lru_br[l], lru_wi[l], lru_bi[l], lru_lambda[l],
                             mla_q_norm_g[l], mla_wqb[l], mla_kv_norm_g[l], mla_wkvb[l],
                             hy_conv_w[l], hy_conv_b[l], hy_f_w1[l], hy_f_b1[l], hy_f_w2[l], hy_f_b2[l], hy_f_w3[l],
                             hy_f_freq[l], hy_decay[l], hy_skip[l])
        x = x + g1 * yx
        hx = rmsnorm(x, norm2_g[l]) * (1.0 + sc2) + sh2
        x = x + g2 * peer(hx, peer_wq[l], peer_keys[l], peer_u[l], peer_v[l])
        if need_ctx:
            ctx = ctx + cg1 * yc
            hc = rmsnorm(ctx, norm2_g[l]) * (1.0 + csc2) + csh2
            ctx = ctx + cg2 * peer(hc, peer_wq[l], peer_keys[l], peer_u[l], peer_v[l])
    return rmsnorm(x, final_g)
```

```cpp
#include <hip/hip_runtime.h>
#include <hip/hip_cooperative_groups.h>
#include <cstdio>
#include <cstdint>
namespace cg = cooperative_groups;

#ifndef MK_SINGLE
#define MK_SINGLE 0
#endif

typedef unsigned short bf16_t;
using bf16x8 = __attribute__((ext_vector_type(8))) short;
using s16x4  = __attribute__((ext_vector_type(4))) short;
using f32x16 = __attribute__((ext_vector_type(16))) float;
using f32x4  = __attribute__((ext_vector_type(4))) float;
using u32x4  = __attribute__((ext_vector_type(4))) unsigned;
using u32x2  = __attribute__((ext_vector_type(2))) unsigned;

constexpr int NB = 2, SEQ = 8192, CTXL = 256, DM = 1024;
constexpr int NLAT = NB * SEQ, NCTX = NB * CTXL, NTOK = NLAT + NCTX;
constexpr int DIN = 2208, DINP = 2304;
constexpr int DLRU = 384, NKEYS = SEQ + CTXL;
constexpr int NTHREADS = 512;
constexpr int NCHUNK = NLAT / 64 + NCTX / 64;
constexpr float EPSV = 1e-6f;

enum { I_X = 0, I_C, I_CTX, I_CCTX, I_WMOD, I_BMOD, I_N1G, I_N2G, I_WIN, I_WOUT, I_LCW, I_LCB, I_LWR, I_LBR, I_LWI, I_LBI, I_LLAM,
       I_QNG, I_WQB, I_KVNG, I_WKVB, I_HCW, I_HCB, I_HW1, I_HB1, I_HW2, I_HB2, I_HW3, I_HFREQ, I_HDECAY, I_HSKIP,
       I_PWQ, I_PKEYS, I_PU, I_PV, I_FG, N_IN };

struct Params { const float* in[N_IN]; float* out; char* ws; };

constexpr size_t al256(size_t x) { return (x + 255) / 256 * 256; }
constexpr size_t OFF_XS    = 0;
constexpr size_t OFF_HB    = OFF_XS    + al256((size_t)NTOK * DM * 4);
constexpr size_t OFF_U     = OFF_HB    + al256((size_t)NTOK * DM * 2);
constexpr size_t OFF_PQ    = OFF_U;
constexpr size_t OFF_MIX   = OFF_U     + al256((size_t)NTOK * DIN * 4);
constexpr size_t OFF_HYIN  = OFF_MIX   + al256((size_t)NTOK * DM * 2);
constexpr size_t OFF_EID   = OFF_HYIN;
constexpr size_t OFF_GATE  = OFF_EID   + al256((size_t)NTOK * 128 * 4);
constexpr size_t OFF_HYINC = OFF_HYIN  + al256((size_t)3 * 2 * 256 * 8192 * 4);
constexpr size_t OFF_QN    = OFF_HYINC + al256((size_t)3 * 2 * 256 * 256 * 4);
constexpr size_t OFF_KVN   = OFF_QN    + al256((size_t)NTOK * 384 * 2);
constexpr size_t OFF_Q     = OFF_KVN   + al256((size_t)NTOK * 256 * 2);
constexpr size_t OFF_QC    = OFF_Q     + al256((size_t)2 * 6 * 8192 * 96 * 2);
constexpr size_t OFF_K     = OFF_QC    + al256((size_t)2 * 6 * 256 * 96 * 2);
constexpr size_t OFF_V     = OFF_K     + al256((size_t)2 * 6 * NKEYS * 96 * 2);
constexpr size_t OFF_LSUM  = OFF_V     + al256((size_t)2 * 6 * NKEYS * 64 * 2);
constexpr size_t OFF_CARRY = OFF_LSUM  + al256((size_t)NCHUNK * 2 * 2 * 384 * 4);
constexpr size_t OFF_MOD   = OFF_CARRY + al256((size_t)NCHUNK * 2 * 384 * 4);
constexpr size_t OFF_MODP  = OFF_MOD   + al256((size_t)2 * 3 * 6144 * 4);
constexpr size_t OFF_WIN   = OFF_MODP  + al256((size_t)2 * 8 * 3 * 6144 * 4);
constexpr size_t OFF_WOUT  = OFF_WIN   + al256((size_t)2 * DINP * 1024 * 2);
constexpr size_t OFF_WQB   = OFF_WOUT  + al256((size_t)2 * 1024 * 1024 * 2);
constexpr size_t OFF_WKVB  = OFF_WQB   + al256((size_t)2 * 640 * 384 * 2);
constexpr size_t OFF_WPQ   = OFF_WKVB  + al256((size_t)2 * 768 * 256 * 2);
constexpr size_t OFF_KEYS  = OFF_WPQ   + al256((size_t)2 * 2048 * 1024 * 2);
constexpr size_t OFF_GW    = OFF_KEYS  + al256((size_t)2 * 2 * 128 * 128 * 2);
constexpr size_t OFF_H2    = OFF_GW    + al256((size_t)2 * 2 * 2 * 6 * 64 * 64 * 2);
constexpr size_t OFF_FILT  = OFF_H2    + al256((size_t)2 * NKEYS * 64 * 4);
constexpr size_t OFF_FILTC = OFF_FILT  + al256((size_t)2 * 1024 * 8192 * 4);
constexpr size_t OFF_SSQP  = OFF_FILTC + al256((size_t)2 * 1024 * 256 * 4);
constexpr size_t OFF_SSQPC = OFF_SSQP  + al256((size_t)2 * 128 * 1024 * 4);
constexpr size_t WS_END    = OFF_SSQPC + al256((size_t)2 * 4 * 1024 * 4);

__device__ __forceinline__ float bf2f(bf16_t v) { return __uint_as_float(((unsigned)v) << 16); }
__device__ __forceinline__ bf16_t f2bf(float f) { unsigned u = __float_as_uint(f); u += 0x7fffu + ((u >> 16) & 1u); return (bf16_t)(u >> 16); }
__device__ __forceinline__ unsigned cvtpk(float lo, float hi) { unsigned r; asm volatile("v_cvt_pk_bf16_f32 %0, %1, %2" : "=v"(r) : "v"(lo), "v"(hi)); return r; }
__device__ __forceinline__ float gelu_tanh(float x) { return 0.5f * x * (1.f + tanhf(0.7978845608028654f * (x + 0.044715f * x * x * x))); }
__device__ __forceinline__ float sigm(float x) { return 1.f / (1.f + __expf(-x)); }
__device__ __forceinline__ float wave_sum(float v) {
#pragma unroll
  for (int o = 32; o > 0; o >>= 1) v += __shfl_xor(v, o);
  return v;
}
__device__ __forceinline__ int crow(int r, int hi) { return (r & 3) + 8 * (r >> 2) + 4 * hi; }
__device__ __forceinline__ void row_info(int r, int& b, int& t, int& isctx) {
  if (r < NLAT) { isctx = 0; b = r >> 13; t = r & (SEQ - 1); } else { isctx = 1; int q = r - NLAT; b = q >> 8; t = q & (CTXL - 1); }
}
__device__ __forceinline__ const float* xrow_src(const Params& p, int layer, int r) {
  if (layer == 0) return (r < NLAT) ? p.in[I_X] + (size_t)r * DM : p.in[I_CTX] + (size_t)(r - NLAT) * DM;
  return (const float*)(p.ws + OFF_XS) + (size_t)r * DM;
}
#define JOB_LOOP(t, ntiles, base) for (int t = (int)(((long)blockIdx.x - ((base) % (long)gridDim.x) + gridDim.x) % gridDim.x); t < (ntiles); t += gridDim.x)

__device__ void transpose_cvt_job(const float* __restrict__ src, bf16_t* __restrict__ dst, int K, int N, int Npad, char* smem, long& base) {
  float* tile = (float*)smem;
  const int tk = K / 64, tn = Npad / 64, nt = tk * tn;
  JOB_LOOP(t, nt, base) {
    const int k0 = (t % tk) * 64, n0 = (t / tk) * 64;
    __syncthreads();
    for (int e = threadIdx.x; e < 4096; e += NTHREADS) { int i = e >> 6, j = e & 63; int n = n0 + j; tile[j * 65 + i] = (n < N) ? src[(size_t)(k0 + i) * N + n] : 0.f; }
    __syncthreads();
    for (int e = threadIdx.x; e < 4096; e += NTHREADS) { int j = e >> 6, i = e & 63; dst[(size_t)(n0 + j) * K + k0 + i] = f2bf(tile[j * 65 + i]); }
  }
  base += nt;
}

__device__ void stage_prep(const Params& p, char* smem) {
  long base = 0;
  for (int l = 0; l < 2; ++l) {
    transpose_cvt_job(p.in[I_WIN] + (size_t)l * 1024 * DIN, (bf16_t*)(p.ws + OFF_WIN) + (size_t)l * DINP * 1024, 1024, DIN, DINP, smem, base);
    transpose_cvt_job(p.in[I_WOUT] + (size_t)l * 1024 * 1024, (bf16_t*)(p.ws + OFF_WOUT) + (size_t)l * 1024 * 1024, 1024, 1024, 1024, smem, base);
    transpose_cvt_job(p.in[I_WQB] + (size_t)l * 384 * 576, (bf16_t*)(p.ws + OFF_WQB) + (size_t)l * 640 * 384, 384, 576, 640, smem, base);
    transpose_cvt_job(p.in[I_WKVB] + (size_t)l * 256 * 768, (bf16_t*)(p.ws + OFF_WKVB) + (size_t)l * 768 * 256, 256, 768, 768, smem, base);
    transpose_cvt_job(p.in[I_PWQ] + (size_t)l * 1024 * 2048, (bf16_t*)(p.ws + OFF_WPQ) + (size_t)l * 2048 * 1024, 1024, 2048, 2048, smem, base);
    for (int d = 0; d < 2; ++d) for (int n = 0; n < 6; ++n) {
      const size_t so = ((size_t)(l * 2 + d) * 6 + n) * 4096;
      transpose_cvt_job(p.in[I_LWR] + so, (bf16_t*)(p.ws + OFF_GW) + ((size_t)((l * 2 + d) * 2 + 0) * 6 + n) * 4096, 64, 64, 64, smem, base);
      transpose_cvt_job(p.in[I_LWI] + so, (bf16_t*)(p.ws + OFF_GW) + ((size_t)((l * 2 + d) * 2 + 1) * 6 + n) * 4096, 64, 64, 64, smem, base);
    }
  }
  {
    const float* src = p.in[I_PKEYS]; bf16_t* dst = (bf16_t*)(p.ws + OFF_KEYS);
    for (int e = blockIdx.x * NTHREADS + threadIdx.x; e < 2 * 2 * 128 * 128; e += gridDim.x * NTHREADS) dst[e] = f2bf(src[e]);
  }
  {
    float* modp = (float*)(p.ws + OFF_MODP);
    JOB_LOOP(it, 192, base) {
      const int l = it / 96, ks = (it % 96) / 12, cgp = it % 12;
      const int col = cgp * 512 + threadIdx.x;
      const float* w = p.in[I_WMOD] + (size_t)l * 1024 * 6144 + col;
      float a0 = 0.f, a1 = 0.f, a2 = 0.f;
      for (int k = ks * 128; k < ks * 128 + 128; ++k) {
        const float wv = w[(size_t)k * 6144];
        const float c0 = p.in[I_C][k], c1 = p.in[I_C][1024 + k], c2 = p.in[I_CCTX][k];
        a0 += c0 * sigm(c0) * wv; a1 += c1 * sigm(c1) * wv; a2 += c2 * sigm(c2) * wv;
      }
      float* o = modp + ((size_t)(l * 8 + ks) * 3) * 6144 + col;
      o[0] = a0; o[6144] = a1; o[2 * 6144] = a2;
    }
    base += 192;
  }
  {
    const int lane = threadIdx.x & 63, wid = threadIdx.x >> 6;
    for (int it = blockIdx.x * 8 + wid; it < 2 * NKEYS; it += gridDim.x * 8) {
      const int l = it / NKEYS, pos = it % NKEYS;
      const float tn = (pos < SEQ) ? (float)pos / (float)SEQ : (float)(pos - SEQ) / (float)CTXL;
      const float* w1 = p.in[I_HW1] + (size_t)l * 17 * 64; const float* b1 = p.in[I_HB1] + l * 64;
      const float* w2 = p.in[I_HW2] + (size_t)l * 64 * 64; const float* b2 = p.in[I_HB2] + l * 64;
      const float fr = p.in[I_HFREQ][l * 64 + lane];
      float pre = b1[lane] + tn * w1[lane];
#pragma unroll
      for (int i = 0; i < 8; ++i) {
        const float band = 1e-4f + (float)i * ((7.f - 1e-4f) / 7.f);
        const float wp = (6.283185307179586f * tn) * band;
        pre += cosf(wp) * w1[(1 + i) * 64 + lane] + sinf(wp) * w1[(9 + i) * 64 + lane];
      }
      const float h1 = sinf(fr * pre);
      float pre2 = b2[lane];
      for (int i = 0; i < 64; ++i) pre2 += __shfl(h1, i) * w2[i * 64 + lane];
      ((float*)(p.ws + OFF_H2))[((size_t)l * NKEYS + pos) * 64 + lane] = sinf(fr * pre2);
    }
  }
}

__device__ void stage_prep2(const Params& p, char* smem) {
  {
    float* mod = (float*)(p.ws + OFF_MOD); const float* modp = (const float*)(p.ws + OFF_MODP);
    for (int e = blockIdx.x * NTHREADS + threadIdx.x; e < 2 * 3 * 6144; e += gridDim.x * NTHREADS) {
      const int l = e / (3 * 6144), w = (e / 6144) % 3, col = e % 6144;
      float s = p.in[I_BMOD][l * 6144 + col];
      for (int ks = 0; ks < 8; ++ks) s += modp[((size_t)(l * 8 + ks) * 3 + w) * 6144 + col];
      mod[e] = s;
    }
  }
  float* h2t = (float*)smem;
  float* w3t = h2t + 64 * 65;
  const int tloc = threadIdx.x & 63, cgp = threadIdx.x >> 6, lane = threadIdx.x & 63;
  for (int it = blockIdx.x; it < 2 * 132 * 16; it += gridDim.x) {
    const int l = it / (132 * 16), tt = (it / 16) % 132, ct = it % 16;
    const bool isc = tt >= 128; const int L = isc ? CTXL : SEQ; const int t0 = isc ? (tt - 128) * 64 : tt * 64;
    const int pos0 = isc ? SEQ + t0 : t0;
    const float* h2 = (const float*)(p.ws + OFF_H2) + ((size_t)l * NKEYS + pos0) * 64;
    const float* w3 = p.in[I_HW3] + (size_t)l * 64 * 1024 + ct * 64;
    __syncthreads();
    for (int e = threadIdx.x; e < 4096; e += NTHREADS) { int i = e >> 6, j = e & 63; h2t[i * 65 + j] = h2[i * 64 + j]; w3t[i * 64 + j] = w3[(size_t)i * 1024 + j]; }
    __syncthreads();
    float acc[8];
#pragma unroll
    for (int cc = 0; cc < 8; ++cc) acc[cc] = 0.f;
#pragma unroll 2
    for (int i = 0; i < 64; ++i) {
      const float hv = h2t[tloc * 65 + i];
#pragma unroll
      for (int cc = 0; cc < 8; ++cc) acc[cc] += hv * w3t[i * 64 + cgp * 8 + cc];
    }
    const float tn = (float)(t0 + tloc) / (float)L;
#pragma unroll
    for (int cc = 0; cc < 8; ++cc) {
      const int col = ct * 64 + cgp * 8 + cc;
      const float val = acc[cc] * __expf(-tn * p.in[I_HDECAY][l * 1024 + col]);
      if (isc) ((float*)(p.ws + OFF_FILTC))[((size_t)l * 1024 + col) * CTXL + t0 + tloc] = val;
      else     ((float*)(p.ws + OFF_FILT))[((size_t)l * 1024 + col) * SEQ + t0 + tloc] = val;
      const float s = wave_sum(val * val);
      if (lane == 0) {
        if (isc) ((float*)(p.ws + OFF_SSQPC))[((size_t)l * 4 + (tt - 128)) * 1024 + col] = s;
        else     ((float*)(p.ws + OFF_SSQP))[((size_t)l * 128 + tt) * 1024 + col] = s;
      }
    }
  }
}

__device__ void stage_norm(const Params& p, int layer, int which  , int nrows) {
  const int lane = threadIdx.x & 63, wid = threadIdx.x >> 6;
  const float* g = p.in[which ? I_N2G : I_N1G] + layer * DM;
  bf16_t* hb = (bf16_t*)(p.ws + OFF_HB);
  for (int r = blockIdx.x * 8 + wid; r < nrows; r += gridDim.x * 8) {
    int b, t, isc; row_info(r, b, t, isc);
    const float* src = (which == 0) ? xrow_src(p, layer, r) : (const float*)(p.ws + OFF_XS) + (size_t)r * DM;
    const float* mod = (const float*)(p.ws + OFF_MOD) + ((size_t)layer * 3 + (isc ? 2 : b)) * 6144 + (which ? 3072 : 0);
    f32x4 v[4]; float ss = 0.f;
#pragma unroll
    for (int i = 0; i < 4; ++i) { v[i] = *(const f32x4*)(src + (i * 64 + lane) * 4); ss += v[i][0] * v[i][0] + v[i][1] * v[i][1] + v[i][2] * v[i][2] + v[i][3] * v[i][3]; }
    ss = wave_sum(ss);
    const float rinv = rsqrtf(ss * (1.f / DM) + EPSV);
#pragma unroll
    for (int i = 0; i < 4; ++i) {
      const int c0 = (i * 64 + lane) * 4;
      float y[4];
#pragma unroll
      for (int j = 0; j < 4; ++j) y[j] = v[i][j] * rinv * g[c0 + j] * (1.f + mod[1024 + c0 + j]) + mod[c0 + j];
      u32x2 o = {cvtpk(y[0], y[1]), cvtpk(y[2], y[3])};
      *(u32x2*)(hb + (size_t)r * DM + c0) = o;
    }
  }
}

template <class Epi>
__device__ void gemm_bt(const bf16_t* __restrict__ A, int lda, const bf16_t* __restrict__ Bt, int ldb, int M, int N, int K, Epi epi, char* smem) {
  const int tid = threadIdx.x, wid = tid >> 6, lane = tid & 63, r32 = lane & 31, hi = lane >> 5;
  const int wm = wid >> 2, wn = wid & 3;
  constexpr int RS = 144;
  char* sA = smem; char* sB = smem + 128 * RS;
  const int tilesM = M / 128, tilesN = N / 128, nk = K / 64;
  const int lr0 = tid >> 3, lc = (tid & 7) * 8;
  for (int tile = blockIdx.x; tile < tilesM * tilesN; tile += gridDim.x) {
    const int tm = tile / tilesN, tn = tile % tilesN;
    const bf16_t* Ap = A + (size_t)(tm * 128 + lr0) * lda + lc;
    const bf16_t* Bp = Bt + (size_t)(tn * 128 + lr0) * ldb + lc;
    f32x16 acc0 = {}, acc1 = {};
    u32x4 ra0 = *(const u32x4*)Ap, ra1 = *(const u32x4*)(Ap + (size_t)64 * lda);
    u32x4 rb0 = *(const u32x4*)Bp, rb1 = *(const u32x4*)(Bp + (size_t)64 * ldb);
    for (int kt = 0; kt < nk; ++kt) {
      __syncthreads();
      *(u32x4*)(sA + lr0 * RS + lc * 2) = ra0; *(u32x4*)(sA + (lr0 + 64) * RS + lc * 2) = ra1;
      *(u32x4*)(sB + lr0 * RS + lc * 2) = rb0; *(u32x4*)(sB + (lr0 + 64) * RS + lc * 2) = rb1;
      __syncthreads();
      if (kt + 1 < nk) {
        const int ko = (kt + 1) * 64;
        ra0 = *(const u32x4*)(Ap + ko); ra1 = *(const u32x4*)(Ap + (size_t)64 * lda + ko);
        rb0 = *(const u32x4*)(Bp + ko); rb1 = *(const u32x4*)(Bp + (size_t)64 * ldb + ko);
      }
#pragma unroll
      for (int ks = 0; ks < 4; ++ks) {
        const int cb = (ks * 16 + hi * 8) * 2;
        const bf16x8 a0 = *(const bf16x8*)(sA + (wm * 64 + r32) * RS + cb);
        const bf16x8 a1 = *(const bf16x8*)(sA + (wm * 64 + 32 + r32) * RS + cb);
        const bf16x8 bb = *(const bf16x8*)(sB + (wn * 32 + r32) * RS + cb);
        acc0 = __builtin_amdgcn_mfma_f32_32x32x16_bf16(a0, bb, acc0, 0, 0, 0);
        acc1 = __builtin_amdgcn_mfma_f32_32x32x16_bf16(a1, bb, acc1, 0, 0, 0);
      }
    }
    const int col = tn * 128 + wn * 32 + r32;
#pragma unroll
    for (int r = 0; r < 16; ++r) {
      epi(tm * 128 + wm * 64 + crow(r, hi), col, acc0[r]);
      epi(tm * 128 + wm * 64 + 32 + crow(r, hi), col, acc1[r]);
    }
  }
}

__device__ __forceinline__ float rope_apply(float x, float xp, int c, int t) {
  const int i = c & 7; const float pos = ((c >> 4) & 1) ? (float)(t & 63) : (float)(t >> 6);
  const float inv = __expf(-(float)i * (9.210340371976184f / 8.f));
  const float ang = pos * inv;
  const float cs = cosf(ang), sn = sinf(ang);
  return x * cs + ((c & 8) ? xp : -xp) * sn;
}

__device__ void lru_units(const Params& p, int layer, int mode, char* smem) {
  const int tid = threadIdx.x, wid = tid >> 6, lane = tid & 63, r32 = lane & 31, hi = lane >> 5;
  float* xcf = (float*)smem;
  char* xcb = smem + 16384;
  float* As = (float*)(smem + 16384 + 9216);
  float* Bs = As + 2 * 64 * 64;
  const float* u = (const float*)(p.ws + OFF_U);
  const float* cw = p.in[I_LCW] + (size_t)layer * 4 * DLRU; const float* cbias = p.in[I_LCB] + layer * DLRU;
  for (int unit = blockIdx.x; unit < NCHUNK * 6; unit += gridDim.x) {
    const int cid = unit / 6, n = unit % 6;
    int rbase, t0, slen;
    if (cid < 256) { const int b = cid >> 7, ch = cid & 127; rbase = b * SEQ; t0 = ch * 64; slen = SEQ; }
    else { const int q = cid - 256, b = q >> 2, ch = q & 3; rbase = NLAT + b * CTXL; t0 = ch * 64; slen = CTXL; }
    __syncthreads();
    {
      const int d = tid & 63, dch = n * 64 + d;
      const float w0 = cw[dch], w1 = cw[DLRU + dch], w2 = cw[2 * DLRU + dch], w3 = cw[3 * DLRU + dch], bb = cbias[dch];
      for (int i = 0; i < 8; ++i) {
        const int tl = (tid >> 6) + 8 * i, t = t0 + tl;
        float acc = bb;
        if (t - 2 >= 0)   acc += w0 * u[(size_t)(rbase + t - 2) * DIN + dch];
        if (t - 1 >= 0)   acc += w1 * u[(size_t)(rbase + t - 1) * DIN + dch];
        acc += w2 * u[(size_t)(rbase + t) * DIN + dch];
        if (t + 1 < slen) acc += w3 * u[(size_t)(rbase + t + 1) * DIN + dch];
        xcf[tl * 64 + d] = acc;
        *(bf16_t*)(xcb + tl * 144 + d * 2) = f2bf(acc);
      }
    }
    __syncthreads();
    {
      const int dir = wid & 1, mh = (wid >> 1) & 1, nt = wid >> 2;
      const bf16_t* gwr = (const bf16_t*)(p.ws + OFF_GW) + ((size_t)((layer * 2 + dir) * 2 + 0) * 6 + n) * 4096;
      const bf16_t* gwi = (const bf16_t*)(p.ws + OFF_GW) + ((size_t)((layer * 2 + dir) * 2 + 1) * 6 + n) * 4096;
      f32x16 accR = {}, accI = {};
#pragma unroll
      for (int ks = 0; ks < 4; ++ks) {
        const bf16x8 a = *(const bf16x8*)(xcb + (mh * 32 + r32) * 144 + (ks * 16 + hi * 8) * 2);
        const bf16x8 br_ = *(const bf16x8*)(gwr + (nt * 32 + r32) * 64 + ks * 16 + hi * 8);
        const bf16x8 bi_ = *(const bf16x8*)(gwi + (nt * 32 + r32) * 64 + ks * 16 + hi * 8);
        accR = __builtin_amdgcn_mfma_f32_32x32x16_bf16(a, br_, accR, 0, 0, 0);
        accI = __builtin_amdgcn_mfma_f32_32x32x16_bf16(a, bi_, accI, 0, 0, 0);
      }
      const int e = nt * 32 + r32, ch = n * 64 + e;
      const size_t po = (size_t)(layer * 2 + dir) * DLRU + ch;
      const float brv = p.in[I_LBR][po], biv = p.in[I_LBI][po];
      const float lam = p.in[I_LLAM][po];
      const float cl = -8.f * log1pf(__expf(-lam));
#pragma unroll
      for (int r = 0; r < 16; ++r) {
        const int tl = mh * 32 + crow(r, hi);
        const float rr = sigm(accR[r] + brv), ii = sigm(accI[r] + biv);
        const float la = rr * cl;
        const float a = __expf(la);
        const float bco = sqrtf(-expm1f(2.f * la)) * (ii * xcf[tl * 64 + e]);
        As[(dir * 64 + tl) * 64 + e] = a; Bs[(dir * 64 + tl) * 64 + e] = bco;
      }
    }
    __syncthreads();
    if (tid < 128) {
      const int dir = tid >> 6, e = tid & 63, ch = n * 64 + e;
      if (mode == 0) {
        float h = 0.f, P = 1.f;
        if (dir == 0) { for (int t = 0; t < 64; ++t) { const float a = As[t * 64 + e]; h = a * h + Bs[t * 64 + e]; P *= a; } }
        else { for (int t = 63; t >= 0; --t) { const float a = As[(64 + t) * 64 + e]; h = a * h + Bs[(64 + t) * 64 + e]; P *= a; } }
        float* ls = (float*)(p.ws + OFF_LSUM) + ((size_t)(cid * 2 + dir) * 2) * DLRU + ch;
        ls[0] = P; ls[DLRU] = h;
      } else {
        float h = ((const float*)(p.ws + OFF_CARRY))[(size_t)(cid * 2 + dir) * DLRU + ch];
        if (dir == 0) { for (int t = 0; t < 64; ++t) { h = As[t * 64 + e] * h + Bs[t * 64 + e]; Bs[t * 64 + e] = h; } }
        else { for (int t = 63; t >= 0; --t) { h = As[(64 + t) * 64 + e] * h + Bs[(64 + t) * 64 + e]; Bs[(64 + t) * 64 + e] = h; } }
      }
    }
    if (mode == 1) {
      __syncthreads();
      bf16_t* mix = (bf16_t*)(p.ws + OFF_MIX);
      const int e = tid & 63;
      for (int i = 0; i < 8; ++i) {
        const int tl = (tid >> 6) + 8 * i; const size_t row = (size_t)rbase + t0 + tl;
        const float y = Bs[tl * 64 + e] + Bs[(64 + tl) * 64 + e];
        const float gt = u[row * DIN + DLRU + n * 64 + e];
        mix[row * DM + n * 64 + e] = f2bf(y * gelu_tanh(gt));
      }
    }
  }
}

__device__ void lru_carry(const Params& p) {
  const int idx = blockIdx.x * NTHREADS + threadIdx.x;
  if (idx >= 2 * 2 * DLRU) return;
  const int b = idx / (2 * DLRU), dir = (idx / DLRU) & 1, ch = idx % DLRU;
  const float* ls = (const float*)(p.ws + OFF_LSUM); float* cr = (float*)(p.ws + OFF_CARRY);
  float st = 0.f;
  for (int k = 0; k < 4 + 128; ++k) {
    int cid;
    if (dir == 0) cid = (k < 4) ? 256 + b * 4 + k : b * 128 + (k - 4);
    else          cid = (k < 4) ? 256 + b * 4 + (3 - k) : b * 128 + (127 - (k - 4));
    cr[(size_t)(cid * 2 + dir) * DLRU + ch] = st;
    const float P = ls[((size_t)(cid * 2 + dir) * 2) * DLRU + ch], H = ls[((size_t)(cid * 2 + dir) * 2 + 1) * DLRU + ch];
    st = P * st + H;
  }
}

__device__ void mla_prep(const Params& p, int layer) {
  const int lane = threadIdx.x & 63, wid = threadIdx.x >> 6;
  const float* u = (const float*)(p.ws + OFF_U);
  const float* qg = p.in[I_QNG] + layer * 384; const float* kvg = p.in[I_KVNG] + layer * 256;
  bf16_t* qn = (bf16_t*)(p.ws + OFF_QN); bf16_t* kvn = (bf16_t*)(p.ws + OFF_KVN); bf16_t* Kb = (bf16_t*)(p.ws + OFF_K);
  for (int r = blockIdx.x * 8 + wid; r < NTOK; r += gridDim.x * 8) {
    int b, t, isc; row_info(r, b, t, isc);
    const float* ur = u + (size_t)r * DIN;
    float q[6], ss = 0.f;
#pragma unroll
    for (int i = 0; i < 6; ++i) { q[i] = ur[768 + i * 64 + lane]; ss += q[i] * q[i]; }
    ss = wave_sum(ss);
    float rinv = rsqrtf(ss * (1.f / 384.f) + EPSV);
#pragma unroll
    for (int i = 0; i < 6; ++i) qn[(size_t)r * 384 + i * 64 + lane] = f2bf(q[i] * rinv * qg[i * 64 + lane]);
    float kv[4]; ss = 0.f;
#pragma unroll
    for (int i = 0; i < 4; ++i) { kv[i] = ur[1152 + i * 64 + lane]; ss += kv[i] * kv[i]; }
    ss = wave_sum(ss);
    rinv = rsqrtf(ss * (1.f / 256.f) + EPSV);
#pragma unroll
    for (int i = 0; i < 4; ++i) kvn[(size_t)r * 256 + i * 64 + lane] = f2bf(kv[i] * rinv * kvg[i * 64 + lane]);
    const float kr = ur[1408 + (lane & 31)];
    const float krp = __shfl_xor(kr, 8);
    const float ko = isc ? kr : rope_apply(kr, krp, lane & 31, t);
    if (lane < 32) {
      const int tk = isc ? t : CTXL + t; const bf16_t kb = f2bf(ko);
#pragma unroll
      for (int h = 0; h < 6; ++h) Kb[((size_t)(b * 6 + h) * NKEYS + tk) * 96 + 64 + lane] = kb;
    }
  }
}

__device__ void hyena_prep(const Params& p, int layer, char* smem) {
  float* tile = (float*)smem;
  const float* u = (const float*)(p.ws + OFF_U);
  const float* cw = p.in[I_HCW] + (size_t)layer * 3 * 768; const float* cb = p.in[I_HCB] + layer * 768;
  const int ntile = (layer == 0) ? NCHUNK : 256;
  for (int unit = blockIdx.x; unit < ntile * 3; unit += gridDim.x) {
    const int cid = unit / 3, part = unit % 3;
    int rbase, t0, slen, b;
    if (cid < 256) { b = cid >> 7; rbase = b * SEQ; t0 = (cid & 127) * 64; slen = SEQ; }
    else { const int q = cid - 256; b = q >> 2; rbase = NLAT + b * CTXL; t0 = (q & 3) * 64; slen = CTXL; }
    __syncthreads();
    {
      const int c = threadIdx.x & 255, pc = part * 256 + c;
      const float w0 = cw[pc], w1 = cw[768 + pc], w2 = cw[1536 + pc], bb = cb[pc];
      for (int i = 0; i < 32; ++i) {
        const int tl = (threadIdx.x >> 8) + 2 * i, t = t0 + tl;
        float acc = bb + w1 * u[(size_t)(rbase + t) * DIN + 1440 + pc];
        if (t - 1 >= 0)   acc += w0 * u[(size_t)(rbase + t - 1) * DIN + 1440 + pc];
        if (t + 1 < slen) acc += w2 * u[(size_t)(rbase + t + 1) * DIN + 1440 + pc];
        tile[c * 65 + tl] = acc;
      }
    }
    __syncthreads();
    {
      const int tl = threadIdx.x & 63;
      float* dst = (cid < 256) ? (float*)(p.ws + OFF_HYIN) + ((size_t)(part * 2 + b) * 256) * SEQ
                               : (float*)(p.ws + OFF_HYINC) + ((size_t)(part * 2 + b) * 256) * CTXL;
      for (int i = 0; i < 32; ++i) { const int c = (threadIdx.x >> 6) + 8 * i; dst[(size_t)c * slen + t0 + tl] = tile[c * 65 + tl]; }
    }
  }
}

__device__ void hyena_direct(const Params& p, int layer, char* smem) {
  float* zs = (float*)smem;
  float* Ts = zs + SEQ;
  bf16_t* mix = (bf16_t*)(p.ws + OFF_MIX);
  const int nunits = (layer == 0) ? 1024 : 512;
  for (int unit = blockIdx.x; unit < nunits; unit += gridDim.x) {
    const bool isc = unit >= 512; const int q = unit & 511, b = q >> 8, c = q & 255;
    const int L = isc ? CTXL : SEQ;
    const float* hin = isc ? (const float*)(p.ws + OFF_HYINC) : (const float*)(p.ws + OFF_HYIN);
    const float* filt = isc ? (const float*)(p.ws + OFF_FILTC) + (size_t)layer * 1024 * CTXL : (const float*)(p.ws + OFF_FILT) + (size_t)layer * 1024 * SEQ;
    const float* ssq = isc ? (const float*)(p.ws + OFF_SSQPC) + (size_t)layer * 4 * 1024 : (const float*)(p.ws + OFF_SSQP) + (size_t)layer * 128 * 1024;
    const int ntt = isc ? 4 : 128;
    const int nout = (L + NTHREADS - 1) / NTHREADS;
    for (int order = 0; order < 2; ++order) {
      const int colf = (order * 2 + 0) * 256 + c, colb = (order * 2 + 1) * 256 + c;
      float sf = 0.f, sb = 0.f;
      for (int tt = 0; tt < ntt; ++tt) { sf += ssq[(size_t)tt * 1024 + colf]; sb += ssq[(size_t)tt * 1024 + colb]; }
      sf = rsqrtf(sf + EPSV); sb = rsqrtf(sb + EPSV);
      const float skip = p.in[I_HSKIP][(size_t)layer * 512 + order * 256 + c];
      __syncthreads();
      for (int i = threadIdx.x; i < 2 * L; i += NTHREADS) {
        const int m = i - L;
        float v = 0.f;
        if (m >= 0) v = filt[(size_t)colf * L + m] * sf; else if (m > -L) v = filt[(size_t)colb * L - m] * sb;
        if (m == 0) v += skip;
        Ts[i] = v;
      }
      if (order == 0) for (int i = threadIdx.x; i < L; i += NTHREADS) zs[i] = hin[((size_t)(0 * 2 + b) * 256 + c) * L + i];
      __syncthreads();
      float acc[16];
#pragma unroll
      for (int j = 0; j < 16; ++j) acc[j] = 0.f;
      if ((int)threadIdx.x < L) {
        const float* tb = Ts + L + threadIdx.x;
        if (!isc) {
          for (int s = 0; s < SEQ; ++s) {
            const float zv = zs[s];
#pragma unroll
            for (int j = 0; j < 16; ++j) acc[j] += tb[j * NTHREADS - s] * zv;
          }
        } else {
          for (int s = 0; s < CTXL; ++s) acc[0] += tb[-s] * zs[s];
        }
      }
      __syncthreads();
      const float* xg = hin + ((size_t)((1 + order) * 2 + b) * 256 + c) * L;
#pragma unroll
      for (int j = 0; j < 16; ++j) {
        const int t = threadIdx.x + j * NTHREADS;
        if (t < L) {
          const float y = xg[t] * acc[j];
          if (order == 0) zs[t] = y;
          else { const size_t row = isc ? (size_t)NLAT + b * CTXL + t : (size_t)b * SEQ + t; mix[row * DM + 768 + c] = f2bf(y); }
        }
      }
    }
  }
}

namespace att {
constexpr int NW = 8, QBLK = 32, KVBLK = 64;
constexpr float SCALE = 0.10206207261596575f;
constexpr float THR = 8.f;
constexpr int SHM_V = KVBLK * 128 * 2, SHM_K = KVBLK * 128 * 2;
constexpr int SHM_ATTN = 2 * SHM_V + 2 * SHM_K + NW * 64 * 4;
#define KSWZ(row, colB) ((row) * 256 + ((colB) ^ (((row) & 7) << 4)))
#define SBAR() __builtin_amdgcn_sched_barrier(0)
__device__ __forceinline__ void partialSM(f32x16& p0, f32x16& p1, float& m_reg, float& mn, float& alpha) {
  constexpr float C = SCALE * 1.4426950408889634f;
  float pmax = p0[0];
#pragma unroll
  for (int r = 1; r < 16; ++r) pmax = fmaxf(pmax, p0[r]);
#pragma unroll
  for (int r = 0; r < 16; ++r) pmax = fmaxf(pmax, p1[r]);
  { auto rr = __builtin_amdgcn_permlane32_swap(__float_as_uint(pmax), __float_as_uint(pmax), false, false);
    pmax = fmaxf(__uint_as_float(rr[0]), __uint_as_float(rr[1])); }
  if (__builtin_expect(__all(pmax - m_reg <= THR / SCALE), 1)) { mn = m_reg; alpha = 1.f; }
  else { mn = fmaxf(m_reg, pmax); alpha = __builtin_amdgcn_exp2f((m_reg - mn) * C); m_reg = mn; }
  const float mnC = -mn * C;
#pragma unroll
  for (int r = 0; r < 16; ++r) p0[r] = fmaf(p0[r], C, mnC);
#pragma unroll
  for (int r = 0; r < 16; ++r) p1[r] = fmaf(p1[r], C, mnC);
#pragma unroll
  for (int r = 0; r < 16; ++r) p0[r] = __builtin_amdgcn_exp2f(p0[r]);
}
__device__ __forceinline__ void finishSM(f32x16& p0, f32x16& p1, float alpha, float& l_reg, bf16x8& pa0, bf16x8& pa1, bf16x8& pa2, bf16x8& pa3) {
#pragma unroll
  for (int r = 0; r < 16; ++r) p1[r] = __builtin_amdgcn_exp2f(p1[r]);
  float ps = 0;
#pragma unroll
  for (int r = 0; r < 16; ++r) ps += p0[r];
#pragma unroll
  for (int r = 0; r < 16; ++r) ps += p1[r];
  { auto rr = __builtin_amdgcn_permlane32_swap(__float_as_uint(ps), __float_as_uint(ps), false, false);
    ps = __uint_as_float(rr[0]) + __uint_as_float(rr[1]); }
  l_reg = l_reg * alpha + ps;
#define PK4(P, BASE, OUT) do { unsigned a0 = cvtpk(P[BASE + 0], P[BASE + 1]), a1 = cvtpk(P[BASE + 2], P[BASE + 3]);   \
    unsigned b0 = cvtpk(P[BASE + 4], P[BASE + 5]), b1 = cvtpk(P[BASE + 6], P[BASE + 7]);                              \
    auto r0 = __builtin_amdgcn_permlane32_swap(a0, b0, false, false); auto r1 = __builtin_amdgcn_permlane32_swap(a1, b1, false, false); \
    u32x4 w = {r0[0], r1[0], r0[1], r1[1]}; OUT = *reinterpret_cast<bf16x8*>(&w); } while (0)
  PK4(p0, 0, pa0); PK4(p0, 8, pa1); PK4(p1, 0, pa2); PK4(p1, 8, pa3);
#undef PK4
}
__device__ __forceinline__ void qkt(f32x16& p0, f32x16& p1, const char* Ks, const bf16x8* qr, int r32, int hi) {
  p0 = f32x16{}; p1 = f32x16{};
#pragma unroll
  for (int d0 = 0; d0 < 6; ++d0) { const int cb = (d0 * 16 + hi * 8) * 2;
    const bf16x8 b0 = *reinterpret_cast<const bf16x8*>(Ks + KSWZ(r32, cb));
    const bf16x8 b1 = *reinterpret_cast<const bf16x8*>(Ks + KSWZ(32 + r32, cb));
    p0 = __builtin_amdgcn_mfma_f32_32x32x16_bf16(b0, qr[d0], p0, 0, 0, 0);
    p1 = __builtin_amdgcn_mfma_f32_32x32x16_bf16(b1, qr[d0], p1, 0, 0, 0); }
}
__device__ __forceinline__ int v_st(int k, int c) { const int kk = (k & ~0xC) | ((k & 4) << 1) | ((k & 8) >> 1); return ((kk >> 3) * 4 + (c >> 5)) * 512 + ((kk & 7) * 32 + (c & 31)) * 2; }
__device__ __forceinline__ int v_rd_base(int lane) { return ((lane & 3) << 3) | (((lane >> 2) & 3) << 6) | (((lane >> 4) & 1) << 5) | (((lane >> 5) & 1) << 8); }
constexpr int v_rd_off(int d0, int ks, int half) { return d0 * 512 + ks * 4096 + half * 2048; }
template <int OFF> __device__ __forceinline__ s16x4 tr_read(int vb) {
  s16x4 r; asm volatile("ds_read_b64_tr_b16 %0, %1 offset:%2" : "=&v"(r) : "v"(vb), "i"(OFF) : "memory"); return r;
}
template <int D0> __device__ __forceinline__ void pv_one(f32x16& od, int vb, bf16x8 pa0, bf16x8 pa1, bf16x8 pa2, bf16x8 pa3) {
  const s16x4 l0 = tr_read<v_rd_off(D0, 0, 0)>(vb), h0 = tr_read<v_rd_off(D0, 0, 1)>(vb), l1 = tr_read<v_rd_off(D0, 1, 0)>(vb), h1 = tr_read<v_rd_off(D0, 1, 1)>(vb);
  const s16x4 l2 = tr_read<v_rd_off(D0, 2, 0)>(vb), h2 = tr_read<v_rd_off(D0, 2, 1)>(vb), l3 = tr_read<v_rd_off(D0, 3, 0)>(vb), h3 = tr_read<v_rd_off(D0, 3, 1)>(vb);
  asm volatile("s_waitcnt lgkmcnt(0)" ::: "memory"); SBAR();
#define PK(L, H) (bf16x8){L[0], L[1], L[2], L[3], H[0], H[1], H[2], H[3]}
  od = __builtin_amdgcn_mfma_f32_32x32x16_bf16(pa0, PK(l0, h0), od, 0, 0, 0);
  od = __builtin_amdgcn_mfma_f32_32x32x16_bf16(pa1, PK(l1, h1), od, 0, 0, 0);
  od = __builtin_amdgcn_mfma_f32_32x32x16_bf16(pa2, PK(l2, h2), od, 0, 0, 0);
  od = __builtin_amdgcn_mfma_f32_32x32x16_bf16(pa3, PK(l3, h3), od, 0, 0, 0);
#undef PK
}
__device__ __forceinline__ void pv_d0(f32x16& o0, f32x16& o1, int vb, bf16x8 pa0, bf16x8 pa1, bf16x8 pa2, bf16x8 pa3) {
  pv_one<0>(o0, vb, pa0, pa1, pa2, pa3); pv_one<1>(o1, vb, pa0, pa1, pa2, pa3);
}
__device__ __forceinline__ void attn_body(const bf16_t* __restrict__ Qb, const bf16_t* __restrict__ Kh, const bf16_t* __restrict__ Vh,
                                          bf16_t* __restrict__ Ob, int seq, char* lds) {
  const int tid = threadIdx.x, wid = tid >> 6, lane = tid & 63, r32 = lane & 31, hi = lane >> 5;
  char* V_lds = lds; char* K_lds = lds + 2 * SHM_V;
  float* ws = (float*)(lds + 2 * SHM_V + 2 * SHM_K) + wid * 64; float* li_l = ws; float* al_l = ws + 32;
  float m_reg = -1e30f, l_reg = 0; f32x16 o0 = {}, o1 = {}; bf16x8 qr[6];
  const bf16_t* Qw = Qb + (size_t)(wid * QBLK + r32) * 96 + hi * 8;
#pragma unroll
  for (int d0 = 0; d0 < 6; ++d0) qr[d0] = *(const bf16x8*)(Qw + d0 * 16);
  const int sr = tid >> 4, sc = (tid & 15) * 8, vst0 = v_st(sr, sc & 63), vst1 = v_st(32 + sr, sc & 63);
  const int vb0 = (int)(uintptr_t)V_lds + v_rd_base(lane);
  const bool kact = sc < 96, vact = sc < 64;
  bf16x8 vs0 = {}, vs1 = {}, ks0 = {}, ks1 = {};
#define SLOAD(k0) do { if (vact) { vs0 = *(const bf16x8*)(&Vh[(size_t)((k0) + sr) * 64 + sc]); vs1 = *(const bf16x8*)(&Vh[(size_t)((k0) + 32 + sr) * 64 + sc]); } \
    if (kact) { ks0 = *(const bf16x8*)(&Kh[(size_t)((k0) + sr) * 96 + sc]); ks1 = *(const bf16x8*)(&Kh[(size_t)((k0) + 32 + sr) * 96 + sc]); } } while (0)
#define SWRITE(b) do { if (vact) { *(bf16x8*)(V_lds + (b) * SHM_V + vst0) = vs0; *(bf16x8*)(V_lds + (b) * SHM_V + vst1) = vs1; } \
    if (kact) { const int kc = sc * 2; *(bf16x8*)(K_lds + (b) * SHM_K + KSWZ(sr, kc)) = ks0; *(bf16x8*)(K_lds + (b) * SHM_K + KSWZ(32 + sr, kc)) = ks1; } } while (0)
#define SWAIT() asm volatile("s_waitcnt vmcnt(0)" ::: "memory")
#define RESC(a) do { if (__any((a) < 1.f)) { if (hi == 0) al_l[r32] = (a); asm volatile("s_waitcnt lgkmcnt(0)" ::: "memory"); \
    _Pragma("unroll") for (int r = 0; r < 16; ++r) { const float f = al_l[crow(r, hi)]; o0[r] *= f; o1[r] *= f; } } } while (0)
  f32x16 pA0, pA1, pB0, pB1; float mnA, mnB, alA, alB; bf16x8 pa0, pa1, pa2, pa3; const int NT = seq / KVBLK;
  __syncthreads();
  SLOAD(0); SWAIT(); SWRITE(0); __syncthreads();
  qkt(pA0, pA1, K_lds, qr, r32, hi); partialSM(pA0, pA1, m_reg, mnA, alA);
  SLOAD(KVBLK);
  SWAIT(); SWRITE(1); __syncthreads();
  for (int j = 1; j + 1 < NT; j += 2) {
    SBAR(); qkt(pB0, pB1, K_lds + SHM_K, qr, r32, hi);
    finishSM(pA0, pA1, alA, l_reg, pa0, pa1, pa2, pa3); SBAR();
    SLOAD((j + 1) * KVBLK); SBAR();
    pv_d0(o0, o1, vb0, pa0, pa1, pa2, pa3); partialSM(pB0, pB1, m_reg, mnB, alB);
    __syncthreads(); SWAIT(); SWRITE(0);
    RESC(alB); __syncthreads();
    SBAR(); qkt(pA0, pA1, K_lds, qr, r32, hi);
    finishSM(pB0, pB1, alB, l_reg, pa0, pa1, pa2, pa3); SBAR();
    SLOAD((j + 2) * KVBLK); SBAR();
    pv_d0(o0, o1, vb0 + SHM_V, pa0, pa1, pa2, pa3); partialSM(pA0, pA1, m_reg, mnA, alA);
    __syncthreads(); SWAIT(); SWRITE(1);
    RESC(alA); __syncthreads();
  }
  SBAR(); qkt(pB0, pB1, K_lds + SHM_K, qr, r32, hi);
  finishSM(pA0, pA1, alA, l_reg, pa0, pa1, pa2, pa3); SBAR();
  pv_d0(o0, o1, vb0, pa0, pa1, pa2, pa3); partialSM(pB0, pB1, m_reg, mnB, alB);
  __syncthreads(); RESC(alB);
  finishSM(pB0, pB1, alB, l_reg, pa0, pa1, pa2, pa3); SBAR();
  pv_d0(o0, o1, vb0 + SHM_V, pa0, pa1, pa2, pa3);
  if (hi == 0) li_l[r32] = l_reg; asm volatile("s_waitcnt lgkmcnt(0)" ::: "memory");
  bf16_t* Ow = Ob + (size_t)(wid * QBLK) * DM;
#pragma unroll
  for (int r = 0; r < 16; ++r) { const int orow = crow(r, hi); const float rl = __builtin_amdgcn_rcpf(li_l[orow]);
    Ow[(size_t)orow * DM + r32] = f2bf(o0[r] * rl); Ow[(size_t)orow * DM + 32 + r32] = f2bf(o1[r] * rl); }
#undef SLOAD
#undef SWRITE
#undef SWAIT
#undef RESC
}
}

__device__ void attn_units(const Params& p, int layer, char* smem) {
  const bf16_t* Q = (const bf16_t*)(p.ws + OFF_Q); const bf16_t* QC = (const bf16_t*)(p.ws + OFF_QC);
  const bf16_t* K = (const bf16_t*)(p.ws + OFF_K); const bf16_t* V = (const bf16_t*)(p.ws + OFF_V);
  bf16_t* mix = (bf16_t*)(p.ws + OFF_MIX);
  const int nunits = 384 + ((layer == 0) ? 12 : 0);
  for (int unit = blockIdx.x; unit < nunits; unit += gridDim.x) {
    if (unit < 384) {
      const int bh = unit >> 5, qb = unit & 31, b = bh / 6, h = bh % 6;
      att::attn_body(Q + ((size_t)bh * SEQ + qb * 256) * 96, K + (size_t)bh * NKEYS * 96, V + (size_t)bh * NKEYS * 64,
                     mix + ((size_t)b * SEQ + qb * 256) * DM + 384 + h * 64, NKEYS, smem);
    } else {
      const int bh = unit - 384, b = bh / 6, h = bh % 6;
      att::attn_body(QC + (size_t)bh * CTXL * 96, K + (size_t)bh * NKEYS * 96, V + (size_t)bh * NKEYS * 64,
                     mix + ((size_t)NLAT + b * CTXL) * DM + 384 + h * 64, CTXL, smem);
    }
  }
}

__device__ __forceinline__ void wave_argmax(float& v, int& idx) {
#pragma unroll
  for (int o = 32; o > 0; o >>= 1) {
    const float ov = __shfl_xor(v, o); const int oi = __shfl_xor(idx, o);
    if (ov > v || (ov == v && oi < idx)) { v = ov; idx = oi; }
  }
}
__device__ void peer_topk(const Params& p, int layer, int nrows, char* smem) {
  const int tid = threadIdx.x, wid = tid >> 6, lane = tid & 63, r32 = lane & 31, hi = lane >> 5;
  float* S = (float*)smem;
  float* topv = S + 64 * 256;
  int* topi = (int*)(topv + 64 * 32);
  const bf16_t* pq = (const bf16_t*)(p.ws + OFF_PQ);
  const bf16_t* keys = (const bf16_t*)(p.ws + OFF_KEYS) + (size_t)layer * 2 * 128 * 128;
  int* eid = (int*)(p.ws + OFF_EID); float* gate = (float*)(p.ws + OFF_GATE);
  const int ntile = nrows / 64;
  for (int unit = blockIdx.x; unit < ntile * 8; unit += gridDim.x) {
    const int tile = unit >> 3, h = unit & 7;
    __syncthreads();
    {
      const int half = wid & 1, mh = (wid >> 1) & 1, nq = wid >> 2;
      const bf16_t* ap = pq + (size_t)(tile * 64 + mh * 32 + r32) * 2048 + h * 256 + half * 128 + hi * 8;
      const bf16_t* bp = keys + (size_t)(half * 128 + nq * 64 + r32) * 128 + hi * 8;
      f32x16 a0 = {}, a1 = {};
#pragma unroll
      for (int ks = 0; ks < 8; ++ks) {
        const bf16x8 a = *(const bf16x8*)(ap + ks * 16);
        const bf16x8 b0 = *(const bf16x8*)(bp + ks * 16);
        const bf16x8 b1 = *(const bf16x8*)(bp + 32 * 128 + ks * 16);
        a0 = __builtin_amdgcn_mfma_f32_32x32x16_bf16(a, b0, a0, 0, 0, 0);
        a1 = __builtin_amdgcn_mfma_f32_32x32x16_bf16(a, b1, a1, 0, 0, 0);
      }
#pragma unroll
      for (int r = 0; r < 16; ++r) {
        const int tok = mh * 32 + crow(r, hi);
        S[(tok * 2 + half) * 128 + nq * 64 + r32] = a0[r];
        S[(tok * 2 + half) * 128 + nq * 64 + 32 + r32] = a1[r];
      }
    }
    __syncthreads();
    for (int rr = 0; rr < 16; ++rr) {
      const int row = wid * 16 + rr;
      float v0 = S[row * 128 + lane], v1 = S[row * 128 + 64 + lane];
      for (int it = 0; it < 16; ++it) {
        float bv; int bi;
        if (v1 > v0) { bv = v1; bi = lane + 64; } else { bv = v0; bi = lane; }
        wave_argmax(bv, bi);
        if (bi == lane) v0 = -3.0e38f; else if (bi == lane + 64) v1 = -3.0e38f;
        if (lane == 0) { topv[row * 16 + it] = bv; topi[row * 16 + it] = bi; }
      }
    }
    __syncthreads();
    for (int tt = 0; tt < 8; ++tt) {
      const int tok = wid * 8 + tt;
      float cv[4];
#pragma unroll
      for (int q = 0; q < 4; ++q) { const int pidx = lane * 4 + q; cv[q] = topv[(tok * 2) * 16 + (pidx >> 4)] + topv[(tok * 2 + 1) * 16 + (pidx & 15)]; }
      float mys = 0.f; int myp = 0;
      for (int it = 0; it < 16; ++it) {
        float bv = cv[0]; int bi = lane * 4;
#pragma unroll
        for (int q = 1; q < 4; ++q) if (cv[q] > bv) { bv = cv[q]; bi = lane * 4 + q; }
        wave_argmax(bv, bi);
#pragma unroll
        for (int q = 0; q < 4; ++q) if (bi == lane * 4 + q) cv[q] = -3.0e38f;
        if (lane == it) { mys = bv; myp = bi; }
      }
      const float mx = __shfl(mys, 0);
      float ex = (lane < 16) ? __expf(mys - mx) : 0.f;
      float sm = ex;
#pragma unroll
      for (int o = 8; o > 0; o >>= 1) sm += __shfl_xor(sm, o);
      if (lane < 16) {
        const size_t row = (size_t)tile * 64 + tok;
        const int e = topi[(tok * 2) * 16 + (myp >> 4)] * 128 + topi[(tok * 2 + 1) * 16 + (myp & 15)];
        eid[row * 128 + h * 16 + lane] = e;
        gate[row * 128 + h * 16 + lane] = ex / sm;
      }
    }
  }
}

__device__ void peer_eval(const Params& p, int layer, int nrows) {
  const int lane = threadIdx.x & 63, wid = threadIdx.x >> 6;
  const bf16_t* hb = (const bf16_t*)(p.ws + OFF_HB);
  const int* eid = (const int*)(p.ws + OFF_EID); const float* gate = (const float*)(p.ws + OFF_GATE);
  const float* ut = p.in[I_PU] + (size_t)layer * 16384 * DM; const float* vt = p.in[I_PV] + (size_t)layer * 16384 * DM;
  float* xs = (float*)(p.ws + OFF_XS);
  for (int r = blockIdx.x * 8 + wid; r < nrows; r += gridDim.x * 8) {
    int b, t, isc; row_info(r, b, t, isc);
    const float* g2 = (const float*)(p.ws + OFF_MOD) + ((size_t)layer * 3 + (isc ? 2 : b)) * 6144 + 5120;
    float x[16], out[16];
    {
      const bf16x8 x0 = *(const bf16x8*)(hb + (size_t)r * DM + lane * 16), x1 = *(const bf16x8*)(hb + (size_t)r * DM + lane * 16 + 8);
#pragma unroll
      for (int i = 0; i < 8; ++i) { x[i] = bf2f((bf16_t)x0[i]); x[8 + i] = bf2f((bf16_t)x1[i]); }
    }
#pragma unroll
    for (int i = 0; i < 16; ++i) out[i] = 0.f;
    for (int it = 0; it < 128; it += 2) {
      const int e0 = eid[(size_t)r * 128 + it], e1 = eid[(size_t)r * 128 + it + 1];
      const float g0 = gate[(size_t)r * 128 + it], g1 = gate[(size_t)r * 128 + it + 1];
      const float* u0 = ut + (size_t)e0 * DM + lane * 16; const float* u1 = ut + (size_t)e1 * DM + lane * 16;
      float d0 = 0.f, d1 = 0.f;
#pragma unroll
      for (int i = 0; i < 4; ++i) {
        const f32x4 a = *(const f32x4*)(u0 + i * 4), c = *(const f32x4*)(u1 + i * 4);
#pragma unroll
        for (int j = 0; j < 4; ++j) { d0 += a[j] * x[i * 4 + j]; d1 += c[j] * x[i * 4 + j]; }
      }
      d0 = wave_sum(d0); d1 = wave_sum(d1);
      const float w0 = g0 * gelu_tanh(d0), w1 = g1 * gelu_tanh(d1);
      const float* v0 = vt + (size_t)e0 * DM + lane * 16; const float* v1 = vt + (size_t)e1 * DM + lane * 16;
#pragma unroll
      for (int i = 0; i < 4; ++i) {
        const f32x4 a = *(const f32x4*)(v0 + i * 4), c = *(const f32x4*)(v1 + i * 4);
#pragma unroll
        for (int j = 0; j < 4; ++j) out[i * 4 + j] += w0 * a[j] + w1 * c[j];
      }
    }
    float* xr = xs + (size_t)r * DM + lane * 16;
#pragma unroll
    for (int i = 0; i < 4; ++i) {
      f32x4 xv = *(const f32x4*)(xr + i * 4);
#pragma unroll
      for (int j = 0; j < 4; ++j) xv[j] += g2[lane * 16 + i * 4 + j] * out[i * 4 + j];
      *(f32x4*)(xr + i * 4) = xv;
    }
  }
}

__device__ void final_norm(const Params& p) {
  const int lane = threadIdx.x & 63, wid = threadIdx.x >> 6;
  const float* xs = (const float*)(p.ws + OFF_XS); const float* g = p.in[I_FG];
  for (int r = blockIdx.x * 8 + wid; r < NLAT; r += gridDim.x * 8) {
    f32x4 v[4]; float ss = 0.f;
#pragma unroll
    for (int i = 0; i < 4; ++i) { v[i] = *(const f32x4*)(xs + (size_t)r * DM + (i * 64 + lane) * 4); ss += v[i][0] * v[i][0] + v[i][1] * v[i][1] + v[i][2] * v[i][2] + v[i][3] * v[i][3]; }
    ss = wave_sum(ss);
    const float rinv = rsqrtf(ss * (1.f / DM) + EPSV);
#pragma unroll
    for (int i = 0; i < 4; ++i) {
      const int c0 = (i * 64 + lane) * 4; f32x4 o;
#pragma unroll
      for (int j = 0; j < 4; ++j) o[j] = v[i][j] * rinv * g[c0 + j];
      *(f32x4*)(p.out + (size_t)r * DM + c0) = o;
    }
  }
}

constexpr int NSTAGES = 23;
template <int S>
__device__ __forceinline__ void run_stage_t(const Params& p, int layer, char* smem) {
  const int nrows = (layer == 0) ? NTOK : NLAT;
  if constexpr (S == 100) stage_prep(p, smem);
  if constexpr (S == 101) stage_prep2(p, smem);
  if constexpr (S == 102) final_norm(p);
  if constexpr (S == 0) stage_norm(p, layer, 0, NTOK);
  if constexpr (S == 1) {
    float* u = (float*)(p.ws + OFF_U);
    gemm_bt((const bf16_t*)(p.ws + OFF_HB), DM, (const bf16_t*)(p.ws + OFF_WIN) + (size_t)layer * DINP * 1024, 1024, NTOK, DINP, 1024,
            [=](int row, int col, float v) { if (col < DIN) u[(size_t)row * DIN + col] = v; }, smem);
  }
  if constexpr (S == 2) { lru_units(p, layer, 0, smem); mla_prep(p, layer); hyena_prep(p, layer, smem); }
  if constexpr (S == 3) {
    bf16_t* Q = (bf16_t*)(p.ws + OFF_Q); bf16_t* QC = (bf16_t*)(p.ws + OFF_QC); bf16_t* K = (bf16_t*)(p.ws + OFF_K); bf16_t* V = (bf16_t*)(p.ws + OFF_V);
    gemm_bt((const bf16_t*)(p.ws + OFF_QN), 384, (const bf16_t*)(p.ws + OFF_WQB) + (size_t)layer * 640 * 384, 384, NTOK, 640, 384,
            [=](int row, int col, float v) {
              const float vp = __shfl_xor(v, 8);
              if (col < 576) {
                int b, t, isc; row_info(row, b, t, isc);
                const int h = col / 96, j = col % 96;
                if (j >= 64 && !isc) v = rope_apply(v, vp, j - 64, t);
                if (isc) QC[((size_t)(b * 6 + h) * CTXL + t) * 96 + j] = f2bf(v);
                else     Q[((size_t)(b * 6 + h) * SEQ + t) * 96 + j] = f2bf(v);
              }
            }, smem);
    gemm_bt((const bf16_t*)(p.ws + OFF_KVN), 256, (const bf16_t*)(p.ws + OFF_WKVB) + (size_t)layer * 768 * 256, 256, NTOK, 768, 256,
            [=](int row, int col, float v) {
              int b, t, isc; row_info(row, b, t, isc);
              const int h = col >> 7, j = col & 127, tk = isc ? t : CTXL + t;
              if (j < 64) K[((size_t)(b * 6 + h) * NKEYS + tk) * 96 + j] = f2bf(v);
              else        V[((size_t)(b * 6 + h) * NKEYS + tk) * 64 + (j - 64)] = f2bf(v);
            }, smem);
    lru_carry(p);
  }
  if constexpr (S == 4) { attn_units(p, layer, smem); hyena_direct(p, layer, smem); lru_units(p, layer, 1, smem); }
  if constexpr (S == 5) {
    float* xs = (float*)(p.ws + OFF_XS); const float* mod = (const float*)(p.ws + OFF_MOD) + (size_t)layer * 3 * 6144;
    const Params pp = p;
    gemm_bt((const bf16_t*)(p.ws + OFF_MIX), DM, (const bf16_t*)(p.ws + OFF_WOUT) + (size_t)layer * 1024 * 1024, 1024, nrows, 1024, 1024,
            [=](int row, int col, float v) {
              int b, t, isc; row_info(row, b, t, isc);
              const float g1 = mod[(size_t)(isc ? 2 : b) * 6144 + 2048 + col];
              xs[(size_t)row * DM + col] = xrow_src(pp, layer, row)[col] + g1 * v;
            }, smem);
  }
  if constexpr (S == 6) stage_norm(p, layer, 1, nrows);
  if constexpr (S == 7) {
    bf16_t* pq = (bf16_t*)(p.ws + OFF_PQ);
    gemm_bt((const bf16_t*)(p.ws + OFF_HB), DM, (const bf16_t*)(p.ws + OFF_WPQ) + (size_t)layer * 2048 * 1024, 1024, nrows, 2048, 1024,
            [=](int row, int col, float v) { pq[(size_t)row * 2048 + col] = f2bf(v); }, smem);
  }
  if constexpr (S == 8) peer_topk(p, layer, nrows, smem);
  if constexpr (S == 9) peer_eval(p, layer, nrows);
}

constexpr int SMEM_BYTES = 98304 + 4096;

#if MK_SINGLE
#define SYNC() grid.sync()
__global__ void __launch_bounds__(NTHREADS) mega_kernel(Params p) {
  __shared__ __attribute__((aligned(16))) char smem[SMEM_BYTES];
  cg::grid_group grid = cg::this_grid();
  run_stage_t<100>(p, 0, smem); SYNC();
  run_stage_t<101>(p, 0, smem); SYNC();
  for (int layer = 0; layer < 2; ++layer) {
    run_stage_t<0>(p, layer, smem); SYNC();
    run_stage_t<1>(p, layer, smem); SYNC();
    run_stage_t<2>(p, layer, smem); SYNC();
    run_stage_t<3>(p, layer, smem); SYNC();
    run_stage_t<4>(p, layer, smem); SYNC();
    run_stage_t<5>(p, layer, smem); SYNC();
    run_stage_t<6>(p, layer, smem); SYNC();
    run_stage_t<7>(p, layer, smem); SYNC();
    run_stage_t<8>(p, layer, smem); SYNC();
    run_stage_t<9>(p, layer, smem); SYNC();
  }
  run_stage_t<102>(p, 0, smem);
}
#else
template <int S>
__global__ void __launch_bounds__(NTHREADS) stage_kernel(Params p, int layer) {
  __shared__ __attribute__((aligned(16))) char smem[SMEM_BYTES];
  run_stage_t<S>(p, layer, smem);
}
#endif

extern "C" void kernel_launch(void* const* d_in, const int* in_sizes, int n_in, void* d_out, int out_size, void* d_ws, size_t ws_size, hipStream_t stream) {
  if (n_in != N_IN || ws_size < WS_END) { fprintf(stderr, "kernel_launch: bad args n_in=%d ws=%zu need=%zu\n", n_in, ws_size, (size_t)WS_END); return; }
  Params p{};
  for (int i = 0; i < N_IN; ++i) p.in[i] = (const float*)d_in[i];
  p.out = (float*)d_out; p.ws = (char*)d_ws;
#if MK_SINGLE
  static int grid_blocks = 0;
  if (!grid_blocks) {
    int dev = 0, cus = 0, per_cu = 0;
    hipGetDevice(&dev);
    hipDeviceGetAttribute(&cus, hipDeviceAttributeMultiprocessorCount, dev);
    hipOccupancyMaxActiveBlocksPerMultiprocessor(&per_cu, mega_kernel, NTHREADS, 0);
    if (per_cu > 1) per_cu = 1;
    grid_blocks = cus * per_cu;
  }
  void* args[] = {&p};
  hipError_t e = hipLaunchCooperativeKernel((void*)mega_kernel, dim3(grid_blocks), dim3(NTHREADS), args, 0, stream);
  if (e != hipSuccess) fprintf(stderr, "cooperative launch failed: %s (grid %d)\n", hipGetErrorString(e), grid_blocks);
#else
#define LAUNCH(S, L) hipLaunchKernelGGL(stage_kernel<S>, dim3(256), dim3(NTHREADS), 0, stream, p, L)
  LAUNCH(100, 0); LAUNCH(101, 0);
  for (int layer = 0; layer < 2; ++layer) {
    LAUNCH(0, layer); LAUNCH(1, layer); LAUNCH(2, layer); LAUNCH(3, layer); LAUNCH(4, layer);
    LAUNCH(5, layer); LAUNCH(6, layer); LAUNCH(7, layer); LAUNCH(8, layer); LAUNCH(9, layer);
  }
  LAUNCH(102, 0);
#endif
}
```

```cpp
#include <hip/hip_runtime.h>
#include <hip/hip_cooperative_groups.h>
#include <cstdio>
#include <cstdint>
namespace cg = cooperative_groups;

__device__ __forceinline__ int launder_v(int x) { asm volatile("" : "+v"(x)); return x; }
__device__ __forceinline__ int launder_s(int x) { asm volatile("" : "+s"(x)); return x; }
#define TIDX launder_v((int)threadIdx.x)
#define BIDX launder_s((int)blockIdx.x)

__device__ __forceinline__ float shx(float v, int mask) { const int l = TIDX & 63; return __int_as_float(__builtin_amdgcn_ds_bpermute((l ^ mask) << 2, __float_as_int(v))); }
__device__ __forceinline__ int shxi(int v, int mask) { const int l = TIDX & 63; return __builtin_amdgcn_ds_bpermute((l ^ mask) << 2, v); }
__device__ __forceinline__ float rdl(float v, int srclane) { return __int_as_float(__builtin_amdgcn_readlane(__float_as_int(v), srclane)); }

#ifndef MK_SINGLE
#define MK_SINGLE 1
#endif

typedef unsigned short bf16_t;
using bf16x8 = __attribute__((ext_vector_type(8))) short;
using s16x4  = __attribute__((ext_vector_type(4))) short;
using f32x16 = __attribute__((ext_vector_type(16))) float;
using f32x4  = __attribute__((ext_vector_type(4))) float;
using u32x4  = __attribute__((ext_vector_type(4))) unsigned;
using u32x2  = __attribute__((ext_vector_type(2))) unsigned;

constexpr int NB = 2, SEQ = 8192, CTXL = 256, DM = 1024;
constexpr int NLAT = NB * SEQ, NCTX = NB * CTXL, NTOK = NLAT + NCTX;
constexpr int DIN = 2208, DINP = 2304;
constexpr int DLRU = 384, NKEYS = SEQ + CTXL;
constexpr int NTHREADS = 512;
constexpr int NCHUNK = NLAT / 64 + NCTX / 64;
constexpr float EPSV = 1e-6f;

enum { I_X = 0, I_C, I_CTX, I_CCTX, I_WMOD, I_BMOD, I_N1G, I_N2G, I_WIN, I_WOUT, I_LCW, I_LCB, I_LWR, I_LBR, I_LWI, I_LBI, I_LLAM,
       I_QNG, I_WQB, I_KVNG, I_WKVB, I_HCW, I_HCB, I_HW1, I_HB1, I_HW2, I_HB2, I_HW3, I_HFREQ, I_HDECAY, I_HSKIP,
       I_PWQ, I_PKEYS, I_PU, I_PV, I_FG, N_IN };

struct KArgs { const float* in[N_IN]; float* out; char* ws; };
struct InTab {
  const char* tab;
  __device__ __forceinline__ const float* operator[](int i) const {
    const unsigned long long v = ((const unsigned long long*)tab)[i];
    const unsigned lo = __builtin_amdgcn_readfirstlane((unsigned)v), hi = __builtin_amdgcn_readfirstlane((unsigned)(v >> 32));
    return (const float*)(const __attribute__((address_space(1))) float*)(((unsigned long long)hi << 32) | lo);
  }
};
struct Params { InTab in; float* out; char* ws; };

constexpr size_t al256(size_t x) { return (x + 255) / 256 * 256; }
constexpr size_t OFF_XS    = 0;
constexpr size_t OFF_HB    = OFF_XS    + al256((size_t)NTOK * DM * 4);
constexpr size_t OFF_U     = OFF_HB    + al256((size_t)NTOK * DM * 2);
constexpr size_t OFF_PQ    = OFF_U;
constexpr size_t OFF_MIX   = OFF_U     + al256((size_t)NTOK * DIN * 4);
constexpr size_t OFF_HYIN  = OFF_MIX   + al256((size_t)NTOK * DM * 2);
constexpr size_t OFF_EID   = OFF_HYIN;
constexpr size_t OFF_GATE  = OFF_EID   + al256((size_t)NTOK * 128 * 4);
constexpr size_t OFF_HYINC = OFF_HYIN  + al256((size_t)3 * 2 * 256 * 8192 * 4);
constexpr size_t OFF_QN    = OFF_HYINC + al256((size_t)3 * 2 * 256 * 256 * 4);
constexpr size_t OFF_KVN   = OFF_QN    + al256((size_t)NTOK * 384 * 2);
constexpr size_t OFF_Q     = OFF_KVN   + al256((size_t)NTOK * 256 * 2);
constexpr size_t OFF_QC    = OFF_Q     + al256((size_t)2 * 6 * 8192 * 96 * 2);
constexpr size_t OFF_K     = OFF_QC    + al256((size_t)2 * 6 * 256 * 96 * 2);
constexpr size_t OFF_V     = OFF_K     + al256((size_t)2 * 6 * NKEYS * 96 * 2);
constexpr size_t OFF_LSUM  = OFF_V     + al256((size_t)2 * 6 * NKEYS * 64 * 2);
constexpr size_t OFF_CARRY = OFF_LSUM  + al256((size_t)NCHUNK * 2 * 2 * 384 * 4);
constexpr size_t OFF_MOD   = OFF_CARRY + al256((size_t)NCHUNK * 2 * 384 * 4);
constexpr size_t OFF_MODP  = OFF_MOD   + al256((size_t)2 * 3 * 6144 * 4);
constexpr size_t OFF_WIN   = OFF_MODP  + al256((size_t)2 * 8 * 3 * 6144 * 4);
constexpr size_t OFF_WOUT  = OFF_WIN   + al256((size_t)2 * DINP * 1024 * 2);
constexpr size_t OFF_WQB   = OFF_WOUT  + al256((size_t)2 * 1024 * 1024 * 2);
constexpr size_t OFF_WKVB  = OFF_WQB   + al256((size_t)2 * 640 * 384 * 2);
constexpr size_t OFF_WPQ   = OFF_WKVB  + al256((size_t)2 * 768 * 256 * 2);
constexpr size_t OFF_KEYS  = OFF_WPQ   + al256((size_t)2 * 2048 * 1024 * 2);
constexpr size_t OFF_GW    = OFF_KEYS  + al256((size_t)2 * 2 * 128 * 128 * 2);
constexpr size_t OFF_H2    = OFF_GW    + al256((size_t)2 * 2 * 2 * 6 * 64 * 64 * 2);
constexpr size_t OFF_FILT  = OFF_H2    + al256((size_t)2 * NKEYS * 64 * 4);
constexpr size_t OFF_FILTC = OFF_FILT  + al256((size_t)2 * 1024 * 8192 * 4);
constexpr size_t OFF_SSQP  = OFF_FILTC + al256((size_t)2 * 1024 * 256 * 4);
constexpr size_t OFF_SSQPC = OFF_SSQP  + al256((size_t)2 * 128 * 1024 * 4);
constexpr size_t WS_END    = OFF_SSQPC + al256((size_t)2 * 4 * 1024 * 4);

__device__ __forceinline__ float bf2f(bf16_t v) { return __uint_as_float(((unsigned)v) << 16); }
__device__ __forceinline__ bf16_t f2bf(float f) { unsigned u = __float_as_uint(f); u += 0x7fffu + ((u >> 16) & 1u); return (bf16_t)(u >> 16); }
__device__ __forceinline__ unsigned cvtpk(float lo, float hi) { unsigned r; asm volatile("v_cvt_pk_bf16_f32 %0, %1, %2" : "=v"(r) : "v"(lo), "v"(hi)); return r; }
__device__ __forceinline__ float gelu_tanh(float x) { return 0.5f * x * (1.f + tanhf(0.7978845608028654f * (x + 0.044715f * x * x * x))); }
__device__ __forceinline__ float sigm(float x) { return 1.f / (1.f + __expf(-x)); }
__device__ __forceinline__ float wave_sum(float v) {
#pragma unroll
  for (int o = 32; o > 0; o >>= 1) v += shx(v, o);
  return v;
}
__device__ __forceinline__ int crow(int r, int hi) { return (r & 3) + 8 * (r >> 2) + 4 * hi; }
__device__ __forceinline__ void row_info(int r, int& b, int& t, int& isctx) {
  if (r < NLAT) { isctx = 0; b = r >> 13; t = r & (SEQ - 1); } else { isctx = 1; int q = r - NLAT; b = q >> 8; t = q & (CTXL - 1); }
}
__device__ __forceinline__ const float* xrow_src(const Params& p, int layer, int r) {
  if (layer == 0) return (r < NLAT) ? p.in[I_X] + (size_t)r * DM : p.in[I_CTX] + (size_t)(r - NLAT) * DM;
  return (const float*)(p.ws + OFF_XS) + (size_t)r * DM;
}
#define JOB_LOOP(t, ntiles, base) for (int t = (int)(((long)BIDX - ((base) % (long)gridDim.x) + gridDim.x) % gridDim.x); t < (ntiles); t += gridDim.x)

__device__ void transpose_cvt_job(const float* __restrict__ src, bf16_t* __restrict__ dst, int K, int N, int Npad, char* smem, long& base) {
  float* tile = (float*)smem;
  const int tk = K / 64, tn = Npad / 64, nt = tk * tn;
  JOB_LOOP(t, nt, base) {
    const int k0 = (t % tk) * 64, n0 = (t / tk) * 64;
    __syncthreads();
    for (int e = TIDX; e < 4096; e += NTHREADS) { int i = e >> 6, j = e & 63; int n = n0 + j; tile[j * 65 + i] = (n < N) ? src[(size_t)(k0 + i) * N + n] : 0.f; }
    __syncthreads();
    for (int e = TIDX; e < 4096; e += NTHREADS) { int j = e >> 6, i = e & 63; dst[(size_t)(n0 + j) * K + k0 + i] = f2bf(tile[j * 65 + i]); }
  }
  base += nt;
}

__device__ void stage_prep(const Params& p, char* smem) {
  long base = 0;
  for (int l = 0; l < 2; ++l) {
    transpose_cvt_job(p.in[I_WIN] + (size_t)l * 1024 * DIN, (bf16_t*)(p.ws + OFF_WIN) + (size_t)l * DINP * 1024, 1024, DIN, DINP, smem, base);
    transpose_cvt_job(p.in[I_WOUT] + (size_t)l * 1024 * 1024, (bf16_t*)(p.ws + OFF_WOUT) + (size_t)l * 1024 * 1024, 1024, 1024, 1024, smem, base);
    transpose_cvt_job(p.in[I_WQB] + (size_t)l * 384 * 576, (bf16_t*)(p.ws + OFF_WQB) + (size_t)l * 640 * 384, 384, 576, 640, smem, base);
    transpose_cvt_job(p.in[I_WKVB] + (size_t)l * 256 * 768, (bf16_t*)(p.ws + OFF_WKVB) + (size_t)l * 768 * 256, 256, 768, 768, smem, base);
    transpose_cvt_job(p.in[I_PWQ] + (size_t)l * 1024 * 2048, (bf16_t*)(p.ws + OFF_WPQ) + (size_t)l * 2048 * 1024, 1024, 2048, 2048, smem, base);
    for (int d = 0; d < 2; ++d) for (int n = 0; n < 6; ++n) {
      const size_t so = ((size_t)(l * 2 + d) * 6 + n) * 4096;
      transpose_cvt_job(p.in[I_LWR] + so, (bf16_t*)(p.ws + OFF_GW) + ((size_t)((l * 2 + d) * 2 + 0) * 6 + n) * 4096, 64, 64, 64, smem, base);
      transpose_cvt_job(p.in[I_LWI] + so, (bf16_t*)(p.ws + OFF_GW) + ((size_t)((l * 2 + d) * 2 + 1) * 6 + n) * 4096, 64, 64, 64, smem, base);
    }
  }
  {
    const float* src = p.in[I_PKEYS]; bf16_t* dst = (bf16_t*)(p.ws + OFF_KEYS);
    for (int e = BIDX * NTHREADS + TIDX; e < 2 * 2 * 128 * 128; e += gridDim.x * NTHREADS) dst[e] = f2bf(src[e]);
  }
  {
    float* modp = (float*)(p.ws + OFF_MODP);
    JOB_LOOP(it, 192, base) {
      const int l = it / 96, ks = (it % 96) / 12, cgp = it % 12;
      const int col = cgp * 512 + TIDX;
      const float* w = p.in[I_WMOD] + (size_t)l * 1024 * 6144 + col;
      float a0 = 0.f, a1 = 0.f, a2 = 0.f;
      for (int k = ks * 128; k < ks * 128 + 128; ++k) {
        const float wv = w[(size_t)k * 6144];
        const float c0 = p.in[I_C][k], c1 = p.in[I_C][1024 + k], c2 = p.in[I_CCTX][k];
        a0 += c0 * sigm(c0) * wv; a1 += c1 * sigm(c1) * wv; a2 += c2 * sigm(c2) * wv;
      }
      float* o = modp + ((size_t)(l * 8 + ks) * 3) * 6144 + col;
      o[0] = a0; o[6144] = a1; o[2 * 6144] = a2;
    }
    base += 192;
  }
  {
    const int lane = TIDX & 63, wid = TIDX >> 6;
    for (int it = BIDX * 8 + wid; it < 2 * NKEYS; it += gridDim.x * 8) {
      const int l = it / NKEYS, pos = it % NKEYS;
      const float tn = (pos < SEQ) ? (float)pos / (float)SEQ : (float)(pos - SEQ) / (float)CTXL;
      const float* w1 = p.in[I_HW1] + (size_t)l * 17 * 64; const float* b1 = p.in[I_HB1] + l * 64;
      const float* w2 = p.in[I_HW2] + (size_t)l * 64 * 64; const float* b2 = p.in[I_HB2] + l * 64;
      const float fr = p.in[I_HFREQ][l * 64 + lane];
      float pre = b1[lane] + tn * w1[lane];
#pragma unroll
      for (int i = 0; i < 8; ++i) {
        const float band = 1e-4f + (float)i * ((7.f - 1e-4f) / 7.f);
        const float wp = (6.283185307179586f * tn) * band;
        pre += cosf(wp) * w1[(1 + i) * 64 + lane] + sinf(wp) * w1[(9 + i) * 64 + lane];
      }
      const float h1 = sinf(fr * pre);
      float pre2 = b2[lane];
      for (int i = 0; i < 64; ++i) pre2 += rdl(h1, i) * w2[i * 64 + lane];
      ((float*)(p.ws + OFF_H2))[((size_t)l * NKEYS + pos) * 64 + lane] = sinf(fr * pre2);
    }
  }
}

__device__ void stage_prep2(const Params& p, char* smem) {
  {
    float* mod = (float*)(p.ws + OFF_MOD); const float* modp = (const float*)(p.ws + OFF_MODP);
    for (int e = BIDX * NTHREADS + TIDX; e < 2 * 3 * 6144; e += gridDim.x * NTHREADS) {
      const int l = e / (3 * 6144), w = (e / 6144) % 3, col = e % 6144;
      float s = p.in[I_BMOD][l * 6144 + col];
      for (int ks = 0; ks < 8; ++ks) s += modp[((size_t)(l * 8 + ks) * 3 + w) * 6144 + col];
      mod[e] = s;
    }
  }
  float* h2t = (float*)smem;
  float* w3t = h2t + 64 * 65;
  const int tloc = TIDX & 63, cgp = TIDX >> 6, lane = TIDX & 63;
  for (int it = BIDX; it < 2 * 132 * 16; it += gridDim.x) {
    const int l = it / (132 * 16), tt = (it / 16) % 132, ct = it % 16;
    const bool isc = tt >= 128; const int L = isc ? CTXL : SEQ; const int t0 = isc ? (tt - 128) * 64 : tt * 64;
    const int pos0 = isc ? SEQ + t0 : t0;
    const float* h2 = (const float*)(p.ws + OFF_H2) + ((size_t)l * NKEYS + pos0) * 64;
    const float* w3 = p.in[I_HW3] + (size_t)l * 64 * 1024 + ct * 64;
    __syncthreads();
    for (int e = TIDX; e < 4096; e += NTHREADS) { int i = e >> 6, j = e & 63; h2t[i * 65 + j] = h2[i * 64 + j]; w3t[i * 64 + j] = w3[(size_t)i * 1024 + j]; }
    __syncthreads();
    float acc[8];
#pragma unroll
    for (int cc = 0; cc < 8; ++cc) acc[cc] = 0.f;
#pragma unroll 2
    for (int i = 0; i < 64; ++i) {
      const float hv = h2t[tloc * 65 + i];
#pragma unroll
      for (int cc = 0; cc < 8; ++cc) acc[cc] += hv * w3t[i * 64 + cgp * 8 + cc];
    }
    const float tn = (float)(t0 + tloc) / (float)L;
#pragma unroll
    for (int cc = 0; cc < 8; ++cc) {
      const int col = ct * 64 + cgp * 8 + cc;
      const float val = acc[cc] * __expf(-tn * p.in[I_HDECAY][l * 1024 + col]);
      if (isc) ((float*)(p.ws + OFF_FILTC))[((size_t)l * 1024 + col) * CTXL + t0 + tloc] = val;
      else     ((float*)(p.ws + OFF_FILT))[((size_t)l * 1024 + col) * SEQ + t0 + tloc] = val;
      const float s = wave_sum(val * val);
      if (lane == 0) {
        if (isc) ((float*)(p.ws + OFF_SSQPC))[((size_t)l * 4 + (tt - 128)) * 1024 + col] = s;
        else     ((float*)(p.ws + OFF_SSQP))[((size_t)l * 128 + tt) * 1024 + col] = s;
      }
    }
  }
}

__device__ void stage_norm(const Params& p, int layer, int which  , int nrows) {
  const int lane = TIDX & 63, wid = TIDX >> 6;
  const float* g = (which ? p.in[I_N2G] : p.in[I_N1G]) + layer * DM;
  bf16_t* hb = (bf16_t*)(p.ws + OFF_HB);
  for (int r = BIDX * 8 + wid; r < nrows; r += gridDim.x * 8) {
    int b, t, isc; row_info(r, b, t, isc);
    const float* src = (which == 0) ? xrow_src(p, layer, r) : (const float*)(p.ws + OFF_XS) + (size_t)r * DM;
    const float* mod = (const float*)(p.ws + OFF_MOD) + ((size_t)layer * 3 + (isc ? 2 : b)) * 6144 + (which ? 3072 : 0);
    f32x4 v[4]; float ss = 0.f;
#pragma unroll
    for (int i = 0; i < 4; ++i) { v[i] = *(const f32x4*)(src + (i * 64 + lane) * 4); ss += v[i][0] * v[i][0] + v[i][1] * v[i][1] + v[i][2] * v[i][2] + v[i][3] * v[i][3]; }
    ss = wave_sum(ss);
    const float rinv = rsqrtf(ss * (1.f / DM) + EPSV);
#pragma unroll
    for (int i = 0; i < 4; ++i) {
      const int c0 = (i * 64 + lane) * 4;
      float y[4];
#pragma unroll
      for (int j = 0; j < 4; ++j) y[j] = v[i][j] * rinv * g[c0 + j] * (1.f + mod[1024 + c0 + j]) + mod[c0 + j];
      u32x2 o = {cvtpk(y[0], y[1]), cvtpk(y[2], y[3])};
      *(u32x2*)(hb + (size_t)r * DM + c0) = o;
    }
  }
}

template <class Epi>
__device__ void gemm_bt(const bf16_t* __restrict__ A, int lda, const bf16_t* __restrict__ Bt, int ldb, int M, int N, int K, Epi epi, char* smem) {
  const int tid = TIDX, wid = tid >> 6, lane = tid & 63, r32 = lane & 31, hi = lane >> 5;
  const int wm = wid >> 2, wn = wid & 3;
  constexpr int RS = 144;
  char* sA = smem; char* sB = smem + 128 * RS;
  const int tilesM = M / 128, tilesN = N / 128, nk = K / 64;
  const int lr0 = tid >> 3, lc = (tid & 7) * 8;
  for (int tile = BIDX; tile < tilesM * tilesN; tile += gridDim.x) {
    const int tm = tile / tilesN, tn = tile % tilesN;
    const bf16_t* Ap = A + (size_t)(tm * 128 + lr0) * lda + lc;
    const bf16_t* Bp = Bt + (size_t)(tn * 128 + lr0) * ldb + lc;
    f32x16 acc0 = {}, acc1 = {};
    u32x4 ra0 = *(const u32x4*)Ap, ra1 = *(const u32x4*)(Ap + (size_t)64 * lda);
    u32x4 rb0 = *(const u32x4*)Bp, rb1 = *(const u32x4*)(Bp + (size_t)64 * ldb);
    for (int kt = 0; kt < nk; ++kt) {
      __syncthreads();
      *(u32x4*)(sA + lr0 * RS + lc * 2) = ra0; *(u32x4*)(sA + (lr0 + 64) * RS + lc * 2) = ra1;
      *(u32x4*)(sB + lr0 * RS + lc * 2) = rb0; *(u32x4*)(sB + (lr0 + 64) * RS + lc * 2) = rb1;
      __syncthreads();
      if (kt + 1 < nk) {
        const int ko = (kt + 1) * 64;
        ra0 = *(const u32x4*)(Ap + ko); ra1 = *(const u32x4*)(Ap + (size_t)64 * lda + ko);
        rb0 = *(const u32x4*)(Bp + ko); rb1 = *(const u32x4*)(Bp + (size_t)64 * ldb + ko);
      }
#pragma unroll
      for (int ks = 0; ks < 4; ++ks) {
        const int cb = (ks * 16 + hi * 8) * 2;
        const bf16x8 a0 = *(const bf16x8*)(sA + (wm * 64 + r32) * RS + cb);
        const bf16x8 a1 = *(const bf16x8*)(sA + (wm * 64 + 32 + r32) * RS + cb);
        const bf16x8 bb = *(const bf16x8*)(sB + (wn * 32 + r32) * RS + cb);
        acc0 = __builtin_amdgcn_mfma_f32_32x32x16_bf16(a0, bb, acc0, 0, 0, 0);
        acc1 = __builtin_amdgcn_mfma_f32_32x32x16_bf16(a1, bb, acc1, 0, 0, 0);
      }
    }
    const int col = tn * 128 + wn * 32 + r32;
#pragma unroll
    for (int r = 0; r < 16; ++r) {
      epi(tm * 128 + wm * 64 + crow(r, hi), col, acc0[r]);
      epi(tm * 128 + wm * 64 + 32 + crow(r, hi), col, acc1[r]);
    }
  }
}

__device__ __forceinline__ float rope_apply(float x, float xp, int c, int t) {
  const int i = c & 7; const float pos = ((c >> 4) & 1) ? (float)(t & 63) : (float)(t >> 6);
  const float inv = __expf(-(float)i * (9.210340371976184f / 8.f));
  const float ang = pos * inv;
  const float cs = cosf(ang), sn = sinf(ang);
  return x * cs + ((c & 8) ? xp : -xp) * sn;
}

__device__ void lru_units(const Params& p, int layer, int mode, char* smem) {
  const int tid = TIDX, wid = tid >> 6, lane = tid & 63, r32 = lane & 31, hi = lane >> 5;
  float* xcf = (float*)smem;
  char* xcb = smem + 16384;
  float* As = (float*)(smem + 16384 + 9216);
  float* Bs = As + 2 * 64 * 64;
  const float* u = (const float*)(p.ws + OFF_U);
  const float* cw = p.in[I_LCW] + (size_t)layer * 4 * DLRU; const float* cbias = p.in[I_LCB] + layer * DLRU;
  for (int unit = BIDX; unit < NCHUNK * 6; unit += gridDim.x) {
    const int cid = unit / 6, n = unit % 6;
    int rbase, t0, slen;
    if (cid < 256) { const int b = cid >> 7, ch = cid & 127; rbase = b * SEQ; t0 = ch * 64; slen = SEQ; }
    else { const int q = cid - 256, b = q >> 2, ch = q & 3; rbase = NLAT + b * CTXL; t0 = ch * 64; slen = CTXL; }
    __syncthreads();
    {
      const int d = tid & 63, dch = n * 64 + d;
      const float w0 = cw[dch], w1 = cw[DLRU + dch], w2 = cw[2 * DLRU + dch], w3 = cw[3 * DLRU + dch], bb = cbias[dch];
      for (int i = 0; i < 8; ++i) {
        const int tl = (tid >> 6) + 8 * i, t = t0 + tl;
        float acc = bb;
        if (t - 2 >= 0)   acc += w0 * u[(size_t)(rbase + t - 2) * DIN + dch];
        if (t - 1 >= 0)   acc += w1 * u[(size_t)(rbase + t - 1) * DIN + dch];
        acc += w2 * u[(size_t)(rbase + t) * DIN + dch];
        if (t + 1 < slen) acc += w3 * u[(size_t)(rbase + t + 1) * DIN + dch];
        xcf[tl * 64 + d] = acc;
        *(bf16_t*)(xcb + tl * 144 + d * 2) = f2bf(acc);
      }
    }
    __syncthreads();
    {
      const int dir = wid & 1, mh = (wid >> 1) & 1, nt = wid >> 2;
      const bf16_t* gwr = (const bf16_t*)(p.ws + OFF_GW) + ((size_t)((layer * 2 + dir) * 2 + 0) * 6 + n) * 4096;
      const bf16_t* gwi = (const bf16_t*)(p.ws + OFF_GW) + ((size_t)((layer * 2 + dir) * 2 + 1) * 6 + n) * 4096;
      f32x16 accR = {}, accI = {};
#pragma unroll
      for (int ks = 0; ks < 4; ++ks) {
        const bf16x8 a = *(const bf16x8*)(xcb + (mh * 32 + r32) * 144 + (ks * 16 + hi * 8) * 2);
        const bf16x8 br_ = *(const bf16x8*)(gwr + (nt * 32 + r32) * 64 + ks * 16 + hi * 8);
        const bf16x8 bi_ = *(const bf16x8*)(gwi + (nt * 32 + r32) * 64 + ks * 16 + hi * 8);
        accR = __builtin_amdgcn_mfma_f32_32x32x16_bf16(a, br_, accR, 0, 0, 0);
        accI = __builtin_amdgcn_mfma_f32_32x32x16_bf16(a, bi_, accI, 0, 0, 0);
      }
      const int e = nt * 32 + r32, ch = n * 64 + e;
      const size_t po = (size_t)(layer * 2 + dir) * DLRU + ch;
      const float brv = p.in[I_LBR][po], biv = p.in[I_LBI][po];
      const float lam = p.in[I_LLAM][po];
      const float cl = -8.f * log1pf(__expf(-lam));
#pragma unroll
      for (int r = 0; r < 16; ++r) {
        const int tl = mh * 32 + crow(r, hi);
        const float rr = sigm(accR[r] + brv), ii = sigm(accI[r] + biv);
        const float la = rr * cl;
        const float a = __expf(la);
        const float bco = sqrtf(-expm1f(2.f * la)) * (ii * xcf[tl * 64 + e]);
        As[(dir * 64 + tl) * 64 + e] = a; Bs[(dir * 64 + tl) * 64 + e] = bco;
      }
    }
    __syncthreads();
    if (tid < 128) {
      const int dir = tid >> 6, e = tid & 63, ch = n * 64 + e;
      if (mode == 0) {
        float h = 0.f, P = 1.f;
        if (dir == 0) { for (int t = 0; t < 64; ++t) { const float a = As[t * 64 + e]; h = a * h + Bs[t * 64 + e]; P *= a; } }
        else { for (int t = 63; t >= 0; --t) { const float a = As[(64 + t) * 64 + e]; h = a * h + Bs[(64 + t) * 64 + e]; P *= a; } }
        float* ls = (float*)(p.ws + OFF_LSUM) + ((size_t)(cid * 2 + dir) * 2) * DLRU + ch;
        ls[0] = P; ls[DLRU] = h;
      } else {
        float h = ((const float*)(p.ws + OFF_CARRY))[(size_t)(cid * 2 + dir) * DLRU + ch];
        if (dir == 0) { for (int t = 0; t < 64; ++t) { h = As[t * 64 + e] * h + Bs[t * 64 + e]; Bs[t * 64 + e] = h; } }
        else { for (int t = 63; t >= 0; --t) { h = As[(64 + t) * 64 + e] * h + Bs[(64 + t) * 64 + e]; Bs[(64 + t) * 64 + e] = h; } }
      }
    }
    if (mode == 1) {
      __syncthreads();
      bf16_t* mix = (bf16_t*)(p.ws + OFF_MIX);
      const int e = tid & 63;
      for (int i = 0; i < 8; ++i) {
        const int tl = (tid >> 6) + 8 * i; const size_t row = (size_t)rbase + t0 + tl;
        const float y = Bs[tl * 64 + e] + Bs[(64 + tl) * 64 + e];
        const float gt = u[row * DIN + DLRU + n * 64 + e];
        mix[row * DM + n * 64 + e] = f2bf(y * gelu_tanh(gt));
      }
    }
  }
}

__device__ void lru_carry(const Params& p) {
  const int idx = BIDX * NTHREADS + TIDX;
  if (idx >= 2 * 2 * DLRU) return;
  const int b = idx / (2 * DLRU), dir = (idx / DLRU) & 1, ch = idx % DLRU;
  const float* ls = (const float*)(p.ws + OFF_LSUM); float* cr = (float*)(p.ws + OFF_CARRY);
  float st = 0.f;
  for (int k = 0; k < 4 + 128; ++k) {
    int cid;
    if (dir == 0) cid = (k < 4) ? 256 + b * 4 + k : b * 128 + (k - 4);
    else          cid = (k < 4) ? 256 + b * 4 + (3 - k) : b * 128 + (127 - (k - 4));
    cr[(size_t)(cid * 2 + dir) * DLRU + ch] = st;
    const float P = ls[((size_t)(cid * 2 + dir) * 2) * DLRU + ch], H = ls[((size_t)(cid * 2 + dir) * 2 + 1) * DLRU + ch];
    st = P * st + H;
  }
}

__device__ void mla_prep(const Params& p, int layer) {
  const int lane = TIDX & 63, wid = TIDX >> 6;
  const float* u = (const float*)(p.ws + OFF_U);
  const float* qg = p.in[I_QNG] + layer * 384; const float* kvg = p.in[I_KVNG] + layer * 256;
  bf16_t* qn = (bf16_t*)(p.ws + OFF_QN); bf16_t* kvn = (bf16_t*)(p.ws + OFF_KVN); bf16_t* Kb = (bf16_t*)(p.ws + OFF_K);
  for (int r = BIDX * 8 + wid; r < NTOK; r += gridDim.x * 8) {
    int b, t, isc; row_info(r, b, t, isc);
    const float* ur = u + (size_t)r * DIN;
    float q[6], ss = 0.f;
#pragma unroll
    for (int i = 0; i < 6; ++i) { q[i] = ur[768 + i * 64 + lane]; ss += q[i] * q[i]; }
    ss = wave_sum(ss);
    float rinv = rsqrtf(ss * (1.f / 384.f) + EPSV);
#pragma unroll
    for (int i = 0; i < 6; ++i) qn[(size_t)r * 384 + i * 64 + lane] = f2bf(q[i] * rinv * qg[i * 64 + lane]);
    float kv[4]; ss = 0.f;
#pragma unroll
    for (int i = 0; i < 4; ++i) { kv[i] = ur[1152 + i * 64 + lane]; ss += kv[i] * kv[i]; }
    ss = wave_sum(ss);
    rinv = rsqrtf(ss * (1.f / 256.f) + EPSV);
#pragma unroll
    for (int i = 0; i < 4; ++i) kvn[(size_t)r * 256 + i * 64 + lane] = f2bf(kv[i] * rinv * kvg[i * 64 + lane]);
    const float kr = ur[1408 + (lane & 31)];
    const float krp = shx(kr, 8);
    const float ko = isc ? kr : rope_apply(kr, krp, lane & 31, t);
    if (lane < 32) {
      const int tk = isc ? t : CTXL + t; const bf16_t kb = f2bf(ko);
#pragma unroll
      for (int h = 0; h < 6; ++h) Kb[((size_t)(b * 6 + h) * NKEYS + tk) * 96 + 64 + lane] = kb;
    }
  }
}

__device__ void hyena_prep(const Params& p, int layer, char* smem) {
  float* tile = (float*)smem;
  const float* u = (const float*)(p.ws + OFF_U);
  const float* cw = p.in[I_HCW] + (size_t)layer * 3 * 768; const float* cb = p.in[I_HCB] + layer * 768;
  const int ntile = (layer == 0) ? NCHUNK : 256;
  for (int unit = BIDX; unit < ntile * 3; unit += gridDim.x) {
    const int cid = unit / 3, part = unit % 3;
    int rbase, t0, slen, b;
    if (cid < 256) { b = cid >> 7; rbase = b * SEQ; t0 = (cid & 127) * 64; slen = SEQ; }
    else { const int q = cid - 256; b = q >> 2; rbase = NLAT + b * CTXL; t0 = (q & 3) * 64; slen = CTXL; }
    __syncthreads();
    {
      const int c = TIDX & 255, pc = part * 256 + c;
      const float w0 = cw[pc], w1 = cw[768 + pc], w2 = cw[1536 + pc], bb = cb[pc];
      for (int i = 0; i < 32; ++i) {
        const int tl = (TIDX >> 8) + 2 * i, t = t0 + tl;
        float acc = bb + w1 * u[(size_t)(rbase + t) * DIN + 1440 + pc];
        if (t - 1 >= 0)   acc += w0 * u[(size_t)(rbase + t - 1) * DIN + 1440 + pc];
        if (t + 1 < slen) acc += w2 * u[(size_t)(rbase + t + 1) * DIN + 1440 + pc];
        tile[c * 65 + tl] = acc;
      }
    }
    __syncthreads();
    {
      const int tl = TIDX & 63;
      float* dst = (cid < 256) ? (float*)(p.ws + OFF_HYIN) + ((size_t)(part * 2 + b) * 256) * SEQ
                               : (float*)(p.ws + OFF_HYINC) + ((size_t)(part * 2 + b) * 256) * CTXL;
      for (int i = 0; i < 32; ++i) { const int c = (TIDX >> 6) + 8 * i; dst[(size_t)c * slen + t0 + tl] = tile[c * 65 + tl]; }
    }
  }
}

__device__ void hyena_direct(const Params& p, int layer, char* smem) {
  float* zs = (float*)smem;
  float* Ts = zs + SEQ;
  bf16_t* mix = (bf16_t*)(p.ws + OFF_MIX);
  const int nunits = (layer == 0) ? 1024 : 512;
  for (int unit = BIDX; unit < nunits; unit += gridDim.x) {
    const bool isc = unit >= 512; const int q = unit & 511, b = q >> 8, c = q & 255;
    const int L = isc ? CTXL : SEQ;
    const float* hin = isc ? (const float*)(p.ws + OFF_HYINC) : (const float*)(p.ws + OFF_HYIN);
    const float* filt = isc ? (const float*)(p.ws + OFF_FILTC) + (size_t)layer * 1024 * CTXL : (const float*)(p.ws + OFF_FILT) + (size_t)layer * 1024 * SEQ;
    const float* ssq = isc ? (const float*)(p.ws + OFF_SSQPC) + (size_t)layer * 4 * 1024 : (const float*)(p.ws + OFF_SSQP) + (size_t)layer * 128 * 1024;
    const int ntt = isc ? 4 : 128;
    const int nout = (L + NTHREADS - 1) / NTHREADS;
    for (int order = 0; order < 2; ++order) {
      const int colf = (order * 2 + 0) * 256 + c, colb = (order * 2 + 1) * 256 + c;
      float sf = 0.f, sb = 0.f;
      for (int tt = 0; tt < ntt; ++tt) { sf += ssq[(size_t)tt * 1024 + colf]; sb += ssq[(size_t)tt * 1024 + colb]; }
      sf = rsqrtf(sf + EPSV); sb = rsqrtf(sb + EPSV);
      const float skip = p.in[I_HSKIP][(size_t)layer * 512 + order * 256 + c];
      __syncthreads();
      for (int i = TIDX; i < 2 * L; i += NTHREADS) {
        const int m = i - L;
        float v = 0.f;
        if (m >= 0) v = filt[(size_t)colf * L + m] * sf; else if (m > -L) v = filt[(size_t)colb * L - m] * sb;
        if (m == 0) v += skip;
        Ts[i] = v;
      }
      if (order == 0) for (int i = TIDX; i < L; i += NTHREADS) zs[i] = hin[((size_t)(0 * 2 + b) * 256 + c) * L + i];
      __syncthreads();
      float acc[16];
#pragma unroll
      for (int j = 0; j < 16; ++j) acc[j] = 0.f;
      if ((int)TIDX < L) {
        const float* tb = Ts + L + TIDX;
        if (!isc) {
          for (int s = 0; s < SEQ; ++s) {
            const float zv = zs[s];
#pragma unroll
            for (int j = 0; j < 16; ++j) acc[j] += tb[j * NTHREADS - s] * zv;
          }
        } else {
          for (int s = 0; s < CTXL; ++s) acc[0] += tb[-s] * zs[s];
        }
      }
      __syncthreads();
      const float* xg = hin + ((size_t)((1 + order) * 2 + b) * 256 + c) * L;
#pragma unroll
      for (int j = 0; j < 16; ++j) {
        const int t = TIDX + j * NTHREADS;
        if (t < L) {
          const float y = xg[t] * acc[j];
          if (order == 0) zs[t] = y;
          else { const size_t row = isc ? (size_t)NLAT + b * CTXL + t : (size_t)b * SEQ + t; mix[row * DM + 768 + c] = f2bf(y); }
        }
      }
    }
  }
}

namespace att {
constexpr int NW = 8, QBLK = 32, KVBLK = 64;
constexpr float SCALE = 0.10206207261596575f;
constexpr float THR = 8.f;
constexpr int SHM_V = KVBLK * 128 * 2, SHM_K = KVBLK * 128 * 2;
constexpr int SHM_ATTN = 2 * SHM_V + 2 * SHM_K + NW * 64 * 4;
#define KSWZ(row, colB) ((row) * 256 + ((colB) ^ (((row) & 7) << 4)))
#define SBAR() __builtin_amdgcn_sched_barrier(0)
__device__ __forceinline__ void partialSM(f32x16& p0, f32x16& p1, float& m_reg, float& mn, float& alpha) {
  constexpr float C = SCALE * 1.4426950408889634f;
  float pmax = p0[0];
#pragma unroll
  for (int r = 1; r < 16; ++r) pmax = fmaxf(pmax, p0[r]);
#pragma unroll
  for (int r = 0; r < 16; ++r) pmax = fmaxf(pmax, p1[r]);
  { auto rr = __builtin_amdgcn_permlane32_swap(__float_as_uint(pmax), __float_as_uint(pmax), false, false);
    pmax = fmaxf(__uint_as_float(rr[0]), __uint_as_float(rr[1])); }
  if (__builtin_expect(__all(pmax - m_reg <= THR / SCALE), 1)) { mn = m_reg; alpha = 1.f; }
  else { mn = fmaxf(m_reg, pmax); alpha = __builtin_amdgcn_exp2f((m_reg - mn) * C); m_reg = mn; }
  const float mnC = -mn * C;
#pragma unroll
  for (int r = 0; r < 16; ++r) p0[r] = fmaf(p0[r], C, mnC);
#pragma unroll
  for (int r = 0; r < 16; ++r) p1[r] = fmaf(p1[r], C, mnC);
#pragma unroll
  for (int r = 0; r < 16; ++r) p0[r] = __builtin_amdgcn_exp2f(p0[r]);
}
__device__ __forceinline__ void finishSM(f32x16& p0, f32x16& p1, float alpha, float& l_reg, bf16x8& pa0, bf16x8& pa1, bf16x8& pa2, bf16x8& pa3) {
#pragma unroll
  for (int r = 0; r < 16; ++r) p1[r] = __builtin_amdgcn_exp2f(p1[r]);
  float ps = 0;
#pragma unroll
  for (int r = 0; r < 16; ++r) ps += p0[r];
#pragma unroll
  for (int r = 0; r < 16; ++r) ps += p1[r];
  { auto rr = __builtin_amdgcn_permlane32_swap(__float_as_uint(ps), __float_as_uint(ps), false, false);
    ps = __uint_as_float(rr[0]) + __uint_as_float(rr[1]); }
  l_reg = l_reg * alpha + ps;
#define PK4(P, BASE, OUT) do { unsigned a0 = cvtpk(P[BASE + 0], P[BASE + 1]), a1 = cvtpk(P[BASE + 2], P[BASE + 3]);   \
    unsigned b0 = cvtpk(P[BASE + 4], P[BASE + 5]), b1 = cvtpk(P[BASE + 6], P[BASE + 7]);                              \
    auto r0 = __builtin_amdgcn_permlane32_swap(a0, b0, false, false); auto r1 = __builtin_amdgcn_permlane32_swap(a1, b1, false, false); \
    u32x4 w = {r0[0], r1[0], r0[1], r1[1]}; OUT = *reinterpret_cast<bf16x8*>(&w); } while (0)
  PK4(p0, 0, pa0); PK4(p0, 8, pa1); PK4(p1, 0, pa2); PK4(p1, 8, pa3);
#undef PK4
}
__device__ __forceinline__ void qkt(f32x16& p0, f32x16& p1, const char* Ks, const bf16x8* qr, int r32, int hi) {
  p0 = f32x16{}; p1 = f32x16{};
#pragma unroll
  for (int d0 = 0; d0 < 6; ++d0) { const int cb = (d0 * 16 + hi * 8) * 2;
    const bf16x8 b0 = *reinterpret_cast<const bf16x8*>(Ks + KSWZ(r32, cb));
    const bf16x8 b1 = *reinterpret_cast<const bf16x8*>(Ks + KSWZ(32 + r32, cb));
    p0 = __builtin_amdgcn_mfma_f32_32x32x16_bf16(b0, qr[d0], p0, 0, 0, 0);
    p1 = __builtin_amdgcn_mfma_f32_32x32x16_bf16(b1, qr[d0], p1, 0, 0, 0); }
}
__device__ __forceinline__ int v_st(int k, int c) { const int kk = (k & ~0xC) | ((k & 4) << 1) | ((k & 8) >> 1); return ((kk >> 3) * 4 + (c >> 5)) * 512 + ((kk & 7) * 32 + (c & 31)) * 2; }
__device__ __forceinline__ int v_rd_base(int lane) { return ((lane & 3) << 3) | (((lane >> 2) & 3) << 6) | (((lane >> 4) & 1) << 5) | (((lane >> 5) & 1) << 8); }
constexpr int v_rd_off(int d0, int ks, int half) { return d0 * 512 + ks * 4096 + half * 2048; }
template <int OFF> __device__ __forceinline__ s16x4 tr_read(int vb) {
  s16x4 r; asm volatile("ds_read_b64_tr_b16 %0, %1 offset:%2" : "=&v"(r) : "v"(vb), "i"(OFF) : "memory"); return r;
}
template <int D0> __device__ __forceinline__ void pv_one(f32x16& od, int vb, bf16x8 pa0, bf16x8 pa1, bf16x8 pa2, bf16x8 pa3) {
  const s16x4 l0 = tr_read<v_rd_off(D0, 0, 0)>(vb), h0 = tr_read<v_rd_off(D0, 0, 1)>(vb), l1 = tr_read<v_rd_off(D0, 1, 0)>(vb), h1 = tr_read<v_rd_off(D0, 1, 1)>(vb);
  const s16x4 l2 = tr_read<v_rd_off(D0, 2, 0)>(vb), h2 = tr_read<v_rd_off(D0, 2, 1)>(vb), l3 = tr_read<v_rd_off(D0, 3, 0)>(vb), h3 = tr_read<v_rd_off(D0, 3, 1)>(vb);
  asm volatile("s_waitcnt lgkmcnt(0)" ::: "memory"); SBAR();
#define PK(L, H) (bf16x8){L[0], L[1], L[2], L[3], H[0], H[1], H[2], H[3]}
  od = __builtin_amdgcn_mfma_f32_32x32x16_bf16(pa0, PK(l0, h0), od, 0, 0, 0);
  od = __builtin_amdgcn_mfma_f32_32x32x16_bf16(pa1, PK(l1, h1), od, 0, 0, 0);
  od = __builtin_amdgcn_mfma_f32_32x32x16_bf16(pa2, PK(l2, h2), od, 0, 0, 0);
  od = __builtin_amdgcn_mfma_f32_32x32x16_bf16(pa3, PK(l3, h3), od, 0, 0, 0);
#undef PK
}
__device__ __forceinline__ void pv_d0(f32x16& o0, f32x16& o1, int vb, bf16x8 pa0, bf16x8 pa1, bf16x8 pa2, bf16x8 pa3) {
  pv_one<0>(o0, vb, pa0, pa1, pa2, pa3); pv_one<1>(o1, vb, pa0, pa1, pa2, pa3);
}
__device__ __forceinline__ void attn_body(const bf16_t* __restrict__ Qb, const bf16_t* __restrict__ Kh, const bf16_t* __restrict__ Vh,
                                          bf16_t* __restrict__ Ob, int seq, char* lds) {
  const int tid = TIDX, wid = tid >> 6, lane = tid & 63, r32 = lane & 31, hi = lane >> 5;
  char* V_lds = lds; char* K_lds = lds + 2 * SHM_V;
  float* ws = (float*)(lds + 2 * SHM_V + 2 * SHM_K) + wid * 64; float* li_l = ws; float* al_l = ws + 32;
  float m_reg = -1e30f, l_reg = 0; f32x16 o0 = {}, o1 = {}; bf16x8 qr[6];
  const bf16_t* Qw = Qb + (size_t)(wid * QBLK + r32) * 96 + hi * 8;
#pragma unroll
  for (int d0 = 0; d0 < 6; ++d0) qr[d0] = *(const bf16x8*)(Qw + d0 * 16);
  const int sr = tid >> 4, sc = (tid & 15) * 8, vst0 = v_st(sr, sc & 63), vst1 = v_st(32 + sr, sc & 63);
  const int vb0 = (int)(uintptr_t)V_lds + v_rd_base(lane);
  const bool kact = sc < 96, vact = sc < 64;
  bf16x8 vs0 = {}, vs1 = {}, ks0 = {}, ks1 = {};
#define SLOAD(k0) do { if (vact) { vs0 = *(const bf16x8*)(&Vh[(size_t)((k0) + sr) * 64 + sc]); vs1 = *(const bf16x8*)(&Vh[(size_t)((k0) + 32 + sr) * 64 + sc]); } \
    if (kact) { ks0 = *(const bf16x8*)(&Kh[(size_t)((k0) + sr) * 96 + sc]); ks1 = *(const bf16x8*)(&Kh[(size_t)((k0) + 32 + sr) * 96 + sc]); } } while (0)
#define SWRITE(b) do { if (vact) { *(bf16x8*)(V_lds + (b) * SHM_V + vst0) = vs0; *(bf16x8*)(V_lds + (b) * SHM_V + vst1) = vs1; } \
    if (kact) { const int kc = sc * 2; *(bf16x8*)(K_lds + (b) * SHM_K + KSWZ(sr, kc)) = ks0; *(bf16x8*)(K_lds + (b) * SHM_K + KSWZ(32 + sr, kc)) = ks1; } } while (0)
#define SWAIT() asm volatile("s_waitcnt vmcnt(0)" ::: "memory")
#define RESC(a) do { if (__any((a) < 1.f)) { if (hi == 0) al_l[r32] = (a); asm volatile("s_waitcnt lgkmcnt(0)" ::: "memory"); \
    _Pragma("unroll") for (int r = 0; r < 16; ++r) { const float f = al_l[crow(r, hi)]; o0[r] *= f; o1[r] *= f; } } } while (0)
  f32x16 pA0, pA1, pB0, pB1; float mnA, mnB, alA, alB; bf16x8 pa0, pa1, pa2, pa3; const int NT = seq / KVBLK;
  __syncthreads();
  SLOAD(0); SWAIT(); SWRITE(0); __syncthreads();
  qkt(pA0, pA1, K_lds, qr, r32, hi); partialSM(pA0, pA1, m_reg, mnA, alA);
  SLOAD(KVBLK);
  SWAIT(); SWRITE(1); __syncthreads();
  for (int j = 1; j + 1 < NT; j += 2) {
    SBAR(); qkt(pB0, pB1, K_lds + SHM_K, qr, r32, hi);
    finishSM(pA0, pA1, alA, l_reg, pa0, pa1, pa2, pa3); SBAR();
    SLOAD((j + 1) * KVBLK); SBAR();
    pv_d0(o0, o1, vb0, pa0, pa1, pa2, pa3); partialSM(pB0, pB1, m_reg, mnB, alB);
    __syncthreads(); SWAIT(); SWRITE(0);
    RESC(alB); __syncthreads();
    SBAR(); qkt(pA0, pA1, K_lds, qr, r32, hi);
    finishSM(pB0, pB1, alB, l_reg, pa0, pa1, pa2, pa3); SBAR();
    SLOAD((j + 2) * KVBLK); SBAR();
    pv_d0(o0, o1, vb0 + SHM_V, pa0, pa1, pa2, pa3); partialSM(pA0, pA1, m_reg, mnA, alA);
    __syncthreads(); SWAIT(); SWRITE(1);
    RESC(alA); __syncthreads();
  }
  SBAR(); qkt(pB0, pB1, K_lds + SHM_K, qr, r32, hi);
  finishSM(pA0, pA1, alA, l_reg, pa0, pa1, pa2, pa3); SBAR();
  pv_d0(o0, o1, vb0, pa0, pa1, pa2, pa3); partialSM(pB0, pB1, m_reg, mnB, alB);
  __syncthreads(); RESC(alB);
  finishSM(pB0, pB1, alB, l_reg, pa0, pa1, pa2, pa3); SBAR();
  pv_d0(o0, o1, vb0 + SHM_V, pa0, pa1, pa2, pa3);
  if (hi == 0) li_l[r32] = l_reg; asm volatile("s_waitcnt lgkmcnt(0)" ::: "memory");
  bf16_t* Ow = Ob + (size_t)(wid * QBLK) * DM;
#pragma unroll
  for (int r = 0; r < 16; ++r) { const int orow = crow(r, hi); const float rl = __builtin_amdgcn_rcpf(li_l[orow]);
    Ow[(size_t)orow * DM + r32] = f2bf(o0[r] * rl); Ow[(size_t)orow * DM + 32 + r32] = f2bf(o1[r] * rl); }
#undef SLOAD
#undef SWRITE
#undef SWAIT
#undef RESC
}
}

__device__ void attn_units(const Params& p, int layer, char* smem) {
  const bf16_t* Q = (const bf16_t*)(p.ws + OFF_Q); const bf16_t* QC = (const bf16_t*)(p.ws + OFF_QC);
  const bf16_t* K = (const bf16_t*)(p.ws + OFF_K); const bf16_t* V = (const bf16_t*)(p.ws + OFF_V);
  bf16_t* mix = (bf16_t*)(p.ws + OFF_MIX);
  const int nunits = 384 + ((layer == 0) ? 12 : 0);
  for (int unit = BIDX; unit < nunits; unit += gridDim.x) {
    if (unit < 384) {
      const int bh = unit >> 5, qb = unit & 31, b = bh / 6, h = bh % 6;
      att::attn_body(Q + ((size_t)bh * SEQ + qb * 256) * 96, K + (size_t)bh * NKEYS * 96, V + (size_t)bh * NKEYS * 64,
                     mix + ((size_t)b * SEQ + qb * 256) * DM + 384 + h * 64, NKEYS, smem);
    } else {
      const int bh = unit - 384, b = bh / 6, h = bh % 6;
      att::attn_body(QC + (size_t)bh * CTXL * 96, K + (size_t)bh * NKEYS * 96, V + (size_t)bh * NKEYS * 64,
                     mix + ((size_t)NLAT + b * CTXL) * DM + 384 + h * 64, CTXL, smem);
    }
  }
}

__device__ __forceinline__ void wave_argmax(float& v, int& idx) {
#pragma unroll
  for (int o = 32; o > 0; o >>= 1) {
    const float ov = shx(v, o); const int oi = shxi(idx, o);
    if (ov > v || (ov == v && oi < idx)) { v = ov; idx = oi; }
  }
}
__device__ void peer_topk(const Params& p, int layer, int nrows, char* smem) {
  const int tid = TIDX, wid = tid >> 6, lane = tid & 63, r32 = lane & 31, hi = lane >> 5;
  float* S = (float*)smem;
  float* topv = S + 64 * 256;
  int* topi = (int*)(topv + 64 * 32);
  const bf16_t* pq = (const bf16_t*)(p.ws + OFF_PQ);
  const bf16_t* keys = (const bf16_t*)(p.ws + OFF_KEYS) + (size_t)layer * 2 * 128 * 128;
  int* eid = (int*)(p.ws + OFF_EID); float* gate = (float*)(p.ws + OFF_GATE);
  const int ntile = nrows / 64;
  for (int unit = BIDX; unit < ntile * 8; unit += gridDim.x) {
    const int tile = unit >> 3, h = unit & 7;
    __syncthreads();
    {
      const int half = wid & 1, mh = (wid >> 1) & 1, nq = wid >> 2;
      const bf16_t* ap = pq + (size_t)(tile * 64 + mh * 32 + r32) * 2048 + h * 256 + half * 128 + hi * 8;
      const bf16_t* bp = keys + (size_t)(half * 128 + nq * 64 + r32) * 128 + hi * 8;
      f32x16 a0 = {}, a1 = {};
#pragma unroll
      for (int ks = 0; ks < 8; ++ks) {
        const bf16x8 a = *(const bf16x8*)(ap + ks * 16);
        const bf16x8 b0 = *(const bf16x8*)(bp + ks * 16);
        const bf16x8 b1 = *(const bf16x8*)(bp + 32 * 128 + ks * 16);
        a0 = __builtin_amdgcn_mfma_f32_32x32x16_bf16(a, b0, a0, 0, 0, 0);
        a1 = __builtin_amdgcn_mfma_f32_32x32x16_bf16(a, b1, a1, 0, 0, 0);
      }
#pragma unroll
      for (int r = 0; r < 16; ++r) {
        const int tok = mh * 32 + crow(r, hi);
        S[(tok * 2 + half) * 128 + nq * 64 + r32] = a0[r];
        S[(tok * 2 + half) * 128 + nq * 64 + 32 + r32] = a1[r];
      }
    }
    __syncthreads();
    for (int rr = 0; rr < 16; ++rr) {
      const int row = wid * 16 + rr;
      float v0 = S[row * 128 + lane], v1 = S[row * 128 + 64 + lane];
      for (int it = 0; it < 16; ++it) {
        float bv; int bi;
        if (v1 > v0) { bv = v1; bi = lane + 64; } else { bv = v0; bi = lane; }
        wave_argmax(bv, bi);
        if (bi == lane) v0 = -3.0e38f; else if (bi == lane + 64) v1 = -3.0e38f;
        if (lane == 0) { topv[row * 16 + it] = bv; topi[row * 16 + it] = bi; }
      }
    }
    __syncthreads();
    for (int tt = 0; tt < 8; ++tt) {
      const int tok = wid * 8 + tt;
      float cv[4];
#pragma unroll
      for (int q = 0; q < 4; ++q) { const int pidx = lane * 4 + q; cv[q] = topv[(tok * 2) * 16 + (pidx >> 4)] + topv[(tok * 2 + 1) * 16 + (pidx & 15)]; }
      float mys = 0.f; int myp = 0;
      for (int it = 0; it < 16; ++it) {
        float bv = cv[0]; int bi = lane * 4;
#pragma unroll
        for (int q = 1; q < 4; ++q) if (cv[q] > bv) { bv = cv[q]; bi = lane * 4 + q; }
        wave_argmax(bv, bi);
#pragma unroll
        for (int q = 0; q < 4; ++q) if (bi == lane * 4 + q) cv[q] = -3.0e38f;
        if (lane == it) { mys = bv; myp = bi; }
      }
      const float mx = rdl(mys, 0);
      float ex = (lane < 16) ? __expf(mys - mx) : 0.f;
      float sm = ex;
#pragma unroll
      for (int o = 8; o > 0; o >>= 1) sm += shx(sm, o);
      if (lane < 16) {
        const size_t row = (size_t)tile * 64 + tok;
        const int e = topi[(tok * 2) * 16 + (myp >> 4)] * 128 + topi[(tok * 2 + 1) * 16 + (myp & 15)];
        eid[row * 128 + h * 16 + lane] = e;
        gate[row * 128 + h * 16 + lane] = ex / sm;
      }
    }
  }
}

__device__ void peer_eval(const Params& p, int layer, int nrows) {
  const int lane = TIDX & 63, wid = TIDX >> 6;
  const bf16_t* hb = (const bf16_t*)(p.ws + OFF_HB);
  const int* eid = (const int*)(p.ws + OFF_EID); const float* gate = (const float*)(p.ws + OFF_GATE);
  const float* ut = p.in[I_PU] + (size_t)layer * 16384 * DM; const float* vt = p.in[I_PV] + (size_t)layer * 16384 * DM;
  float* xs = (float*)(p.ws + OFF_XS);
  for (int r = BIDX * 8 + wid; r < nrows; r += gridDim.x * 8) {
    int b, t, isc; row_info(r, b, t, isc);
    const float* g2 = (const float*)(p.ws + OFF_MOD) + ((size_t)layer * 3 + (isc ? 2 : b)) * 6144 + 5120;
    float x[16], out[16];
    {
      const bf16x8 x0 = *(const bf16x8*)(hb + (size_t)r * DM + lane * 16), x1 = *(const bf16x8*)(hb + (size_t)r * DM + lane * 16 + 8);
#pragma unroll
      for (int i = 0; i < 8; ++i) { x[i] = bf2f((bf16_t)x0[i]); x[8 + i] = bf2f((bf16_t)x1[i]); }
    }
#pragma unroll
    for (int i = 0; i < 16; ++i) out[i] = 0.f;
    for (int it = 0; it < 128; it += 2) {
      const int e0 = eid[(size_t)r * 128 + it], e1 = eid[(size_t)r * 128 + it + 1];
      const float g0 = gate[(size_t)r * 128 + it], g1 = gate[(size_t)r * 128 + it + 1];
      const float* u0 = ut + (size_t)e0 * DM + lane * 16; const float* u1 = ut + (size_t)e1 * DM + lane * 16;
      float d0 = 0.f, d1 = 0.f;
#pragma unroll
      for (int i = 0; i < 4; ++i) {
        const f32x4 a = *(const f32x4*)(u0 + i * 4), c = *(const f32x4*)(u1 + i * 4);
#pragma unroll
        for (int j = 0; j < 4; ++j) { d0 += a[j] * x[i * 4 + j]; d1 += c[j] * x[i * 4 + j]; }
      }
      d0 = wave_sum(d0); d1 = wave_sum(d1);
      const float w0 = g0 * gelu_tanh(d0), w1 = g1 * gelu_tanh(d1);
      const float* v0 = vt + (size_t)e0 * DM + lane * 16; const float* v1 = vt + (size_t)e1 * DM + lane * 16;
#pragma unroll
      for (int i = 0; i < 4; ++i) {
        const f32x4 a = *(const f32x4*)(v0 + i * 4), c = *(const f32x4*)(v1 + i * 4);
#pragma unroll
        for (int j = 0; j < 4; ++j) out[i * 4 + j] += w0 * a[j] + w1 * c[j];
      }
    }
    float* xr = xs + (size_t)r * DM + lane * 16;
#pragma unroll
    for (int i = 0; i < 4; ++i) {
      f32x4 xv = *(const f32x4*)(xr + i * 4);
#pragma unroll
      for (int j = 0; j < 4; ++j) xv[j] += g2[lane * 16 + i * 4 + j] * out[i * 4 + j];
      *(f32x4*)(xr + i * 4) = xv;
    }
  }
}

__device__ void final_norm(const Params& p) {
  const int lane = TIDX & 63, wid = TIDX >> 6;
  const float* xs = (const float*)(p.ws + OFF_XS); const float* g = p.in[I_FG];
  for (int r = BIDX * 8 + wid; r < NLAT; r += gridDim.x * 8) {
    f32x4 v[4]; float ss = 0.f;
#pragma unroll
    for (int i = 0; i < 4; ++i) { v[i] = *(const f32x4*)(xs + (size_t)r * DM + (i * 64 + lane) * 4); ss += v[i][0] * v[i][0] + v[i][1] * v[i][1] + v[i][2] * v[i][2] + v[i][3] * v[i][3]; }
    ss = wave_sum(ss);
    const float rinv = rsqrtf(ss * (1.f / DM) + EPSV);
#pragma unroll
    for (int i = 0; i < 4; ++i) {
      const int c0 = (i * 64 + lane) * 4; f32x4 o;
#pragma unroll
      for (int j = 0; j < 4; ++j) o[j] = v[i][j] * rinv * g[c0 + j];
      *(f32x4*)(p.out + (size_t)r * DM + c0) = o;
    }
  }
}

constexpr int NSTAGES = 23;
constexpr int SMEM_BYTES = 98304 + 4096;
template <int S>
__device__ __forceinline__ void run_stage_t(const Params& p0, int layer0, char* smem0) {
  Params p = p0; int layer = layer0; char* smem = smem0;
  { unsigned long long w = (unsigned long long)p0.ws, o = (unsigned long long)p0.out;
    asm volatile("" : "+s"(w), "+s"(o), "+s"(layer));
    p.ws = (char*)(__attribute__((address_space(1))) char*)w; p.out = (float*)(__attribute__((address_space(1))) float*)o; }
  const int nrows = (layer == 0) ? NTOK : NLAT;
  if constexpr (S == 100) stage_prep(p, smem);
  if constexpr (S == 101) stage_prep2(p, smem);
  if constexpr (S == 102) final_norm(p);
  if constexpr (S == 0) stage_norm(p, layer, 0, NTOK);
  if constexpr (S == 1) {
    float* u = (float*)(p.ws + OFF_U);
    gemm_bt((const bf16_t*)(p.ws + OFF_HB), DM, (const bf16_t*)(p.ws + OFF_WIN) + (size_t)layer * DINP * 1024, 1024, NTOK, DINP, 1024,
            [=](int row, int col, float v) { if (col < DIN) u[(size_t)row * DIN + col] = v; }, smem);
  }
  if constexpr (S == 2) { lru_units(p, layer, 0, smem); mla_prep(p, layer); hyena_prep(p, layer, smem); }
  if constexpr (S == 3) {
    bf16_t* Q = (bf16_t*)(p.ws + OFF_Q); bf16_t* QC = (bf16_t*)(p.ws + OFF_QC); bf16_t* K = (bf16_t*)(p.ws + OFF_K); bf16_t* V = (bf16_t*)(p.ws + OFF_V);
    gemm_bt((const bf16_t*)(p.ws + OFF_QN), 384, (const bf16_t*)(p.ws + OFF_WQB) + (size_t)layer * 640 * 384, 384, NTOK, 640, 384,
            [=](int row, int col, float v) {
              const float vp = shx(v, 8);
              if (col < 576) {
                int b, t, isc; row_info(row, b, t, isc);
                const int h = col / 96, j = col % 96;
                if (j >= 64 && !isc) v = rope_apply(v, vp, j - 64, t);
                if (isc) QC[((size_t)(b * 6 + h) * CTXL + t) * 96 + j] = f2bf(v);
                else     Q[((size_t)(b * 6 + h) * SEQ + t) * 96 + j] = f2bf(v);
              }
            }, smem);
    gemm_bt((const bf16_t*)(p.ws + OFF_KVN), 256, (const bf16_t*)(p.ws + OFF_WKVB) + (size_t)layer * 768 * 256, 256, NTOK, 768, 256,
            [=](int row, int col, float v) {
              int b, t, isc; row_info(row, b, t, isc);
              const int h = col >> 7, j = col & 127, tk = isc ? t : CTXL + t;
              if (j < 64) K[((size_t)(b * 6 + h) * NKEYS + tk) * 96 + j] = f2bf(v);
              else        V[((size_t)(b * 6 + h) * NKEYS + tk) * 64 + (j - 64)] = f2bf(v);
            }, smem);
    lru_carry(p);
  }
  if constexpr (S == 4) { attn_units(p, layer, smem); hyena_direct(p, layer, smem); lru_units(p, layer, 1, smem); }
  if constexpr (S == 5) {
    float* xs = (float*)(p.ws + OFF_XS); const float* mod = (const float*)(p.ws + OFF_MOD) + (size_t)layer * 3 * 6144;
    const float* xin = p.in[I_X]; const float* cin = p.in[I_CTX];
    gemm_bt((const bf16_t*)(p.ws + OFF_MIX), DM, (const bf16_t*)(p.ws + OFF_WOUT) + (size_t)layer * 1024 * 1024, 1024, nrows, 1024, 1024,
            [=](int row, int col, float v) {
              int b, t, isc; row_info(row, b, t, isc);
              const float g1 = mod[(size_t)(isc ? 2 : b) * 6144 + 2048 + col];
              const float* src = (layer == 0) ? ((row < NLAT) ? xin + (size_t)row * DM : cin + (size_t)(row - NLAT) * DM) : xs + (size_t)row * DM;
              xs[(size_t)row * DM + col] = src[col] + g1 * v;
            }, smem);
  }
  if constexpr (S == 6) stage_norm(p, layer, 1, nrows);
  if constexpr (S == 7) {
    bf16_t* pq = (bf16_t*)(p.ws + OFF_PQ);
    gemm_bt((const bf16_t*)(p.ws + OFF_HB), DM, (const bf16_t*)(p.ws + OFF_WPQ) + (size_t)layer * 2048 * 1024, 1024, nrows, 2048, 1024,
            [=](int row, int col, float v) { pq[(size_t)row * 2048 + col] = f2bf(v); }, smem);
  }
  if constexpr (S == 8) peer_topk(p, layer, nrows, smem);
  if constexpr (S == 9) peer_eval(p, layer, nrows);
}

__device__ __forceinline__ void init_params(Params& p, const KArgs& ka, char* smem) {
  unsigned long long* tab = (unsigned long long*)(smem + SMEM_BYTES);
  if (threadIdx.x == 0) {
#pragma unroll
    for (int i = 0; i < N_IN; ++i) tab[i] = (unsigned long long)ka.in[i];
  }
  __syncthreads();
  p.in.tab = smem + SMEM_BYTES; p.out = ka.out; p.ws = ka.ws;
}

#if MK_SINGLE
#define SYNC() grid.sync()
__global__ void __launch_bounds__(NTHREADS) mega_kernel(KArgs ka) {
  __shared__ __attribute__((aligned(16))) char smem[SMEM_BYTES + 512];
  cg::grid_group grid = cg::this_grid();
  Params p; init_params(p, ka, smem);
  run_stage_t<100>(p, 0, smem); SYNC();
  run_stage_t<101>(p, 0, smem); SYNC();
#define LAYER_PASS(layer) \
    run_stage_t<0>(p, layer, smem); SYNC(); \
    run_stage_t<1>(p, layer, smem); SYNC(); \
    run_stage_t<2>(p, layer, smem); SYNC(); \
    run_stage_t<3>(p, layer, smem); SYNC(); \
    run_stage_t<4>(p, layer, smem); SYNC(); \
    run_stage_t<5>(p, layer, smem); SYNC(); \
    run_stage_t<6>(p, layer, smem); SYNC(); \
    run_stage_t<7>(p, layer, smem); SYNC(); \
    run_stage_t<8>(p, layer, smem); SYNC(); \
    run_stage_t<9>(p, layer, smem); SYNC();
  LAYER_PASS(0)
  LAYER_PASS(1)
  run_stage_t<102>(p, 0, smem);
}
#else
template <int S>
__global__ void __launch_bounds__(NTHREADS) stage_kernel(KArgs ka, int layer) {
  __shared__ __attribute__((aligned(16))) char smem[SMEM_BYTES + 512];
  Params p; init_params(p, ka, smem);
  run_stage_t<S>(p, layer, smem);
}
#endif

extern "C" void kernel_launch(void* const* d_in, const int* in_sizes, int n_in, void* d_out, int out_size, void* d_ws, size_t ws_size, hipStream_t stream) {
  if (n_in != N_IN || ws_size < WS_END) { fprintf(stderr, "kernel_launch: bad args n_in=%d ws=%zu need=%zu\n", n_in, ws_size, (size_t)WS_END); return; }
  KArgs p{};
  for (int i = 0; i < N_IN; ++i) p.in[i] = (const float*)d_in[i];
  p.out = (float*)d_out; p.ws = (char*)d_ws;
#if MK_SINGLE
  static int grid_blocks = 0;
  if (!grid_blocks) {
    int dev = 0, cus = 0, per_cu = 0;
    hipGetDevice(&dev);
    hipDeviceGetAttribute(&cus, hipDeviceAttributeMultiprocessorCount, dev);
    hipOccupancyMaxActiveBlocksPerMultiprocessor(&per_cu, mega_kernel, NTHREADS, 0);
    if (per_cu > 1) per_cu = 1;
    grid_blocks = cus * per_cu;
  }
  void* args[] = {&p};
  hipError_t e = hipLaunchCooperativeKernel((void*)mega_kernel, dim3(grid_blocks), dim3(NTHREADS), args, 0, stream);
  if (e != hipSuccess) fprintf(stderr, "cooperative launch failed: %s (grid %d)\n", hipGetErrorString(e), grid_blocks);
#else
#define LAUNCH(S, L) hipLaunchKernelGGL(stage_kernel<S>, dim3(256), dim3(NTHREADS), 0, stream, p, L)
  LAUNCH(100, 0); LAUNCH(101, 0);
  for (int layer = 0; layer < 2; ++layer) {
    LAUNCH(0, layer); LAUNCH(1, layer); LAUNCH(2, layer); LAUNCH(3, layer); LAUNCH(4, layer);
    LAUNCH(5, layer); LAUNCH(6, layer); LAUNCH(7, layer); LAUNCH(8, layer); LAUNCH(9, layer);
  }
  LAUNCH(102, 0);
#endif
}
```

```cpp
#include <hip/hip_runtime.h>
#include <hip/hip_cooperative_groups.h>
#include <cstdio>
#include <cstdint>
namespace cg = cooperative_groups;

__device__ __forceinline__ int launder_v(int x) { asm volatile("" : "+v"(x)); return x; }
__device__ __forceinline__ int launder_s(int x) { asm volatile("" : "+s"(x)); return x; }
#define TIDX launder_v((int)threadIdx.x)
#define BIDX launder_s((int)blockIdx.x)

__device__ __forceinline__ float shx(float v, int mask) { const int l = TIDX & 63; return __int_as_float(__builtin_amdgcn_ds_bpermute((l ^ mask) << 2, __float_as_int(v))); }
__device__ __forceinline__ int shxi(int v, int mask) { const int l = TIDX & 63; return __builtin_amdgcn_ds_bpermute((l ^ mask) << 2, v); }
__device__ __forceinline__ float rdl(float v, int srclane) { return __int_as_float(__builtin_amdgcn_readlane(__float_as_int(v), srclane)); }

#ifndef MK_SINGLE
#define MK_SINGLE 1
#endif

typedef unsigned short bf16_t;
using bf16x8 = __attribute__((ext_vector_type(8))) short;
using s16x4  = __attribute__((ext_vector_type(4))) short;
using f32x16 = __attribute__((ext_vector_type(16))) float;
using f32x4  = __attribute__((ext_vector_type(4))) float;
using u32x4  = __attribute__((ext_vector_type(4))) unsigned;
using u32x2  = __attribute__((ext_vector_type(2))) unsigned;

constexpr int NB = 2, SEQ = 8192, CTXL = 256, DM = 1024;
constexpr int NLAT = NB * SEQ, NCTX = NB * CTXL, NTOK = NLAT + NCTX;
constexpr int DIN = 2208, DINP = 2304;
constexpr int DLRU = 384, NKEYS = SEQ + CTXL;
constexpr int NTHREADS = 512;
constexpr int NCHUNK = NLAT / 64 + NCTX / 64;
constexpr float EPSV = 1e-6f;

enum { I_X = 0, I_C, I_CTX, I_CCTX, I_WMOD, I_BMOD, I_N1G, I_N2G, I_WIN, I_WOUT, I_LCW, I_LCB, I_LWR, I_LBR, I_LWI, I_LBI, I_LLAM,
       I_QNG, I_WQB, I_KVNG, I_WKVB, I_HCW, I_HCB, I_HW1, I_HB1, I_HW2, I_HB2, I_HW3, I_HFREQ, I_HDECAY, I_HSKIP,
       I_PWQ, I_PKEYS, I_PU, I_PV, I_FG, N_IN };

struct KArgs { const float* in[N_IN]; float* out; char* ws; };
struct InTab {
  const char* tab;
  __device__ __forceinline__ const float* operator[](int i) const {
    const unsigned long long v = ((const unsigned long long*)tab)[i];
    const unsigned lo = __builtin_amdgcn_readfirstlane((unsigned)v), hi = __builtin_amdgcn_readfirstlane((unsigned)(v >> 32));
    return (const float*)(const __attribute__((address_space(1))) float*)(((unsigned long long)hi << 32) | lo);
  }
};
struct Params { InTab in; float* out; char* ws; };

constexpr size_t al256(size_t x) { return (x + 255) / 256 * 256; }
constexpr size_t OFF_XS    = 0;
constexpr size_t OFF_HB    = OFF_XS    + al256((size_t)NTOK * DM * 4);
constexpr size_t OFF_U     = OFF_HB    + al256((size_t)NTOK * DM * 2);
constexpr size_t OFF_PQ    = OFF_U;
constexpr size_t OFF_MIX   = OFF_U     + al256((size_t)NTOK * DIN * 4);
constexpr size_t OFF_HYIN  = OFF_MIX   + al256((size_t)NTOK * DM * 2);
constexpr size_t OFF_EID   = OFF_HYIN;
constexpr size_t OFF_GATE  = OFF_EID   + al256((size_t)NTOK * 128 * 4);
constexpr size_t OFF_HYINC = OFF_HYIN  + al256((size_t)3 * 2 * 256 * 8192 * 4);
constexpr size_t OFF_QN    = OFF_HYINC + al256((size_t)3 * 2 * 256 * 256 * 4);
constexpr size_t OFF_UTAB  = OFF_QN;
constexpr size_t OFF_VTAB  = OFF_UTAB  + (size_t)16384 * 1024 * 2;
constexpr size_t OFF_KVN   = OFF_QN    + al256((size_t)NTOK * 384 * 2);
constexpr size_t OFF_Q     = OFF_KVN   + al256((size_t)NTOK * 256 * 2);
constexpr size_t OFF_QC    = OFF_Q     + al256((size_t)2 * 6 * 8192 * 96 * 2);
constexpr size_t OFF_K     = OFF_QC    + al256((size_t)2 * 6 * 256 * 96 * 2);
constexpr size_t OFF_V     = OFF_K     + al256((size_t)2 * 6 * NKEYS * 96 * 2);
constexpr size_t OFF_LSUM  = OFF_V     + al256((size_t)2 * 6 * NKEYS * 64 * 2);
static_assert(OFF_VTAB + (size_t)16384 * 1024 * 2 <= OFF_LSUM, "PEER bf16 tables must fit in the dead QN..V region");
constexpr size_t OFF_CARRY = OFF_LSUM  + al256((size_t)NCHUNK * 2 * 2 * 384 * 4);
constexpr size_t OFF_MOD   = OFF_CARRY + al256((size_t)NCHUNK * 2 * 384 * 4);
constexpr size_t OFF_MODP  = OFF_MOD   + al256((size_t)2 * 3 * 6144 * 4);
constexpr size_t OFF_WIN   = OFF_MODP  + al256((size_t)2 * 8 * 3 * 6144 * 4);
constexpr size_t OFF_WOUT  = OFF_WIN   + al256((size_t)2 * DINP * 1024 * 2);
constexpr size_t OFF_WQB   = OFF_WOUT  + al256((size_t)2 * 1024 * 1024 * 2);
constexpr size_t OFF_WKVB  = OFF_WQB   + al256((size_t)2 * 640 * 384 * 2);
constexpr size_t OFF_WPQ   = OFF_WKVB  + al256((size_t)2 * 768 * 256 * 2);
constexpr size_t OFF_KEYS  = OFF_WPQ   + al256((size_t)2 * 2048 * 1024 * 2);
constexpr size_t OFF_GW    = OFF_KEYS  + al256((size_t)2 * 2 * 128 * 128 * 2);
constexpr size_t OFF_H2    = OFF_GW    + al256((size_t)2 * 2 * 2 * 6 * 64 * 64 * 2);
constexpr size_t OFF_HSPEC = OFF_H2    + al256((size_t)2 * NKEYS * 64 * 4);
constexpr size_t OFF_FILTC = OFF_HSPEC + al256((size_t)2 * 256 * 2 * 16384 * 4);
constexpr size_t OFF_SSQPC = OFF_FILTC + al256((size_t)2 * 1024 * 256 * 4);
constexpr size_t WS_END    = OFF_SSQPC + al256((size_t)2 * 4 * 1024 * 4);

__device__ __forceinline__ float bf2f(bf16_t v) { return __uint_as_float(((unsigned)v) << 16); }
__device__ __forceinline__ bf16_t f2bf(float f) { unsigned u = __float_as_uint(f); u += 0x7fffu + ((u >> 16) & 1u); return (bf16_t)(u >> 16); }
__device__ __forceinline__ unsigned cvtpk(float lo, float hi) { unsigned r; asm volatile("v_cvt_pk_bf16_f32 %0, %1, %2" : "=v"(r) : "v"(lo), "v"(hi)); return r; }
__device__ __forceinline__ float gelu_tanh(float x) { return 0.5f * x * (1.f + tanhf(0.7978845608028654f * (x + 0.044715f * x * x * x))); }
__device__ __forceinline__ float sigm(float x) { return 1.f / (1.f + __expf(-x)); }
template <int CTRL> __device__ __forceinline__ float dpp_mov(float x) { return __builtin_bit_cast(float, __builtin_amdgcn_mov_dpp(__builtin_bit_cast(int, x), CTRL, 0xf, 0xf, true)); }
__device__ __forceinline__ float wave_sum(float v) {
  v += dpp_mov<0xB1>(v); v += dpp_mov<0x4E>(v); v += dpp_mov<0x141>(v); v += dpp_mov<0x128>(v);
  { auto r = __builtin_amdgcn_permlane16_swap(__float_as_uint(v), __float_as_uint(v), false, false); v = __uint_as_float(r[0]) + __uint_as_float(r[1]); }
  { auto r = __builtin_amdgcn_permlane32_swap(__float_as_uint(v), __float_as_uint(v), false, false); v = __uint_as_float(r[0]) + __uint_as_float(r[1]); }
  return v;
}
using bf16x2v = __attribute__((ext_vector_type(2))) __bf16;
__device__ __forceinline__ float dot2bf(unsigned a, unsigned b, float acc) { return __builtin_amdgcn_fdot2_f32_bf16(__builtin_bit_cast(bf16x2v, a), __builtin_bit_cast(bf16x2v, b), acc, false); }
__device__ __forceinline__ int crow(int r, int hi) { return (r & 3) + 8 * (r >> 2) + 4 * hi; }
__device__ __forceinline__ void row_info(int r, int& b, int& t, int& isctx) {
  if (r < NLAT) { isctx = 0; b = r >> 13; t = r & (SEQ - 1); } else { isctx = 1; int q = r - NLAT; b = q >> 8; t = q & (CTXL - 1); }
}
__device__ __forceinline__ const float* xrow_src(const Params& p, int layer, int r) {
  if (layer == 0) return (r < NLAT) ? p.in[I_X] + (size_t)r * DM : p.in[I_CTX] + (size_t)(r - NLAT) * DM;
  return (const float*)(p.ws + OFF_XS) + (size_t)r * DM;
}
#define JOB_LOOP(t, ntiles, base) for (int t = (int)(((long)BIDX - ((base) % (long)gridDim.x) + gridDim.x) % gridDim.x); t < (ntiles); t += gridDim.x)

__device__ void transpose_cvt_job(const float* __restrict__ src, bf16_t* __restrict__ dst, int K, int N, int Npad, char* smem, long& base) {
  float* tile = (float*)smem;
  const int tk = K / 64, tn = Npad / 64, nt = tk * tn;
  JOB_LOOP(t, nt, base) {
    const int k0 = (t % tk) * 64, n0 = (t / tk) * 64;
    __syncthreads();
    for (int e = TIDX; e < 4096; e += NTHREADS) { int i = e >> 6, j = e & 63; int n = n0 + j; tile[j * 65 + i] = (n < N) ? src[(size_t)(k0 + i) * N + n] : 0.f; }
    __syncthreads();
    for (int e = TIDX; e < 4096; e += NTHREADS) { int j = e >> 6, i = e & 63; dst[(size_t)(n0 + j) * K + k0 + i] = f2bf(tile[j * 65 + i]); }
  }
  base += nt;
}

__device__ void stage_prep(const Params& p, char* smem) {
  long base = 0;
  for (int l = 0; l < 2; ++l) {
    transpose_cvt_job(p.in[I_WIN] + (size_t)l * 1024 * DIN, (bf16_t*)(p.ws + OFF_WIN) + (size_t)l * DINP * 1024, 1024, DIN, DINP, smem, base);
    transpose_cvt_job(p.in[I_WOUT] + (size_t)l * 1024 * 1024, (bf16_t*)(p.ws + OFF_WOUT) + (size_t)l * 1024 * 1024, 1024, 1024, 1024, smem, base);
    transpose_cvt_job(p.in[I_WQB] + (size_t)l * 384 * 576, (bf16_t*)(p.ws + OFF_WQB) + (size_t)l * 640 * 384, 384, 576, 640, smem, base);
    transpose_cvt_job(p.in[I_WKVB] + (size_t)l * 256 * 768, (bf16_t*)(p.ws + OFF_WKVB) + (size_t)l * 768 * 256, 256, 768, 768, smem, base);
    transpose_cvt_job(p.in[I_PWQ] + (size_t)l * 1024 * 2048, (bf16_t*)(p.ws + OFF_WPQ) + (size_t)l * 2048 * 1024, 1024, 2048, 2048, smem, base);
    for (int d = 0; d < 2; ++d) for (int n = 0; n < 6; ++n) {
      const size_t so = ((size_t)(l * 2 + d) * 6 + n) * 4096;
      transpose_cvt_job(p.in[I_LWR] + so, (bf16_t*)(p.ws + OFF_GW) + ((size_t)((l * 2 + d) * 2 + 0) * 6 + n) * 4096, 64, 64, 64, smem, base);
      transpose_cvt_job(p.in[I_LWI] + so, (bf16_t*)(p.ws + OFF_GW) + ((size_t)((l * 2 + d) * 2 + 1) * 6 + n) * 4096, 64, 64, 64, smem, base);
    }
  }
  {
    const float* src = p.in[I_PKEYS]; bf16_t* dst = (bf16_t*)(p.ws + OFF_KEYS);
    for (int e = BIDX * NTHREADS + TIDX; e < 2 * 2 * 128 * 128; e += gridDim.x * NTHREADS) dst[e] = f2bf(src[e]);
  }
  {
    float* modp = (float*)(p.ws + OFF_MODP);
    JOB_LOOP(it, 192, base) {
      const int l = it / 96, ks = (it % 96) / 12, cgp = it % 12;
      const int col = cgp * 512 + TIDX;
      const float* w = p.in[I_WMOD] + (size_t)l * 1024 * 6144 + col;
      float a0 = 0.f, a1 = 0.f, a2 = 0.f;
      for (int k = ks * 128; k < ks * 128 + 128; ++k) {
        const float wv = w[(size_t)k * 6144];
        const float c0 = p.in[I_C][k], c1 = p.in[I_C][1024 + k], c2 = p.in[I_CCTX][k];
        a0 += c0 * sigm(c0) * wv; a1 += c1 * sigm(c1) * wv; a2 += c2 * sigm(c2) * wv;
      }
      float* o = modp + ((size_t)(l * 8 + ks) * 3) * 6144 + col;
      o[0] = a0; o[6144] = a1; o[2 * 6144] = a2;
    }
    base += 192;
  }
  {
    const int lane = TIDX & 63, wid = TIDX >> 6;
    for (int it = BIDX * 8 + wid; it < 2 * NKEYS; it += gridDim.x * 8) {
      const int l = it / NKEYS, pos = it % NKEYS;
      const float tn = (pos < SEQ) ? (float)pos / (float)SEQ : (float)(pos - SEQ) / (float)CTXL;
      const float* w1 = p.in[I_HW1] + (size_t)l * 17 * 64; const float* b1 = p.in[I_HB1] + l * 64;
      const float* w2 = p.in[I_HW2] + (size_t)l * 64 * 64; const float* b2 = p.in[I_HB2] + l * 64;
      const float fr = p.in[I_HFREQ][l * 64 + lane];
      float pre = b1[lane] + tn * w1[lane];
#pragma unroll
      for (int i = 0; i < 8; ++i) {
        const float band = 1e-4f + (float)i * ((7.f - 1e-4f) / 7.f);
        const float wp = (6.283185307179586f * tn) * band;
        pre += cosf(wp) * w1[(1 + i) * 64 + lane] + sinf(wp) * w1[(9 + i) * 64 + lane];
      }
      const float h1 = sinf(fr * pre);
      float pre2 = b2[lane];
      for (int i = 0; i < 64; ++i) pre2 += rdl(h1, i) * w2[i * 64 + lane];
      ((float*)(p.ws + OFF_H2))[((size_t)l * NKEYS + pos) * 64 + lane] = sinf(fr * pre2);
    }
  }
}


struct cf { float x, y; };
__device__ __forceinline__ cf cmul(cf a, cf b) { return {a.x * b.x - a.y * b.y, a.x * b.y + a.y * b.x}; }
template <bool INV> __device__ __forceinline__ cf twid(float frac) {
  const float c = __builtin_amdgcn_cosf(frac), s = __builtin_amdgcn_sinf(frac); return {c, INV ? s : -s};
}
template <bool INV> __device__ __forceinline__ void r4(cf& a, cf& b, cf& c, cf& d) {
  const cf s0 = {a.x + c.x, a.y + c.y}, s1 = {a.x - c.x, a.y - c.y}, s2 = {b.x + d.x, b.y + d.y}, s3 = {b.x - d.x, b.y - d.y};
  a = {s0.x + s2.x, s0.y + s2.y}; c = {s0.x - s2.x, s0.y - s2.y};
  if (!INV) { b = {s1.x + s3.y, s1.y - s3.x}; d = {s1.x - s3.y, s1.y + s3.x}; }
  else      { b = {s1.x - s3.y, s1.y + s3.x}; d = {s1.x + s3.y, s1.y - s3.x}; }
}
template <bool INV> __device__ __forceinline__ cf cj(cf w) { return {w.x, INV ? -w.y : w.y}; }
template <bool INV> __device__ __forceinline__ void dft16(cf* x) {
#pragma unroll
  for (int m0 = 0; m0 < 4; ++m0) r4<INV>(x[m0], x[4 + m0], x[8 + m0], x[12 + m0]);
  const cf W1 = {0.92387953251128674f, -0.38268343236508977f}, W2 = {0.70710678118654752f, -0.70710678118654752f}, W3 = {0.38268343236508977f, -0.92387953251128674f};
  const cf W4 = {0.f, -1.f}, W6 = {-0.70710678118654752f, -0.70710678118654752f}, W9 = {-0.92387953251128674f, 0.38268343236508977f};
  x[5] = cmul(x[5], cj<INV>(W1)); x[6] = cmul(x[6], cj<INV>(W2)); x[7] = cmul(x[7], cj<INV>(W3));
  x[9] = cmul(x[9], cj<INV>(W2)); x[10] = cmul(x[10], cj<INV>(W4)); x[11] = cmul(x[11], cj<INV>(W6));
  x[13] = cmul(x[13], cj<INV>(W3)); x[14] = cmul(x[14], cj<INV>(W6)); x[15] = cmul(x[15], cj<INV>(W9));
#pragma unroll
  for (int q0 = 0; q0 < 4; ++q0) r4<INV>(x[4 * q0], x[4 * q0 + 1], x[4 * q0 + 2], x[4 * q0 + 3]);
}
template <bool INV> __device__ __forceinline__ void dft8(cf* x) {
#pragma unroll
  for (int m0 = 0; m0 < 4; ++m0) { const cf a = x[m0], b = x[4 + m0]; x[m0] = {a.x + b.x, a.y + b.y}; x[4 + m0] = {a.x - b.x, a.y - b.y}; }
  const cf V1 = {0.70710678118654752f, -0.70710678118654752f}, V2 = {0.f, -1.f}, V3 = {-0.70710678118654752f, -0.70710678118654752f};
  x[5] = cmul(x[5], cj<INV>(V1)); x[6] = cmul(x[6], cj<INV>(V2)); x[7] = cmul(x[7], cj<INV>(V3));
  r4<INV>(x[0], x[1], x[2], x[3]); r4<INV>(x[4], x[5], x[6], x[7]);
}
template <bool COL> __device__ __forceinline__ int fidx(int ln, int i) { return COL ? i * 129 + ln : ln * 129 + i; }
template <bool INV, bool COL> __device__ __forceinline__ void fft_passA(cf* buf) {
  for (int it = 0; it < 2; ++it) {
    const int bf = TIDX + NTHREADS * it, ln = bf & 127, j = bf >> 7;
    cf x[16];
    if (!INV) {
#pragma unroll
      for (int m = 0; m < 16; ++m) x[m] = buf[fidx<COL>(ln, j + 8 * m)];
      dft16<false>(x);
#pragma unroll
      for (int q = 0; q < 16; ++q) buf[fidx<COL>(ln, j + 8 * q)] = cmul(x[4 * (q & 3) + (q >> 2)], twid<false>((float)(q * j) * (1.f / 128.f)));
    } else {
#pragma unroll
      for (int q = 0; q < 16; ++q) x[q] = cmul(buf[fidx<COL>(ln, j + 8 * q)], twid<true>((float)(q * j) * (1.f / 128.f)));
      dft16<true>(x);
#pragma unroll
      for (int m = 0; m < 16; ++m) buf[fidx<COL>(ln, j + 8 * m)] = x[4 * (m & 3) + (m >> 2)];
    }
  }
}
template <bool INV, bool COL> __device__ __forceinline__ void fft_passB(cf* buf) {
  for (int it = 0; it < 4; ++it) {
    const int bf = TIDX + NTHREADS * it, ln = bf & 127, B = bf >> 7;
    cf x[8];
    if (!INV) {
#pragma unroll
      for (int m = 0; m < 8; ++m) x[m] = buf[fidx<COL>(ln, 8 * B + m)];
      dft8<false>(x);
#pragma unroll
      for (int q = 0; q < 8; ++q) {
        cf v = x[4 * (q & 1) + (q >> 1)];
        if (COL) v = cmul(v, twid<false>((float)(ln * (B + 16 * q)) * (1.f / 16384.f)));
        buf[fidx<COL>(ln, 8 * B + q)] = v;
      }
    } else {
#pragma unroll
      for (int q = 0; q < 8; ++q) {
        cf v = buf[fidx<COL>(ln, 8 * B + q)];
        if (COL) v = cmul(v, twid<true>((float)(ln * (B + 16 * q)) * (1.f / 16384.f)));
        x[q] = v;
      }
      dft8<true>(x);
#pragma unroll
      for (int m = 0; m < 8; ++m) buf[fidx<COL>(ln, 8 * B + m)] = x[4 * (m & 1) + (m >> 1)];
    }
  }
}
__device__ __forceinline__ void fft_fwd(cf* buf) {
  fft_passA<false, true>(buf); __syncthreads(); fft_passB<false, true>(buf); __syncthreads();
  fft_passA<false, false>(buf); __syncthreads(); fft_passB<false, false>(buf); __syncthreads();
}
__device__ __forceinline__ void fft_inv(cf* buf) {
  fft_passB<true, false>(buf); __syncthreads(); fft_passA<true, false>(buf); __syncthreads();
  fft_passB<true, true>(buf); __syncthreads(); fft_passA<true, true>(buf); __syncthreads();
}
__device__ __forceinline__ int fft_freq(int r, int c) { return ((r >> 3) + 16 * (r & 7)) + 128 * ((c >> 3) + 16 * (c & 7)); }
__device__ __forceinline__ int fft_pos(int k) {
  const int k1 = k & 127, k2 = k >> 7; return (8 * (k1 & 15) + (k1 >> 4)) * 129 + 8 * (k2 & 15) + (k2 >> 4);
}
constexpr int FFT_LDS = 128 * 129 * 8;

__device__ void hyena_spectra(const Params& p, char* smem) {
  cf* buf = (cf*)smem; float* fb = (float*)smem;
  float* w3s = (float*)(smem + FFT_LDS);
  float* red = w3s + 256;
  const int tid = TIDX, lane = tid & 63, wid = tid >> 6;
  for (int unit = BIDX; unit < 512; unit += gridDim.x) {
    const int l = unit >> 8, c = unit & 255;
    __syncthreads();
    if (tid < 256) { const int i = tid >> 2, j = tid & 3; w3s[tid] = p.in[I_HW3][(size_t)l * 64 * 1024 + (size_t)i * 1024 + j * 256 + c]; }
    if (tid == 0) buf[64 * 129] = cf{0.f, 0.f};
    __syncthreads();
    float dec[4], ss[4];
#pragma unroll
    for (int j = 0; j < 4; ++j) { dec[j] = p.in[I_HDECAY][l * 1024 + j * 256 + c]; ss[j] = 0.f; }
    const float* h2 = (const float*)(p.ws + OFF_H2) + (size_t)l * NKEYS * 64;
    for (int i = 0; i < 16; ++i) {
      const int t = tid + NTHREADS * i;
      float a[4] = {0.f, 0.f, 0.f, 0.f};
      const f32x4* hr = (const f32x4*)(h2 + (size_t)t * 64);
#pragma unroll 4
      for (int k4 = 0; k4 < 16; ++k4) {
        const f32x4 hv = hr[k4];
#pragma unroll
        for (int kk = 0; kk < 4; ++kk) {
          const f32x4 wv = *(const f32x4*)(w3s + (k4 * 4 + kk) * 4);
          a[0] += hv[kk] * wv[0]; a[1] += hv[kk] * wv[1]; a[2] += hv[kk] * wv[2]; a[3] += hv[kk] * wv[3];
        }
      }
      const float tn = (float)t * (1.f / (float)SEQ);
#pragma unroll
      for (int j = 0; j < 4; ++j) { a[j] *= __expf(-tn * dec[j]); ss[j] += a[j] * a[j]; }
      const int pf = (t >> 7) * 129 + (t & 127);
      fb[2 * pf] = a[0]; fb[2 * pf + 1] = a[2];
      if (t > 0) { const int n = 16384 - t, pb = (n >> 7) * 129 + (n & 127); fb[2 * pb] = a[1]; fb[2 * pb + 1] = a[3]; }
    }
#pragma unroll
    for (int j = 0; j < 4; ++j) { ss[j] = wave_sum(ss[j]); if (lane == 0) red[wid * 4 + j] = ss[j]; }
    __syncthreads();
    float sc[4];
#pragma unroll
    for (int j = 0; j < 4; ++j) { float s = 0.f; for (int w = 0; w < 8; ++w) s += red[w * 4 + j]; sc[j] = rsqrtf(s + EPSV) * (1.f / 16384.f); }
    const float sk0 = p.in[I_HSKIP][l * 512 + c] * (1.f / 16384.f), sk1 = p.in[I_HSKIP][l * 512 + 256 + c] * (1.f / 16384.f);
    for (int i = 0; i < 32; ++i) {
      const int n = tid + NTHREADS * i, pi = (n >> 7) * 129 + (n & 127);
      cf v = buf[pi];
      if (n < 8192) { v.x *= sc[0]; v.y *= sc[2]; } else { v.x *= sc[1]; v.y *= sc[3]; }
      if (n == 0) { v.x += sk0; v.y += sk1; }
      buf[pi] = v;
    }
    __syncthreads();
    fft_fwd(buf);
    unsigned* hs = (unsigned*)(p.ws + OFF_HSPEC) + ((size_t)(l * 256 + c) * 2) * 16384;
    for (int i = 0; i < 32; ++i) {
      const int e = tid + NTHREADS * i, r = e >> 7, cc = e & 127;
      const int k = fft_freq(r, cc), k2 = (16384 - k) & 16383;
      const cf a = buf[r * 129 + cc], b = buf[fft_pos(k2)];
      hs[e] = cvtpk(0.5f * (a.x + b.x), 0.5f * (a.y - b.y));
      hs[16384 + e] = cvtpk(0.5f * (a.y + b.y), -0.5f * (a.x - b.x));
    }
  }
}

__device__ void hyena_fft(const Params& p, int layer, char* smem) {
  cf* buf = (cf*)smem;
  const int tid = TIDX;
  bf16_t* mix = (bf16_t*)(p.ws + OFF_MIX);
  const float* hin = (const float*)(p.ws + OFF_HYIN);
  for (int unit = (int)gridDim.x - 1 - BIDX; unit < 256; unit += gridDim.x) {
    const int c = unit;
    const unsigned* hs = (const unsigned*)(p.ws + OFF_HSPEC) + ((size_t)(layer * 256 + c) * 2) * 16384;
    __syncthreads();
    {
      const float* z0 = hin + ((size_t)(0 * 2 + 0) * 256 + c) * SEQ; const float* z1 = hin + ((size_t)(0 * 2 + 1) * 256 + c) * SEQ;
      for (int i = 0; i < 16; ++i) { const int t = tid + NTHREADS * i; buf[(t >> 7) * 129 + (t & 127)] = cf{z0[t], z1[t]}; }
      for (int i = 0; i < 16; ++i) { const int t = 8192 + tid + NTHREADS * i; buf[(t >> 7) * 129 + (t & 127)] = cf{0.f, 0.f}; }
    }
    __syncthreads();
    for (int order = 0; order < 2; ++order) {
      fft_fwd(buf);
      for (int i = 0; i < 32; ++i) {
        const int e = tid + NTHREADS * i, pi = (e >> 7) * 129 + (e & 127);
        const unsigned hv = hs[order * 16384 + e];
        const cf h = {__uint_as_float(hv << 16), __uint_as_float(hv & 0xffff0000u)};
        buf[pi] = cmul(buf[pi], h);
      }
      __syncthreads();
      fft_inv(buf);
      const float* x0 = hin + ((size_t)((1 + order) * 2 + 0) * 256 + c) * SEQ; const float* x1 = hin + ((size_t)((1 + order) * 2 + 1) * 256 + c) * SEQ;
      if (order == 0) {
        for (int i = 0; i < 16; ++i) { const int t = tid + NTHREADS * i, pi = (t >> 7) * 129 + (t & 127); const cf v = buf[pi]; buf[pi] = cf{v.x * x0[t], v.y * x1[t]}; }
        for (int i = 0; i < 16; ++i) { const int t = 8192 + tid + NTHREADS * i; buf[(t >> 7) * 129 + (t & 127)] = cf{0.f, 0.f}; }
        __syncthreads();
      } else {
        for (int i = 0; i < 16; ++i) {
          const int t = tid + NTHREADS * i; const cf v = buf[(t >> 7) * 129 + (t & 127)];
          mix[(size_t)t * DM + 768 + c] = f2bf(v.x * x0[t]);
          mix[((size_t)SEQ + t) * DM + 768 + c] = f2bf(v.y * x1[t]);
        }
      }
    }
  }
}

__device__ void stage_prep2(const Params& p, char* smem) {
  {
    float* mod = (float*)(p.ws + OFF_MOD); const float* modp = (const float*)(p.ws + OFF_MODP);
    for (int e = BIDX * NTHREADS + TIDX; e < 2 * 3 * 6144; e += gridDim.x * NTHREADS) {
      const int l = e / (3 * 6144), w = (e / 6144) % 3, col = e % 6144;
      float s = p.in[I_BMOD][l * 6144 + col];
      for (int ks = 0; ks < 8; ++ks) s += modp[((size_t)(l * 8 + ks) * 3 + w) * 6144 + col];
      mod[e] = s;
    }
  }
  float* h2t = (float*)smem;
  float* w3t = h2t + 64 * 65;
  const int tloc = TIDX & 63, cgp = TIDX >> 6, lane = TIDX & 63;
  for (int it = BIDX; it < 2 * 4 * 16; it += gridDim.x) {
    const int l = it / (4 * 16), tt = 128 + (it / 16) % 4, ct = it % 16;
    const bool isc = tt >= 128; const int L = isc ? CTXL : SEQ; const int t0 = isc ? (tt - 128) * 64 : tt * 64;
    const int pos0 = isc ? SEQ + t0 : t0;
    const float* h2 = (const float*)(p.ws + OFF_H2) + ((size_t)l * NKEYS + pos0) * 64;
    const float* w3 = p.in[I_HW3] + (size_t)l * 64 * 1024 + ct * 64;
    __syncthreads();
    for (int e = TIDX; e < 4096; e += NTHREADS) { int i = e >> 6, j = e & 63; h2t[i * 65 + j] = h2[i * 64 + j]; w3t[i * 64 + j] = w3[(size_t)i * 1024 + j]; }
    __syncthreads();
    float acc[8];
#pragma unroll
    for (int cc = 0; cc < 8; ++cc) acc[cc] = 0.f;
#pragma unroll 2
    for (int i = 0; i < 64; ++i) {
      const float hv = h2t[tloc * 65 + i];
#pragma unroll
      for (int cc = 0; cc < 8; ++cc) acc[cc] += hv * w3t[i * 64 + cgp * 8 + cc];
    }
    const float tn = (float)(t0 + tloc) / (float)L;
#pragma unroll
    for (int cc = 0; cc < 8; ++cc) {
      const int col = ct * 64 + cgp * 8 + cc;
      const float val = acc[cc] * __expf(-tn * p.in[I_HDECAY][l * 1024 + col]);
      ((float*)(p.ws + OFF_FILTC))[((size_t)l * 1024 + col) * CTXL + t0 + tloc] = val;
      const float s = wave_sum(val * val);
      if (lane == 0) ((float*)(p.ws + OFF_SSQPC))[((size_t)l * 4 + (tt - 128)) * 1024 + col] = s;
    }
  }
  hyena_spectra(p, smem);
}

__device__ void stage_norm(const Params& p, int layer, int which  , int nrows) {
  const int lane = TIDX & 63, wid = TIDX >> 6;
  const float* g = (which ? p.in[I_N2G] : p.in[I_N1G]) + layer * DM;
  bf16_t* hb = (bf16_t*)(p.ws + OFF_HB);
  for (int r = BIDX * 8 + wid; r < nrows; r += gridDim.x * 8) {
    int b, t, isc; row_info(r, b, t, isc);
    const float* src = (which == 0) ? xrow_src(p, layer, r) : (const float*)(p.ws + OFF_XS) + (size_t)r * DM;
    const float* mod = (const float*)(p.ws + OFF_MOD) + ((size_t)layer * 3 + (isc ? 2 : b)) * 6144 + (which ? 3072 : 0);
    f32x4 v[4]; float ss = 0.f;
#pragma unroll
    for (int i = 0; i < 4; ++i) { v[i] = *(const f32x4*)(src + (i * 64 + lane) * 4); ss += v[i][0] * v[i][0] + v[i][1] * v[i][1] + v[i][2] * v[i][2] + v[i][3] * v[i][3]; }
    ss = wave_sum(ss);
    const float rinv = rsqrtf(ss * (1.f / DM) + EPSV);
#pragma unroll
    for (int i = 0; i < 4; ++i) {
      const int c0 = (i * 64 + lane) * 4;
      float y[4];
#pragma unroll
      for (int j = 0; j < 4; ++j) y[j] = v[i][j] * rinv * g[c0 + j] * (1.f + mod[1024 + c0 + j]) + mod[c0 + j];
      u32x2 o = {cvtpk(y[0], y[1]), cvtpk(y[2], y[3])};
      *(u32x2*)(hb + (size_t)r * DM + c0) = o;
    }
  }
}

template <class Epi>
__device__ void gemm_bt(const bf16_t* __restrict__ A, int lda, const bf16_t* __restrict__ Bt, int ldb, int M, int N, int K, Epi epi, char* smem) {
  const int tid = TIDX, wid = tid >> 6, lane = tid & 63, r32 = lane & 31, hi = lane >> 5;
  const int wm = wid >> 2, wn = wid & 3;
  constexpr int RS = 144;
  char* sA = smem; char* sB = smem + 128 * RS;
  const int tilesM = M / 128, tilesN = N / 128, nk = K / 64;
  const int lr0 = tid >> 3, lc = (tid & 7) * 8;
  for (int tile = BIDX; tile < tilesM * tilesN; tile += gridDim.x) {
    const int tm = tile / tilesN, tn = tile % tilesN;
    const bf16_t* Ap = A + (size_t)(tm * 128 + lr0) * lda + lc;
    const bf16_t* Bp = Bt + (size_t)(tn * 128 + lr0) * ldb + lc;
    f32x16 acc0 = {}, acc1 = {};
    u32x4 ra0 = *(const u32x4*)Ap, ra1 = *(const u32x4*)(Ap + (size_t)64 * lda);
    u32x4 rb0 = *(const u32x4*)Bp, rb1 = *(const u32x4*)(Bp + (size_t)64 * ldb);
    for (int kt = 0; kt < nk; ++kt) {
      __syncthreads();
      *(u32x4*)(sA + lr0 * RS + lc * 2) = ra0; *(u32x4*)(sA + (lr0 + 64) * RS + lc * 2) = ra1;
      *(u32x4*)(sB + lr0 * RS + lc * 2) = rb0; *(u32x4*)(sB + (lr0 + 64) * RS + lc * 2) = rb1;
      __syncthreads();
      if (kt + 1 < nk) {
        const int ko = (kt + 1) * 64;
        ra0 = *(const u32x4*)(Ap + ko); ra1 = *(const u32x4*)(Ap + (size_t)64 * lda + ko);
        rb0 = *(const u32x4*)(Bp + ko); rb1 = *(const u32x4*)(Bp + (size_t)64 * ldb + ko);
      }
#pragma unroll
      for (int ks = 0; ks < 4; ++ks) {
        const int cb = (ks * 16 + hi * 8) * 2;
        const bf16x8 a0 = *(const bf16x8*)(sA + (wm * 64 + r32) * RS + cb);
        const bf16x8 a1 = *(const bf16x8*)(sA + (wm * 64 + 32 + r32) * RS + cb);
        const bf16x8 bb = *(const bf16x8*)(sB + (wn * 32 + r32) * RS + cb);
        acc0 = __builtin_amdgcn_mfma_f32_32x32x16_bf16(a0, bb, acc0, 0, 0, 0);
        acc1 = __builtin_amdgcn_mfma_f32_32x32x16_bf16(a1, bb, acc1, 0, 0, 0);
      }
    }
    const int col = tn * 128 + wn * 32 + r32;
#pragma unroll
    for (int r = 0; r < 16; ++r) {
      epi(tm * 128 + wm * 64 + crow(r, hi), col, acc0[r]);
      epi(tm * 128 + wm * 64 + 32 + crow(r, hi), col, acc1[r]);
    }
  }
}

__device__ __forceinline__ float rope_apply(float x, float xp, int c, int t) {
  const int i = c & 7; const float pos = ((c >> 4) & 1) ? (float)(t & 63) : (float)(t >> 6);
  const float inv = __expf(-(float)i * (9.210340371976184f / 8.f));
  const float ang = pos * inv;
  const float cs = cosf(ang), sn = sinf(ang);
  return x * cs + ((c & 8) ? xp : -xp) * sn;
}

__device__ void lru_units(const Params& p, int layer, int mode, char* smem) {
  const int tid = TIDX, wid = tid >> 6, lane = tid & 63, r32 = lane & 31, hi = lane >> 5;
  float* xcf = (float*)smem;
  char* xcb = smem + 16384;
  float* As = (float*)(smem + 16384 + 9216);
  float* Bs = As + 2 * 64 * 64;
  const float* u = (const float*)(p.ws + OFF_U);
  const float* cw = p.in[I_LCW] + (size_t)layer * 4 * DLRU; const float* cbias = p.in[I_LCB] + layer * DLRU;
  for (int unit = BIDX; unit < NCHUNK * 6; unit += gridDim.x) {
    const int cid = unit / 6, n = unit % 6;
    int rbase, t0, slen;
    if (cid < 256) { const int b = cid >> 7, ch = cid & 127; rbase = b * SEQ; t0 = ch * 64; slen = SEQ; }
    else { const int q = cid - 256, b = q >> 2, ch = q & 3; rbase = NLAT + b * CTXL; t0 = ch * 64; slen = CTXL; }
    __syncthreads();
    {
      const int d = tid & 63, dch = n * 64 + d;
      const float w0 = cw[dch], w1 = cw[DLRU + dch], w2 = cw[2 * DLRU + dch], w3 = cw[3 * DLRU + dch], bb = cbias[dch];
      for (int i = 0; i < 8; ++i) {
        const int tl = (tid >> 6) + 8 * i, t = t0 + tl;
        float acc = bb;
        if (t - 2 >= 0)   acc += w0 * u[(size_t)(rbase + t - 2) * DIN + dch];
        if (t - 1 >= 0)   acc += w1 * u[(size_t)(rbase + t - 1) * DIN + dch];
        acc += w2 * u[(size_t)(rbase + t) * DIN + dch];
        if (t + 1 < slen) acc += w3 * u[(size_t)(rbase + t + 1) * DIN + dch];
        xcf[tl * 64 + d] = acc;
        *(bf16_t*)(xcb + tl * 144 + d * 2) = f2bf(acc);
      }
    }
    __syncthreads();
    {
      const int dir = wid & 1, mh = (wid >> 1) & 1, nt = wid >> 2;
      const bf16_t* gwr = (const bf16_t*)(p.ws + OFF_GW) + ((size_t)((layer * 2 + dir) * 2 + 0) * 6 + n) * 4096;
      const bf16_t* gwi = (const bf16_t*)(p.ws + OFF_GW) + ((size_t)((layer * 2 + dir) * 2 + 1) * 6 + n) * 4096;
      f32x16 accR = {}, accI = {};
#pragma unroll
      for (int ks = 0; ks < 4; ++ks) {
        const bf16x8 a = *(const bf16x8*)(xcb + (mh * 32 + r32) * 144 + (ks * 16 + hi * 8) * 2);
        const bf16x8 br_ = *(const bf16x8*)(gwr + (nt * 32 + r32) * 64 + ks * 16 + hi * 8);
        const bf16x8 bi_ = *(const bf16x8*)(gwi + (nt * 32 + r32) * 64 + ks * 16 + hi * 8);
        accR = __builtin_amdgcn_mfma_f32_32x32x16_bf16(a, br_, accR, 0, 0, 0);
        accI = __builtin_amdgcn_mfma_f32_32x32x16_bf16(a, bi_, accI, 0, 0, 0);
      }
      const int e = nt * 32 + r32, ch = n * 64 + e;
      const size_t po = (size_t)(layer * 2 + dir) * DLRU + ch;
      const float brv = p.in[I_LBR][po], biv = p.in[I_LBI][po];
      const float lam = p.in[I_LLAM][po];
      const float cl = -8.f * log1pf(__expf(-lam));
#pragma unroll
      for (int r = 0; r < 16; ++r) {
        const int tl = mh * 32 + crow(r, hi);
        const float rr = sigm(accR[r] + brv), ii = sigm(accI[r] + biv);
        const float la = rr * cl;
        const float a = __expf(la);
        const float bco = sqrtf(-expm1f(2.f * la)) * (ii * xcf[tl * 64 + e]);
        As[(dir * 64 + tl) * 64 + e] = a; Bs[(dir * 64 + tl) * 64 + e] = bco;
      }
    }
    __syncthreads();
    if (tid < 128) {
      const int dir = tid >> 6, e = tid & 63, ch = n * 64 + e;
      if (mode == 0) {
        float h = 0.f, P = 1.f;
        if (dir == 0) { for (int t = 0; t < 64; ++t) { const float a = As[t * 64 + e]; h = a * h + Bs[t * 64 + e]; P *= a; } }
        else { for (int t = 63; t >= 0; --t) { const float a = As[(64 + t) * 64 + e]; h = a * h + Bs[(64 + t) * 64 + e]; P *= a; } }
        float* ls = (float*)(p.ws + OFF_LSUM) + ((size_t)(cid * 2 + dir) * 2) * DLRU + ch;
        ls[0] = P; ls[DLRU] = h;
      } else {
        float h = ((const float*)(p.ws + OFF_CARRY))[(size_t)(cid * 2 + dir) * DLRU + ch];
        if (dir == 0) { for (int t = 0; t < 64; ++t) { h = As[t * 64 + e] * h + Bs[t * 64 + e]; Bs[t * 64 + e] = h; } }
        else { for (int t = 63; t >= 0; --t) { h = As[(64 + t) * 64 + e] * h + Bs[(64 + t) * 64 + e]; Bs[(64 + t) * 64 + e] = h; } }
      }
    }
    if (mode == 1) {
      __syncthreads();
      bf16_t* mix = (bf16_t*)(p.ws + OFF_MIX);
      const int e = tid & 63;
      for (int i = 0; i < 8; ++i) {
        const int tl = (tid >> 6) + 8 * i; const size_t row = (size_t)rbase + t0 + tl;
        const float y = Bs[tl * 64 + e] + Bs[(64 + tl) * 64 + e];
        const float gt = u[row * DIN + DLRU + n * 64 + e];
        mix[row * DM + n * 64 + e] = f2bf(y * gelu_tanh(gt));
      }
    }
  }
}

__device__ void lru_carry(const Params& p) {
  const int idx = BIDX * NTHREADS + TIDX;
  if (idx >= 2 * 2 * DLRU) return;
  const int b = idx / (2 * DLRU), dir = (idx / DLRU) & 1, ch = idx % DLRU;
  const float* ls = (const float*)(p.ws + OFF_LSUM); float* cr = (float*)(p.ws + OFF_CARRY);
  float st = 0.f;
  for (int k = 0; k < 4 + 128; ++k) {
    int cid;
    if (dir == 0) cid = (k < 4) ? 256 + b * 4 + k : b * 128 + (k - 4);
    else          cid = (k < 4) ? 256 + b * 4 + (3 - k) : b * 128 + (127 - (k - 4));
    cr[(size_t)(cid * 2 + dir) * DLRU + ch] = st;
    const float P = ls[((size_t)(cid * 2 + dir) * 2) * DLRU + ch], H = ls[((size_t)(cid * 2 + dir) * 2 + 1) * DLRU + ch];
    st = P * st + H;
  }
}

__device__ void mla_prep(const Params& p, int layer) {
  const int lane = TIDX & 63, wid = TIDX >> 6;
  const float* u = (const float*)(p.ws + OFF_U);
  const float* qg = p.in[I_QNG] + layer * 384; const float* kvg = p.in[I_KVNG] + layer * 256;
  bf16_t* qn = (bf16_t*)(p.ws + OFF_QN); bf16_t* kvn = (bf16_t*)(p.ws + OFF_KVN); bf16_t* Kb = (bf16_t*)(p.ws + OFF_K);
  for (int r = BIDX * 8 + wid; r < NTOK; r += gridDim.x * 8) {
    int b, t, isc; row_info(r, b, t, isc);
    const float* ur = u + (size_t)r * DIN;
    float q[6], ss = 0.f;
#pragma unroll
    for (int i = 0; i < 6; ++i) { q[i] = ur[768 + i * 64 + lane]; ss += q[i] * q[i]; }
    ss = wave_sum(ss);
    float rinv = rsqrtf(ss * (1.f / 384.f) + EPSV);
#pragma unroll
    for (int i = 0; i < 6; ++i) qn[(size_t)r * 384 + i * 64 + lane] = f2bf(q[i] * rinv * qg[i * 64 + lane]);
    float kv[4]; ss = 0.f;
#pragma unroll
    for (int i = 0; i < 4; ++i) { kv[i] = ur[1152 + i * 64 + lane]; ss += kv[i] * kv[i]; }
    ss = wave_sum(ss);
    rinv = rsqrtf(ss * (1.f / 256.f) + EPSV);
#pragma unroll
    for (int i = 0; i < 4; ++i) kvn[(size_t)r * 256 + i * 64 + lane] = f2bf(kv[i] * rinv * kvg[i * 64 + lane]);
    const float kr = ur[1408 + (lane & 31)];
    const float krp = shx(kr, 8);
    const float ko = isc ? kr : rope_apply(kr, krp, lane & 31, t);
    if (lane < 32) {
      const int tk = isc ? t : CTXL + t; const bf16_t kb = f2bf(ko);
#pragma unroll
      for (int h = 0; h < 6; ++h) Kb[((size_t)(b * 6 + h) * NKEYS + tk) * 96 + 64 + lane] = kb;
    }
  }
}

__device__ void hyena_prep(const Params& p, int layer, char* smem) {
  float* tile = (float*)smem;
  const float* u = (const float*)(p.ws + OFF_U);
  const float* cw = p.in[I_HCW] + (size_t)layer * 3 * 768; const float* cb = p.in[I_HCB] + layer * 768;
  const int ntile = (layer == 0) ? NCHUNK : 256;
  for (int unit = BIDX; unit < ntile * 3; unit += gridDim.x) {
    const int cid = unit / 3, part = unit % 3;
    int rbase, t0, slen, b;
    if (cid < 256) { b = cid >> 7; rbase = b * SEQ; t0 = (cid & 127) * 64; slen = SEQ; }
    else { const int q = cid - 256; b = q >> 2; rbase = NLAT + b * CTXL; t0 = (q & 3) * 64; slen = CTXL; }
    __syncthreads();
    {
      const int c = TIDX & 255, pc = part * 256 + c;
      const float w0 = cw[pc], w1 = cw[768 + pc], w2 = cw[1536 + pc], bb = cb[pc];
      for (int i = 0; i < 32; ++i) {
        const int tl = (TIDX >> 8) + 2 * i, t = t0 + tl;
        float acc = bb + w1 * u[(size_t)(rbase + t) * DIN + 1440 + pc];
        if (t - 1 >= 0)   acc += w0 * u[(size_t)(rbase + t - 1) * DIN + 1440 + pc];
        if (t + 1 < slen) acc += w2 * u[(size_t)(rbase + t + 1) * DIN + 1440 + pc];
        tile[c * 65 + tl] = acc;
      }
    }
    __syncthreads();
    {
      const int tl = TIDX & 63;
      float* dst = (cid < 256) ? (float*)(p.ws + OFF_HYIN) + ((size_t)(part * 2 + b) * 256) * SEQ
                               : (float*)(p.ws + OFF_HYINC) + ((size_t)(part * 2 + b) * 256) * CTXL;
      for (int i = 0; i < 32; ++i) { const int c = (TIDX >> 6) + 8 * i; dst[(size_t)c * slen + t0 + tl] = tile[c * 65 + tl]; }
    }
  }
}

__device__ void hyena_direct(const Params& p, int layer, char* smem) {
  float* zs = (float*)smem;
  float* Ts = zs + SEQ;
  bf16_t* mix = (bf16_t*)(p.ws + OFF_MIX);
  const int nunits = (layer == 0) ? 512 : 0;
  for (int unit = BIDX; unit < nunits; unit += gridDim.x) {
    const bool isc = true; const int q = unit & 511, b = q >> 8, c = q & 255;
    const int L = CTXL;
    const float* hin = (const float*)(p.ws + OFF_HYINC);
    const float* filt = (const float*)(p.ws + OFF_FILTC) + (size_t)layer * 1024 * CTXL;
    const float* ssq = (const float*)(p.ws + OFF_SSQPC) + (size_t)layer * 4 * 1024;
    const int ntt = 4;
    const int nout = (L + NTHREADS - 1) / NTHREADS;
    for (int order = 0; order < 2; ++order) {
      const int colf = (order * 2 + 0) * 256 + c, colb = (order * 2 + 1) * 256 + c;
      float sf = 0.f, sb = 0.f;
      for (int tt = 0; tt < ntt; ++tt) { sf += ssq[(size_t)tt * 1024 + colf]; sb += ssq[(size_t)tt * 1024 + colb]; }
      sf = rsqrtf(sf + EPSV); sb = rsqrtf(sb + EPSV);
      const float skip = p.in[I_HSKIP][(size_t)layer * 512 + order * 256 + c];
      __syncthreads();
      for (int i = TIDX; i < 2 * L; i += NTHREADS) {
        const int m = i - L;
        float v = 0.f;
        if (m >= 0) v = filt[(size_t)colf * L + m] * sf; else if (m > -L) v = filt[(size_t)colb * L - m] * sb;
        if (m == 0) v += skip;
        Ts[i] = v;
      }
      if (order == 0) for (int i = TIDX; i < L; i += NTHREADS) zs[i] = hin[((size_t)(0 * 2 + b) * 256 + c) * L + i];
      __syncthreads();
      float acc[16];
#pragma unroll
      for (int j = 0; j < 16; ++j) acc[j] = 0.f;
      if ((int)TIDX < L) {
        const float* tb = Ts + L + TIDX;
        if (!isc) {
          for (int s = 0; s < SEQ; ++s) {
            const float zv = zs[s];
#pragma unroll
            for (int j = 0; j < 16; ++j) acc[j] += tb[j * NTHREADS - s] * zv;
          }
        } else {
          for (int s = 0; s < CTXL; ++s) acc[0] += tb[-s] * zs[s];
        }
      }
      __syncthreads();
      const float* xg = hin + ((size_t)((1 + order) * 2 + b) * 256 + c) * L;
#pragma unroll
      for (int j = 0; j < 16; ++j) {
        const int t = TIDX + j * NTHREADS;
        if (t < L) {
          const float y = xg[t] * acc[j];
          if (order == 0) zs[t] = y;
          else { const size_t row = isc ? (size_t)NLAT + b * CTXL + t : (size_t)b * SEQ + t; mix[row * DM + 768 + c] = f2bf(y); }
        }
      }
    }
  }
}

namespace att {
constexpr int NW = 8, QBLK = 32, KVBLK = 64;
constexpr float SCALE = 0.10206207261596575f;
constexpr float THR = 8.f;
constexpr int SHM_V = KVBLK * 128 * 2, SHM_K = KVBLK * 128 * 2;
constexpr int SHM_ATTN = 2 * SHM_V + 2 * SHM_K + NW * 64 * 4;
#define KSWZ(row, colB) ((row) * 256 + ((colB) ^ (((row) & 7) << 4)))
#define SBAR() __builtin_amdgcn_sched_barrier(0)
__device__ __forceinline__ void partialSM(f32x16& p0, f32x16& p1, float& m_reg, float& mn, float& alpha) {
  constexpr float C = SCALE * 1.4426950408889634f;
  float pmax = p0[0];
#pragma unroll
  for (int r = 1; r < 16; ++r) pmax = fmaxf(pmax, p0[r]);
#pragma unroll
  for (int r = 0; r < 16; ++r) pmax = fmaxf(pmax, p1[r]);
  { auto rr = __builtin_amdgcn_permlane32_swap(__float_as_uint(pmax), __float_as_uint(pmax), false, false);
    pmax = fmaxf(__uint_as_float(rr[0]), __uint_as_float(rr[1])); }
  if (__builtin_expect(__all(pmax - m_reg <= THR / SCALE), 1)) { mn = m_reg; alpha = 1.f; }
  else { mn = fmaxf(m_reg, pmax); alpha = __builtin_amdgcn_exp2f((m_reg - mn) * C); m_reg = mn; }
  const float mnC = -mn * C;
#pragma unroll
  for (int r = 0; r < 16; ++r) p0[r] = fmaf(p0[r], C, mnC);
#pragma unroll
  for (int r = 0; r < 16; ++r) p1[r] = fmaf(p1[r], C, mnC);
#pragma unroll
  for (int r = 0; r < 16; ++r) p0[r] = __builtin_amdgcn_exp2f(p0[r]);
}
__device__ __forceinline__ void finishSM(f32x16& p0, f32x16& p1, float alpha, float& l_reg, bf16x8& pa0, bf16x8& pa1, bf16x8& pa2, bf16x8& pa3) {
#pragma unroll
  for (int r = 0; r < 16; ++r) p1[r] = __builtin_amdgcn_exp2f(p1[r]);
  float ps = 0;
#pragma unroll
  for (int r = 0; r < 16; ++r) ps += p0[r];
#pragma unroll
  for (int r = 0; r < 16; ++r) ps += p1[r];
  { auto rr = __builtin_amdgcn_permlane32_swap(__float_as_uint(ps), __float_as_uint(ps), false, false);
    ps = __uint_as_float(rr[0]) + __uint_as_float(rr[1]); }
  l_reg = l_reg * alpha + ps;
#define PK4(P, BASE, OUT) do { unsigned a0 = cvtpk(P[BASE + 0], P[BASE + 1]), a1 = cvtpk(P[BASE + 2], P[BASE + 3]);   \
    unsigned b0 = cvtpk(P[BASE + 4], P[BASE + 5]), b1 = cvtpk(P[BASE + 6], P[BASE + 7]);                              \
    auto r0 = __builtin_amdgcn_permlane32_swap(a0, b0, false, false); auto r1 = __builtin_amdgcn_permlane32_swap(a1, b1, false, false); \
    u32x4 w = {r0[0], r1[0], r0[1], r1[1]}; OUT = *reinterpret_cast<bf16x8*>(&w); } while (0)
  PK4(p0, 0, pa0); PK4(p0, 8, pa1); PK4(p1, 0, pa2); PK4(p1, 8, pa3);
#undef PK4
}
__device__ __forceinline__ void qkt(f32x16& p0, f32x16& p1, const char* Ks, const bf16x8* qr, int r32, int hi) {
  p0 = f32x16{}; p1 = f32x16{};
#pragma unroll
  for (int d0 = 0; d0 < 6; ++d0) { const int cb = (d0 * 16 + hi * 8) * 2;
    const bf16x8 b0 = *reinterpret_cast<const bf16x8*>(Ks + KSWZ(r32, cb));
    const bf16x8 b1 = *reinterpret_cast<const bf16x8*>(Ks + KSWZ(32 + r32, cb));
    p0 = __builtin_amdgcn_mfma_f32_32x32x16_bf16(b0, qr[d0], p0, 0, 0, 0);
    p1 = __builtin_amdgcn_mfma_f32_32x32x16_bf16(b1, qr[d0], p1, 0, 0, 0); }
}
__device__ __forceinline__ int v_st(int k, int c) { const int kk = (k & ~0xC) | ((k & 4) << 1) | ((k & 8) >> 1); return ((kk >> 3) * 4 + (c >> 5)) * 512 + ((kk & 7) * 32 + (c & 31)) * 2; }
__device__ __forceinline__ int v_rd_base(int lane) { return ((lane & 3) << 3) | (((lane >> 2) & 3) << 6) | (((lane >> 4) & 1) << 5) | (((lane >> 5) & 1) << 8); }
constexpr int v_rd_off(int d0, int ks, int half) { return d0 * 512 + ks * 4096 + half * 2048; }
template <int OFF> __device__ __forceinline__ s16x4 tr_read(int vb) {
  s16x4 r; asm volatile("ds_read_b64_tr_b16 %0, %1 offset:%2" : "=&v"(r) : "v"(vb), "i"(OFF) : "memory"); return r;
}
template <int D0> __device__ __forceinline__ void pv_one(f32x16& od, int vb, bf16x8 pa0, bf16x8 pa1, bf16x8 pa2, bf16x8 pa3) {
  const s16x4 l0 = tr_read<v_rd_off(D0, 0, 0)>(vb), h0 = tr_read<v_rd_off(D0, 0, 1)>(vb), l1 = tr_read<v_rd_off(D0, 1, 0)>(vb), h1 = tr_read<v_rd_off(D0, 1, 1)>(vb);
  const s16x4 l2 = tr_read<v_rd_off(D0, 2, 0)>(vb), h2 = tr_read<v_rd_off(D0, 2, 1)>(vb), l3 = tr_read<v_rd_off(D0, 3, 0)>(vb), h3 = tr_read<v_rd_off(D0, 3, 1)>(vb);
  asm volatile("s_waitcnt lgkmcnt(0)" ::: "memory"); SBAR();
#define PK(L, H) (bf16x8){L[0], L[1], L[2], L[3], H[0], H[1], H[2], H[3]}
  od = __builtin_amdgcn_mfma_f32_32x32x16_bf16(pa0, PK(l0, h0), od, 0, 0, 0);
  od = __builtin_amdgcn_mfma_f32_32x32x16_bf16(pa1, PK(l1, h1), od, 0, 0, 0);
  od = __builtin_amdgcn_mfma_f32_32x32x16_bf16(pa2, PK(l2, h2), od, 0, 0, 0);
  od = __builtin_amdgcn_mfma_f32_32x32x16_bf16(pa3, PK(l3, h3), od, 0, 0, 0);
#undef PK
}
__device__ __forceinline__ void pv_d0(f32x16& o0, f32x16& o1, int vb, bf16x8 pa0, bf16x8 pa1, bf16x8 pa2, bf16x8 pa3) {
  pv_one<0>(o0, vb, pa0, pa1, pa2, pa3); pv_one<1>(o1, vb, pa0, pa1, pa2, pa3);
}
__device__ __forceinline__ void attn_body(const bf16_t* __restrict__ Qb, const bf16_t* __restrict__ Kh, const bf16_t* __restrict__ Vh,
                                          bf16_t* __restrict__ Ob, int seq, char* lds) {
  const int tid = TIDX, wid = tid >> 6, lane = tid & 63, r32 = lane & 31, hi = lane >> 5;
  char* V_lds = lds; char* K_lds = lds + 2 * SHM_V;
  float* ws = (float*)(lds + 2 * SHM_V + 2 * SHM_K) + wid * 64; float* li_l = ws; float* al_l = ws + 32;
  float m_reg = -1e30f, l_reg = 0; f32x16 o0 = {}, o1 = {}; bf16x8 qr[6];
  const bf16_t* Qw = Qb + (size_t)(wid * QBLK + r32) * 96 + hi * 8;
#pragma unroll
  for (int d0 = 0; d0 < 6; ++d0) qr[d0] = *(const bf16x8*)(Qw + d0 * 16);
  const int sr = tid >> 4, sc = (tid & 15) * 8, vst0 = v_st(sr, sc & 63), vst1 = v_st(32 + sr, sc & 63);
  const int vb0 = (int)(uintptr_t)V_lds + v_rd_base(lane);
  const bool kact = sc < 96, vact = sc < 64;
  bf16x8 vs0 = {}, vs1 = {}, ks0 = {}, ks1 = {};
#define SLOAD(k0) do { if (vact) { vs0 = *(const bf16x8*)(&Vh[(size_t)((k0) + sr) * 64 + sc]); vs1 = *(const bf16x8*)(&Vh[(size_t)((k0) + 32 + sr) * 64 + sc]); } \
    if (kact) { ks0 = *(const bf16x8*)(&Kh[(size_t)((k0) + sr) * 96 + sc]); ks1 = *(const bf16x8*)(&Kh[(size_t)((k0) + 32 + sr) * 96 + sc]); } } while (0)
#define SWRITE(b) do { if (vact) { *(bf16x8*)(V_lds + (b) * SHM_V + vst0) = vs0; *(bf16x8*)(V_lds + (b) * SHM_V + vst1) = vs1; } \
    if (kact) { const int kc = sc * 2; *(bf16x8*)(K_lds + (b) * SHM_K + KSWZ(sr, kc)) = ks0; *(bf16x8*)(K_lds + (b) * SHM_K + KSWZ(32 + sr, kc)) = ks1; } } while (0)
#define SWAIT() asm volatile("s_waitcnt vmcnt(0)" ::: "memory")
#define RESC(a) do { if (__any((a) < 1.f)) { if (hi == 0) al_l[r32] = (a); asm volatile("s_waitcnt lgkmcnt(0)" ::: "memory"); \
    _Pragma("unroll") for (int r = 0; r < 16; ++r) { const float f = al_l[crow(r, hi)]; o0[r] *= f; o1[r] *= f; } } } while (0)
  f32x16 pA0, pA1, pB0, pB1; float mnA, mnB, alA, alB; bf16x8 pa0, pa1, pa2, pa3; const int NT = seq / KVBLK;
  __syncthreads();
  SLOAD(0); SWAIT(); SWRITE(0); __syncthreads();
  qkt(pA0, pA1, K_lds, qr, r32, hi); partialSM(pA0, pA1, m_reg, mnA, alA);
  SLOAD(KVBLK);
  SWAIT(); SWRITE(1); __syncthreads();
  for (int j = 1; j + 1 < NT; j += 2) {
    SBAR(); qkt(pB0, pB1, K_lds + SHM_K, qr, r32, hi);
    finishSM(pA0, pA1, alA, l_reg, pa0, pa1, pa2, pa3); SBAR();
    SLOAD((j + 1) * KVBLK); SBAR();
    pv_d0(o0, o1, vb0, pa0, pa1, pa2, pa3); partialSM(pB0, pB1, m_reg, mnB, alB);
    __syncthreads(); SWAIT(); SWRITE(0);
    RESC(alB); __syncthreads();
    SBAR(); qkt(pA0, pA1, K_lds, qr, r32, hi);
    finishSM(pB0, pB1, alB, l_reg, pa0, pa1, pa2, pa3); SBAR();
    SLOAD((j + 2) * KVBLK); SBAR();
    pv_d0(o0, o1, vb0 + SHM_V, pa0, pa1, pa2, pa3); partialSM(pA0, pA1, m_reg, mnA, alA);
    __syncthreads(); SWAIT(); SWRITE(1);
    RESC(alA); __syncthreads();
  }
  SBAR(); qkt(pB0, pB1, K_lds + SHM_K, qr, r32, hi);
  finishSM(pA0, pA1, alA, l_reg, pa0, pa1, pa2, pa3); SBAR();
  pv_d0(o0, o1, vb0, pa0, pa1, pa2, pa3); partialSM(pB0, pB1, m_reg, mnB, alB);
  __syncthreads(); RESC(alB);
  finishSM(pB0, pB1, alB, l_reg, pa0, pa1, pa2, pa3); SBAR();
  pv_d0(o0, o1, vb0 + SHM_V, pa0, pa1, pa2, pa3);
  if (hi == 0) li_l[r32] = l_reg; asm volatile("s_waitcnt lgkmcnt(0)" ::: "memory");
  bf16_t* Ow = Ob + (size_t)(wid * QBLK) * DM;
#pragma unroll
  for (int r = 0; r < 16; ++r) { const int orow = crow(r, hi); const float rl = __builtin_amdgcn_rcpf(li_l[orow]);
    Ow[(size_t)orow * DM + r32] = f2bf(o0[r] * rl); Ow[(size_t)orow * DM + 32 + r32] = f2bf(o1[r] * rl); }
#undef SLOAD
#undef SWRITE
#undef SWAIT
#undef RESC
}
}

__device__ void attn_units(const Params& p, int layer, char* smem) {
  const bf16_t* Q = (const bf16_t*)(p.ws + OFF_Q); const bf16_t* QC = (const bf16_t*)(p.ws + OFF_QC);
  const bf16_t* K = (const bf16_t*)(p.ws + OFF_K); const bf16_t* V = (const bf16_t*)(p.ws + OFF_V);
  bf16_t* mix = (bf16_t*)(p.ws + OFF_MIX);
  const int nunits = 384 + ((layer == 0) ? 12 : 0);
  for (int unit = BIDX; unit < nunits; unit += gridDim.x) {
    if (unit < 384) {
      const int bh = unit >> 5, qb = unit & 31, b = bh / 6, h = bh % 6;
      att::attn_body(Q + ((size_t)bh * SEQ + qb * 256) * 96, K + (size_t)bh * NKEYS * 96, V + (size_t)bh * NKEYS * 64,
                     mix + ((size_t)b * SEQ + qb * 256) * DM + 384 + h * 64, NKEYS, smem);
    } else {
      const int bh = unit - 384, b = bh / 6, h = bh % 6;
      att::attn_body(QC + (size_t)bh * CTXL * 96, K + (size_t)bh * NKEYS * 96, V + (size_t)bh * NKEYS * 64,
                     mix + ((size_t)NLAT + b * CTXL) * DM + 384 + h * 64, CTXL, smem);
    }
  }
}

#define CEK(a, b) { const unsigned _h = max(k[a], k[b]), _l = min(k[a], k[b]); k[a] = _h; k[b] = _l; }
__device__ __forceinline__ void sort16k(unsigned* k) {
  CEK(0,1) CEK(2,3) CEK(0,2) CEK(1,3) CEK(1,2) CEK(4,5) CEK(6,7) CEK(4,6)
  CEK(5,7) CEK(5,6) CEK(0,4) CEK(2,6) CEK(2,4) CEK(1,5) CEK(3,7) CEK(3,5)
  CEK(1,2) CEK(3,4) CEK(5,6) CEK(8,9) CEK(10,11) CEK(8,10) CEK(9,11) CEK(9,10)
  CEK(12,13) CEK(14,15) CEK(12,14) CEK(13,15) CEK(13,14) CEK(8,12) CEK(10,14) CEK(10,12)
  CEK(9,13) CEK(11,15) CEK(11,13) CEK(9,10) CEK(11,12) CEK(13,14) CEK(0,8) CEK(4,12)
  CEK(4,8) CEK(2,10) CEK(6,14) CEK(6,10) CEK(2,4) CEK(6,8) CEK(10,12) CEK(1,9)
  CEK(5,13) CEK(5,9) CEK(3,11) CEK(7,15) CEK(7,11) CEK(3,5) CEK(7,9) CEK(11,13)
  CEK(1,2) CEK(3,4) CEK(5,6) CEK(7,8) CEK(9,10) CEK(11,12) CEK(13,14)
}
__device__ __forceinline__ void bmerge16k(unsigned* k) {
  CEK(0,8) CEK(1,9) CEK(2,10) CEK(3,11) CEK(4,12) CEK(5,13) CEK(6,14) CEK(7,15)
  CEK(0,4) CEK(1,5) CEK(2,6) CEK(3,7) CEK(8,12) CEK(9,13) CEK(10,14) CEK(11,15)
  CEK(0,2) CEK(1,3) CEK(4,6) CEK(5,7) CEK(8,10) CEK(9,11) CEK(12,14) CEK(13,15)
  CEK(0,1) CEK(2,3) CEK(4,5) CEK(6,7) CEK(8,9) CEK(10,11) CEK(12,13) CEK(14,15)
}
#undef CEK
#define CEP(a, b) { const bool _s = v[a] < v[b]; const float _va = _s ? v[b] : v[a], _vb = _s ? v[a] : v[b]; const int _pa = _s ? pl[b] : pl[a], _pb = _s ? pl[a] : pl[b]; \
                    v[a] = _va; v[b] = _vb; pl[a] = _pa; pl[b] = _pb; }
__device__ __forceinline__ void sort16p(float* v, int* pl) {
  CEP(0,1) CEP(2,3) CEP(0,2) CEP(1,3)
  CEP(1,2) CEP(4,5) CEP(6,7) CEP(4,6)
  CEP(5,7) CEP(5,6) CEP(0,4) CEP(2,6)
  CEP(2,4) CEP(1,5) CEP(3,7) CEP(3,5)
  CEP(1,2) CEP(3,4) CEP(5,6) CEP(8,9)
  CEP(10,11) CEP(8,10) CEP(9,11) CEP(9,10)
  CEP(12,13) CEP(14,15) CEP(12,14) CEP(13,15)
  CEP(13,14) CEP(8,12) CEP(10,14) CEP(10,12)
  CEP(9,13) CEP(11,15) CEP(11,13) CEP(9,10)
  CEP(11,12) CEP(13,14) CEP(0,8) CEP(4,12)
  CEP(4,8) CEP(2,10) CEP(6,14) CEP(6,10)
  CEP(2,4) CEP(6,8) CEP(10,12) CEP(1,9)
  CEP(5,13) CEP(5,9) CEP(3,11) CEP(7,15)
  CEP(7,11) CEP(3,5) CEP(7,9) CEP(11,13)
  CEP(1,2) CEP(3,4) CEP(5,6) CEP(7,8)
  CEP(9,10) CEP(11,12) CEP(13,14)
}
__device__ __forceinline__ void bmerge16p(float* v, int* pl) {
  CEP(0,8) CEP(1,9) CEP(2,10) CEP(3,11)
  CEP(4,12) CEP(5,13) CEP(6,14) CEP(7,15)
  CEP(0,4) CEP(1,5) CEP(2,6) CEP(3,7)
  CEP(8,12) CEP(9,13) CEP(10,14) CEP(11,15)
  CEP(0,2) CEP(1,3) CEP(4,6) CEP(5,7)
  CEP(8,10) CEP(9,11) CEP(12,14) CEP(13,15)
  CEP(0,1) CEP(2,3) CEP(4,5) CEP(6,7)
  CEP(8,9) CEP(10,11) CEP(12,13) CEP(14,15)
}
#undef CEP
__device__ __forceinline__ unsigned fkey(float f, int low7) { unsigned u = __float_as_uint(f); u ^= (unsigned)((int)u >> 31) | 0x80000000u; return (u & ~127u) | (unsigned)low7; }
__device__ __forceinline__ float funkey(unsigned k) { unsigned u = k & ~127u; u ^= (u & 0x80000000u) ? 0x80000000u : 0xFFFFFFFFu; return __uint_as_float(u); }
__device__ __forceinline__ void peer_half_top16(const bf16_t* __restrict__ kp, const bf16_t* __restrict__ qp, int hi, unsigned* T) {
  f32x16 acc[4] = {};
#pragma unroll
  for (int ks = 0; ks < 8; ++ks) {
    const bf16x8 bq = *(const bf16x8*)(qp + ks * 16);
#pragma unroll
    for (int mt = 0; mt < 4; ++mt) {
      const bf16x8 a = *(const bf16x8*)(kp + (size_t)mt * 32 * 128 + ks * 16);
      acc[mt] = __builtin_amdgcn_mfma_f32_32x32x16_bf16(a, bq, acc[mt], 0, 0, 0);
    }
  }
  unsigned L[16];
#pragma unroll
  for (int mt = 0; mt < 4; ++mt) {
    unsigned k[16];
#pragma unroll
    for (int r = 0; r < 16; ++r) k[r] = fkey(acc[mt][r], 127 - (mt * 32 + (r & 3) + 8 * (r >> 2) + 4 * hi));
    sort16k(k);
    if (mt == 0) {
#pragma unroll
      for (int i = 0; i < 16; ++i) L[i] = k[i];
    } else {
#pragma unroll
      for (int i = 0; i < 16; ++i) L[i] = max(L[i], k[15 - i]);
      bmerge16k(L);
    }
  }
#pragma unroll
  for (int i = 0; i < 16; ++i) {
    const auto rr = __builtin_amdgcn_permlane32_swap(L[15 - i], L[15 - i], false, false);
    const unsigned partner = hi ? rr[0] : rr[1];
    T[i] = max(L[i], partner);
  }
  bmerge16k(T);
}
__device__ void peer_topk(const Params& p, int layer, int nrows, char* smem) {
  const int tid = TIDX, wid = tid >> 6, lane = tid & 63, r32 = lane & 31, hi = lane >> 5;
  const bf16_t* pq = (const bf16_t*)(p.ws + OFF_PQ);
  const bf16_t* keys = (const bf16_t*)(p.ws + OFF_KEYS) + (size_t)layer * 2 * 128 * 128;
  int* eid = (int*)(p.ws + OFF_EID); float* gate = (float*)(p.ws + OFF_GATE);
  const int ntask = (nrows / 32) * 8;
  for (int task = BIDX * 8 + wid; task < ntask; task += gridDim.x * 8) {
    const int grp = task >> 3, h = task & 7;
    const size_t row = (size_t)grp * 32 + r32;
    unsigned K1[16], K2[16];
    peer_half_top16(keys + (size_t)r32 * 128 + hi * 8, pq + row * 2048 + h * 256 + hi * 8, hi, K1);
    peer_half_top16(keys + (size_t)(128 + r32) * 128 + hi * 8, pq + row * 2048 + h * 256 + 128 + hi * 8, hi, K2);
    float v1[16], v2[16]; int i1[16], i2[16];
#pragma unroll
    for (int i = 0; i < 16; ++i) { v1[i] = funkey(K1[i]); v2[i] = funkey(K2[i]); i1[i] = 127 - (int)(K1[i] & 127u); i2[i] = 127 - (int)(K2[i] & 127u); }
    float ts[16]; int tp[16];
    {
      float* cv = ts; int* cp = tp;
    cv[0] = v1[0] + v2[0]; cp[0] = (i1[0] << 7) | i2[0];
    cv[1] = v1[0] + v2[1]; cp[1] = (i1[0] << 7) | i2[1];
    cv[2] = v1[0] + v2[2]; cp[2] = (i1[0] << 7) | i2[2];
    cv[3] = v1[0] + v2[3]; cp[3] = (i1[0] << 7) | i2[3];
    cv[4] = v1[0] + v2[4]; cp[4] = (i1[0] << 7) | i2[4];
    cv[5] = v1[0] + v2[5]; cp[5] = (i1[0] << 7) | i2[5];
    cv[6] = v1[0] + v2[6]; cp[6] = (i1[0] << 7) | i2[6];
    cv[7] = v1[0] + v2[7]; cp[7] = (i1[0] << 7) | i2[7];
    cv[8] = v1[0] + v2[8]; cp[8] = (i1[0] << 7) | i2[8];
    cv[9] = v1[0] + v2[9]; cp[9] = (i1[0] << 7) | i2[9];
    cv[10] = v1[0] + v2[10]; cp[10] = (i1[0] << 7) | i2[10];
    cv[11] = v1[0] + v2[11]; cp[11] = (i1[0] << 7) | i2[11];
    cv[12] = v1[0] + v2[12]; cp[12] = (i1[0] << 7) | i2[12];
    cv[13] = v1[0] + v2[13]; cp[13] = (i1[0] << 7) | i2[13];
    cv[14] = v1[0] + v2[14]; cp[14] = (i1[0] << 7) | i2[14];
    cv[15] = v1[0] + v2[15]; cp[15] = (i1[0] << 7) | i2[15];
      sort16p(ts, tp);
    }
#pragma unroll 1
    for (int g = 1; g < 3; ++g) {
      float cv[16]; int cp[16];
      if (g == 1) {
    cv[0] = v1[1] + v2[0]; cp[0] = (i1[1] << 7) | i2[0];
    cv[1] = v1[1] + v2[1]; cp[1] = (i1[1] << 7) | i2[1];
    cv[2] = v1[1] + v2[2]; cp[2] = (i1[1] << 7) | i2[2];
    cv[3] = v1[1] + v2[3]; cp[3] = (i1[1] << 7) | i2[3];
    cv[4] = v1[1] + v2[4]; cp[4] = (i1[1] << 7) | i2[4];
    cv[5] = v1[1] + v2[5]; cp[5] = (i1[1] << 7) | i2[5];
    cv[6] = v1[1] + v2[6]; cp[6] = (i1[1] << 7) | i2[6];
    cv[7] = v1[1] + v2[7]; cp[7] = (i1[1] << 7) | i2[7];
    cv[8] = v1[2] + v2[0]; cp[8] = (i1[2] << 7) | i2[0];
    cv[9] = v1[2] + v2[1]; cp[9] = (i1[2] << 7) | i2[1];
    cv[10] = v1[2] + v2[2]; cp[10] = (i1[2] << 7) | i2[2];
    cv[11] = v1[2] + v2[3]; cp[11] = (i1[2] << 7) | i2[3];
    cv[12] = v1[2] + v2[4]; cp[12] = (i1[2] << 7) | i2[4];
    cv[13] = v1[3] + v2[0]; cp[13] = (i1[3] << 7) | i2[0];
    cv[14] = v1[3] + v2[1]; cp[14] = (i1[3] << 7) | i2[1];
    cv[15] = v1[3] + v2[2]; cp[15] = (i1[3] << 7) | i2[2];
      } else {
    cv[0] = v1[3] + v2[3]; cp[0] = (i1[3] << 7) | i2[3];
    cv[1] = v1[4] + v2[0]; cp[1] = (i1[4] << 7) | i2[0];
    cv[2] = v1[4] + v2[1]; cp[2] = (i1[4] << 7) | i2[1];
    cv[3] = v1[4] + v2[2]; cp[3] = (i1[4] << 7) | i2[2];
    cv[4] = v1[5] + v2[0]; cp[4] = (i1[5] << 7) | i2[0];
    cv[5] = v1[5] + v2[1]; cp[5] = (i1[5] << 7) | i2[1];
    cv[6] = v1[6] + v2[0]; cp[6] = (i1[6] << 7) | i2[0];
    cv[7] = v1[6] + v2[1]; cp[7] = (i1[6] << 7) | i2[1];
    cv[8] = v1[7] + v2[0]; cp[8] = (i1[7] << 7) | i2[0];
    cv[9] = v1[7] + v2[1]; cp[9] = (i1[7] << 7) | i2[1];
    cv[10] = v1[8] + v2[0]; cp[10] = (i1[8] << 7) | i2[0];
    cv[11] = v1[9] + v2[0]; cp[11] = (i1[9] << 7) | i2[0];
    cv[12] = v1[10] + v2[0]; cp[12] = (i1[10] << 7) | i2[0];
    cv[13] = v1[11] + v2[0]; cp[13] = (i1[11] << 7) | i2[0];
    cv[14] = v1[12] + v2[0]; cp[14] = (i1[12] << 7) | i2[0];
    cv[15] = v1[13] + v2[0]; cp[15] = (i1[13] << 7) | i2[0];
      }
      sort16p(cv, cp);
#pragma unroll
      for (int i = 0; i < 16; ++i) if (cv[15 - i] > ts[i]) { ts[i] = cv[15 - i]; tp[i] = cp[15 - i]; }
      bmerge16p(ts, tp);
    }
    {
      float cv[2]; int cp[2];
    cv[0] = v1[14] + v2[0]; cp[0] = (i1[14] << 7) | i2[0];
    cv[1] = v1[15] + v2[0]; cp[1] = (i1[15] << 7) | i2[0];
      if (cv[0] < cv[1]) { const float tv = cv[0]; cv[0] = cv[1]; cv[1] = tv; const int ti = cp[0]; cp[0] = cp[1]; cp[1] = ti; }
      if (cv[1] > ts[14]) { ts[14] = cv[1]; tp[14] = cp[1]; }
      if (cv[0] > ts[15]) { ts[15] = cv[0]; tp[15] = cp[0]; }
      bmerge16p(ts, tp);
    }
    float ex[16], sm = 0.f;
#pragma unroll
    for (int i = 0; i < 16; ++i) { ex[i] = __expf(ts[i] - ts[0]); sm += ex[i]; }
    const float rs = 1.f / sm;
    if (hi == 0) {
      int* eo = eid + row * 128 + h * 16;
#pragma unroll
      for (int i = 0; i < 4; ++i) { const u32x4 o = {(unsigned)tp[4 * i], (unsigned)tp[4 * i + 1], (unsigned)tp[4 * i + 2], (unsigned)tp[4 * i + 3]}; *(u32x4*)(eo + 4 * i) = o; }
    } else {
      float* go = gate + row * 128 + h * 16;
#pragma unroll
      for (int i = 0; i < 4; ++i) { const f32x4 o = {ex[4 * i] * rs, ex[4 * i + 1] * rs, ex[4 * i + 2] * rs, ex[4 * i + 3] * rs}; *(f32x4*)(go + 4 * i) = o; }
    }
  }
}

__device__ void peer_cvt_tables(const Params& p, int layer) {
  const float* ut = p.in[I_PU] + (size_t)layer * 16384 * DM; const float* vt = p.in[I_PV] + (size_t)layer * 16384 * DM;
  u32x4* uo = (u32x4*)(p.ws + OFF_UTAB); u32x4* vo = (u32x4*)(p.ws + OFF_VTAB);
  const int n8 = 16384 * DM / 8;
  for (int i = BIDX * NTHREADS + TIDX; i < 2 * n8; i += gridDim.x * NTHREADS) {
    const bool isv = i >= n8; const int j = isv ? i - n8 : i;
    const float* s = (isv ? vt : ut) + (size_t)j * 8;
    const f32x4 a = *(const f32x4*)s, b = *(const f32x4*)(s + 4);
    const u32x4 o = {cvtpk(a[0], a[1]), cvtpk(a[2], a[3]), cvtpk(b[0], b[1]), cvtpk(b[2], b[3])};
    (isv ? vo : uo)[j] = o;
  }
}

__device__ void peer_eval(const Params& p, int layer, int nrows, int dry = 0) {
  const int lane = TIDX & 63, wid = TIDX >> 6;
  const bf16_t* hb = (const bf16_t*)(p.ws + OFF_HB);
  const int* eid = (const int*)(p.ws + OFF_EID); const float* gate = (const float*)(p.ws + OFF_GATE);
  const bf16_t* ut = (const bf16_t*)(p.ws + OFF_UTAB) + lane * 16; const bf16_t* vt = (const bf16_t*)(p.ws + OFF_VTAB) + lane * 16;
  float* xs = (float*)(p.ws + OFF_XS);
  for (int r = BIDX * 8 + wid; r < nrows; r += gridDim.x * 8) {
    int b, t, isc; row_info(r, b, t, isc);
    const float* g2 = (const float*)(p.ws + OFF_MOD) + ((size_t)layer * 3 + (isc ? 2 : b)) * 6144 + 5120;
    const u32x4 xa = *(const u32x4*)(hb + (size_t)r * DM + lane * 16), xb = *(const u32x4*)(hb + (size_t)r * DM + lane * 16 + 8);
    float out[16];
#pragma unroll
    for (int i = 0; i < 16; ++i) out[i] = 0.f;
    const int* er = eid + (size_t)r * 128; const float* gr = gate + (size_t)r * 128;
    for (int it = 0; it < 128; it += 4) {
      u32x4 ua[4], ub[4], va[4], vb[4]; float gk[4];
#pragma unroll
      for (int k = 0; k < 4; ++k) {
        const int e = __builtin_amdgcn_readfirstlane(er[it + k]); gk[k] = gr[it + k];
        const bf16_t* up = ut + (size_t)e * DM; const bf16_t* vp = vt + (size_t)e * DM;
        ua[k] = *(const u32x4*)up; ub[k] = *(const u32x4*)(up + 8); va[k] = *(const u32x4*)vp; vb[k] = *(const u32x4*)(vp + 8);
      }
#pragma unroll
      for (int k = 0; k < 4; ++k) {
        float d = 0.f;
#pragma unroll
        for (int j = 0; j < 4; ++j) { d = dot2bf(ua[k][j], xa[j], d); d = dot2bf(ub[k][j], xb[j], d); }
        d = wave_sum(d);
        const float w = gk[k] * gelu_tanh(d);
#pragma unroll
        for (int j = 0; j < 4; ++j) {
          out[2 * j]         += w * __uint_as_float(va[k][j] << 16);
          out[2 * j + 1]     += w * __uint_as_float(va[k][j] & 0xffff0000u);
          out[8 + 2 * j]     += w * __uint_as_float(vb[k][j] << 16);
          out[8 + 2 * j + 1] += w * __uint_as_float(vb[k][j] & 0xffff0000u);
        }
      }
    }
    float* xr = xs + (size_t)r * DM + lane * 16;
#pragma unroll
    for (int i = 0; i < 4; ++i) {
      f32x4 xv = *(const f32x4*)(xr + i * 4);
#pragma unroll
      for (int j = 0; j < 4; ++j) xv[j] += g2[lane * 16 + i * 4 + j] * out[i * 4 + j];
      if (dry == 0) *(f32x4*)(xr + i * 4) = xv;
    }
  }
}

__device__ void final_norm(const Params& p) {
  const int lane = TIDX & 63, wid = TIDX >> 6;
  const float* xs = (const float*)(p.ws + OFF_XS); const float* g = p.in[I_FG];
  for (int r = BIDX * 8 + wid; r < NLAT; r += gridDim.x * 8) {
    f32x4 v[4]; float ss = 0.f;
#pragma unroll
    for (int i = 0; i < 4; ++i) { v[i] = *(const f32x4*)(xs + (size_t)r * DM + (i * 64 + lane) * 4); ss += v[i][0] * v[i][0] + v[i][1] * v[i][1] + v[i][2] * v[i][2] + v[i][3] * v[i][3]; }
    ss = wave_sum(ss);
    const float rinv = rsqrtf(ss * (1.f / DM) + EPSV);
#pragma unroll
    for (int i = 0; i < 4; ++i) {
      const int c0 = (i * 64 + lane) * 4; f32x4 o;
#pragma unroll
      for (int j = 0; j < 4; ++j) o[j] = v[i][j] * rinv * g[c0 + j];
      *(f32x4*)(p.out + (size_t)r * DM + c0) = o;
    }
  }
}

constexpr int NSTAGES = 23;
constexpr int SMEM_BYTES = 135168;
template <int S>
__device__ __forceinline__ void run_stage_t(const Params& p0, int layer0, char* smem0) {
  Params p = p0; int layer = layer0; char* smem = smem0;
  { unsigned long long w = (unsigned long long)p0.ws, o = (unsigned long long)p0.out;
    asm volatile("" : "+s"(w), "+s"(o), "+s"(layer));
    p.ws = (char*)(__attribute__((address_space(1))) char*)w; p.out = (float*)(__attribute__((address_space(1))) float*)o; }
  const int nrows = (layer == 0) ? NTOK : NLAT;
  if constexpr (S == 100) stage_prep(p, smem);
  if constexpr (S == 101) stage_prep2(p, smem);
  if constexpr (S == 102) final_norm(p);
  if constexpr (S == 0) stage_norm(p, layer, 0, NTOK);
  if constexpr (S == 1) {
    float* u = (float*)(p.ws + OFF_U);
    gemm_bt((const bf16_t*)(p.ws + OFF_HB), DM, (const bf16_t*)(p.ws + OFF_WIN) + (size_t)layer * DINP * 1024, 1024, NTOK, DINP, 1024,
            [=](int row, int col, float v) { if (col < DIN) u[(size_t)row * DIN + col] = v; }, smem);
  }
  if constexpr (S == 2) { lru_units(p, layer, 0, smem); mla_prep(p, layer); hyena_prep(p, layer, smem); }
  if constexpr (S == 3) {
    bf16_t* Q = (bf16_t*)(p.ws + OFF_Q); bf16_t* QC = (bf16_t*)(p.ws + OFF_QC); bf16_t* K = (bf16_t*)(p.ws + OFF_K); bf16_t* V = (bf16_t*)(p.ws + OFF_V);
    gemm_bt((const bf16_t*)(p.ws + OFF_QN), 384, (const bf16_t*)(p.ws + OFF_WQB) + (size_t)layer * 640 * 384, 384, NTOK, 640, 384,
            [=](int row, int col, float v) {
              const float vp = shx(v, 8);
              if (col < 576) {
                int b, t, isc; row_info(row, b, t, isc);
                const int h = col / 96, j = col % 96;
                if (j >= 64 && !isc) v = rope_apply(v, vp, j - 64, t);
                if (isc) QC[((size_t)(b * 6 + h) * CTXL + t) * 96 + j] = f2bf(v);
                else     Q[((size_t)(b * 6 + h) * SEQ + t) * 96 + j] = f2bf(v);
              }
            }, smem);
    gemm_bt((const bf16_t*)(p.ws + OFF_KVN), 256, (const bf16_t*)(p.ws + OFF_WKVB) + (size_t)layer * 768 * 256, 256, NTOK, 768, 256,
            [=](int row, int col, float v) {
              int b, t, isc; row_info(row, b, t, isc);
              const int h = col >> 7, j = col & 127, tk = isc ? t : CTXL + t;
              if (j < 64) K[((size_t)(b * 6 + h) * NKEYS + tk) * 96 + j] = f2bf(v);
              else        V[((size_t)(b * 6 + h) * NKEYS + tk) * 64 + (j - 64)] = f2bf(v);
            }, smem);
    lru_carry(p);
  }
  if constexpr (S == 4) { attn_units(p, layer, smem); hyena_fft(p, layer, smem); hyena_direct(p, layer, smem); lru_units(p, layer, 1, smem); }
  if constexpr (S == 5) {
    float* xs = (float*)(p.ws + OFF_XS); const float* mod = (const float*)(p.ws + OFF_MOD) + (size_t)layer * 3 * 6144;
    const float* xin = p.in[I_X]; const float* cin = p.in[I_CTX];
    gemm_bt((const bf16_t*)(p.ws + OFF_MIX), DM, (const bf16_t*)(p.ws + OFF_WOUT) + (size_t)layer * 1024 * 1024, 1024, nrows, 1024, 1024,
            [=](int row, int col, float v) {
              int b, t, isc; row_info(row, b, t, isc);
              const float g1 = mod[(size_t)(isc ? 2 : b) * 6144 + 2048 + col];
              const float* src = (layer == 0) ? ((row < NLAT) ? xin + (size_t)row * DM : cin + (size_t)(row - NLAT) * DM) : xs + (size_t)row * DM;
              xs[(size_t)row * DM + col] = src[col] + g1 * v;
            }, smem);
  }
  if constexpr (S == 6) { stage_norm(p, layer, 1, nrows); peer_cvt_tables(p, layer); }
  if constexpr (S == 7) {
    bf16_t* pq = (bf16_t*)(p.ws + OFF_PQ);
    gemm_bt((const bf16_t*)(p.ws + OFF_HB), DM, (const bf16_t*)(p.ws + OFF_WPQ) + (size_t)layer * 2048 * 1024, 1024, nrows, 2048, 1024,
            [=](int row, int col, float v) { pq[(size_t)row * 2048 + col] = f2bf(v); }, smem);
  }
  if constexpr (S == 8) peer_topk(p, layer, nrows, smem);
  if constexpr (S == 9) peer_eval(p, layer, nrows);
}

__device__ __forceinline__ void init_params(Params& p, const KArgs& ka, char* smem) {
  unsigned long long* tab = (unsigned long long*)(smem + SMEM_BYTES);
  if (threadIdx.x == 0) {
#pragma unroll
    for (int i = 0; i < N_IN; ++i) tab[i] = (unsigned long long)ka.in[i];
  }
  __syncthreads();
  p.in.tab = smem + SMEM_BYTES; p.out = ka.out; p.ws = ka.ws;
}

#if MK_SINGLE
#define SYNC() grid.sync()
__global__ void __launch_bounds__(NTHREADS) mega_kernel(KArgs ka) {
  __shared__ __attribute__((aligned(16))) char smem[SMEM_BYTES + 512];
  cg::grid_group grid = cg::this_grid();
  Params p; init_params(p, ka, smem);
  run_stage_t<100>(p, 0, smem); SYNC();
  run_stage_t<101>(p, 0, smem); SYNC();
#ifndef PROBE_DUP
#define PROBE_DUP -1
#endif
#define RUNSTAGE(S, layer) do { if (PROBE_DUP == S) { int nrep = 2; asm volatile("" : "+s"(nrep)); \
      for (int rep = 0; rep < nrep; ++rep) { if (S == 9) peer_eval(p, layer, (layer == 0) ? NTOK : NLAT, rep + 1 < nrep); else run_stage_t<S>(p, layer, smem); SYNC(); } } \
    else { run_stage_t<S>(p, layer, smem); SYNC(); } } while (0)
#define LAYER_PASS(layer) \
    RUNSTAGE(0, layer); RUNSTAGE(1, layer); RUNSTAGE(2, layer); RUNSTAGE(3, layer); RUNSTAGE(4, layer); \
    RUNSTAGE(5, layer); RUNSTAGE(6, layer); RUNSTAGE(7, layer); RUNSTAGE(8, layer); RUNSTAGE(9, layer);
  LAYER_PASS(0)
  LAYER_PASS(1)
  run_stage_t<102>(p, 0, smem);
}
#else
template <int S>
__global__ void __launch_bounds__(NTHREADS) stage_kernel(KArgs ka, int layer) {
  __shared__ __attribute__((aligned(16))) char smem[SMEM_BYTES + 512];
  Params p; init_params(p, ka, smem);
  run_stage_t<S>(p, layer, smem);
}
#endif

extern "C" void kernel_launch(void* const* d_in, const int* in_sizes, int n_in, void* d_out, int out_size, void* d_ws, size_t ws_size, hipStream_t stream) {
  if (n_in != N_IN || ws_size < WS_END) { fprintf(stderr, "kernel_launch: bad args n_in=%d ws=%zu need=%zu\n", n_in, ws_size, (size_t)WS_END); return; }
  KArgs p{};
  for (int i = 0; i < N_IN; ++i) p.in[i] = (const float*)d_in[i];
  p.out = (float*)d_out; p.ws = (char*)d_ws;
#if MK_SINGLE
  static int grid_blocks = 0;
  if (!grid_blocks) {
    int dev = 0, cus = 0, per_cu = 0;
    hipGetDevice(&dev);
    hipDeviceGetAttribute(&cus, hipDeviceAttributeMultiprocessorCount, dev);
    hipOccupancyMaxActiveBlocksPerMultiprocessor(&per_cu, mega_kernel, NTHREADS, 0);
    if (per_cu > 1) per_cu = 1;
    grid_blocks = cus * per_cu;
  }
  void* args[] = {&p};
  hipError_t e = hipLaunchCooperativeKernel((void*)mega_kernel, dim3(grid_blocks), dim3(NTHREADS), args, 0, stream);
  if (e != hipSuccess) fprintf(stderr, "cooperative launch failed: %s (grid %d)\n", hipGetErrorString(e), grid_blocks);
#else
#define LAUNCH(S, L) hipLaunchKernelGGL(stage_kernel<S>, dim3(256), dim3(NTHREADS), 0, stream, p, L)
  LAUNCH(100, 0); LAUNCH(101, 0);
  for (int layer = 0; layer < 2; ++layer) {
    LAUNCH(0, layer); LAUNCH(1, layer); LAUNCH(2, layer); LAUNCH(3, layer); LAUNCH(4, layer);
    LAUNCH(5, layer); LAUNCH(6, layer); LAUNCH(7, layer); LAUNCH(8, layer); LAUNCH(9, layer);
  }
  LAUNCH(102, 0);
#endif
}
```

```cpp
#include <hip/hip_runtime.h>
#include <hip/hip_cooperative_groups.h>
#include <cstdio>
#include <cstdint>
namespace cg = cooperative_groups;

__device__ __forceinline__ int launder_v(int x) { asm volatile("" : "+v"(x)); return x; }
__device__ __forceinline__ int launder_s(int x) { asm volatile("" : "+s"(x)); return x; }
#define TIDX launder_v((int)threadIdx.x)
#define BIDX launder_s((int)blockIdx.x)

__device__ __forceinline__ float shx(float v, int mask) { const int l = TIDX & 63; return __int_as_float(__builtin_amdgcn_ds_bpermute((l ^ mask) << 2, __float_as_int(v))); }
__device__ __forceinline__ int shxi(int v, int mask) { const int l = TIDX & 63; return __builtin_amdgcn_ds_bpermute((l ^ mask) << 2, v); }
__device__ __forceinline__ float rdl(float v, int srclane) { return __int_as_float(__builtin_amdgcn_readlane(__float_as_int(v), srclane)); }

#ifndef MK_SINGLE
#define MK_SINGLE 1
#endif

typedef unsigned short bf16_t;
using bf16x8 = __attribute__((ext_vector_type(8))) short;
using s16x4  = __attribute__((ext_vector_type(4))) short;
using f32x16 = __attribute__((ext_vector_type(16))) float;
using f32x4  = __attribute__((ext_vector_type(4))) float;
using u32x4  = __attribute__((ext_vector_type(4))) unsigned;
using u32x2  = __attribute__((ext_vector_type(2))) unsigned;

constexpr int NB = 2, SEQ = 8192, CTXL = 256, DM = 1024;
constexpr int NLAT = NB * SEQ, NCTX = NB * CTXL, NTOK = NLAT + NCTX;
constexpr int DIN = 2208, DINP = 2304;
constexpr int DLRU = 384, NKEYS = SEQ + CTXL;
constexpr int NTHREADS = 512;
constexpr int NCHUNK = NLAT / 64 + NCTX / 64;
constexpr float EPSV = 1e-6f;

enum { I_X = 0, I_C, I_CTX, I_CCTX, I_WMOD, I_BMOD, I_N1G, I_N2G, I_WIN, I_WOUT, I_LCW, I_LCB, I_LWR, I_LBR, I_LWI, I_LBI, I_LLAM,
       I_QNG, I_WQB, I_KVNG, I_WKVB, I_HCW, I_HCB, I_HW1, I_HB1, I_HW2, I_HB2, I_HW3, I_HFREQ, I_HDECAY, I_HSKIP,
       I_PWQ, I_PKEYS, I_PU, I_PV, I_FG, N_IN };

struct KArgs { const float* in[N_IN]; float* out; char* ws; };
struct InTab {
  const char* tab;
  __device__ __forceinline__ const float* operator[](int i) const {
    const unsigned long long v = ((const unsigned long long*)tab)[i];
    const unsigned lo = __builtin_amdgcn_readfirstlane((unsigned)v), hi = __builtin_amdgcn_readfirstlane((unsigned)(v >> 32));
    return (const float*)(const __attribute__((address_space(1))) float*)(((unsigned long long)hi << 32) | lo);
  }
};
struct Params { InTab in; float* out; char* ws; };

constexpr size_t al256(size_t x) { return (x + 255) / 256 * 256; }
constexpr size_t OFF_XS    = 0;
constexpr size_t OFF_HB    = OFF_XS    + al256((size_t)NTOK * DM * 4);
constexpr size_t OFF_U     = OFF_HB    + al256((size_t)NTOK * DM * 2);
constexpr size_t OFF_PQ    = OFF_U;
constexpr size_t OFF_LAB   = OFF_U     + al256((size_t)NTOK * DIN * 2);
static_assert(OFF_LAB + (size_t)(NTOK / 32) * 6 * 2 * 2 * 16 * 64 * 4 <= OFF_U + al256((size_t)NTOK * DIN * 4), "LRU coefficient buffer must fit behind the bf16 u");
constexpr size_t OFF_MIX   = OFF_U     + al256((size_t)NTOK * DIN * 4);
constexpr size_t OFF_HYIN  = OFF_MIX   + al256((size_t)NTOK * DM * 2);
constexpr size_t OFF_EID   = OFF_HYIN;
constexpr size_t OFF_GATE  = OFF_EID   + al256((size_t)NTOK * 128 * 4);
constexpr size_t OFF_HYINC = OFF_HYIN  + al256((size_t)3 * 2 * 256 * 8192 * 4);
constexpr size_t OFF_QN    = OFF_HYINC + al256((size_t)3 * 2 * 256 * 256 * 4);
constexpr size_t TAB_BYTES = (size_t)16384 * 1024;
constexpr size_t OFF_UTAB  = al256(OFF_LAB + (size_t)(NTOK / 32) * 6 * 2 * 2 * 16 * 64 * 4);
constexpr size_t OFF_OPART = OFF_QN;
constexpr size_t OFF_OML   = OFF_OPART + (size_t)4 * 2 * SEQ * 64 * 4;
constexpr size_t OFF_KVN   = OFF_QN    + al256((size_t)NTOK * 384 * 2);
constexpr size_t OFF_Q     = OFF_KVN   + al256((size_t)NTOK * 256 * 2);
constexpr size_t OFF_K     = OFF_Q     + al256((size_t)NTOK * 576 * 2);
constexpr size_t OFF_V     = OFF_K     + al256((size_t)NTOK * 768 * 2);
constexpr size_t OFF_LSUM  = OFF_V     + al256((size_t)NTOK * 32 * 2);
static_assert(OFF_OML + (size_t)4 * 2 * SEQ * 2 * 4 <= OFF_Q, "attention partials must fit in the dead QN/KVN region");
static_assert(OFF_UTAB + TAB_BYTES <= OFF_U + al256((size_t)NTOK * DIN * 4), "u table must fit in the tail of the u region");
constexpr size_t OFF_CARRY = OFF_LSUM  + al256((size_t)(NTOK / 32) * 2 * 2 * 384 * 4);
constexpr size_t OFF_MOD   = OFF_CARRY + al256((size_t)(NTOK / 32) * 2 * 384 * 4);
constexpr size_t OFF_MODP  = OFF_MIX;
constexpr size_t OFF_WIN   = OFF_MOD   + al256((size_t)2 * 3 * 6144 * 4);
constexpr size_t OFF_WOUT  = OFF_WIN   + al256((size_t)2 * DINP * 1024 * 2);
constexpr size_t OFF_WQB   = OFF_WOUT  + al256((size_t)2 * 1024 * 1024 * 2);
constexpr size_t OFF_WKVB  = OFF_WQB   + al256((size_t)2 * 768 * 384 * 2);
constexpr size_t OFF_WPQ   = OFF_WKVB  + al256((size_t)2 * 768 * 256 * 2);
constexpr size_t OFF_KEYS  = OFF_WPQ   + al256((size_t)2 * 2048 * 1024 * 2);
constexpr size_t OFF_GW    = OFF_KEYS  + al256((size_t)2 * 2 * 128 * 128 * 2);
constexpr size_t OFF_H2    = OFF_GW    + al256((size_t)2 * 2 * 2 * 6 * 64 * 64 * 2);
constexpr size_t OFF_HSPEC = OFF_H2    + al256((size_t)2 * NKEYS * 64 * 4);
constexpr size_t OFF_FILTC = OFF_HSPEC + al256((size_t)2 * 256 * 2 * 16384 * 4);
constexpr size_t OFF_SSQPC = OFF_FILTC + al256((size_t)2 * 1024 * 256 * 4);
constexpr size_t OFF_BAR   = OFF_SSQPC + al256((size_t)2 * 4 * 1024 * 4);
constexpr size_t OFF_CTR   = OFF_BAR   + al256(3456 * 4);
constexpr size_t BAR_BYTES = al256(3456 * 4) + 2 * 2 * 2 * 16 * 256;
constexpr size_t OFF_VTAB  = OFF_BAR   + al256(BAR_BYTES);
constexpr size_t WS_END    = OFF_VTAB  + al256(TAB_BYTES);
static_assert(WS_END <= (size_t)4 * 2 * 16384 * 1024 * 4, "workspace layout exceeds the guaranteed 4 x largest-tensor size");
constexpr size_t OFF_SP    = OFF_U;
constexpr size_t OFF_WBUF  = OFF_SP    + (size_t)16 * NTOK * 128 * 4;
static_assert(OFF_WBUF + (size_t)NTOK * 128 * 4 <= OFF_MIX, "PEER partials must fit in the u region");

__device__ __forceinline__ float bf2f(bf16_t v) { return __uint_as_float(((unsigned)v) << 16); }
__device__ __forceinline__ bf16_t f2bf(float f) { unsigned u = __float_as_uint(f); u += 0x7fffu + ((u >> 16) & 1u); return (bf16_t)(u >> 16); }
__device__ __forceinline__ unsigned cvtpk(float lo, float hi) { unsigned r; asm volatile("v_cvt_pk_bf16_f32 %0, %1, %2" : "=v"(r) : "v"(lo), "v"(hi)); return r; }
__device__ __forceinline__ float gelu_tanh(float x) { const float z2 = 1.5957691216057308f * (x + 0.044715f * x * x * x); return x * __builtin_amdgcn_rcpf(1.f + __expf(-z2)); }
__device__ __forceinline__ float sigm(float x) { return 1.f / (1.f + __expf(-x)); }
template <int CTRL> __device__ __forceinline__ float dpp_mov(float x) { return __builtin_bit_cast(float, __builtin_amdgcn_mov_dpp(__builtin_bit_cast(int, x), CTRL, 0xf, 0xf, true)); }
__device__ __forceinline__ float wave_sum(float v) {
  v += dpp_mov<0xB1>(v); v += dpp_mov<0x4E>(v); v += dpp_mov<0x141>(v); v += dpp_mov<0x128>(v);
  { auto r = __builtin_amdgcn_permlane16_swap(__float_as_uint(v), __float_as_uint(v), false, false); v = __uint_as_float(r[0]) + __uint_as_float(r[1]); }
  { auto r = __builtin_amdgcn_permlane32_swap(__float_as_uint(v), __float_as_uint(v), false, false); v = __uint_as_float(r[0]) + __uint_as_float(r[1]); }
  return v;
}
using bf16x2v = __attribute__((ext_vector_type(2))) __bf16;
__device__ __forceinline__ float dot2bf(unsigned a, unsigned b, float acc) { return __builtin_amdgcn_fdot2_f32_bf16(__builtin_bit_cast(bf16x2v, a), __builtin_bit_cast(bf16x2v, b), acc, false); }
__device__ __forceinline__ int crow(int r, int hi) { return (r & 3) + 8 * (r >> 2) + 4 * hi; }
__device__ __forceinline__ void row_info(int r, int& b, int& t, int& isctx) {
  if (r < NLAT) { isctx = 0; b = r >> 13; t = r & (SEQ - 1); } else { isctx = 1; int q = r - NLAT; b = q >> 8; t = q & (CTXL - 1); }
}
__device__ __forceinline__ const float* xrow_src(const Params& p, int layer, int r) {
  if (layer == 0) return (r < NLAT) ? p.in[I_X] + (size_t)r * DM : p.in[I_CTX] + (size_t)(r - NLAT) * DM;
  return (const float*)(p.ws + OFF_XS) + (size_t)r * DM;
}
__device__ __forceinline__ size_t h2idx(int l, int pos, int j) { return (((size_t)l * 16 + (j >> 2)) * NKEYS + pos) * 4 + (j & 3); }
#define JOB_LOOP(t, ntiles, base) for (int t = (int)(((long)BIDX - ((base) % (long)gridDim.x) + gridDim.x) % gridDim.x); t < (ntiles); t += gridDim.x)

__device__ __forceinline__ int rope_slot(int c) { return (c & 16) | ((c & 7) << 1) | ((c >> 3) & 1); }
__device__ void transpose_cvt_job(const float* __restrict__ src, bf16_t* __restrict__ dst, int K, int N, int Npad, char* smem, long& base, int rp = 0) {
  float* tile = (float*)smem;
  const int tk = K / 64, tn = Npad / 64, nt = tk * tn;
  JOB_LOOP(t, nt, base) {
    const int k0 = (t % tk) * 64, n0 = (t / tk) * 64;
    __syncthreads();
    for (int e = TIDX; e < 1024; e += NTHREADS) {
      const int i = e >> 4, j = (e & 15) * 4, n = n0 + j;
      f32x4 v = {0.f, 0.f, 0.f, 0.f};
      if (n < N) v = *(const f32x4*)(src + (size_t)(k0 + i) * N + n);
      tile[j * 65 + i] = v[0]; tile[(j + 1) * 65 + i] = v[1]; tile[(j + 2) * 65 + i] = v[2]; tile[(j + 3) * 65 + i] = v[3];
    }
    __syncthreads();
    {
      const int e = TIDX, j = e >> 3, i8 = (e & 7) * 8;
      const float* tr = tile + j * 65 + i8;
      const u32x4 o = {cvtpk(tr[0], tr[1]), cvtpk(tr[2], tr[3]), cvtpk(tr[4], tr[5]), cvtpk(tr[6], tr[7])};
      int n = n0 + j;
      if (rp && n < N) { const int hh = n / 96, jj = n - hh * 96; if (jj >= 64) n = hh * 96 + 64 + rope_slot(jj - 64); }
      *(u32x4*)(dst + (size_t)n * K + k0 + i8) = o;
    }
  }
  base += nt;
}

__device__ void stage_prep(const Params& p, char* smem) {
  long base = 0;
  for (int l = 0; l < 2; ++l) {
    transpose_cvt_job(p.in[I_WIN] + (size_t)l * 1024 * DIN, (bf16_t*)(p.ws + OFF_WIN) + (size_t)l * DINP * 1024, 1024, DIN, DINP, smem, base);
    transpose_cvt_job(p.in[I_WOUT] + (size_t)l * 1024 * 1024, (bf16_t*)(p.ws + OFF_WOUT) + (size_t)l * 1024 * 1024, 1024, 1024, 1024, smem, base);
    transpose_cvt_job(p.in[I_WQB] + (size_t)l * 384 * 576, (bf16_t*)(p.ws + OFF_WQB) + (size_t)l * 768 * 384, 384, 576, 768, smem, base, 1);
    transpose_cvt_job(p.in[I_WKVB] + (size_t)l * 256 * 768, (bf16_t*)(p.ws + OFF_WKVB) + (size_t)l * 768 * 256, 256, 768, 768, smem, base);
    transpose_cvt_job(p.in[I_PWQ] + (size_t)l * 1024 * 2048, (bf16_t*)(p.ws + OFF_WPQ) + (size_t)l * 2048 * 1024, 1024, 2048, 2048, smem, base);
    for (int d = 0; d < 2; ++d) for (int n = 0; n < 6; ++n) {
      const size_t so = ((size_t)(l * 2 + d) * 6 + n) * 4096;
      transpose_cvt_job(p.in[I_LWR] + so, (bf16_t*)(p.ws + OFF_GW) + ((size_t)((l * 2 + d) * 2 + 0) * 6 + n) * 4096, 64, 64, 64, smem, base);
      transpose_cvt_job(p.in[I_LWI] + so, (bf16_t*)(p.ws + OFF_GW) + ((size_t)((l * 2 + d) * 2 + 1) * 6 + n) * 4096, 64, 64, 64, smem, base);
    }
  }
  {
    const float* src = p.in[I_PKEYS]; bf16_t* dst = (bf16_t*)(p.ws + OFF_KEYS);
    for (int e = BIDX * NTHREADS + TIDX; e < 2 * 2 * 128 * 128; e += gridDim.x * NTHREADS) dst[e] = f2bf(src[e]);
  }
  {
    float* modp = (float*)(p.ws + OFF_MODP);
    const float* cp = p.in[I_C]; const float* ccp = p.in[I_CCTX]; const float* wmod = p.in[I_WMOD];
    JOB_LOOP(it, 768, base) {
      const int l = it / 384, ks = (it % 384) / 12, cgp = it % 12;
      const int col = cgp * 512 + TIDX;
      const float* w = wmod + (size_t)l * 1024 * 6144 + (size_t)(ks * 32) * 6144 + col;
      float a0 = 0.f, a1 = 0.f, a2 = 0.f;
#pragma unroll
      for (int k0 = 0; k0 < 32; k0 += 8) {
        float wv[8];
#pragma unroll
        for (int j = 0; j < 8; ++j) wv[j] = w[(size_t)(k0 + j) * 6144];
#pragma unroll
        for (int j = 0; j < 8; ++j) {
          const int k = ks * 32 + k0 + j;
          const float c0 = cp[k], c1 = cp[1024 + k], c2 = ccp[k];
          a0 += c0 * sigm(c0) * wv[j]; a1 += c1 * sigm(c1) * wv[j]; a2 += c2 * sigm(c2) * wv[j];
        }
      }
      float* o = modp + ((size_t)(l * 32 + ks) * 3) * 6144 + col;
      o[0] = a0; o[6144] = a1; o[2 * 6144] = a2;
    }
    base += 768;
  }
  {
    const int lane = TIDX & 63, wid = TIDX >> 6;
    const float* hw1 = p.in[I_HW1]; const float* hb1 = p.in[I_HB1]; const float* hw2 = p.in[I_HW2]; const float* hb2 = p.in[I_HB2]; const float* hfr = p.in[I_HFREQ];
    constexpr float INV2PI = 0.15915494309189535f;
    for (int it = BIDX * 8 + wid; it < 2 * NKEYS / 4; it += gridDim.x * 8) {
      const int l = it / (NKEYS / 4), pos0 = (it % (NKEYS / 4)) * 4;
      const float* w1 = hw1 + (size_t)l * 17 * 64; const float* w2 = hw2 + (size_t)l * 64 * 64;
      const float fr = hfr[l * 64 + lane], b1v = hb1[l * 64 + lane], b2v = hb2[l * 64 + lane];
      float w1v[17];
#pragma unroll
      for (int i = 0; i < 17; ++i) w1v[i] = w1[i * 64 + lane];
      float h1[4], pre2[4];
#pragma unroll
      for (int j = 0; j < 4; ++j) {
        const int pos = pos0 + j;
        const float tn = (pos < SEQ) ? (float)pos / (float)SEQ : (float)(pos - SEQ) / (float)CTXL;
        float pre = b1v + tn * w1v[0];
#pragma unroll
        for (int i = 0; i < 8; ++i) {
          const float band = 1e-4f + (float)i * ((7.f - 1e-4f) / 7.f);
          const float rev = tn * band;
          pre += __builtin_amdgcn_cosf(rev) * w1v[1 + i] + __builtin_amdgcn_sinf(rev) * w1v[9 + i];
        }
        h1[j] = __builtin_amdgcn_sinf(fr * pre * INV2PI);
        pre2[j] = b2v;
      }
      for (int i = 0; i < 64; ++i) {
        const float wv = w2[i * 64 + lane];
#pragma unroll
        for (int j = 0; j < 4; ++j) pre2[j] += rdl(h1[j], i) * wv;
      }
#pragma unroll
      for (int j = 0; j < 4; ++j) ((float*)(p.ws + OFF_H2))[h2idx(l, pos0 + j, lane)] = __builtin_amdgcn_sinf(fr * pre2[j] * INV2PI);
    }
  }
}

struct cf { float x, y; };
__device__ __forceinline__ cf cmul(cf a, cf b) { return {a.x * b.x - a.y * b.y, a.x * b.y + a.y * b.x}; }
template <bool INV> __device__ __forceinline__ cf twid(float frac) {
  const float c = __builtin_amdgcn_cosf(frac), s = __builtin_amdgcn_sinf(frac); return {c, INV ? s : -s};
}
template <bool INV> __device__ __forceinline__ void r4(cf& a, cf& b, cf& c, cf& d) {
  const cf s0 = {a.x + c.x, a.y + c.y}, s1 = {a.x - c.x, a.y - c.y}, s2 = {b.x + d.x, b.y + d.y}, s3 = {b.x - d.x, b.y - d.y};
  a = {s0.x + s2.x, s0.y + s2.y}; c = {s0.x - s2.x, s0.y - s2.y};
  if (!INV) { b = {s1.x + s3.y, s1.y - s3.x}; d = {s1.x - s3.y, s1.y + s3.x}; }
  else      { b = {s1.x - s3.y, s1.y + s3.x}; d = {s1.x + s3.y, s1.y - s3.x}; }
}
template <bool INV> __device__ __forceinline__ cf cj(cf w) { return {w.x, INV ? -w.y : w.y}; }
template <bool INV> __device__ __forceinline__ void dft16(cf* x) {
#pragma unroll
  for (int m0 = 0; m0 < 4; ++m0) r4<INV>(x[m0], x[4 + m0], x[8 + m0], x[12 + m0]);
  const cf W1 = {0.92387953251128674f, -0.38268343236508977f}, W2 = {0.70710678118654752f, -0.70710678118654752f}, W3 = {0.38268343236508977f, -0.92387953251128674f};
  const cf W4 = {0.f, -1.f}, W6 = {-0.70710678118654752f, -0.70710678118654752f}, W9 = {-0.92387953251128674f, 0.38268343236508977f};
  x[5] = cmul(x[5], cj<INV>(W1)); x[6] = cmul(x[6], cj<INV>(W2)); x[7] = cmul(x[7], cj<INV>(W3));
  x[9] = cmul(x[9], cj<INV>(W2)); x[10] = cmul(x[10], cj<INV>(W4)); x[11] = cmul(x[11], cj<INV>(W6));
  x[13] = cmul(x[13], cj<INV>(W3)); x[14] = cmul(x[14], cj<INV>(W6)); x[15] = cmul(x[15], cj<INV>(W9));
#pragma unroll
  for (int q0 = 0; q0 < 4; ++q0) r4<INV>(x[4 * q0], x[4 * q0 + 1], x[4 * q0 + 2], x[4 * q0 + 3]);
}
template <bool INV> __device__ __forceinline__ void dft8(cf* x) {
#pragma unroll
  for (int m0 = 0; m0 < 4; ++m0) { const cf a = x[m0], b = x[4 + m0]; x[m0] = {a.x + b.x, a.y + b.y}; x[4 + m0] = {a.x - b.x, a.y - b.y}; }
  const cf V1 = {0.70710678118654752f, -0.70710678118654752f}, V2 = {0.f, -1.f}, V3 = {-0.70710678118654752f, -0.70710678118654752f};
  x[5] = cmul(x[5], cj<INV>(V1)); x[6] = cmul(x[6], cj<INV>(V2)); x[7] = cmul(x[7], cj<INV>(V3));
  r4<INV>(x[0], x[1], x[2], x[3]); r4<INV>(x[4], x[5], x[6], x[7]);
}
template <bool COL> __device__ __forceinline__ int fidx(int ln, int i) { return COL ? i * 129 + ln : ln * 129 + i; }
template <bool INV, bool COL> __device__ __forceinline__ void fft_passA(cf* buf) {
  for (int it = 0; it < 2; ++it) {
    const int bf = TIDX + NTHREADS * it, ln = bf & 127, j = bf >> 7;
    cf x[16];
    if (!INV) {
#pragma unroll
      for (int m = 0; m < 16; ++m) x[m] = buf[fidx<COL>(ln, j + 8 * m)];
      dft16<false>(x);
#pragma unroll
      for (int q = 0; q < 16; ++q) buf[fidx<COL>(ln, j + 8 * q)] = cmul(x[4 * (q & 3) + (q >> 2)], twid<false>((float)(q * j) * (1.f / 128.f)));
    } else {
#pragma unroll
      for (int q = 0; q < 16; ++q) x[q] = cmul(buf[fidx<COL>(ln, j + 8 * q)], twid<true>((float)(q * j) * (1.f / 128.f)));
      dft16<true>(x);
#pragma unroll
      for (int m = 0; m < 16; ++m) buf[fidx<COL>(ln, j + 8 * m)] = x[4 * (m & 3) + (m >> 2)];
    }
  }
}
template <bool INV, bool COL> __device__ __forceinline__ void fft_passB(cf* buf) {
  for (int it = 0; it < 4; ++it) {
    const int bf = TIDX + NTHREADS * it, ln = bf & 127, B = bf >> 7;
    cf x[8];
    if (!INV) {
#pragma unroll
      for (int m = 0; m < 8; ++m) x[m] = buf[fidx<COL>(ln, 8 * B + m)];
      dft8<false>(x);
#pragma unroll
      for (int q = 0; q < 8; ++q) {
        cf v = x[4 * (q & 1) + (q >> 1)];
        if (COL) v = cmul(v, twid<false>((float)(ln * (B + 16 * q)) * (1.f / 16384.f)));
        buf[fidx<COL>(ln, 8 * B + q)] = v;
      }
    } else {
#pragma unroll
      for (int q = 0; q < 8; ++q) {
        cf v = buf[fidx<COL>(ln, 8 * B + q)];
        if (COL) v = cmul(v, twid<true>((float)(ln * (B + 16 * q)) * (1.f / 16384.f)));
        x[q] = v;
      }
      dft8<true>(x);
#pragma unroll
      for (int m = 0; m < 8; ++m) buf[fidx<COL>(ln, 8 * B + m)] = x[4 * (m & 1) + (m >> 1)];
    }
  }
}
__device__ __forceinline__ void fft_fwd(cf* buf) {
  fft_passA<false, true>(buf); __syncthreads(); fft_passB<false, true>(buf); __syncthreads();
  fft_passA<false, false>(buf); __syncthreads(); fft_passB<false, false>(buf); __syncthreads();
}
__device__ __forceinline__ void fft_inv(cf* buf) {
  fft_passB<true, false>(buf); __syncthreads(); fft_passA<true, false>(buf); __syncthreads();
  fft_passB<true, true>(buf); __syncthreads(); fft_passA<true, true>(buf); __syncthreads();
}
__device__ __forceinline__ int fft_freq(int r, int c) { return ((r >> 3) + 16 * (r & 7)) + 128 * ((c >> 3) + 16 * (c & 7)); }
__device__ __forceinline__ int fft_pos(int k) {
  const int k1 = k & 127, k2 = k >> 7; return (8 * (k1 & 15) + (k1 >> 4)) * 129 + 8 * (k2 & 15) + (k2 >> 4);
}
constexpr int FFT_LDS = 128 * 129 * 8;

__device__ void hyena_spectra(const Params& p, char* smem) {
  cf* buf = (cf*)smem; float* fb = (float*)smem;
  float* w3s = (float*)(smem + FFT_LDS);
  float* red = w3s + 256;
  const int tid = TIDX, lane = tid & 63, wid = tid >> 6;
  for (int unit = BIDX; unit < 512; unit += gridDim.x) {
    const int l = unit >> 8, c = unit & 255;
    __syncthreads();
    if (tid < 256) { const int i = tid >> 2, j = tid & 3; w3s[tid] = p.in[I_HW3][(size_t)l * 64 * 1024 + (size_t)i * 1024 + j * 256 + c]; }
    if (tid == 0) buf[64 * 129] = cf{0.f, 0.f};
    __syncthreads();
    float dec[4], ss[4];
#pragma unroll
    for (int j = 0; j < 4; ++j) { dec[j] = p.in[I_HDECAY][l * 1024 + j * 256 + c]; ss[j] = 0.f; }
    const float* h2 = (const float*)(p.ws + OFF_H2) + (size_t)l * 16 * NKEYS * 4;
#pragma unroll 1
    for (int i = 0; i < 16; ++i) {
      const int t = tid + NTHREADS * i;
      float a[4] = {0.f, 0.f, 0.f, 0.f};
      const f32x4* hr = (const f32x4*)(h2 + (size_t)t * 4);
#pragma unroll
      for (int kh = 0; kh < 2; ++kh) {
        f32x4 hv8[8];
#pragma unroll
        for (int k4 = 0; k4 < 8; ++k4) hv8[k4] = hr[(size_t)(kh * 8 + k4) * NKEYS];
#pragma unroll
        for (int k4 = 0; k4 < 8; ++k4) {
          const f32x4 hv = hv8[k4];
#pragma unroll
          for (int kk = 0; kk < 4; ++kk) {
            const f32x4 wv = *(const f32x4*)(w3s + ((kh * 8 + k4) * 4 + kk) * 4);
            a[0] += hv[kk] * wv[0]; a[1] += hv[kk] * wv[1]; a[2] += hv[kk] * wv[2]; a[3] += hv[kk] * wv[3];
          }
        }
      }
      const float tn = (float)t * (1.f / (float)SEQ);
#pragma unroll
      for (int j = 0; j < 4; ++j) { a[j] *= __expf(-tn * dec[j]); ss[j] += a[j] * a[j]; }
      const int pf = (t >> 7) * 129 + (t & 127);
      fb[2 * pf] = a[0]; fb[2 * pf + 1] = a[2];
      if (t > 0) { const int n = 16384 - t, pb = (n >> 7) * 129 + (n & 127); fb[2 * pb] = a[1]; fb[2 * pb + 1] = a[3]; }
    }
#pragma unroll
    for (int j = 0; j < 4; ++j) { ss[j] = wave_sum(ss[j]); if (lane == 0) red[wid * 4 + j] = ss[j]; }
    __syncthreads();
    float sc[4];
#pragma unroll
    for (int j = 0; j < 4; ++j) { float s = 0.f; for (int w = 0; w < 8; ++w) s += red[w * 4 + j]; sc[j] = rsqrtf(s + EPSV) * (1.f / 16384.f); }
    const float sk0 = p.in[I_HSKIP][l * 512 + c] * (1.f / 16384.f), sk1 = p.in[I_HSKIP][l * 512 + 256 + c] * (1.f / 16384.f);
    for (int i = 0; i < 32; ++i) {
      const int n = tid + NTHREADS * i, pi = (n >> 7) * 129 + (n & 127);
      cf v = buf[pi];
      if (n < 8192) { v.x *= sc[0]; v.y *= sc[2]; } else { v.x *= sc[1]; v.y *= sc[3]; }
      if (n == 0) { v.x += sk0; v.y += sk1; }
      buf[pi] = v;
    }
    __syncthreads();
    fft_fwd(buf);
    unsigned* hs = (unsigned*)(p.ws + OFF_HSPEC) + ((size_t)(l * 256 + c) * 2) * 16384;
    for (int i = 0; i < 32; ++i) {
      const int e = tid + NTHREADS * i, r = e >> 7, cc = e & 127;
      const int k = fft_freq(r, cc), k2 = (16384 - k) & 16383;
      const cf a = buf[r * 129 + cc], b = buf[fft_pos(k2)];
      hs[e] = cvtpk(0.5f * (a.x + b.x), 0.5f * (a.y - b.y));
      hs[16384 + e] = cvtpk(0.5f * (a.y + b.y), -0.5f * (a.x - b.x));
    }
  }
}

__device__ void hyena_fft(const Params& p, int layer, char* smem) {
  cf* buf = (cf*)smem;
  const int tid = TIDX;
  bf16_t* mix = (bf16_t*)(p.ws + OFF_MIX);
  const float* hin = (const float*)(p.ws + OFF_HYIN);
  for (int unit = (int)gridDim.x - 1 - BIDX; unit < 256; unit += gridDim.x) {
    const int c = unit;
    const unsigned* hs = (const unsigned*)(p.ws + OFF_HSPEC) + ((size_t)(layer * 256 + c) * 2) * 16384;
    __syncthreads();
    {
      const float* z0 = hin + ((size_t)(0 * 2 + 0) * 256 + c) * SEQ; const float* z1 = hin + ((size_t)(0 * 2 + 1) * 256 + c) * SEQ;
      for (int i = 0; i < 16; ++i) { const int t = tid + NTHREADS * i; buf[(t >> 7) * 129 + (t & 127)] = cf{z0[t], z1[t]}; }
      for (int i = 0; i < 16; ++i) { const int t = 8192 + tid + NTHREADS * i; buf[(t >> 7) * 129 + (t & 127)] = cf{0.f, 0.f}; }
    }
    __syncthreads();
    for (int order = 0; order < 2; ++order) {
      fft_fwd(buf);
      for (int i = 0; i < 32; ++i) {
        const int e = tid + NTHREADS * i, pi = (e >> 7) * 129 + (e & 127);
        const unsigned hv = hs[order * 16384 + e];
        const cf h = {__uint_as_float(hv << 16), __uint_as_float(hv & 0xffff0000u)};
        buf[pi] = cmul(buf[pi], h);
      }
      __syncthreads();
      fft_inv(buf);
      const float* x0 = hin + ((size_t)((1 + order) * 2 + 0) * 256 + c) * SEQ; const float* x1 = hin + ((size_t)((1 + order) * 2 + 1) * 256 + c) * SEQ;
      if (order == 0) {
        for (int i = 0; i < 16; ++i) { const int t = tid + NTHREADS * i, pi = (t >> 7) * 129 + (t & 127); const cf v = buf[pi]; buf[pi] = cf{v.x * x0[t], v.y * x1[t]}; }
        for (int i = 0; i < 16; ++i) { const int t = 8192 + tid + NTHREADS * i; buf[(t >> 7) * 129 + (t & 127)] = cf{0.f, 0.f}; }
        __syncthreads();
      } else {
        bf16_t* yc = (bf16_t*)(p.ws + OFF_HB);
        for (int i = 0; i < 8; ++i) {
          const int t = 2 * (tid + NTHREADS * i); const cf v0 = buf[(t >> 7) * 129 + (t & 127)], v1 = buf[(t >> 7) * 129 + (t & 127) + 1];
          *(unsigned*)(yc + ((size_t)(0 * 256 + c)) * SEQ + t) = cvtpk(v0.x * x0[t], v1.x * x0[t + 1]);
          *(unsigned*)(yc + ((size_t)(1 * 256 + c)) * SEQ + t) = cvtpk(v0.y * x1[t], v1.y * x1[t + 1]);
        }
      }
    }
  }
}

__device__ void stage_prep2(const Params& p, char* smem) {
  {
    float* mod = (float*)(p.ws + OFF_MOD); const float* modp = (const float*)(p.ws + OFF_MODP);
    for (int e = BIDX * NTHREADS + TIDX; e < 2 * 3 * 6144; e += gridDim.x * NTHREADS) {
      const int l = e / (3 * 6144), w = (e / 6144) % 3, col = e % 6144;
      float s = p.in[I_BMOD][l * 6144 + col];
      for (int ks = 0; ks < 32; ++ks) s += modp[((size_t)(l * 32 + ks) * 3 + w) * 6144 + col];
      mod[e] = s;
    }
  }
  float* h2t = (float*)smem;
  float* w3t = h2t + 64 * 65;
  const int tloc = TIDX & 63, cgp = TIDX >> 6, lane = TIDX & 63;
  for (int it = BIDX; it < 2 * 4 * 16; it += gridDim.x) {
    const int l = it / (4 * 16), tt = 128 + (it / 16) % 4, ct = it % 16;
    const bool isc = tt >= 128; const int L = isc ? CTXL : SEQ; const int t0 = isc ? (tt - 128) * 64 : tt * 64;
    const int pos0 = isc ? SEQ + t0 : t0;
    const float* h2 = (const float*)(p.ws + OFF_H2);
    const float* w3 = p.in[I_HW3] + (size_t)l * 64 * 1024 + ct * 64;
    __syncthreads();
    for (int e = TIDX; e < 4096; e += NTHREADS) { int i = e >> 6, j = e & 63; h2t[i * 65 + j] = h2[h2idx(l, pos0 + i, j)]; w3t[i * 64 + j] = w3[(size_t)i * 1024 + j]; }
    __syncthreads();
    float acc[8];
#pragma unroll
    for (int cc = 0; cc < 8; ++cc) acc[cc] = 0.f;
#pragma unroll 2
    for (int i = 0; i < 64; ++i) {
      const float hv = h2t[tloc * 65 + i];
#pragma unroll
      for (int cc = 0; cc < 8; ++cc) acc[cc] += hv * w3t[i * 64 + cgp * 8 + cc];
    }
    const float tn = (float)(t0 + tloc) / (float)L;
#pragma unroll
    for (int cc = 0; cc < 8; ++cc) {
      const int col = ct * 64 + cgp * 8 + cc;
      const float val = acc[cc] * __expf(-tn * p.in[I_HDECAY][l * 1024 + col]);
      ((float*)(p.ws + OFF_FILTC))[((size_t)l * 1024 + col) * CTXL + t0 + tloc] = val;
      const float s = wave_sum(val * val);
      if (lane == 0) ((float*)(p.ws + OFF_SSQPC))[((size_t)l * 4 + (tt - 128)) * 1024 + col] = s;
    }
  }
  hyena_spectra(p, smem);
}

__device__ void stage_norm(const Params& p, int layer, int which  , int nrows) {
  const int lane = TIDX & 63, wid = TIDX >> 6;
  const float* g = (which ? p.in[I_N2G] : p.in[I_N1G]) + layer * DM;
  bf16_t* hb = (bf16_t*)(p.ws + OFF_HB);
  const int ngrp = nrows / 4, gstride = gridDim.x * 8;
  int grp = BIDX * 8 + wid;
  f32x4 v[4][4], vn[4][4];
  auto rowsrc = [&](int r0) -> const float* { return (which == 0) ? xrow_src(p, layer, r0) : (const float*)(p.ws + OFF_XS) + (size_t)r0 * DM; };
  if (grp < ngrp) {
    const float* src = rowsrc(grp * 4);
#pragma unroll
    for (int j = 0; j < 4; ++j)
#pragma unroll
      for (int i = 0; i < 2; ++i) { v[j][2 * i] = *(const f32x4*)(src + (size_t)j * DM + i * 512 + lane * 8); v[j][2 * i + 1] = *(const f32x4*)(src + (size_t)j * DM + i * 512 + lane * 8 + 4); }
  }
  for (; grp < ngrp; grp += gstride) {
    const int r0 = grp * 4, gn = grp + gstride;
    if (gn < ngrp) {
      const float* src = rowsrc(gn * 4);
#pragma unroll
      for (int j = 0; j < 4; ++j)
#pragma unroll
        for (int i = 0; i < 2; ++i) { vn[j][2 * i] = *(const f32x4*)(src + (size_t)j * DM + i * 512 + lane * 8); vn[j][2 * i + 1] = *(const f32x4*)(src + (size_t)j * DM + i * 512 + lane * 8 + 4); }
    }
    int b, t, isc; row_info(r0, b, t, isc);
    const float* mod = (const float*)(p.ws + OFF_MOD) + ((size_t)layer * 3 + (isc ? 2 : b)) * 6144 + (which ? 3072 : 0);
    float ss[4];
#pragma unroll
    for (int j = 0; j < 4; ++j) {
      float s = 0.f;
#pragma unroll
      for (int i = 0; i < 4; ++i) s += v[j][i][0] * v[j][i][0] + v[j][i][1] * v[j][i][1] + v[j][i][2] * v[j][i][2] + v[j][i][3] * v[j][i][3];
      ss[j] = s;
    }
#pragma unroll
    for (int j = 0; j < 4; ++j) ss[j] = rsqrtf(wave_sum(ss[j]) * (1.f / DM) + EPSV);
#pragma unroll
    for (int i = 0; i < 2; ++i) {
      const int c0 = i * 512 + lane * 8;
      const f32x4 g0 = *(const f32x4*)(g + c0), g1 = *(const f32x4*)(g + c0 + 4);
      const f32x4 sc0 = *(const f32x4*)(mod + 1024 + c0), sc1 = *(const f32x4*)(mod + 1024 + c0 + 4), sh0 = *(const f32x4*)(mod + c0), sh1 = *(const f32x4*)(mod + c0 + 4);
#pragma unroll
      for (int j = 0; j < 4; ++j) {
        float y[8];
#pragma unroll
        for (int q = 0; q < 4; ++q) { y[q] = v[j][2 * i][q] * ss[j] * g0[q] * (1.f + sc0[q]) + sh0[q]; y[4 + q] = v[j][2 * i + 1][q] * ss[j] * g1[q] * (1.f + sc1[q]) + sh1[q]; }
        const u32x4 o = {cvtpk(y[0], y[1]), cvtpk(y[2], y[3]), cvtpk(y[4], y[5]), cvtpk(y[6], y[7])};
        *(u32x4*)(hb + (size_t)(r0 + j) * DM + c0) = o;
      }
    }
#pragma unroll
    for (int j = 0; j < 4; ++j)
#pragma unroll
      for (int i = 0; i < 4; ++i) v[j][i] = vn[j][i];
  }
}

template <class Epi>
__device__ void gemm_bt(const bf16_t* __restrict__ A, int lda, const bf16_t* __restrict__ Bt, int ldb, int M, int N, int K, Epi epi, char* smem) {
  const int tid = TIDX, wid = tid >> 6, lane = tid & 63, r32 = lane & 31, hi = lane >> 5;
  const int wm = wid >> 2, wn = wid & 3;
  constexpr int RS = 144;
  char* sA = smem; char* sB = smem + 128 * RS;
  const int tilesM = M / 128, tilesN = N / 128, nk = K / 64;
  const int lr0 = tid >> 3, lc = (tid & 7) * 8;
  for (int tile = BIDX; tile < tilesM * tilesN; tile += gridDim.x) {
    const int tm = tile / tilesN, tn = tile % tilesN;
    const bf16_t* Ap = A + (size_t)(tm * 128 + lr0) * lda + lc;
    const bf16_t* Bp = Bt + (size_t)(tn * 128 + lr0) * ldb + lc;
    f32x16 acc0 = {}, acc1 = {};
    u32x4 ra0 = *(const u32x4*)Ap, ra1 = *(const u32x4*)(Ap + (size_t)64 * lda);
    u32x4 rb0 = *(const u32x4*)Bp, rb1 = *(const u32x4*)(Bp + (size_t)64 * ldb);
    for (int kt = 0; kt < nk; ++kt) {
      __syncthreads();
      *(u32x4*)(sA + lr0 * RS + lc * 2) = ra0; *(u32x4*)(sA + (lr0 + 64) * RS + lc * 2) = ra1;
      *(u32x4*)(sB + lr0 * RS + lc * 2) = rb0; *(u32x4*)(sB + (lr0 + 64) * RS + lc * 2) = rb1;
      __syncthreads();
      if (kt + 1 < nk) {
        const int ko = (kt + 1) * 64;
        ra0 = *(const u32x4*)(Ap + ko); ra1 = *(const u32x4*)(Ap + (size_t)64 * lda + ko);
        rb0 = *(const u32x4*)(Bp + ko); rb1 = *(const u32x4*)(Bp + (size_t)64 * ldb + ko);
      }
#pragma unroll
      for (int ks = 0; ks < 4; ++ks) {
        const int cb = (ks * 16 + hi * 8) * 2;
        const bf16x8 a0 = *(const bf16x8*)(sA + (wm * 64 + r32) * RS + cb);
        const bf16x8 a1 = *(const bf16x8*)(sA + (wm * 64 + 32 + r32) * RS + cb);
        const bf16x8 bb = *(const bf16x8*)(sB + (wn * 32 + r32) * RS + cb);
        acc0 = __builtin_amdgcn_mfma_f32_32x32x16_bf16(a0, bb, acc0, 0, 0, 0);
        acc1 = __builtin_amdgcn_mfma_f32_32x32x16_bf16(a1, bb, acc1, 0, 0, 0);
      }
    }
    const int col = tn * 128 + wn * 32 + r32;
#pragma unroll
    for (int r = 0; r < 16; ++r) {
      epi(tm * 128 + wm * 64 + crow(r, hi), col, acc0[r]);
      epi(tm * 128 + wm * 64 + 32 + crow(r, hi), col, acc1[r]);
    }
  }
}

__device__ __forceinline__ float rope_apply(float x, float xp, int c, int t) {
  const int i = c & 7; const float pos = ((c >> 4) & 1) ? (float)(t & 63) : (float)(t >> 6);
  const float inv = __expf(-(float)i * (9.210340371976184f / 8.f));
  const float rev = (pos * inv) * 0.15915494309189535f;
  const float cs = __builtin_amdgcn_cosf(rev), sn = __builtin_amdgcn_sinf(rev);
  return x * cs + ((c & 8) ? xp : -xp) * sn;
}

constexpr int NCH32 = NTOK / 32;
__device__ __forceinline__ float swap32(float v, int hi) { const auto rr = __builtin_amdgcn_permlane32_swap(__float_as_uint(v), __float_as_uint(v), false, false); return __uint_as_float(hi ? rr[0] : rr[1]); }
template <bool BWD>
__device__ __forceinline__ void lru_seg_scan(const float* a, const float* b, int hi, float S, float* h, float& Sout) {
  float P[4], H[4], Sin[4];
#pragma unroll
  for (int g = 0; g < 4; ++g) {
    if (!BWD) { H[g] = b[4 * g]; P[g] = a[4 * g];
#pragma unroll
      for (int q = 1; q < 4; ++q) { H[g] = a[4 * g + q] * H[g] + b[4 * g + q]; P[g] *= a[4 * g + q]; } }
    else { H[g] = b[4 * g + 3]; P[g] = a[4 * g + 3];
#pragma unroll
      for (int q = 2; q >= 0; --q) { H[g] = a[4 * g + q] * H[g] + b[4 * g + q]; P[g] *= a[4 * g + q]; } }
    Sin[g] = 0.f;
  }
#pragma unroll
  for (int step = 0; step < 8; ++step) {
    const int s = BWD ? 7 - step : step, g = s >> 1, owner = s & 1;
    const bool mine = (hi == owner);
    if (mine) Sin[g] = S;
    const float cand = P[g] * S + H[g];
    const float other = swap32(cand, hi);
    S = mine ? cand : other;
  }
  Sout = S;
#pragma unroll
  for (int g = 0; g < 4; ++g) {
    float hp = Sin[g];
    if (!BWD) {
#pragma unroll
      for (int q = 0; q < 4; ++q) { hp = a[4 * g + q] * hp + b[4 * g + q]; h[4 * g + q] = hp; } }
    else {
#pragma unroll
      for (int q = 3; q >= 0; --q) { hp = a[4 * g + q] * hp + b[4 * g + q]; h[4 * g + q] = hp; } }
  }
}
__device__ void lru_units(const Params& p, int layer, int mode, char* smem) {
  const int tid = TIDX, wid = tid >> 6, lane = tid & 63, r32 = lane & 31, hi = lane >> 5;
  const bf16_t* u = (const bf16_t*)(p.ws + OFF_U);
  const float* cw = p.in[I_LCW] + (size_t)layer * 4 * DLRU; const float* cbias = p.in[I_LCB] + layer * DLRU;
  bf16_t* mix = (bf16_t*)(p.ws + OFF_MIX);
  constexpr int RS = 272;
  char* tile = smem + wid * (35 * RS);
  const int bid = BIDX, n = bid % 6, rk = bid / 6, nbn = ((int)gridDim.x - n + 5) / 6;
  char* gwl = smem + 8 * 35 * RS;
  __syncthreads();
  for (int i = tid; i < 2048; i += NTHREADS) {
    const int mat = i >> 9, row = (i >> 3) & 63, c = i & 7;
    const bf16_t* gsrc = (const bf16_t*)(p.ws + OFF_GW) + ((size_t)((layer * 2 + (mat >> 1)) * 2 + (mat & 1)) * 6 + n) * 4096 + row * 64 + c * 8;
    *(u32x4*)(gwl + mat * 8192 + row * 128 + ((c ^ (row & 7)) << 4)) = *(const u32x4*)gsrc;
  }
  __syncthreads();
  for (int cid = rk * 8 + wid; cid < NCH32; cid += nbn * 8) {
    const int unit = cid * 6 + n;
    int rbase, t0, slen;
    if (cid < 512) { const int b = cid >> 8; rbase = b * SEQ; t0 = (cid & 255) * 32; slen = SEQ; }
    else { const int q = cid - 512, b = q >> 3; rbase = NLAT + b * CTXL; t0 = (q & 7) * 32; slen = CTXL; }
    {
      const int row8 = lane >> 3, c8 = lane & 7;
      const bf16_t* ub = u + (size_t)rbase * DIN + n * 64 + c8 * 8;
#pragma unroll
      for (int i = 0; i < 5; ++i) {
        const int row = i * 8 + row8, t = t0 + row - 2;
        if (row < 35) {
          u32x4 v = {0u, 0u, 0u, 0u};
          if (t >= 0 && t < slen) v = *(const u32x4*)(ub + (size_t)t * DIN);
          const f32x4 lo = {__uint_as_float(v[0] << 16), __uint_as_float(v[0] & 0xffff0000u), __uint_as_float(v[1] << 16), __uint_as_float(v[1] & 0xffff0000u)};
          const f32x4 hi4 = {__uint_as_float(v[2] << 16), __uint_as_float(v[2] & 0xffff0000u), __uint_as_float(v[3] << 16), __uint_as_float(v[3] & 0xffff0000u)};
          *(f32x4*)(tile + row * RS + c8 * 32) = lo; *(f32x4*)(tile + row * RS + c8 * 32 + 16) = hi4;
        }
      }
    }
    bf16x8 af[4];
    {
      const char* tl = tile + r32 * RS + hi * 32;
#pragma unroll
      for (int ks = 0; ks < 4; ++ks) {
        const int col = n * 64 + ks * 16 + 8 * hi;
        f32x4 c0 = *(const f32x4*)(cbias + col), c1 = *(const f32x4*)(cbias + col + 4);
#pragma unroll
        for (int k = 0; k < 4; ++k) {
          const f32x4 x0 = *(const f32x4*)(tl + k * RS + ks * 64), x1 = *(const f32x4*)(tl + k * RS + ks * 64 + 16);
          const f32x4 w0 = *(const f32x4*)(cw + k * DLRU + col), w1 = *(const f32x4*)(cw + k * DLRU + col + 4);
          c0 += w0 * x0; c1 += w1 * x1;
        }
        const u32x4 pk = {cvtpk(c0[0], c0[1]), cvtpk(c0[2], c0[3]), cvtpk(c1[0], c1[1]), cvtpk(c1[2], c1[3])};
        af[ks] = *(const bf16x8*)&pk;
      }
    }
    float xo[2][16];
#pragma unroll
    for (int nt = 0; nt < 2; ++nt) {
      const int ch = n * 64 + nt * 32 + r32;
      const float w0 = cw[ch], w1 = cw[DLRU + ch], w2 = cw[2 * DLRU + ch], w3 = cw[3 * DLRU + ch], bb = cbias[ch];
      const char* tl = tile + (4 * hi) * RS + (nt * 32 + r32) * 4;
#pragma unroll
      for (int g = 0; g < 4; ++g) {
        float xr[7];
#pragma unroll
        for (int i = 0; i < 7; ++i) xr[i] = *(const float*)(tl + (8 * g + i) * RS);
#pragma unroll
        for (int q = 0; q < 4; ++q) xo[nt][4 * g + q] = bb + w0 * xr[q] + w1 * xr[q + 1] + w2 * xr[q + 2] + w3 * xr[q + 3];
      }
    }
    if (mode == 1) {
      const bf16_t* ub = u + (size_t)(rbase + t0) * DIN + DLRU + n * 64 + lane;
#pragma unroll 4
      for (int i = 0; i < 32; ++i) *(float*)(tile + i * RS + lane * 4) = bf2f(ub[(size_t)i * DIN]);
    }
#pragma unroll 1
    for (int nt = 0; nt < 2; ++nt) {
      const int ch = n * 64 + nt * 32 + r32;
      float hf[16];
#pragma unroll
      for (int dir = 0; dir < 2; ++dir) {
        const char* gwr = gwl + (dir * 2 + 0) * 8192 + (nt * 32 + r32) * 128;
        const char* gwi = gwl + (dir * 2 + 1) * 8192 + (nt * 32 + r32) * 128;
        f32x16 accR = {}, accI = {};
#pragma unroll
        for (int ks = 0; ks < 4; ++ks) {
          const int co = ((ks * 2 + hi) ^ (r32 & 7)) << 4;
          const bf16x8 br_ = *(const bf16x8*)(gwr + co), bi_ = *(const bf16x8*)(gwi + co);
          accR = __builtin_amdgcn_mfma_f32_32x32x16_bf16(af[ks], br_, accR, 0, 0, 0);
          accI = __builtin_amdgcn_mfma_f32_32x32x16_bf16(af[ks], bi_, accI, 0, 0, 0);
        }
        const size_t po = (size_t)(layer * 2 + dir) * DLRU + ch;
        const float brv = p.in[I_LBR][po], biv = p.in[I_LBI][po];
        const float cl = -8.f * __logf(1.f + __expf(-p.in[I_LLAM][po]));
        float a[16], bq[16];
#pragma unroll
        for (int r = 0; r < 16; ++r) {
          const float rr = __builtin_amdgcn_rcpf(1.f + __expf(-(accR[r] + brv))), ii = __builtin_amdgcn_rcpf(1.f + __expf(-(accI[r] + biv)));
          const float av = __expf(rr * cl);
          a[r] = av; bq[r] = __builtin_amdgcn_sqrtf(fmaxf(1.f - av * av, 0.f)) * (ii * (nt == 0 ? xo[0][r] : xo[1][r]));
        }
        if (mode == 0) {
          {
            u32x4* ab = (u32x4*)(p.ws + OFF_LAB) + ((((size_t)unit * 2 + nt) * 2 + dir) * 4) * 64 + lane;
#pragma unroll
            for (int r4 = 0; r4 < 4; ++r4) { const u32x4 o = {cvtpk(1.f - a[4 * r4], bq[4 * r4]), cvtpk(1.f - a[4 * r4 + 1], bq[4 * r4 + 1]), cvtpk(1.f - a[4 * r4 + 2], bq[4 * r4 + 2]), cvtpk(1.f - a[4 * r4 + 3], bq[4 * r4 + 3])}; ab[r4 * 64] = o; }
          }
          float hd[16], Send;
          if (dir == 0) lru_seg_scan<false>(a, bq, hi, 0.f, hd, Send); else lru_seg_scan<true>(a, bq, hi, 0.f, hd, Send);
          float pp = a[0];
#pragma unroll
          for (int r = 1; r < 16; ++r) pp *= a[r];
          pp *= swap32(pp, hi);
          if (hi == 0) { float* ls = (float*)(p.ws + OFF_LSUM) + ((size_t)(cid * 2 + dir) * 2) * DLRU + ch; ls[0] = pp; ls[DLRU] = Send; }
        } else {
          const float cin = ((const float*)(p.ws + OFF_CARRY))[(size_t)(cid * 2 + dir) * DLRU + ch];
          float Send;
          if (dir == 0) lru_seg_scan<false>(a, bq, hi, cin, hf, Send);
          else {
            float hb[16];
            lru_seg_scan<true>(a, bq, hi, cin, hb, Send);
            const char* tl = tile + (4 * hi) * RS + (nt * 32 + r32) * 4;
            bf16_t* mo = mix + ((size_t)rbase + t0 + 4 * hi) * DM + ch;
#pragma unroll
            for (int r = 0; r < 16; ++r) {
              const int tk = (r & 3) + 8 * (r >> 2);
              const float gt = *(const float*)(tl + tk * RS);
              mo[(size_t)tk * DM] = f2bf((hf[r] + hb[r]) * gelu_tanh(gt));
            }
          }
        }
      }
    }
  }
}

__device__ void lru_final(const Params& p, int layer, char* smem) {
  const int tid = TIDX, wid = tid >> 6, lane = tid & 63, r32 = lane & 31, hi = lane >> 5;
  const bf16_t* u = (const bf16_t*)(p.ws + OFF_U);
  bf16_t* mix = (bf16_t*)(p.ws + OFF_MIX);
  constexpr int RS = 272;
  char* tile = smem + wid * (35 * RS);
  __syncthreads();
  for (int unit = BIDX * 8 + wid; unit < NCH32 * 6; unit += gridDim.x * 8) {
    const int cid = unit / 6, n = unit % 6;
    int rbase, t0;
    if (cid < 512) { const int b = cid >> 8; rbase = b * SEQ; t0 = (cid & 255) * 32; }
    else { const int q = cid - 512, b = q >> 3; rbase = NLAT + b * CTXL; t0 = (q & 7) * 32; }
    unsigned ab[2][2][16];
#pragma unroll
    for (int nt = 0; nt < 2; ++nt)
#pragma unroll
      for (int dir = 0; dir < 2; ++dir) {
        const u32x4* abp = (const u32x4*)(p.ws + OFF_LAB) + ((((size_t)unit * 2 + nt) * 2 + dir) * 4) * 64 + lane;
#pragma unroll
        for (int r4 = 0; r4 < 4; ++r4) { const u32x4 v = abp[r4 * 64]; ab[nt][dir][4 * r4] = v[0]; ab[nt][dir][4 * r4 + 1] = v[1]; ab[nt][dir][4 * r4 + 2] = v[2]; ab[nt][dir][4 * r4 + 3] = v[3]; }
      }
    {
      const int row8 = lane >> 3, c8 = lane & 7;
      const bf16_t* ub = u + (size_t)(rbase + t0) * DIN + DLRU + n * 64 + c8 * 8;
#pragma unroll
      for (int i = 0; i < 4; ++i) {
        const int row = i * 8 + row8;
        const u32x4 v = *(const u32x4*)(ub + (size_t)row * DIN);
        const f32x4 lo = {__uint_as_float(v[0] << 16), __uint_as_float(v[0] & 0xffff0000u), __uint_as_float(v[1] << 16), __uint_as_float(v[1] & 0xffff0000u)};
        const f32x4 hi4 = {__uint_as_float(v[2] << 16), __uint_as_float(v[2] & 0xffff0000u), __uint_as_float(v[3] << 16), __uint_as_float(v[3] & 0xffff0000u)};
        *(f32x4*)(tile + row * RS + c8 * 32) = lo; *(f32x4*)(tile + row * RS + c8 * 32 + 16) = hi4;
      }
    }
#pragma unroll
    for (int nt = 0; nt < 2; ++nt) {
      const int ch = n * 64 + nt * 32 + r32;
      float hf[16], hb[16], a[16], bq[16], Send;
#pragma unroll
      for (int r = 0; r < 16; ++r) { a[r] = 1.f - __uint_as_float(ab[nt][0][r] << 16); bq[r] = __uint_as_float(ab[nt][0][r] & 0xffff0000u); }
      lru_seg_scan<false>(a, bq, hi, ((const float*)(p.ws + OFF_CARRY))[(size_t)(cid * 2 + 0) * DLRU + ch], hf, Send);
#pragma unroll
      for (int r = 0; r < 16; ++r) { a[r] = 1.f - __uint_as_float(ab[nt][1][r] << 16); bq[r] = __uint_as_float(ab[nt][1][r] & 0xffff0000u); }
      lru_seg_scan<true>(a, bq, hi, ((const float*)(p.ws + OFF_CARRY))[(size_t)(cid * 2 + 1) * DLRU + ch], hb, Send);
      const char* tl = tile + (4 * hi) * RS + (nt * 32 + r32) * 4;
      bf16_t* mo = mix + ((size_t)rbase + t0 + 4 * hi) * DM + ch;
#pragma unroll
      for (int r = 0; r < 16; ++r) {
        const int tk = (r & 3) + 8 * (r >> 2);
        const float gt = *(const float*)(tl + tk * RS);
        mo[(size_t)tk * DM] = f2bf((hf[r] + hb[r]) * gelu_tanh(gt));
      }
    }
  }
}

__device__ void lru_carry(const Params& p, char* smem) {
  const int tid = TIDX, seg = tid >> 6, c = tid & 63;
  const float* __restrict__ ls = (const float*)(p.ws + OFF_LSUM); float* __restrict__ cr = (float*)(p.ws + OFF_CARRY);
  float* comp = (float*)smem;
  for (int item = BIDX; item < 2 * 2 * 6; item += gridDim.x) {
    const int b = item / 12, dir = (item / 6) & 1, ch = (item % 6) * 64 + c;
    float P[33], H[33];
#pragma unroll
    for (int i = 0; i < 33; ++i) {
      const int k = seg * 33 + i;
      int cid;
      if (dir == 0) cid = (k < 8) ? 512 + b * 8 + k : b * 256 + (k - 8);
      else          cid = (k < 8) ? 512 + b * 8 + (7 - k) : b * 256 + (255 - (k - 8));
      P[i] = ls[((size_t)(cid * 2 + dir) * 2) * DLRU + ch]; H[i] = ls[((size_t)(cid * 2 + dir) * 2 + 1) * DLRU + ch];
    }
    float pc = 1.f, hc = 0.f;
#pragma unroll
    for (int i = 0; i < 33; ++i) { hc = P[i] * hc + H[i]; pc *= P[i]; }
    __syncthreads();
    comp[(seg * 2) * 64 + c] = pc; comp[(seg * 2 + 1) * 64 + c] = hc;
    __syncthreads();
    float st = 0.f;
    for (int s = 0; s < seg; ++s) st = comp[(s * 2) * 64 + c] * st + comp[(s * 2 + 1) * 64 + c];
#pragma unroll
    for (int i = 0; i < 33; ++i) {
      const int k = seg * 33 + i;
      int cid;
      if (dir == 0) cid = (k < 8) ? 512 + b * 8 + k : b * 256 + (k - 8);
      else          cid = (k < 8) ? 512 + b * 8 + (7 - k) : b * 256 + (255 - (k - 8));
      cr[(size_t)(cid * 2 + dir) * DLRU + ch] = st;
      st = P[i] * st + H[i];
    }
  }
}

__device__ void mla_prep(const Params& p, int layer) {
  const int lane = TIDX & 63, wid = TIDX >> 6;
  const bf16_t* u = (const bf16_t*)(p.ws + OFF_U);
  const float* qg = p.in[I_QNG] + layer * 384; const float* kvg = p.in[I_KVNG] + layer * 256;
  bf16_t* qn = (bf16_t*)(p.ws + OFF_QN); bf16_t* kvn = (bf16_t*)(p.ws + OFF_KVN); bf16_t* Kb = (bf16_t*)(p.ws + OFF_K);
  const bool qact = lane < 48, kact = lane < 32;
  f32x4 qg0 = {0.f, 0.f, 0.f, 0.f}, qg1 = qg0, kg0 = qg0, kg1 = qg0;
  if (qact) { qg0 = *(const f32x4*)(qg + lane * 8); qg1 = *(const f32x4*)(qg + lane * 8 + 4); }
  if (kact) { kg0 = *(const f32x4*)(kvg + lane * 8); kg1 = *(const f32x4*)(kvg + lane * 8 + 4); }
  for (int grp = BIDX * 8 + wid; grp < NTOK / 4; grp += gridDim.x * 8) {
    const int r0 = grp * 4;
    u32x4 qv[4], kv[4]; float kr[4];
#pragma unroll
    for (int j = 0; j < 4; ++j) {
      const bf16_t* ur = u + (size_t)(r0 + j) * DIN;
      qv[j] = u32x4{0u, 0u, 0u, 0u}; kv[j] = u32x4{0u, 0u, 0u, 0u};
      if (qact) qv[j] = *(const u32x4*)(ur + 768 + lane * 8);
      if (kact) kv[j] = *(const u32x4*)(ur + 1152 + lane * 8);
      kr[j] = bf2f(ur[1408 + (lane & 31)]);
    }
#pragma unroll
    for (int j = 0; j < 4; ++j) {
      const int r = r0 + j;
      int b, t, isc; row_info(r, b, t, isc);
      float q[8], k[8], ss = 0.f;
#pragma unroll
      for (int i = 0; i < 4; ++i) { q[2 * i] = __uint_as_float(qv[j][i] << 16); q[2 * i + 1] = __uint_as_float(qv[j][i] & 0xffff0000u); ss += q[2 * i] * q[2 * i] + q[2 * i + 1] * q[2 * i + 1]; }
      float rinv = rsqrtf(wave_sum(ss) * (1.f / 384.f) + EPSV);
      if (qact) {
        const u32x4 o = {cvtpk(q[0] * rinv * qg0[0], q[1] * rinv * qg0[1]), cvtpk(q[2] * rinv * qg0[2], q[3] * rinv * qg0[3]),
                         cvtpk(q[4] * rinv * qg1[0], q[5] * rinv * qg1[1]), cvtpk(q[6] * rinv * qg1[2], q[7] * rinv * qg1[3])};
        *(u32x4*)(qn + (size_t)r * 384 + lane * 8) = o;
      }
      ss = 0.f;
#pragma unroll
      for (int i = 0; i < 4; ++i) { k[2 * i] = __uint_as_float(kv[j][i] << 16); k[2 * i + 1] = __uint_as_float(kv[j][i] & 0xffff0000u); ss += k[2 * i] * k[2 * i] + k[2 * i + 1] * k[2 * i + 1]; }
      rinv = rsqrtf(wave_sum(ss) * (1.f / 256.f) + EPSV);
      if (kact) {
        const u32x4 o = {cvtpk(k[0] * rinv * kg0[0], k[1] * rinv * kg0[1]), cvtpk(k[2] * rinv * kg0[2], k[3] * rinv * kg0[3]),
                         cvtpk(k[4] * rinv * kg1[0], k[5] * rinv * kg1[1]), cvtpk(k[6] * rinv * kg1[2], k[7] * rinv * kg1[3])};
        *(u32x4*)(kvn + (size_t)r * 256 + lane * 8) = o;
      }
      const float krp = shx(kr[j], 8);
      const float ko = isc ? kr[j] : rope_apply(kr[j], krp, lane & 31, t);
      if (lane < 32) ((bf16_t*)(p.ws + OFF_V))[(size_t)r * 32 + rope_slot(lane)] = f2bf(ko);
    }
  }
}

__device__ void hyena_prep(const Params& p, int layer, char* smem) {
  constexpr int RS = 516;
  const bf16_t* u = (const bf16_t*)(p.ws + OFF_U);
  const float* cw = p.in[I_HCW] + (size_t)layer * 3 * 768; const float* cb = p.in[I_HCB] + layer * 768;
  const int tid = TIDX;
  const int ntile = (layer == 0) ? NCHUNK : 256;
  for (int unit = BIDX; unit < ntile * 3; unit += gridDim.x) {
    const int cid = unit / 3, part = unit % 3;
    int rbase, t0, slen, b;
    if (cid < 256) { b = cid >> 7; rbase = b * SEQ; t0 = (cid & 127) * 64; slen = SEQ; }
    else { const int q = cid - 256; b = q >> 2; rbase = NLAT + b * CTXL; t0 = (q & 3) * 64; slen = CTXL; }
    __syncthreads();
    {
      const int chunk = tid & 31;
      for (int row = tid >> 5; row < 66; row += 16) {
        const int t = t0 + row - 1;
        u32x4 v = {0u, 0u, 0u, 0u};
        if (t >= 0 && t < slen) v = *(const u32x4*)(u + (size_t)(rbase + t) * DIN + 1440 + part * 256 + chunk * 8);
        unsigned* d = (unsigned*)(smem + row * RS + chunk * 16);
        d[0] = v[0]; d[1] = v[1]; d[2] = v[2]; d[3] = v[3];
      }
    }
    __syncthreads();
    {
      const int tg = tid & 15;
      const char* tb = smem + (4 * tg) * RS;
#pragma unroll
      for (int i = 0; i < 4; ++i) {
        const int cp = (tid >> 4) + 32 * i, pc = part * 256 + 2 * cp;
        unsigned x[6];
#pragma unroll
        for (int k = 0; k < 6; ++k) x[k] = *(const unsigned*)(tb + k * RS + cp * 4);
        const float wa0 = cw[pc], wa1 = cw[768 + pc], wa2 = cw[1536 + pc], ba = cb[pc];
        const float wb0 = cw[pc + 1], wb1 = cw[768 + pc + 1], wb2 = cw[1536 + pc + 1], bb = cb[pc + 1];
        f32x4 ya, yb;
#pragma unroll
        for (int q = 0; q < 4; ++q) {
          ya[q] = ba + wa0 * __uint_as_float(x[q] << 16) + wa1 * __uint_as_float(x[q + 1] << 16) + wa2 * __uint_as_float(x[q + 2] << 16);
          yb[q] = bb + wb0 * __uint_as_float(x[q] & 0xffff0000u) + wb1 * __uint_as_float(x[q + 1] & 0xffff0000u) + wb2 * __uint_as_float(x[q + 2] & 0xffff0000u);
        }
        float* dst = (cid < 256) ? (float*)(p.ws + OFF_HYIN) + ((size_t)(part * 2 + b) * 256 + 2 * cp) * SEQ + t0 + 4 * tg
                                 : (float*)(p.ws + OFF_HYINC) + ((size_t)(part * 2 + b) * 256 + 2 * cp) * CTXL + t0 + 4 * tg;
        *(f32x4*)dst = ya; *(f32x4*)(dst + slen) = yb;
      }
    }
  }
}

__device__ void hyena_out_transpose(const Params& p, char* smem) {
  const bf16_t* yc = (const bf16_t*)(p.ws + OFF_HB); bf16_t* mix = (bf16_t*)(p.ws + OFF_MIX);
  constexpr int RS = 132;
  const int tid = TIDX;
  for (int unit = BIDX; unit < 2 * (SEQ / 64); unit += gridDim.x) {
    const int b = unit / (SEQ / 64), t0 = (unit % (SEQ / 64)) * 64;
    __syncthreads();
    {
      const int chunk = tid & 7;
      for (int c = tid >> 3; c < 256; c += 64) {
        const u32x4 v = *(const u32x4*)(yc + ((size_t)(b * 256 + c)) * SEQ + t0 + chunk * 8);
        unsigned* d = (unsigned*)(smem + c * RS + chunk * 16);
        d[0] = v[0]; d[1] = v[1]; d[2] = v[2]; d[3] = v[3];
      }
    }
    __syncthreads();
    {
      const int c8 = (tid & 31) * 8;
      for (int tl = tid >> 5; tl < 64; tl += 16) {
        unsigned short h[8];
#pragma unroll
        for (int q = 0; q < 8; ++q) h[q] = *(const unsigned short*)(smem + (c8 + q) * RS + tl * 2);
        const u32x4 o = {(unsigned)h[0] | ((unsigned)h[1] << 16), (unsigned)h[2] | ((unsigned)h[3] << 16), (unsigned)h[4] | ((unsigned)h[5] << 16), (unsigned)h[6] | ((unsigned)h[7] << 16)};
        *(u32x4*)(mix + ((size_t)b * SEQ + t0 + tl) * DM + 768 + c8) = o;
      }
    }
  }
}

__device__ void hyena_direct(const Params& p, int layer, char* smem) {
  float* zs = (float*)smem;
  float* Ts = zs + SEQ;
  bf16_t* mix = (bf16_t*)(p.ws + OFF_MIX);
  const int nunits = (layer == 0) ? 512 : 0;
  for (int unit = BIDX; unit < nunits; unit += gridDim.x) {
    const bool isc = true; const int q = unit & 511, b = q >> 8, c = q & 255;
    const int L = CTXL;
    const float* hin = (const float*)(p.ws + OFF_HYINC);
    const float* filt = (const float*)(p.ws + OFF_FILTC) + (size_t)layer * 1024 * CTXL;
    const float* ssq = (const float*)(p.ws + OFF_SSQPC) + (size_t)layer * 4 * 1024;
    const int ntt = 4;
    const int nout = (L + NTHREADS - 1) / NTHREADS;
    for (int order = 0; order < 2; ++order) {
      const int colf = (order * 2 + 0) * 256 + c, colb = (order * 2 + 1) * 256 + c;
      float sf = 0.f, sb = 0.f;
      for (int tt = 0; tt < ntt; ++tt) { sf += ssq[(size_t)tt * 1024 + colf]; sb += ssq[(size_t)tt * 1024 + colb]; }
      sf = rsqrtf(sf + EPSV); sb = rsqrtf(sb + EPSV);
      const float skip = p.in[I_HSKIP][(size_t)layer * 512 + order * 256 + c];
      __syncthreads();
      for (int i = TIDX; i < 2 * L; i += NTHREADS) {
        const int m = i - L;
        float v = 0.f;
        if (m >= 0) v = filt[(size_t)colf * L + m] * sf; else if (m > -L) v = filt[(size_t)colb * L - m] * sb;
        if (m == 0) v += skip;
        Ts[i] = v;
      }
      if (order == 0) for (int i = TIDX; i < L; i += NTHREADS) zs[i] = hin[((size_t)(0 * 2 + b) * 256 + c) * L + i];
      __syncthreads();
      float acc[16];
#pragma unroll
      for (int j = 0; j < 16; ++j) acc[j] = 0.f;
      if ((int)TIDX < L) {
        const float* tb = Ts + L + TIDX;
        if (!isc) {
          for (int s = 0; s < SEQ; ++s) {
            const float zv = zs[s];
#pragma unroll
            for (int j = 0; j < 16; ++j) acc[j] += tb[j * NTHREADS - s] * zv;
          }
        } else {
          for (int s = 0; s < CTXL; ++s) acc[0] += tb[-s] * zs[s];
        }
      }
      __syncthreads();
      const float* xg = hin + ((size_t)((1 + order) * 2 + b) * 256 + c) * L;
#pragma unroll
      for (int j = 0; j < 16; ++j) {
        const int t = TIDX + j * NTHREADS;
        if (t < L) {
          const float y = xg[t] * acc[j];
          if (order == 0) zs[t] = y;
          else { const size_t row = isc ? (size_t)NLAT + b * CTXL + t : (size_t)b * SEQ + t; mix[row * DM + 768 + c] = f2bf(y); }
        }
      }
    }
  }
}

namespace att {
constexpr int NW = 8, QBLK = 32, KVBLK = 64;
constexpr float SCALE = 0.10206207261596575f;
constexpr float THR = 8.f;
constexpr int SHM_V = KVBLK * 128 * 2, SHM_K = KVBLK * 128 * 2;
constexpr int SHM_ATTN = 2 * SHM_V + 2 * SHM_K + NW * 64 * 4;
#define KSWZ(row, colB) ((row) * 256 + ((colB) ^ (((row) & 7) << 4)))
#define SBAR() __builtin_amdgcn_sched_barrier(0)
template <int VAR> __device__ __forceinline__ float ex2(float x) { if constexpr (VAR == 2) return x; else return __builtin_amdgcn_exp2f(x); }
template <int VAR> __device__ __forceinline__ void partialSM(f32x16& p0, f32x16& p1, float& m_reg, float& mn, float& alpha) {
  constexpr float C = SCALE * 1.4426950408889634f;
  float pmax = p0[0];
#pragma unroll
  for (int r = 1; r < 16; ++r) pmax = fmaxf(pmax, p0[r]);
#pragma unroll
  for (int r = 0; r < 16; ++r) pmax = fmaxf(pmax, p1[r]);
  { auto rr = __builtin_amdgcn_permlane32_swap(__float_as_uint(pmax), __float_as_uint(pmax), false, false);
    pmax = fmaxf(__uint_as_float(rr[0]), __uint_as_float(rr[1])); }
  if (__builtin_expect(__all(pmax - m_reg <= THR / SCALE), 1)) { mn = m_reg; alpha = 1.f; }
  else { mn = fmaxf(m_reg, pmax); alpha = __builtin_amdgcn_exp2f((m_reg - mn) * C); m_reg = mn; }
  const float mnC = -mn * C;
#pragma unroll
  for (int r = 0; r < 16; ++r) p0[r] = fmaf(p0[r], C, mnC);
#pragma unroll
  for (int r = 0; r < 16; ++r) p1[r] = fmaf(p1[r], C, mnC);
#pragma unroll
  for (int r = 0; r < 16; ++r) p0[r] = ex2<VAR>(p0[r]);
}
template <int VAR> __device__ __forceinline__ void finishSM(f32x16& p0, f32x16& p1, float alpha, float& l_reg, bf16x8& pa0, bf16x8& pa1, bf16x8& pa2, bf16x8& pa3) {
#pragma unroll
  for (int r = 0; r < 16; ++r) p1[r] = ex2<VAR>(p1[r]);
  float ps = 0;
#pragma unroll
  for (int r = 0; r < 16; ++r) ps += p0[r];
#pragma unroll
  for (int r = 0; r < 16; ++r) ps += p1[r];
  { auto rr = __builtin_amdgcn_permlane32_swap(__float_as_uint(ps), __float_as_uint(ps), false, false);
    ps = __uint_as_float(rr[0]) + __uint_as_float(rr[1]); }
  l_reg = l_reg * alpha + ps;
#define PK4(P, BASE, OUT) do { unsigned a0 = cvtpk(P[BASE + 0], P[BASE + 1]), a1 = cvtpk(P[BASE + 2], P[BASE + 3]);   \
    unsigned b0 = cvtpk(P[BASE + 4], P[BASE + 5]), b1 = cvtpk(P[BASE + 6], P[BASE + 7]);                              \
    auto r0 = __builtin_amdgcn_permlane32_swap(a0, b0, false, false); auto r1 = __builtin_amdgcn_permlane32_swap(a1, b1, false, false); \
    u32x4 w = {r0[0], r1[0], r0[1], r1[1]}; OUT = *reinterpret_cast<bf16x8*>(&w); } while (0)
  PK4(p0, 0, pa0); PK4(p0, 8, pa1); PK4(p1, 0, pa2); PK4(p1, 8, pa3);
#undef PK4
}
__device__ __forceinline__ void qkt(f32x16& p0, f32x16& p1, const char* Ks, const bf16x8* qr, int r32, int hi) {
  p0 = f32x16{}; p1 = f32x16{};
#pragma unroll
  for (int d0 = 0; d0 < 6; ++d0) { const int cb = (d0 * 16 + hi * 8) * 2;
    const bf16x8 b0 = *reinterpret_cast<const bf16x8*>(Ks + KSWZ(r32, cb));
    const bf16x8 b1 = *reinterpret_cast<const bf16x8*>(Ks + KSWZ(32 + r32, cb));
    p0 = __builtin_amdgcn_mfma_f32_32x32x16_bf16(b0, qr[d0], p0, 0, 0, 0);
    p1 = __builtin_amdgcn_mfma_f32_32x32x16_bf16(b1, qr[d0], p1, 0, 0, 0); }
}
__device__ __forceinline__ int v_st(int k, int c) { const int kk = (k & ~0xC) | ((k & 4) << 1) | ((k & 8) >> 1); return ((kk >> 3) * 4 + (c >> 5)) * 512 + ((kk & 7) * 32 + (c & 31)) * 2; }
__device__ __forceinline__ int v_rd_base(int lane) { return ((lane & 3) << 3) | (((lane >> 2) & 3) << 6) | (((lane >> 4) & 1) << 5) | (((lane >> 5) & 1) << 8); }
constexpr int v_rd_off(int d0, int ks, int half) { return d0 * 512 + ks * 4096 + half * 2048; }
template <int OFF> __device__ __forceinline__ s16x4 tr_read(int vb) {
  s16x4 r; asm volatile("ds_read_b64_tr_b16 %0, %1 offset:%2" : "=&v"(r) : "v"(vb), "i"(OFF) : "memory"); return r;
}
template <int D0> __device__ __forceinline__ void pv_one(f32x16& od, int vb, bf16x8 pa0, bf16x8 pa1, bf16x8 pa2, bf16x8 pa3) {
  const s16x4 l0 = tr_read<v_rd_off(D0, 0, 0)>(vb), h0 = tr_read<v_rd_off(D0, 0, 1)>(vb), l1 = tr_read<v_rd_off(D0, 1, 0)>(vb), h1 = tr_read<v_rd_off(D0, 1, 1)>(vb);
  const s16x4 l2 = tr_read<v_rd_off(D0, 2, 0)>(vb), h2 = tr_read<v_rd_off(D0, 2, 1)>(vb), l3 = tr_read<v_rd_off(D0, 3, 0)>(vb), h3 = tr_read<v_rd_off(D0, 3, 1)>(vb);
  asm volatile("s_waitcnt lgkmcnt(0)" ::: "memory"); SBAR();
#define PK(L, H) (bf16x8){L[0], L[1], L[2], L[3], H[0], H[1], H[2], H[3]}
  od = __builtin_amdgcn_mfma_f32_32x32x16_bf16(pa0, PK(l0, h0), od, 0, 0, 0);
  od = __builtin_amdgcn_mfma_f32_32x32x16_bf16(pa1, PK(l1, h1), od, 0, 0, 0);
  od = __builtin_amdgcn_mfma_f32_32x32x16_bf16(pa2, PK(l2, h2), od, 0, 0, 0);
  od = __builtin_amdgcn_mfma_f32_32x32x16_bf16(pa3, PK(l3, h3), od, 0, 0, 0);
#undef PK
}
__device__ __forceinline__ void pv_d0(f32x16& o0, f32x16& o1, int vb, bf16x8 pa0, bf16x8 pa1, bf16x8 pa2, bf16x8 pa3) {
  pv_one<0>(o0, vb, pa0, pa1, pa2, pa3); pv_one<1>(o1, vb, pa0, pa1, pa2, pa3);
}
template <int VAR>
__device__ __forceinline__ void attn_body(const bf16_t* __restrict__ Qb, const bf16_t* __restrict__ KVh, const bf16_t* __restrict__ KR, int bsel, int key0,
                                          bf16_t* __restrict__ Ob, float* __restrict__ Op, float* __restrict__ Oml, int seq, char* lds) {
  const int tid = TIDX, wid = tid >> 6, lane = tid & 63, r32 = lane & 31, hi = lane >> 5;
  char* V_lds = lds; char* K_lds = lds + 2 * SHM_V;
  float* ws = (float*)(lds + 2 * SHM_V + 2 * SHM_K) + wid * 64; float* li_l = ws; float* al_l = ws + 32;
  float m_reg = -1e30f, l_reg = 0; f32x16 o0 = {}, o1 = {}; bf16x8 qr[6];
  const bf16_t* Qw = Qb + (size_t)(wid * QBLK + r32) * 576 + hi * 8;
#pragma unroll
  for (int d0 = 0; d0 < 6; ++d0) qr[d0] = *(const bf16x8*)(Qw + d0 * 16);
  const int sr = tid >> 4, sc = (tid & 15) * 8, vst0 = v_st(sr, sc & 63), vst1 = v_st(32 + sr, sc & 63);
  const int vb0 = (int)(uintptr_t)V_lds + v_rd_base(lane);
  const bool kact = sc < 96, vact = sc < 64;
  bf16x8 vs0 = {}, vs1 = {}, ks0 = {}, ks1 = {};
#define SLOAD(k0) do { const int kk_ = key0 + (k0); const size_t rb_ = (size_t)((kk_ < CTXL) ? NLAT + bsel * CTXL + kk_ : bsel * SEQ + kk_ - CTXL) + sr; \
    if (vact) { vs0 = *(const bf16x8*)(KVh + rb_ * 768 + 64 + sc); vs1 = *(const bf16x8*)(KVh + (rb_ + 32) * 768 + 64 + sc); } \
    if (kact) { if (sc < 64) { ks0 = *(const bf16x8*)(KVh + rb_ * 768 + sc); ks1 = *(const bf16x8*)(KVh + (rb_ + 32) * 768 + sc); } \
                else { ks0 = *(const bf16x8*)(KR + rb_ * 32 + (sc - 64)); ks1 = *(const bf16x8*)(KR + (rb_ + 32) * 32 + (sc - 64)); } } } while (0)
#define SWRITE(b) do { if (vact) { *(bf16x8*)(V_lds + (b) * SHM_V + vst0) = vs0; *(bf16x8*)(V_lds + (b) * SHM_V + vst1) = vs1; } \
    if (kact) { const int kc = sc * 2; *(bf16x8*)(K_lds + (b) * SHM_K + KSWZ(sr, kc)) = ks0; *(bf16x8*)(K_lds + (b) * SHM_K + KSWZ(32 + sr, kc)) = ks1; } } while (0)
#define SWAIT() asm volatile("s_waitcnt vmcnt(0)" ::: "memory")
#define RESC(a) do { if (__any((a) < 1.f)) { if (hi == 0) al_l[r32] = (a); asm volatile("s_waitcnt lgkmcnt(0)" ::: "memory"); \
    _Pragma("unroll") for (int r = 0; r < 16; ++r) { const float f = al_l[crow(r, hi)]; o0[r] *= f; o1[r] *= f; } } } while (0)
  f32x16 pA0, pA1, pB0, pB1; float mnA, mnB, alA, alB; bf16x8 pa0, pa1, pa2, pa3; const int NT = seq / KVBLK;
  __syncthreads();
  SLOAD(0); SWAIT(); SWRITE(0); __syncthreads();
  qkt(pA0, pA1, K_lds, qr, r32, hi); partialSM<VAR>(pA0, pA1, m_reg, mnA, alA);
  SLOAD(KVBLK);
  SWAIT(); SWRITE(1); __syncthreads();
#define LSYNC() do { if constexpr (VAR != 1) __syncthreads(); } while (0)
#define LLOAD(k0) do { if constexpr (VAR != 3) SLOAD(k0); } while (0)
#define LWRITE(b) do { if constexpr (VAR != 3) { SWAIT(); SWRITE(b); } } while (0)
#define LPV(O0, O1, VB) do { if constexpr (VAR != 5) pv_d0(O0, O1, VB, pa0, pa1, pa2, pa3); else { asm volatile("" :: "v"(pa0), "v"(pa1), "v"(pa2), "v"(pa3)); } } while (0)
  for (int j = 1; j + 1 < NT; j += 2) {
    SBAR(); LLOAD((j + 1) * KVBLK); SBAR(); qkt(pB0, pB1, K_lds + SHM_K, qr, r32, hi);
    finishSM<VAR>(pA0, pA1, alA, l_reg, pa0, pa1, pa2, pa3); SBAR();
    LPV(o0, o1, vb0); partialSM<VAR>(pB0, pB1, m_reg, mnB, alB);
    LSYNC(); LWRITE(0);
    RESC(alB); LSYNC();
    SBAR(); LLOAD((j + 2) * KVBLK); SBAR(); qkt(pA0, pA1, K_lds, qr, r32, hi);
    finishSM<VAR>(pB0, pB1, alB, l_reg, pa0, pa1, pa2, pa3); SBAR();
    LPV(o0, o1, vb0 + SHM_V); partialSM<VAR>(pA0, pA1, m_reg, mnA, alA);
    LSYNC(); LWRITE(1);
    RESC(alA); LSYNC();
  }
#undef LSYNC
#undef LLOAD
#undef LWRITE
#undef LPV
  SBAR(); qkt(pB0, pB1, K_lds + SHM_K, qr, r32, hi);
  finishSM<VAR>(pA0, pA1, alA, l_reg, pa0, pa1, pa2, pa3); SBAR();
  pv_d0(o0, o1, vb0, pa0, pa1, pa2, pa3); partialSM<VAR>(pB0, pB1, m_reg, mnB, alB);
  __syncthreads(); RESC(alB);
  finishSM<VAR>(pB0, pB1, alB, l_reg, pa0, pa1, pa2, pa3); SBAR();
  pv_d0(o0, o1, vb0 + SHM_V, pa0, pa1, pa2, pa3);
  if (Op != nullptr) {
    float* Pw = Op + (size_t)(wid * QBLK) * 64;
#pragma unroll
    for (int r = 0; r < 16; ++r) { const int orow = crow(r, hi); Pw[(size_t)orow * 64 + r32] = o0[r]; Pw[(size_t)orow * 64 + 32 + r32] = o1[r]; }
    if (hi == 0) { Oml[(size_t)(wid * QBLK + r32) * 2] = m_reg; Oml[(size_t)(wid * QBLK + r32) * 2 + 1] = l_reg; }
  } else {
    if (hi == 0) li_l[r32] = l_reg; asm volatile("s_waitcnt lgkmcnt(0)" ::: "memory");
    bf16_t* Ow = Ob + (size_t)(wid * QBLK) * DM;
#pragma unroll
    for (int r = 0; r < 16; ++r) { const int orow = crow(r, hi); const float rl = __builtin_amdgcn_rcpf(li_l[orow]);
      Ow[(size_t)orow * DM + r32] = f2bf(o0[r] * rl); Ow[(size_t)orow * DM + 32 + r32] = f2bf(o1[r] * rl); }
  }
#undef SLOAD
#undef SWRITE
#undef SWAIT
#undef RESC
}
}

template <int VAR = 0, bool ATT_DUMMY = false>
__device__ __forceinline__ void attn_units(const Params& p, int layer, char* smem) {
  const bf16_t* Q = (const bf16_t*)(p.ws + OFF_Q);
  const bf16_t* KV = (const bf16_t*)(p.ws + OFF_K); const bf16_t* KR = (const bf16_t*)(p.ws + OFF_V);
  bf16_t* mix = (bf16_t*)(p.ws + OFF_MIX); float* opart = (float*)(p.ws + OFF_OPART); float* oml = (float*)(p.ws + OFF_OML);
  const int nunits = 512 + ((layer == 0) ? 12 : 0);
  for (int unit = BIDX; unit < nunits; unit += gridDim.x) {
    const bf16_t *qp, *kvp; bf16_t* ob; float* op = nullptr; float* ml = nullptr; int seq, bsel, key0 = 0;
    if (unit < 256) {
      const int bh = unit & 7, qb = unit >> 3, b = bh / 6, h = bh % 6;
      qp = Q + ((size_t)b * SEQ + qb * 256) * 576 + h * 96; kvp = KV + h * 128; bsel = b;
      ob = mix + ((size_t)b * SEQ + qb * 256) * DM + 384 + h * 64; seq = NKEYS;
    } else if (unit < 512) {
      const int v = unit - 256, bhi = v & 3, half = (v >> 2) & 1, qb = v >> 3, bh = 8 + bhi, b = bh / 6, h = bh % 6;
      qp = Q + ((size_t)b * SEQ + qb * 256) * 576 + h * 96; kvp = KV + h * 128; bsel = b; key0 = half * (NKEYS / 2);
      ob = mix; op = opart + ((size_t)(bhi * 2 + half) * SEQ + qb * 256) * 64; ml = oml + ((size_t)(bhi * 2 + half) * SEQ + qb * 256) * 2; seq = NKEYS / 2;
    } else {
      const int bh = unit - 512, b = bh / 6, h = bh % 6;
      qp = Q + ((size_t)NLAT + b * CTXL) * 576 + h * 96; kvp = KV + h * 128; bsel = b;
      ob = mix + ((size_t)NLAT + b * CTXL) * DM + 384 + h * 64; seq = CTXL;
    }
    if constexpr (VAR != 0 || ATT_DUMMY) {
      ob = (bf16_t*)(p.ws + OFF_HB) + (size_t)(unit & 63) * 256 * DM; if (op) { op = (float*)(p.ws + OFF_HB) + (size_t)(unit & 63) * 256 * 64; ml = op; }
    }
    att::attn_body<VAR>(qp, kvp, KR, bsel, key0, ob, op, ml, seq, smem);
  }
}
__device__ void attn_combine(const Params& p) {
  const int lane = TIDX & 63, wid = TIDX >> 6;
  const float* opart = (const float*)(p.ws + OFF_OPART); const float* oml = (const float*)(p.ws + OFF_OML); bf16_t* mix = (bf16_t*)(p.ws + OFF_MIX);
  constexpr float C = att::SCALE * 1.4426950408889634f;
  for (int grp = BIDX * 8 + wid; grp < 4 * SEQ / 4; grp += gridDim.x * 8) {
    const int idx0 = grp * 4, bhi = idx0 >> 13, q0 = idx0 & (SEQ - 1), bh = 8 + bhi, b = bh / 6, h = bh % 6;
    const size_t r0 = (size_t)(bhi * 2) * SEQ + q0, r1 = r0 + SEQ;
    float m0[4], l0[4], m1[4], l1[4], o0[4], o1[4];
#pragma unroll
    for (int j = 0; j < 4; ++j) {
      m0[j] = oml[(r0 + j) * 2]; l0[j] = oml[(r0 + j) * 2 + 1]; m1[j] = oml[(r1 + j) * 2]; l1[j] = oml[(r1 + j) * 2 + 1];
      o0[j] = opart[(r0 + j) * 64 + lane]; o1[j] = opart[(r1 + j) * 64 + lane];
    }
#pragma unroll
    for (int j = 0; j < 4; ++j) {
      const float m = fmaxf(m0[j], m1[j]), f0 = __builtin_amdgcn_exp2f((m0[j] - m) * C), f1 = __builtin_amdgcn_exp2f((m1[j] - m) * C);
      const float o = (o0[j] * f0 + o1[j] * f1) / (l0[j] * f0 + l1[j] * f1);
      mix[((size_t)b * SEQ + q0 + j) * DM + 384 + h * 64 + lane] = f2bf(o);
    }
  }
}

#define CEK(a, b) { const unsigned _h = max(k[a], k[b]), _l = min(k[a], k[b]); k[a] = _h; k[b] = _l; }
__device__ __forceinline__ void sort16k(unsigned* k) {
  CEK(0,1) CEK(2,3) CEK(0,2) CEK(1,3) CEK(1,2) CEK(4,5) CEK(6,7) CEK(4,6)
  CEK(5,7) CEK(5,6) CEK(0,4) CEK(2,6) CEK(2,4) CEK(1,5) CEK(3,7) CEK(3,5)
  CEK(1,2) CEK(3,4) CEK(5,6) CEK(8,9) CEK(10,11) CEK(8,10) CEK(9,11) CEK(9,10)
  CEK(12,13) CEK(14,15) CEK(12,14) CEK(13,15) CEK(13,14) CEK(8,12) CEK(10,14) CEK(10,12)
  CEK(9,13) CEK(11,15) CEK(11,13) CEK(9,10) CEK(11,12) CEK(13,14) CEK(0,8) CEK(4,12)
  CEK(4,8) CEK(2,10) CEK(6,14) CEK(6,10) CEK(2,4) CEK(6,8) CEK(10,12) CEK(1,9)
  CEK(5,13) CEK(5,9) CEK(3,11) CEK(7,15) CEK(7,11) CEK(3,5) CEK(7,9) CEK(11,13)
  CEK(1,2) CEK(3,4) CEK(5,6) CEK(7,8) CEK(9,10) CEK(11,12) CEK(13,14)
}
__device__ __forceinline__ void bmerge16k(unsigned* k) {
  CEK(0,8) CEK(1,9) CEK(2,10) CEK(3,11) CEK(4,12) CEK(5,13) CEK(6,14) CEK(7,15)
  CEK(0,4) CEK(1,5) CEK(2,6) CEK(3,7) CEK(8,12) CEK(9,13) CEK(10,14) CEK(11,15)
  CEK(0,2) CEK(1,3) CEK(4,6) CEK(5,7) CEK(8,10) CEK(9,11) CEK(12,14) CEK(13,15)
  CEK(0,1) CEK(2,3) CEK(4,5) CEK(6,7) CEK(8,9) CEK(10,11) CEK(12,13) CEK(14,15)
}
#undef CEK
#define CEP(a, b) { const bool _s = v[a] < v[b]; const float _va = _s ? v[b] : v[a], _vb = _s ? v[a] : v[b]; const int _pa = _s ? pl[b] : pl[a], _pb = _s ? pl[a] : pl[b]; \
                    v[a] = _va; v[b] = _vb; pl[a] = _pa; pl[b] = _pb; }
__device__ __forceinline__ void sort16p(float* v, int* pl) {
  CEP(0,1) CEP(2,3) CEP(0,2) CEP(1,3)
  CEP(1,2) CEP(4,5) CEP(6,7) CEP(4,6)
  CEP(5,7) CEP(5,6) CEP(0,4) CEP(2,6)
  CEP(2,4) CEP(1,5) CEP(3,7) CEP(3,5)
  CEP(1,2) CEP(3,4) CEP(5,6) CEP(8,9)
  CEP(10,11) CEP(8,10) CEP(9,11) CEP(9,10)
  CEP(12,13) CEP(14,15) CEP(12,14) CEP(13,15)
  CEP(13,14) CEP(8,12) CEP(10,14) CEP(10,12)
  CEP(9,13) CEP(11,15) CEP(11,13) CEP(9,10)
  CEP(11,12) CEP(13,14) CEP(0,8) CEP(4,12)
  CEP(4,8) CEP(2,10) CEP(6,14) CEP(6,10)
  CEP(2,4) CEP(6,8) CEP(10,12) CEP(1,9)
  CEP(5,13) CEP(5,9) CEP(3,11) CEP(7,15)
  CEP(7,11) CEP(3,5) CEP(7,9) CEP(11,13)
  CEP(1,2) CEP(3,4) CEP(5,6) CEP(7,8)
  CEP(9,10) CEP(11,12) CEP(13,14)
}
__device__ __forceinline__ void bmerge16p(float* v, int* pl) {
  CEP(0,8) CEP(1,9) CEP(2,10) CEP(3,11)
  CEP(4,12) CEP(5,13) CEP(6,14) CEP(7,15)
  CEP(0,4) CEP(1,5) CEP(2,6) CEP(3,7)
  CEP(8,12) CEP(9,13) CEP(10,14) CEP(11,15)
  CEP(0,2) CEP(1,3) CEP(4,6) CEP(5,7)
  CEP(8,10) CEP(9,11) CEP(12,14) CEP(13,15)
  CEP(0,1) CEP(2,3) CEP(4,5) CEP(6,7)
  CEP(8,9) CEP(10,11) CEP(12,13) CEP(14,15)
}
#undef CEP
__device__ __forceinline__ unsigned fkey(float f, int low7) { unsigned u = __float_as_uint(f); u ^= (unsigned)((int)u >> 31) | 0x80000000u; return (u & ~127u) | (unsigned)low7; }
__device__ __forceinline__ float funkey(unsigned k) { unsigned u = k & ~127u; u ^= (u & 0x80000000u) ? 0x80000000u : 0xFFFFFFFFu; return __uint_as_float(u); }
__device__ __forceinline__ void peer_half_top16(const char* __restrict__ kl  , int r32, const bf16_t* __restrict__ qp, int hi, unsigned* T) {
  bf16x8 bq[8]; int kofs[8];
#pragma unroll
  for (int ks = 0; ks < 8; ++ks) { bq[ks] = *(const bf16x8*)(qp + ks * 16); kofs[ks] = r32 * 256 + (((ks * 16 + hi * 8) * 2) ^ ((r32 & 7) << 4)); }
  unsigned L[16];
#pragma unroll
  for (int mt = 0; mt < 4; ++mt) {
    f32x16 acc = {};
#pragma unroll
    for (int ks = 0; ks < 8; ++ks) {
      const bf16x8 a = *(const bf16x8*)(kl + mt * 8192 + kofs[ks]);
      acc = __builtin_amdgcn_mfma_f32_32x32x16_bf16(a, bq[ks], acc, 0, 0, 0);
    }
    unsigned k[16];
#pragma unroll
    for (int r = 0; r < 16; ++r) k[r] = fkey(acc[r], 127 - (mt * 32 + (r & 3) + 8 * (r >> 2) + 4 * hi));
    sort16k(k);
    if (mt == 0) {
#pragma unroll
      for (int i = 0; i < 16; ++i) L[i] = k[i];
    } else {
#pragma unroll
      for (int i = 0; i < 16; ++i) L[i] = max(L[i], k[15 - i]);
      bmerge16k(L);
    }
  }
#pragma unroll
  for (int i = 0; i < 16; ++i) {
    const auto rr = __builtin_amdgcn_permlane32_swap(L[15 - i], L[15 - i], false, false);
    const unsigned partner = hi ? rr[0] : rr[1];
    T[i] = max(L[i], partner);
  }
  bmerge16k(T);
}
__device__ void peer_topk(const Params& p, int layer, int nrows, char* smem) {
  const int tid = TIDX, wid = tid >> 6, lane = tid & 63, r32 = lane & 31, hi = lane >> 5;
  const bf16_t* pq = (const bf16_t*)(p.ws + OFF_PQ);
  const bf16_t* keys = (const bf16_t*)(p.ws + OFF_KEYS) + (size_t)layer * 2 * 128 * 128;
  int* eid = (int*)(p.ws + OFF_EID); float* gate = (float*)(p.ws + OFF_GATE);
  __syncthreads();
  for (int i = tid; i < 4096; i += NTHREADS) {
    const int half = i >> 11, key = (i >> 4) & 127, c16 = i & 15;
    *(u32x4*)(smem + half * 32768 + KSWZ(key, c16 * 16)) = *(const u32x4*)(keys + (size_t)(half * 128 + key) * 128 + c16 * 8);
  }
  __syncthreads();
  const int ntask = (nrows / 32) * 8;
  for (int task = BIDX * 8 + wid; task < ntask; task += gridDim.x * 8) {
    const int grp = task >> 3, h = task & 7;
    const size_t row = (size_t)grp * 32 + r32;
    unsigned K1[16], K2[16];
    const int lofs = launder_v(0);
    peer_half_top16(smem + lofs, r32, pq + row * 2048 + h * 256 + hi * 8, hi, K1);
    peer_half_top16(smem + lofs + 32768, r32, pq + row * 2048 + h * 256 + 128 + hi * 8, hi, K2);
    float v1[16], v2[16]; int i1[16], i2[16];
#pragma unroll
    for (int i = 0; i < 16; ++i) { v1[i] = funkey(K1[i]); v2[i] = funkey(K2[i]); i1[i] = 127 - (int)(K1[i] & 127u); i2[i] = 127 - (int)(K2[i] & 127u); }
    float ts[16]; int tp[16];
    {
      float* cv = ts; int* cp = tp;
    cv[0] = v1[0] + v2[0]; cp[0] = (i1[0] << 7) | i2[0];
    cv[1] = v1[0] + v2[1]; cp[1] = (i1[0] << 7) | i2[1];
    cv[2] = v1[0] + v2[2]; cp[2] = (i1[0] << 7) | i2[2];
    cv[3] = v1[0] + v2[3]; cp[3] = (i1[0] << 7) | i2[3];
    cv[4] = v1[0] + v2[4]; cp[4] = (i1[0] << 7) | i2[4];
    cv[5] = v1[0] + v2[5]; cp[5] = (i1[0] << 7) | i2[5];
    cv[6] = v1[0] + v2[6]; cp[6] = (i1[0] << 7) | i2[6];
    cv[7] = v1[0] + v2[7]; cp[7] = (i1[0] << 7) | i2[7];
    cv[8] = v1[0] + v2[8]; cp[8] = (i1[0] << 7) | i2[8];
    cv[9] = v1[0] + v2[9]; cp[9] = (i1[0] << 7) | i2[9];
    cv[10] = v1[0] + v2[10]; cp[10] = (i1[0] << 7) | i2[10];
    cv[11] = v1[0] + v2[11]; cp[11] = (i1[0] << 7) | i2[11];
    cv[12] = v1[0] + v2[12]; cp[12] = (i1[0] << 7) | i2[12];
    cv[13] = v1[0] + v2[13]; cp[13] = (i1[0] << 7) | i2[13];
    cv[14] = v1[0] + v2[14]; cp[14] = (i1[0] << 7) | i2[14];
    cv[15] = v1[0] + v2[15]; cp[15] = (i1[0] << 7) | i2[15];
      sort16p(ts, tp);
    }
#pragma unroll 1
    for (int g = 1; g < 3; ++g) {
      float cv[16]; int cp[16];
      if (g == 1) {
    cv[0] = v1[1] + v2[0]; cp[0] = (i1[1] << 7) | i2[0];
    cv[1] = v1[1] + v2[1]; cp[1] = (i1[1] << 7) | i2[1];
    cv[2] = v1[1] + v2[2]; cp[2] = (i1[1] << 7) | i2[2];
    cv[3] = v1[1] + v2[3]; cp[3] = (i1[1] << 7) | i2[3];
    cv[4] = v1[1] + v2[4]; cp[4] = (i1[1] << 7) | i2[4];
    cv[5] = v1[1] + v2[5]; cp[5] = (i1[1] << 7) | i2[5];
    cv[6] = v1[1] + v2[6]; cp[6] = (i1[1] << 7) | i2[6];
    cv[7] = v1[1] + v2[7]; cp[7] = (i1[1] << 7) | i2[7];
    cv[8] = v1[2] + v2[0]; cp[8] = (i1[2] << 7) | i2[0];
    cv[9] = v1[2] + v2[1]; cp[9] = (i1[2] << 7) | i2[1];
    cv[10] = v1[2] + v2[2]; cp[10] = (i1[2] << 7) | i2[2];
    cv[11] = v1[2] + v2[3]; cp[11] = (i1[2] << 7) | i2[3];
    cv[12] = v1[2] + v2[4]; cp[12] = (i1[2] << 7) | i2[4];
    cv[13] = v1[3] + v2[0]; cp[13] = (i1[3] << 7) | i2[0];
    cv[14] = v1[3] + v2[1]; cp[14] = (i1[3] << 7) | i2[1];
    cv[15] = v1[3] + v2[2]; cp[15] = (i1[3] << 7) | i2[2];
      } else {
    cv[0] = v1[3] + v2[3]; cp[0] = (i1[3] << 7) | i2[3];
    cv[1] = v1[4] + v2[0]; cp[1] = (i1[4] << 7) | i2[0];
    cv[2] = v1[4] + v2[1]; cp[2] = (i1[4] << 7) | i2[1];
    cv[3] = v1[4] + v2[2]; cp[3] = (i1[4] << 7) | i2[2];
    cv[4] = v1[5] + v2[0]; cp[4] = (i1[5] << 7) | i2[0];
    cv[5] = v1[5] + v2[1]; cp[5] = (i1[5] << 7) | i2[1];
    cv[6] = v1[6] + v2[0]; cp[6] = (i1[6] << 7) | i2[0];
    cv[7] = v1[6] + v2[1]; cp[7] = (i1[6] << 7) | i2[1];
    cv[8] = v1[7] + v2[0]; cp[8] = (i1[7] << 7) | i2[0];
    cv[9] = v1[7] + v2[1]; cp[9] = (i1[7] << 7) | i2[1];
    cv[10] = v1[8] + v2[0]; cp[10] = (i1[8] << 7) | i2[0];
    cv[11] = v1[9] + v2[0]; cp[11] = (i1[9] << 7) | i2[0];
    cv[12] = v1[10] + v2[0]; cp[12] = (i1[10] << 7) | i2[0];
    cv[13] = v1[11] + v2[0]; cp[13] = (i1[11] << 7) | i2[0];
    cv[14] = v1[12] + v2[0]; cp[14] = (i1[12] << 7) | i2[0];
    cv[15] = v1[13] + v2[0]; cp[15] = (i1[13] << 7) | i2[0];
      }
      sort16p(cv, cp);
#pragma unroll
      for (int i = 0; i < 16; ++i) if (cv[15 - i] > ts[i]) { ts[i] = cv[15 - i]; tp[i] = cp[15 - i]; }
      bmerge16p(ts, tp);
    }
    {
      float cv[2]; int cp[2];
    cv[0] = v1[14] + v2[0]; cp[0] = (i1[14] << 7) | i2[0];
    cv[1] = v1[15] + v2[0]; cp[1] = (i1[15] << 7) | i2[0];
      if (cv[0] < cv[1]) { const float tv = cv[0]; cv[0] = cv[1]; cv[1] = tv; const int ti = cp[0]; cp[0] = cp[1]; cp[1] = ti; }
      if (cv[1] > ts[14]) { ts[14] = cv[1]; tp[14] = cp[1]; }
      if (cv[0] > ts[15]) { ts[15] = cv[0]; tp[15] = cp[0]; }
      bmerge16p(ts, tp);
    }
    float ex[16], sm = 0.f;
#pragma unroll
    for (int i = 0; i < 16; ++i) { ex[i] = __expf(ts[i] - ts[0]); sm += ex[i]; }
    const float rs = 1.f / sm;
    if (hi == 0) {
      int* eo = eid + row * 128 + h * 16;
#pragma unroll
      for (int i = 0; i < 4; ++i) { const u32x4 o = {(unsigned)tp[4 * i], (unsigned)tp[4 * i + 1], (unsigned)tp[4 * i + 2], (unsigned)tp[4 * i + 3]}; *(u32x4*)(eo + 4 * i) = o; }
    } else {
      float* go = gate + row * 128 + h * 16;
#pragma unroll
      for (int i = 0; i < 4; ++i) { const f32x4 o = {ex[4 * i] * rs, ex[4 * i + 1] * rs, ex[4 * i + 2] * rs, ex[4 * i + 3] * rs}; *(f32x4*)(go + 4 * i) = o; }
    }
  }
}

constexpr float PEER_USCALE = 16.f;
__device__ void peer_cvt_tables(const Params& p, int layer, int rank, int nb) {
  const float* ut = p.in[I_PU] + (size_t)layer * 16384 * DM; const float* vt = p.in[I_PV] + (size_t)layer * 16384 * DM;
  u32x4* uo = (u32x4*)(p.ws + OFF_UTAB); u32x4* vo = (u32x4*)(p.ws + OFF_VTAB);
  const int n16 = 16384 * DM / 16, stride = nb * NTHREADS;
  for (int i = rank * NTHREADS + TIDX; i < 2 * n16; i += 2 * stride) {
    f32x4 a[2][4];
#pragma unroll
    for (int k = 0; k < 2; ++k) {
      const int ii = i + k * stride;
      if (ii < 2 * n16) {
        const bool isv = ii >= n16; const int j = isv ? ii - n16 : ii;
        const float* s = (isv ? vt : ut) + (size_t)j * 16;
#pragma unroll
        for (int q = 0; q < 4; ++q) a[k][q] = *(const f32x4*)(s + 4 * q);
      }
    }
#pragma unroll
    for (int k = 0; k < 2; ++k) {
      const int ii = i + k * stride;
      if (ii < 2 * n16) {
        const bool isv = ii >= n16; const int j = isv ? ii - n16 : ii; const float sc = isv ? 1.f : PEER_USCALE;
        u32x4 o;
#pragma unroll
        for (int q = 0; q < 4; ++q) {
          int w = __builtin_amdgcn_cvt_pk_fp8_f32(a[k][q][0] * sc, a[k][q][1] * sc, 0, false);
          w = __builtin_amdgcn_cvt_pk_fp8_f32(a[k][q][2] * sc, a[k][q][3] * sc, w, true);
          o[q] = (unsigned)w;
        }
        (isv ? vo : uo)[j] = o;
      }
    }
  }
}

__device__ __forceinline__ int xcc_slice() { return (int)((unsigned)__builtin_amdgcn_s_getreg((3 << 11) | 20) & 7u); }
__device__ __forceinline__ float row16_sum(float v) { v += dpp_mov<0xB1>(v); v += dpp_mov<0x4E>(v); v += dpp_mov<0x141>(v); v += dpp_mov<0x128>(v); return v; }
constexpr int PNS = 8;
constexpr int PSEGL = 8;
constexpr int PEPL = 64 / PSEGL;
constexpr int PNI = 128 / PEPL;
constexpr int PCOLS = 1024 / PNS;
using f32x2 = __attribute__((ext_vector_type(2))) float;
template <int PHASE>
__device__ void peer_sliced(const Params& p, int layer, int nrows) {
#if defined(PROBE_PEER_REP)
  int nrep = (PHASE == PROBE_PEER_REP) ? 2 : 1; asm volatile("" : "+s"(nrep));
#else
  constexpr int nrep = 1;
#endif
  for (int rep = 0; rep < nrep; ++rep) {
  const int dry = (rep + 1 < nrep) ? 1 : 0;
  const int lane = TIDX & 63, eg = lane / PSEGL, ch = lane % PSEGL;
  const bf16_t* hb = (const bf16_t*)(p.ws + OFF_HB);
  const int* eid = (const int*)(p.ws + OFF_EID);
  const unsigned char* tab = (const unsigned char*)(p.ws + (PHASE == 0 ? OFF_UTAB : OFF_VTAB)) + ch * 16;
  float* sp = (float*)(p.ws + OFF_SP); const float* wbuf = (const float*)(p.ws + OFF_WBUF);
  float* xs = (float*)(p.ws + OFF_XS);
  unsigned* ctr = (unsigned*)(p.ws + OFF_CTR) + (size_t)(((rep * 2 + layer) * 2 + PHASE) * 16) * 64;
  const int x0 = xcc_slice();
  const int bpa = eg << 2;
  for (int si = 0; si < PNS; ++si) {
    const int slice = (x0 + si) % PNS;
    int nbase = 0;
    if (lane == 0) nbase = (int)__hip_atomic_fetch_add(&ctr[slice * 64], 4u, __ATOMIC_RELAXED, __HIP_MEMORY_SCOPE_AGENT);
    for (;;) {
      const int base = __builtin_amdgcn_readfirstlane(nbase);
      if (base >= nrows) break;
      if (lane == 0) nbase = (int)__hip_atomic_fetch_add(&ctr[slice * 64], 4u, __ATOMIC_RELAXED, __HIP_MEMORY_SCOPE_AGENT);
      int eA = eid[(size_t)base * 128 + lane], eB = eid[(size_t)base * 128 + 64 + lane];
      float wA = 0.f, wB = 0.f;
      if (PHASE == 1) { wA = wbuf[(size_t)base * 128 + lane]; wB = wbuf[(size_t)base * 128 + 64 + lane]; }
#pragma unroll 1
      for (int tt = 0; tt < 4; ++tt) {
        const int r = base + tt;
        const int ceA = eA, ceB = eB; const float cwA = wA, cwB = wB;
        if (tt < 3) {
          eA = eid[(size_t)(r + 1) * 128 + lane]; eB = eid[(size_t)(r + 1) * 128 + 64 + lane];
          if (PHASE == 1) { wA = wbuf[(size_t)(r + 1) * 128 + lane]; wB = wbuf[(size_t)(r + 1) * 128 + 64 + lane]; }
        }
        int ev[PNI];
#pragma unroll
        for (int i = 0; i < PNI; ++i) ev[i] = __builtin_amdgcn_ds_bpermute(bpa + 32 * (i & 7), (i < 8) ? ceA : ceB);
        if (PHASE == 0) {
          float xv[16];
          {
            const u32x4 xa = *(const u32x4*)(hb + (size_t)r * DM + slice * PCOLS + ch * 16), xb = *(const u32x4*)(hb + (size_t)r * DM + slice * PCOLS + ch * 16 + 8);
#pragma unroll
            for (int q = 0; q < 4; ++q) { xv[2 * q] = __uint_as_float(xa[q] << 16); xv[2 * q + 1] = __uint_as_float(xa[q] & 0xffff0000u);
                                          xv[8 + 2 * q] = __uint_as_float(xb[q] << 16); xv[8 + 2 * q + 1] = __uint_as_float(xb[q] & 0xffff0000u); }
          }
          u32x4 uv[PNI];
#pragma unroll
          for (int j = 0; j < PNI; ++j) uv[j] = *(const u32x4*)(tab + (size_t)ev[j] * DM + slice * PCOLS);
          float keep0 = 0.f, keep1 = 0.f;
#pragma unroll
          for (int j = 0; j < PNI; ++j) {
            float d = 0.f;
#pragma unroll
            for (int q = 0; q < 4; ++q) {
              const f32x2 lo = __builtin_amdgcn_cvt_pk_f32_fp8((int)uv[j][q], false), hi2 = __builtin_amdgcn_cvt_pk_f32_fp8((int)uv[j][q], true);
              d += lo[0] * xv[4 * q] + lo[1] * xv[4 * q + 1] + hi2[0] * xv[4 * q + 2] + hi2[1] * xv[4 * q + 3];
            }
            d += dpp_mov<0xB1>(d); d += dpp_mov<0x4E>(d); d += dpp_mov<0x141>(d);
            if (ch == (j % PSEGL)) { if (j < PSEGL) keep0 = d; else keep1 = d; }
          }
          float* so = sp + ((size_t)slice * NTOK + r) * 128 + PEPL * ch + eg;
          so[0] = keep0 * (1.f / PEER_USCALE); so[64] = keep1 * (1.f / PEER_USCALE);
        } else {
          u32x4 vv[PNI];
#pragma unroll
          for (int j = 0; j < PNI; ++j) vv[j] = *(const u32x4*)(tab + (size_t)ev[j] * DM + slice * PCOLS);
          float acc[16];
#pragma unroll
          for (int j = 0; j < 16; ++j) acc[j] = 0.f;
#pragma unroll
          for (int j = 0; j < PNI; ++j) {
            const float w = __int_as_float(__builtin_amdgcn_ds_bpermute(bpa + 32 * (j & 7), __float_as_int((j < 8) ? cwA : cwB)));
#pragma unroll
            for (int q = 0; q < 4; ++q) {
              const f32x2 lo = __builtin_amdgcn_cvt_pk_f32_fp8((int)vv[j][q], false), hi2 = __builtin_amdgcn_cvt_pk_f32_fp8((int)vv[j][q], true);
              acc[4 * q] += w * lo[0]; acc[4 * q + 1] += w * lo[1]; acc[4 * q + 2] += w * hi2[0]; acc[4 * q + 3] += w * hi2[1];
            }
          }
#pragma unroll
          for (int j = 0; j < 16; ++j) {
            acc[j] += dpp_mov<0x128>(acc[j]);
            { auto rr = __builtin_amdgcn_permlane16_swap(__float_as_uint(acc[j]), __float_as_uint(acc[j]), false, false); acc[j] = __uint_as_float(rr[0]) + __uint_as_float(rr[1]); }
            { auto rr = __builtin_amdgcn_permlane32_swap(__float_as_uint(acc[j]), __float_as_uint(acc[j]), false, false); acc[j] = __uint_as_float(rr[0]) + __uint_as_float(rr[1]); }
          }
          if (eg == 0) {
            int b, t, isc; row_info(r, b, t, isc);
            const float* g2 = (const float*)(p.ws + OFF_MOD) + ((size_t)layer * 3 + (isc ? 2 : b)) * 6144 + 5120 + slice * PCOLS + ch * 16;
            float* xr = xs + (size_t)r * DM + slice * PCOLS + ch * 16;
#pragma unroll
            for (int q = 0; q < 4; ++q) {
              f32x4 xq = *(const f32x4*)(xr + 4 * q);
#pragma unroll
              for (int j = 0; j < 4; ++j) xq[j] += g2[4 * q + j] * acc[4 * q + j];
              if (dry == 0) *(f32x4*)(xr + 4 * q) = xq;
            }
          }
        }
      }
    }
  }
  }
}
__device__ void peer_weights(const Params& p, int nrows) {
  const float* sp = (const float*)(p.ws + OFF_SP); const float* gate = (const float*)(p.ws + OFF_GATE); float* wbuf = (float*)(p.ws + OFF_WBUF);
  for (int i = BIDX * NTHREADS + TIDX; i < nrows * 128; i += gridDim.x * NTHREADS) {
    float s = 0.f;
#pragma unroll
    for (int x = 0; x < PNS; ++x) s += sp[(size_t)x * NTOK * 128 + i];
    wbuf[i] = gate[i] * gelu_tanh(s);
  }
}

__device__ void peer_eval_fused(const Params& p, int layer, int nrows, char* smem) {
  const int tid = TIDX, wid = tid >> 6, lane = tid & 63, eg = lane >> 3, ch = lane & 7;
  const int ntb = nrows / (int)gridDim.x, tok0 = BIDX * ntb;
  float* S = (float*)smem;
  int* E = (int*)(smem + 72 * 128 * 4);
  const bf16_t* hb = (const bf16_t*)(p.ws + OFF_HB);
  const int* eid = (const int*)(p.ws + OFF_EID); const float* gate = (const float*)(p.ws + OFF_GATE);
  const unsigned char* utab = (const unsigned char*)(p.ws + OFF_UTAB) + ch * 16; const unsigned char* vtab = (const unsigned char*)(p.ws + OFF_VTAB) + ch * 16;
  float* xs = (float*)(p.ws + OFF_XS);
  __syncthreads();
  for (int i = tid; i < ntb * 128; i += NTHREADS) { S[i] = 0.f; E[i] = eid[(size_t)tok0 * 128 + i]; }
  __syncthreads();
#pragma unroll 1
  for (int it = wid; it < ntb * 8; it += 8) {
    const int slice = it / ntb, tl = it - slice * ntb, r = tok0 + tl;
    int ev[16];
#pragma unroll
    for (int j = 0; j < 16; ++j) ev[j] = E[tl * 128 + 8 * j + eg];
    float xv[16];
    {
      const u32x4 xa = *(const u32x4*)(hb + (size_t)r * DM + slice * 128 + ch * 16), xb = *(const u32x4*)(hb + (size_t)r * DM + slice * 128 + ch * 16 + 8);
#pragma unroll
      for (int q = 0; q < 4; ++q) { xv[2 * q] = __uint_as_float(xa[q] << 16); xv[2 * q + 1] = __uint_as_float(xa[q] & 0xffff0000u);
                                    xv[8 + 2 * q] = __uint_as_float(xb[q] << 16); xv[8 + 2 * q + 1] = __uint_as_float(xb[q] & 0xffff0000u); }
    }
    u32x4 uv[16];
#pragma unroll
    for (int j = 0; j < 16; ++j) uv[j] = *(const u32x4*)(utab + (size_t)ev[j] * DM + slice * 128);
    float keep0 = 0.f, keep1 = 0.f;
#pragma unroll
    for (int j = 0; j < 16; ++j) {
      float d = 0.f;
#pragma unroll
      for (int q = 0; q < 4; ++q) {
        const f32x2 lo = __builtin_amdgcn_cvt_pk_f32_fp8((int)uv[j][q], false), hi2 = __builtin_amdgcn_cvt_pk_f32_fp8((int)uv[j][q], true);
        d += lo[0] * xv[4 * q] + lo[1] * xv[4 * q + 1] + hi2[0] * xv[4 * q + 2] + hi2[1] * xv[4 * q + 3];
      }
      d += dpp_mov<0xB1>(d); d += dpp_mov<0x4E>(d); d += dpp_mov<0x141>(d);
      if (ch == (j & 7)) { if (j < 8) keep0 = d; else keep1 = d; }
    }
    atomicAdd(&S[tl * 128 + 8 * ch + eg], keep0); atomicAdd(&S[tl * 128 + 64 + 8 * ch + eg], keep1);
  }
  __syncthreads();
  for (int i = tid; i < ntb * 128; i += NTHREADS) S[i] = gate[(size_t)tok0 * 128 + i] * gelu_tanh(S[i] * (1.f / PEER_USCALE));
  __syncthreads();
#pragma unroll 1
  for (int it = wid; it < ntb * 8; it += 8) {
    const int slice = it / ntb, tl = it - slice * ntb, r = tok0 + tl;
    int ev[16]; float wv[16];
#pragma unroll
    for (int j = 0; j < 16; ++j) { ev[j] = E[tl * 128 + 8 * j + eg]; wv[j] = S[tl * 128 + 8 * j + eg]; }
    u32x4 vv[16];
#pragma unroll
    for (int j = 0; j < 16; ++j) vv[j] = *(const u32x4*)(vtab + (size_t)ev[j] * DM + slice * 128);
    float acc[16];
#pragma unroll
    for (int j = 0; j < 16; ++j) acc[j] = 0.f;
#pragma unroll
    for (int j = 0; j < 16; ++j) {
      const float w = wv[j];
#pragma unroll
      for (int q = 0; q < 4; ++q) {
        const f32x2 lo = __builtin_amdgcn_cvt_pk_f32_fp8((int)vv[j][q], false), hi2 = __builtin_amdgcn_cvt_pk_f32_fp8((int)vv[j][q], true);
        acc[4 * q] += w * lo[0]; acc[4 * q + 1] += w * lo[1]; acc[4 * q + 2] += w * hi2[0]; acc[4 * q + 3] += w * hi2[1];
      }
    }
#pragma unroll
    for (int j = 0; j < 16; ++j) {
      acc[j] += dpp_mov<0x128>(acc[j]);
      { auto rr = __builtin_amdgcn_permlane16_swap(__float_as_uint(acc[j]), __float_as_uint(acc[j]), false, false); acc[j] = __uint_as_float(rr[0]) + __uint_as_float(rr[1]); }
      { auto rr = __builtin_amdgcn_permlane32_swap(__float_as_uint(acc[j]), __float_as_uint(acc[j]), false, false); acc[j] = __uint_as_float(rr[0]) + __uint_as_float(rr[1]); }
    }
    if (eg == 0) {
      int b, t, isc; row_info(r, b, t, isc);
      const float* g2 = (const float*)(p.ws + OFF_MOD) + ((size_t)layer * 3 + (isc ? 2 : b)) * 6144 + 5120 + slice * 128 + ch * 16;
      float* xr = xs + (size_t)r * DM + slice * 128 + ch * 16;
#pragma unroll
      for (int q = 0; q < 4; ++q) {
        f32x4 xq = *(const f32x4*)(xr + 4 * q);
#pragma unroll
        for (int j = 0; j < 4; ++j) xq[j] += g2[4 * q + j] * acc[4 * q + j];
        *(f32x4*)(xr + 4 * q) = xq;
      }
    }
  }
  __syncthreads();
  {
    const bool last = (layer == 1);
    const float* g = last ? p.in[I_FG] : p.in[I_N1G] + (layer + 1) * DM;
    bf16_t* hbw = (bf16_t*)(p.ws + OFF_HB);
#pragma unroll 1
    for (int tl0 = wid * 3; tl0 < ntb; tl0 += 24) {
      f32x4 v[3][4]; float ss[3]; const float* modj[3];
#pragma unroll
      for (int j = 0; j < 3; ++j) {
        int b, t, isc; row_info(min(tok0 + tl0 + j, tok0 + ntb - 1), b, t, isc);
        modj[j] = (const float*)(p.ws + OFF_MOD) + ((size_t)(last ? 1 : layer + 1) * 3 + (isc ? 2 : b)) * 6144;
      }
#pragma unroll
      for (int j = 0; j < 3; ++j) {
        const int r = min(tok0 + tl0 + j, tok0 + ntb - 1);
        ss[j] = 0.f;
#pragma unroll
        for (int i = 0; i < 4; ++i) { v[j][i] = *(const f32x4*)(xs + (size_t)r * DM + (i * 64 + lane) * 4); ss[j] += v[j][i][0] * v[j][i][0] + v[j][i][1] * v[j][i][1] + v[j][i][2] * v[j][i][2] + v[j][i][3] * v[j][i][3]; }
      }
#pragma unroll
      for (int j = 0; j < 3; ++j) ss[j] = rsqrtf(wave_sum(ss[j]) * (1.f / DM) + EPSV);
#pragma unroll
      for (int i = 0; i < 4; ++i) {
        const int c0 = (i * 64 + lane) * 4; const f32x4 gv = *(const f32x4*)(g + c0);
#pragma unroll
        for (int j = 0; j < 3; ++j) {
          const int r = tok0 + tl0 + j;
          if (tl0 + j < ntb) {
            if (last) { if (r < NLAT) *(f32x4*)(p.out + (size_t)r * DM + c0) = v[j][i] * ss[j] * gv; }
            else {
              const f32x4 sc = *(const f32x4*)(modj[j] + 1024 + c0), sh = *(const f32x4*)(modj[j] + c0);
              float y[4];
#pragma unroll
              for (int q = 0; q < 4; ++q) y[q] = v[j][i][q] * ss[j] * gv[q] * (1.f + sc[q]) + sh[q];
              const u32x2 o = {cvtpk(y[0], y[1]), cvtpk(y[2], y[3])};
              *(u32x2*)(hbw + (size_t)r * DM + c0) = o;
            }
          }
        }
      }
    }
  }
}

__device__ void final_norm(const Params& p) {
  const int lane = TIDX & 63, wid = TIDX >> 6;
  const float* xs = (const float*)(p.ws + OFF_XS); const float* g = p.in[I_FG];
  for (int grp = BIDX * 8 + wid; grp < NLAT / 4; grp += gridDim.x * 8) {
    const int r0 = grp * 4;
    f32x4 v[4][4]; float ss[4];
#pragma unroll
    for (int j = 0; j < 4; ++j) {
      ss[j] = 0.f;
#pragma unroll
      for (int i = 0; i < 4; ++i) { v[j][i] = *(const f32x4*)(xs + (size_t)(r0 + j) * DM + (i * 64 + lane) * 4); ss[j] += v[j][i][0] * v[j][i][0] + v[j][i][1] * v[j][i][1] + v[j][i][2] * v[j][i][2] + v[j][i][3] * v[j][i][3]; }
    }
#pragma unroll
    for (int j = 0; j < 4; ++j) ss[j] = rsqrtf(wave_sum(ss[j]) * (1.f / DM) + EPSV);
#pragma unroll
    for (int i = 0; i < 4; ++i) {
      const int c0 = (i * 64 + lane) * 4; const f32x4 gv = *(const f32x4*)(g + c0);
#pragma unroll
      for (int j = 0; j < 4; ++j) { const f32x4 o = v[j][i] * ss[j] * gv; *(f32x4*)(p.out + (size_t)(r0 + j) * DM + c0) = o; }
    }
  }
}

namespace pg8 {
#define PG8_LAS __attribute__((address_space(3)))
typedef unsigned short bf16_t;
typedef short bf16x8 __attribute__((ext_vector_type(8)));
typedef float f32x4 __attribute__((ext_vector_type(4)));
typedef unsigned u32x4 __attribute__((ext_vector_type(4)));
constexpr int BM = 256, BK = 64, HALF = 128, HTB = HALF * BK * 2  , STAGE_BYTES = 8 * HTB, NXCD = 8, WGM = 8;

__host__ __device__ __forceinline__ int lds_byte(int r, int c) { const int st = (r >> 4) * 2 + (c >> 5), rr = r & 15, cc = c & 31, ob = rr * 64 + cc * 2; return st * 1024 + (ob ^ (((ob >> 9) & 1) << 5)); }
__host__ __device__ __forceinline__ void stage_rc(int b, int& R, int& C) { const int st = b / 1024, sb = b % 1024, swz = sb ^ (((sb >> 9) & 1) << 5); R = (st >> 1) * 16 + swz / 64; C = (st & 1) * 32 + (swz % 64) / 2; }
__host__ __device__ __forceinline__ int perm32(int rho) { const int n = rho >> 4, i = rho & 15; return 8 * (i >> 2) + 4 * n + (i & 3); }

struct Unit { int pm, pn; };
struct Gemm { const bf16_t* A; const bf16_t* Bt; int M, N, K; };

struct StaticOrder {
    int nM, nN, nwg, G, c;
    __host__ __device__ void init(int M, int N, int G_, int c_) { nM = M / BM; nN = N / BM; nwg = nM * nN; G = G_; c = c_; }
    __host__ __device__ bool next(int i, Unit& u) const {
        const long L = (long)i * G + c; if (L >= nwg) return false;
        int wgid = (int)L; { const int q = nwg / NXCD, r = nwg % NXCD, xcd = wgid % NXCD, off = wgid / NXCD; wgid = (xcd < r ? xcd * (q + 1) : r * (q + 1) + (xcd - r) * q) + off; }
        const int nig = WGM * nN, gid = wgid / nig, fm = gid * WGM, gsz = (nM - fm) < WGM ? (nM - fm) : WGM;
        u.pm = fm + ((wgid % nig) % gsz); u.pn = (wgid % nig) / gsz; return true;
    }
    __device__ __forceinline__ void a_ready(const Unit&) const {}
    __device__ __forceinline__ void done(const Unit&) const {}
};
template <class Epi, class Sched, bool STAMP = false>
__device__ __forceinline__ void gemm_phase(PG8_LAS unsigned char* lds, const Gemm g, const Sched& S, const Epi& E, unsigned long long* stamps) {
    const int tid = launder_v((int)threadIdx.x)  , wid = __builtin_amdgcn_readfirstlane(tid >> 6), lane = tid & 63, wr = wid >> 2, wc = wid & 3, fr = lane & 15, fq = lane >> 4;
    const int K = g.K, nt = K / BK;
    int ts_lo = 0, ts_hi = 0, nts = 0; const unsigned long long rt_entry = STAMP ? 0ull : 0ull;
#define PG8_STAMP() do { if (STAMP && wid == 0 && nts < 64) { const unsigned long long _c = 0ull; \
        ts_lo = (lane == nts) ? (int)(unsigned)_c : ts_lo; ts_hi = (lane == nts) ? (int)(unsigned)(_c >> 32) : ts_hi; ++nts; } } while (0)
    PG8_STAMP();
    unsigned voffA[2], voffB[2];
#pragma unroll
    for (int i = 0; i < 2; ++i) { int R, C; stage_rc(tid * 16 + i * 8192, R, C); const int Rb = Epi::PERM ? ((R & ~31) + perm32(R & 31)) : R;
        voffA[i] = (unsigned)(R * K + C) * 2u; voffB[i] = (unsigned)(Rb * K + C) * 2u; }
    const size_t kstep = (size_t)(BK * 2);
    const size_t hstep = (size_t)HALF * K * 2;
    const size_t tstep = 2 * hstep;
    const unsigned ldsw = (unsigned)wid * 1024u;
    const int aoff = lds_byte(wr * 64 + fr, fq * 8), boff = launder_v(lds_byte(wc * 32 + fr, fq * 8) + 4 * HTB);
#define PG8_SA(b, h) (((b) * 2 + (h)) * HTB)
#define PG8_SB(b, h) ((4 + (b) * 2 + (h)) * HTB)
#define PG8_STAGE(bufoff, gbase, voff) do { _Pragma("unroll") for (int _i = 0; _i < 2; ++_i) \
        __builtin_amdgcn_global_load_lds((const unsigned*)((const char*)(gbase) + (voff)[_i]), (PG8_LAS unsigned*)(lds + (bufoff) + ldsw + _i * 8192), 16, 0, 0); } while (0)
#define PG8_LDA(dst, b, h) do { _Pragma("unroll") for (int m = 0; m < 4; ++m) _Pragma("unroll") for (int k = 0; k < 2; ++k) dst[m][k] = *(const PG8_LAS bf16x8*)(lds + PG8_SA(b, h) + aoff + m * 2048 + k * 1024); } while (0)
#define PG8_LDB(dst, b, h) do { _Pragma("unroll") for (int n = 0; n < 2; ++n) _Pragma("unroll") for (int k = 0; k < 2; ++k) dst[n][k] = *(const PG8_LAS bf16x8*)(lds + boff + ((b) * 2 + (h)) * HTB + n * 2048 + k * 1024); } while (0)
#define PG8_MMA(ai, bj, At, Bt) do { __builtin_amdgcn_s_setprio(1); _Pragma("unroll") for (int m = 0; m < 4; ++m) _Pragma("unroll") for (int n = 0; n < 2; ++n) _Pragma("unroll") for (int k = 0; k < 2; ++k) \
        acc[ai][bj][m][n] = __builtin_amdgcn_mfma_f32_16x16x32_bf16(Bt[n][k], At[m][k], acc[ai][bj][m][n], 0, 0, 0); __builtin_amdgcn_s_setprio(0); } while (0)
#define PG8_WAIT_V(n) asm volatile("s_waitcnt vmcnt(" #n ")" ::: "memory")
#define PG8_WAIT_L(n) asm volatile("s_waitcnt lgkmcnt(" #n ")" ::: "memory")
#define PG8_BAR __builtin_amdgcn_s_barrier()
#define PG8_SCHED __builtin_amdgcn_sched_barrier(0)
    Unit cur, nxt; int ui = 0;
    if (!S.next(0, cur)) return;
    f32x4 acc[2][2][4][2];
#pragma unroll
    for (int a = 0; a < 2; ++a)
#pragma unroll
        for (int b = 0; b < 2; ++b)
#pragma unroll
            for (int m = 0; m < 4; ++m)
#pragma unroll
                for (int n = 0; n < 2; ++n) acc[a][b][m][n] = (f32x4){0.f, 0.f, 0.f, 0.f};
    bf16x8 At[4][2], B0[2][2], B1[2][2];
    const char* cA = (const char*)g.A + (size_t)cur.pm * tstep; const char* cB = (const char*)g.Bt + (size_t)cur.pn * tstep;
    S.a_ready(cur);
    PG8_STAGE(PG8_SB(0, 0), cB, voffB); PG8_STAGE(PG8_SA(0, 0), cA, voffA); PG8_STAGE(PG8_SB(0, 1), cB + hstep, voffB); PG8_STAGE(PG8_SA(0, 1), cA + hstep, voffA);
    if (wr == 1) PG8_BAR;
    PG8_WAIT_V(4); PG8_BAR;
    PG8_STAGE(PG8_SB(1, 0), cB + kstep, voffB); PG8_STAGE(PG8_SA(1, 0), cA + kstep, voffA); PG8_STAGE(PG8_SB(1, 1), cB + hstep + kstep, voffB);
    PG8_WAIT_V(6); PG8_BAR;
    PG8_STAMP();
    for (;;) {
        const bool has_next = S.next(ui + 1, nxt);
        const char* nA = has_next ? (const char*)g.A + (size_t)nxt.pm * tstep : cA; const char* nB = has_next ? (const char*)g.Bt + (size_t)nxt.pn * tstep : cB;
        for (int t = 0; t < nt; t += 2) {
            const bool last = (t == nt - 2);
            const char* a1 = cA + (size_t)(t + 1) * kstep;
            const char* a2 = last ? nA : cA + (size_t)(t + 2) * kstep; const char* b2 = last ? nB : cB + (size_t)(t + 2) * kstep;
            const char* a3 = a2 + kstep; const char* b3 = b2 + kstep;
            if (last && has_next) S.a_ready(nxt);
            PG8_LDB(B0, 0, 0); PG8_SCHED; PG8_LDA(At, 0, 0); PG8_STAGE(PG8_SA(1, 1), a1 + hstep, voffA);
            PG8_WAIT_L(8); PG8_BAR; PG8_WAIT_L(0); PG8_MMA(0, 0, At, B0); PG8_BAR; PG8_SCHED;
            PG8_LDB(B1, 0, 1); PG8_STAGE(PG8_SB(0, 0), b2, voffB);
            PG8_BAR; PG8_WAIT_L(0); PG8_MMA(0, 1, At, B1); PG8_BAR;
            PG8_LDA(At, 0, 1); PG8_STAGE(PG8_SA(0, 0), a2, voffA);
            PG8_BAR; PG8_WAIT_L(0); PG8_MMA(1, 0, At, B0); PG8_BAR; PG8_SCHED;
            PG8_STAGE(PG8_SB(0, 1), b2 + hstep, voffB);
            PG8_WAIT_V(6); PG8_BAR; PG8_MMA(1, 1, At, B1); PG8_BAR;
            PG8_LDB(B0, 1, 0); PG8_SCHED; PG8_LDA(At, 1, 0); PG8_STAGE(PG8_SA(0, 1), a2 + hstep, voffA);
            PG8_WAIT_L(8); PG8_BAR; PG8_WAIT_L(0); PG8_MMA(0, 0, At, B0); PG8_BAR; PG8_SCHED;
            PG8_LDB(B1, 1, 1); PG8_STAGE(PG8_SB(1, 0), b3, voffB);
            PG8_BAR; PG8_WAIT_L(0); PG8_MMA(0, 1, At, B1); PG8_BAR;
            PG8_LDA(At, 1, 1); PG8_STAGE(PG8_SA(1, 0), a3, voffA);
            PG8_BAR; PG8_WAIT_L(0); PG8_MMA(1, 0, At, B0); PG8_BAR; PG8_SCHED;
            PG8_STAGE(PG8_SB(1, 1), b3 + hstep, voffB);
            PG8_WAIT_V(6); PG8_BAR; PG8_MMA(1, 1, At, B1); PG8_BAR;
        }
        PG8_STAMP();
        if constexpr (!Epi::AFTER_DRAIN) { E(acc, cur, wr, wc, fr, fq); S.done(cur); }
        PG8_STAMP();
        if (!has_next) break;
#pragma unroll
        for (int a = 0; a < 2; ++a)
#pragma unroll
            for (int b = 0; b < 2; ++b)
#pragma unroll
                for (int m = 0; m < 4; ++m)
#pragma unroll
                    for (int n = 0; n < 2; ++n) acc[a][b][m][n] = (f32x4){0.f, 0.f, 0.f, 0.f};
        cur = nxt; cA = nA; cB = nB; ++ui;
    }
    PG8_WAIT_V(0);
    if (wr == 0) PG8_BAR;
    PG8_BAR;
    if constexpr (Epi::AFTER_DRAIN) { E.fused(acc, cur, wr, wc, fr, fq, lds, wid, lane); S.done(cur); }
    PG8_STAMP();
    if (STAMP && wid == 0) { stamps[lane] = lane < nts ? (((unsigned long long)(unsigned)ts_hi << 32) | (unsigned)ts_lo) : 0ull;
        if (lane == 62) stamps[62] = rt_entry; if (lane == 63) stamps[63] = 0ull; }
#undef PG8_STAMP
#undef PG8_SA
#undef PG8_SB
#undef PG8_STAGE
#undef PG8_LDA
#undef PG8_LDB
#undef PG8_MMA
#undef PG8_WAIT_V
#undef PG8_WAIT_L
#undef PG8_BAR
#undef PG8_SCHED
}
}

template <class F> struct EpiFn {
  static constexpr bool PERM = false, AFTER_DRAIN = false;
  F f;
  __device__ __forceinline__ void operator()(const pg8::f32x4 (&acc)[2][2][4][2], const pg8::Unit& u, int wr, int wc, int fr, int fq) const {
#pragma unroll
    for (int ai = 0; ai < 2; ++ai)
#pragma unroll
      for (int m = 0; m < 4; ++m) {
        const int row = u.pm * 256 + ai * 128 + wr * 64 + m * 16 + fr;
#pragma unroll
        for (int bj = 0; bj < 2; ++bj)
#pragma unroll
          for (int n = 0; n < 2; ++n) f(row, u.pn * 256 + bj * 128 + wc * 32 + n * 16 + 4 * fq, acc[ai][bj][m][n]);
      }
  }
};
template <int NN> struct RowMajorOrder {
  int nwg, G, c;
  __device__ __forceinline__ bool next(int i, pg8::Unit& u) const { const int L = i * G + c; if (L >= nwg) return false; u.pm = L / NN; u.pn = L - u.pm * NN; return true; }
  __device__ __forceinline__ void a_ready(const pg8::Unit&) const {}
  __device__ __forceinline__ void done(const pg8::Unit&) const {}
};
template <class F> struct EpiFn8 {
  static constexpr bool PERM = true, AFTER_DRAIN = false;
  F f;
  __device__ __forceinline__ void operator()(const pg8::f32x4 (&acc)[2][2][4][2], const pg8::Unit& u, int wr, int wc, int fr_, int fq_) const {
    const int fr = launder_v(fr_), fq = launder_v(fq_);
#pragma unroll
    for (int ai = 0; ai < 2; ++ai)
#pragma unroll
      for (int m = 0; m < 4; ++m) {
        const int row = u.pm * 256 + ai * 128 + wr * 64 + m * 16 + fr;
#pragma unroll
        for (int bj = 0; bj < 2; ++bj) f(row, u.pn * 256 + bj * 128 + wc * 32 + 8 * fq, acc[ai][bj][m][0], acc[ai][bj][m][1]);
      }
  }
};
template <int N, class F>
__device__ __forceinline__ void gemm256p(const bf16_t* A, const bf16_t* Bt, int M, int K, F f, char* smem) {
  pg8::Gemm g; g.A = A; g.Bt = Bt; g.M = M; g.N = N; g.K = K;
  RowMajorOrder<N / 256> S; S.nwg = (M / 256) * (N / 256); S.G = (int)gridDim.x; S.c = BIDX;
  EpiFn8<F> E{f};
  __syncthreads();
  pg8::gemm_phase<EpiFn8<F>, RowMajorOrder<N / 256>, false>((PG8_LAS unsigned char*)smem, g, S, E, nullptr);
  __syncthreads();
}
template <int N, class F>
__device__ __forceinline__ void gemm256(const bf16_t* A, const bf16_t* Bt, int M, int K, F f, char* smem) {
  pg8::Gemm g; g.A = A; g.Bt = Bt; g.M = M; g.N = N; g.K = K;
  RowMajorOrder<N / 256> S; S.nwg = (M / 256) * (N / 256); S.G = (int)gridDim.x; S.c = BIDX;
  EpiFn<F> E{f};
  __syncthreads();
  pg8::gemm_phase<EpiFn<F>, RowMajorOrder<N / 256>, false>((PG8_LAS unsigned char*)smem, g, S, E, nullptr);
  __syncthreads();
}

#define XB_TMO      128
#define XB_XCNT(j)  (256  + 64 * (j))
#define XB_XSUB(j)  (1280 + 64 * (j))
#define XB_XGEN(j)  (2304 + 64 * (j))
#define XB_TOP      3328
#define XB_TOPGEN   3392
#define XCD_BAR_WORDS 3456
#define XB_SPIN_CAP (1u << 22)
#define LAS __attribute__((address_space(3)))
__device__ __forceinline__ unsigned xb_ld(unsigned* p)              { return __hip_atomic_load(p, __ATOMIC_RELAXED, __HIP_MEMORY_SCOPE_AGENT); }
__device__ __forceinline__ unsigned xb_add(unsigned* p, unsigned v) { return __hip_atomic_fetch_add(p, v, __ATOMIC_RELAXED, __HIP_MEMORY_SCOPE_AGENT); }
__device__ __forceinline__ unsigned xb_xcc_id() { return (unsigned)__builtin_amdgcn_s_getreg((3 << 11) | 20) & 0xFu; }
#define XB_SPIN(cond, bar) do { unsigned _sp = 0; while (cond) { __builtin_amdgcn_s_sleep(1); \
    if ((++_sp & 255u) == 0u) { if (xb_ld(&(bar)[XB_TMO])) break; if (_sp > XB_SPIN_CAP) { atomicAdd(&(bar)[XB_TMO], 1u); break; } } } } while (0)
struct XcdBarrier { unsigned* bar; unsigned x; volatile LAS unsigned* st; };
__device__ __forceinline__ XcdBarrier xcd_barrier_post(unsigned* bar, volatile LAS unsigned* st) {
  XcdBarrier b; b.bar = bar; b.x = xb_xcc_id(); b.st = st;
  if (threadIdx.x == 0) (void)xb_add(&bar[XB_XCNT(b.x)], 1u);
  return b;
}
__device__ __forceinline__ void xcd_barrier_complete(unsigned* bar, unsigned x, unsigned& nloc, unsigned& nx) {
  const unsigned G = gridDim.x * gridDim.y * gridDim.z;
  unsigned sum, cnt, mine, sp = 0u;
  for (;;) {
    sum = 0u; cnt = 0u; mine = 0u;
#pragma unroll
    for (unsigned j = 0; j < 16; ++j) { const unsigned c = xb_ld(&bar[XB_XCNT(j)]); sum += c; cnt += (c > 0u) ? 1u : 0u; mine = (j == x) ? c : mine; }
    if (sum == G) break;
    __builtin_amdgcn_s_sleep(1);
    if ((++sp & 255u) == 0u) { if (xb_ld(&bar[XB_TMO])) break; if (sp > XB_SPIN_CAP) { atomicAdd(&bar[XB_TMO], 1u); break; } }
  }
  nloc = mine > 0u ? mine : 1u; nx = cnt > 0u ? cnt : 1u;
}
__device__ __forceinline__ void xcd_barrier(const XcdBarrier& b) {
  asm volatile("s_waitcnt vmcnt(0)" ::: "memory");
  __syncthreads();
  if (threadIdx.x == 0) {
    unsigned* bar = b.bar;
    __builtin_amdgcn_s_waitcnt(0);
    unsigned nloc = b.st[0], nx = b.st[1];
    if (nloc == 0u) { xcd_barrier_complete(bar, b.x, nloc, nx); b.st[0] = nloc; b.st[1] = nx; }
    const unsigned old = xb_add(&bar[XB_XSUB(b.x)], 1u);
    const unsigned gen = old / nloc;
    if (old + 1u == (gen + 1u) * nloc) {
      __builtin_amdgcn_fence(__ATOMIC_RELEASE, "agent");
      asm volatile("s_waitcnt vmcnt(0)" ::: "memory");
      const unsigned og = xb_add(&bar[XB_TOP], 1u);
      const unsigned tg = og / nx;
      if (og + 1u == (tg + 1u) * nx) xb_add(&bar[XB_TOPGEN], 1u);
      else XB_SPIN(xb_ld(&bar[XB_TOPGEN]) == tg, bar);
      __builtin_amdgcn_fence(__ATOMIC_ACQUIRE, "agent");
      xb_add(&bar[XB_XGEN(b.x)], 1u);
      asm volatile("s_waitcnt vmcnt(0)" ::: "memory");
    } else {
      XB_SPIN(xb_ld(&bar[XB_XGEN(b.x)]) == gen, bar);
      __builtin_amdgcn_fence(__ATOMIC_ACQUIRE, "agent");
      asm volatile("s_waitcnt vmcnt(0)" ::: "memory");
    }
  }
  __syncthreads();
}

constexpr int NSTAGES = 23;
constexpr int SMEM_BYTES = 135168;
template <int S>
__device__ __forceinline__ void run_stage_t(const Params& p0, int layer0, char* smem0) {
  Params p = p0; int layer = layer0; char* smem = smem0;
  { unsigned long long w = (unsigned long long)p0.ws, o = (unsigned long long)p0.out;
    asm volatile("" : "+s"(w), "+s"(o), "+s"(layer));
    p.ws = (char*)(__attribute__((address_space(1))) char*)w; p.out = (float*)(__attribute__((address_space(1))) float*)o; }
  const int nrows = (layer == 0) ? NTOK : NLAT;
  if constexpr (S == 100) stage_prep(p, smem);
  if constexpr (S == 101) stage_prep2(p, smem);
  if constexpr (S == 102) final_norm(p);
  if constexpr (S == 0) stage_norm(p, layer, 0, NTOK);
  if constexpr (S == 1) {
    bf16_t* u = (bf16_t*)(p.ws + OFF_U);
    gemm256p<DINP>((const bf16_t*)(p.ws + OFF_HB), (const bf16_t*)(p.ws + OFF_WIN) + (size_t)layer * DINP * 1024, NTOK, 1024,
            [=](int row, int col0, f32x4 v, f32x4 w) { if (col0 < DIN) { const u32x4 o = {cvtpk(v[0], v[1]), cvtpk(v[2], v[3]), cvtpk(w[0], w[1]), cvtpk(w[2], w[3])}; *(u32x4*)(u + (size_t)row * DIN + col0) = o; } }, smem);
    {
      const int nunits = (NTOK / 256) * (DINP / 256), G = (int)gridDim.x, rem = nunits % G, c = BIDX;
      if (rem == 0) peer_cvt_tables(p, layer, c, G); else if (c >= rem) peer_cvt_tables(p, layer, c - rem, G - rem);
    }
  }
  if constexpr (S == 2) { lru_units(p, layer, 0, smem); mla_prep(p, layer); hyena_prep(p, layer, smem);
#if defined(PROBE_S2)
    __syncthreads();
    if (PROBE_S2 == 0) lru_units(p, layer, 0, smem); else if (PROBE_S2 == 1) mla_prep(p, layer); else hyena_prep(p, layer, smem);
#endif
  }
  if constexpr (S == 3) {
    bf16_t* Q = (bf16_t*)(p.ws + OFF_Q); bf16_t* K = (bf16_t*)(p.ws + OFF_K);
    gemm256p<768>((const bf16_t*)(p.ws + OFF_QN), (const bf16_t*)(p.ws + OFF_WQB) + (size_t)layer * 768 * 384, NTOK, 384,
            [=](int row, int col0, f32x4 v, f32x4 w) {
              if (col0 < 576) {
                const int j = col0 % 96;
                if (j >= 64 && row < NLAT) {
                  const int t = row & (SEQ - 1), i0 = (j & 8) >> 1;
                  const float pos = (j & 16) ? (float)(t & 63) : (float)(t >> 6);
#pragma unroll
                  for (int q = 0; q < 4; ++q) {
                    constexpr float R1 = 0.31622776601683794f;
                    const float invq = (q == 0 ? 1.f : q == 1 ? R1 : q == 2 ? R1 * R1 : R1 * R1 * R1) * 0.15915494309189535f;
                    const float rev = pos * (i0 ? invq * 0.01f : invq);
                    const float cs = __builtin_amdgcn_cosf(rev), sn = __builtin_amdgcn_sinf(rev);
                    if (q < 2) { const float lo = v[2 * q], hh = v[2 * q + 1]; v[2 * q] = lo * cs - hh * sn; v[2 * q + 1] = hh * cs + lo * sn; }
                    else { const float lo = w[2 * q - 4], hh = w[2 * q - 3]; w[2 * q - 4] = lo * cs - hh * sn; w[2 * q - 3] = hh * cs + lo * sn; }
                  }
                }
                const u32x4 o = {cvtpk(v[0], v[1]), cvtpk(v[2], v[3]), cvtpk(w[0], w[1]), cvtpk(w[2], w[3])};
                *(u32x4*)(Q + (size_t)row * 576 + col0) = o;
              }
            }, smem);
    gemm256p<768>((const bf16_t*)(p.ws + OFF_KVN), (const bf16_t*)(p.ws + OFF_WKVB) + (size_t)layer * 768 * 256, NTOK, 256,
            [=](int row, int col0, f32x4 v, f32x4 w) { const u32x4 o = {cvtpk(v[0], v[1]), cvtpk(v[2], v[3]), cvtpk(w[0], w[1]), cvtpk(w[2], w[3])}; *(u32x4*)(K + (size_t)row * 768 + col0) = o; }, smem);
    lru_carry(p, smem);
  }
  if constexpr (S == 4) { attn_units(p, layer, smem); hyena_fft(p, layer, smem); }
  if constexpr (S == 12) { attn_combine(p); hyena_out_transpose(p, smem); hyena_direct(p, layer, smem); lru_final(p, layer, smem); }
  if constexpr (S == 5) {
    float* xs = (float*)(p.ws + OFF_XS); const float* mod = (const float*)(p.ws + OFF_MOD) + (size_t)layer * 3 * 6144;
    const float* xin = p.in[I_X]; const float* cin = p.in[I_CTX];
    const bf16_t* wo = (const bf16_t*)(p.ws + OFF_WOUT) + (size_t)layer * 1024 * 1024;
    gemm256<1024>((const bf16_t*)(p.ws + OFF_MIX), wo, NLAT, 1024,
            [=](int row, int col0, f32x4 v) {
              const float* g1 = mod + (size_t)(row >> 13) * 6144 + 2048 + col0;
              const float* src = (layer == 0) ? xin + (size_t)row * DM + col0 : xs + (size_t)row * DM + col0;
              const f32x4 s4 = *(const f32x4*)src, g4 = *(const f32x4*)g1;
              *(f32x4*)(xs + (size_t)row * DM + col0) = s4 + g4 * v;
            }, smem);
    if (layer == 0)
      gemm_bt((const bf16_t*)(p.ws + OFF_MIX) + (size_t)NLAT * DM, DM, wo, 1024, NCTX, 1024, 1024,
              [=](int row, int col, float v) {
                const float g1 = mod[(size_t)2 * 6144 + 2048 + col];
                xs[(size_t)(NLAT + row) * DM + col] = cin[(size_t)row * DM + col] + g1 * v;
              }, smem);
  }
  if constexpr (S == 6) { stage_norm(p, layer, 1, nrows); }
  if constexpr (S == 7) {
    bf16_t* pq = (bf16_t*)(p.ws + OFF_PQ);
    const bf16_t* wq = (const bf16_t*)(p.ws + OFF_WPQ) + (size_t)layer * 2048 * 1024;
    gemm256p<2048>((const bf16_t*)(p.ws + OFF_HB), wq, NLAT, 1024,
            [=](int row, int col0, f32x4 v, f32x4 w) { const u32x4 o = {cvtpk(v[0], v[1]), cvtpk(v[2], v[3]), cvtpk(w[0], w[1]), cvtpk(w[2], w[3])}; *(u32x4*)(pq + (size_t)row * 2048 + col0) = o; }, smem);
    if (layer == 0)
      gemm_bt((const bf16_t*)(p.ws + OFF_HB) + (size_t)NLAT * DM, DM, wq, 1024, NCTX, 2048, 1024,
              [=](int row, int col, float v) { pq[(size_t)(NLAT + row) * 2048 + col] = f2bf(v); }, smem);
  }
  if constexpr (S == 8) peer_topk(p, layer, nrows, smem);
  if constexpr (S == 9) peer_eval_fused(p, layer, nrows, smem);
}

__device__ __forceinline__ void init_params(Params& p, const KArgs& ka, char* smem) {
  unsigned long long* tab = (unsigned long long*)(smem + SMEM_BYTES);
  if (threadIdx.x == 0) {
#pragma unroll
    for (int i = 0; i < N_IN; ++i) tab[i] = (unsigned long long)ka.in[i];
  }
  __syncthreads();
  p.in.tab = smem + SMEM_BYTES; p.out = ka.out; p.ws = ka.ws;
}

#if MK_SINGLE
#define SYNC() xcd_barrier(xb)
__global__ void __launch_bounds__(NTHREADS) mega_kernel(KArgs ka) {
  __shared__ __attribute__((aligned(16))) char smem[SMEM_BYTES + 512];
  cg::grid_group grid = cg::this_grid();
  if (threadIdx.x == 0) *(uint4*)(smem + SMEM_BYTES + 320) = make_uint4(0u, 0u, 0u, 0u);
  Params p; init_params(p, ka, smem);
  const XcdBarrier xb = xcd_barrier_post((unsigned*)(ka.ws + OFF_BAR), (volatile LAS unsigned*)(smem + SMEM_BYTES + 320));
  run_stage_t<100>(p, 0, smem); grid.sync();
#if defined(PROBE_PREP) && PROBE_PREP == 100
  run_stage_t<100>(p, 0, smem); SYNC();
#endif
  run_stage_t<101>(p, 0, smem); SYNC();
#if defined(PROBE_BW)
  {
    const u32x4* base = (const u32x4*)(ka.ws + (size_t)64 * 1024 * 1024);
    const size_t n16 = (size_t)PROBE_BW * 64 * 1024 * 1024 / 16;
    unsigned acc_ = 0;
    for (size_t i = (size_t)blockIdx.x * NTHREADS + threadIdx.x; i + 7 * (size_t)gridDim.x * NTHREADS < n16; i += 8 * (size_t)gridDim.x * NTHREADS) {
      u32x4 t_[8];
#pragma unroll
      for (int k = 0; k < 8; ++k) t_[k] = base[i + k * (size_t)gridDim.x * NTHREADS];
#pragma unroll
      for (int k = 0; k < 8; ++k) acc_ ^= t_[k][0] ^ t_[k][1] ^ t_[k][2] ^ t_[k][3];
    }
    if (acc_ == 0x12345u) ((unsigned*)(ka.ws + OFF_BAR))[1000] = acc_;
    SYNC();
  }
#endif
#if defined(PROBE_BAR)
  SYNC(); SYNC(); SYNC(); SYNC(); SYNC(); SYNC(); SYNC(); SYNC(); SYNC(); SYNC(); SYNC(); SYNC(); SYNC(); SYNC(); SYNC(); SYNC(); SYNC(); SYNC(); SYNC(); SYNC();
#endif
#if defined(PROBE_PREP) && PROBE_PREP == 101
  run_stage_t<101>(p, 0, smem); SYNC();
#endif
#ifndef PROBE_DUP
#define PROBE_DUP -1
#endif
#define RUNSTAGE(S, layer) do { if (PROBE_DUP == S) { int nrep = 2; asm volatile("" : "+s"(nrep)); \
      for (int rep = 0; rep < nrep; ++rep) { run_stage_t<S>(p, layer, smem); SYNC(); if (S == 9 || S == 11) break; } } \
    else { run_stage_t<S>(p, layer, smem); SYNC(); } } while (0)
#if defined(PROBE_ATT)
#define PROBE_ATT_HOOK(layer) { attn_units<PROBE_ATT, true>(p, layer, smem); SYNC(); }
#else
#define PROBE_ATT_HOOK(layer)
#endif
#define LAYER_PASS(layer) \
    if (layer == 0) { RUNSTAGE(0, layer); } RUNSTAGE(1, layer); RUNSTAGE(2, layer); RUNSTAGE(3, layer); RUNSTAGE(4, layer); PROBE_ATT_HOOK(layer) RUNSTAGE(12, layer); \
    RUNSTAGE(5, layer); RUNSTAGE(6, layer); RUNSTAGE(7, layer); RUNSTAGE(8, layer); RUNSTAGE(9, layer);
  LAYER_PASS(0)
  LAYER_PASS(1)
}
#else
template <int S>
__global__ void __launch_bounds__(NTHREADS) stage_kernel(KArgs ka, int layer) {
  __shared__ __attribute__((aligned(16))) char smem[SMEM_BYTES + 512];
  Params p; init_params(p, ka, smem);
  run_stage_t<S>(p, layer, smem);
}
#endif

extern "C" void kernel_launch(void* const* d_in, const int* in_sizes, int n_in, void* d_out, int out_size, void* d_ws, size_t ws_size, hipStream_t stream) {
  if (n_in != N_IN || ws_size < WS_END) { fprintf(stderr, "kernel_launch: bad args n_in=%d ws=%zu need=%zu\n", n_in, ws_size, (size_t)WS_END); return; }
  KArgs p{};
  for (int i = 0; i < N_IN; ++i) p.in[i] = (const float*)d_in[i];
  p.out = (float*)d_out; p.ws = (char*)d_ws;
#if MK_SINGLE
  static int grid_blocks = 0;
  if (!grid_blocks) {
    int dev = 0, cus = 0, per_cu = 0;
    hipGetDevice(&dev);
    hipDeviceGetAttribute(&cus, hipDeviceAttributeMultiprocessorCount, dev);
    hipOccupancyMaxActiveBlocksPerMultiprocessor(&per_cu, mega_kernel, NTHREADS, 0);
    if (per_cu > 1) per_cu = 1;
    grid_blocks = cus * per_cu;
  }
  hipMemsetAsync((char*)d_ws + OFF_BAR, 0, BAR_BYTES, stream);
  void* args[] = {&p};
  hipError_t e = hipLaunchCooperativeKernel((void*)mega_kernel, dim3(grid_blocks), dim3(NTHREADS), args, 0, stream);
  if (e != hipSuccess) fprintf(stderr, "cooperative launch failed: %s (grid %d)\n", hipGetErrorString(e), grid_blocks);
#else
#define LAUNCH(S, L) hipLaunchKernelGGL(stage_kernel<S>, dim3(256), dim3(NTHREADS), 0, stream, p, L)
  LAUNCH(100, 0); LAUNCH(101, 0);
  for (int layer = 0; layer < 2; ++layer) {
    LAUNCH(0, layer); LAUNCH(1, layer); LAUNCH(2, layer); LAUNCH(3, layer); LAUNCH(4, layer);
    LAUNCH(5, layer); LAUNCH(6, layer); LAUNCH(7, layer); LAUNCH(8, layer); LAUNCH(9, layer);
  }
  LAUNCH(102, 0);
#endif
}
```

```cpp
#include <hip/hip_runtime.h>
#include <hip/hip_cooperative_groups.h>
#include <cstdio>
#include <cstdint>
namespace cg = cooperative_groups;

__device__ __forceinline__ int launder_v(int x) { asm volatile("" : "+v"(x)); return x; }
__device__ __forceinline__ int launder_s(int x) { asm volatile("" : "+s"(x)); return x; }
#define TIDX launder_v((int)threadIdx.x)
#define BIDX launder_s((int)blockIdx.x)

__device__ __forceinline__ float shx(float v, int mask) { const int l = TIDX & 63; return __int_as_float(__builtin_amdgcn_ds_bpermute((l ^ mask) << 2, __float_as_int(v))); }
__device__ __forceinline__ int shxi(int v, int mask) { const int l = TIDX & 63; return __builtin_amdgcn_ds_bpermute((l ^ mask) << 2, v); }
__device__ __forceinline__ float rdl(float v, int srclane) { return __int_as_float(__builtin_amdgcn_readlane(__float_as_int(v), srclane)); }

#ifndef MK_SINGLE
#define MK_SINGLE 1
#endif

typedef unsigned short bf16_t;
using bf16x8 = __attribute__((ext_vector_type(8))) short;
using s16x4  = __attribute__((ext_vector_type(4))) short;
using f32x16 = __attribute__((ext_vector_type(16))) float;
using f32x4  = __attribute__((ext_vector_type(4))) float;
using u32x4  = __attribute__((ext_vector_type(4))) unsigned;
using u32x2  = __attribute__((ext_vector_type(2))) unsigned;

constexpr int NB = 2, SEQ = 8192, CTXL = 256, DM = 1024;
constexpr int NLAT = NB * SEQ, NCTX = NB * CTXL, NTOK = NLAT + NCTX;
constexpr int DIN = 2208, DINP = 2304;
constexpr int DLRU = 384, NKEYS = SEQ + CTXL;
constexpr int NTHREADS = 512;
constexpr int NCHUNK = NLAT / 64 + NCTX / 64;
constexpr float EPSV = 1e-6f;

enum { I_X = 0, I_C, I_CTX, I_CCTX, I_WMOD, I_BMOD, I_N1G, I_N2G, I_WIN, I_WOUT, I_LCW, I_LCB, I_LWR, I_LBR, I_LWI, I_LBI, I_LLAM,
       I_QNG, I_WQB, I_KVNG, I_WKVB, I_HCW, I_HCB, I_HW1, I_HB1, I_HW2, I_HB2, I_HW3, I_HFREQ, I_HDECAY, I_HSKIP,
       I_PWQ, I_PKEYS, I_PU, I_PV, I_FG, N_IN };

struct KArgs { const float* in[N_IN]; float* out; char* ws; };
struct InTab {
  const char* tab;
  __device__ __forceinline__ const float* operator[](int i) const {
    const unsigned long long v = ((const unsigned long long*)tab)[i];
    const unsigned lo = __builtin_amdgcn_readfirstlane((unsigned)v), hi = __builtin_amdgcn_readfirstlane((unsigned)(v >> 32));
    return (const float*)(const __attribute__((address_space(1))) float*)(((unsigned long long)hi << 32) | lo);
  }
};
struct Params { InTab in; float* out; char* ws; };

constexpr size_t al256(size_t x) { return (x + 255) / 256 * 256; }
constexpr size_t OFF_XS    = 0;
constexpr size_t OFF_HB    = OFF_XS    + al256((size_t)NTOK * DM * 4);
constexpr size_t OFF_U     = OFF_HB    + al256((size_t)NTOK * DM * 2);
constexpr size_t OFF_PQ    = OFF_U;
constexpr size_t OFF_LAB   = OFF_U     + al256((size_t)NTOK * DIN * 2);
static_assert(OFF_LAB + (size_t)(NTOK / 32) * 6 * 2 * 2 * 16 * 64 * 4 <= OFF_U + al256((size_t)NTOK * DIN * 4), "LRU coefficient buffer must fit behind the bf16 u");
constexpr size_t OFF_MIX   = OFF_U     + al256((size_t)NTOK * DIN * 4);
constexpr size_t OFF_HYIN  = OFF_MIX   + al256((size_t)NTOK * DM * 2);
constexpr size_t OFF_EID   = OFF_HYIN;
constexpr size_t OFF_GATE  = OFF_EID   + al256((size_t)NTOK * 128 * 4);
constexpr size_t OFF_HYINC = OFF_HYIN  + al256((size_t)3 * 2 * 256 * 8192 * 4);
constexpr size_t OFF_QN    = OFF_HYINC + al256((size_t)3 * 2 * 256 * 256 * 4);
constexpr size_t TAB_BYTES = (size_t)16384 * 1024;
constexpr size_t OFF_UTAB  = al256(OFF_LAB + (size_t)(NTOK / 32) * 6 * 2 * 2 * 16 * 64 * 4);
constexpr size_t OFF_OPART = OFF_QN;
constexpr size_t OFF_OML   = OFF_OPART + (size_t)4 * 2 * SEQ * 64 * 4;
constexpr size_t OFF_KVN   = OFF_QN    + al256((size_t)NTOK * 384 * 2);
constexpr size_t OFF_Q     = OFF_KVN   + al256((size_t)NTOK * 256 * 2);
constexpr size_t OFF_K     = OFF_Q     + al256((size_t)NTOK * 576 * 2);
constexpr size_t OFF_V     = OFF_K     + al256((size_t)NTOK * 768 * 2);
constexpr size_t OFF_LSUM  = OFF_V     + al256((size_t)NTOK * 32 * 2);
static_assert(OFF_OML + (size_t)4 * 2 * SEQ * 2 * 4 <= OFF_Q, "attention partials must fit in the dead QN/KVN region");
static_assert(OFF_UTAB + TAB_BYTES <= OFF_U + al256((size_t)NTOK * DIN * 4), "u table must fit in the tail of the u region");
constexpr size_t OFF_CARRY = OFF_LSUM  + al256((size_t)(NTOK / 32) * 2 * 2 * 384 * 4);
constexpr size_t OFF_MOD   = OFF_CARRY + al256((size_t)(NTOK / 32) * 2 * 384 * 4);
constexpr size_t OFF_MODP  = OFF_MIX;
constexpr size_t OFF_WIN   = OFF_MOD   + al256((size_t)2 * 3 * 6144 * 4);
constexpr size_t OFF_WOUT  = OFF_WIN   + al256((size_t)2 * DINP * 1024 * 2);
constexpr size_t OFF_WQB   = OFF_WOUT  + al256((size_t)2 * 1024 * 1024 * 2);
constexpr size_t OFF_WKVB  = OFF_WQB   + al256((size_t)2 * 768 * 384 * 2);
constexpr size_t OFF_WPQ   = OFF_WKVB  + al256((size_t)2 * 768 * 256 * 2);
constexpr size_t OFF_KEYS  = OFF_WPQ   + al256((size_t)2 * 2048 * 1024 * 2);
constexpr size_t OFF_GW    = OFF_KEYS  + al256((size_t)2 * 2 * 128 * 128 * 2);
constexpr size_t OFF_H2    = OFF_GW    + al256((size_t)2 * 2 * 2 * 6 * 64 * 64 * 2);
constexpr size_t OFF_HSPEC = OFF_H2    + al256((size_t)2 * NKEYS * 64 * 4);
constexpr size_t OFF_FILTC = OFF_HSPEC + al256((size_t)2 * 256 * 2 * 16384 * 4);
constexpr size_t OFF_SSQPC = OFF_FILTC + al256((size_t)2 * 1024 * 256 * 4);
constexpr size_t OFF_BAR   = OFF_SSQPC + al256((size_t)2 * 4 * 1024 * 4);
constexpr size_t OFF_CTR   = OFF_BAR   + al256(3456 * 4);
constexpr size_t BAR_BYTES = al256(3456 * 4) + 2 * 2 * 2 * 16 * 256;
constexpr size_t OFF_VTAB  = OFF_BAR   + al256(BAR_BYTES);
constexpr size_t WS_END    = OFF_VTAB  + al256(TAB_BYTES);
static_assert(WS_END <= (size_t)4 * 2 * 16384 * 1024 * 4, "workspace layout exceeds the guaranteed 4 x largest-tensor size");
constexpr size_t OFF_SP    = OFF_U;
constexpr size_t OFF_WBUF  = OFF_SP    + (size_t)16 * NTOK * 128 * 4;
static_assert(OFF_WBUF + (size_t)NTOK * 128 * 4 <= OFF_MIX, "PEER partials must fit in the u region");

__device__ __forceinline__ float bf2f(bf16_t v) { return __uint_as_float(((unsigned)v) << 16); }
__device__ __forceinline__ bf16_t f2bf(float f) { unsigned u = __float_as_uint(f); u += 0x7fffu + ((u >> 16) & 1u); return (bf16_t)(u >> 16); }
__device__ __forceinline__ unsigned cvtpk(float lo, float hi) { unsigned r; asm volatile("v_cvt_pk_bf16_f32 %0, %1, %2" : "=v"(r) : "v"(lo), "v"(hi)); return r; }
__device__ __forceinline__ float gelu_tanh(float x) { const float z2 = 1.5957691216057308f * (x + 0.044715f * x * x * x); return x * __builtin_amdgcn_rcpf(1.f + __expf(-z2)); }
__device__ __forceinline__ float sigm(float x) { return 1.f / (1.f + __expf(-x)); }
template <int CTRL> __device__ __forceinline__ float dpp_mov(float x) { return __builtin_bit_cast(float, __builtin_amdgcn_mov_dpp(__builtin_bit_cast(int, x), CTRL, 0xf, 0xf, true)); }
__device__ __forceinline__ float wave_sum(float v) {
  v += dpp_mov<0xB1>(v); v += dpp_mov<0x4E>(v); v += dpp_mov<0x141>(v); v += dpp_mov<0x128>(v);
  { auto r = __builtin_amdgcn_permlane16_swap(__float_as_uint(v), __float_as_uint(v), false, false); v = __uint_as_float(r[0]) + __uint_as_float(r[1]); }
  { auto r = __builtin_amdgcn_permlane32_swap(__float_as_uint(v), __float_as_uint(v), false, false); v = __uint_as_float(r[0]) + __uint_as_float(r[1]); }
  return v;
}
using bf16x2v = __attribute__((ext_vector_type(2))) __bf16;
__device__ __forceinline__ float dot2bf(unsigned a, unsigned b, float acc) { return __builtin_amdgcn_fdot2_f32_bf16(__builtin_bit_cast(bf16x2v, a), __builtin_bit_cast(bf16x2v, b), acc, false); }
__device__ __forceinline__ int crow(int r, int hi) { return (r & 3) + 8 * (r >> 2) + 4 * hi; }
__device__ __forceinline__ void row_info(int r, int& b, int& t, int& isctx) {
  if (r < NLAT) { isctx = 0; b = r >> 13; t = r & (SEQ - 1); } else { isctx = 1; int q = r - NLAT; b = q >> 8; t = q & (CTXL - 1); }
}
__device__ __forceinline__ const float* xrow_src(const Params& p, int layer, int r) {
  if (layer == 0) return (r < NLAT) ? p.in[I_X] + (size_t)r * DM : p.in[I_CTX] + (size_t)(r - NLAT) * DM;
  return (const float*)(p.ws + OFF_XS) + (size_t)r * DM;
}
__device__ __forceinline__ size_t h2idx(int l, int pos, int j) { return (((size_t)l * 16 + (j >> 2)) * NKEYS + pos) * 4 + (j & 3); }
#define JOB_LOOP(t, ntiles, base) for (int t = (int)(((long)BIDX - ((base) % (long)gridDim.x) + gridDim.x) % gridDim.x); t < (ntiles); t += gridDim.x)

__device__ __forceinline__ int rope_slot(int c) { return (c & 16) | ((c & 7) << 1) | ((c >> 3) & 1); }
__device__ void transpose_cvt_job(const float* __restrict__ src, bf16_t* __restrict__ dst, int K, int N, int Npad, char* smem, long& base, int rp = 0) {
  float* tile = (float*)smem;
  const int tk = K / 64, tn = Npad / 64, nt = tk * tn;
  JOB_LOOP(t, nt, base) {
    const int k0 = (t % tk) * 64, n0 = (t / tk) * 64;
    __syncthreads();
    for (int e = TIDX; e < 1024; e += NTHREADS) {
      const int i = e >> 4, j = (e & 15) * 4, n = n0 + j;
      f32x4 v = {0.f, 0.f, 0.f, 0.f};
      if (n < N) v = *(const f32x4*)(src + (size_t)(k0 + i) * N + n);
      tile[j * 65 + i] = v[0]; tile[(j + 1) * 65 + i] = v[1]; tile[(j + 2) * 65 + i] = v[2]; tile[(j + 3) * 65 + i] = v[3];
    }
    __syncthreads();
    {
      const int e = TIDX, j = e >> 3, i8 = (e & 7) * 8;
      const float* tr = tile + j * 65 + i8;
      const u32x4 o = {cvtpk(tr[0], tr[1]), cvtpk(tr[2], tr[3]), cvtpk(tr[4], tr[5]), cvtpk(tr[6], tr[7])};
      int n = n0 + j;
      if (rp && n < N) { const int hh = n / 96, jj = n - hh * 96; if (jj >= 64) n = hh * 96 + 64 + rope_slot(jj - 64); }
      *(u32x4*)(dst + (size_t)n * K + k0 + i8) = o;
    }
  }
  base += nt;
}

__device__ void stage_prep(const Params& p, char* smem) {
  long base = 0;
  for (int l = 0; l < 2; ++l) {
    transpose_cvt_job(p.in[I_WIN] + (size_t)l * 1024 * DIN, (bf16_t*)(p.ws + OFF_WIN) + (size_t)l * DINP * 1024, 1024, DIN, DINP, smem, base);
    transpose_cvt_job(p.in[I_WOUT] + (size_t)l * 1024 * 1024, (bf16_t*)(p.ws + OFF_WOUT) + (size_t)l * 1024 * 1024, 1024, 1024, 1024, smem, base);
    transpose_cvt_job(p.in[I_WQB] + (size_t)l * 384 * 576, (bf16_t*)(p.ws + OFF_WQB) + (size_t)l * 768 * 384, 384, 576, 768, smem, base, 1);
    transpose_cvt_job(p.in[I_WKVB] + (size_t)l * 256 * 768, (bf16_t*)(p.ws + OFF_WKVB) + (size_t)l * 768 * 256, 256, 768, 768, smem, base);
    transpose_cvt_job(p.in[I_PWQ] + (size_t)l * 1024 * 2048, (bf16_t*)(p.ws + OFF_WPQ) + (size_t)l * 2048 * 1024, 1024, 2048, 2048, smem, base);
    for (int d = 0; d < 2; ++d) for (int n = 0; n < 6; ++n) {
      const size_t so = ((size_t)(l * 2 + d) * 6 + n) * 4096;
      transpose_cvt_job(p.in[I_LWR] + so, (bf16_t*)(p.ws + OFF_GW) + ((size_t)((l * 2 + d) * 2 + 0) * 6 + n) * 4096, 64, 64, 64, smem, base);
      transpose_cvt_job(p.in[I_LWI] + so, (bf16_t*)(p.ws + OFF_GW) + ((size_t)((l * 2 + d) * 2 + 1) * 6 + n) * 4096, 64, 64, 64, smem, base);
    }
  }
  {
    const float* src = p.in[I_PKEYS]; bf16_t* dst = (bf16_t*)(p.ws + OFF_KEYS);
    for (int e = BIDX * NTHREADS + TIDX; e < 2 * 2 * 128 * 128; e += gridDim.x * NTHREADS) dst[e] = f2bf(src[e]);
  }
  {
    float* modp = (float*)(p.ws + OFF_MODP);
    const float* cp = p.in[I_C]; const float* ccp = p.in[I_CCTX]; const float* wmod = p.in[I_WMOD];
    JOB_LOOP(it, 768, base) {
      const int l = it / 384, ks = (it % 384) / 12, cgp = it % 12;
      const int col = cgp * 512 + TIDX;
      const float* w = wmod + (size_t)l * 1024 * 6144 + (size_t)(ks * 32) * 6144 + col;
      float a0 = 0.f, a1 = 0.f, a2 = 0.f;
#pragma unroll
      for (int k0 = 0; k0 < 32; k0 += 8) {
        float wv[8];
#pragma unroll
        for (int j = 0; j < 8; ++j) wv[j] = w[(size_t)(k0 + j) * 6144];
#pragma unroll
        for (int j = 0; j < 8; ++j) {
          const int k = ks * 32 + k0 + j;
          const float c0 = cp[k], c1 = cp[1024 + k], c2 = ccp[k];
          a0 += c0 * sigm(c0) * wv[j]; a1 += c1 * sigm(c1) * wv[j]; a2 += c2 * sigm(c2) * wv[j];
        }
      }
      float* o = modp + ((size_t)(l * 32 + ks) * 3) * 6144 + col;
      o[0] = a0; o[6144] = a1; o[2 * 6144] = a2;
    }
    base += 768;
  }
  {
    const int lane = TIDX & 63, wid = TIDX >> 6;
    const float* hw1 = p.in[I_HW1]; const float* hb1 = p.in[I_HB1]; const float* hw2 = p.in[I_HW2]; const float* hb2 = p.in[I_HB2]; const float* hfr = p.in[I_HFREQ];
    constexpr float INV2PI = 0.15915494309189535f;
    for (int it = BIDX * 8 + wid; it < 2 * NKEYS / 4; it += gridDim.x * 8) {
      const int l = it / (NKEYS / 4), pos0 = (it % (NKEYS / 4)) * 4;
      const float* w1 = hw1 + (size_t)l * 17 * 64; const float* w2 = hw2 + (size_t)l * 64 * 64;
      const float fr = hfr[l * 64 + lane], b1v = hb1[l * 64 + lane], b2v = hb2[l * 64 + lane];
      float w1v[17];
#pragma unroll
      for (int i = 0; i < 17; ++i) w1v[i] = w1[i * 64 + lane];
      float h1[4], pre2[4];
#pragma unroll
      for (int j = 0; j < 4; ++j) {
        const int pos = pos0 + j;
        const float tn = (pos < SEQ) ? (float)pos / (float)SEQ : (float)(pos - SEQ) / (float)CTXL;
        float pre = b1v + tn * w1v[0];
#pragma unroll
        for (int i = 0; i < 8; ++i) {
          const float band = 1e-4f + (float)i * ((7.f - 1e-4f) / 7.f);
          const float rev = tn * band;
          pre += __builtin_amdgcn_cosf(rev) * w1v[1 + i] + __builtin_amdgcn_sinf(rev) * w1v[9 + i];
        }
        h1[j] = __builtin_amdgcn_sinf(fr * pre * INV2PI);
        pre2[j] = b2v;
      }
      for (int i = 0; i < 64; ++i) {
        const float wv = w2[i * 64 + lane];
#pragma unroll
        for (int j = 0; j < 4; ++j) pre2[j] += rdl(h1[j], i) * wv;
      }
#pragma unroll
      for (int j = 0; j < 4; ++j) ((float*)(p.ws + OFF_H2))[h2idx(l, pos0 + j, lane)] = __builtin_amdgcn_sinf(fr * pre2[j] * INV2PI);
    }
  }
}

struct cf { float x, y; };
__device__ __forceinline__ cf cmul(cf a, cf b) { return {a.x * b.x - a.y * b.y, a.x * b.y + a.y * b.x}; }
template <bool INV> __device__ __forceinline__ cf twid(float frac) {
  const float c = __builtin_amdgcn_cosf(frac), s = __builtin_amdgcn_sinf(frac); return {c, INV ? s : -s};
}
template <bool INV> __device__ __forceinline__ void r4(cf& a, cf& b, cf& c, cf& d) {
  const cf s0 = {a.x + c.x, a.y + c.y}, s1 = {a.x - c.x, a.y - c.y}, s2 = {b.x + d.x, b.y + d.y}, s3 = {b.x - d.x, b.y - d.y};
  a = {s0.x + s2.x, s0.y + s2.y}; c = {s0.x - s2.x, s0.y - s2.y};
  if (!INV) { b = {s1.x + s3.y, s1.y - s3.x}; d = {s1.x - s3.y, s1.y + s3.x}; }
  else      { b = {s1.x - s3.y, s1.y + s3.x}; d = {s1.x + s3.y, s1.y - s3.x}; }
}
template <bool INV> __device__ __forceinline__ cf cj(cf w) { return {w.x, INV ? -w.y : w.y}; }
template <bool INV> __device__ __forceinline__ void dft16(cf* x) {
#pragma unroll
  for (int m0 = 0; m0 < 4; ++m0) r4<INV>(x[m0], x[4 + m0], x[8 + m0], x[12 + m0]);
  const cf W1 = {0.92387953251128674f, -0.38268343236508977f}, W2 = {0.70710678118654752f, -0.70710678118654752f}, W3 = {0.38268343236508977f, -0.92387953251128674f};
  const cf W4 = {0.f, -1.f}, W6 = {-0.70710678118654752f, -0.70710678118654752f}, W9 = {-0.92387953251128674f, 0.38268343236508977f};
  x[5] = cmul(x[5], cj<INV>(W1)); x[6] = cmul(x[6], cj<INV>(W2)); x[7] = cmul(x[7], cj<INV>(W3));
  x[9] = cmul(x[9], cj<INV>(W2)); x[10] = cmul(x[10], cj<INV>(W4)); x[11] = cmul(x[11], cj<INV>(W6));
  x[13] = cmul(x[13], cj<INV>(W3)); x[14] = cmul(x[14], cj<INV>(W6)); x[15] = cmul(x[15], cj<INV>(W9));
#pragma unroll
  for (int q0 = 0; q0 < 4; ++q0) r4<INV>(x[4 * q0], x[4 * q0 + 1], x[4 * q0 + 2], x[4 * q0 + 3]);
}
template <bool INV> __device__ __forceinline__ void dft8(cf* x) {
#pragma unroll
  for (int m0 = 0; m0 < 4; ++m0) { const cf a = x[m0], b = x[4 + m0]; x[m0] = {a.x + b.x, a.y + b.y}; x[4 + m0] = {a.x - b.x, a.y - b.y}; }
  const cf V1 = {0.70710678118654752f, -0.70710678118654752f}, V2 = {0.f, -1.f}, V3 = {-0.70710678118654752f, -0.70710678118654752f};
  x[5] = cmul(x[5], cj<INV>(V1)); x[6] = cmul(x[6], cj<INV>(V2)); x[7] = cmul(x[7], cj<INV>(V3));
  r4<INV>(x[0], x[1], x[2], x[3]); r4<INV>(x[4], x[5], x[6], x[7]);
}
template <bool COL> __device__ __forceinline__ int fidx(int ln, int i) { return COL ? i * 129 + ln : ln * 129 + i; }
template <bool INV, bool COL> __device__ __forceinline__ void fft_passA(cf* buf) {
  for (int it = 0; it < 2; ++it) {
    const int bf = TIDX + NTHREADS * it, ln = bf & 127, j = bf >> 7;
    cf x[16];
    if (!INV) {
#pragma unroll
      for (int m = 0; m < 16; ++m) x[m] = buf[fidx<COL>(ln, j + 8 * m)];
      dft16<false>(x);
#pragma unroll
      for (int q = 0; q < 16; ++q) buf[fidx<COL>(ln, j + 8 * q)] = cmul(x[4 * (q & 3) + (q >> 2)], twid<false>((float)(q * j) * (1.f / 128.f)));
    } else {
#pragma unroll
      for (int q = 0; q < 16; ++q) x[q] = cmul(buf[fidx<COL>(ln, j + 8 * q)], twid<true>((float)(q * j) * (1.f / 128.f)));
      dft16<true>(x);
#pragma unroll
      for (int m = 0; m < 16; ++m) buf[fidx<COL>(ln, j + 8 * m)] = x[4 * (m & 3) + (m >> 2)];
    }
  }
}
template <bool INV, bool COL> __device__ __forceinline__ void fft_passB(cf* buf) {
  for (int it = 0; it < 4; ++it) {
    const int bf = TIDX + NTHREADS * it, ln = bf & 127, B = bf >> 7;
    cf x[8];
    if (!INV) {
#pragma unroll
      for (int m = 0; m < 8; ++m) x[m] = buf[fidx<COL>(ln, 8 * B + m)];
      dft8<false>(x);
#pragma unroll
      for (int q = 0; q < 8; ++q) {
        cf v = x[4 * (q & 1) + (q >> 1)];
        if (COL) v = cmul(v, twid<false>((float)(ln * (B + 16 * q)) * (1.f / 16384.f)));
        buf[fidx<COL>(ln, 8 * B + q)] = v;
      }
    } else {
#pragma unroll
      for (int q = 0; q < 8; ++q) {
        cf v = buf[fidx<COL>(ln, 8 * B + q)];
        if (COL) v = cmul(v, twid<true>((float)(ln * (B + 16 * q)) * (1.f / 16384.f)));
        x[q] = v;
      }
      dft8<true>(x);
#pragma unroll
      for (int m = 0; m < 8; ++m) buf[fidx<COL>(ln, 8 * B + m)] = x[4 * (m & 1) + (m >> 1)];
    }
  }
}
__device__ __forceinline__ void fft_fwd(cf* buf) {
  fft_passA<false, true>(buf); __syncthreads(); fft_passB<false, true>(buf); __syncthreads();
  fft_passA<false, false>(buf); __syncthreads(); fft_passB<false, false>(buf); __syncthreads();
}
__device__ __forceinline__ void fft_inv(cf* buf) {
  fft_passB<true, false>(buf); __syncthreads(); fft_passA<true, false>(buf); __syncthreads();
  fft_passB<true, true>(buf); __syncthreads(); fft_passA<true, true>(buf); __syncthreads();
}
__device__ __forceinline__ int fft_freq(int r, int c) { return ((r >> 3) + 16 * (r & 7)) + 128 * ((c >> 3) + 16 * (c & 7)); }
__device__ __forceinline__ int fft_pos(int k) {
  const int k1 = k & 127, k2 = k >> 7; return (8 * (k1 & 15) + (k1 >> 4)) * 129 + 8 * (k2 & 15) + (k2 >> 4);
}
constexpr int FFT_LDS = 128 * 129 * 8;

__device__ void hyena_spectra(const Params& p, char* smem) {
  cf* buf = (cf*)smem; float* fb = (float*)smem;
  float* w3s = (float*)(smem + FFT_LDS);
  float* red = w3s + 256;
  const int tid = TIDX, lane = tid & 63, wid = tid >> 6;
  for (int unit = BIDX; unit < 512; unit += gridDim.x) {
    const int l = unit >> 8, c = unit & 255;
    __syncthreads();
    if (tid < 256) { const int i = tid >> 2, j = tid & 3; w3s[tid] = p.in[I_HW3][(size_t)l * 64 * 1024 + (size_t)i * 1024 + j * 256 + c]; }
    if (tid == 0) buf[64 * 129] = cf{0.f, 0.f};
    __syncthreads();
    float dec[4], ss[4];
#pragma unroll
    for (int j = 0; j < 4; ++j) { dec[j] = p.in[I_HDECAY][l * 1024 + j * 256 + c]; ss[j] = 0.f; }
    const float* h2 = (const float*)(p.ws + OFF_H2) + (size_t)l * 16 * NKEYS * 4;
#pragma unroll 1
    for (int i = 0; i < 16; ++i) {
      const int t = tid + NTHREADS * i;
      float a[4] = {0.f, 0.f, 0.f, 0.f};
      const f32x4* hr = (const f32x4*)(h2 + (size_t)t * 4);
#pragma unroll
      for (int kh = 0; kh < 2; ++kh) {
        f32x4 hv8[8];
#pragma unroll
        for (int k4 = 0; k4 < 8; ++k4) hv8[k4] = hr[(size_t)(kh * 8 + k4) * NKEYS];
#pragma unroll
        for (int k4 = 0; k4 < 8; ++k4) {
          const f32x4 hv = hv8[k4];
#pragma unroll
          for (int kk = 0; kk < 4; ++kk) {
            const f32x4 wv = *(const f32x4*)(w3s + ((kh * 8 + k4) * 4 + kk) * 4);
            a[0] += hv[kk] * wv[0]; a[1] += hv[kk] * wv[1]; a[2] += hv[kk] * wv[2]; a[3] += hv[kk] * wv[3];
          }
        }
      }
      const float tn = (float)t * (1.f / (float)SEQ);
#pragma unroll
      for (int j = 0; j < 4; ++j) { a[j] *= __expf(-tn * dec[j]); ss[j] += a[j] * a[j]; }
      const int pf = (t >> 7) * 129 + (t & 127);
      fb[2 * pf] = a[0]; fb[2 * pf + 1] = a[2];
      if (t > 0) { const int n = 16384 - t, pb = (n >> 7) * 129 + (n & 127); fb[2 * pb] = a[1]; fb[2 * pb + 1] = a[3]; }
    }
#pragma unroll
    for (int j = 0; j < 4; ++j) { ss[j] = wave_sum(ss[j]); if (lane == 0) red[wid * 4 + j] = ss[j]; }
    __syncthreads();
    float sc[4];
#pragma unroll
    for (int j = 0; j < 4; ++j) { float s = 0.f; for (int w = 0; w < 8; ++w) s += red[w * 4 + j]; sc[j] = rsqrtf(s + EPSV) * (1.f / 16384.f); }
    const float sk0 = p.in[I_HSKIP][l * 512 + c] * (1.f / 16384.f), sk1 = p.in[I_HSKIP][l * 512 + 256 + c] * (1.f / 16384.f);
    for (int i = 0; i < 32; ++i) {
      const int n = tid + NTHREADS * i, pi = (n >> 7) * 129 + (n & 127);
      cf v = buf[pi];
      if (n < 8192) { v.x *= sc[0]; v.y *= sc[2]; } else { v.x *= sc[1]; v.y *= sc[3]; }
      if (n == 0) { v.x += sk0; v.y += sk1; }
      buf[pi] = v;
    }
    __syncthreads();
    fft_fwd(buf);
    unsigned* hs = (unsigned*)(p.ws + OFF_HSPEC) + ((size_t)(l * 256 + c) * 2) * 16384;
    for (int i = 0; i < 32; ++i) {
      const int e = tid + NTHREADS * i, r = e >> 7, cc = e & 127;
      const int k = fft_freq(r, cc), k2 = (16384 - k) & 16383;
      const cf a = buf[r * 129 + cc], b = buf[fft_pos(k2)];
      hs[e] = cvtpk(0.5f * (a.x + b.x), 0.5f * (a.y - b.y));
      hs[16384 + e] = cvtpk(0.5f * (a.y + b.y), -0.5f * (a.x - b.x));
    }
  }
}

__device__ void hyena_fft(const Params& p, int layer, char* smem) {
  cf* buf = (cf*)smem;
  const int tid = TIDX;
  bf16_t* mix = (bf16_t*)(p.ws + OFF_MIX);
  const float* hin = (const float*)(p.ws + OFF_HYIN);
  for (int unit = (int)gridDim.x - 1 - BIDX; unit < 256; unit += gridDim.x) {
    const int c = unit;
    const unsigned* hs = (const unsigned*)(p.ws + OFF_HSPEC) + ((size_t)(layer * 256 + c) * 2) * 16384;
    __syncthreads();
    {
      const float* z0 = hin + ((size_t)(0 * 2 + 0) * 256 + c) * SEQ; const float* z1 = hin + ((size_t)(0 * 2 + 1) * 256 + c) * SEQ;
      for (int i = 0; i < 16; ++i) { const int t = tid + NTHREADS * i; buf[(t >> 7) * 129 + (t & 127)] = cf{z0[t], z1[t]}; }
      for (int i = 0; i < 16; ++i) { const int t = 8192 + tid + NTHREADS * i; buf[(t >> 7) * 129 + (t & 127)] = cf{0.f, 0.f}; }
    }
    __syncthreads();
    for (int order = 0; order < 2; ++order) {
      fft_fwd(buf);
      for (int i = 0; i < 32; ++i) {
        const int e = tid + NTHREADS * i, pi = (e >> 7) * 129 + (e & 127);
        const unsigned hv = hs[order * 16384 + e];
        const cf h = {__uint_as_float(hv << 16), __uint_as_float(hv & 0xffff0000u)};
        buf[pi] = cmul(buf[pi], h);
      }
      __syncthreads();
      fft_inv(buf);
      const float* x0 = hin + ((size_t)((1 + order) * 2 + 0) * 256 + c) * SEQ; const float* x1 = hin + ((size_t)((1 + order) * 2 + 1) * 256 + c) * SEQ;
      if (order == 0) {
        for (int i = 0; i < 16; ++i) { const int t = tid + NTHREADS * i, pi = (t >> 7) * 129 + (t & 127); const cf v = buf[pi]; buf[pi] = cf{v.x * x0[t], v.y * x1[t]}; }
        for (int i = 0; i < 16; ++i) { const int t = 8192 + tid + NTHREADS * i; buf[(t >> 7) * 129 + (t & 127)] = cf{0.f, 0.f}; }
        __syncthreads();
      } else {
        bf16_t* yc = (bf16_t*)(p.ws + OFF_HB);
        for (int i = 0; i < 8; ++i) {
          const int t = 2 * (tid + NTHREADS * i); const cf v0 = buf[(t >> 7) * 129 + (t & 127)], v1 = buf[(t >> 7) * 129 + (t & 127) + 1];
          *(unsigned*)(yc + ((size_t)(0 * 256 + c)) * SEQ + t) = cvtpk(v0.x * x0[t], v1.x * x0[t + 1]);
          *(unsigned*)(yc + ((size_t)(1 * 256 + c)) * SEQ + t) = cvtpk(v0.y * x1[t], v1.y * x1[t + 1]);
        }
      }
    }
  }
}

__device__ void stage_prep2(const Params& p, char* smem) {
  {
    float* mod = (float*)(p.ws + OFF_MOD); const float* modp = (const float*)(p.ws + OFF_MODP);
    for (int e = BIDX * NTHREADS + TIDX; e < 2 * 3 * 6144; e += gridDim.x * NTHREADS) {
      const int l = e / (3 * 6144), w = (e / 6144) % 3, col = e % 6144;
      float s = p.in[I_BMOD][l * 6144 + col];
      for (int ks = 0; ks < 32; ++ks) s += modp[((size_t)(l * 32 + ks) * 3 + w) * 6144 + col];
      mod[e] = s;
    }
  }
  float* h2t = (float*)smem;
  float* w3t = h2t + 64 * 65;
  const int tloc = TIDX & 63, cgp = TIDX >> 6, lane = TIDX & 63;
  for (int it = BIDX; it < 2 * 4 * 16; it += gridDim.x) {
    const int l = it / (4 * 16), tt = 128 + (it / 16) % 4, ct = it % 16;
    const bool isc = tt >= 128; const int L = isc ? CTXL : SEQ; const int t0 = isc ? (tt - 128) * 64 : tt * 64;
    const int pos0 = isc ? SEQ + t0 : t0;
    const float* h2 = (const float*)(p.ws + OFF_H2);
    const float* w3 = p.in[I_HW3] + (size_t)l * 64 * 1024 + ct * 64;
    __syncthreads();
    for (int e = TIDX; e < 4096; e += NTHREADS) { int i = e >> 6, j = e & 63; h2t[i * 65 + j] = h2[h2idx(l, pos0 + i, j)]; w3t[i * 64 + j] = w3[(size_t)i * 1024 + j]; }
    __syncthreads();
    float acc[8];
#pragma unroll
    for (int cc = 0; cc < 8; ++cc) acc[cc] = 0.f;
#pragma unroll 2
    for (int i = 0; i < 64; ++i) {
      const float hv = h2t[tloc * 65 + i];
#pragma unroll
      for (int cc = 0; cc < 8; ++cc) acc[cc] += hv * w3t[i * 64 + cgp * 8 + cc];
    }
    const float tn = (float)(t0 + tloc) / (float)L;
#pragma unroll
    for (int cc = 0; cc < 8; ++cc) {
      const int col = ct * 64 + cgp * 8 + cc;
      const float val = acc[cc] * __expf(-tn * p.in[I_HDECAY][l * 1024 + col]);
      ((float*)(p.ws + OFF_FILTC))[((size_t)l * 1024 + col) * CTXL + t0 + tloc] = val;
      const float s = wave_sum(val * val);
      if (lane == 0) ((float*)(p.ws + OFF_SSQPC))[((size_t)l * 4 + (tt - 128)) * 1024 + col] = s;
    }
  }
  hyena_spectra(p, smem);
}

__device__ void stage_norm(const Params& p, int layer, int which  , int nrows) {
  const int lane = TIDX & 63, wid = TIDX >> 6;
  const float* g = (which ? p.in[I_N2G] : p.in[I_N1G]) + layer * DM;
  bf16_t* hb = (bf16_t*)(p.ws + OFF_HB);
  const int ngrp = nrows / 4, gstride = gridDim.x * 8;
  int grp = BIDX * 8 + wid;
  f32x4 v[4][4], vn[4][4];
  auto rowsrc = [&](int r0) -> const float* { return (which == 0) ? xrow_src(p, layer, r0) : (const float*)(p.ws + OFF_XS) + (size_t)r0 * DM; };
  if (grp < ngrp) {
    const float* src = rowsrc(grp * 4);
#pragma unroll
    for (int j = 0; j < 4; ++j)
#pragma unroll
      for (int i = 0; i < 2; ++i) { v[j][2 * i] = *(const f32x4*)(src + (size_t)j * DM + i * 512 + lane * 8); v[j][2 * i + 1] = *(const f32x4*)(src + (size_t)j * DM + i * 512 + lane * 8 + 4); }
  }
  for (; grp < ngrp; grp += gstride) {
    const int r0 = grp * 4, gn = grp + gstride;
    if (gn < ngrp) {
      const float* src = rowsrc(gn * 4);
#pragma unroll
      for (int j = 0; j < 4; ++j)
#pragma unroll
        for (int i = 0; i < 2; ++i) { vn[j][2 * i] = *(const f32x4*)(src + (size_t)j * DM + i * 512 + lane * 8); vn[j][2 * i + 1] = *(const f32x4*)(src + (size_t)j * DM + i * 512 + lane * 8 + 4); }
    }
    int b, t, isc; row_info(r0, b, t, isc);
    const float* mod = (const float*)(p.ws + OFF_MOD) + ((size_t)layer * 3 + (isc ? 2 : b)) * 6144 + (which ? 3072 : 0);
    float ss[4];
#pragma unroll
    for (int j = 0; j < 4; ++j) {
      float s = 0.f;
#pragma unroll
      for (int i = 0; i < 4; ++i) s += v[j][i][0] * v[j][i][0] + v[j][i][1] * v[j][i][1] + v[j][i][2] * v[j][i][2] + v[j][i][3] * v[j][i][3];
      ss[j] = s;
    }
#pragma unroll
    for (int j = 0; j < 4; ++j) ss[j] = rsqrtf(wave_sum(ss[j]) * (1.f / DM) + EPSV);
#pragma unroll
    for (int i = 0; i < 2; ++i) {
      const int c0 = i * 512 + lane * 8;
      const f32x4 g0 = *(const f32x4*)(g + c0), g1 = *(const f32x4*)(g + c0 + 4);
      const f32x4 sc0 = *(const f32x4*)(mod + 1024 + c0), sc1 = *(const f32x4*)(mod + 1024 + c0 + 4), sh0 = *(const f32x4*)(mod + c0), sh1 = *(const f32x4*)(mod + c0 + 4);
#pragma unroll
      for (int j = 0; j < 4; ++j) {
        float y[8];
#pragma unroll
        for (int q = 0; q < 4; ++q) { y[q] = v[j][2 * i][q] * ss[j] * g0[q] * (1.f + sc0[q]) + sh0[q]; y[4 + q] = v[j][2 * i + 1][q] * ss[j] * g1[q] * (1.f + sc1[q]) + sh1[q]; }
        const u32x4 o = {cvtpk(y[0], y[1]), cvtpk(y[2], y[3]), cvtpk(y[4], y[5]), cvtpk(y[6], y[7])};
        *(u32x4*)(hb + (size_t)(r0 + j) * DM + c0) = o;
      }
    }
#pragma unroll
    for (int j = 0; j < 4; ++j)
#pragma unroll
      for (int i = 0; i < 4; ++i) v[j][i] = vn[j][i];
  }
}

template <class Epi>
__device__ void gemm_bt(const bf16_t* __restrict__ A, int lda, const bf16_t* __restrict__ Bt, int ldb, int M, int N, int K, Epi epi, char* smem) {
  const int tid = TIDX, wid = tid >> 6, lane = tid & 63, r32 = lane & 31, hi = lane >> 5;
  const int wm = wid >> 2, wn = wid & 3;
  constexpr int RS = 144;
  char* sA = smem; char* sB = smem + 128 * RS;
  const int tilesM = M / 128, tilesN = N / 128, nk = K / 64;
  const int lr0 = tid >> 3, lc = (tid & 7) * 8;
  for (int tile = BIDX; tile < tilesM * tilesN; tile += gridDim.x) {
    const int tm = tile / tilesN, tn = tile % tilesN;
    const bf16_t* Ap = A + (size_t)(tm * 128 + lr0) * lda + lc;
    const bf16_t* Bp = Bt + (size_t)(tn * 128 + lr0) * ldb + lc;
    f32x16 acc0 = {}, acc1 = {};
    u32x4 ra0 = *(const u32x4*)Ap, ra1 = *(const u32x4*)(Ap + (size_t)64 * lda);
    u32x4 rb0 = *(const u32x4*)Bp, rb1 = *(const u32x4*)(Bp + (size_t)64 * ldb);
    for (int kt = 0; kt < nk; ++kt) {
      __syncthreads();
      *(u32x4*)(sA + lr0 * RS + lc * 2) = ra0; *(u32x4*)(sA + (lr0 + 64) * RS + lc * 2) = ra1;
      *(u32x4*)(sB + lr0 * RS + lc * 2) = rb0; *(u32x4*)(sB + (lr0 + 64) * RS + lc * 2) = rb1;
      __syncthreads();
      if (kt + 1 < nk) {
        const int ko = (kt + 1) * 64;
        ra0 = *(const u32x4*)(Ap + ko); ra1 = *(const u32x4*)(Ap + (size_t)64 * lda + ko);
        rb0 = *(const u32x4*)(Bp + ko); rb1 = *(const u32x4*)(Bp + (size_t)64 * ldb + ko);
      }
#pragma unroll
      for (int ks = 0; ks < 4; ++ks) {
        const int cb = (ks * 16 + hi * 8) * 2;
        const bf16x8 a0 = *(const bf16x8*)(sA + (wm * 64 + r32) * RS + cb);
        const bf16x8 a1 = *(const bf16x8*)(sA + (wm * 64 + 32 + r32) * RS + cb);
        const bf16x8 bb = *(const bf16x8*)(sB + (wn * 32 + r32) * RS + cb);
        acc0 = __builtin_amdgcn_mfma_f32_32x32x16_bf16(a0, bb, acc0, 0, 0, 0);
        acc1 = __builtin_amdgcn_mfma_f32_32x32x16_bf16(a1, bb, acc1, 0, 0, 0);
      }
    }
    const int col = tn * 128 + wn * 32 + r32;
#pragma unroll
    for (int r = 0; r < 16; ++r) {
      epi(tm * 128 + wm * 64 + crow(r, hi), col, acc0[r]);
      epi(tm * 128 + wm * 64 + 32 + crow(r, hi), col, acc1[r]);
    }
  }
}

__device__ __forceinline__ float rope_apply(float x, float xp, int c, int t) {
  const int i = c & 7; const float pos = ((c >> 4) & 1) ? (float)(t & 63) : (float)(t >> 6);
  const float inv = __expf(-(float)i * (9.210340371976184f / 8.f));
  const float rev = (pos * inv) * 0.15915494309189535f;
  const float cs = __builtin_amdgcn_cosf(rev), sn = __builtin_amdgcn_sinf(rev);
  return x * cs + ((c & 8) ? xp : -xp) * sn;
}

constexpr int NCH32 = NTOK / 32;
__device__ __forceinline__ float swap32(float v, int hi) { const auto rr = __builtin_amdgcn_permlane32_swap(__float_as_uint(v), __float_as_uint(v), false, false); return __uint_as_float(hi ? rr[0] : rr[1]); }
template <bool BWD>
__device__ __forceinline__ void lru_seg_scan(const float* a, const float* b, int hi, float S, float* h, float& Sout) {
  float P[4], H[4], Sin[4];
#pragma unroll
  for (int g = 0; g < 4; ++g) {
    if (!BWD) { H[g] = b[4 * g]; P[g] = a[4 * g];
#pragma unroll
      for (int q = 1; q < 4; ++q) { H[g] = a[4 * g + q] * H[g] + b[4 * g + q]; P[g] *= a[4 * g + q]; } }
    else { H[g] = b[4 * g + 3]; P[g] = a[4 * g + 3];
#pragma unroll
      for (int q = 2; q >= 0; --q) { H[g] = a[4 * g + q] * H[g] + b[4 * g + q]; P[g] *= a[4 * g + q]; } }
    Sin[g] = 0.f;
  }
#pragma unroll
  for (int step = 0; step < 8; ++step) {
    const int s = BWD ? 7 - step : step, g = s >> 1, owner = s & 1;
    const bool mine = (hi == owner);
    if (mine) Sin[g] = S;
    const float cand = P[g] * S + H[g];
    const float other = swap32(cand, hi);
    S = mine ? cand : other;
  }
  Sout = S;
#pragma unroll
  for (int g = 0; g < 4; ++g) {
    float hp = Sin[g];
    if (!BWD) {
#pragma unroll
      for (int q = 0; q < 4; ++q) { hp = a[4 * g + q] * hp + b[4 * g + q]; h[4 * g + q] = hp; } }
    else {
#pragma unroll
      for (int q = 3; q >= 0; --q) { hp = a[4 * g + q] * hp + b[4 * g + q]; h[4 * g + q] = hp; } }
  }
}
__device__ void lru_units(const Params& p, int layer, int mode, char* smem) {
  const int tid = TIDX, wid = tid >> 6, lane = tid & 63, r32 = lane & 31, hi = lane >> 5;
  const bf16_t* u = (const bf16_t*)(p.ws + OFF_U);
  const float* cw = p.in[I_LCW] + (size_t)layer * 4 * DLRU; const float* cbias = p.in[I_LCB] + layer * DLRU;
  bf16_t* mix = (bf16_t*)(p.ws + OFF_MIX);
  constexpr int RS = 272;
  char* tile = smem + wid * (35 * RS);
  const int bid = BIDX, n = bid % 6, rk = bid / 6, nbn = ((int)gridDim.x - n + 5) / 6;
  char* gwl = smem + 8 * 35 * RS;
  __syncthreads();
  for (int i = tid; i < 2048; i += NTHREADS) {
    const int mat = i >> 9, row = (i >> 3) & 63, c = i & 7;
    const bf16_t* gsrc = (const bf16_t*)(p.ws + OFF_GW) + ((size_t)((layer * 2 + (mat >> 1)) * 2 + (mat & 1)) * 6 + n) * 4096 + row * 64 + c * 8;
    *(u32x4*)(gwl + mat * 8192 + row * 128 + ((c ^ (row & 7)) << 4)) = *(const u32x4*)gsrc;
  }
  __syncthreads();
  for (int cid = rk * 8 + wid; cid < NCH32; cid += nbn * 8) {
    const int unit = cid * 6 + n;
    int rbase, t0, slen;
    if (cid < 512) { const int b = cid >> 8; rbase = b * SEQ; t0 = (cid & 255) * 32; slen = SEQ; }
    else { const int q = cid - 512, b = q >> 3; rbase = NLAT + b * CTXL; t0 = (q & 7) * 32; slen = CTXL; }
    {
      const int row8 = lane >> 3, c8 = lane & 7;
      const bf16_t* ub = u + (size_t)rbase * DIN + n * 64 + c8 * 8;
#pragma unroll
      for (int i = 0; i < 5; ++i) {
        const int row = i * 8 + row8, t = t0 + row - 2;
        if (row < 35) {
          u32x4 v = {0u, 0u, 0u, 0u};
          if (t >= 0 && t < slen) v = *(const u32x4*)(ub + (size_t)t * DIN);
          const f32x4 lo = {__uint_as_float(v[0] << 16), __uint_as_float(v[0] & 0xffff0000u), __uint_as_float(v[1] << 16), __uint_as_float(v[1] & 0xffff0000u)};
          const f32x4 hi4 = {__uint_as_float(v[2] << 16), __uint_as_float(v[2] & 0xffff0000u), __uint_as_float(v[3] << 16), __uint_as_float(v[3] & 0xffff0000u)};
          *(f32x4*)(tile + row * RS + c8 * 32) = lo; *(f32x4*)(tile + row * RS + c8 * 32 + 16) = hi4;
        }
      }
    }
    bf16x8 af[4];
    {
      const char* tl = tile + r32 * RS + hi * 32;
#pragma unroll
      for (int ks = 0; ks < 4; ++ks) {
        const int col = n * 64 + ks * 16 + 8 * hi;
        f32x4 c0 = *(const f32x4*)(cbias + col), c1 = *(const f32x4*)(cbias + col + 4);
#pragma unroll
        for (int k = 0; k < 4; ++k) {
          const f32x4 x0 = *(const f32x4*)(tl + k * RS + ks * 64), x1 = *(const f32x4*)(tl + k * RS + ks * 64 + 16);
          const f32x4 w0 = *(const f32x4*)(cw + k * DLRU + col), w1 = *(const f32x4*)(cw + k * DLRU + col + 4);
          c0 += w0 * x0; c1 += w1 * x1;
        }
        const u32x4 pk = {cvtpk(c0[0], c0[1]), cvtpk(c0[2], c0[3]), cvtpk(c1[0], c1[1]), cvtpk(c1[2], c1[3])};
        af[ks] = *(const bf16x8*)&pk;
      }
    }
    float xo[2][16];
#pragma unroll
    for (int nt = 0; nt < 2; ++nt) {
      const int ch = n * 64 + nt * 32 + r32;
      const float w0 = cw[ch], w1 = cw[DLRU + ch], w2 = cw[2 * DLRU + ch], w3 = cw[3 * DLRU + ch], bb = cbias[ch];
      const char* tl = tile + (4 * hi) * RS + (nt * 32 + r32) * 4;
#pragma unroll
      for (int g = 0; g < 4; ++g) {
        float xr[7];
#pragma unroll
        for (int i = 0; i < 7; ++i) xr[i] = *(const float*)(tl + (8 * g + i) * RS);
#pragma unroll
        for (int q = 0; q < 4; ++q) xo[nt][4 * g + q] = bb + w0 * xr[q] + w1 * xr[q + 1] + w2 * xr[q + 2] + w3 * xr[q + 3];
      }
    }
    if (mode == 1) {
      const bf16_t* ub = u + (size_t)(rbase + t0) * DIN + DLRU + n * 64 + lane;
#pragma unroll 4
      for (int i = 0; i < 32; ++i) *(float*)(tile + i * RS + lane * 4) = bf2f(ub[(size_t)i * DIN]);
    }
#pragma unroll 1
    for (int nt = 0; nt < 2; ++nt) {
      const int ch = n * 64 + nt * 32 + r32;
      float hf[16];
#pragma unroll
      for (int dir = 0; dir < 2; ++dir) {
        const char* gwr = gwl + (dir * 2 + 0) * 8192 + (nt * 32 + r32) * 128;
        const char* gwi = gwl + (dir * 2 + 1) * 8192 + (nt * 32 + r32) * 128;
        f32x16 accR = {}, accI = {};
#pragma unroll
        for (int ks = 0; ks < 4; ++ks) {
          const int co = ((ks * 2 + hi) ^ (r32 & 7)) << 4;
          const bf16x8 br_ = *(const bf16x8*)(gwr + co), bi_ = *(const bf16x8*)(gwi + co);
          accR = __builtin_amdgcn_mfma_f32_32x32x16_bf16(af[ks], br_, accR, 0, 0, 0);
          accI = __builtin_amdgcn_mfma_f32_32x32x16_bf16(af[ks], bi_, accI, 0, 0, 0);
        }
        const size_t po = (size_t)(layer * 2 + dir) * DLRU + ch;
        const float brv = p.in[I_LBR][po], biv = p.in[I_LBI][po];
        const float cl = -8.f * __logf(1.f + __expf(-p.in[I_LLAM][po]));
        float a[16], bq[16];
#pragma unroll
        for (int r = 0; r < 16; ++r) {
          const float rr = __builtin_amdgcn_rcpf(1.f + __expf(-(accR[r] + brv))), ii = __builtin_amdgcn_rcpf(1.f + __expf(-(accI[r] + biv)));
          const float av = __expf(rr * cl);
          a[r] = av; bq[r] = __builtin_amdgcn_sqrtf(fmaxf(1.f - av * av, 0.f)) * (ii * (nt == 0 ? xo[0][r] : xo[1][r]));
        }
        if (mode == 0) {
          {
            u32x4* ab = (u32x4*)(p.ws + OFF_LAB) + ((((size_t)unit * 2 + nt) * 2 + dir) * 4) * 64 + lane;
#pragma unroll
            for (int r4 = 0; r4 < 4; ++r4) { const u32x4 o = {cvtpk(1.f - a[4 * r4], bq[4 * r4]), cvtpk(1.f - a[4 * r4 + 1], bq[4 * r4 + 1]), cvtpk(1.f - a[4 * r4 + 2], bq[4 * r4 + 2]), cvtpk(1.f - a[4 * r4 + 3], bq[4 * r4 + 3])}; ab[r4 * 64] = o; }
          }
          float hd[16], Send;
          if (dir == 0) lru_seg_scan<false>(a, bq, hi, 0.f, hd, Send); else lru_seg_scan<true>(a, bq, hi, 0.f, hd, Send);
          float pp = a[0];
#pragma unroll
          for (int r = 1; r < 16; ++r) pp *= a[r];
          pp *= swap32(pp, hi);
          if (hi == 0) { float* ls = (float*)(p.ws + OFF_LSUM) + ((size_t)(cid * 2 + dir) * 2) * DLRU + ch; ls[0] = pp; ls[DLRU] = Send; }
        } else {
          const float cin = ((const float*)(p.ws + OFF_CARRY))[(size_t)(cid * 2 + dir) * DLRU + ch];
          float Send;
          if (dir == 0) lru_seg_scan<false>(a, bq, hi, cin, hf, Send);
          else {
            float hb[16];
            lru_seg_scan<true>(a, bq, hi, cin, hb, Send);
            const char* tl = tile + (4 * hi) * RS + (nt * 32 + r32) * 4;
            bf16_t* mo = mix + ((size_t)rbase + t0 + 4 * hi) * DM + ch;
#pragma unroll
            for (int r = 0; r < 16; ++r) {
              const int tk = (r & 3) + 8 * (r >> 2);
              const float gt = *(const float*)(tl + tk * RS);
              mo[(size_t)tk * DM] = f2bf((hf[r] + hb[r]) * gelu_tanh(gt));
            }
          }
        }
      }
    }
  }
}

__device__ void lru_final(const Params& p, int layer, char* smem) {
  const int tid = TIDX, wid = tid >> 6, lane = tid & 63, r32 = lane & 31, hi = lane >> 5;
  const bf16_t* u = (const bf16_t*)(p.ws + OFF_U);
  bf16_t* mix = (bf16_t*)(p.ws + OFF_MIX);
  constexpr int RS = 272;
  char* tile = smem + wid * (35 * RS);
  __syncthreads();
  for (int unit = BIDX * 8 + wid; unit < NCH32 * 6; unit += gridDim.x * 8) {
    const int cid = unit / 6, n = unit % 6;
    int rbase, t0;
    if (cid < 512) { const int b = cid >> 8; rbase = b * SEQ; t0 = (cid & 255) * 32; }
    else { const int q = cid - 512, b = q >> 3; rbase = NLAT + b * CTXL; t0 = (q & 7) * 32; }
    unsigned ab[2][2][16];
#pragma unroll
    for (int nt = 0; nt < 2; ++nt)
#pragma unroll
      for (int dir = 0; dir < 2; ++dir) {
        const u32x4* abp = (const u32x4*)(p.ws + OFF_LAB) + ((((size_t)unit * 2 + nt) * 2 + dir) * 4) * 64 + lane;
#pragma unroll
        for (int r4 = 0; r4 < 4; ++r4) { const u32x4 v = abp[r4 * 64]; ab[nt][dir][4 * r4] = v[0]; ab[nt][dir][4 * r4 + 1] = v[1]; ab[nt][dir][4 * r4 + 2] = v[2]; ab[nt][dir][4 * r4 + 3] = v[3]; }
      }
    {
      const int row8 = lane >> 3, c8 = lane & 7;
      const bf16_t* ub = u + (size_t)(rbase + t0) * DIN + DLRU + n * 64 + c8 * 8;
#pragma unroll
      for (int i = 0; i < 4; ++i) {
        const int row = i * 8 + row8;
        const u32x4 v = *(const u32x4*)(ub + (size_t)row * DIN);
        const f32x4 lo = {__uint_as_float(v[0] << 16), __uint_as_float(v[0] & 0xffff0000u), __uint_as_float(v[1] << 16), __uint_as_float(v[1] & 0xffff0000u)};
        const f32x4 hi4 = {__uint_as_float(v[2] << 16), __uint_as_float(v[2] & 0xffff0000u), __uint_as_float(v[3] << 16), __uint_as_float(v[3] & 0xffff0000u)};
        *(f32x4*)(tile + row * RS + c8 * 32) = lo; *(f32x4*)(tile + row * RS + c8 * 32 + 16) = hi4;
      }
    }
#pragma unroll
    for (int nt = 0; nt < 2; ++nt) {
      const int ch = n * 64 + nt * 32 + r32;
      float hf[16], hb[16], a[16], bq[16], Send;
#pragma unroll
      for (int r = 0; r < 16; ++r) { a[r] = 1.f - __uint_as_float(ab[nt][0][r] << 16); bq[r] = __uint_as_float(ab[nt][0][r] & 0xffff0000u); }
      lru_seg_scan<false>(a, bq, hi, ((const float*)(p.ws + OFF_CARRY))[(size_t)(cid * 2 + 0) * DLRU + ch], hf, Send);
#pragma unroll
      for (int r = 0; r < 16; ++r) { a[r] = 1.f - __uint_as_float(ab[nt][1][r] << 16); bq[r] = __uint_as_float(ab[nt][1][r] & 0xffff0000u); }
      lru_seg_scan<true>(a, bq, hi, ((const float*)(p.ws + OFF_CARRY))[(size_t)(cid * 2 + 1) * DLRU + ch], hb, Send);
      const char* tl = tile + (4 * hi) * RS + (nt * 32 + r32) * 4;
      bf16_t* mo = mix + ((size_t)rbase + t0 + 4 * hi) * DM + ch;
#pragma unroll
      for (int r = 0; r < 16; ++r) {
        const int tk = (r & 3) + 8 * (r >> 2);
        const float gt = *(const float*)(tl + tk * RS);
        mo[(size_t)tk * DM] = f2bf((hf[r] + hb[r]) * gelu_tanh(gt));
      }
    }
  }
}

__device__ void lru_carry(const Params& p, char* smem) {
  const int tid = TIDX, seg = tid >> 6, c = tid & 63;
  const float* __restrict__ ls = (const float*)(p.ws + OFF_LSUM); float* __restrict__ cr = (float*)(p.ws + OFF_CARRY);
  float* comp = (float*)smem;
  for (int item = BIDX; item < 2 * 2 * 6; item += gridDim.x) {
    const int b = item / 12, dir = (item / 6) & 1, ch = (item % 6) * 64 + c;
    float P[33], H[33];
#pragma unroll
    for (int i = 0; i < 33; ++i) {
      const int k = seg * 33 + i;
      int cid;
      if (dir == 0) cid = (k < 8) ? 512 + b * 8 + k : b * 256 + (k - 8);
      else          cid = (k < 8) ? 512 + b * 8 + (7 - k) : b * 256 + (255 - (k - 8));
      P[i] = ls[((size_t)(cid * 2 + dir) * 2) * DLRU + ch]; H[i] = ls[((size_t)(cid * 2 + dir) * 2 + 1) * DLRU + ch];
    }
    float pc = 1.f, hc = 0.f;
#pragma unroll
    for (int i = 0; i < 33; ++i) { hc = P[i] * hc + H[i]; pc *= P[i]; }
    __syncthreads();
    comp[(seg * 2) * 64 + c] = pc; comp[(seg * 2 + 1) * 64 + c] = hc;
    __syncthreads();
    float st = 0.f;
    for (int s = 0; s < seg; ++s) st = comp[(s * 2) * 64 + c] * st + comp[(s * 2 + 1) * 64 + c];
#pragma unroll
    for (int i = 0; i < 33; ++i) {
      const int k = seg * 33 + i;
      int cid;
      if (dir == 0) cid = (k < 8) ? 512 + b * 8 + k : b * 256 + (k - 8);
      else          cid = (k < 8) ? 512 + b * 8 + (7 - k) : b * 256 + (255 - (k - 8));
      cr[(size_t)(cid * 2 + dir) * DLRU + ch] = st;
      st = P[i] * st + H[i];
    }
  }
}

__device__ void mla_prep(const Params& p, int layer) {
  const int lane = TIDX & 63, wid = TIDX >> 6;
  const bf16_t* u = (const bf16_t*)(p.ws + OFF_U);
  const float* qg = p.in[I_QNG] + layer * 384; const float* kvg = p.in[I_KVNG] + layer * 256;
  bf16_t* qn = (bf16_t*)(p.ws + OFF_QN); bf16_t* kvn = (bf16_t*)(p.ws + OFF_KVN); bf16_t* Kb = (bf16_t*)(p.ws + OFF_K);
  const bool qact = lane < 48, kact = lane < 32;
  f32x4 qg0 = {0.f, 0.f, 0.f, 0.f}, qg1 = qg0, kg0 = qg0, kg1 = qg0;
  if (qact) { qg0 = *(const f32x4*)(qg + lane * 8); qg1 = *(const f32x4*)(qg + lane * 8 + 4); }
  if (kact) { kg0 = *(const f32x4*)(kvg + lane * 8); kg1 = *(const f32x4*)(kvg + lane * 8 + 4); }
  for (int grp = BIDX * 8 + wid; grp < NTOK / 4; grp += gridDim.x * 8) {
    const int r0 = grp * 4;
    u32x4 qv[4], kv[4]; float kr[4];
#pragma unroll
    for (int j = 0; j < 4; ++j) {
      const bf16_t* ur = u + (size_t)(r0 + j) * DIN;
      qv[j] = u32x4{0u, 0u, 0u, 0u}; kv[j] = u32x4{0u, 0u, 0u, 0u};
      if (qact) qv[j] = *(const u32x4*)(ur + 768 + lane * 8);
      if (kact) kv[j] = *(const u32x4*)(ur + 1152 + lane * 8);
      kr[j] = bf2f(ur[1408 + (lane & 31)]);
    }
#pragma unroll
    for (int j = 0; j < 4; ++j) {
      const int r = r0 + j;
      int b, t, isc; row_info(r, b, t, isc);
      float q[8], k[8], ss = 0.f;
#pragma unroll
      for (int i = 0; i < 4; ++i) { q[2 * i] = __uint_as_float(qv[j][i] << 16); q[2 * i + 1] = __uint_as_float(qv[j][i] & 0xffff0000u); ss += q[2 * i] * q[2 * i] + q[2 * i + 1] * q[2 * i + 1]; }
      float rinv = rsqrtf(wave_sum(ss) * (1.f / 384.f) + EPSV);
      if (qact) {
        const u32x4 o = {cvtpk(q[0] * rinv * qg0[0], q[1] * rinv * qg0[1]), cvtpk(q[2] * rinv * qg0[2], q[3] * rinv * qg0[3]),
                         cvtpk(q[4] * rinv * qg1[0], q[5] * rinv * qg1[1]), cvtpk(q[6] * rinv * qg1[2], q[7] * rinv * qg1[3])};
        *(u32x4*)(qn + (size_t)r * 384 + lane * 8) = o;
      }
      ss = 0.f;
#pragma unroll
      for (int i = 0; i < 4; ++i) { k[2 * i] = __uint_as_float(kv[j][i] << 16); k[2 * i + 1] = __uint_as_float(kv[j][i] & 0xffff0000u); ss += k[2 * i] * k[2 * i] + k[2 * i + 1] * k[2 * i + 1]; }
      rinv = rsqrtf(wave_sum(ss) * (1.f / 256.f) + EPSV);
      if (kact) {
        const u32x4 o = {cvtpk(k[0] * rinv * kg0[0], k[1] * rinv * kg0[1]), cvtpk(k[2] * rinv * kg0[2], k[3] * rinv * kg0[3]),
                         cvtpk(k[4] * rinv * kg1[0], k[5] * rinv * kg1[1]), cvtpk(k[6] * rinv * kg1[2], k[7] * rinv * kg1[3])};
        *(u32x4*)(kvn + (size_t)r * 256 + lane * 8) = o;
      }
      const float krp = shx(kr[j], 8);
      const float ko = isc ? kr[j] : rope_apply(kr[j], krp, lane & 31, t);
      if (lane < 32) ((bf16_t*)(p.ws + OFF_V))[(size_t)r * 32 + rope_slot(lane)] = f2bf(ko);
    }
  }
}

__device__ void hyena_prep(const Params& p, int layer, char* smem) {
  constexpr int RS = 516;
  const bf16_t* u = (const bf16_t*)(p.ws + OFF_U);
  const float* cw = p.in[I_HCW] + (size_t)layer * 3 * 768; const float* cb = p.in[I_HCB] + layer * 768;
  const int tid = TIDX;
  const int ntile = (layer == 0) ? NCHUNK : 256;
  for (int unit = BIDX; unit < ntile * 3; unit += gridDim.x) {
    const int cid = unit / 3, part = unit % 3;
    int rbase, t0, slen, b;
    if (cid < 256) { b = cid >> 7; rbase = b * SEQ; t0 = (cid & 127) * 64; slen = SEQ; }
    else { const int q = cid - 256; b = q >> 2; rbase = NLAT + b * CTXL; t0 = (q & 3) * 64; slen = CTXL; }
    __syncthreads();
    {
      const int chunk = tid & 31;
      for (int row = tid >> 5; row < 66; row += 16) {
        const int t = t0 + row - 1;
        u32x4 v = {0u, 0u, 0u, 0u};
        if (t >= 0 && t < slen) v = *(const u32x4*)(u + (size_t)(rbase + t) * DIN + 1440 + part * 256 + chunk * 8);
        unsigned* d = (unsigned*)(smem + row * RS + chunk * 16);
        d[0] = v[0]; d[1] = v[1]; d[2] = v[2]; d[3] = v[3];
      }
    }
    __syncthreads();
    {
      const int tg = tid & 15;
      const char* tb = smem + (4 * tg) * RS;
#pragma unroll
      for (int i = 0; i < 4; ++i) {
        const int cp = (tid >> 4) + 32 * i, pc = part * 256 + 2 * cp;
        unsigned x[6];
#pragma unroll
        for (int k = 0; k < 6; ++k) x[k] = *(const unsigned*)(tb + k * RS + cp * 4);
        const float wa0 = cw[pc], wa1 = cw[768 + pc], wa2 = cw[1536 + pc], ba = cb[pc];
        const float wb0 = cw[pc + 1], wb1 = cw[768 + pc + 1], wb2 = cw[1536 + pc + 1], bb = cb[pc + 1];
        f32x4 ya, yb;
#pragma unroll
        for (int q = 0; q < 4; ++q) {
          ya[q] = ba + wa0 * __uint_as_float(x[q] << 16) + wa1 * __uint_as_float(x[q + 1] << 16) + wa2 * __uint_as_float(x[q + 2] << 16);
          yb[q] = bb + wb0 * __uint_as_float(x[q] & 0xffff0000u) + wb1 * __uint_as_float(x[q + 1] & 0xffff0000u) + wb2 * __uint_as_float(x[q + 2] & 0xffff0000u);
        }
        float* dst = (cid < 256) ? (float*)(p.ws + OFF_HYIN) + ((size_t)(part * 2 + b) * 256 + 2 * cp) * SEQ + t0 + 4 * tg
                                 : (float*)(p.ws + OFF_HYINC) + ((size_t)(part * 2 + b) * 256 + 2 * cp) * CTXL + t0 + 4 * tg;
        *(f32x4*)dst = ya; *(f32x4*)(dst + slen) = yb;
      }
    }
  }
}

__device__ void hyena_out_transpose(const Params& p, char* smem) {
  const bf16_t* yc = (const bf16_t*)(p.ws + OFF_HB); bf16_t* mix = (bf16_t*)(p.ws + OFF_MIX);
  constexpr int RS = 132;
  const int tid = TIDX;
  for (int unit = BIDX; unit < 2 * (SEQ / 64); unit += gridDim.x) {
    const int b = unit / (SEQ / 64), t0 = (unit % (SEQ / 64)) * 64;
    __syncthreads();
    {
      const int chunk = tid & 7;
      for (int c = tid >> 3; c < 256; c += 64) {
        const u32x4 v = *(const u32x4*)(yc + ((size_t)(b * 256 + c)) * SEQ + t0 + chunk * 8);
        unsigned* d = (unsigned*)(smem + c * RS + chunk * 16);
        d[0] = v[0]; d[1] = v[1]; d[2] = v[2]; d[3] = v[3];
      }
    }
    __syncthreads();
    {
      const int c8 = (tid & 31) * 8;
      for (int tl = tid >> 5; tl < 64; tl += 16) {
        unsigned short h[8];
#pragma unroll
        for (int q = 0; q < 8; ++q) h[q] = *(const unsigned short*)(smem + (c8 + q) * RS + tl * 2);
        const u32x4 o = {(unsigned)h[0] | ((unsigned)h[1] << 16), (unsigned)h[2] | ((unsigned)h[3] << 16), (unsigned)h[4] | ((unsigned)h[5] << 16), (unsigned)h[6] | ((unsigned)h[7] << 16)};
        *(u32x4*)(mix + ((size_t)b * SEQ + t0 + tl) * DM + 768 + c8) = o;
      }
    }
  }
}

__device__ void hyena_direct(const Params& p, int layer, char* smem) {
  float* zs = (float*)smem;
  float* Ts = zs + SEQ;
  bf16_t* mix = (bf16_t*)(p.ws + OFF_MIX);
  const int nunits = (layer == 0) ? 512 : 0;
  for (int unit = BIDX; unit < nunits; unit += gridDim.x) {
    const bool isc = true; const int q = unit & 511, b = q >> 8, c = q & 255;
    const int L = CTXL;
    const float* hin = (const float*)(p.ws + OFF_HYINC);
    const float* filt = (const float*)(p.ws + OFF_FILTC) + (size_t)layer * 1024 * CTXL;
    const float* ssq = (const float*)(p.ws + OFF_SSQPC) + (size_t)layer * 4 * 1024;
    const int ntt = 4;
    const int nout = (L + NTHREADS - 1) / NTHREADS;
    for (int order = 0; order < 2; ++order) {
      const int colf = (order * 2 + 0) * 256 + c, colb = (order * 2 + 1) * 256 + c;
      float sf = 0.f, sb = 0.f;
      for (int tt = 0; tt < ntt; ++tt) { sf += ssq[(size_t)tt * 1024 + colf]; sb += ssq[(size_t)tt * 1024 + colb]; }
      sf = rsqrtf(sf + EPSV); sb = rsqrtf(sb + EPSV);
      const float skip = p.in[I_HSKIP][(size_t)layer * 512 + order * 256 + c];
      __syncthreads();
      for (int i = TIDX; i < 2 * L; i += NTHREADS) {
        const int m = i - L;
        float v = 0.f;
        if (m >= 0) v = filt[(size_t)colf * L + m] * sf; else if (m > -L) v = filt[(size_t)colb * L - m] * sb;
        if (m == 0) v += skip;
        Ts[i] = v;
      }
      if (order == 0) for (int i = TIDX; i < L; i += NTHREADS) zs[i] = hin[((size_t)(0 * 2 + b) * 256 + c) * L + i];
      __syncthreads();
      float acc[16];
#pragma unroll
      for (int j = 0; j < 16; ++j) acc[j] = 0.f;
      if ((int)TIDX < L) {
        const float* tb = Ts + L + TIDX;
        if (!isc) {
          for (int s = 0; s < SEQ; ++s) {
            const float zv = zs[s];
#pragma unroll
            for (int j = 0; j < 16; ++j) acc[j] += tb[j * NTHREADS - s] * zv;
          }
        } else {
          for (int s = 0; s < CTXL; ++s) acc[0] += tb[-s] * zs[s];
        }
      }
      __syncthreads();
      const float* xg = hin + ((size_t)((1 + order) * 2 + b) * 256 + c) * L;
#pragma unroll
      for (int j = 0; j < 16; ++j) {
        const int t = TIDX + j * NTHREADS;
        if (t < L) {
          const float y = xg[t] * acc[j];
          if (order == 0) zs[t] = y;
          else { const size_t row = isc ? (size_t)NLAT + b * CTXL + t : (size_t)b * SEQ + t; mix[row * DM + 768 + c] = f2bf(y); }
        }
      }
    }
  }
}

namespace att {
constexpr int NW = 8, QBLK = 32, KVBLK = 64;
constexpr float SCALE = 0.10206207261596575f;
constexpr float THR = 8.f;
constexpr int SHM_V = KVBLK * 128 * 2, SHM_K = KVBLK * 128 * 2;
constexpr int SHM_ATTN = 2 * SHM_V + 2 * SHM_K + NW * 64 * 4;
#define KSWZ(row, colB) ((row) * 256 + ((colB) ^ (((row) & 7) << 4)))
#define SBAR() __builtin_amdgcn_sched_barrier(0)
template <int VAR> __device__ __forceinline__ float ex2(float x) { if constexpr (VAR == 2) return x; else return __builtin_amdgcn_exp2f(x); }
template <int VAR> __device__ __forceinline__ void partialSM(f32x16& p0, f32x16& p1, float& m_reg, float& mn, float& alpha) {
  constexpr float C = SCALE * 1.4426950408889634f;
  float pmax = p0[0];
#pragma unroll
  for (int r = 1; r < 16; ++r) pmax = fmaxf(pmax, p0[r]);
#pragma unroll
  for (int r = 0; r < 16; ++r) pmax = fmaxf(pmax, p1[r]);
  { auto rr = __builtin_amdgcn_permlane32_swap(__float_as_uint(pmax), __float_as_uint(pmax), false, false);
    pmax = fmaxf(__uint_as_float(rr[0]), __uint_as_float(rr[1])); }
  if (__builtin_expect(__all(pmax - m_reg <= THR / SCALE), 1)) { mn = m_reg; alpha = 1.f; }
  else { mn = fmaxf(m_reg, pmax); alpha = __builtin_amdgcn_exp2f((m_reg - mn) * C); m_reg = mn; }
  const float mnC = -mn * C;
#pragma unroll
  for (int r = 0; r < 16; ++r) p0[r] = fmaf(p0[r], C, mnC);
#pragma unroll
  for (int r = 0; r < 16; ++r) p1[r] = fmaf(p1[r], C, mnC);
#pragma unroll
  for (int r = 0; r < 16; ++r) p0[r] = ex2<VAR>(p0[r]);
}
template <int VAR> __device__ __forceinline__ void finishSM(f32x16& p0, f32x16& p1, float alpha, float& l_reg, bf16x8& pa0, bf16x8& pa1, bf16x8& pa2, bf16x8& pa3) {
#pragma unroll
  for (int r = 0; r < 16; ++r) p1[r] = ex2<VAR>(p1[r]);
  float ps = 0;
#pragma unroll
  for (int r = 0; r < 16; ++r) ps += p0[r];
#pragma unroll
  for (int r = 0; r < 16; ++r) ps += p1[r];
  { auto rr = __builtin_amdgcn_permlane32_swap(__float_as_uint(ps), __float_as_uint(ps), false, false);
    ps = __uint_as_float(rr[0]) + __uint_as_float(rr[1]); }
  l_reg = l_reg * alpha + ps;
#define PK4(P, BASE, OUT) do { unsigned a0 = cvtpk(P[BASE + 0], P[BASE + 1]), a1 = cvtpk(P[BASE + 2], P[BASE + 3]);   \
    unsigned b0 = cvtpk(P[BASE + 4], P[BASE + 5]), b1 = cvtpk(P[BASE + 6], P[BASE + 7]);                              \
    auto r0 = __builtin_amdgcn_permlane32_swap(a0, b0, false, false); auto r1 = __builtin_amdgcn_permlane32_swap(a1, b1, false, false); \
    u32x4 w = {r0[0], r1[0], r0[1], r1[1]}; OUT = *reinterpret_cast<bf16x8*>(&w); } while (0)
  PK4(p0, 0, pa0); PK4(p0, 8, pa1); PK4(p1, 0, pa2); PK4(p1, 8, pa3);
#undef PK4
}
__device__ __forceinline__ void qkt(f32x16& p0, f32x16& p1, const char* Ks, const bf16x8* qr, int r32, int hi) {
  p0 = f32x16{}; p1 = f32x16{};
#pragma unroll
  for (int d0 = 0; d0 < 6; ++d0) { const int cb = (d0 * 16 + hi * 8) * 2;
    const bf16x8 b0 = *reinterpret_cast<const bf16x8*>(Ks + KSWZ(r32, cb));
    const bf16x8 b1 = *reinterpret_cast<const bf16x8*>(Ks + KSWZ(32 + r32, cb));
    p0 = __builtin_amdgcn_mfma_f32_32x32x16_bf16(b0, qr[d0], p0, 0, 0, 0);
    p1 = __builtin_amdgcn_mfma_f32_32x32x16_bf16(b1, qr[d0], p1, 0, 0, 0); }
}
__device__ __forceinline__ int v_st(int k, int c) { const int kk = (k & ~0xC) | ((k & 4) << 1) | ((k & 8) >> 1); return ((kk >> 3) * 4 + (c >> 5)) * 512 + ((kk & 7) * 32 + (c & 31)) * 2; }
__device__ __forceinline__ int v_rd_base(int lane) { return ((lane & 3) << 3) | (((lane >> 2) & 3) << 6) | (((lane >> 4) & 1) << 5) | (((lane >> 5) & 1) << 8); }
constexpr int v_rd_off(int d0, int ks, int half) { return d0 * 512 + ks * 4096 + half * 2048; }
template <int OFF> __device__ __forceinline__ s16x4 tr_read(int vb) {
  s16x4 r; asm volatile("ds_read_b64_tr_b16 %0, %1 offset:%2" : "=&v"(r) : "v"(vb), "i"(OFF) : "memory"); return r;
}
template <int D0> __device__ __forceinline__ void pv_one(f32x16& od, int vb, bf16x8 pa0, bf16x8 pa1, bf16x8 pa2, bf16x8 pa3) {
  const s16x4 l0 = tr_read<v_rd_off(D0, 0, 0)>(vb), h0 = tr_read<v_rd_off(D0, 0, 1)>(vb), l1 = tr_read<v_rd_off(D0, 1, 0)>(vb), h1 = tr_read<v_rd_off(D0, 1, 1)>(vb);
  const s16x4 l2 = tr_read<v_rd_off(D0, 2, 0)>(vb), h2 = tr_read<v_rd_off(D0, 2, 1)>(vb), l3 = tr_read<v_rd_off(D0, 3, 0)>(vb), h3 = tr_read<v_rd_off(D0, 3, 1)>(vb);
  asm volatile("s_waitcnt lgkmcnt(0)" ::: "memory"); SBAR();
#define PK(L, H) (bf16x8){L[0], L[1], L[2], L[3], H[0], H[1], H[2], H[3]}
  od = __builtin_amdgcn_mfma_f32_32x32x16_bf16(pa0, PK(l0, h0), od, 0, 0, 0);
  od = __builtin_amdgcn_mfma_f32_32x32x16_bf16(pa1, PK(l1, h1), od, 0, 0, 0);
  od = __builtin_amdgcn_mfma_f32_32x32x16_bf16(pa2, PK(l2, h2), od, 0, 0, 0);
  od = __builtin_amdgcn_mfma_f32_32x32x16_bf16(pa3, PK(l3, h3), od, 0, 0, 0);
#undef PK
}
__device__ __forceinline__ void pv_d0(f32x16& o0, f32x16& o1, int vb, bf16x8 pa0, bf16x8 pa1, bf16x8 pa2, bf16x8 pa3) {
  pv_one<0>(o0, vb, pa0, pa1, pa2, pa3); pv_one<1>(o1, vb, pa0, pa1, pa2, pa3);
}
template <int VAR>
__device__ __forceinline__ void attn_body(const bf16_t* __restrict__ Qb, const bf16_t* __restrict__ KVh, const bf16_t* __restrict__ KR, int bsel, int key0,
                                          bf16_t* __restrict__ Ob, float* __restrict__ Op, float* __restrict__ Oml, int seq, char* lds) {
  const int tid = TIDX, wid = tid >> 6, lane = tid & 63, r32 = lane & 31, hi = lane >> 5;
  char* V_lds = lds; char* K_lds = lds + 2 * SHM_V;
  float* ws = (float*)(lds + 2 * SHM_V + 2 * SHM_K) + wid * 64; float* li_l = ws; float* al_l = ws + 32;
  float m_reg = -1e30f, l_reg = 0; f32x16 o0 = {}, o1 = {}; bf16x8 qr[6];
  const bf16_t* Qw = Qb + (size_t)(wid * QBLK + r32) * 576 + hi * 8;
#pragma unroll
  for (int d0 = 0; d0 < 6; ++d0) qr[d0] = *(const bf16x8*)(Qw + d0 * 16);
  const int sr = tid >> 4, sc = (tid & 15) * 8, vst0 = v_st(sr, sc & 63), vst1 = v_st(32 + sr, sc & 63);
  const int vb0 = (int)(uintptr_t)V_lds + v_rd_base(lane);
  const bool kact = sc < 96, vact = sc < 64;
  bf16x8 vs0 = {}, vs1 = {}, ks0 = {}, ks1 = {};
#define SLOAD(k0) do { const int kk_ = key0 + (k0); const size_t rb_ = (size_t)((kk_ < CTXL) ? NLAT + bsel * CTXL + kk_ : bsel * SEQ + kk_ - CTXL) + sr; \
    if (vact) { vs0 = *(const bf16x8*)(KVh + rb_ * 768 + 64 + sc); vs1 = *(const bf16x8*)(KVh + (rb_ + 32) * 768 + 64 + sc); } \
    if (kact) { if (sc < 64) { ks0 = *(const bf16x8*)(KVh + rb_ * 768 + sc); ks1 = *(const bf16x8*)(KVh + (rb_ + 32) * 768 + sc); } \
                else { ks0 = *(const bf16x8*)(KR + rb_ * 32 + (sc - 64)); ks1 = *(const bf16x8*)(KR + (rb_ + 32) * 32 + (sc - 64)); } } } while (0)
#define SWRITE(b) do { if (vact) { *(bf16x8*)(V_lds + (b) * SHM_V + vst0) = vs0; *(bf16x8*)(V_lds + (b) * SHM_V + vst1) = vs1; } \
    if (kact) { const int kc = sc * 2; *(bf16x8*)(K_lds + (b) * SHM_K + KSWZ(sr, kc)) = ks0; *(bf16x8*)(K_lds + (b) * SHM_K + KSWZ(32 + sr, kc)) = ks1; } } while (0)
#define SWAIT() asm volatile("s_waitcnt vmcnt(0)" ::: "memory")
#define RESC(a) do { if (__any((a) < 1.f)) { if (hi == 0) al_l[r32] = (a); asm volatile("s_waitcnt lgkmcnt(0)" ::: "memory"); \
    _Pragma("unroll") for (int r = 0; r < 16; ++r) { const float f = al_l[crow(r, hi)]; o0[r] *= f; o1[r] *= f; } } } while (0)
  f32x16 pA0, pA1, pB0, pB1; float mnA, mnB, alA, alB; bf16x8 pa0, pa1, pa2, pa3; const int NT = seq / KVBLK;
  __syncthreads();
  SLOAD(0); SWAIT(); SWRITE(0); __syncthreads();
  qkt(pA0, pA1, K_lds, qr, r32, hi); partialSM<VAR>(pA0, pA1, m_reg, mnA, alA);
  SLOAD(KVBLK);
  SWAIT(); SWRITE(1); __syncthreads();
#define LSYNC() do { if constexpr (VAR != 1) __syncthreads(); } while (0)
#define LLOAD(k0) do { if constexpr (VAR != 3) SLOAD(k0); } while (0)
#define LWRITE(b) do { if constexpr (VAR != 3) { SWAIT(); SWRITE(b); } } while (0)
#define LPV(O0, O1, VB) do { if constexpr (VAR != 5) pv_d0(O0, O1, VB, pa0, pa1, pa2, pa3); else { asm volatile("" :: "v"(pa0), "v"(pa1), "v"(pa2), "v"(pa3)); } } while (0)
  const int wodd = __builtin_amdgcn_readfirstlane(wid) & 1;
#define HALF_IT(PN0, PN1, MN, AN, PO0, PO1, AO, KB, VB) do { \
    if (!wodd) { qkt(PN0, PN1, KB, qr, r32, hi); finishSM<VAR>(PO0, PO1, AO, l_reg, pa0, pa1, pa2, pa3); SBAR(); LPV(o0, o1, VB); partialSM<VAR>(PN0, PN1, m_reg, MN, AN); } \
    else { finishSM<VAR>(PO0, PO1, AO, l_reg, pa0, pa1, pa2, pa3); SBAR(); qkt(PN0, PN1, KB, qr, r32, hi); SBAR(); partialSM<VAR>(PN0, PN1, m_reg, MN, AN); SBAR(); LPV(o0, o1, VB); } } while (0)
  for (int j = 1; j + 1 < NT; j += 2) {
    SBAR(); LLOAD((j + 1) * KVBLK); SBAR();
    HALF_IT(pB0, pB1, mnB, alB, pA0, pA1, alA, K_lds + SHM_K, vb0);
    LSYNC(); LWRITE(0);
    RESC(alB); LSYNC();
    SBAR(); LLOAD((j + 2) * KVBLK); SBAR();
    HALF_IT(pA0, pA1, mnA, alA, pB0, pB1, alB, K_lds, vb0 + SHM_V);
    LSYNC(); LWRITE(1);
    RESC(alA); LSYNC();
  }
#undef HALF_IT
#undef LSYNC
#undef LLOAD
#undef LWRITE
#undef LPV
  SBAR(); qkt(pB0, pB1, K_lds + SHM_K, qr, r32, hi);
  finishSM<VAR>(pA0, pA1, alA, l_reg, pa0, pa1, pa2, pa3); SBAR();
  pv_d0(o0, o1, vb0, pa0, pa1, pa2, pa3); partialSM<VAR>(pB0, pB1, m_reg, mnB, alB);
  __syncthreads(); RESC(alB);
  finishSM<VAR>(pB0, pB1, alB, l_reg, pa0, pa1, pa2, pa3); SBAR();
  pv_d0(o0, o1, vb0 + SHM_V, pa0, pa1, pa2, pa3);
  if (Op != nullptr) {
    float* Pw = Op + (size_t)(wid * QBLK) * 64;
#pragma unroll
    for (int r = 0; r < 16; ++r) { const int orow = crow(r, hi); Pw[(size_t)orow * 64 + r32] = o0[r]; Pw[(size_t)orow * 64 + 32 + r32] = o1[r]; }
    if (hi == 0) { Oml[(size_t)(wid * QBLK + r32) * 2] = m_reg; Oml[(size_t)(wid * QBLK + r32) * 2 + 1] = l_reg; }
  } else {
    if (hi == 0) li_l[r32] = l_reg; asm volatile("s_waitcnt lgkmcnt(0)" ::: "memory");
    bf16_t* Ow = Ob + (size_t)(wid * QBLK) * DM;
#pragma unroll
    for (int r = 0; r < 16; ++r) { const int orow = crow(r, hi); const float rl = __builtin_amdgcn_rcpf(li_l[orow]);
      Ow[(size_t)orow * DM + r32] = f2bf(o0[r] * rl); Ow[(size_t)orow * DM + 32 + r32] = f2bf(o1[r] * rl); }
  }
#undef SLOAD
#undef SWRITE
#undef SWAIT
#undef RESC
}
}

template <int VAR = 0, bool ATT_DUMMY = false>
__device__ __forceinline__ void attn_units(const Params& p, int layer, char* smem) {
  const bf16_t* Q = (const bf16_t*)(p.ws + OFF_Q);
  const bf16_t* KV = (const bf16_t*)(p.ws + OFF_K); const bf16_t* KR = (const bf16_t*)(p.ws + OFF_V);
  bf16_t* mix = (bf16_t*)(p.ws + OFF_MIX); float* opart = (float*)(p.ws + OFF_OPART); float* oml = (float*)(p.ws + OFF_OML);
  const int nunits = 512 + ((layer == 0) ? 12 : 0);
  for (int unit = BIDX; unit < nunits; unit += gridDim.x) {
    const bf16_t *qp, *kvp; bf16_t* ob; float* op = nullptr; float* ml = nullptr; int seq, bsel, key0 = 0;
    if (unit < 256) {
      const int bh = unit & 7, qb = unit >> 3, b = bh / 6, h = bh % 6;
      qp = Q + ((size_t)b * SEQ + qb * 256) * 576 + h * 96; kvp = KV + h * 128; bsel = b;
      ob = mix + ((size_t)b * SEQ + qb * 256) * DM + 384 + h * 64; seq = NKEYS;
    } else if (unit < 512) {
      const int v = unit - 256, bhi = v & 3, half = (v >> 2) & 1, qb = v >> 3, bh = 8 + bhi, b = bh / 6, h = bh % 6;
      qp = Q + ((size_t)b * SEQ + qb * 256) * 576 + h * 96; kvp = KV + h * 128; bsel = b; key0 = half * (NKEYS / 2);
      ob = mix; op = opart + ((size_t)(bhi * 2 + half) * SEQ + qb * 256) * 64; ml = oml + ((size_t)(bhi * 2 + half) * SEQ + qb * 256) * 2; seq = NKEYS / 2;
    } else {
      const int bh = unit - 512, b = bh / 6, h = bh % 6;
      qp = Q + ((size_t)NLAT + b * CTXL) * 576 + h * 96; kvp = KV + h * 128; bsel = b;
      ob = mix + ((size_t)NLAT + b * CTXL) * DM + 384 + h * 64; seq = CTXL;
    }
    if constexpr (VAR != 0 || ATT_DUMMY) {
      ob = (bf16_t*)(p.ws + OFF_HB) + (size_t)(unit & 63) * 256 * DM; if (op) { op = (float*)(p.ws + OFF_HB) + (size_t)(unit & 63) * 256 * 64; ml = op; }
    }
    att::attn_body<VAR>(qp, kvp, KR, bsel, key0, ob, op, ml, seq, smem);
  }
}
__device__ void attn_combine(const Params& p) {
  const int lane = TIDX & 63, wid = TIDX >> 6;
  const float* opart = (const float*)(p.ws + OFF_OPART); const float* oml = (const float*)(p.ws + OFF_OML); bf16_t* mix = (bf16_t*)(p.ws + OFF_MIX);
  constexpr float C = att::SCALE * 1.4426950408889634f;
  for (int grp = BIDX * 8 + wid; grp < 4 * SEQ / 4; grp += gridDim.x * 8) {
    const int idx0 = grp * 4, bhi = idx0 >> 13, q0 = idx0 & (SEQ - 1), bh = 8 + bhi, b = bh / 6, h = bh % 6;
    const size_t r0 = (size_t)(bhi * 2) * SEQ + q0, r1 = r0 + SEQ;
    float m0[4], l0[4], m1[4], l1[4], o0[4], o1[4];
#pragma unroll
    for (int j = 0; j < 4; ++j) {
      m0[j] = oml[(r0 + j) * 2]; l0[j] = oml[(r0 + j) * 2 + 1]; m1[j] = oml[(r1 + j) * 2]; l1[j] = oml[(r1 + j) * 2 + 1];
      o0[j] = opart[(r0 + j) * 64 + lane]; o1[j] = opart[(r1 + j) * 64 + lane];
    }
#pragma unroll
    for (int j = 0; j < 4; ++j) {
      const float m = fmaxf(m0[j], m1[j]), f0 = __builtin_amdgcn_exp2f((m0[j] - m) * C), f1 = __builtin_amdgcn_exp2f((m1[j] - m) * C);
      const float o = (o0[j] * f0 + o1[j] * f1) / (l0[j] * f0 + l1[j] * f1);
      mix[((size_t)b * SEQ + q0 + j) * DM + 384 + h * 64 + lane] = f2bf(o);
    }
  }
}

#define CEK(a, b) { const unsigned _h = max(k[a], k[b]), _l = min(k[a], k[b]); k[a] = _h; k[b] = _l; }
__device__ __forceinline__ void sort16k(unsigned* k) {
  CEK(0,1) CEK(2,3) CEK(0,2) CEK(1,3) CEK(1,2) CEK(4,5) CEK(6,7) CEK(4,6)
  CEK(5,7) CEK(5,6) CEK(0,4) CEK(2,6) CEK(2,4) CEK(1,5) CEK(3,7) CEK(3,5)
  CEK(1,2) CEK(3,4) CEK(5,6) CEK(8,9) CEK(10,11) CEK(8,10) CEK(9,11) CEK(9,10)
  CEK(12,13) CEK(14,15) CEK(12,14) CEK(13,15) CEK(13,14) CEK(8,12) CEK(10,14) CEK(10,12)
  CEK(9,13) CEK(11,15) CEK(11,13) CEK(9,10) CEK(11,12) CEK(13,14) CEK(0,8) CEK(4,12)
  CEK(4,8) CEK(2,10) CEK(6,14) CEK(6,10) CEK(2,4) CEK(6,8) CEK(10,12) CEK(1,9)
  CEK(5,13) CEK(5,9) CEK(3,11) CEK(7,15) CEK(7,11) CEK(3,5) CEK(7,9) CEK(11,13)
  CEK(1,2) CEK(3,4) CEK(5,6) CEK(7,8) CEK(9,10) CEK(11,12) CEK(13,14)
}
__device__ __forceinline__ void bmerge16k(unsigned* k) {
  CEK(0,8) CEK(1,9) CEK(2,10) CEK(3,11) CEK(4,12) CEK(5,13) CEK(6,14) CEK(7,15)
  CEK(0,4) CEK(1,5) CEK(2,6) CEK(3,7) CEK(8,12) CEK(9,13) CEK(10,14) CEK(11,15)
  CEK(0,2) CEK(1,3) CEK(4,6) CEK(5,7) CEK(8,10) CEK(9,11) CEK(12,14) CEK(13,15)
  CEK(0,1) CEK(2,3) CEK(4,5) CEK(6,7) CEK(8,9) CEK(10,11) CEK(12,13) CEK(14,15)
}
#undef CEK
#define CEP(a, b) { const bool _s = v[a] < v[b]; const float _va = _s ? v[b] : v[a], _vb = _s ? v[a] : v[b]; const int _pa = _s ? pl[b] : pl[a], _pb = _s ? pl[a] : pl[b]; \
                    v[a] = _va; v[b] = _vb; pl[a] = _pa; pl[b] = _pb; }
__device__ __forceinline__ void sort16p(float* v, int* pl) {
  CEP(0,1) CEP(2,3) CEP(0,2) CEP(1,3)
  CEP(1,2) CEP(4,5) CEP(6,7) CEP(4,6)
  CEP(5,7) CEP(5,6) CEP(0,4) CEP(2,6)
  CEP(2,4) CEP(1,5) CEP(3,7) CEP(3,5)
  CEP(1,2) CEP(3,4) CEP(5,6) CEP(8,9)
  CEP(10,11) CEP(8,10) CEP(9,11) CEP(9,10)
  CEP(12,13) CEP(14,15) CEP(12,14) CEP(13,15)
  CEP(13,14) CEP(8,12) CEP(10,14) CEP(10,12)
  CEP(9,13) CEP(11,15) CEP(11,13) CEP(9,10)
  CEP(11,12) CEP(13,14) CEP(0,8) CEP(4,12)
  CEP(4,8) CEP(2,10) CEP(6,14) CEP(6,10)
  CEP(2,4) CEP(6,8) CEP(10,12) CEP(1,9)
  CEP(5,13) CEP(5,9) CEP(3,11) CEP(7,15)
  CEP(7,11) CEP(3,5) CEP(7,9) CEP(11,13)
  CEP(1,2) CEP(3,4) CEP(5,6) CEP(7,8)
  CEP(9,10) CEP(11,12) CEP(13,14)
}
__device__ __forceinline__ void bmerge16p(float* v, int* pl) {
  CEP(0,8) CEP(1,9) CEP(2,10) CEP(3,11)
  CEP(4,12) CEP(5,13) CEP(6,14) CEP(7,15)
  CEP(0,4) CEP(1,5) CEP(2,6) CEP(3,7)
  CEP(8,12) CEP(9,13) CEP(10,14) CEP(11,15)
  CEP(0,2) CEP(1,3) CEP(4,6) CEP(5,7)
  CEP(8,10) CEP(9,11) CEP(12,14) CEP(13,15)
  CEP(0,1) CEP(2,3) CEP(4,5) CEP(6,7)
  CEP(8,9) CEP(10,11) CEP(12,13) CEP(14,15)
}
#undef CEP
__device__ __forceinline__ unsigned fkey(float f, int low7) { unsigned u = __float_as_uint(f); u ^= (unsigned)((int)u >> 31) | 0x80000000u; return (u & ~127u) | (unsigned)low7; }
__device__ __forceinline__ float funkey(unsigned k) { unsigned u = k & ~127u; u ^= (u & 0x80000000u) ? 0x80000000u : 0xFFFFFFFFu; return __uint_as_float(u); }
__device__ __forceinline__ void peer_half_top16(const char* __restrict__ kl  , int r32, const bf16_t* __restrict__ qp, int hi, unsigned* T) {
  bf16x8 bq[8]; int kofs[8];
#pragma unroll
  for (int ks = 0; ks < 8; ++ks) { bq[ks] = *(const bf16x8*)(qp + ks * 16); kofs[ks] = r32 * 256 + (((ks * 16 + hi * 8) * 2) ^ ((r32 & 7) << 4)); }
  unsigned L[16];
#pragma unroll
  for (int mt = 0; mt < 4; ++mt) {
    f32x16 acc = {};
#pragma unroll
    for (int ks = 0; ks < 8; ++ks) {
      const bf16x8 a = *(const bf16x8*)(kl + mt * 8192 + kofs[ks]);
      acc = __builtin_amdgcn_mfma_f32_32x32x16_bf16(a, bq[ks], acc, 0, 0, 0);
    }
    unsigned k[16];
#pragma unroll
    for (int r = 0; r < 16; ++r) k[r] = fkey(acc[r], 127 - (mt * 32 + (r & 3) + 8 * (r >> 2) + 4 * hi));
    sort16k(k);
    if (mt == 0) {
#pragma unroll
      for (int i = 0; i < 16; ++i) L[i] = k[i];
    } else {
#pragma unroll
      for (int i = 0; i < 16; ++i) L[i] = max(L[i], k[15 - i]);
      bmerge16k(L);
    }
  }
#pragma unroll
  for (int i = 0; i < 16; ++i) {
    const auto rr = __builtin_amdgcn_permlane32_swap(L[15 - i], L[15 - i], false, false);
    const unsigned partner = hi ? rr[0] : rr[1];
    T[i] = max(L[i], partner);
  }
  bmerge16k(T);
}
__device__ void peer_topk(const Params& p, int layer, int nrows, char* smem) {
  const int tid = TIDX, wid = tid >> 6, lane = tid & 63, r32 = lane & 31, hi = lane >> 5;
  const bf16_t* pq = (const bf16_t*)(p.ws + OFF_PQ);
  const bf16_t* keys = (const bf16_t*)(p.ws + OFF_KEYS) + (size_t)layer * 2 * 128 * 128;
  int* eid = (int*)(p.ws + OFF_EID); float* gate = (float*)(p.ws + OFF_GATE);
  __syncthreads();
  for (int i = tid; i < 4096; i += NTHREADS) {
    const int half = i >> 11, key = (i >> 4) & 127, c16 = i & 15;
    *(u32x4*)(smem + half * 32768 + KSWZ(key, c16 * 16)) = *(const u32x4*)(keys + (size_t)(half * 128 + key) * 128 + c16 * 8);
  }
  __syncthreads();
  const int ntask = (nrows / 32) * 8;
  for (int task = BIDX * 8 + wid; task < ntask; task += gridDim.x * 8) {
    const int grp = task >> 3, h = task & 7;
    const size_t row = (size_t)grp * 32 + r32;
    unsigned K1[16], K2[16];
    const int lofs = launder_v(0);
    peer_half_top16(smem + lofs, r32, pq + row * 2048 + h * 256 + hi * 8, hi, K1);
    peer_half_top16(smem + lofs + 32768, r32, pq + row * 2048 + h * 256 + 128 + hi * 8, hi, K2);
    float v1[16], v2[16]; int i1[16], i2[16];
#pragma unroll
    for (int i = 0; i < 16; ++i) { v1[i] = funkey(K1[i]); v2[i] = funkey(K2[i]); i1[i] = 127 - (int)(K1[i] & 127u); i2[i] = 127 - (int)(K2[i] & 127u); }
    float ts[16]; int tp[16];
    {
      float* cv = ts; int* cp = tp;
    cv[0] = v1[0] + v2[0]; cp[0] = (i1[0] << 7) | i2[0];
    cv[1] = v1[0] + v2[1]; cp[1] = (i1[0] << 7) | i2[1];
    cv[2] = v1[0] + v2[2]; cp[2] = (i1[0] << 7) | i2[2];
    cv[3] = v1[0] + v2[3]; cp[3] = (i1[0] << 7) | i2[3];
    cv[4] = v1[0] + v2[4]; cp[4] = (i1[0] << 7) | i2[4];
    cv[5] = v1[0] + v2[5]; cp[5] = (i1[0] << 7) | i2[5];
    cv[6] = v1[0] + v2[6]; cp[6] = (i1[0] << 7) | i2[6];
    cv[7] = v1[0] + v2[7]; cp[7] = (i1[0] << 7) | i2[7];
    cv[8] = v1[0] + v2[8]; cp[8] = (i1[0] << 7) | i2[8];
    cv[9] = v1[0] + v2[9]; cp[9] = (i1[0] << 7) | i2[9];
    cv[10] = v1[0] + v2[10]; cp[10] = (i1[0] << 7) | i2[10];
    cv[11] = v1[0] + v2[11]; cp[11] = (i1[0] << 7) | i2[11];
    cv[12] = v1[0] + v2[12]; cp[12] = (i1[0] << 7) | i2[12];
    cv[13] = v1[0] + v2[13]; cp[13] = (i1[0] << 7) | i2[13];
    cv[14] = v1[0] + v2[14]; cp[14] = (i1[0] << 7) | i2[14];
    cv[15] = v1[0] + v2[15]; cp[15] = (i1[0] << 7) | i2[15];
      sort16p(ts, tp);
    }
#pragma unroll 1
    for (int g = 1; g < 3; ++g) {
      float cv[16]; int cp[16];
      if (g == 1) {
    cv[0] = v1[1] + v2[0]; cp[0] = (i1[1] << 7) | i2[0];
    cv[1] = v1[1] + v2[1]; cp[1] = (i1[1] << 7) | i2[1];
    cv[2] = v1[1] + v2[2]; cp[2] = (i1[1] << 7) | i2[2];
    cv[3] = v1[1] + v2[3]; cp[3] = (i1[1] << 7) | i2[3];
    cv[4] = v1[1] + v2[4]; cp[4] = (i1[1] << 7) | i2[4];
    cv[5] = v1[1] + v2[5]; cp[5] = (i1[1] << 7) | i2[5];
    cv[6] = v1[1] + v2[6]; cp[6] = (i1[1] << 7) | i2[6];
    cv[7] = v1[1] + v2[7]; cp[7] = (i1[1] << 7) | i2[7];
    cv[8] = v1[2] + v2[0]; cp[8] = (i1[2] << 7) | i2[0];
    cv[9] = v1[2] + v2[1]; cp[9] = (i1[2] << 7) | i2[1];
    cv[10] = v1[2] + v2[2]; cp[10] = (i1[2] << 7) | i2[2];
    cv[11] = v1[2] + v2[3]; cp[11] = (i1[2] << 7) | i2[3];
    cv[12] = v1[2] + v2[4]; cp[12] = (i1[2] << 7) | i2[4];
    cv[13] = v1[3] + v2[0]; cp[13] = (i1[3] << 7) | i2[0];
    cv[14] = v1[3] + v2[1]; cp[14] = (i1[3] << 7) | i2[1];
    cv[15] = v1[3] + v2[2]; cp[15] = (i1[3] << 7) | i2[2];
      } else {
    cv[0] = v1[3] + v2[3]; cp[0] = (i1[3] << 7) | i2[3];
    cv[1] = v1[4] + v2[0]; cp[1] = (i1[4] << 7) | i2[0];
    cv[2] = v1[4] + v2[1]; cp[2] = (i1[4] << 7) | i2[1];
    cv[3] = v1[4] + v2[2]; cp[3] = (i1[4] << 7) | i2[2];
    cv[4] = v1[5] + v2[0]; cp[4] = (i1[5] << 7) | i2[0];
    cv[5] = v1[5] + v2[1]; cp[5] = (i1[5] << 7) | i2[1];
    cv[6] = v1[6] + v2[0]; cp[6] = (i1[6] << 7) | i2[0];
    cv[7] = v1[6] + v2[1]; cp[7] = (i1[6] << 7) | i2[1];
    cv[8] = v1[7] + v2[0]; cp[8] = (i1[7] << 7) | i2[0];
    cv[9] = v1[7] + v2[1]; cp[9] = (i1[7] << 7) | i2[1];
    cv[10] = v1[8] + v2[0]; cp[10] = (i1[8] << 7) | i2[0];
    cv[11] = v1[9] + v2[0]; cp[11] = (i1[9] << 7) | i2[0];
    cv[12] = v1[10] + v2[0]; cp[12] = (i1[10] << 7) | i2[0];
    cv[13] = v1[11] + v2[0]; cp[13] = (i1[11] << 7) | i2[0];
    cv[14] = v1[12] + v2[0]; cp[14] = (i1[12] << 7) | i2[0];
    cv[15] = v1[13] + v2[0]; cp[15] = (i1[13] << 7) | i2[0];
      }
      sort16p(cv, cp);
#pragma unroll
      for (int i = 0; i < 16; ++i) if (cv[15 - i] > ts[i]) { ts[i] = cv[15 - i]; tp[i] = cp[15 - i]; }
      bmerge16p(ts, tp);
    }
    {
      float cv[2]; int cp[2];
    cv[0] = v1[14] + v2[0]; cp[0] = (i1[14] << 7) | i2[0];
    cv[1] = v1[15] + v2[0]; cp[1] = (i1[15] << 7) | i2[0];
      if (cv[0] < cv[1]) { const float tv = cv[0]; cv[0] = cv[1]; cv[1] = tv; const int ti = cp[0]; cp[0] = cp[1]; cp[1] = ti; }
      if (cv[1] > ts[14]) { ts[14] = cv[1]; tp[14] = cp[1]; }
      if (cv[0] > ts[15]) { ts[15] = cv[0]; tp[15] = cp[0]; }
      bmerge16p(ts, tp);
    }
    float ex[16], sm = 0.f;
#pragma unroll
    for (int i = 0; i < 16; ++i) { ex[i] = __expf(ts[i] - ts[0]); sm += ex[i]; }
    const float rs = 1.f / sm;
    if (hi == 0) {
      int* eo = eid + row * 128 + h * 16;
#pragma unroll
      for (int i = 0; i < 4; ++i) { const u32x4 o = {(unsigned)tp[4 * i], (unsigned)tp[4 * i + 1], (unsigned)tp[4 * i + 2], (unsigned)tp[4 * i + 3]}; *(u32x4*)(eo + 4 * i) = o; }
    } else {
      float* go = gate + row * 128 + h * 16;
#pragma unroll
      for (int i = 0; i < 4; ++i) { const f32x4 o = {ex[4 * i] * rs, ex[4 * i + 1] * rs, ex[4 * i + 2] * rs, ex[4 * i + 3] * rs}; *(f32x4*)(go + 4 * i) = o; }
    }
  }
}

constexpr float PEER_USCALE = 16.f;
__device__ void peer_cvt_tables(const Params& p, int layer, int rank, int nb) {
  const float* ut = p.in[I_PU] + (size_t)layer * 16384 * DM; const float* vt = p.in[I_PV] + (size_t)layer * 16384 * DM;
  u32x4* uo = (u32x4*)(p.ws + OFF_UTAB); u32x4* vo = (u32x4*)(p.ws + OFF_VTAB);
  const int n16 = 16384 * DM / 16, stride = nb * NTHREADS;
  for (int i = rank * NTHREADS + TIDX; i < 2 * n16; i += 2 * stride) {
    f32x4 a[2][4];
#pragma unroll
    for (int k = 0; k < 2; ++k) {
      const int ii = i + k * stride;
      if (ii < 2 * n16) {
        const bool isv = ii >= n16; const int j = isv ? ii - n16 : ii;
        const float* s = (isv ? vt : ut) + (size_t)j * 16;
#pragma unroll
        for (int q = 0; q < 4; ++q) a[k][q] = *(const f32x4*)(s + 4 * q);
      }
    }
#pragma unroll
    for (int k = 0; k < 2; ++k) {
      const int ii = i + k * stride;
      if (ii < 2 * n16) {
        const bool isv = ii >= n16; const int j = isv ? ii - n16 : ii; const float sc = isv ? 1.f : PEER_USCALE;
        u32x4 o;
#pragma unroll
        for (int q = 0; q < 4; ++q) {
          int w = __builtin_amdgcn_cvt_pk_fp8_f32(a[k][q][0] * sc, a[k][q][1] * sc, 0, false);
          w = __builtin_amdgcn_cvt_pk_fp8_f32(a[k][q][2] * sc, a[k][q][3] * sc, w, true);
          o[q] = (unsigned)w;
        }
        (isv ? vo : uo)[j] = o;
      }
    }
  }
}

__device__ __forceinline__ int xcc_slice() { return (int)((unsigned)__builtin_amdgcn_s_getreg((3 << 11) | 20) & 7u); }
__device__ __forceinline__ float row16_sum(float v) { v += dpp_mov<0xB1>(v); v += dpp_mov<0x4E>(v); v += dpp_mov<0x141>(v); v += dpp_mov<0x128>(v); return v; }
constexpr int PNS = 8;
constexpr int PSEGL = 8;
constexpr int PEPL = 64 / PSEGL;
constexpr int PNI = 128 / PEPL;
constexpr int PCOLS = 1024 / PNS;
using f32x2 = __attribute__((ext_vector_type(2))) float;
template <int PHASE>
__device__ void peer_sliced(const Params& p, int layer, int nrows) {
#if defined(PROBE_PEER_REP)
  int nrep = (PHASE == PROBE_PEER_REP) ? 2 : 1; asm volatile("" : "+s"(nrep));
#else
  constexpr int nrep = 1;
#endif
  for (int rep = 0; rep < nrep; ++rep) {
  const int dry = (rep + 1 < nrep) ? 1 : 0;
  const int lane = TIDX & 63, eg = lane / PSEGL, ch = lane % PSEGL;
  const bf16_t* hb = (const bf16_t*)(p.ws + OFF_HB);
  const int* eid = (const int*)(p.ws + OFF_EID);
  const unsigned char* tab = (const unsigned char*)(p.ws + (PHASE == 0 ? OFF_UTAB : OFF_VTAB)) + ch * 16;
  float* sp = (float*)(p.ws + OFF_SP); const float* wbuf = (const float*)(p.ws + OFF_WBUF);
  float* xs = (float*)(p.ws + OFF_XS);
  unsigned* ctr = (unsigned*)(p.ws + OFF_CTR) + (size_t)(((rep * 2 + layer) * 2 + PHASE) * 16) * 64;
  const int x0 = xcc_slice();
  const int bpa = eg << 2;
  for (int si = 0; si < PNS; ++si) {
    const int slice = (x0 + si) % PNS;
    int nbase = 0;
    if (lane == 0) nbase = (int)__hip_atomic_fetch_add(&ctr[slice * 64], 4u, __ATOMIC_RELAXED, __HIP_MEMORY_SCOPE_AGENT);
    for (;;) {
      const int base = __builtin_amdgcn_readfirstlane(nbase);
      if (base >= nrows) break;
      if (lane == 0) nbase = (int)__hip_atomic_fetch_add(&ctr[slice * 64], 4u, __ATOMIC_RELAXED, __HIP_MEMORY_SCOPE_AGENT);
      int eA = eid[(size_t)base * 128 + lane], eB = eid[(size_t)base * 128 + 64 + lane];
      float wA = 0.f, wB = 0.f;
      if (PHASE == 1) { wA = wbuf[(size_t)base * 128 + lane]; wB = wbuf[(size_t)base * 128 + 64 + lane]; }
#pragma unroll 1
      for (int tt = 0; tt < 4; ++tt) {
        const int r = base + tt;
        const int ceA = eA, ceB = eB; const float cwA = wA, cwB = wB;
        if (tt < 3) {
          eA = eid[(size_t)(r + 1) * 128 + lane]; eB = eid[(size_t)(r + 1) * 128 + 64 + lane];
          if (PHASE == 1) { wA = wbuf[(size_t)(r + 1) * 128 + lane]; wB = wbuf[(size_t)(r + 1) * 128 + 64 + lane]; }
        }
        int ev[PNI];
#pragma unroll
        for (int i = 0; i < PNI; ++i) ev[i] = __builtin_amdgcn_ds_bpermute(bpa + 32 * (i & 7), (i < 8) ? ceA : ceB);
        if (PHASE == 0) {
          float xv[16];
          {
            const u32x4 xa = *(const u32x4*)(hb + (size_t)r * DM + slice * PCOLS + ch * 16), xb = *(const u32x4*)(hb + (size_t)r * DM + slice * PCOLS + ch * 16 + 8);
#pragma unroll
            for (int q = 0; q < 4; ++q) { xv[2 * q] = __uint_as_float(xa[q] << 16); xv[2 * q + 1] = __uint_as_float(xa[q] & 0xffff0000u);
                                          xv[8 + 2 * q] = __uint_as_float(xb[q] << 16); xv[8 + 2 * q + 1] = __uint_as_float(xb[q] & 0xffff0000u); }
          }
          u32x4 uv[PNI];
#pragma unroll
          for (int j = 0; j < PNI; ++j) uv[j] = *(const u32x4*)(tab + (size_t)ev[j] * DM + slice * PCOLS);
          float keep0 = 0.f, keep1 = 0.f;
#pragma unroll
          for (int j = 0; j < PNI; ++j) {
            float d = 0.f;
#pragma unroll
            for (int q = 0; q < 4; ++q) {
              const f32x2 lo = __builtin_amdgcn_cvt_pk_f32_fp8((int)uv[j][q], false), hi2 = __builtin_amdgcn_cvt_pk_f32_fp8((int)uv[j][q], true);
              d += lo[0] * xv[4 * q] + lo[1] * xv[4 * q + 1] + hi2[0] * xv[4 * q + 2] + hi2[1] * xv[4 * q + 3];
            }
            d += dpp_mov<0xB1>(d); d += dpp_mov<0x4E>(d); d += dpp_mov<0x141>(d);
            if (ch == (j % PSEGL)) { if (j < PSEGL) keep0 = d; else keep1 = d; }
          }
          float* so = sp + ((size_t)slice * NTOK + r) * 128 + PEPL * ch + eg;
          so[0] = keep0 * (1.f / PEER_USCALE); so[64] = keep1 * (1.f / PEER_USCALE);
        } else {
          u32x4 vv[PNI];
#pragma unroll
          for (int j = 0; j < PNI; ++j) vv[j] = *(const u32x4*)(tab + (size_t)ev[j] * DM + slice * PCOLS);
          float acc[16];
#pragma unroll
          for (int j = 0; j < 16; ++j) acc[j] = 0.f;
#pragma unroll
          for (int j = 0; j < PNI; ++j) {
            const float w = __int_as_float(__builtin_amdgcn_ds_bpermute(bpa + 32 * (j & 7), __float_as_int((j < 8) ? cwA : cwB)));
#pragma unroll
            for (int q = 0; q < 4; ++q) {
              const f32x2 lo = __builtin_amdgcn_cvt_pk_f32_fp8((int)vv[j][q], false), hi2 = __builtin_amdgcn_cvt_pk_f32_fp8((int)vv[j][q], true);
              acc[4 * q] += w * lo[0]; acc[4 * q + 1] += w * lo[1]; acc[4 * q + 2] += w * hi2[0]; acc[4 * q + 3] += w * hi2[1];
            }
          }
#pragma unroll
          for (int j = 0; j < 16; ++j) {
            acc[j] += dpp_mov<0x128>(acc[j]);
            { auto rr = __builtin_amdgcn_permlane16_swap(__float_as_uint(acc[j]), __float_as_uint(acc[j]), false, false); acc[j] = __uint_as_float(rr[0]) + __uint_as_float(rr[1]); }
            { auto rr = __builtin_amdgcn_permlane32_swap(__float_as_uint(acc[j]), __float_as_uint(acc[j]), false, false); acc[j] = __uint_as_float(rr[0]) + __uint_as_float(rr[1]); }
          }
          if (eg == 0) {
            int b, t, isc; row_info(r, b, t, isc);
            const float* g2 = (const float*)(p.ws + OFF_MOD) + ((size_t)layer * 3 + (isc ? 2 : b)) * 6144 + 5120 + slice * PCOLS + ch * 16;
            float* xr = xs + (size_t)r * DM + slice * PCOLS + ch * 16;
#pragma unroll
            for (int q = 0; q < 4; ++q) {
              f32x4 xq = *(const f32x4*)(xr + 4 * q);
#pragma unroll
              for (int j = 0; j < 4; ++j) xq[j] += g2[4 * q + j] * acc[4 * q + j];
              if (dry == 0) *(f32x4*)(xr + 4 * q) = xq;
            }
          }
        }
      }
    }
  }
  }
}
__device__ void peer_weights(const Params& p, int nrows) {
  const float* sp = (const float*)(p.ws + OFF_SP); const float* gate = (const float*)(p.ws + OFF_GATE); float* wbuf = (float*)(p.ws + OFF_WBUF);
  for (int i = BIDX * NTHREADS + TIDX; i < nrows * 128; i += gridDim.x * NTHREADS) {
    float s = 0.f;
#pragma unroll
    for (int x = 0; x < PNS; ++x) s += sp[(size_t)x * NTOK * 128 + i];
    wbuf[i] = gate[i] * gelu_tanh(s);
  }
}

__device__ void peer_eval_fused(const Params& p, int layer, int nrows, char* smem) {
  const int tid = TIDX, wid = tid >> 6, lane = tid & 63, eg = lane >> 3, ch = lane & 7;
  const int ntb = nrows / (int)gridDim.x, tok0 = BIDX * ntb;
  float* S = (float*)smem;
  int* E = (int*)(smem + 72 * 128 * 4);
  const bf16_t* hb = (const bf16_t*)(p.ws + OFF_HB);
  const int* eid = (const int*)(p.ws + OFF_EID); const float* gate = (const float*)(p.ws + OFF_GATE);
  const unsigned char* utab = (const unsigned char*)(p.ws + OFF_UTAB) + ch * 16; const unsigned char* vtab = (const unsigned char*)(p.ws + OFF_VTAB) + ch * 16;
  float* xs = (float*)(p.ws + OFF_XS);
  __syncthreads();
  for (int i = tid; i < ntb * 128; i += NTHREADS) { S[i] = 0.f; E[i] = eid[(size_t)tok0 * 128 + i]; }
  __syncthreads();
#pragma unroll 1
  for (int it = wid; it < ntb * 8; it += 8) {
    const int slice = it / ntb, tl = it - slice * ntb, r = tok0 + tl;
    int ev[16];
#pragma unroll
    for (int j = 0; j < 16; ++j) ev[j] = E[tl * 128 + 8 * j + eg];
    float xv[16];
    {
      const u32x4 xa = *(const u32x4*)(hb + (size_t)r * DM + slice * 128 + ch * 16), xb = *(const u32x4*)(hb + (size_t)r * DM + slice * 128 + ch * 16 + 8);
#pragma unroll
      for (int q = 0; q < 4; ++q) { xv[2 * q] = __uint_as_float(xa[q] << 16); xv[2 * q + 1] = __uint_as_float(xa[q] & 0xffff0000u);
                                    xv[8 + 2 * q] = __uint_as_float(xb[q] << 16); xv[8 + 2 * q + 1] = __uint_as_float(xb[q] & 0xffff0000u); }
    }
    u32x4 uv[16];
#pragma unroll
    for (int j = 0; j < 16; ++j) uv[j] = *(const u32x4*)(utab + (size_t)ev[j] * DM + slice * 128);
    float keep0 = 0.f, keep1 = 0.f;
#pragma unroll
    for (int j = 0; j < 16; ++j) {
      float d = 0.f;
#pragma unroll
      for (int q = 0; q < 4; ++q) {
        const f32x2 lo = __builtin_amdgcn_cvt_pk_f32_fp8((int)uv[j][q], false), hi2 = __builtin_amdgcn_cvt_pk_f32_fp8((int)uv[j][q], true);
        d += lo[0] * xv[4 * q] + lo[1] * xv[4 * q + 1] + hi2[0] * xv[4 * q + 2] + hi2[1] * xv[4 * q + 3];
      }
      d += dpp_mov<0xB1>(d); d += dpp_mov<0x4E>(d); d += dpp_mov<0x141>(d);
      if (ch == (j & 7)) { if (j < 8) keep0 = d; else keep1 = d; }
    }
    atomicAdd(&S[tl * 128 + 8 * ch + eg], keep0); atomicAdd(&S[tl * 128 + 64 + 8 * ch + eg], keep1);
  }
  __syncthreads();
  for (int i = tid; i < ntb * 128; i += NTHREADS) S[i] = gate[(size_t)tok0 * 128 + i] * gelu_tanh(S[i] * (1.f / PEER_USCALE));
  __syncthreads();
#pragma unroll 1
  for (int it = wid; it < ntb * 8; it += 8) {
    const int slice = it / ntb, tl = it - slice * ntb, r = tok0 + tl;
    int ev[16]; float wv[16];
#pragma unroll
    for (int j = 0; j < 16; ++j) { ev[j] = E[tl * 128 + 8 * j + eg]; wv[j] = S[tl * 128 + 8 * j + eg]; }
    u32x4 vv[16];
#pragma unroll
    for (int j = 0; j < 16; ++j) vv[j] = *(const u32x4*)(vtab + (size_t)ev[j] * DM + slice * 128);
    float acc[16];
#pragma unroll
    for (int j = 0; j < 16; ++j) acc[j] = 0.f;
#pragma unroll
    for (int j = 0; j < 16; ++j) {
      const float w = wv[j];
#pragma unroll
      for (int q = 0; q < 4; ++q) {
        const f32x2 lo = __builtin_amdgcn_cvt_pk_f32_fp8((int)vv[j][q], false), hi2 = __builtin_amdgcn_cvt_pk_f32_fp8((int)vv[j][q], true);
        acc[4 * q] += w * lo[0]; acc[4 * q + 1] += w * lo[1]; acc[4 * q + 2] += w * hi2[0]; acc[4 * q + 3] += w * hi2[1];
      }
    }
#pragma unroll
    for (int j = 0; j < 16; ++j) {
      acc[j] += dpp_mov<0x128>(acc[j]);
      { auto rr = __builtin_amdgcn_permlane16_swap(__float_as_uint(acc[j]), __float_as_uint(acc[j]), false, false); acc[j] = __uint_as_float(rr[0]) + __uint_as_float(rr[1]); }
      { auto rr = __builtin_amdgcn_permlane32_swap(__float_as_uint(acc[j]), __float_as_uint(acc[j]), false, false); acc[j] = __uint_as_float(rr[0]) + __uint_as_float(rr[1]); }
    }
    if (eg == 0) {
      int b, t, isc; row_info(r, b, t, isc);
      const float* g2 = (const float*)(p.ws + OFF_MOD) + ((size_t)layer * 3 + (isc ? 2 : b)) * 6144 + 5120 + slice * 128 + ch * 16;
      float* xr = xs + (size_t)r * DM + slice * 128 + ch * 16;
#pragma unroll
      for (int q = 0; q < 4; ++q) {
        f32x4 xq = *(const f32x4*)(xr + 4 * q);
#pragma unroll
        for (int j = 0; j < 4; ++j) xq[j] += g2[4 * q + j] * acc[4 * q + j];
        *(f32x4*)(xr + 4 * q) = xq;
      }
    }
  }
  __syncthreads();
  {
    const bool last = (layer == 1);
    const float* g = last ? p.in[I_FG] : p.in[I_N1G] + (layer + 1) * DM;
    bf16_t* hbw = (bf16_t*)(p.ws + OFF_HB);
#pragma unroll 1
    for (int tl0 = wid * 3; tl0 < ntb; tl0 += 24) {
      f32x4 v[3][4]; float ss[3]; const float* modj[3];
#pragma unroll
      for (int j = 0; j < 3; ++j) {
        int b, t, isc; row_info(min(tok0 + tl0 + j, tok0 + ntb - 1), b, t, isc);
        modj[j] = (const float*)(p.ws + OFF_MOD) + ((size_t)(last ? 1 : layer + 1) * 3 + (isc ? 2 : b)) * 6144;
      }
#pragma unroll
      for (int j = 0; j < 3; ++j) {
        const int r = min(tok0 + tl0 + j, tok0 + ntb - 1);
        ss[j] = 0.f;
#pragma unroll
        for (int i = 0; i < 4; ++i) { v[j][i] = *(const f32x4*)(xs + (size_t)r * DM + (i * 64 + lane) * 4); ss[j] += v[j][i][0] * v[j][i][0] + v[j][i][1] * v[j][i][1] + v[j][i][2] * v[j][i][2] + v[j][i][3] * v[j][i][3]; }
      }
#pragma unroll
      for (int j = 0; j < 3; ++j) ss[j] = rsqrtf(wave_sum(ss[j]) * (1.f / DM) + EPSV);
#pragma unroll
      for (int i = 0; i < 4; ++i) {
        const int c0 = (i * 64 + lane) * 4; const f32x4 gv = *(const f32x4*)(g + c0);
#pragma unroll
        for (int j = 0; j < 3; ++j) {
          const int r = tok0 + tl0 + j;
          if (tl0 + j < ntb) {
            if (last) { if (r < NLAT) *(f32x4*)(p.out + (size_t)r * DM + c0) = v[j][i] * ss[j] * gv; }
            else {
              const f32x4 sc = *(const f32x4*)(modj[j] + 1024 + c0), sh = *(const f32x4*)(modj[j] + c0);
              float y[4];
#pragma unroll
              for (int q = 0; q < 4; ++q) y[q] = v[j][i][q] * ss[j] * gv[q] * (1.f + sc[q]) + sh[q];
              const u32x2 o = {cvtpk(y[0], y[1]), cvtpk(y[2], y[3])};
              *(u32x2*)(hbw + (size_t)r * DM + c0) = o;
            }
          }
        }
      }
    }
  }
}

__device__ void final_norm(const Params& p) {
  const int lane = TIDX & 63, wid = TIDX >> 6;
  const float* xs = (const float*)(p.ws + OFF_XS); const float* g = p.in[I_FG];
  for (int grp = BIDX * 8 + wid; grp < NLAT / 4; grp += gridDim.x * 8) {
    const int r0 = grp * 4;
    f32x4 v[4][4]; float ss[4];
#pragma unroll
    for (int j = 0; j < 4; ++j) {
      ss[j] = 0.f;
#pragma unroll
      for (int i = 0; i < 4; ++i) { v[j][i] = *(const f32x4*)(xs + (size_t)(r0 + j) * DM + (i * 64 + lane) * 4); ss[j] += v[j][i][0] * v[j][i][0] + v[j][i][1] * v[j][i][1] + v[j][i][2] * v[j][i][2] + v[j][i][3] * v[j][i][3]; }
    }
#pragma unroll
    for (int j = 0; j < 4; ++j) ss[j] = rsqrtf(wave_sum(ss[j]) * (1.f / DM) + EPSV);
#pragma unroll
    for (int i = 0; i < 4; ++i) {
      const int c0 = (i * 64 + lane) * 4; const f32x4 gv = *(const f32x4*)(g + c0);
#pragma unroll
      for (int j = 0; j < 4; ++j) { const f32x4 o = v[j][i] * ss[j] * gv; *(f32x4*)(p.out + (size_t)(r0 + j) * DM + c0) = o; }
    }
  }
}

namespace pg8 {
#define PG8_LAS __attribute__((address_space(3)))
typedef unsigned short bf16_t;
typedef short bf16x8 __attribute__((ext_vector_type(8)));
typedef float f32x4 __attribute__((ext_vector_type(4)));
typedef unsigned u32x4 __attribute__((ext_vector_type(4)));
constexpr int BM = 256, BK = 64, HALF = 128, HTB = HALF * BK * 2  , STAGE_BYTES = 8 * HTB, NXCD = 8, WGM = 8;

__host__ __device__ __forceinline__ int lds_byte(int r, int c) { const int st = (r >> 4) * 2 + (c >> 5), rr = r & 15, cc = c & 31, ob = rr * 64 + cc * 2; return st * 1024 + (ob ^ (((ob >> 9) & 1) << 5)); }
__host__ __device__ __forceinline__ void stage_rc(int b, int& R, int& C) { const int st = b / 1024, sb = b % 1024, swz = sb ^ (((sb >> 9) & 1) << 5); R = (st >> 1) * 16 + swz / 64; C = (st & 1) * 32 + (swz % 64) / 2; }
__host__ __device__ __forceinline__ int perm32(int rho) { const int n = rho >> 4, i = rho & 15; return 8 * (i >> 2) + 4 * n + (i & 3); }

struct Unit { int pm, pn; };
struct Gemm { const bf16_t* A; const bf16_t* Bt; int M, N, K; };

struct StaticOrder {
    int nM, nN, nwg, G, c;
    __host__ __device__ void init(int M, int N, int G_, int c_) { nM = M / BM; nN = N / BM; nwg = nM * nN; G = G_; c = c_; }
    __host__ __device__ bool next(int i, Unit& u) const {
        const long L = (long)i * G + c; if (L >= nwg) return false;
        int wgid = (int)L; { const int q = nwg / NXCD, r = nwg % NXCD, xcd = wgid % NXCD, off = wgid / NXCD; wgid = (xcd < r ? xcd * (q + 1) : r * (q + 1) + (xcd - r) * q) + off; }
        const int nig = WGM * nN, gid = wgid / nig, fm = gid * WGM, gsz = (nM - fm) < WGM ? (nM - fm) : WGM;
        u.pm = fm + ((wgid % nig) % gsz); u.pn = (wgid % nig) / gsz; return true;
    }
    __device__ __forceinline__ void a_ready(const Unit&) const {}
    __device__ __forceinline__ void done(const Unit&) const {}
};
template <class Epi, class Sched, bool STAMP = false>
__device__ __forceinline__ void gemm_phase(PG8_LAS unsigned char* lds, const Gemm g, const Sched& S, const Epi& E, unsigned long long* stamps) {
    const int tid = launder_v((int)threadIdx.x)  , wid = __builtin_amdgcn_readfirstlane(tid >> 6), lane = tid & 63, wr = wid >> 2, wc = wid & 3, fr = lane & 15, fq = lane >> 4;
    const int K = g.K, nt = K / BK;
    int ts_lo = 0, ts_hi = 0, nts = 0; const unsigned long long rt_entry = STAMP ? 0ull : 0ull;
#define PG8_STAMP() do { if (STAMP && wid == 0 && nts < 64) { const unsigned long long _c = 0ull; \
        ts_lo = (lane == nts) ? (int)(unsigned)_c : ts_lo; ts_hi = (lane == nts) ? (int)(unsigned)(_c >> 32) : ts_hi; ++nts; } } while (0)
    PG8_STAMP();
    unsigned voffA[2], voffB[2];
#pragma unroll
    for (int i = 0; i < 2; ++i) { int R, C; stage_rc(tid * 16 + i * 8192, R, C); const int Rb = Epi::PERM ? ((R & ~31) + perm32(R & 31)) : R;
        voffA[i] = (unsigned)(R * K + C) * 2u; voffB[i] = (unsigned)(Rb * K + C) * 2u; }
    const size_t kstep = (size_t)(BK * 2);
    const size_t hstep = (size_t)HALF * K * 2;
    const size_t tstep = 2 * hstep;
    const unsigned ldsw = (unsigned)wid * 1024u;
    const int aoff = lds_byte(wr * 64 + fr, fq * 8), boff = launder_v(lds_byte(wc * 32 + fr, fq * 8) + 4 * HTB);
#define PG8_SA(b, h) (((b) * 2 + (h)) * HTB)
#define PG8_SB(b, h) ((4 + (b) * 2 + (h)) * HTB)
#define PG8_STAGE(bufoff, gbase, voff) do { _Pragma("unroll") for (int _i = 0; _i < 2; ++_i) \
        __builtin_amdgcn_global_load_lds((const unsigned*)((const char*)(gbase) + (voff)[_i]), (PG8_LAS unsigned*)(lds + (bufoff) + ldsw + _i * 8192), 16, 0, 0); } while (0)
#define PG8_LDA(dst, b, h) do { _Pragma("unroll") for (int m = 0; m < 4; ++m) _Pragma("unroll") for (int k = 0; k < 2; ++k) dst[m][k] = *(const PG8_LAS bf16x8*)(lds + PG8_SA(b, h) + aoff + m * 2048 + k * 1024); } while (0)
#define PG8_LDB(dst, b, h) do { _Pragma("unroll") for (int n = 0; n < 2; ++n) _Pragma("unroll") for (int k = 0; k < 2; ++k) dst[n][k] = *(const PG8_LAS bf16x8*)(lds + boff + ((b) * 2 + (h)) * HTB + n * 2048 + k * 1024); } while (0)
#define PG8_MMA(ai, bj, At, Bt) do { __builtin_amdgcn_s_setprio(1); _Pragma("unroll") for (int m = 0; m < 4; ++m) _Pragma("unroll") for (int n = 0; n < 2; ++n) _Pragma("unroll") for (int k = 0; k < 2; ++k) \
        acc[ai][bj][m][n] = __builtin_amdgcn_mfma_f32_16x16x32_bf16(Bt[n][k], At[m][k], acc[ai][bj][m][n], 0, 0, 0); __builtin_amdgcn_s_setprio(0); } while (0)
#define PG8_WAIT_V(n) asm volatile("s_waitcnt vmcnt(" #n ")" ::: "memory")
#define PG8_WAIT_L(n) asm volatile("s_waitcnt lgkmcnt(" #n ")" ::: "memory")
#define PG8_BAR __builtin_amdgcn_s_barrier()
#define PG8_SCHED __builtin_amdgcn_sched_barrier(0)
    Unit cur, nxt; int ui = 0;
    if (!S.next(0, cur)) return;
    f32x4 acc[2][2][4][2];
#pragma unroll
    for (int a = 0; a < 2; ++a)
#pragma unroll
        for (int b = 0; b < 2; ++b)
#pragma unroll
            for (int m = 0; m < 4; ++m)
#pragma unroll
                for (int n = 0; n < 2; ++n) acc[a][b][m][n] = (f32x4){0.f, 0.f, 0.f, 0.f};
    bf16x8 At[4][2], B0[2][2], B1[2][2];
    const char* cA = (const char*)g.A + (size_t)cur.pm * tstep; const char* cB = (const char*)g.Bt + (size_t)cur.pn * tstep;
    S.a_ready(cur);
    PG8_STAGE(PG8_SB(0, 0), cB, voffB); PG8_STAGE(PG8_SA(0, 0), cA, voffA); PG8_STAGE(PG8_SB(0, 1), cB + hstep, voffB); PG8_STAGE(PG8_SA(0, 1), cA + hstep, voffA);
    if (wr == 1) PG8_BAR;
    PG8_WAIT_V(4); PG8_BAR;
    PG8_STAGE(PG8_SB(1, 0), cB + kstep, voffB); PG8_STAGE(PG8_SA(1, 0), cA + kstep, voffA); PG8_STAGE(PG8_SB(1, 1), cB + hstep + kstep, voffB);
    PG8_WAIT_V(6); PG8_BAR;
    PG8_STAMP();
    for (;;) {
        const bool has_next = S.next(ui + 1, nxt);
        const char* nA = has_next ? (const char*)g.A + (size_t)nxt.pm * tstep : cA; const char* nB = has_next ? (const char*)g.Bt + (size_t)nxt.pn * tstep : cB;
        for (int t = 0; t < nt; t += 2) {
            const bool last = (t == nt - 2);
            const char* a1 = cA + (size_t)(t + 1) * kstep;
            const char* a2 = last ? nA : cA + (size_t)(t + 2) * kstep; const char* b2 = last ? nB : cB + (size_t)(t + 2) * kstep;
            const char* a3 = a2 + kstep; const char* b3 = b2 + kstep;
            if (last && has_next) S.a_ready(nxt);
            PG8_LDB(B0, 0, 0); PG8_SCHED; PG8_LDA(At, 0, 0); PG8_STAGE(PG8_SA(1, 1), a1 + hstep, voffA);
            PG8_WAIT_L(8); PG8_BAR; PG8_WAIT_L(0); PG8_MMA(0, 0, At, B0); PG8_BAR; PG8_SCHED;
            PG8_LDB(B1, 0, 1); PG8_STAGE(PG8_SB(0, 0), b2, voffB);
            PG8_BAR; PG8_WAIT_L(0); PG8_MMA(0, 1, At, B1); PG8_BAR;
            PG8_LDA(At, 0, 1); PG8_STAGE(PG8_SA(0, 0), a2, voffA);
            PG8_BAR; PG8_WAIT_L(0); PG8_MMA(1, 0, At, B0); PG8_BAR; PG8_SCHED;
            PG8_STAGE(PG8_SB(0, 1), b2 + hstep, voffB);
            PG8_WAIT_V(6); PG8_BAR; PG8_MMA(1, 1, At, B1); PG8_BAR;
            PG8_LDB(B0, 1, 0); PG8_SCHED; PG8_LDA(At, 1, 0); PG8_STAGE(PG8_SA(0, 1), a2 + hstep, voffA);
            PG8_WAIT_L(8); PG8_BAR; PG8_WAIT_L(0); PG8_MMA(0, 0, At, B0); PG8_BAR; PG8_SCHED;
            PG8_LDB(B1, 1, 1); PG8_STAGE(PG8_SB(1, 0), b3, voffB);
            PG8_BAR; PG8_WAIT_L(0); PG8_MMA(0, 1, At, B1); PG8_BAR;
            PG8_LDA(At, 1, 1); PG8_STAGE(PG8_SA(1, 0), a3, voffA);
            PG8_BAR; PG8_WAIT_L(0); PG8_MMA(1, 0, At, B0); PG8_BAR; PG8_SCHED;
            PG8_STAGE(PG8_SB(1, 1), b3 + hstep, voffB);
            PG8_WAIT_V(6); PG8_BAR; PG8_MMA(1, 1, At, B1); PG8_BAR;
        }
        PG8_STAMP();
        if constexpr (!Epi::AFTER_DRAIN) { E(acc, cur, wr, wc, fr, fq); S.done(cur); }
        PG8_STAMP();
        if (!has_next) break;
#pragma unroll
        for (int a = 0; a < 2; ++a)
#pragma unroll
            for (int b = 0; b < 2; ++b)
#pragma unroll
                for (int m = 0; m < 4; ++m)
#pragma unroll
                    for (int n = 0; n < 2; ++n) acc[a][b][m][n] = (f32x4){0.f, 0.f, 0.f, 0.f};
        cur = nxt; cA = nA; cB = nB; ++ui;
    }
    PG8_WAIT_V(0);
    if (wr == 0) PG8_BAR;
    PG8_BAR;
    if constexpr (Epi::AFTER_DRAIN) { E.fused(acc, cur, wr, wc, fr, fq, lds, wid, lane); S.done(cur); }
    PG8_STAMP();
    if (STAMP && wid == 0) { stamps[lane] = lane < nts ? (((unsigned long long)(unsigned)ts_hi << 32) | (unsigned)ts_lo) : 0ull;
        if (lane == 62) stamps[62] = rt_entry; if (lane == 63) stamps[63] = 0ull; }
#undef PG8_STAMP
#undef PG8_SA
#undef PG8_SB
#undef PG8_STAGE
#undef PG8_LDA
#undef PG8_LDB
#undef PG8_MMA
#undef PG8_WAIT_V
#undef PG8_WAIT_L
#undef PG8_BAR
#undef PG8_SCHED
}
}

template <class F> struct EpiFn {
  static constexpr bool PERM = false, AFTER_DRAIN = false;
  F f;
  __device__ __forceinline__ void operator()(const pg8::f32x4 (&acc)[2][2][4][2], const pg8::Unit& u, int wr, int wc, int fr, int fq) const {
#pragma unroll
    for (int ai = 0; ai < 2; ++ai)
#pragma unroll
      for (int m = 0; m < 4; ++m) {
        const int row = u.pm * 256 + ai * 128 + wr * 64 + m * 16 + fr;
#pragma unroll
        for (int bj = 0; bj < 2; ++bj)
#pragma unroll
          for (int n = 0; n < 2; ++n) f(row, u.pn * 256 + bj * 128 + wc * 32 + n * 16 + 4 * fq, acc[ai][bj][m][n]);
      }
  }
};
template <int NN> struct RowMajorOrder {
  int nwg, G, c;
  __device__ __forceinline__ bool next(int i, pg8::Unit& u) const { const int L = i * G + c; if (L >= nwg) return false; u.pm = L / NN; u.pn = L - u.pm * NN; return true; }
  __device__ __forceinline__ void a_ready(const pg8::Unit&) const {}
  __device__ __forceinline__ void done(const pg8::Unit&) const {}
};
template <class F> struct EpiFn8 {
  static constexpr bool PERM = true, AFTER_DRAIN = false;
  F f;
  __device__ __forceinline__ void operator()(const pg8::f32x4 (&acc)[2][2][4][2], const pg8::Unit& u, int wr, int wc, int fr_, int fq_) const {
    const int fr = launder_v(fr_), fq = launder_v(fq_);
#pragma unroll
    for (int ai = 0; ai < 2; ++ai)
#pragma unroll
      for (int m = 0; m < 4; ++m) {
        const int row = u.pm * 256 + ai * 128 + wr * 64 + m * 16 + fr;
#pragma unroll
        for (int bj = 0; bj < 2; ++bj) f(row, u.pn * 256 + bj * 128 + wc * 32 + 8 * fq, acc[ai][bj][m][0], acc[ai][bj][m][1]);
      }
  }
};
template <int N, class F>
__device__ __forceinline__ void gemm256p(const bf16_t* A, const bf16_t* Bt, int M, int K, F f, char* smem) {
  pg8::Gemm g; g.A = A; g.Bt = Bt; g.M = M; g.N = N; g.K = K;
  RowMajorOrder<N / 256> S; S.nwg = (M / 256) * (N / 256); S.G = (int)gridDim.x; S.c = BIDX;
  EpiFn8<F> E{f};
  __syncthreads();
  pg8::gemm_phase<EpiFn8<F>, RowMajorOrder<N / 256>, false>((PG8_LAS unsigned char*)smem, g, S, E, nullptr);
  __syncthreads();
}
template <int N, class F>
__device__ __forceinline__ void gemm256(const bf16_t* A, const bf16_t* Bt, int M, int K, F f, char* smem) {
  pg8::Gemm g; g.A = A; g.Bt = Bt; g.M = M; g.N = N; g.K = K;
  RowMajorOrder<N / 256> S; S.nwg = (M / 256) * (N / 256); S.G = (int)gridDim.x; S.c = BIDX;
  EpiFn<F> E{f};
  __syncthreads();
  pg8::gemm_phase<EpiFn<F>, RowMajorOrder<N / 256>, false>((PG8_LAS unsigned char*)smem, g, S, E, nullptr);
  __syncthreads();
}

#define XB_TMO      128
#define XB_XCNT(j)  (256  + 64 * (j))
#define XB_XSUB(j)  (1280 + 64 * (j))
#define XB_XGEN(j)  (2304 + 64 * (j))
#define XB_TOP      3328
#define XB_TOPGEN   3392
#define XCD_BAR_WORDS 3456
#define XB_SPIN_CAP (1u << 22)
#define LAS __attribute__((address_space(3)))
__device__ __forceinline__ unsigned xb_ld(unsigned* p)              { return __hip_atomic_load(p, __ATOMIC_RELAXED, __HIP_MEMORY_SCOPE_AGENT); }
__device__ __forceinline__ unsigned xb_add(unsigned* p, unsigned v) { return __hip_atomic_fetch_add(p, v, __ATOMIC_RELAXED, __HIP_MEMORY_SCOPE_AGENT); }
__device__ __forceinline__ unsigned xb_xcc_id() { return (unsigned)__builtin_amdgcn_s_getreg((3 << 11) | 20) & 0xFu; }
#define XB_SPIN(cond, bar) do { unsigned _sp = 0; while (cond) { __builtin_amdgcn_s_sleep(1); \
    if ((++_sp & 255u) == 0u) { if (xb_ld(&(bar)[XB_TMO])) break; if (_sp > XB_SPIN_CAP) { atomicAdd(&(bar)[XB_TMO], 1u); break; } } } } while (0)
struct XcdBarrier { unsigned* bar; unsigned x; volatile LAS unsigned* st; };
__device__ __forceinline__ XcdBarrier xcd_barrier_post(unsigned* bar, volatile LAS unsigned* st) {
  XcdBarrier b; b.bar = bar; b.x = xb_xcc_id(); b.st = st;
  if (threadIdx.x == 0) (void)xb_add(&bar[XB_XCNT(b.x)], 1u);
  return b;
}
__device__ __forceinline__ void xcd_barrier_complete(unsigned* bar, unsigned x, unsigned& nloc, unsigned& nx) {
  const unsigned G = gridDim.x * gridDim.y * gridDim.z;
  unsigned sum, cnt, mine, sp = 0u;
  for (;;) {
    sum = 0u; cnt = 0u; mine = 0u;
#pragma unroll
    for (unsigned j = 0; j < 16; ++j) { const unsigned c = xb_ld(&bar[XB_XCNT(j)]); sum += c; cnt += (c > 0u) ? 1u : 0u; mine = (j == x) ? c : mine; }
    if (sum == G) break;
    __builtin_amdgcn_s_sleep(1);
    if ((++sp & 255u) == 0u) { if (xb_ld(&bar[XB_TMO])) break; if (sp > XB_SPIN_CAP) { atomicAdd(&bar[XB_TMO], 1u); break; } }
  }
  nloc = mine > 0u ? mine : 1u; nx = cnt > 0u ? cnt : 1u;
}
__device__ __forceinline__ void xcd_barrier(const XcdBarrier& b) {
  asm volatile("s_waitcnt vmcnt(0)" ::: "memory");
  __syncthreads();
  if (threadIdx.x == 0) {
    unsigned* bar = b.bar;
    __builtin_amdgcn_s_waitcnt(0);
    unsigned nloc = b.st[0], nx = b.st[1];
    if (nloc == 0u) { xcd_barrier_complete(bar, b.x, nloc, nx); b.st[0] = nloc; b.st[1] = nx; }
    const unsigned old = xb_add(&bar[XB_XSUB(b.x)], 1u);
    const unsigned gen = old / nloc;
    if (old + 1u == (gen + 1u) * nloc) {
      __builtin_amdgcn_fence(__ATOMIC_RELEASE, "agent");
      asm volatile("s_waitcnt vmcnt(0)" ::: "memory");
      const unsigned og = xb_add(&bar[XB_TOP], 1u);
      const unsigned tg = og / nx;
      if (og + 1u == (tg + 1u) * nx) xb_add(&bar[XB_TOPGEN], 1u);
      else XB_SPIN(xb_ld(&bar[XB_TOPGEN]) == tg, bar);
      __builtin_amdgcn_fence(__ATOMIC_ACQUIRE, "agent");
      xb_add(&bar[XB_XGEN(b.x)], 1u);
      asm volatile("s_waitcnt vmcnt(0)" ::: "memory");
    } else {
      XB_SPIN(xb_ld(&bar[XB_XGEN(b.x)]) == gen, bar);
      __builtin_amdgcn_fence(__ATOMIC_ACQUIRE, "agent");
      asm volatile("s_waitcnt vmcnt(0)" ::: "memory");
    }
  }
  __syncthreads();
}

constexpr int NSTAGES = 23;
constexpr int SMEM_BYTES = 135168;
template <int S>
__device__ __forceinline__ void run_stage_t(const Params& p0, int layer0, char* smem0) {
  Params p = p0; int layer = layer0; char* smem = smem0;
  { unsigned long long w = (unsigned long long)p0.ws, o = (unsigned long long)p0.out;
    asm volatile("" : "+s"(w), "+s"(o), "+s"(layer));
    p.ws = (char*)(__attribute__((address_space(1))) char*)w; p.out = (float*)(__attribute__((address_space(1))) float*)o; }
  const int nrows = (layer == 0) ? NTOK : NLAT;
  if constexpr (S == 100) stage_prep(p, smem);
  if constexpr (S == 101) stage_prep2(p, smem);
  if constexpr (S == 102) final_norm(p);
  if constexpr (S == 0) stage_norm(p, layer, 0, NTOK);
  if constexpr (S == 1) {
    bf16_t* u = (bf16_t*)(p.ws + OFF_U);
    gemm256p<DINP>((const bf16_t*)(p.ws + OFF_HB), (const bf16_t*)(p.ws + OFF_WIN) + (size_t)layer * DINP * 1024, NTOK, 1024,
            [=](int row, int col0, f32x4 v, f32x4 w) { if (col0 < DIN) { const u32x4 o = {cvtpk(v[0], v[1]), cvtpk(v[2], v[3]), cvtpk(w[0], w[1]), cvtpk(w[2], w[3])}; *(u32x4*)(u + (size_t)row * DIN + col0) = o; } }, smem);
    {
      const int nunits = (NTOK / 256) * (DINP / 256), G = (int)gridDim.x, rem = nunits % G, c = BIDX;
      if (rem == 0) peer_cvt_tables(p, layer, c, G); else if (c >= rem) peer_cvt_tables(p, layer, c - rem, G - rem);
    }
  }
  if constexpr (S == 2) { lru_units(p, layer, 0, smem); mla_prep(p, layer); hyena_prep(p, layer, smem);
#if defined(PROBE_S2)
    __syncthreads();
    if (PROBE_S2 == 0) lru_units(p, layer, 0, smem); else if (PROBE_S2 == 1) mla_prep(p, layer); else hyena_prep(p, layer, smem);
#endif
  }
  if constexpr (S == 3) {
    bf16_t* Q = (bf16_t*)(p.ws + OFF_Q); bf16_t* K = (bf16_t*)(p.ws + OFF_K);
    gemm256p<768>((const bf16_t*)(p.ws + OFF_QN), (const bf16_t*)(p.ws + OFF_WQB) + (size_t)layer * 768 * 384, NTOK, 384,
            [=](int row, int col0, f32x4 v, f32x4 w) {
              if (col0 < 576) {
                const int j = col0 % 96;
                if (j >= 64 && row < NLAT) {
                  const int t = row & (SEQ - 1), i0 = (j & 8) >> 1;
                  const float pos = (j & 16) ? (float)(t & 63) : (float)(t >> 6);
#pragma unroll
                  for (int q = 0; q < 4; ++q) {
                    constexpr float R1 = 0.31622776601683794f;
                    const float invq = (q == 0 ? 1.f : q == 1 ? R1 : q == 2 ? R1 * R1 : R1 * R1 * R1) * 0.15915494309189535f;
                    const float rev = pos * (i0 ? invq * 0.01f : invq);
                    const float cs = __builtin_amdgcn_cosf(rev), sn = __builtin_amdgcn_sinf(rev);
                    if (q < 2) { const float lo = v[2 * q], hh = v[2 * q + 1]; v[2 * q] = lo * cs - hh * sn; v[2 * q + 1] = hh * cs + lo * sn; }
                    else { const float lo = w[2 * q - 4], hh = w[2 * q - 3]; w[2 * q - 4] = lo * cs - hh * sn; w[2 * q - 3] = hh * cs + lo * sn; }
                  }
                }
                const u32x4 o = {cvtpk(v[0], v[1]), cvtpk(v[2], v[3]), cvtpk(w[0], w[1]), cvtpk(w[2], w[3])};
                *(u32x4*)(Q + (size_t)row * 576 + col0) = o;
              }
            }, smem);
    gemm256p<768>((const bf16_t*)(p.ws + OFF_KVN), (const bf16_t*)(p.ws + OFF_WKVB) + (size_t)layer * 768 * 256, NTOK, 256,
            [=](int row, int col0, f32x4 v, f32x4 w) { const u32x4 o = {cvtpk(v[0], v[1]), cvtpk(v[2], v[3]), cvtpk(w[0], w[1]), cvtpk(w[2], w[3])}; *(u32x4*)(K + (size_t)row * 768 + col0) = o; }, smem);
    lru_carry(p, smem);
  }
  if constexpr (S == 4) { attn_units(p, layer, smem); hyena_fft(p, layer, smem); }
  if constexpr (S == 12) { attn_combine(p); hyena_out_transpose(p, smem); hyena_direct(p, layer, smem); lru_final(p, layer, smem); }
  if constexpr (S == 5) {
    float* xs = (float*)(p.ws + OFF_XS); const float* mod = (const float*)(p.ws + OFF_MOD) + (size_t)layer * 3 * 6144;
    const float* xin = p.in[I_X]; const float* cin = p.in[I_CTX];
    const bf16_t* wo = (const bf16_t*)(p.ws + OFF_WOUT) + (size_t)layer * 1024 * 1024;
    gemm256<1024>((const bf16_t*)(p.ws + OFF_MIX), wo, NLAT, 1024,
            [=](int row, int col0, f32x4 v) {
              const float* g1 = mod + (size_t)(row >> 13) * 6144 + 2048 + col0;
              const float* src = (layer == 0) ? xin + (size_t)row * DM + col0 : xs + (size_t)row * DM + col0;
              const f32x4 s4 = *(const f32x4*)src, g4 = *(const f32x4*)g1;
              *(f32x4*)(xs + (size_t)row * DM + col0) = s4 + g4 * v;
            }, smem);
    if (layer == 0)
      gemm_bt((const bf16_t*)(p.ws + OFF_MIX) + (size_t)NLAT * DM, DM, wo, 1024, NCTX, 1024, 1024,
              [=](int row, int col, float v) {
                const float g1 = mod[(size_t)2 * 6144 + 2048 + col];
                xs[(size_t)(NLAT + row) * DM + col] = cin[(size_t)row * DM + col] + g1 * v;
              }, smem);
  }
  if constexpr (S == 6) { stage_norm(p, layer, 1, nrows); }
  if constexpr (S == 7) {
    bf16_t* pq = (bf16_t*)(p.ws + OFF_PQ);
    const bf16_t* wq = (const bf16_t*)(p.ws + OFF_WPQ) + (size_t)layer * 2048 * 1024;
    gemm256p<2048>((const bf16_t*)(p.ws + OFF_HB), wq, NLAT, 1024,
            [=](int row, int col0, f32x4 v, f32x4 w) { const u32x4 o = {cvtpk(v[0], v[1]), cvtpk(v[2], v[3]), cvtpk(w[0], w[1]), cvtpk(w[2], w[3])}; *(u32x4*)(pq + (size_t)row * 2048 + col0) = o; }, smem);
    if (layer == 0)
      gemm_bt((const bf16_t*)(p.ws + OFF_HB) + (size_t)NLAT * DM, DM, wq, 1024, NCTX, 2048, 1024,
              [=](int row, int col, float v) { pq[(size_t)(NLAT + row) * 2048 + col] = f2bf(v); }, smem);
  }
  if constexpr (S == 8) peer_topk(p, layer, nrows, smem);
  if constexpr (S == 9) peer_eval_fused(p, layer, nrows, smem);
}

__device__ __forceinline__ void init_params(Params& p, const KArgs& ka, char* smem) {
  unsigned long long* tab = (unsigned long long*)(smem + SMEM_BYTES);
  if (threadIdx.x == 0) {
#pragma unroll
    for (int i = 0; i < N_IN; ++i) tab[i] = (unsigned long long)ka.in[i];
  }
  __syncthreads();
  p.in.tab = smem + SMEM_BYTES; p.out = ka.out; p.ws = ka.ws;
}

#if MK_SINGLE
#define SYNC() xcd_barrier(xb)
__global__ void __launch_bounds__(NTHREADS) mega_kernel(KArgs ka) {
  __shared__ __attribute__((aligned(16))) char smem[SMEM_BYTES + 512];
  cg::grid_group grid = cg::this_grid();
  if (threadIdx.x == 0) *(uint4*)(smem + SMEM_BYTES + 320) = make_uint4(0u, 0u, 0u, 0u);
  Params p; init_params(p, ka, smem);
  const XcdBarrier xb = xcd_barrier_post((unsigned*)(ka.ws + OFF_BAR), (volatile LAS unsigned*)(smem + SMEM_BYTES + 320));
  run_stage_t<100>(p, 0, smem); grid.sync();
#if defined(PROBE_PREP) && PROBE_PREP == 100
  run_stage_t<100>(p, 0, smem); SYNC();
#endif
  run_stage_t<101>(p, 0, smem); SYNC();
#if defined(PROBE_BW)
  {
    const u32x4* base = (const u32x4*)(ka.ws + (size_t)64 * 1024 * 1024);
    const size_t n16 = (size_t)PROBE_BW * 64 * 1024 * 1024 / 16;
    unsigned acc_ = 0;
    for (size_t i = (size_t)blockIdx.x * NTHREADS + threadIdx.x; i + 7 * (size_t)gridDim.x * NTHREADS < n16; i += 8 * (size_t)gridDim.x * NTHREADS) {
      u32x4 t_[8];
#pragma unroll
      for (int k = 0; k < 8; ++k) t_[k] = base[i + k * (size_t)gridDim.x * NTHREADS];
#pragma unroll
      for (int k = 0; k < 8; ++k) acc_ ^= t_[k][0] ^ t_[k][1] ^ t_[k][2] ^ t_[k][3];
    }
    if (acc_ == 0x12345u) ((unsigned*)(ka.ws + OFF_BAR))[1000] = acc_;
    SYNC();
  }
#endif
#if defined(PROBE_BAR)
  SYNC(); SYNC(); SYNC(); SYNC(); SYNC(); SYNC(); SYNC(); SYNC(); SYNC(); SYNC(); SYNC(); SYNC(); SYNC(); SYNC(); SYNC(); SYNC(); SYNC(); SYNC(); SYNC(); SYNC();
#endif
#if defined(PROBE_PREP) && PROBE_PREP == 101
  run_stage_t<101>(p, 0, smem); SYNC();
#endif
#ifndef PROBE_DUP
#define PROBE_DUP -1
#endif
#define RUNSTAGE(S, layer) do { if (PROBE_DUP == S) { int nrep = 2; asm volatile("" : "+s"(nrep)); \
      for (int rep = 0; rep < nrep; ++rep) { run_stage_t<S>(p, layer, smem); SYNC(); if (S == 9 || S == 11) break; } } \
    else { run_stage_t<S>(p, layer, smem); SYNC(); } } while (0)
#if defined(PROBE_ATT)
#define PROBE_ATT_HOOK(layer) { attn_units<PROBE_ATT, true>(p, layer, smem); SYNC(); }
#else
#define PROBE_ATT_HOOK(layer)
#endif
#define LAYER_PASS(layer) \
    if (layer == 0) { RUNSTAGE(0, layer); } RUNSTAGE(1, layer); RUNSTAGE(2, layer); RUNSTAGE(3, layer); RUNSTAGE(4, layer); PROBE_ATT_HOOK(layer) RUNSTAGE(12, layer); \
    RUNSTAGE(5, layer); RUNSTAGE(6, layer); RUNSTAGE(7, layer); RUNSTAGE(8, layer); RUNSTAGE(9, layer);
  LAYER_PASS(0)
  LAYER_PASS(1)
}
#else
template <int S>
__global__ void __launch_bounds__(NTHREADS) stage_kernel(KArgs ka, int layer) {
  __shared__ __attribute__((aligned(16))) char smem[SMEM_BYTES + 512];
  Params p; init_params(p, ka, smem);
  run_stage_t<S>(p, layer, smem);
}
#endif

extern "C" void kernel_launch(void* const* d_in, const int* in_sizes, int n_in, void* d_out, int out_size, void* d_ws, size_t ws_size, hipStream_t stream) {
  if (n_in != N_IN || ws_size < WS_END) { fprintf(stderr, "kernel_launch: bad args n_in=%d ws=%zu need=%zu\n", n_in, ws_size, (size_t)WS_END); return; }
  KArgs p{};
  for (int i = 0; i < N_IN; ++i) p.in[i] = (const float*)d_in[i];
  p.out = (float*)d_out; p.ws = (char*)d_ws;
#if MK_SINGLE
  static int grid_blocks = 0;
  if (!grid_blocks) {
    int dev = 0, cus = 0, per_cu = 0;
    hipGetDevice(&dev);
    hipDeviceGetAttribute(&cus, hipDeviceAttributeMultiprocessorCount, dev);
    hipOccupancyMaxActiveBlocksPerMultiprocessor(&per_cu, mega_kernel, NTHREADS, 0);
    if (per_cu > 1) per_cu = 1;
    grid_blocks = cus * per_cu;
  }
  hipMemsetAsync((char*)d_ws + OFF_BAR, 0, BAR_BYTES, stream);
  void* args[] = {&p};
  hipError_t e = hipLaunchCooperativeKernel((void*)mega_kernel, dim3(grid_blocks), dim3(NTHREADS), args, 0, stream);
  if (e != hipSuccess) fprintf(stderr, "cooperative launch failed: %s (grid %d)\n", hipGetErrorString(e), grid_blocks);
#else
#define LAUNCH(S, L) hipLaunchKernelGGL(stage_kernel<S>, dim3(256), dim3(NTHREADS), 0, stream, p, L)
  LAUNCH(100, 0); LAUNCH(101, 0);
  for (int layer = 0; layer < 2; ++layer) {
    LAUNCH(0, layer); LAUNCH(1, layer); LAUNCH(2, layer); LAUNCH(3, layer); LAUNCH(4, layer);
    LAUNCH(5, layer); LAUNCH(6, layer); LAUNCH(7, layer); LAUNCH(8, layer); LAUNCH(9, layer);
  }
  LAUNCH(102, 0);
#endif
}
```

```cpp
#include <hip/hip_runtime.h>
#include <hip/hip_cooperative_groups.h>
#include <cstdio>
#include <cstdint>
namespace cg = cooperative_groups;

__device__ __forceinline__ int launder_v(int x) { asm volatile("" : "+v"(x)); return x; }
__device__ __forceinline__ int launder_s(int x) { asm volatile("" : "+s"(x)); return x; }
#define TIDX launder_v((int)threadIdx.x)
#define BIDX launder_s((int)blockIdx.x)

__device__ __forceinline__ float shx(float v, int mask) { const int l = TIDX & 63; return __int_as_float(__builtin_amdgcn_ds_bpermute((l ^ mask) << 2, __float_as_int(v))); }
__device__ __forceinline__ int shxi(int v, int mask) { const int l = TIDX & 63; return __builtin_amdgcn_ds_bpermute((l ^ mask) << 2, v); }
__device__ __forceinline__ float rdl(float v, int srclane) { return __int_as_float(__builtin_amdgcn_readlane(__float_as_int(v), srclane)); }

#ifndef MK_SINGLE
#define MK_SINGLE 1
#endif

typedef unsigned short bf16_t;
using bf16x8 = __attribute__((ext_vector_type(8))) short;
using s16x4  = __attribute__((ext_vector_type(4))) short;
using f32x16 = __attribute__((ext_vector_type(16))) float;
using f32x4  = __attribute__((ext_vector_type(4))) float;
using u32x4  = __attribute__((ext_vector_type(4))) unsigned;
using u32x2  = __attribute__((ext_vector_type(2))) unsigned;

constexpr int NB = 2, SEQ = 8192, CTXL = 256, DM = 1024;
constexpr int NLAT = NB * SEQ, NCTX = NB * CTXL, NTOK = NLAT + NCTX;
constexpr int DIN = 2208, DINP = 2304;
constexpr int DLRU = 384, NKEYS = SEQ + CTXL;
constexpr int NTHREADS = 512;
constexpr int NCHUNK = NLAT / 64 + NCTX / 64;
constexpr float EPSV = 1e-6f;

enum { I_X = 0, I_C, I_CTX, I_CCTX, I_WMOD, I_BMOD, I_N1G, I_N2G, I_WIN, I_WOUT, I_LCW, I_LCB, I_LWR, I_LBR, I_LWI, I_LBI, I_LLAM,
       I_QNG, I_WQB, I_KVNG, I_WKVB, I_HCW, I_HCB, I_HW1, I_HB1, I_HW2, I_HB2, I_HW3, I_HFREQ, I_HDECAY, I_HSKIP,
       I_PWQ, I_PKEYS, I_PU, I_PV, I_FG, N_IN };

struct KArgs { const float* in[N_IN]; float* out; char* ws; };
struct InTab {
  const char* tab;
  __device__ __forceinline__ const float* operator[](int i) const {
    const unsigned long long v = ((const unsigned long long*)tab)[i];
    const unsigned lo = __builtin_amdgcn_readfirstlane((unsigned)v), hi = __builtin_amdgcn_readfirstlane((unsigned)(v >> 32));
    return (const float*)(const __attribute__((address_space(1))) float*)(((unsigned long long)hi << 32) | lo);
  }
};
struct Params { InTab in; float* out; char* ws; };

constexpr size_t al256(size_t x) { return (x + 255) / 256 * 256; }
constexpr size_t OFF_XS    = 0;
constexpr size_t OFF_HB    = OFF_XS    + al256((size_t)NTOK * DM * 4);
constexpr size_t OFF_U     = OFF_HB    + al256((size_t)NTOK * DM * 2);
constexpr size_t OFF_PQ    = OFF_U;
constexpr size_t OFF_LAB   = OFF_U     + al256((size_t)NTOK * DIN * 2);
static_assert(OFF_LAB + (size_t)(NTOK / 32) * 6 * 2 * 2 * 16 * 64 * 4 <= OFF_U + al256((size_t)NTOK * DIN * 4), "LRU coefficient buffer must fit behind the bf16 u");
constexpr size_t OFF_MIX   = OFF_U     + al256((size_t)NTOK * DIN * 4);
constexpr size_t OFF_HYIN  = OFF_MIX   + al256((size_t)NTOK * DM * 2);
constexpr size_t OFF_EID   = OFF_HYIN;
constexpr size_t OFF_GATE  = OFF_EID   + al256((size_t)NTOK * 128 * 4);
constexpr size_t OFF_HYINC = OFF_HYIN  + al256((size_t)3 * 2 * 256 * 8192 * 4);
constexpr size_t OFF_QN    = OFF_HYINC + al256((size_t)3 * 2 * 256 * 256 * 4);
constexpr size_t TAB_BYTES = (size_t)16384 * 1024;
constexpr size_t OFF_UTAB  = al256(OFF_LAB + (size_t)(NTOK / 32) * 6 * 2 * 2 * 16 * 64 * 4);
constexpr size_t OFF_OPART = OFF_QN;
constexpr size_t OFF_OML   = OFF_OPART + (size_t)4 * 2 * SEQ * 64 * 4;
constexpr size_t OFF_KVN   = OFF_QN    + al256((size_t)NTOK * 384 * 2);
constexpr size_t OFF_Q     = OFF_KVN   + al256((size_t)NTOK * 256 * 2);
constexpr size_t OFF_K     = OFF_Q     + al256((size_t)NTOK * 576 * 2);
constexpr size_t OFF_V     = OFF_K     + al256((size_t)NTOK * 768 * 2);
constexpr size_t OFF_LSUM  = OFF_V     + al256((size_t)NTOK * 32 * 2);
static_assert(OFF_OML + (size_t)4 * 2 * SEQ * 2 * 4 <= OFF_Q, "attention partials must fit in the dead QN/KVN region");
static_assert(OFF_UTAB + TAB_BYTES <= OFF_U + al256((size_t)NTOK * DIN * 4), "u table must fit in the tail of the u region");
constexpr size_t OFF_CARRY = OFF_LSUM  + al256((size_t)(NTOK / 32) * 2 * 2 * 384 * 4);
constexpr size_t OFF_MOD   = OFF_CARRY + al256((size_t)(NTOK / 32) * 2 * 384 * 4);
constexpr size_t OFF_MODP  = OFF_MIX;
constexpr size_t OFF_WIN   = OFF_MOD   + al256((size_t)2 * 3 * 6144 * 4);
constexpr size_t OFF_WOUT  = OFF_WIN   + al256((size_t)2 * DINP * 1024 * 2);
constexpr size_t OFF_WQB   = OFF_WOUT  + al256((size_t)2 * 1024 * 1024 * 2);
constexpr size_t OFF_WKVB  = OFF_WQB   + al256((size_t)2 * 768 * 384 * 2);
constexpr size_t OFF_WPQ   = OFF_WKVB  + al256((size_t)2 * 768 * 256 * 2);
constexpr size_t OFF_KEYS  = OFF_WPQ   + al256((size_t)2 * 2048 * 1024 * 2);
constexpr size_t OFF_GW    = OFF_KEYS  + al256((size_t)2 * 2 * 128 * 128 * 2);
constexpr size_t OFF_H2    = OFF_GW    + al256((size_t)2 * 2 * 2 * 6 * 64 * 64 * 2);
constexpr size_t OFF_HSPEC = OFF_H2    + al256((size_t)2 * NKEYS * 64 * 4);
constexpr size_t OFF_FILTC = OFF_HSPEC + al256((size_t)2 * 256 * 2 * 16384 * 4);
constexpr size_t OFF_SSQPC = OFF_FILTC + al256((size_t)2 * 1024 * 256 * 4);
constexpr size_t OFF_BAR   = OFF_SSQPC + al256((size_t)2 * 4 * 1024 * 4);
constexpr size_t OFF_CTR   = OFF_BAR   + al256(3456 * 4);
constexpr size_t BAR_BYTES = al256(3456 * 4) + 2 * 2 * 2 * 16 * 256;
constexpr size_t OFF_VTAB  = OFF_BAR   + al256(BAR_BYTES);
constexpr size_t WS_END    = OFF_VTAB  + al256(TAB_BYTES);
static_assert(WS_END <= (size_t)4 * 2 * 16384 * 1024 * 4, "workspace layout exceeds the guaranteed 4 x largest-tensor size");
constexpr size_t OFF_SP    = OFF_U;
constexpr size_t OFF_WBUF  = OFF_SP    + (size_t)16 * NTOK * 128 * 4;
static_assert(OFF_WBUF + (size_t)NTOK * 128 * 4 <= OFF_MIX, "PEER partials must fit in the u region");

__device__ __forceinline__ float bf2f(bf16_t v) { return __uint_as_float(((unsigned)v) << 16); }
__device__ __forceinline__ bf16_t f2bf(float f) { unsigned u = __float_as_uint(f); u += 0x7fffu + ((u >> 16) & 1u); return (bf16_t)(u >> 16); }
__device__ __forceinline__ unsigned cvtpk(float lo, float hi) { unsigned r; asm volatile("v_cvt_pk_bf16_f32 %0, %1, %2" : "=v"(r) : "v"(lo), "v"(hi)); return r; }
__device__ __forceinline__ float gelu_tanh(float x) { const float z2 = 1.5957691216057308f * (x + 0.044715f * x * x * x); return x * __builtin_amdgcn_rcpf(1.f + __expf(-z2)); }
__device__ __forceinline__ float sigm(float x) { return 1.f / (1.f + __expf(-x)); }
template <int CTRL> __device__ __forceinline__ float dpp_mov(float x) { return __builtin_bit_cast(float, __builtin_amdgcn_mov_dpp(__builtin_bit_cast(int, x), CTRL, 0xf, 0xf, true)); }
__device__ __forceinline__ float wave_sum(float v) {
  v += dpp_mov<0xB1>(v); v += dpp_mov<0x4E>(v); v += dpp_mov<0x141>(v); v += dpp_mov<0x128>(v);
  { auto r = __builtin_amdgcn_permlane16_swap(__float_as_uint(v), __float_as_uint(v), false, false); v = __uint_as_float(r[0]) + __uint_as_float(r[1]); }
  { auto r = __builtin_amdgcn_permlane32_swap(__float_as_uint(v), __float_as_uint(v), false, false); v = __uint_as_float(r[0]) + __uint_as_float(r[1]); }
  return v;
}
using bf16x2v = __attribute__((ext_vector_type(2))) __bf16;
__device__ __forceinline__ float dot2bf(unsigned a, unsigned b, float acc) { return __builtin_amdgcn_fdot2_f32_bf16(__builtin_bit_cast(bf16x2v, a), __builtin_bit_cast(bf16x2v, b), acc, false); }
__device__ __forceinline__ int crow(int r, int hi) { return (r & 3) + 8 * (r >> 2) + 4 * hi; }
__device__ __forceinline__ void row_info(int r, int& b, int& t, int& isctx) {
  if (r < NLAT) { isctx = 0; b = r >> 13; t = r & (SEQ - 1); } else { isctx = 1; int q = r - NLAT; b = q >> 8; t = q & (CTXL - 1); }
}
__device__ __forceinline__ const float* xrow_src(const Params& p, int layer, int r) {
  if (layer == 0) return (r < NLAT) ? p.in[I_X] + (size_t)r * DM : p.in[I_CTX] + (size_t)(r - NLAT) * DM;
  return (const float*)(p.ws + OFF_XS) + (size_t)r * DM;
}
__device__ __forceinline__ size_t h2idx(int l, int pos, int j) { return (((size_t)l * 16 + (j >> 2)) * NKEYS + pos) * 4 + (j & 3); }
#define JOB_LOOP(t, ntiles, base) for (int t = (int)(((long)BIDX - ((base) % (long)gridDim.x) + gridDim.x) % gridDim.x); t < (ntiles); t += gridDim.x)

__device__ __forceinline__ int rope_slot(int c) { return (c & 16) | ((c & 7) << 1) | ((c >> 3) & 1); }
__device__ void transpose_cvt_job(const float* __restrict__ src, bf16_t* __restrict__ dst, int K, int N, int Npad, char* smem, long& base, int rp = 0) {
  float* tile = (float*)smem;
  const int tk = K / 64, tn = Npad / 64, nt = tk * tn;
  JOB_LOOP(t, nt, base) {
    const int k0 = (t % tk) * 64, n0 = (t / tk) * 64;
    __syncthreads();
    for (int e = TIDX; e < 1024; e += NTHREADS) {
      const int i = e >> 4, j = (e & 15) * 4, n = n0 + j;
      f32x4 v = {0.f, 0.f, 0.f, 0.f};
      if (n < N) v = *(const f32x4*)(src + (size_t)(k0 + i) * N + n);
      tile[j * 65 + i] = v[0]; tile[(j + 1) * 65 + i] = v[1]; tile[(j + 2) * 65 + i] = v[2]; tile[(j + 3) * 65 + i] = v[3];
    }
    __syncthreads();
    {
      const int e = TIDX, j = e >> 3, i8 = (e & 7) * 8;
      const float* tr = tile + j * 65 + i8;
      const u32x4 o = {cvtpk(tr[0], tr[1]), cvtpk(tr[2], tr[3]), cvtpk(tr[4], tr[5]), cvtpk(tr[6], tr[7])};
      int n = n0 + j;
      if (rp && n < N) { const int hh = n / 96, jj = n - hh * 96; if (jj >= 64) n = hh * 96 + 64 + rope_slot(jj - 64); }
      *(u32x4*)(dst + (size_t)n * K + k0 + i8) = o;
    }
  }
  base += nt;
}

__device__ void stage_prep(const Params& p, char* smem) {
  long base = 0;
  for (int l = 0; l < 2; ++l) {
    transpose_cvt_job(p.in[I_WIN] + (size_t)l * 1024 * DIN, (bf16_t*)(p.ws + OFF_WIN) + (size_t)l * DINP * 1024, 1024, DIN, DINP, smem, base);
    transpose_cvt_job(p.in[I_WOUT] + (size_t)l * 1024 * 1024, (bf16_t*)(p.ws + OFF_WOUT) + (size_t)l * 1024 * 1024, 1024, 1024, 1024, smem, base);
    transpose_cvt_job(p.in[I_WQB] + (size_t)l * 384 * 576, (bf16_t*)(p.ws + OFF_WQB) + (size_t)l * 768 * 384, 384, 576, 768, smem, base, 1);
    transpose_cvt_job(p.in[I_WKVB] + (size_t)l * 256 * 768, (bf16_t*)(p.ws + OFF_WKVB) + (size_t)l * 768 * 256, 256, 768, 768, smem, base);
    transpose_cvt_job(p.in[I_PWQ] + (size_t)l * 1024 * 2048, (bf16_t*)(p.ws + OFF_WPQ) + (size_t)l * 2048 * 1024, 1024, 2048, 2048, smem, base);
    for (int d = 0; d < 2; ++d) for (int n = 0; n < 6; ++n) {
      const size_t so = ((size_t)(l * 2 + d) * 6 + n) * 4096;
      transpose_cvt_job(p.in[I_LWR] + so, (bf16_t*)(p.ws + OFF_GW) + ((size_t)((l * 2 + d) * 2 + 0) * 6 + n) * 4096, 64, 64, 64, smem, base);
      transpose_cvt_job(p.in[I_LWI] + so, (bf16_t*)(p.ws + OFF_GW) + ((size_t)((l * 2 + d) * 2 + 1) * 6 + n) * 4096, 64, 64, 64, smem, base);
    }
  }
  {
    const float* src = p.in[I_PKEYS]; bf16_t* dst = (bf16_t*)(p.ws + OFF_KEYS);
    for (int e = BIDX * NTHREADS + TIDX; e < 2 * 2 * 128 * 128; e += gridDim.x * NTHREADS) dst[e] = f2bf(src[e]);
  }
  {
    float* modp = (float*)(p.ws + OFF_MODP);
    const float* cp = p.in[I_C]; const float* ccp = p.in[I_CCTX]; const float* wmod = p.in[I_WMOD];
    JOB_LOOP(it, 768, base) {
      const int l = it / 384, ks = (it % 384) / 12, cgp = it % 12;
      const int col = cgp * 512 + TIDX;
      const float* w = wmod + (size_t)l * 1024 * 6144 + (size_t)(ks * 32) * 6144 + col;
      float a0 = 0.f, a1 = 0.f, a2 = 0.f;
#pragma unroll
      for (int k0 = 0; k0 < 32; k0 += 8) {
        float wv[8];
#pragma unroll
        for (int j = 0; j < 8; ++j) wv[j] = w[(size_t)(k0 + j) * 6144];
#pragma unroll
        for (int j = 0; j < 8; ++j) {
          const int k = ks * 32 + k0 + j;
          const float c0 = cp[k], c1 = cp[1024 + k], c2 = ccp[k];
          a0 += c0 * sigm(c0) * wv[j]; a1 += c1 * sigm(c1) * wv[j]; a2 += c2 * sigm(c2) * wv[j];
        }
      }
      float* o = modp + ((size_t)(l * 32 + ks) * 3) * 6144 + col;
      o[0] = a0; o[6144] = a1; o[2 * 6144] = a2;
    }
    base += 768;
  }
  {
    const int lane = TIDX & 63, wid = TIDX >> 6;
    const float* hw1 = p.in[I_HW1]; const float* hb1 = p.in[I_HB1]; const float* hw2 = p.in[I_HW2]; const float* hb2 = p.in[I_HB2]; const float* hfr = p.in[I_HFREQ];
    constexpr float INV2PI = 0.15915494309189535f;
    for (int it = BIDX * 8 + wid; it < 2 * NKEYS / 4; it += gridDim.x * 8) {
      const int l = it / (NKEYS / 4), pos0 = (it % (NKEYS / 4)) * 4;
      const float* w1 = hw1 + (size_t)l * 17 * 64; const float* w2 = hw2 + (size_t)l * 64 * 64;
      const float fr = hfr[l * 64 + lane], b1v = hb1[l * 64 + lane], b2v = hb2[l * 64 + lane];
      float w1v[17];
#pragma unroll
      for (int i = 0; i < 17; ++i) w1v[i] = w1[i * 64 + lane];
      float h1[4], pre2[4];
#pragma unroll
      for (int j = 0; j < 4; ++j) {
        const int pos = pos0 + j;
        const float tn = (pos < SEQ) ? (float)pos / (float)SEQ : (float)(pos - SEQ) / (float)CTXL;
        float pre = b1v + tn * w1v[0];
#pragma unroll
        for (int i = 0; i < 8; ++i) {
          const float band = 1e-4f + (float)i * ((7.f - 1e-4f) / 7.f);
          const float rev = tn * band;
          pre += __builtin_amdgcn_cosf(rev) * w1v[1 + i] + __builtin_amdgcn_sinf(rev) * w1v[9 + i];
        }
        h1[j] = __builtin_amdgcn_sinf(fr * pre * INV2PI);
        pre2[j] = b2v;
      }
      for (int i = 0; i < 64; ++i) {
        const float wv = w2[i * 64 + lane];
#pragma unroll
        for (int j = 0; j < 4; ++j) pre2[j] += rdl(h1[j], i) * wv;
      }
#pragma unroll
      for (int j = 0; j < 4; ++j) ((float*)(p.ws + OFF_H2))[h2idx(l, pos0 + j, lane)] = __builtin_amdgcn_sinf(fr * pre2[j] * INV2PI);
    }
  }
}

struct cf { float x, y; };
__device__ __forceinline__ cf cmul(cf a, cf b) { return {a.x * b.x - a.y * b.y, a.x * b.y + a.y * b.x}; }
__device__ __forceinline__ cf opq(cf v) { asm("" : "+v"(v.x), "+v"(v.y)); return v; }
template <bool INV> __device__ __forceinline__ cf twid(float frac) {
  const float c = __builtin_amdgcn_cosf(frac), s = __builtin_amdgcn_sinf(frac); return {c, INV ? s : -s};
}
template <bool INV> __device__ __forceinline__ void r4(cf& a, cf& b, cf& c, cf& d) {
  const cf s0 = {a.x + c.x, a.y + c.y}, s1 = {a.x - c.x, a.y - c.y}, s2 = {b.x + d.x, b.y + d.y}, s3 = {b.x - d.x, b.y - d.y};
  a = {s0.x + s2.x, s0.y + s2.y}; c = {s0.x - s2.x, s0.y - s2.y};
  if (!INV) { b = {s1.x + s3.y, s1.y - s3.x}; d = {s1.x - s3.y, s1.y + s3.x}; }
  else      { b = {s1.x - s3.y, s1.y + s3.x}; d = {s1.x + s3.y, s1.y - s3.x}; }
}
template <bool INV> __device__ __forceinline__ cf cj(cf w) { return {w.x, INV ? -w.y : w.y}; }
template <bool INV> __device__ __forceinline__ void dft16(cf* x) {
#pragma unroll
  for (int m0 = 0; m0 < 4; ++m0) r4<INV>(x[m0], x[4 + m0], x[8 + m0], x[12 + m0]);
  const cf W1 = {0.92387953251128674f, -0.38268343236508977f}, W2 = {0.70710678118654752f, -0.70710678118654752f}, W3 = {0.38268343236508977f, -0.92387953251128674f};
  const cf W4 = {0.f, -1.f}, W6 = {-0.70710678118654752f, -0.70710678118654752f}, W9 = {-0.92387953251128674f, 0.38268343236508977f};
  x[5] = cmul(x[5], cj<INV>(W1)); x[6] = cmul(x[6], cj<INV>(W2)); x[7] = cmul(x[7], cj<INV>(W3));
  x[9] = cmul(x[9], cj<INV>(W2)); x[10] = cmul(x[10], cj<INV>(W4)); x[11] = cmul(x[11], cj<INV>(W6));
  x[13] = cmul(x[13], cj<INV>(W3)); x[14] = cmul(x[14], cj<INV>(W6)); x[15] = cmul(x[15], cj<INV>(W9));
#pragma unroll
  for (int q0 = 0; q0 < 4; ++q0) r4<INV>(x[4 * q0], x[4 * q0 + 1], x[4 * q0 + 2], x[4 * q0 + 3]);
}
template <bool INV> __device__ __forceinline__ void dft8(cf* x) {
#pragma unroll
  for (int m0 = 0; m0 < 4; ++m0) { const cf a = x[m0], b = x[4 + m0]; x[m0] = {a.x + b.x, a.y + b.y}; x[4 + m0] = {a.x - b.x, a.y - b.y}; }
  const cf V1 = {0.70710678118654752f, -0.70710678118654752f}, V2 = {0.f, -1.f}, V3 = {-0.70710678118654752f, -0.70710678118654752f};
  x[5] = cmul(x[5], cj<INV>(V1)); x[6] = cmul(x[6], cj<INV>(V2)); x[7] = cmul(x[7], cj<INV>(V3));
  r4<INV>(x[0], x[1], x[2], x[3]); r4<INV>(x[4], x[5], x[6], x[7]);
}
template <bool COL> __device__ __forceinline__ int fidx(int ln, int i) { return COL ? i * 129 + ln : ln * 129 + i; }
template <bool INV, bool COL> __device__ __forceinline__ void fft_passA(cf* buf) {
  for (int it = 0; it < 2; ++it) {
    const int bf = TIDX + NTHREADS * it, ln = bf & 127, j = bf >> 7;
    cf x[16];
    if (!INV) {
#pragma unroll
      for (int m = 0; m < 16; ++m) x[m] = buf[fidx<COL>(ln, j + 8 * m)];
      dft16<false>(x);
#pragma unroll
      for (int q = 0; q < 16; ++q) buf[fidx<COL>(ln, j + 8 * q)] = opq(cmul(x[4 * (q & 3) + (q >> 2)], twid<false>((float)(q * j) * (1.f / 128.f))));
    } else {
#pragma unroll
      for (int q = 0; q < 16; ++q) x[q] = cmul(buf[fidx<COL>(ln, j + 8 * q)], twid<true>((float)(q * j) * (1.f / 128.f)));
      dft16<true>(x);
#pragma unroll
      for (int m = 0; m < 16; ++m) buf[fidx<COL>(ln, j + 8 * m)] = opq(x[4 * (m & 3) + (m >> 2)]);
    }
  }
}
template <bool INV, bool COL> __device__ __forceinline__ void fft_passB(cf* buf) {
  for (int it = 0; it < 4; ++it) {
    const int bf = TIDX + NTHREADS * it, ln = bf & 127, B = bf >> 7;
    cf x[8];
    if (!INV) {
#pragma unroll
      for (int m = 0; m < 8; ++m) x[m] = buf[fidx<COL>(ln, 8 * B + m)];
      dft8<false>(x);
#pragma unroll
      for (int q = 0; q < 8; ++q) {
        cf v = x[4 * (q & 1) + (q >> 1)];
        if (COL) v = cmul(v, twid<false>((float)(ln * (B + 16 * q)) * (1.f / 16384.f)));
        buf[fidx<COL>(ln, 8 * B + q)] = opq(v);
      }
    } else {
#pragma unroll
      for (int q = 0; q < 8; ++q) {
        cf v = buf[fidx<COL>(ln, 8 * B + q)];
        if (COL) v = cmul(v, twid<true>((float)(ln * (B + 16 * q)) * (1.f / 16384.f)));
        x[q] = v;
      }
      dft8<true>(x);
#pragma unroll
      for (int m = 0; m < 8; ++m) buf[fidx<COL>(ln, 8 * B + m)] = opq(x[4 * (m & 1) + (m >> 1)]);
    }
  }
}
__device__ __forceinline__ void fft_fwd(cf* buf) {
  fft_passA<false, true>(buf); __syncthreads(); fft_passB<false, true>(buf); __syncthreads();
  fft_passA<false, false>(buf); __syncthreads(); fft_passB<false, false>(buf); __syncthreads();
}
__device__ __forceinline__ void fft_inv(cf* buf) {
  fft_passB<true, false>(buf); __syncthreads(); fft_passA<true, false>(buf); __syncthreads();
  fft_passB<true, true>(buf); __syncthreads(); fft_passA<true, true>(buf); __syncthreads();
}
__device__ __forceinline__ int fft_freq(int r, int c) { return ((r >> 3) + 16 * (r & 7)) + 128 * ((c >> 3) + 16 * (c & 7)); }
__device__ __forceinline__ int fft_pos(int k) {
  const int k1 = k & 127, k2 = k >> 7; return (8 * (k1 & 15) + (k1 >> 4)) * 129 + 8 * (k2 & 15) + (k2 >> 4);
}
constexpr int FFT_LDS = 128 * 129 * 8;

__device__ void hyena_spectra(const Params& p, char* smem) {
  cf* buf = (cf*)smem; float* fb = (float*)smem;
  float* w3s = (float*)(smem + FFT_LDS);
  float* red = w3s + 256;
  const int tid = TIDX, lane = tid & 63, wid = tid >> 6;
  for (int unit = BIDX; unit < 512; unit += gridDim.x) {
    const int l = unit >> 8, c = unit & 255;
    __syncthreads();
    if (tid < 256) { const int i = tid >> 2, j = tid & 3; w3s[tid] = p.in[I_HW3][(size_t)l * 64 * 1024 + (size_t)i * 1024 + j * 256 + c]; }
    if (tid == 0) buf[64 * 129] = cf{0.f, 0.f};
    __syncthreads();
    float dec[4], ss[4];
#pragma unroll
    for (int j = 0; j < 4; ++j) { dec[j] = p.in[I_HDECAY][l * 1024 + j * 256 + c]; ss[j] = 0.f; }
    const float* h2 = (const float*)(p.ws + OFF_H2) + (size_t)l * 16 * NKEYS * 4;
#pragma unroll 1
    for (int i = 0; i < 16; ++i) {
      const int t = tid + NTHREADS * i;
      float a[4] = {0.f, 0.f, 0.f, 0.f};
      const f32x4* hr = (const f32x4*)(h2 + (size_t)t * 4);
#pragma unroll
      for (int kh = 0; kh < 2; ++kh) {
        f32x4 hv8[8];
#pragma unroll
        for (int k4 = 0; k4 < 8; ++k4) hv8[k4] = hr[(size_t)(kh * 8 + k4) * NKEYS];
#pragma unroll
        for (int k4 = 0; k4 < 8; ++k4) {
          const f32x4 hv = hv8[k4];
#pragma unroll
          for (int kk = 0; kk < 4; ++kk) {
            const f32x4 wv = *(const f32x4*)(w3s + ((kh * 8 + k4) * 4 + kk) * 4);
            a[0] += hv[kk] * wv[0]; a[1] += hv[kk] * wv[1]; a[2] += hv[kk] * wv[2]; a[3] += hv[kk] * wv[3];
          }
        }
      }
      const float tn = (float)t * (1.f / (float)SEQ);
#pragma unroll
      for (int j = 0; j < 4; ++j) { a[j] *= __expf(-tn * dec[j]); ss[j] += a[j] * a[j]; }
      const int pf = (t >> 7) * 129 + (t & 127);
      fb[2 * pf] = a[0]; fb[2 * pf + 1] = a[2];
      if (t > 0) { const int n = 16384 - t, pb = (n >> 7) * 129 + (n & 127); fb[2 * pb] = a[1]; fb[2 * pb + 1] = a[3]; }
    }
#pragma unroll
    for (int j = 0; j < 4; ++j) { ss[j] = wave_sum(ss[j]); if (lane == 0) red[wid * 4 + j] = ss[j]; }
    __syncthreads();
    float sc[4];
#pragma unroll
    for (int j = 0; j < 4; ++j) { float s = 0.f; for (int w = 0; w < 8; ++w) s += red[w * 4 + j]; sc[j] = rsqrtf(s + EPSV) * (1.f / 16384.f); }
    const float sk0 = p.in[I_HSKIP][l * 512 + c] * (1.f / 16384.f), sk1 = p.in[I_HSKIP][l * 512 + 256 + c] * (1.f / 16384.f);
    for (int i = 0; i < 32; ++i) {
      const int n = tid + NTHREADS * i, pi = (n >> 7) * 129 + (n & 127);
      cf v = buf[pi];
      if (n < 8192) { v.x *= sc[0]; v.y *= sc[2]; } else { v.x *= sc[1]; v.y *= sc[3]; }
      if (n == 0) { v.x += sk0; v.y += sk1; }
      buf[pi] = v;
    }
    __syncthreads();
    fft_fwd(buf);
    unsigned* hs = (unsigned*)(p.ws + OFF_HSPEC) + ((size_t)(l * 256 + c) * 2) * 16384;
    for (int i = 0; i < 32; ++i) {
      const int e = tid + NTHREADS * i, r = e >> 7, cc = e & 127;
      const int k = fft_freq(r, cc), k2 = (16384 - k) & 16383;
      const cf a = buf[r * 129 + cc], b = buf[fft_pos(k2)];
      hs[e] = cvtpk(0.5f * (a.x + b.x), 0.5f * (a.y - b.y));
      hs[16384 + e] = cvtpk(0.5f * (a.y + b.y), -0.5f * (a.x - b.x));
    }
  }
}

__device__ void hyena_fft(const Params& p, int layer, char* smem) {
  cf* buf = (cf*)smem;
  const int tid = TIDX;
  bf16_t* mix = (bf16_t*)(p.ws + OFF_MIX);
  const float* hin = (const float*)(p.ws + OFF_HYIN);
  for (int unit = (int)gridDim.x - 1 - BIDX; unit < 256; unit += gridDim.x) {
    const int c = unit;
    const unsigned* hs = (const unsigned*)(p.ws + OFF_HSPEC) + ((size_t)(layer * 256 + c) * 2) * 16384;
    __syncthreads();
    {
      const float* z0 = hin + ((size_t)(0 * 2 + 0) * 256 + c) * SEQ; const float* z1 = hin + ((size_t)(0 * 2 + 1) * 256 + c) * SEQ;
      for (int i = 0; i < 16; ++i) { const int t = tid + NTHREADS * i; buf[(t >> 7) * 129 + (t & 127)] = cf{z0[t], z1[t]}; }
      for (int i = 0; i < 16; ++i) { const int t = 8192 + tid + NTHREADS * i; buf[(t >> 7) * 129 + (t & 127)] = cf{0.f, 0.f}; }
    }
    __syncthreads();
    for (int order = 0; order < 2; ++order) {
      fft_fwd(buf);
      for (int i = 0; i < 32; ++i) {
        const int e = tid + NTHREADS * i, pi = (e >> 7) * 129 + (e & 127);
        const unsigned hv = hs[order * 16384 + e];
        const cf h = {__uint_as_float(hv << 16), __uint_as_float(hv & 0xffff0000u)};
        buf[pi] = cmul(buf[pi], h);
      }
      __syncthreads();
      fft_inv(buf);
      const float* x0 = hin + ((size_t)((1 + order) * 2 + 0) * 256 + c) * SEQ; const float* x1 = hin + ((size_t)((1 + order) * 2 + 1) * 256 + c) * SEQ;
      if (order == 0) {
        for (int i = 0; i < 16; ++i) { const int t = tid + NTHREADS * i, pi = (t >> 7) * 129 + (t & 127); const cf v = buf[pi]; buf[pi] = cf{v.x * x0[t], v.y * x1[t]}; }
        for (int i = 0; i < 16; ++i) { const int t = 8192 + tid + NTHREADS * i; buf[(t >> 7) * 129 + (t & 127)] = cf{0.f, 0.f}; }
        __syncthreads();
      } else {
        bf16_t* yc = (bf16_t*)(p.ws + OFF_HB);
        for (int i = 0; i < 8; ++i) {
          const int t = 2 * (tid + NTHREADS * i); const cf v0 = buf[(t >> 7) * 129 + (t & 127)], v1 = buf[(t >> 7) * 129 + (t & 127) + 1];
          *(unsigned*)(yc + ((size_t)(0 * 256 + c)) * SEQ + t) = cvtpk(v0.x * x0[t], v1.x * x0[t + 1]);
          *(unsigned*)(yc + ((size_t)(1 * 256 + c)) * SEQ + t) = cvtpk(v0.y * x1[t], v1.y * x1[t + 1]);
        }
      }
    }
  }
}

__device__ void stage_prep2(const Params& p, char* smem) {
  {
    float* mod = (float*)(p.ws + OFF_MOD); const float* modp = (const float*)(p.ws + OFF_MODP);
    for (int e = BIDX * NTHREADS + TIDX; e < 2 * 3 * 6144; e += gridDim.x * NTHREADS) {
      const int l = e / (3 * 6144), w = (e / 6144) % 3, col = e % 6144;
      float s = p.in[I_BMOD][l * 6144 + col];
      for (int ks = 0; ks < 32; ++ks) s += modp[((size_t)(l * 32 + ks) * 3 + w) * 6144 + col];
      mod[e] = s;
    }
  }
  float* h2t = (float*)smem;
  float* w3t = h2t + 64 * 65;
  const int tloc = TIDX & 63, cgp = TIDX >> 6, lane = TIDX & 63;
  for (int it = BIDX; it < 2 * 4 * 16; it += gridDim.x) {
    const int l = it / (4 * 16), tt = 128 + (it / 16) % 4, ct = it % 16;
    const bool isc = tt >= 128; const int L = isc ? CTXL : SEQ; const int t0 = isc ? (tt - 128) * 64 : tt * 64;
    const int pos0 = isc ? SEQ + t0 : t0;
    const float* h2 = (const float*)(p.ws + OFF_H2);
    const float* w3 = p.in[I_HW3] + (size_t)l * 64 * 1024 + ct * 64;
    __syncthreads();
    for (int e = TIDX; e < 4096; e += NTHREADS) { int i = e >> 6, j = e & 63; h2t[i * 65 + j] = h2[h2idx(l, pos0 + i, j)]; w3t[i * 64 + j] = w3[(size_t)i * 1024 + j]; }
    __syncthreads();
    float acc[8];
#pragma unroll
    for (int cc = 0; cc < 8; ++cc) acc[cc] = 0.f;
#pragma unroll 2
    for (int i = 0; i < 64; ++i) {
      const float hv = h2t[tloc * 65 + i];
#pragma unroll
      for (int cc = 0; cc < 8; ++cc) acc[cc] += hv * w3t[i * 64 + cgp * 8 + cc];
    }
    const float tn = (float)(t0 + tloc) / (float)L;
#pragma unroll
    for (int cc = 0; cc < 8; ++cc) {
      const int col = ct * 64 + cgp * 8 + cc;
      const float val = acc[cc] * __expf(-tn * p.in[I_HDECAY][l * 1024 + col]);
      ((float*)(p.ws + OFF_FILTC))[((size_t)l * 1024 + col) * CTXL + t0 + tloc] = val;
      const float s = wave_sum(val * val);
      if (lane == 0) ((float*)(p.ws + OFF_SSQPC))[((size_t)l * 4 + (tt - 128)) * 1024 + col] = s;
    }
  }
  hyena_spectra(p, smem);
}

__device__ void stage_norm(const Params& p, int layer, int which  , int nrows) {
  const int lane = TIDX & 63, wid = TIDX >> 6;
  const float* g = (which ? p.in[I_N2G] : p.in[I_N1G]) + layer * DM;
  bf16_t* hb = (bf16_t*)(p.ws + OFF_HB);
  const int ngrp = nrows / 4, gstride = gridDim.x * 8;
  int grp = BIDX * 8 + wid;
  f32x4 v[4][4], vn[4][4];
  auto rowsrc = [&](int r0) -> const float* { return (which == 0) ? xrow_src(p, layer, r0) : (const float*)(p.ws + OFF_XS) + (size_t)r0 * DM; };
  if (grp < ngrp) {
    const float* src = rowsrc(grp * 4);
#pragma unroll
    for (int j = 0; j < 4; ++j)
#pragma unroll
      for (int i = 0; i < 2; ++i) { v[j][2 * i] = *(const f32x4*)(src + (size_t)j * DM + i * 512 + lane * 8); v[j][2 * i + 1] = *(const f32x4*)(src + (size_t)j * DM + i * 512 + lane * 8 + 4); }
  }
  for (; grp < ngrp; grp += gstride) {
    const int r0 = grp * 4, gn = grp + gstride;
    if (gn < ngrp) {
      const float* src = rowsrc(gn * 4);
#pragma unroll
      for (int j = 0; j < 4; ++j)
#pragma unroll
        for (int i = 0; i < 2; ++i) { vn[j][2 * i] = *(const f32x4*)(src + (size_t)j * DM + i * 512 + lane * 8); vn[j][2 * i + 1] = *(const f32x4*)(src + (size_t)j * DM + i * 512 + lane * 8 + 4); }
    }
    int b, t, isc; row_info(r0, b, t, isc);
    const float* mod = (const float*)(p.ws + OFF_MOD) + ((size_t)layer * 3 + (isc ? 2 : b)) * 6144 + (which ? 3072 : 0);
    float ss[4];
#pragma unroll
    for (int j = 0; j < 4; ++j) {
      float s = 0.f;
#pragma unroll
      for (int i = 0; i < 4; ++i) s += v[j][i][0] * v[j][i][0] + v[j][i][1] * v[j][i][1] + v[j][i][2] * v[j][i][2] + v[j][i][3] * v[j][i][3];
      ss[j] = s;
    }
#pragma unroll
    for (int j = 0; j < 4; ++j) ss[j] = rsqrtf(wave_sum(ss[j]) * (1.f / DM) + EPSV);
#pragma unroll
    for (int i = 0; i < 2; ++i) {
      const int c0 = i * 512 + lane * 8;
      const f32x4 g0 = *(const f32x4*)(g + c0), g1 = *(const f32x4*)(g + c0 + 4);
      const f32x4 sc0 = *(const f32x4*)(mod + 1024 + c0), sc1 = *(const f32x4*)(mod + 1024 + c0 + 4), sh0 = *(const f32x4*)(mod + c0), sh1 = *(const f32x4*)(mod + c0 + 4);
#pragma unroll
      for (int j = 0; j < 4; ++j) {
        float y[8];
#pragma unroll
        for (int q = 0; q < 4; ++q) { y[q] = v[j][2 * i][q] * ss[j] * g0[q] * (1.f + sc0[q]) + sh0[q]; y[4 + q] = v[j][2 * i + 1][q] * ss[j] * g1[q] * (1.f + sc1[q]) + sh1[q]; }
        const u32x4 o = {cvtpk(y[0], y[1]), cvtpk(y[2], y[3]), cvtpk(y[4], y[5]), cvtpk(y[6], y[7])};
        *(u32x4*)(hb + (size_t)(r0 + j) * DM + c0) = o;
      }
    }
#pragma unroll
    for (int j = 0; j < 4; ++j)
#pragma unroll
      for (int i = 0; i < 4; ++i) v[j][i] = vn[j][i];
  }
}

template <class Epi>
__device__ void gemm_bt(const bf16_t* __restrict__ A, int lda, const bf16_t* __restrict__ Bt, int ldb, int M, int N, int K, Epi epi, char* smem) {
  const int tid = TIDX, wid = tid >> 6, lane = tid & 63, r32 = lane & 31, hi = lane >> 5;
  const int wm = wid >> 2, wn = wid & 3;
  constexpr int RS = 144;
  char* sA = smem; char* sB = smem + 128 * RS;
  const int tilesM = M / 128, tilesN = N / 128, nk = K / 64;
  const int lr0 = tid >> 3, lc = (tid & 7) * 8;
  for (int tile = BIDX; tile < tilesM * tilesN; tile += gridDim.x) {
    const int tm = tile / tilesN, tn = tile % tilesN;
    const bf16_t* Ap = A + (size_t)(tm * 128 + lr0) * lda + lc;
    const bf16_t* Bp = Bt + (size_t)(tn * 128 + lr0) * ldb + lc;
    f32x16 acc0 = {}, acc1 = {};
    u32x4 ra0 = *(const u32x4*)Ap, ra1 = *(const u32x4*)(Ap + (size_t)64 * lda);
    u32x4 rb0 = *(const u32x4*)Bp, rb1 = *(const u32x4*)(Bp + (size_t)64 * ldb);
    for (int kt = 0; kt < nk; ++kt) {
      __syncthreads();
      *(u32x4*)(sA + lr0 * RS + lc * 2) = ra0; *(u32x4*)(sA + (lr0 + 64) * RS + lc * 2) = ra1;
      *(u32x4*)(sB + lr0 * RS + lc * 2) = rb0; *(u32x4*)(sB + (lr0 + 64) * RS + lc * 2) = rb1;
      __syncthreads();
      if (kt + 1 < nk) {
        const int ko = (kt + 1) * 64;
        ra0 = *(const u32x4*)(Ap + ko); ra1 = *(const u32x4*)(Ap + (size_t)64 * lda + ko);
        rb0 = *(const u32x4*)(Bp + ko); rb1 = *(const u32x4*)(Bp + (size_t)64 * ldb + ko);
      }
#pragma unroll
      for (int ks = 0; ks < 4; ++ks) {
        const int cb = (ks * 16 + hi * 8) * 2;
        const bf16x8 a0 = *(const bf16x8*)(sA + (wm * 64 + r32) * RS + cb);
        const bf16x8 a1 = *(const bf16x8*)(sA + (wm * 64 + 32 + r32) * RS + cb);
        const bf16x8 bb = *(const bf16x8*)(sB + (wn * 32 + r32) * RS + cb);
        acc0 = __builtin_amdgcn_mfma_f32_32x32x16_bf16(a0, bb, acc0, 0, 0, 0);
        acc1 = __builtin_amdgcn_mfma_f32_32x32x16_bf16(a1, bb, acc1, 0, 0, 0);
      }
    }
    const int col = tn * 128 + wn * 32 + r32;
#pragma unroll
    for (int r = 0; r < 16; ++r) {
      epi(tm * 128 + wm * 64 + crow(r, hi), col, acc0[r]);
      epi(tm * 128 + wm * 64 + 32 + crow(r, hi), col, acc1[r]);
    }
  }
}

__device__ __forceinline__ float rope_apply(float x, float xp, int c, int t) {
  const int i = c & 7; const float pos = ((c >> 4) & 1) ? (float)(t & 63) : (float)(t >> 6);
  const float inv = __expf(-(float)i * (9.210340371976184f / 8.f));
  const float rev = (pos * inv) * 0.15915494309189535f;
  const float cs = __builtin_amdgcn_cosf(rev), sn = __builtin_amdgcn_sinf(rev);
  return x * cs + ((c & 8) ? xp : -xp) * sn;
}

constexpr int NCH32 = NTOK / 32;
__device__ __forceinline__ float swap32(float v, int hi) { const auto rr = __builtin_amdgcn_permlane32_swap(__float_as_uint(v), __float_as_uint(v), false, false); return __uint_as_float(hi ? rr[0] : rr[1]); }
template <bool BWD>
__device__ __forceinline__ void lru_seg_scan(const float* a, const float* b, int hi, float S, float* h, float& Sout) {
  float P[4], H[4], Sin[4];
#pragma unroll
  for (int g = 0; g < 4; ++g) {
    if (!BWD) { H[g] = b[4 * g]; P[g] = a[4 * g];
#pragma unroll
      for (int q = 1; q < 4; ++q) { H[g] = a[4 * g + q] * H[g] + b[4 * g + q]; P[g] *= a[4 * g + q]; } }
    else { H[g] = b[4 * g + 3]; P[g] = a[4 * g + 3];
#pragma unroll
      for (int q = 2; q >= 0; --q) { H[g] = a[4 * g + q] * H[g] + b[4 * g + q]; P[g] *= a[4 * g + q]; } }
    Sin[g] = 0.f;
  }
#pragma unroll
  for (int step = 0; step < 8; ++step) {
    const int s = BWD ? 7 - step : step, g = s >> 1, owner = s & 1;
    const bool mine = (hi == owner);
    if (mine) Sin[g] = S;
    const float cand = P[g] * S + H[g];
    const float other = swap32(cand, hi);
    S = mine ? cand : other;
  }
  Sout = S;
#pragma unroll
  for (int g = 0; g < 4; ++g) {
    float hp = Sin[g];
    if (!BWD) {
#pragma unroll
      for (int q = 0; q < 4; ++q) { hp = a[4 * g + q] * hp + b[4 * g + q]; h[4 * g + q] = hp; } }
    else {
#pragma unroll
      for (int q = 3; q >= 0; --q) { hp = a[4 * g + q] * hp + b[4 * g + q]; h[4 * g + q] = hp; } }
  }
}
__device__ void lru_units(const Params& p, int layer, int mode, char* smem) {
  const int tid = TIDX, wid = tid >> 6, lane = tid & 63, r32 = lane & 31, hi = lane >> 5;
  const bf16_t* u = (const bf16_t*)(p.ws + OFF_U);
  const float* cw = p.in[I_LCW] + (size_t)layer * 4 * DLRU; const float* cbias = p.in[I_LCB] + layer * DLRU;
  bf16_t* mix = (bf16_t*)(p.ws + OFF_MIX);
  constexpr int RS = 272;
  char* tile = smem + wid * (35 * RS);
  const int bid = BIDX, n = bid % 6, rk = bid / 6, nbn = ((int)gridDim.x - n + 5) / 6;
  char* gwl = smem + 8 * 35 * RS;
  __syncthreads();
  for (int i = tid; i < 2048; i += NTHREADS) {
    const int mat = i >> 9, row = (i >> 3) & 63, c = i & 7;
    const bf16_t* gsrc = (const bf16_t*)(p.ws + OFF_GW) + ((size_t)((layer * 2 + (mat >> 1)) * 2 + (mat & 1)) * 6 + n) * 4096 + row * 64 + c * 8;
    *(u32x4*)(gwl + mat * 8192 + row * 128 + ((c ^ (row & 7)) << 4)) = *(const u32x4*)gsrc;
  }
  __syncthreads();
  for (int cid = rk * 8 + wid; cid < NCH32; cid += nbn * 8) {
    const int unit = cid * 6 + n;
    int rbase, t0, slen;
    if (cid < 512) { const int b = cid >> 8; rbase = b * SEQ; t0 = (cid & 255) * 32; slen = SEQ; }
    else { const int q = cid - 512, b = q >> 3; rbase = NLAT + b * CTXL; t0 = (q & 7) * 32; slen = CTXL; }
    {
      const int row8 = lane >> 3, c8 = lane & 7;
      const bf16_t* ub = u + (size_t)rbase * DIN + n * 64 + c8 * 8;
#pragma unroll
      for (int i = 0; i < 5; ++i) {
        const int row = i * 8 + row8, t = t0 + row - 2;
        if (row < 35) {
          u32x4 v = {0u, 0u, 0u, 0u};
          if (t >= 0 && t < slen) v = *(const u32x4*)(ub + (size_t)t * DIN);
          const f32x4 lo = {__uint_as_float(v[0] << 16), __uint_as_float(v[0] & 0xffff0000u), __uint_as_float(v[1] << 16), __uint_as_float(v[1] & 0xffff0000u)};
          const f32x4 hi4 = {__uint_as_float(v[2] << 16), __uint_as_float(v[2] & 0xffff0000u), __uint_as_float(v[3] << 16), __uint_as_float(v[3] & 0xffff0000u)};
          *(f32x4*)(tile + row * RS + c8 * 32) = lo; *(f32x4*)(tile + row * RS + c8 * 32 + 16) = hi4;
        }
      }
    }
    bf16x8 af[4];
    {
      const char* tl = tile + r32 * RS + hi * 32;
#pragma unroll
      for (int ks = 0; ks < 4; ++ks) {
        const int col = n * 64 + ks * 16 + 8 * hi;
        f32x4 c0 = *(const f32x4*)(cbias + col), c1 = *(const f32x4*)(cbias + col + 4);
#pragma unroll
        for (int k = 0; k < 4; ++k) {
          const f32x4 x0 = *(const f32x4*)(tl + k * RS + ks * 64), x1 = *(const f32x4*)(tl + k * RS + ks * 64 + 16);
          const f32x4 w0 = *(const f32x4*)(cw + k * DLRU + col), w1 = *(const f32x4*)(cw + k * DLRU + col + 4);
          c0 += w0 * x0; c1 += w1 * x1;
        }
        const u32x4 pk = {cvtpk(c0[0], c0[1]), cvtpk(c0[2], c0[3]), cvtpk(c1[0], c1[1]), cvtpk(c1[2], c1[3])};
        af[ks] = *(const bf16x8*)&pk;
      }
    }
    float xo[2][16];
#pragma unroll
    for (int nt = 0; nt < 2; ++nt) {
      const int ch = n * 64 + nt * 32 + r32;
      const float w0 = cw[ch], w1 = cw[DLRU + ch], w2 = cw[2 * DLRU + ch], w3 = cw[3 * DLRU + ch], bb = cbias[ch];
      const char* tl = tile + (4 * hi) * RS + (nt * 32 + r32) * 4;
#pragma unroll
      for (int g = 0; g < 4; ++g) {
        float xr[7];
#pragma unroll
        for (int i = 0; i < 7; ++i) xr[i] = *(const float*)(tl + (8 * g + i) * RS);
#pragma unroll
        for (int q = 0; q < 4; ++q) xo[nt][4 * g + q] = bb + w0 * xr[q] + w1 * xr[q + 1] + w2 * xr[q + 2] + w3 * xr[q + 3];
      }
    }
    if (mode == 1) {
      const bf16_t* ub = u + (size_t)(rbase + t0) * DIN + DLRU + n * 64 + lane;
#pragma unroll 4
      for (int i = 0; i < 32; ++i) *(float*)(tile + i * RS + lane * 4) = bf2f(ub[(size_t)i * DIN]);
    }
#pragma unroll 1
    for (int nt = 0; nt < 2; ++nt) {
      const int ch = n * 64 + nt * 32 + r32;
      float hf[16];
#pragma unroll
      for (int dir = 0; dir < 2; ++dir) {
        const char* gwr = gwl + (dir * 2 + 0) * 8192 + (nt * 32 + r32) * 128;
        const char* gwi = gwl + (dir * 2 + 1) * 8192 + (nt * 32 + r32) * 128;
        f32x16 accR = {}, accI = {};
#pragma unroll
        for (int ks = 0; ks < 4; ++ks) {
          const int co = ((ks * 2 + hi) ^ (r32 & 7)) << 4;
          const bf16x8 br_ = *(const bf16x8*)(gwr + co), bi_ = *(const bf16x8*)(gwi + co);
          accR = __builtin_amdgcn_mfma_f32_32x32x16_bf16(af[ks], br_, accR, 0, 0, 0);
          accI = __builtin_amdgcn_mfma_f32_32x32x16_bf16(af[ks], bi_, accI, 0, 0, 0);
        }
        const size_t po = (size_t)(layer * 2 + dir) * DLRU + ch;
        const float brv = p.in[I_LBR][po], biv = p.in[I_LBI][po];
        const float cl = -8.f * __logf(1.f + __expf(-p.in[I_LLAM][po]));
        float a[16], bq[16];
#pragma unroll
        for (int r = 0; r < 16; ++r) {
          const float rr = __builtin_amdgcn_rcpf(1.f + __expf(-(accR[r] + brv))), ii = __builtin_amdgcn_rcpf(1.f + __expf(-(accI[r] + biv)));
          const float av = __expf(rr * cl);
          a[r] = av; bq[r] = __builtin_amdgcn_sqrtf(fmaxf(1.f - av * av, 0.f)) * (ii * (nt == 0 ? xo[0][r] : xo[1][r]));
        }
        if (mode == 0) {
          {
            u32x4* ab = (u32x4*)(p.ws + OFF_LAB) + ((((size_t)unit * 2 + nt) * 2 + dir) * 4) * 64 + lane;
#pragma unroll
            for (int r4 = 0; r4 < 4; ++r4) { const u32x4 o = {cvtpk(1.f - a[4 * r4], bq[4 * r4]), cvtpk(1.f - a[4 * r4 + 1], bq[4 * r4 + 1]), cvtpk(1.f - a[4 * r4 + 2], bq[4 * r4 + 2]), cvtpk(1.f - a[4 * r4 + 3], bq[4 * r4 + 3])}; ab[r4 * 64] = o; }
          }
          float hd[16], Send;
          if (dir == 0) lru_seg_scan<false>(a, bq, hi, 0.f, hd, Send); else lru_seg_scan<true>(a, bq, hi, 0.f, hd, Send);
          float pp = a[0];
#pragma unroll
          for (int r = 1; r < 16; ++r) pp *= a[r];
          pp *= swap32(pp, hi);
          if (hi == 0) { float* ls = (float*)(p.ws + OFF_LSUM) + ((size_t)(cid * 2 + dir) * 2) * DLRU + ch; ls[0] = pp; ls[DLRU] = Send; }
        } else {
          const float cin = ((const float*)(p.ws + OFF_CARRY))[(size_t)(cid * 2 + dir) * DLRU + ch];
          float Send;
          if (dir == 0) lru_seg_scan<false>(a, bq, hi, cin, hf, Send);
          else {
            float hb[16];
            lru_seg_scan<true>(a, bq, hi, cin, hb, Send);
            const char* tl = tile + (4 * hi) * RS + (nt * 32 + r32) * 4;
            bf16_t* mo = mix + ((size_t)rbase + t0 + 4 * hi) * DM + ch;
#pragma unroll
            for (int r = 0; r < 16; ++r) {
              const int tk = (r & 3) + 8 * (r >> 2);
              const float gt = *(const float*)(tl + tk * RS);
              mo[(size_t)tk * DM] = f2bf((hf[r] + hb[r]) * gelu_tanh(gt));
            }
          }
        }
      }
    }
  }
}

__device__ void lru_final(const Params& p, int layer, char* smem) {
  const int tid = TIDX, wid = tid >> 6, lane = tid & 63, r32 = lane & 31, hi = lane >> 5;
  const bf16_t* u = (const bf16_t*)(p.ws + OFF_U);
  bf16_t* mix = (bf16_t*)(p.ws + OFF_MIX);
  constexpr int RS = 272;
  char* tile = smem + wid * (35 * RS);
  __syncthreads();
  for (int unit = BIDX * 8 + wid; unit < NCH32 * 6; unit += gridDim.x * 8) {
    const int cid = unit / 6, n = unit % 6;
    int rbase, t0;
    if (cid < 512) { const int b = cid >> 8; rbase = b * SEQ; t0 = (cid & 255) * 32; }
    else { const int q = cid - 512, b = q >> 3; rbase = NLAT + b * CTXL; t0 = (q & 7) * 32; }
    unsigned ab[2][2][16];
#pragma unroll
    for (int nt = 0; nt < 2; ++nt)
#pragma unroll
      for (int dir = 0; dir < 2; ++dir) {
        const u32x4* abp = (const u32x4*)(p.ws + OFF_LAB) + ((((size_t)unit * 2 + nt) * 2 + dir) * 4) * 64 + lane;
#pragma unroll
        for (int r4 = 0; r4 < 4; ++r4) { const u32x4 v = abp[r4 * 64]; ab[nt][dir][4 * r4] = v[0]; ab[nt][dir][4 * r4 + 1] = v[1]; ab[nt][dir][4 * r4 + 2] = v[2]; ab[nt][dir][4 * r4 + 3] = v[3]; }
      }
    {
      const int row8 = lane >> 3, c8 = lane & 7;
      const bf16_t* ub = u + (size_t)(rbase + t0) * DIN + DLRU + n * 64 + c8 * 8;
#pragma unroll
      for (int i = 0; i < 4; ++i) {
        const int row = i * 8 + row8;
        const u32x4 v = *(const u32x4*)(ub + (size_t)row * DIN);
        const f32x4 lo = {__uint_as_float(v[0] << 16), __uint_as_float(v[0] & 0xffff0000u), __uint_as_float(v[1] << 16), __uint_as_float(v[1] & 0xffff0000u)};
        const f32x4 hi4 = {__uint_as_float(v[2] << 16), __uint_as_float(v[2] & 0xffff0000u), __uint_as_float(v[3] << 16), __uint_as_float(v[3] & 0xffff0000u)};
        *(f32x4*)(tile + row * RS + c8 * 32) = lo; *(f32x4*)(tile + row * RS + c8 * 32 + 16) = hi4;
      }
    }
#pragma unroll
    for (int nt = 0; nt < 2; ++nt) {
      const int ch = n * 64 + nt * 32 + r32;
      float hf[16], hb[16], a[16], bq[16], Send;
#pragma unroll
      for (int r = 0; r < 16; ++r) { a[r] = 1.f - __uint_as_float(ab[nt][0][r] << 16); bq[r] = __uint_as_float(ab[nt][0][r] & 0xffff0000u); }
      lru_seg_scan<false>(a, bq, hi, ((const float*)(p.ws + OFF_CARRY))[(size_t)(cid * 2 + 0) * DLRU + ch], hf, Send);
#pragma unroll
      for (int r = 0; r < 16; ++r) { a[r] = 1.f - __uint_as_float(ab[nt][1][r] << 16); bq[r] = __uint_as_float(ab[nt][1][r] & 0xffff0000u); }
      lru_seg_scan<true>(a, bq, hi, ((const float*)(p.ws + OFF_CARRY))[(size_t)(cid * 2 + 1) * DLRU + ch], hb, Send);
      const char* tl = tile + (4 * hi) * RS + (nt * 32 + r32) * 4;
      bf16_t* mo = mix + ((size_t)rbase + t0 + 4 * hi) * DM + ch;
#pragma unroll
      for (int r = 0; r < 16; ++r) {
        const int tk = (r & 3) + 8 * (r >> 2);
        const float gt = *(const float*)(tl + tk * RS);
        mo[(size_t)tk * DM] = f2bf((hf[r] + hb[r]) * gelu_tanh(gt));
      }
    }
  }
}

__device__ void lru_carry(const Params& p, char* smem) {
  const int tid = TIDX, seg = tid >> 6, c = tid & 63;
  const float* __restrict__ ls = (const float*)(p.ws + OFF_LSUM); float* __restrict__ cr = (float*)(p.ws + OFF_CARRY);
  float* comp = (float*)smem;
  for (int item = (int)gridDim.x - 1 - BIDX; item < 2 * 2 * 6; item += gridDim.x) {
    const int b = item / 12, dir = (item / 6) & 1, ch = (item % 6) * 64 + c;
    float P[33], H[33];
#pragma unroll
    for (int i = 0; i < 33; ++i) {
      const int k = seg * 33 + i;
      int cid;
      if (dir == 0) cid = (k < 8) ? 512 + b * 8 + k : b * 256 + (k - 8);
      else          cid = (k < 8) ? 512 + b * 8 + (7 - k) : b * 256 + (255 - (k - 8));
      P[i] = ls[((size_t)(cid * 2 + dir) * 2) * DLRU + ch]; H[i] = ls[((size_t)(cid * 2 + dir) * 2 + 1) * DLRU + ch];
    }
    float pc = 1.f, hc = 0.f;
#pragma unroll
    for (int i = 0; i < 33; ++i) { hc = P[i] * hc + H[i]; pc *= P[i]; }
    __syncthreads();
    comp[(seg * 2) * 64 + c] = pc; comp[(seg * 2 + 1) * 64 + c] = hc;
    __syncthreads();
    float st = 0.f;
    for (int s = 0; s < seg; ++s) st = comp[(s * 2) * 64 + c] * st + comp[(s * 2 + 1) * 64 + c];
#pragma unroll
    for (int i = 0; i < 33; ++i) {
      const int k = seg * 33 + i;
      int cid;
      if (dir == 0) cid = (k < 8) ? 512 + b * 8 + k : b * 256 + (k - 8);
      else          cid = (k < 8) ? 512 + b * 8 + (7 - k) : b * 256 + (255 - (k - 8));
      cr[(size_t)(cid * 2 + dir) * DLRU + ch] = st;
      st = P[i] * st + H[i];
    }
  }
}

__device__ void mla_prep(const Params& p, int layer) {
  const int lane = TIDX & 63, wid = TIDX >> 6;
  const bf16_t* u = (const bf16_t*)(p.ws + OFF_U);
  const float* qg = p.in[I_QNG] + layer * 384; const float* kvg = p.in[I_KVNG] + layer * 256;
  bf16_t* qn = (bf16_t*)(p.ws + OFF_QN); bf16_t* kvn = (bf16_t*)(p.ws + OFF_KVN); bf16_t* Kb = (bf16_t*)(p.ws + OFF_K);
  const bool qact = lane < 48, kact = lane < 32;
  f32x4 qg0 = {0.f, 0.f, 0.f, 0.f}, qg1 = qg0, kg0 = qg0, kg1 = qg0;
  if (qact) { qg0 = *(const f32x4*)(qg + lane * 8); qg1 = *(const f32x4*)(qg + lane * 8 + 4); }
  if (kact) { kg0 = *(const f32x4*)(kvg + lane * 8); kg1 = *(const f32x4*)(kvg + lane * 8 + 4); }
  u32x4 qv[4], kv[4], qvn[4], kvn_[4]; unsigned short kr[4], krn[4];
  const int gstride = gridDim.x * 8;
  int grp = BIDX * 8 + wid;
#define MLA_LOAD(QV, KV, KR, G) do { _Pragma("unroll") for (int j = 0; j < 4; ++j) { const bf16_t* ur = u + (size_t)((G) * 4 + j) * DIN; \
      QV[j] = u32x4{0u, 0u, 0u, 0u}; KV[j] = u32x4{0u, 0u, 0u, 0u}; \
      if (qact) QV[j] = *(const u32x4*)(ur + 768 + lane * 8); if (kact) KV[j] = *(const u32x4*)(ur + 1152 + lane * 8); KR[j] = ur[1408 + (lane & 31)]; } } while (0)
  if (grp < NTOK / 4) MLA_LOAD(qv, kv, kr, grp);
  for (; grp < NTOK / 4; grp += gstride) {
    const int r0 = grp * 4;
    if (grp + gstride < NTOK / 4) MLA_LOAD(qvn, kvn_, krn, grp + gstride);
#pragma unroll
    for (int j = 0; j < 4; ++j) {
      const int r = r0 + j;
      int b, t, isc; row_info(r, b, t, isc);
      float q[8], k[8], ss = 0.f;
#pragma unroll
      for (int i = 0; i < 4; ++i) { q[2 * i] = __uint_as_float(qv[j][i] << 16); q[2 * i + 1] = __uint_as_float(qv[j][i] & 0xffff0000u); ss += q[2 * i] * q[2 * i] + q[2 * i + 1] * q[2 * i + 1]; }
      float rinv = rsqrtf(wave_sum(ss) * (1.f / 384.f) + EPSV);
      if (qact) {
        const u32x4 o = {cvtpk(q[0] * rinv * qg0[0], q[1] * rinv * qg0[1]), cvtpk(q[2] * rinv * qg0[2], q[3] * rinv * qg0[3]),
                         cvtpk(q[4] * rinv * qg1[0], q[5] * rinv * qg1[1]), cvtpk(q[6] * rinv * qg1[2], q[7] * rinv * qg1[3])};
        *(u32x4*)(qn + (size_t)r * 384 + lane * 8) = o;
      }
      ss = 0.f;
#pragma unroll
      for (int i = 0; i < 4; ++i) { k[2 * i] = __uint_as_float(kv[j][i] << 16); k[2 * i + 1] = __uint_as_float(kv[j][i] & 0xffff0000u); ss += k[2 * i] * k[2 * i] + k[2 * i + 1] * k[2 * i + 1]; }
      rinv = rsqrtf(wave_sum(ss) * (1.f / 256.f) + EPSV);
      if (kact) {
        const u32x4 o = {cvtpk(k[0] * rinv * kg0[0], k[1] * rinv * kg0[1]), cvtpk(k[2] * rinv * kg0[2], k[3] * rinv * kg0[3]),
                         cvtpk(k[4] * rinv * kg1[0], k[5] * rinv * kg1[1]), cvtpk(k[6] * rinv * kg1[2], k[7] * rinv * kg1[3])};
        *(u32x4*)(kvn + (size_t)r * 256 + lane * 8) = o;
      }
      const float krv = bf2f(kr[j]), krp = shx(krv, 8);
      const float ko = isc ? krv : rope_apply(krv, krp, lane & 31, t);
      if (lane < 32) ((bf16_t*)(p.ws + OFF_V))[(size_t)r * 32 + rope_slot(lane)] = f2bf(ko);
    }
#pragma unroll
    for (int j = 0; j < 4; ++j) { qv[j] = qvn[j]; kv[j] = kvn_[j]; kr[j] = krn[j]; }
  }
#undef MLA_LOAD
}

__device__ void hyena_prep(const Params& p, int layer, char* smem) {
  constexpr int RS = 516;
  const bf16_t* u = (const bf16_t*)(p.ws + OFF_U);
  const float* cw = p.in[I_HCW] + (size_t)layer * 3 * 768; const float* cb = p.in[I_HCB] + layer * 768;
  const int tid = TIDX;
  const int ntile = (layer == 0) ? NCHUNK : 256;
  for (int unit = BIDX; unit < ntile * 3; unit += gridDim.x) {
    const int cid = unit / 3, part = unit % 3;
    int rbase, t0, slen, b;
    if (cid < 256) { b = cid >> 7; rbase = b * SEQ; t0 = (cid & 127) * 64; slen = SEQ; }
    else { const int q = cid - 256; b = q >> 2; rbase = NLAT + b * CTXL; t0 = (q & 3) * 64; slen = CTXL; }
    __syncthreads();
    {
      const int chunk = tid & 31;
      for (int row = tid >> 5; row < 66; row += 16) {
        const int t = t0 + row - 1;
        u32x4 v = {0u, 0u, 0u, 0u};
        if (t >= 0 && t < slen) v = *(const u32x4*)(u + (size_t)(rbase + t) * DIN + 1440 + part * 256 + chunk * 8);
        unsigned* d = (unsigned*)(smem + row * RS + chunk * 16);
        d[0] = v[0]; d[1] = v[1]; d[2] = v[2]; d[3] = v[3];
      }
    }
    __syncthreads();
    {
      const int tg = tid & 15;
      const char* tb = smem + (4 * tg) * RS;
#pragma unroll
      for (int i = 0; i < 4; ++i) {
        const int cp = (tid >> 4) + 32 * i, pc = part * 256 + 2 * cp;
        unsigned x[6];
#pragma unroll
        for (int k = 0; k < 6; ++k) x[k] = *(const unsigned*)(tb + k * RS + cp * 4);
        const float wa0 = cw[pc], wa1 = cw[768 + pc], wa2 = cw[1536 + pc], ba = cb[pc];
        const float wb0 = cw[pc + 1], wb1 = cw[768 + pc + 1], wb2 = cw[1536 + pc + 1], bb = cb[pc + 1];
        f32x4 ya, yb;
#pragma unroll
        for (int q = 0; q < 4; ++q) {
          ya[q] = ba + wa0 * __uint_as_float(x[q] << 16) + wa1 * __uint_as_float(x[q + 1] << 16) + wa2 * __uint_as_float(x[q + 2] << 16);
          yb[q] = bb + wb0 * __uint_as_float(x[q] & 0xffff0000u) + wb1 * __uint_as_float(x[q + 1] & 0xffff0000u) + wb2 * __uint_as_float(x[q + 2] & 0xffff0000u);
        }
        float* dst = (cid < 256) ? (float*)(p.ws + OFF_HYIN) + ((size_t)(part * 2 + b) * 256 + 2 * cp) * SEQ + t0 + 4 * tg
                                 : (float*)(p.ws + OFF_HYINC) + ((size_t)(part * 2 + b) * 256 + 2 * cp) * CTXL + t0 + 4 * tg;
        *(f32x4*)dst = ya; *(f32x4*)(dst + slen) = yb;
      }
    }
  }
}

__device__ void hyena_out_transpose(const Params& p, char* smem) {
  const bf16_t* yc = (const bf16_t*)(p.ws + OFF_HB); bf16_t* mix = (bf16_t*)(p.ws + OFF_MIX);
  constexpr int RS = 132;
  const int tid = TIDX;
  for (int unit = BIDX; unit < 2 * (SEQ / 64); unit += gridDim.x) {
    const int b = unit / (SEQ / 64), t0 = (unit % (SEQ / 64)) * 64;
    __syncthreads();
    {
      const int chunk = tid & 7;
      for (int c = tid >> 3; c < 256; c += 64) {
        const u32x4 v = *(const u32x4*)(yc + ((size_t)(b * 256 + c)) * SEQ + t0 + chunk * 8);
        unsigned* d = (unsigned*)(smem + c * RS + chunk * 16);
        d[0] = v[0]; d[1] = v[1]; d[2] = v[2]; d[3] = v[3];
      }
    }
    __syncthreads();
    {
      const int c8 = (tid & 31) * 8;
      for (int tl = tid >> 5; tl < 64; tl += 16) {
        unsigned short h[8];
#pragma unroll
        for (int q = 0; q < 8; ++q) h[q] = *(const unsigned short*)(smem + (c8 + q) * RS + tl * 2);
        const u32x4 o = {(unsigned)h[0] | ((unsigned)h[1] << 16), (unsigned)h[2] | ((unsigned)h[3] << 16), (unsigned)h[4] | ((unsigned)h[5] << 16), (unsigned)h[6] | ((unsigned)h[7] << 16)};
        *(u32x4*)(mix + ((size_t)b * SEQ + t0 + tl) * DM + 768 + c8) = o;
      }
    }
  }
}

__device__ void hyena_direct(const Params& p, int layer, char* smem) {
  float* zs = (float*)smem;
  float* Ts = zs + SEQ;
  bf16_t* mix = (bf16_t*)(p.ws + OFF_MIX);
  const int nunits = (layer == 0) ? 512 : 0;
  for (int unit = BIDX; unit < nunits; unit += gridDim.x) {
    const bool isc = true; const int q = unit & 511, b = q >> 8, c = q & 255;
    const int L = CTXL;
    const float* hin = (const float*)(p.ws + OFF_HYINC);
    const float* filt = (const float*)(p.ws + OFF_FILTC) + (size_t)layer * 1024 * CTXL;
    const float* ssq = (const float*)(p.ws + OFF_SSQPC) + (size_t)layer * 4 * 1024;
    const int ntt = 4;
    const int nout = (L + NTHREADS - 1) / NTHREADS;
    for (int order = 0; order < 2; ++order) {
      const int colf = (order * 2 + 0) * 256 + c, colb = (order * 2 + 1) * 256 + c;
      float sf = 0.f, sb = 0.f;
      for (int tt = 0; tt < ntt; ++tt) { sf += ssq[(size_t)tt * 1024 + colf]; sb += ssq[(size_t)tt * 1024 + colb]; }
      sf = rsqrtf(sf + EPSV); sb = rsqrtf(sb + EPSV);
      const float skip = p.in[I_HSKIP][(size_t)layer * 512 + order * 256 + c];
      __syncthreads();
      for (int i = TIDX; i < 2 * L; i += NTHREADS) {
        const int m = i - L;
        float v = 0.f;
        if (m >= 0) v = filt[(size_t)colf * L + m] * sf; else if (m > -L) v = filt[(size_t)colb * L - m] * sb;
        if (m == 0) v += skip;
        Ts[i] = v;
      }
      if (order == 0) for (int i = TIDX; i < L; i += NTHREADS) zs[i] = hin[((size_t)(0 * 2 + b) * 256 + c) * L + i];
      __syncthreads();
      float acc[16];
#pragma unroll
      for (int j = 0; j < 16; ++j) acc[j] = 0.f;
      if ((int)TIDX < L) {
        const float* tb = Ts + L + TIDX;
        if (!isc) {
          for (int s = 0; s < SEQ; ++s) {
            const float zv = zs[s];
#pragma unroll
            for (int j = 0; j < 16; ++j) acc[j] += tb[j * NTHREADS - s] * zv;
          }
        } else {
          for (int s = 0; s < CTXL; ++s) acc[0] += tb[-s] * zs[s];
        }
      }
      __syncthreads();
      const float* xg = hin + ((size_t)((1 + order) * 2 + b) * 256 + c) * L;
#pragma unroll
      for (int j = 0; j < 16; ++j) {
        const int t = TIDX + j * NTHREADS;
        if (t < L) {
          const float y = xg[t] * acc[j];
          if (order == 0) zs[t] = y;
          else { const size_t row = isc ? (size_t)NLAT + b * CTXL + t : (size_t)b * SEQ + t; mix[row * DM + 768 + c] = f2bf(y); }
        }
      }
    }
  }
}

namespace att {
constexpr int NW = 8, QBLK = 32, KVBLK = 64;
constexpr float SCALE = 0.10206207261596575f;
constexpr float THR = 8.f;
constexpr int SHM_V = KVBLK * 128 * 2, SHM_K = KVBLK * 128 * 2;
constexpr int SHM_ATTN = 2 * SHM_V + 2 * SHM_K + NW * 64 * 4;
#define KSWZ(row, colB) ((row) * 256 + ((colB) ^ (((row) & 7) << 4)))
#define SBAR() __builtin_amdgcn_sched_barrier(0)
template <int VAR> __device__ __forceinline__ float ex2(float x) { if constexpr (VAR == 2) return x; else return __builtin_amdgcn_exp2f(x); }
template <int VAR> __device__ __forceinline__ void partialSM(f32x16& p0, f32x16& p1, float& m_reg, float& mn, float& alpha) {
  constexpr float C = SCALE * 1.4426950408889634f;
  float pmax = p0[0];
#pragma unroll
  for (int r = 1; r < 16; ++r) pmax = fmaxf(pmax, p0[r]);
#pragma unroll
  for (int r = 0; r < 16; ++r) pmax = fmaxf(pmax, p1[r]);
  { auto rr = __builtin_amdgcn_permlane32_swap(__float_as_uint(pmax), __float_as_uint(pmax), false, false);
    pmax = fmaxf(__uint_as_float(rr[0]), __uint_as_float(rr[1])); }
  if (__builtin_expect(__all(pmax - m_reg <= THR / SCALE), 1)) { mn = m_reg; alpha = 1.f; }
  else { mn = fmaxf(m_reg, pmax); alpha = __builtin_amdgcn_exp2f((m_reg - mn) * C); m_reg = mn; }
  const float mnC = -mn * C;
#pragma unroll
  for (int r = 0; r < 16; ++r) p0[r] = fmaf(p0[r], C, mnC);
#pragma unroll
  for (int r = 0; r < 16; ++r) p1[r] = fmaf(p1[r], C, mnC);
#pragma unroll
  for (int r = 0; r < 16; ++r) p0[r] = ex2<VAR>(p0[r]);
}
template <int VAR> __device__ __forceinline__ void finishSM(f32x16& p0, f32x16& p1, float alpha, float& l_reg, bf16x8& pa0, bf16x8& pa1, bf16x8& pa2, bf16x8& pa3) {
#pragma unroll
  for (int r = 0; r < 16; ++r) p1[r] = ex2<VAR>(p1[r]);
  float ps = 0;
#pragma unroll
  for (int r = 0; r < 16; ++r) ps += p0[r];
#pragma unroll
  for (int r = 0; r < 16; ++r) ps += p1[r];
  { auto rr = __builtin_amdgcn_permlane32_swap(__float_as_uint(ps), __float_as_uint(ps), false, false);
    ps = __uint_as_float(rr[0]) + __uint_as_float(rr[1]); }
  l_reg = l_reg * alpha + ps;
#define PK4(P, BASE, OUT) do { unsigned a0 = cvtpk(P[BASE + 0], P[BASE + 1]), a1 = cvtpk(P[BASE + 2], P[BASE + 3]);   \
    unsigned b0 = cvtpk(P[BASE + 4], P[BASE + 5]), b1 = cvtpk(P[BASE + 6], P[BASE + 7]);                              \
    auto r0 = __builtin_amdgcn_permlane32_swap(a0, b0, false, false); auto r1 = __builtin_amdgcn_permlane32_swap(a1, b1, false, false); \
    u32x4 w = {r0[0], r1[0], r0[1], r1[1]}; OUT = *reinterpret_cast<bf16x8*>(&w); } while (0)
  PK4(p0, 0, pa0); PK4(p0, 8, pa1); PK4(p1, 0, pa2); PK4(p1, 8, pa3);
#undef PK4
}
__device__ __forceinline__ void qkt(f32x16& p0, f32x16& p1, const char* Ks, const bf16x8* qr, int r32, int hi) {
  p0 = f32x16{}; p1 = f32x16{};
#pragma unroll
  for (int d0 = 0; d0 < 6; ++d0) { const int cb = (d0 * 16 + hi * 8) * 2;
    const bf16x8 b0 = *reinterpret_cast<const bf16x8*>(Ks + KSWZ(r32, cb));
    const bf16x8 b1 = *reinterpret_cast<const bf16x8*>(Ks + KSWZ(32 + r32, cb));
    p0 = __builtin_amdgcn_mfma_f32_32x32x16_bf16(b0, qr[d0], p0, 0, 0, 0);
    p1 = __builtin_amdgcn_mfma_f32_32x32x16_bf16(b1, qr[d0], p1, 0, 0, 0); }
}
__device__ __forceinline__ int v_st(int k, int c) { const int kk = (k & ~0xC) | ((k & 4) << 1) | ((k & 8) >> 1); return ((kk >> 3) * 4 + (c >> 5)) * 512 + ((kk & 7) * 32 + (c & 31)) * 2; }
__device__ __forceinline__ int v_rd_base(int lane) { return ((lane & 3) << 3) | (((lane >> 2) & 3) << 6) | (((lane >> 4) & 1) << 5) | (((lane >> 5) & 1) << 8); }
constexpr int v_rd_off(int d0, int ks, int half) { return d0 * 512 + ks * 4096 + half * 2048; }
template <int OFF> __device__ __forceinline__ s16x4 tr_read(int vb) {
  s16x4 r; asm volatile("ds_read_b64_tr_b16 %0, %1 offset:%2" : "=&v"(r) : "v"(vb), "i"(OFF) : "memory"); return r;
}
template <int D0> __device__ __forceinline__ void pv_one(f32x16& od, int vb, bf16x8 pa0, bf16x8 pa1, bf16x8 pa2, bf16x8 pa3) {
  const s16x4 l0 = tr_read<v_rd_off(D0, 0, 0)>(vb), h0 = tr_read<v_rd_off(D0, 0, 1)>(vb), l1 = tr_read<v_rd_off(D0, 1, 0)>(vb), h1 = tr_read<v_rd_off(D0, 1, 1)>(vb);
  const s16x4 l2 = tr_read<v_rd_off(D0, 2, 0)>(vb), h2 = tr_read<v_rd_off(D0, 2, 1)>(vb), l3 = tr_read<v_rd_off(D0, 3, 0)>(vb), h3 = tr_read<v_rd_off(D0, 3, 1)>(vb);
  asm volatile("s_waitcnt lgkmcnt(0)" ::: "memory"); SBAR();
#define PK(L, H) (bf16x8){L[0], L[1], L[2], L[3], H[0], H[1], H[2], H[3]}
  od = __builtin_amdgcn_mfma_f32_32x32x16_bf16(pa0, PK(l0, h0), od, 0, 0, 0);
  od = __builtin_amdgcn_mfma_f32_32x32x16_bf16(pa1, PK(l1, h1), od, 0, 0, 0);
  od = __builtin_amdgcn_mfma_f32_32x32x16_bf16(pa2, PK(l2, h2), od, 0, 0, 0);
  od = __builtin_amdgcn_mfma_f32_32x32x16_bf16(pa3, PK(l3, h3), od, 0, 0, 0);
#undef PK
}
__device__ __forceinline__ void pv_d0(f32x16& o0, f32x16& o1, int vb, bf16x8 pa0, bf16x8 pa1, bf16x8 pa2, bf16x8 pa3) {
  pv_one<0>(o0, vb, pa0, pa1, pa2, pa3); pv_one<1>(o1, vb, pa0, pa1, pa2, pa3);
}
template <int VAR>
__device__ __forceinline__ void attn_body(const bf16_t* __restrict__ Qb, const bf16_t* __restrict__ KVh, const bf16_t* __restrict__ KR, int bsel, int key0,
                                          bf16_t* __restrict__ Ob, float* __restrict__ Op, float* __restrict__ Oml, int seq, char* lds) {
  const int tid = TIDX, wid = tid >> 6, lane = tid & 63, r32 = lane & 31, hi = lane >> 5;
  char* V_lds = lds; char* K_lds = lds + 2 * SHM_V;
  float* ws = (float*)(lds + 2 * SHM_V + 2 * SHM_K) + wid * 64; float* li_l = ws; float* al_l = ws + 32;
  float m_reg = -1e30f, l_reg = 0; f32x16 o0 = {}, o1 = {}; bf16x8 qr[6];
  const bf16_t* Qw = Qb + (size_t)(wid * QBLK + r32) * 576 + hi * 8;
#pragma unroll
  for (int d0 = 0; d0 < 6; ++d0) qr[d0] = *(const bf16x8*)(Qw + d0 * 16);
  const int sr = tid >> 4, sc = (tid & 15) * 8, vst0 = v_st(sr, sc & 63), vst1 = v_st(32 + sr, sc & 63);
  const int vb0 = (int)(uintptr_t)V_lds + v_rd_base(lane);
  const bool kact = sc < 96, vact = sc < 64;
  bf16x8 vs0 = {}, vs1 = {}, ks0 = {}, ks1 = {};
#define SLOAD(k0) do { const int kk_ = key0 + (k0); const size_t rb_ = (size_t)((kk_ < CTXL) ? NLAT + bsel * CTXL + kk_ : bsel * SEQ + kk_ - CTXL) + sr; \
    if (vact) { vs0 = *(const bf16x8*)(KVh + rb_ * 768 + 64 + sc); vs1 = *(const bf16x8*)(KVh + (rb_ + 32) * 768 + 64 + sc); } \
    if (kact) { if (sc < 64) { ks0 = *(const bf16x8*)(KVh + rb_ * 768 + sc); ks1 = *(const bf16x8*)(KVh + (rb_ + 32) * 768 + sc); } \
                else { ks0 = *(const bf16x8*)(KR + rb_ * 32 + (sc - 64)); ks1 = *(const bf16x8*)(KR + (rb_ + 32) * 32 + (sc - 64)); } } } while (0)
#define SWRITE(b) do { if (vact) { *(bf16x8*)(V_lds + (b) * SHM_V + vst0) = vs0; *(bf16x8*)(V_lds + (b) * SHM_V + vst1) = vs1; } \
    if (kact) { const int kc = sc * 2; *(bf16x8*)(K_lds + (b) * SHM_K + KSWZ(sr, kc)) = ks0; *(bf16x8*)(K_lds + (b) * SHM_K + KSWZ(32 + sr, kc)) = ks1; } } while (0)
#define SWAIT() asm volatile("s_waitcnt vmcnt(0)" ::: "memory")
#define RESC(a) do { if (__any((a) < 1.f)) { if (hi == 0) al_l[r32] = (a); asm volatile("s_waitcnt lgkmcnt(0)" ::: "memory"); \
    _Pragma("unroll") for (int r = 0; r < 16; ++r) { const float f = al_l[crow(r, hi)]; o0[r] *= f; o1[r] *= f; } } } while (0)
  f32x16 pA0, pA1, pB0, pB1; float mnA, mnB, alA, alB; bf16x8 pa0, pa1, pa2, pa3; const int NT = seq / KVBLK;
  __syncthreads();
  SLOAD(0); SWAIT(); SWRITE(0); __syncthreads();
  qkt(pA0, pA1, K_lds, qr, r32, hi); partialSM<VAR>(pA0, pA1, m_reg, mnA, alA);
  SLOAD(KVBLK);
  SWAIT(); SWRITE(1); __syncthreads();
#define LSYNC() do { if constexpr (VAR != 1) __syncthreads(); } while (0)
#define LLOAD(k0) do { if constexpr (VAR != 3) SLOAD(k0); } while (0)
#define LWRITE(b) do { if constexpr (VAR != 3) { SWAIT(); SWRITE(b); } } while (0)
#define LPV(O0, O1, VB) do { if constexpr (VAR != 5) pv_d0(O0, O1, VB, pa0, pa1, pa2, pa3); else { asm volatile("" :: "v"(pa0), "v"(pa1), "v"(pa2), "v"(pa3)); } } while (0)
  const int wodd = __builtin_amdgcn_readfirstlane(wid) & 1;
#define HALF_IT(PN0, PN1, MN, AN, PO0, PO1, AO, KB, VB) do { \
    if (!wodd) { qkt(PN0, PN1, KB, qr, r32, hi); finishSM<VAR>(PO0, PO1, AO, l_reg, pa0, pa1, pa2, pa3); SBAR(); LPV(o0, o1, VB); partialSM<VAR>(PN0, PN1, m_reg, MN, AN); } \
    else { finishSM<VAR>(PO0, PO1, AO, l_reg, pa0, pa1, pa2, pa3); SBAR(); qkt(PN0, PN1, KB, qr, r32, hi); SBAR(); partialSM<VAR>(PN0, PN1, m_reg, MN, AN); SBAR(); LPV(o0, o1, VB); } } while (0)
  for (int j = 1; j + 1 < NT; j += 2) {
    SBAR(); LLOAD((j + 1) * KVBLK); SBAR();
    HALF_IT(pB0, pB1, mnB, alB, pA0, pA1, alA, K_lds + SHM_K, vb0);
    LSYNC(); LWRITE(0);
    RESC(alB); LSYNC();
    SBAR(); LLOAD((j + 2) * KVBLK); SBAR();
    HALF_IT(pA0, pA1, mnA, alA, pB0, pB1, alB, K_lds, vb0 + SHM_V);
    LSYNC(); LWRITE(1);
    RESC(alA); LSYNC();
  }
#undef HALF_IT
#undef LSYNC
#undef LLOAD
#undef LWRITE
#undef LPV
  SBAR(); qkt(pB0, pB1, K_lds + SHM_K, qr, r32, hi);
  finishSM<VAR>(pA0, pA1, alA, l_reg, pa0, pa1, pa2, pa3); SBAR();
  pv_d0(o0, o1, vb0, pa0, pa1, pa2, pa3); partialSM<VAR>(pB0, pB1, m_reg, mnB, alB);
  __syncthreads(); RESC(alB);
  finishSM<VAR>(pB0, pB1, alB, l_reg, pa0, pa1, pa2, pa3); SBAR();
  pv_d0(o0, o1, vb0 + SHM_V, pa0, pa1, pa2, pa3);
  if (Op != nullptr) {
    float* Pw = Op + (size_t)(wid * QBLK) * 64;
#pragma unroll
    for (int r = 0; r < 16; ++r) { const int orow = crow(r, hi); Pw[(size_t)orow * 64 + r32] = o0[r]; Pw[(size_t)orow * 64 + 32 + r32] = o1[r]; }
    if (hi == 0) { Oml[(size_t)(wid * QBLK + r32) * 2] = m_reg; Oml[(size_t)(wid * QBLK + r32) * 2 + 1] = l_reg; }
  } else {
    if (hi == 0) li_l[r32] = l_reg; asm volatile("s_waitcnt lgkmcnt(0)" ::: "memory");
    bf16_t* Ow = Ob + (size_t)(wid * QBLK) * DM;
#pragma unroll
    for (int r = 0; r < 16; ++r) { const int orow = crow(r, hi); const float rl = __builtin_amdgcn_rcpf(li_l[orow]);
      Ow[(size_t)orow * DM + r32] = f2bf(o0[r] * rl); Ow[(size_t)orow * DM + 32 + r32] = f2bf(o1[r] * rl); }
  }
#undef SLOAD
#undef SWRITE
#undef SWAIT
#undef RESC
}
}

template <int VAR = 0, bool ATT_DUMMY = false>
__device__ __forceinline__ void attn_units(const Params& p, int layer, char* smem) {
  const bf16_t* Q = (const bf16_t*)(p.ws + OFF_Q);
  const bf16_t* KV = (const bf16_t*)(p.ws + OFF_K); const bf16_t* KR = (const bf16_t*)(p.ws + OFF_V);
  bf16_t* mix = (bf16_t*)(p.ws + OFF_MIX); float* opart = (float*)(p.ws + OFF_OPART); float* oml = (float*)(p.ws + OFF_OML);
  const int nunits = 512 + ((layer == 0) ? 12 : 0);
  for (int unit = BIDX; unit < nunits; unit += gridDim.x) {
    const bf16_t *qp, *kvp; bf16_t* ob; float* op = nullptr; float* ml = nullptr; int seq, bsel, key0 = 0;
    if (unit < 256) {
      const int bh = unit & 7, qb = unit >> 3, b = bh / 6, h = bh % 6;
      qp = Q + ((size_t)b * SEQ + qb * 256) * 576 + h * 96; kvp = KV + h * 128; bsel = b;
      ob = mix + ((size_t)b * SEQ + qb * 256) * DM + 384 + h * 64; seq = NKEYS;
    } else if (unit < 512) {
      const int v = unit - 256, bhi = v & 3, half = (v >> 2) & 1, qb = v >> 3, bh = 8 + bhi, b = bh / 6, h = bh % 6;
      qp = Q + ((size_t)b * SEQ + qb * 256) * 576 + h * 96; kvp = KV + h * 128; bsel = b; key0 = half * (NKEYS / 2);
      ob = mix; op = opart + ((size_t)(bhi * 2 + half) * SEQ + qb * 256) * 64; ml = oml + ((size_t)(bhi * 2 + half) * SEQ + qb * 256) * 2; seq = NKEYS / 2;
    } else {
      const int bh = unit - 512, b = bh / 6, h = bh % 6;
      qp = Q + ((size_t)NLAT + b * CTXL) * 576 + h * 96; kvp = KV + h * 128; bsel = b;
      ob = mix + ((size_t)NLAT + b * CTXL) * DM + 384 + h * 64; seq = CTXL;
    }
    if constexpr (VAR != 0 || ATT_DUMMY) {
      ob = (bf16_t*)(p.ws + OFF_HB) + (size_t)(unit & 63) * 256 * DM; if (op) { op = (float*)(p.ws + OFF_HB) + (size_t)(unit & 63) * 256 * 64; ml = op; }
    }
    att::attn_body<VAR>(qp, kvp, KR, bsel, key0, ob, op, ml, seq, smem);
  }
}
__device__ void attn_combine(const Params& p) {
  const int lane = TIDX & 63, wid = TIDX >> 6;
  const float* opart = (const float*)(p.ws + OFF_OPART); const float* oml = (const float*)(p.ws + OFF_OML); bf16_t* mix = (bf16_t*)(p.ws + OFF_MIX);
  constexpr float C = att::SCALE * 1.4426950408889634f;
  for (int grp = BIDX * 8 + wid; grp < 4 * SEQ / 4; grp += gridDim.x * 8) {
    const int idx0 = grp * 4, bhi = idx0 >> 13, q0 = idx0 & (SEQ - 1), bh = 8 + bhi, b = bh / 6, h = bh % 6;
    const size_t r0 = (size_t)(bhi * 2) * SEQ + q0, r1 = r0 + SEQ;
    float m0[4], l0[4], m1[4], l1[4], o0[4], o1[4];
#pragma unroll
    for (int j = 0; j < 4; ++j) {
      m0[j] = oml[(r0 + j) * 2]; l0[j] = oml[(r0 + j) * 2 + 1]; m1[j] = oml[(r1 + j) * 2]; l1[j] = oml[(r1 + j) * 2 + 1];
      o0[j] = opart[(r0 + j) * 64 + lane]; o1[j] = opart[(r1 + j) * 64 + lane];
    }
#pragma unroll
    for (int j = 0; j < 4; ++j) {
      const float m = fmaxf(m0[j], m1[j]), f0 = __builtin_amdgcn_exp2f((m0[j] - m) * C), f1 = __builtin_amdgcn_exp2f((m1[j] - m) * C);
      const float o = (o0[j] * f0 + o1[j] * f1) / (l0[j] * f0 + l1[j] * f1);
      mix[((size_t)b * SEQ + q0 + j) * DM + 384 + h * 64 + lane] = f2bf(o);
    }
  }
}

#define CEK(a, b) { const unsigned _h = max(k[a], k[b]), _l = min(k[a], k[b]); k[a] = _h; k[b] = _l; }
__device__ __forceinline__ void sort16k(unsigned* k) {
  CEK(0,1) CEK(2,3) CEK(0,2) CEK(1,3) CEK(1,2) CEK(4,5) CEK(6,7) CEK(4,6)
  CEK(5,7) CEK(5,6) CEK(0,4) CEK(2,6) CEK(2,4) CEK(1,5) CEK(3,7) CEK(3,5)
  CEK(1,2) CEK(3,4) CEK(5,6) CEK(8,9) CEK(10,11) CEK(8,10) CEK(9,11) CEK(9,10)
  CEK(12,13) CEK(14,15) CEK(12,14) CEK(13,15) CEK(13,14) CEK(8,12) CEK(10,14) CEK(10,12)
  CEK(9,13) CEK(11,15) CEK(11,13) CEK(9,10) CEK(11,12) CEK(13,14) CEK(0,8) CEK(4,12)
  CEK(4,8) CEK(2,10) CEK(6,14) CEK(6,10) CEK(2,4) CEK(6,8) CEK(10,12) CEK(1,9)
  CEK(5,13) CEK(5,9) CEK(3,11) CEK(7,15) CEK(7,11) CEK(3,5) CEK(7,9) CEK(11,13)
  CEK(1,2) CEK(3,4) CEK(5,6) CEK(7,8) CEK(9,10) CEK(11,12) CEK(13,14)
}
__device__ __forceinline__ void bmerge16k(unsigned* k) {
  CEK(0,8) CEK(1,9) CEK(2,10) CEK(3,11) CEK(4,12) CEK(5,13) CEK(6,14) CEK(7,15)
  CEK(0,4) CEK(1,5) CEK(2,6) CEK(3,7) CEK(8,12) CEK(9,13) CEK(10,14) CEK(11,15)
  CEK(0,2) CEK(1,3) CEK(4,6) CEK(5,7) CEK(8,10) CEK(9,11) CEK(12,14) CEK(13,15)
  CEK(0,1) CEK(2,3) CEK(4,5) CEK(6,7) CEK(8,9) CEK(10,11) CEK(12,13) CEK(14,15)
}
#undef CEK
#define CEP(a, b) { const bool _s = v[a] < v[b]; const float _va = _s ? v[b] : v[a], _vb = _s ? v[a] : v[b]; const int _pa = _s ? pl[b] : pl[a], _pb = _s ? pl[a] : pl[b]; \
                    v[a] = _va; v[b] = _vb; pl[a] = _pa; pl[b] = _pb; }
__device__ __forceinline__ void sort16p(float* v, int* pl) {
  CEP(0,1) CEP(2,3) CEP(0,2) CEP(1,3)
  CEP(1,2) CEP(4,5) CEP(6,7) CEP(4,6)
  CEP(5,7) CEP(5,6) CEP(0,4) CEP(2,6)
  CEP(2,4) CEP(1,5) CEP(3,7) CEP(3,5)
  CEP(1,2) CEP(3,4) CEP(5,6) CEP(8,9)
  CEP(10,11) CEP(8,10) CEP(9,11) CEP(9,10)
  CEP(12,13) CEP(14,15) CEP(12,14) CEP(13,15)
  CEP(13,14) CEP(8,12) CEP(10,14) CEP(10,12)
  CEP(9,13) CEP(11,15) CEP(11,13) CEP(9,10)
  CEP(11,12) CEP(13,14) CEP(0,8) CEP(4,12)
  CEP(4,8) CEP(2,10) CEP(6,14) CEP(6,10)
  CEP(2,4) CEP(6,8) CEP(10,12) CEP(1,9)
  CEP(5,13) CEP(5,9) CEP(3,11) CEP(7,15)
  CEP(7,11) CEP(3,5) CEP(7,9) CEP(11,13)
  CEP(1,2) CEP(3,4) CEP(5,6) CEP(7,8)
  CEP(9,10) CEP(11,12) CEP(13,14)
}
__device__ __forceinline__ void bmerge16p(float* v, int* pl) {
  CEP(0,8) CEP(1,9) CEP(2,10) CEP(3,11)
  CEP(4,12) CEP(5,13) CEP(6,14) CEP(7,15)
  CEP(0,4) CEP(1,5) CEP(2,6) CEP(3,7)
  CEP(8,12) CEP(9,13) CEP(10,14) CEP(11,15)
  CEP(0,2) CEP(1,3) CEP(4,6) CEP(5,7)
  CEP(8,10) CEP(9,11) CEP(12,14) CEP(13,15)
  CEP(0,1) CEP(2,3) CEP(4,5) CEP(6,7)
  CEP(8,9) CEP(10,11) CEP(12,13) CEP(14,15)
}
#undef CEP
__device__ __forceinline__ unsigned fkey(float f, int low7) { unsigned u = __float_as_uint(f); u ^= (unsigned)((int)u >> 31) | 0x80000000u; return (u & ~127u) | (unsigned)low7; }
__device__ __forceinline__ float funkey(unsigned k) { unsigned u = k & ~127u; u ^= (u & 0x80000000u) ? 0x80000000u : 0xFFFFFFFFu; return __uint_as_float(u); }
__device__ __forceinline__ void peer_half_top16(const char* __restrict__ kl  , int r32, const bf16_t* __restrict__ qp, int hi, unsigned* T) {
  bf16x8 bq[8]; int kofs[8];
#pragma unroll
  for (int ks = 0; ks < 8; ++ks) { bq[ks] = *(const bf16x8*)(qp + ks * 16); kofs[ks] = r32 * 256 + (((ks * 16 + hi * 8) * 2) ^ ((r32 & 7) << 4)); }
  unsigned L[16];
#pragma unroll
  for (int mt = 0; mt < 4; ++mt) {
    f32x16 acc = {};
#pragma unroll
    for (int ks = 0; ks < 8; ++ks) {
      const bf16x8 a = *(const bf16x8*)(kl + mt * 8192 + kofs[ks]);
      acc = __builtin_amdgcn_mfma_f32_32x32x16_bf16(a, bq[ks], acc, 0, 0, 0);
    }
    unsigned k[16];
#pragma unroll
    for (int r = 0; r < 16; ++r) k[r] = fkey(acc[r], 127 - (mt * 32 + (r & 3) + 8 * (r >> 2) + 4 * hi));
    sort16k(k);
    if (mt == 0) {
#pragma unroll
      for (int i = 0; i < 16; ++i) L[i] = k[i];
    } else {
#pragma unroll
      for (int i = 0; i < 16; ++i) L[i] = max(L[i], k[15 - i]);
      bmerge16k(L);
    }
  }
#pragma unroll
  for (int i = 0; i < 16; ++i) {
    const auto rr = __builtin_amdgcn_permlane32_swap(L[15 - i], L[15 - i], false, false);
    const unsigned partner = hi ? rr[0] : rr[1];
    T[i] = max(L[i], partner);
  }
  bmerge16k(T);
}
__device__ void peer_topk(const Params& p, int layer, int nrows, char* smem) {
  const int tid = TIDX, wid = tid >> 6, lane = tid & 63, r32 = lane & 31, hi = lane >> 5;
  const bf16_t* pq = (const bf16_t*)(p.ws + OFF_PQ);
  const bf16_t* keys = (const bf16_t*)(p.ws + OFF_KEYS) + (size_t)layer * 2 * 128 * 128;
  int* eid = (int*)(p.ws + OFF_EID); float* gate = (float*)(p.ws + OFF_GATE);
  __syncthreads();
  for (int i = tid; i < 4096; i += NTHREADS) {
    const int half = i >> 11, key = (i >> 4) & 127, c16 = i & 15;
    *(u32x4*)(smem + half * 32768 + KSWZ(key, c16 * 16)) = *(const u32x4*)(keys + (size_t)(half * 128 + key) * 128 + c16 * 8);
  }
  __syncthreads();
  const int ntask = (nrows / 32) * 8;
  for (int task = BIDX * 8 + wid; task < ntask; task += gridDim.x * 8) {
    const int grp = task >> 3, h = task & 7;
    const size_t row = (size_t)grp * 32 + r32;
    unsigned K1[16], K2[16];
    const int lofs = launder_v(0);
    peer_half_top16(smem + lofs, r32, pq + row * 2048 + h * 256 + hi * 8, hi, K1);
    peer_half_top16(smem + lofs + 32768, r32, pq + row * 2048 + h * 256 + 128 + hi * 8, hi, K2);
    float v1[16], v2[16]; int i1[16], i2[16];
#pragma unroll
    for (int i = 0; i < 16; ++i) { v1[i] = funkey(K1[i]); v2[i] = funkey(K2[i]); i1[i] = 127 - (int)(K1[i] & 127u); i2[i] = 127 - (int)(K2[i] & 127u); }
    float ts[16]; int tp[16];
    {
      float* cv = ts; int* cp = tp;
    cv[0] = v1[0] + v2[0]; cp[0] = (i1[0] << 7) | i2[0];
    cv[1] = v1[0] + v2[1]; cp[1] = (i1[0] << 7) | i2[1];
    cv[2] = v1[0] + v2[2]; cp[2] = (i1[0] << 7) | i2[2];
    cv[3] = v1[0] + v2[3]; cp[3] = (i1[0] << 7) | i2[3];
    cv[4] = v1[0] + v2[4]; cp[4] = (i1[0] << 7) | i2[4];
    cv[5] = v1[0] + v2[5]; cp[5] = (i1[0] << 7) | i2[5];
    cv[6] = v1[0] + v2[6]; cp[6] = (i1[0] << 7) | i2[6];
    cv[7] = v1[0] + v2[7]; cp[7] = (i1[0] << 7) | i2[7];
    cv[8] = v1[0] + v2[8]; cp[8] = (i1[0] << 7) | i2[8];
    cv[9] = v1[0] + v2[9]; cp[9] = (i1[0] << 7) | i2[9];
    cv[10] = v1[0] + v2[10]; cp[10] = (i1[0] << 7) | i2[10];
    cv[11] = v1[0] + v2[11]; cp[11] = (i1[0] << 7) | i2[11];
    cv[12] = v1[0] + v2[12]; cp[12] = (i1[0] << 7) | i2[12];
    cv[13] = v1[0] + v2[13]; cp[13] = (i1[0] << 7) | i2[13];
    cv[14] = v1[0] + v2[14]; cp[14] = (i1[0] << 7) | i2[14];
    cv[15] = v1[0] + v2[15]; cp[15] = (i1[0] << 7) | i2[15];
      sort16p(ts, tp);
    }
#pragma unroll 1
    for (int g = 1; g < 3; ++g) {
      float cv[16]; int cp[16];
      if (g == 1) {
    cv[0] = v1[1] + v2[0]; cp[0] = (i1[1] << 7) | i2[0];
    cv[1] = v1[1] + v2[1]; cp[1] = (i1[1] << 7) | i2[1];
    cv[2] = v1[1] + v2[2]; cp[2] = (i1[1] << 7) | i2[2];
    cv[3] = v1[1] + v2[3]; cp[3] = (i1[1] << 7) | i2[3];
    cv[4] = v1[1] + v2[4]; cp[4] = (i1[1] << 7) | i2[4];
    cv[5] = v1[1] + v2[5]; cp[5] = (i1[1] << 7) | i2[5];
    cv[6] = v1[1] + v2[6]; cp[6] = (i1[1] << 7) | i2[6];
    cv[7] = v1[1] + v2[7]; cp[7] = (i1[1] << 7) | i2[7];
    cv[8] = v1[2] + v2[0]; cp[8] = (i1[2] << 7) | i2[0];
    cv[9] = v1[2] + v2[1]; cp[9] = (i1[2] << 7) | i2[1];
    cv[10] = v1[2] + v2[2]; cp[10] = (i1[2] << 7) | i2[2];
    cv[11] = v1[2] + v2[3]; cp[11] = (i1[2] << 7) | i2[3];
    cv[12] = v1[2] + v2[4]; cp[12] = (i1[2] << 7) | i2[4];
    cv[13] = v1[3] + v2[0]; cp[13] = (i1[3] << 7) | i2[0];
    cv[14] = v1[3] + v2[1]; cp[14] = (i1[3] << 7) | i2[1];
    cv[15] = v1[3] + v2[2]; cp[15] = (i1[3] << 7) | i2[2];
      } else {
    cv[0] = v1[3] + v2[3]; cp[0] = (i1[3] << 7) | i2[3];
    cv[1] = v1[4] + v2[0]; cp[1] = (i1[4] << 7) | i2[0];
    cv[2] = v1[4] + v2[1]; cp[2] = (i1[4] << 7) | i2[1];
    cv[3] = v1[4] + v2[2]; cp[3] = (i1[4] << 7) | i2[2];
    cv[4] = v1[5] + v2[0]; cp[4] = (i1[5] << 7) | i2[0];
    cv[5] = v1[5] + v2[1]; cp[5] = (i1[5] << 7) | i2[1];
    cv[6] = v1[6] + v2[0]; cp[6] = (i1[6] << 7) | i2[0];
    cv[7] = v1[6] + v2[1]; cp[7] = (i1[6] << 7) | i2[1];
    cv[8] = v1[7] + v2[0]; cp[8] = (i1[7] << 7) | i2[0];
    cv[9] = v1[7] + v2[1]; cp[9] = (i1[7] << 7) | i2[1];
    cv[10] = v1[8] + v2[0]; cp[10] = (i1[8] << 7) | i2[0];
    cv[11] = v1[9] + v2[0]; cp[11] = (i1[9] << 7) | i2[0];
    cv[12] = v1[10] + v2[0]; cp[12] = (i1[10] << 7) | i2[0];
    cv[13] = v1[11] + v2[0]; cp[13] = (i1[11] << 7) | i2[0];
    cv[14] = v1[12] + v2[0]; cp[14] = (i1[12] << 7) | i2[0];
    cv[15] = v1[13] + v2[0]; cp[15] = (i1[13] << 7) | i2[0];
      }
      sort16p(cv, cp);
#pragma unroll
      for (int i = 0; i < 16; ++i) if (cv[15 - i] > ts[i]) { ts[i] = cv[15 - i]; tp[i] = cp[15 - i]; }
      bmerge16p(ts, tp);
    }
    {
      float cv[2]; int cp[2];
    cv[0] = v1[14] + v2[0]; cp[0] = (i1[14] << 7) | i2[0];
    cv[1] = v1[15] + v2[0]; cp[1] = (i1[15] << 7) | i2[0];
      if (cv[0] < cv[1]) { const float tv = cv[0]; cv[0] = cv[1]; cv[1] = tv; const int ti = cp[0]; cp[0] = cp[1]; cp[1] = ti; }
      if (cv[1] > ts[14]) { ts[14] = cv[1]; tp[14] = cp[1]; }
      if (cv[0] > ts[15]) { ts[15] = cv[0]; tp[15] = cp[0]; }
      bmerge16p(ts, tp);
    }
    float ex[16], sm = 0.f;
#pragma unroll
    for (int i = 0; i < 16; ++i) { ex[i] = __expf(ts[i] - ts[0]); sm += ex[i]; }
    const float rs = 1.f / sm;
    if (hi == 0) {
      int* eo = eid + row * 128 + h * 16;
#pragma unroll
      for (int i = 0; i < 4; ++i) { const u32x4 o = {(unsigned)tp[4 * i], (unsigned)tp[4 * i + 1], (unsigned)tp[4 * i + 2], (unsigned)tp[4 * i + 3]}; *(u32x4*)(eo + 4 * i) = o; }
    } else {
      float* go = gate + row * 128 + h * 16;
#pragma unroll
      for (int i = 0; i < 4; ++i) { const f32x4 o = {ex[4 * i] * rs, ex[4 * i + 1] * rs, ex[4 * i + 2] * rs, ex[4 * i + 3] * rs}; *(f32x4*)(go + 4 * i) = o; }
    }
  }
}

constexpr float PEER_USCALE = 16.f;
__device__ void peer_cvt_tables(const Params& p, int layer, int rank, int nb) {
  const float* ut = p.in[I_PU] + (size_t)layer * 16384 * DM; const float* vt = p.in[I_PV] + (size_t)layer * 16384 * DM;
  u32x4* uo = (u32x4*)(p.ws + OFF_UTAB); u32x4* vo = (u32x4*)(p.ws + OFF_VTAB);
  const int n16 = 16384 * DM / 16, stride = nb * NTHREADS;
  for (int i = rank * NTHREADS + TIDX; i < 2 * n16; i += 2 * stride) {
    f32x4 a[2][4];
#pragma unroll
    for (int k = 0; k < 2; ++k) {
      const int ii = i + k * stride;
      if (ii < 2 * n16) {
        const bool isv = ii >= n16; const int j = isv ? ii - n16 : ii;
        const float* s = (isv ? vt : ut) + (size_t)j * 16;
#pragma unroll
        for (int q = 0; q < 4; ++q) a[k][q] = *(const f32x4*)(s + 4 * q);
      }
    }
#pragma unroll
    for (int k = 0; k < 2; ++k) {
      const int ii = i + k * stride;
      if (ii < 2 * n16) {
        const bool isv = ii >= n16; const int j = isv ? ii - n16 : ii; const float sc = isv ? 1.f : PEER_USCALE;
        u32x4 o;
#pragma unroll
        for (int q = 0; q < 4; ++q) {
          int w = __builtin_amdgcn_cvt_pk_fp8_f32(a[k][q][0] * sc, a[k][q][1] * sc, 0, false);
          w = __builtin_amdgcn_cvt_pk_fp8_f32(a[k][q][2] * sc, a[k][q][3] * sc, w, true);
          o[q] = (unsigned)w;
        }
        (isv ? vo : uo)[j] = o;
      }
    }
  }
}

__device__ __forceinline__ int xcc_slice() { return (int)((unsigned)__builtin_amdgcn_s_getreg((3 << 11) | 20) & 7u); }
__device__ __forceinline__ float row16_sum(float v) { v += dpp_mov<0xB1>(v); v += dpp_mov<0x4E>(v); v += dpp_mov<0x141>(v); v += dpp_mov<0x128>(v); return v; }
constexpr int PNS = 8;
constexpr int PSEGL = 8;
constexpr int PEPL = 64 / PSEGL;
constexpr int PNI = 128 / PEPL;
constexpr int PCOLS = 1024 / PNS;
using f32x2 = __attribute__((ext_vector_type(2))) float;
template <int PHASE>
__device__ void peer_sliced(const Params& p, int layer, int nrows) {
#if defined(PROBE_PEER_REP)
  int nrep = (PHASE == PROBE_PEER_REP) ? 2 : 1; asm volatile("" : "+s"(nrep));
#else
  constexpr int nrep = 1;
#endif
  for (int rep = 0; rep < nrep; ++rep) {
  const int dry = (rep + 1 < nrep) ? 1 : 0;
  const int lane = TIDX & 63, eg = lane / PSEGL, ch = lane % PSEGL;
  const bf16_t* hb = (const bf16_t*)(p.ws + OFF_HB);
  const int* eid = (const int*)(p.ws + OFF_EID);
  const unsigned char* tab = (const unsigned char*)(p.ws + (PHASE == 0 ? OFF_UTAB : OFF_VTAB)) + ch * 16;
  float* sp = (float*)(p.ws + OFF_SP); const float* wbuf = (const float*)(p.ws + OFF_WBUF);
  float* xs = (float*)(p.ws + OFF_XS);
  unsigned* ctr = (unsigned*)(p.ws + OFF_CTR) + (size_t)(((rep * 2 + layer) * 2 + PHASE) * 16) * 64;
  const int x0 = xcc_slice();
  const int bpa = eg << 2;
  for (int si = 0; si < PNS; ++si) {
    const int slice = (x0 + si) % PNS;
    int nbase = 0;
    if (lane == 0) nbase = (int)__hip_atomic_fetch_add(&ctr[slice * 64], 4u, __ATOMIC_RELAXED, __HIP_MEMORY_SCOPE_AGENT);
    for (;;) {
      const int base = __builtin_amdgcn_readfirstlane(nbase);
      if (base >= nrows) break;
      if (lane == 0) nbase = (int)__hip_atomic_fetch_add(&ctr[slice * 64], 4u, __ATOMIC_RELAXED, __HIP_MEMORY_SCOPE_AGENT);
      int eA = eid[(size_t)base * 128 + lane], eB = eid[(size_t)base * 128 + 64 + lane];
      float wA = 0.f, wB = 0.f;
      if (PHASE == 1) { wA = wbuf[(size_t)base * 128 + lane]; wB = wbuf[(size_t)base * 128 + 64 + lane]; }
#pragma unroll 1
      for (int tt = 0; tt < 4; ++tt) {
        const int r = base + tt;
        const int ceA = eA, ceB = eB; const float cwA = wA, cwB = wB;
        if (tt < 3) {
          eA = eid[(size_t)(r + 1) * 128 + lane]; eB = eid[(size_t)(r + 1) * 128 + 64 + lane];
          if (PHASE == 1) { wA = wbuf[(size_t)(r + 1) * 128 + lane]; wB = wbuf[(size_t)(r + 1) * 128 + 64 + lane]; }
        }
        int ev[PNI];
#pragma unroll
        for (int i = 0; i < PNI; ++i) ev[i] = __builtin_amdgcn_ds_bpermute(bpa + 32 * (i & 7), (i < 8) ? ceA : ceB);
        if (PHASE == 0) {
          float xv[16];
          {
            const u32x4 xa = *(const u32x4*)(hb + (size_t)r * DM + slice * PCOLS + ch * 16), xb = *(const u32x4*)(hb + (size_t)r * DM + slice * PCOLS + ch * 16 + 8);
#pragma unroll
            for (int q = 0; q < 4; ++q) { xv[2 * q] = __uint_as_float(xa[q] << 16); xv[2 * q + 1] = __uint_as_float(xa[q] & 0xffff0000u);
                                          xv[8 + 2 * q] = __uint_as_float(xb[q] << 16); xv[8 + 2 * q + 1] = __uint_as_float(xb[q] & 0xffff0000u); }
          }
          u32x4 uv[PNI];
#pragma unroll
          for (int j = 0; j < PNI; ++j) uv[j] = *(const u32x4*)(tab + (size_t)ev[j] * DM + slice * PCOLS);
          float keep0 = 0.f, keep1 = 0.f;
#pragma unroll
          for (int j = 0; j < PNI; ++j) {
            float d = 0.f;
#pragma unroll
            for (int q = 0; q < 4; ++q) {
              const f32x2 lo = __builtin_amdgcn_cvt_pk_f32_fp8((int)uv[j][q], false), hi2 = __builtin_amdgcn_cvt_pk_f32_fp8((int)uv[j][q], true);
              d += lo[0] * xv[4 * q] + lo[1] * xv[4 * q + 1] + hi2[0] * xv[4 * q + 2] + hi2[1] * xv[4 * q + 3];
            }
            d += dpp_mov<0xB1>(d); d += dpp_mov<0x4E>(d); d += dpp_mov<0x141>(d);
            if (ch == (j % PSEGL)) { if (j < PSEGL) keep0 = d; else keep1 = d; }
          }
          float* so = sp + ((size_t)slice * NTOK + r) * 128 + PEPL * ch + eg;
          so[0] = keep0 * (1.f / PEER_USCALE); so[64] = keep1 * (1.f / PEER_USCALE);
        } else {
          u32x4 vv[PNI];
#pragma unroll
          for (int j = 0; j < PNI; ++j) vv[j] = *(const u32x4*)(tab + (size_t)ev[j] * DM + slice * PCOLS);
          float acc[16];
#pragma unroll
          for (int j = 0; j < 16; ++j) acc[j] = 0.f;
#pragma unroll
          for (int j = 0; j < PNI; ++j) {
            const float w = __int_as_float(__builtin_amdgcn_ds_bpermute(bpa + 32 * (j & 7), __float_as_int((j < 8) ? cwA : cwB)));
#pragma unroll
            for (int q = 0; q < 4; ++q) {
              const f32x2 lo = __builtin_amdgcn_cvt_pk_f32_fp8((int)vv[j][q], false), hi2 = __builtin_amdgcn_cvt_pk_f32_fp8((int)vv[j][q], true);
              acc[4 * q] += w * lo[0]; acc[4 * q + 1] += w * lo[1]; acc[4 * q + 2] += w * hi2[0]; acc[4 * q + 3] += w * hi2[1];
            }
          }
#pragma unroll
          for (int j = 0; j < 16; ++j) {
            acc[j] += dpp_mov<0x128>(acc[j]);
            { auto rr = __builtin_amdgcn_permlane16_swap(__float_as_uint(acc[j]), __float_as_uint(acc[j]), false, false); acc[j] = __uint_as_float(rr[0]) + __uint_as_float(rr[1]); }
            { auto rr = __builtin_amdgcn_permlane32_swap(__float_as_uint(acc[j]), __float_as_uint(acc[j]), false, false); acc[j] = __uint_as_float(rr[0]) + __uint_as_float(rr[1]); }
          }
          if (eg == 0) {
            int b, t, isc; row_info(r, b, t, isc);
            const float* g2 = (const float*)(p.ws + OFF_MOD) + ((size_t)layer * 3 + (isc ? 2 : b)) * 6144 + 5120 + slice * PCOLS + ch * 16;
            float* xr = xs + (size_t)r * DM + slice * PCOLS + ch * 16;
#pragma unroll
            for (int q = 0; q < 4; ++q) {
              f32x4 xq = *(const f32x4*)(xr + 4 * q);
#pragma unroll
              for (int j = 0; j < 4; ++j) xq[j] += g2[4 * q + j] * acc[4 * q + j];
              if (dry == 0) *(f32x4*)(xr + 4 * q) = xq;
            }
          }
        }
      }
    }
  }
  }
}
__device__ void peer_weights(const Params& p, int nrows) {
  const float* sp = (const float*)(p.ws + OFF_SP); const float* gate = (const float*)(p.ws + OFF_GATE); float* wbuf = (float*)(p.ws + OFF_WBUF);
  for (int i = BIDX * NTHREADS + TIDX; i < nrows * 128; i += gridDim.x * NTHREADS) {
    float s = 0.f;
#pragma unroll
    for (int x = 0; x < PNS; ++x) s += sp[(size_t)x * NTOK * 128 + i];
    wbuf[i] = gate[i] * gelu_tanh(s);
  }
}

__device__ void peer_eval_fused(const Params& p, int layer, int nrows, char* smem) {
  const int tid = TIDX, wid = tid >> 6, lane = tid & 63, eg = lane >> 3, ch = lane & 7;
  const int ntb = nrows / (int)gridDim.x, tok0 = BIDX * ntb;
  float* S = (float*)smem;
  int* E = (int*)(smem + 72 * 128 * 4);
  const bf16_t* hb = (const bf16_t*)(p.ws + OFF_HB);
  const int* eid = (const int*)(p.ws + OFF_EID); const float* gate = (const float*)(p.ws + OFF_GATE);
  const unsigned char* utab = (const unsigned char*)(p.ws + OFF_UTAB) + ch * 16; const unsigned char* vtab = (const unsigned char*)(p.ws + OFF_VTAB) + ch * 16;
  float* xs = (float*)(p.ws + OFF_XS);
  __syncthreads();
  for (int i = tid; i < ntb * 128; i += NTHREADS) { S[i] = 0.f; E[i] = eid[(size_t)tok0 * 128 + i]; }
  __syncthreads();
#pragma unroll 1
  for (int it = wid; it < ntb * 8; it += 8) {
    const int slice = it / ntb, tl = it - slice * ntb, r = tok0 + tl;
    int ev[16];
#pragma unroll
    for (int j = 0; j < 16; ++j) ev[j] = E[tl * 128 + 8 * j + eg];
    float xv[16];
    {
      const u32x4 xa = *(const u32x4*)(hb + (size_t)r * DM + slice * 128 + ch * 16), xb = *(const u32x4*)(hb + (size_t)r * DM + slice * 128 + ch * 16 + 8);
#pragma unroll
      for (int q = 0; q < 4; ++q) { xv[2 * q] = __uint_as_float(xa[q] << 16); xv[2 * q + 1] = __uint_as_float(xa[q] & 0xffff0000u);
                                    xv[8 + 2 * q] = __uint_as_float(xb[q] << 16); xv[8 + 2 * q + 1] = __uint_as_float(xb[q] & 0xffff0000u); }
    }
    u32x4 uv[16];
#pragma unroll
    for (int j = 0; j < 16; ++j) uv[j] = *(const u32x4*)(utab + (size_t)ev[j] * DM + slice * 128);
    float keep0 = 0.f, keep1 = 0.f;
#pragma unroll
    for (int j = 0; j < 16; ++j) {
      float d = 0.f;
#pragma unroll
      for (int q = 0; q < 4; ++q) {
        const f32x2 lo = __builtin_amdgcn_cvt_pk_f32_fp8((int)uv[j][q], false), hi2 = __builtin_amdgcn_cvt_pk_f32_fp8((int)uv[j][q], true);
        d += lo[0] * xv[4 * q] + lo[1] * xv[4 * q + 1] + hi2[0] * xv[4 * q + 2] + hi2[1] * xv[4 * q + 3];
      }
      d += dpp_mov<0xB1>(d); d += dpp_mov<0x4E>(d); d += dpp_mov<0x141>(d);
      if (ch == (j & 7)) { if (j < 8) keep0 = d; else keep1 = d; }
    }
    atomicAdd(&S[tl * 128 + 8 * ch + eg], keep0); atomicAdd(&S[tl * 128 + 64 + 8 * ch + eg], keep1);
  }
  __syncthreads();
  for (int i = tid; i < ntb * 128; i += NTHREADS) S[i] = gate[(size_t)tok0 * 128 + i] * gelu_tanh(S[i] * (1.f / PEER_USCALE));
  __syncthreads();
#pragma unroll 1
  for (int it = wid; it < ntb * 8; it += 8) {
    const int slice = it / ntb, tl = it - slice * ntb, r = tok0 + tl;
    int ev[16]; float wv[16];
#pragma unroll
    for (int j = 0; j < 16; ++j) { ev[j] = E[tl * 128 + 8 * j + eg]; wv[j] = S[tl * 128 + 8 * j + eg]; }
    u32x4 vv[16];
#pragma unroll
    for (int j = 0; j < 16; ++j) vv[j] = *(const u32x4*)(vtab + (size_t)ev[j] * DM + slice * 128);
    float acc[16];
#pragma unroll
    for (int j = 0; j < 16; ++j) acc[j] = 0.f;
#pragma unroll
    for (int j = 0; j < 16; ++j) {
      const float w = wv[j];
#pragma unroll
      for (int q = 0; q < 4; ++q) {
        const f32x2 lo = __builtin_amdgcn_cvt_pk_f32_fp8((int)vv[j][q], false), hi2 = __builtin_amdgcn_cvt_pk_f32_fp8((int)vv[j][q], true);
        acc[4 * q] += w * lo[0]; acc[4 * q + 1] += w * lo[1]; acc[4 * q + 2] += w * hi2[0]; acc[4 * q + 3] += w * hi2[1];
      }
    }
#pragma unroll
    for (int j = 0; j < 16; ++j) {
      acc[j] += dpp_mov<0x128>(acc[j]);
      { auto rr = __builtin_amdgcn_permlane16_swap(__float_as_uint(acc[j]), __float_as_uint(acc[j]), false, false); acc[j] = __uint_as_float(rr[0]) + __uint_as_float(rr[1]); }
      { auto rr = __builtin_amdgcn_permlane32_swap(__float_as_uint(acc[j]), __float_as_uint(acc[j]), false, false); acc[j] = __uint_as_float(rr[0]) + __uint_as_float(rr[1]); }
    }
    if (eg == 0) {
      int b, t, isc; row_info(r, b, t, isc);
      const float* g2 = (const float*)(p.ws + OFF_MOD) + ((size_t)layer * 3 + (isc ? 2 : b)) * 6144 + 5120 + slice * 128 + ch * 16;
      float* xr = xs + (size_t)r * DM + slice * 128 + ch * 16;
#pragma unroll
      for (int q = 0; q < 4; ++q) {
        f32x4 xq = *(const f32x4*)(xr + 4 * q);
#pragma unroll
        for (int j = 0; j < 4; ++j) xq[j] += g2[4 * q + j] * acc[4 * q + j];
        *(f32x4*)(xr + 4 * q) = xq;
      }
    }
  }
  __syncthreads();
  {
    const bool last = (layer == 1);
    const float* g = last ? p.in[I_FG] : p.in[I_N1G] + (layer + 1) * DM;
    bf16_t* hbw = (bf16_t*)(p.ws + OFF_HB);
#pragma unroll 1
    for (int tl0 = wid * 3; tl0 < ntb; tl0 += 24) {
      f32x4 v[3][4]; float ss[3]; const float* modj[3];
#pragma unroll
      for (int j = 0; j < 3; ++j) {
        int b, t, isc; row_info(min(tok0 + tl0 + j, tok0 + ntb - 1), b, t, isc);
        modj[j] = (const float*)(p.ws + OFF_MOD) + ((size_t)(last ? 1 : layer + 1) * 3 + (isc ? 2 : b)) * 6144;
      }
#pragma unroll
      for (int j = 0; j < 3; ++j) {
        const int r = min(tok0 + tl0 + j, tok0 + ntb - 1);
        ss[j] = 0.f;
#pragma unroll
        for (int i = 0; i < 4; ++i) { v[j][i] = *(const f32x4*)(xs + (size_t)r * DM + (i * 64 + lane) * 4); ss[j] += v[j][i][0] * v[j][i][0] + v[j][i][1] * v[j][i][1] + v[j][i][2] * v[j][i][2] + v[j][i][3] * v[j][i][3]; }
      }
#pragma unroll
      for (int j = 0; j < 3; ++j) ss[j] = rsqrtf(wave_sum(ss[j]) * (1.f / DM) + EPSV);
#pragma unroll
      for (int i = 0; i < 4; ++i) {
        const int c0 = (i * 64 + lane) * 4; const f32x4 gv = *(const f32x4*)(g + c0);
#pragma unroll
        for (int j = 0; j < 3; ++j) {
          const int r = tok0 + tl0 + j;
          if (tl0 + j < ntb) {
            if (last) { if (r < NLAT) *(f32x4*)(p.out + (size_t)r * DM + c0) = v[j][i] * ss[j] * gv; }
            else {
              const f32x4 sc = *(const f32x4*)(modj[j] + 1024 + c0), sh = *(const f32x4*)(modj[j] + c0);
              float y[4];
#pragma unroll
              for (int q = 0; q < 4; ++q) y[q] = v[j][i][q] * ss[j] * gv[q] * (1.f + sc[q]) + sh[q];
              const u32x2 o = {cvtpk(y[0], y[1]), cvtpk(y[2], y[3])};
              *(u32x2*)(hbw + (size_t)r * DM + c0) = o;
            }
          }
        }
      }
    }
  }
}

__device__ void final_norm(const Params& p) {
  const int lane = TIDX & 63, wid = TIDX >> 6;
  const float* xs = (const float*)(p.ws + OFF_XS); const float* g = p.in[I_FG];
  for (int grp = BIDX * 8 + wid; grp < NLAT / 4; grp += gridDim.x * 8) {
    const int r0 = grp * 4;
    f32x4 v[4][4]; float ss[4];
#pragma unroll
    for (int j = 0; j < 4; ++j) {
      ss[j] = 0.f;
#pragma unroll
      for (int i = 0; i < 4; ++i) { v[j][i] = *(const f32x4*)(xs + (size_t)(r0 + j) * DM + (i * 64 + lane) * 4); ss[j] += v[j][i][0] * v[j][i][0] + v[j][i][1] * v[j][i][1] + v[j][i][2] * v[j][i][2] + v[j][i][3] * v[j][i][3]; }
    }
#pragma unroll
    for (int j = 0; j < 4; ++j) ss[j] = rsqrtf(wave_sum(ss[j]) * (1.f / DM) + EPSV);
#pragma unroll
    for (int i = 0; i < 4; ++i) {
      const int c0 = (i * 64 + lane) * 4; const f32x4 gv = *(const f32x4*)(g + c0);
#pragma unroll
      for (int j = 0; j < 4; ++j) { const f32x4 o = v[j][i] * ss[j] * gv; *(f32x4*)(p.out + (size_t)(r0 + j) * DM + c0) = o; }
    }
  }
}

namespace pg8 {
#define PG8_LAS __attribute__((address_space(3)))
typedef unsigned short bf16_t;
typedef short bf16x8 __attribute__((ext_vector_type(8)));
typedef float f32x4 __attribute__((ext_vector_type(4)));
typedef unsigned u32x4 __attribute__((ext_vector_type(4)));
constexpr int BM = 256, BK = 64, HALF = 128, HTB = HALF * BK * 2  , STAGE_BYTES = 8 * HTB, NXCD = 8, WGM = 8;

__host__ __device__ __forceinline__ int lds_byte(int r, int c) { const int st = (r >> 4) * 2 + (c >> 5), rr = r & 15, cc = c & 31, ob = rr * 64 + cc * 2; return st * 1024 + (ob ^ (((ob >> 9) & 1) << 5)); }
__host__ __device__ __forceinline__ void stage_rc(int b, int& R, int& C) { const int st = b / 1024, sb = b % 1024, swz = sb ^ (((sb >> 9) & 1) << 5); R = (st >> 1) * 16 + swz / 64; C = (st & 1) * 32 + (swz % 64) / 2; }
__host__ __device__ __forceinline__ int perm32(int rho) { const int n = rho >> 4, i = rho & 15; return 8 * (i >> 2) + 4 * n + (i & 3); }

struct Unit { int pm, pn; };
struct Gemm { const bf16_t* A; const bf16_t* Bt; int M, N, K; };

struct StaticOrder {
    int nM, nN, nwg, G, c;
    __host__ __device__ void init(int M, int N, int G_, int c_) { nM = M / BM; nN = N / BM; nwg = nM * nN; G = G_; c = c_; }
    __host__ __device__ bool next(int i, Unit& u) const {
        const long L = (long)i * G + c; if (L >= nwg) return false;
        int wgid = (int)L; { const int q = nwg / NXCD, r = nwg % NXCD, xcd = wgid % NXCD, off = wgid / NXCD; wgid = (xcd < r ? xcd * (q + 1) : r * (q + 1) + (xcd - r) * q) + off; }
        const int nig = WGM * nN, gid = wgid / nig, fm = gid * WGM, gsz = (nM - fm) < WGM ? (nM - fm) : WGM;
        u.pm = fm + ((wgid % nig) % gsz); u.pn = (wgid % nig) / gsz; return true;
    }
    __device__ __forceinline__ void a_ready(const Unit&) const {}
    __device__ __forceinline__ void done(const Unit&) const {}
};
template <class Epi, class Sched, bool STAMP = false>
__device__ __forceinline__ void gemm_phase(PG8_LAS unsigned char* lds, const Gemm g, const Sched& S, const Epi& E, unsigned long long* stamps) {
    const int tid = launder_v((int)threadIdx.x)  , wid = __builtin_amdgcn_readfirstlane(tid >> 6), lane = tid & 63, wr = wid >> 2, wc = wid & 3, fr = lane & 15, fq = lane >> 4;
    const int K = g.K, nt = K / BK;
    int ts_lo = 0, ts_hi = 0, nts = 0; const unsigned long long rt_entry = STAMP ? 0ull : 0ull;
#define PG8_STAMP() do { if (STAMP && wid == 0 && nts < 64) { const unsigned long long _c = 0ull; \
        ts_lo = (lane == nts) ? (int)(unsigned)_c : ts_lo; ts_hi = (lane == nts) ? (int)(unsigned)(_c >> 32) : ts_hi; ++nts; } } while (0)
    PG8_STAMP();
    unsigned voffA[2], voffB[2];
#pragma unroll
    for (int i = 0; i < 2; ++i) { int R, C; stage_rc(tid * 16 + i * 8192, R, C); const int Rb = Epi::PERM ? ((R & ~31) + perm32(R & 31)) : R;
        voffA[i] = (unsigned)(R * K + C) * 2u; voffB[i] = (unsigned)(Rb * K + C) * 2u; }
    const size_t kstep = (size_t)(BK * 2);
    const size_t hstep = (size_t)HALF * K * 2;
    const size_t tstep = 2 * hstep;
    const unsigned ldsw = (unsigned)wid * 1024u;
    const int aoff = lds_byte(wr * 64 + fr, fq * 8), boff = launder_v(lds_byte(wc * 32 + fr, fq * 8) + 4 * HTB);
#define PG8_SA(b, h) (((b) * 2 + (h)) * HTB)
#define PG8_SB(b, h) ((4 + (b) * 2 + (h)) * HTB)
#define PG8_STAGE(bufoff, gbase, voff) do { _Pragma("unroll") for (int _i = 0; _i < 2; ++_i) \
        __builtin_amdgcn_global_load_lds((const unsigned*)((const char*)(gbase) + (voff)[_i]), (PG8_LAS unsigned*)(lds + (bufoff) + ldsw + _i * 8192), 16, 0, 0); } while (0)
#define PG8_LDA(dst, b, h) do { _Pragma("unroll") for (int m = 0; m < 4; ++m) _Pragma("unroll") for (int k = 0; k < 2; ++k) dst[m][k] = *(const PG8_LAS bf16x8*)(lds + PG8_SA(b, h) + aoff + m * 2048 + k * 1024); } while (0)
#define PG8_LDB(dst, b, h) do { _Pragma("unroll") for (int n = 0; n < 2; ++n) _Pragma("unroll") for (int k = 0; k < 2; ++k) dst[n][k] = *(const PG8_LAS bf16x8*)(lds + boff + ((b) * 2 + (h)) * HTB + n * 2048 + k * 1024); } while (0)
#define PG8_MMA(ai, bj, At, Bt) do { __builtin_amdgcn_s_setprio(1); _Pragma("unroll") for (int m = 0; m < 4; ++m) _Pragma("unroll") for (int n = 0; n < 2; ++n) _Pragma("unroll") for (int k = 0; k < 2; ++k) \
        acc[ai][bj][m][n] = __builtin_amdgcn_mfma_f32_16x16x32_bf16(Bt[n][k], At[m][k], acc[ai][bj][m][n], 0, 0, 0); __builtin_amdgcn_s_setprio(0); } while (0)
#define PG8_WAIT_V(n) asm volatile("s_waitcnt vmcnt(" #n ")" ::: "memory")
#define PG8_WAIT_L(n) asm volatile("s_waitcnt lgkmcnt(" #n ")" ::: "memory")
#define PG8_BAR __builtin_amdgcn_s_barrier()
#define PG8_SCHED __builtin_amdgcn_sched_barrier(0)
    Unit cur, nxt; int ui = 0;
    if (!S.next(0, cur)) return;
    f32x4 acc[2][2][4][2];
#pragma unroll
    for (int a = 0; a < 2; ++a)
#pragma unroll
        for (int b = 0; b < 2; ++b)
#pragma unroll
            for (int m = 0; m < 4; ++m)
#pragma unroll
                for (int n = 0; n < 2; ++n) acc[a][b][m][n] = (f32x4){0.f, 0.f, 0.f, 0.f};
    bf16x8 At[4][2], B0[2][2], B1[2][2];
    const char* cA = (const char*)g.A + (size_t)cur.pm * tstep; const char* cB = (const char*)g.Bt + (size_t)cur.pn * tstep;
    S.a_ready(cur);
    PG8_STAGE(PG8_SB(0, 0), cB, voffB); PG8_STAGE(PG8_SA(0, 0), cA, voffA); PG8_STAGE(PG8_SB(0, 1), cB + hstep, voffB); PG8_STAGE(PG8_SA(0, 1), cA + hstep, voffA);
    if (wr == 1) PG8_BAR;
    PG8_WAIT_V(4); PG8_BAR;
    PG8_STAGE(PG8_SB(1, 0), cB + kstep, voffB); PG8_STAGE(PG8_SA(1, 0), cA + kstep, voffA); PG8_STAGE(PG8_SB(1, 1), cB + hstep + kstep, voffB);
    PG8_WAIT_V(6); PG8_BAR;
    PG8_STAMP();
    for (;;) {
        const bool has_next = S.next(ui + 1, nxt);
        const char* nA = has_next ? (const char*)g.A + (size_t)nxt.pm * tstep : cA; const char* nB = has_next ? (const char*)g.Bt + (size_t)nxt.pn * tstep : cB;
        for (int t = 0; t < nt; t += 2) {
            const bool last = (t == nt - 2);
            const char* a1 = cA + (size_t)(t + 1) * kstep;
            const char* a2 = last ? nA : cA + (size_t)(t + 2) * kstep; const char* b2 = last ? nB : cB + (size_t)(t + 2) * kstep;
            const char* a3 = a2 + kstep; const char* b3 = b2 + kstep;
            if (last && has_next) S.a_ready(nxt);
            PG8_LDB(B0, 0, 0); PG8_SCHED; PG8_LDA(At, 0, 0); PG8_STAGE(PG8_SA(1, 1), a1 + hstep, voffA);
            PG8_WAIT_L(8); PG8_BAR; PG8_WAIT_L(0); PG8_MMA(0, 0, At, B0); PG8_BAR; PG8_SCHED;
            PG8_LDB(B1, 0, 1); PG8_STAGE(PG8_SB(0, 0), b2, voffB);
            PG8_BAR; PG8_WAIT_L(0); PG8_MMA(0, 1, At, B1); PG8_BAR;
            PG8_LDA(At, 0, 1); PG8_STAGE(PG8_SA(0, 0), a2, voffA);
            PG8_BAR; PG8_WAIT_L(0); PG8_MMA(1, 0, At, B0); PG8_BAR; PG8_SCHED;
            PG8_STAGE(PG8_SB(0, 1), b2 + hstep, voffB);
            PG8_WAIT_V(6); PG8_BAR; PG8_MMA(1, 1, At, B1); PG8_BAR;
            PG8_LDB(B0, 1, 0); PG8_SCHED; PG8_LDA(At, 1, 0); PG8_STAGE(PG8_SA(0, 1), a2 + hstep, voffA);
            PG8_WAIT_L(8); PG8_BAR; PG8_WAIT_L(0); PG8_MMA(0, 0, At, B0); PG8_BAR; PG8_SCHED;
            PG8_LDB(B1, 1, 1); PG8_STAGE(PG8_SB(1, 0), b3, voffB);
            PG8_BAR; PG8_WAIT_L(0); PG8_MMA(0, 1, At, B1); PG8_BAR;
            PG8_LDA(At, 1, 1); PG8_STAGE(PG8_SA(1, 0), a3, voffA);
            PG8_BAR; PG8_WAIT_L(0); PG8_MMA(1, 0, At, B0); PG8_BAR; PG8_SCHED;
            PG8_STAGE(PG8_SB(1, 1), b3 + hstep, voffB);
            PG8_WAIT_V(6); PG8_BAR; PG8_MMA(1, 1, At, B1); PG8_BAR;
        }
        PG8_STAMP();
        if constexpr (!Epi::AFTER_DRAIN) { E(acc, cur, wr, wc, fr, fq); S.done(cur); }
        PG8_STAMP();
        if (!has_next) break;
#pragma unroll
        for (int a = 0; a < 2; ++a)
#pragma unroll
            for (int b = 0; b < 2; ++b)
#pragma unroll
                for (int m = 0; m < 4; ++m)
#pragma unroll
                    for (int n = 0; n < 2; ++n) acc[a][b][m][n] = (f32x4){0.f, 0.f, 0.f, 0.f};
        cur = nxt; cA = nA; cB = nB; ++ui;
    }
    PG8_WAIT_V(0);
    if (wr == 0) PG8_BAR;
    PG8_BAR;
    if constexpr (Epi::AFTER_DRAIN) { E.fused(acc, cur, wr, wc, fr, fq, lds, wid, lane); S.done(cur); }
    PG8_STAMP();
    if (STAMP && wid == 0) { stamps[lane] = lane < nts ? (((unsigned long long)(unsigned)ts_hi << 32) | (unsigned)ts_lo) : 0ull;
        if (lane == 62) stamps[62] = rt_entry; if (lane == 63) stamps[63] = 0ull; }
#undef PG8_STAMP
#undef PG8_SA
#undef PG8_SB
#undef PG8_STAGE
#undef PG8_LDA
#undef PG8_LDB
#undef PG8_MMA
#undef PG8_WAIT_V
#undef PG8_WAIT_L
#undef PG8_BAR
#undef PG8_SCHED
}
}

template <class F> struct EpiFn {
  static constexpr bool PERM = false, AFTER_DRAIN = false;
  F f;
  __device__ __forceinline__ void operator()(const pg8::f32x4 (&acc)[2][2][4][2], const pg8::Unit& u, int wr, int wc, int fr, int fq) const {
#pragma unroll
    for (int ai = 0; ai < 2; ++ai)
#pragma unroll
      for (int m = 0; m < 4; ++m) {
        const int row = u.pm * 256 + ai * 128 + wr * 64 + m * 16 + fr;
#pragma unroll
        for (int bj = 0; bj < 2; ++bj)
#pragma unroll
          for (int n = 0; n < 2; ++n) f(row, u.pn * 256 + bj * 128 + wc * 32 + n * 16 + 4 * fq, acc[ai][bj][m][n]);
      }
  }
};
template <int NN> struct RowMajorOrder {
  int nwg, G, c;
  __device__ __forceinline__ bool next(int i, pg8::Unit& u) const { const int L = i * G + c; if (L >= nwg) return false; u.pm = L / NN; u.pn = L - u.pm * NN; return true; }
  __device__ __forceinline__ void a_ready(const pg8::Unit&) const {}
  __device__ __forceinline__ void done(const pg8::Unit&) const {}
};
template <class F> struct EpiFn8 {
  static constexpr bool PERM = true, AFTER_DRAIN = false;
  F f;
  __device__ __forceinline__ void operator()(const pg8::f32x4 (&acc)[2][2][4][2], const pg8::Unit& u, int wr, int wc, int fr_, int fq_) const {
    const int fr = launder_v(fr_), fq = launder_v(fq_);
#pragma unroll
    for (int ai = 0; ai < 2; ++ai)
#pragma unroll
      for (int m = 0; m < 4; ++m) {
        const int row = u.pm * 256 + ai * 128 + wr * 64 + m * 16 + fr;
#pragma unroll
        for (int bj = 0; bj < 2; ++bj) f(row, u.pn * 256 + bj * 128 + wc * 32 + 8 * fq, acc[ai][bj][m][0], acc[ai][bj][m][1]);
      }
  }
};
template <int N, class F>
__device__ __forceinline__ void gemm256p(const bf16_t* A, const bf16_t* Bt, int M, int K, F f, char* smem) {
  pg8::Gemm g; g.A = A; g.Bt = Bt; g.M = M; g.N = N; g.K = K;
  RowMajorOrder<N / 256> S; S.nwg = (M / 256) * (N / 256); S.G = (int)gridDim.x; S.c = BIDX;
  EpiFn8<F> E{f};
  __syncthreads();
  pg8::gemm_phase<EpiFn8<F>, RowMajorOrder<N / 256>, false>((PG8_LAS unsigned char*)smem, g, S, E, nullptr);
  __syncthreads();
}
template <int N, class F>
__device__ __forceinline__ void gemm256(const bf16_t* A, const bf16_t* Bt, int M, int K, F f, char* smem) {
  pg8::Gemm g; g.A = A; g.Bt = Bt; g.M = M; g.N = N; g.K = K;
  RowMajorOrder<N / 256> S; S.nwg = (M / 256) * (N / 256); S.G = (int)gridDim.x; S.c = BIDX;
  EpiFn<F> E{f};
  __syncthreads();
  pg8::gemm_phase<EpiFn<F>, RowMajorOrder<N / 256>, false>((PG8_LAS unsigned char*)smem, g, S, E, nullptr);
  __syncthreads();
}

#define XB_TMO      128
#define XB_XCNT(j)  (256  + 64 * (j))
#define XB_XSUB(j)  (1280 + 64 * (j))
#define XB_XGEN(j)  (2304 + 64 * (j))
#define XB_TOP      3328
#define XB_TOPGEN   3392
#define XCD_BAR_WORDS 3456
#define XB_SPIN_CAP (1u << 22)
#define LAS __attribute__((address_space(3)))
__device__ __forceinline__ unsigned xb_ld(unsigned* p)              { return __hip_atomic_load(p, __ATOMIC_RELAXED, __HIP_MEMORY_SCOPE_AGENT); }
__device__ __forceinline__ unsigned xb_add(unsigned* p, unsigned v) { return __hip_atomic_fetch_add(p, v, __ATOMIC_RELAXED, __HIP_MEMORY_SCOPE_AGENT); }
__device__ __forceinline__ unsigned xb_xcc_id() { return (unsigned)__builtin_amdgcn_s_getreg((3 << 11) | 20) & 0xFu; }
#define XB_SPIN(cond, bar) do { unsigned _sp = 0; while (cond) { __builtin_amdgcn_s_sleep(1); \
    if ((++_sp & 255u) == 0u) { if (xb_ld(&(bar)[XB_TMO])) break; if (_sp > XB_SPIN_CAP) { atomicAdd(&(bar)[XB_TMO], 1u); break; } } } } while (0)
struct XcdBarrier { unsigned* bar; unsigned x; volatile LAS unsigned* st; };
__device__ __forceinline__ XcdBarrier xcd_barrier_post(unsigned* bar, volatile LAS unsigned* st) {
  XcdBarrier b; b.bar = bar; b.x = xb_xcc_id(); b.st = st;
  if (threadIdx.x == 0) (void)xb_add(&bar[XB_XCNT(b.x)], 1u);
  return b;
}
__device__ __forceinline__ void xcd_barrier_complete(unsigned* bar, unsigned x, unsigned& nloc, unsigned& nx) {
  const unsigned G = gridDim.x * gridDim.y * gridDim.z;
  unsigned sum, cnt, mine, sp = 0u;
  for (;;) {
    sum = 0u; cnt = 0u; mine = 0u;
#pragma unroll
    for (unsigned j = 0; j < 16; ++j) { const unsigned c = xb_ld(&bar[XB_XCNT(j)]); sum += c; cnt += (c > 0u) ? 1u : 0u; mine = (j == x) ? c : mine; }
    if (sum == G) break;
    __builtin_amdgcn_s_sleep(1);
    if ((++sp & 255u) == 0u) { if (xb_ld(&bar[XB_TMO])) break; if (sp > XB_SPIN_CAP) { atomicAdd(&bar[XB_TMO], 1u); break; } }
  }
  nloc = mine > 0u ? mine : 1u; nx = cnt > 0u ? cnt : 1u;
}
__device__ __forceinline__ void xcd_barrier(const XcdBarrier& b) {
  asm volatile("s_waitcnt vmcnt(0)" ::: "memory");
  __syncthreads();
  if (threadIdx.x == 0) {
    unsigned* bar = b.bar;
    __builtin_amdgcn_s_waitcnt(0);
    unsigned nloc = b.st[0], nx = b.st[1];
    if (nloc == 0u) { xcd_barrier_complete(bar, b.x, nloc, nx); b.st[0] = nloc; b.st[1] = nx; }
    const unsigned old = xb_add(&bar[XB_XSUB(b.x)], 1u);
    const unsigned gen = old / nloc;
    if (old + 1u == (gen + 1u) * nloc) {
      __builtin_amdgcn_fence(__ATOMIC_RELEASE, "agent");
      asm volatile("s_waitcnt vmcnt(0)" ::: "memory");
      const unsigned og = xb_add(&bar[XB_TOP], 1u);
      const unsigned tg = og / nx;
      if (og + 1u == (tg + 1u) * nx) xb_add(&bar[XB_TOPGEN], 1u);
      else XB_SPIN(xb_ld(&bar[XB_TOPGEN]) == tg, bar);
      __builtin_amdgcn_fence(__ATOMIC_ACQUIRE, "agent");
      xb_add(&bar[XB_XGEN(b.x)], 1u);
      asm volatile("s_waitcnt vmcnt(0)" ::: "memory");
    } else {
      XB_SPIN(xb_ld(&bar[XB_XGEN(b.x)]) == gen, bar);
      __builtin_amdgcn_fence(__ATOMIC_ACQUIRE, "agent");
      asm volatile("s_waitcnt vmcnt(0)" ::: "memory");
    }
  }
  __syncthreads();
}

constexpr int NSTAGES = 23;
constexpr int SMEM_BYTES = 135168;
template <int S>
__device__ __forceinline__ void run_stage_t(const Params& p0, int layer0, char* smem0) {
  Params p = p0; int layer = layer0; char* smem = smem0;
  { unsigned long long w = (unsigned long long)p0.ws, o = (unsigned long long)p0.out;
    asm volatile("" : "+s"(w), "+s"(o), "+s"(layer));
    p.ws = (char*)(__attribute__((address_space(1))) char*)w; p.out = (float*)(__attribute__((address_space(1))) float*)o; }
  const int nrows = (layer == 0) ? NTOK : NLAT;
  if constexpr (S == 100) stage_prep(p, smem);
  if constexpr (S == 101) stage_prep2(p, smem);
  if constexpr (S == 102) final_norm(p);
  if constexpr (S == 0) stage_norm(p, layer, 0, NTOK);
  if constexpr (S == 1) {
    bf16_t* u = (bf16_t*)(p.ws + OFF_U);
    gemm256p<DINP>((const bf16_t*)(p.ws + OFF_HB), (const bf16_t*)(p.ws + OFF_WIN) + (size_t)layer * DINP * 1024, NTOK, 1024,
            [=](int row, int col0, f32x4 v, f32x4 w) { if (col0 < DIN) { const u32x4 o = {cvtpk(v[0], v[1]), cvtpk(v[2], v[3]), cvtpk(w[0], w[1]), cvtpk(w[2], w[3])}; *(u32x4*)(u + (size_t)row * DIN + col0) = o; } }, smem);
    {
      const int nunits = (NTOK / 256) * (DINP / 256), G = (int)gridDim.x, rem = nunits % G, c = BIDX;
      if (rem == 0) peer_cvt_tables(p, layer, c, G); else if (c >= rem) peer_cvt_tables(p, layer, c - rem, G - rem);
    }
  }
  if constexpr (S == 2) { lru_units(p, layer, 0, smem); mla_prep(p, layer); hyena_prep(p, layer, smem);
#if defined(PROBE_S2)
    __syncthreads();
    if (PROBE_S2 == 0) lru_units(p, layer, 0, smem); else if (PROBE_S2 == 1) mla_prep(p, layer); else hyena_prep(p, layer, smem);
#endif
  }
  if constexpr (S == 3) {
    bf16_t* Q = (bf16_t*)(p.ws + OFF_Q); bf16_t* K = (bf16_t*)(p.ws + OFF_K);
    lru_carry(p, smem);
    gemm256p<768>((const bf16_t*)(p.ws + OFF_QN), (const bf16_t*)(p.ws + OFF_WQB) + (size_t)layer * 768 * 384, NTOK, 384,
            [=](int row, int col0, f32x4 v, f32x4 w) {
              if (col0 < 576) {
                const int j = col0 % 96;
                if (j >= 64 && row < NLAT) {
                  const int t = row & (SEQ - 1), i0 = (j & 8) >> 1;
                  const float pos = (j & 16) ? (float)(t & 63) : (float)(t >> 6);
#pragma unroll
                  for (int q = 0; q < 4; ++q) {
                    constexpr float R1 = 0.31622776601683794f;
                    const float invq = (q == 0 ? 1.f : q == 1 ? R1 : q == 2 ? R1 * R1 : R1 * R1 * R1) * 0.15915494309189535f;
                    const float rev = pos * (i0 ? invq * 0.01f : invq);
                    const float cs = __builtin_amdgcn_cosf(rev), sn = __builtin_amdgcn_sinf(rev);
                    if (q < 2) { const float lo = v[2 * q], hh = v[2 * q + 1]; v[2 * q] = lo * cs - hh * sn; v[2 * q + 1] = hh * cs + lo * sn; }
                    else { const float lo = w[2 * q - 4], hh = w[2 * q - 3]; w[2 * q - 4] = lo * cs - hh * sn; w[2 * q - 3] = hh * cs + lo * sn; }
                  }
                }
                const u32x4 o = {cvtpk(v[0], v[1]), cvtpk(v[2], v[3]), cvtpk(w[0], w[1]), cvtpk(w[2], w[3])};
                *(u32x4*)(Q + (size_t)row * 576 + col0) = o;
              }
            }, smem);
    gemm256p<768>((const bf16_t*)(p.ws + OFF_KVN), (const bf16_t*)(p.ws + OFF_WKVB) + (size_t)layer * 768 * 256, NTOK, 256,
            [=](int row, int col0, f32x4 v, f32x4 w) { const u32x4 o = {cvtpk(v[0], v[1]), cvtpk(v[2], v[3]), cvtpk(w[0], w[1]), cvtpk(w[2], w[3])}; *(u32x4*)(K + (size_t)row * 768 + col0) = o; }, smem);
  }
  if constexpr (S == 4) { attn_units(p, layer, smem); hyena_fft(p, layer, smem); }
  if constexpr (S == 12) { attn_combine(p); hyena_out_transpose(p, smem); hyena_direct(p, layer, smem); lru_final(p, layer, smem); }
  if constexpr (S == 5) {
    float* xs = (float*)(p.ws + OFF_XS); const float* mod = (const float*)(p.ws + OFF_MOD) + (size_t)layer * 3 * 6144;
    const float* xin = p.in[I_X]; const float* cin = p.in[I_CTX];
    const bf16_t* wo = (const bf16_t*)(p.ws + OFF_WOUT) + (size_t)layer * 1024 * 1024;
    gemm256<1024>((const bf16_t*)(p.ws + OFF_MIX), wo, NLAT, 1024,
            [=](int row, int col0, f32x4 v) {
              const float* g1 = mod + (size_t)(row >> 13) * 6144 + 2048 + col0;
              const float* src = (layer == 0) ? xin + (size_t)row * DM + col0 : xs + (size_t)row * DM + col0;
              const f32x4 s4 = *(const f32x4*)src, g4 = *(const f32x4*)g1;
              *(f32x4*)(xs + (size_t)row * DM + col0) = s4 + g4 * v;
            }, smem);
    if (layer == 0)
      gemm_bt((const bf16_t*)(p.ws + OFF_MIX) + (size_t)NLAT * DM, DM, wo, 1024, NCTX, 1024, 1024,
              [=](int row, int col, float v) {
                const float g1 = mod[(size_t)2 * 6144 + 2048 + col];
                xs[(size_t)(NLAT + row) * DM + col] = cin[(size_t)row * DM + col] + g1 * v;
              }, smem);
  }
  if constexpr (S == 6) { stage_norm(p, layer, 1, nrows); }
  if constexpr (S == 7) {
    bf16_t* pq = (bf16_t*)(p.ws + OFF_PQ);
    const bf16_t* wq = (const bf16_t*)(p.ws + OFF_WPQ) + (size_t)layer * 2048 * 1024;
    gemm256p<2048>((const bf16_t*)(p.ws + OFF_HB), wq, NLAT, 1024,
            [=](int row, int col0, f32x4 v, f32x4 w) { const u32x4 o = {cvtpk(v[0], v[1]), cvtpk(v[2], v[3]), cvtpk(w[0], w[1]), cvtpk(w[2], w[3])}; *(u32x4*)(pq + (size_t)row * 2048 + col0) = o; }, smem);
    if (layer == 0)
      gemm_bt((const bf16_t*)(p.ws + OFF_HB) + (size_t)NLAT * DM, DM, wq, 1024, NCTX, 2048, 1024,
              [=](int row, int col, float v) { pq[(size_t)(NLAT + row) * 2048 + col] = f2bf(v); }, smem);
  }
  if constexpr (S == 8) peer_topk(p, layer, nrows, smem);
  if constexpr (S == 9) peer_eval_fused(p, layer, nrows, smem);
}

__device__ __forceinline__ void init_params(Params& p, const KArgs& ka, char* smem) {
  unsigned long long* tab = (unsigned long long*)(smem + SMEM_BYTES);
  if (threadIdx.x == 0) {
#pragma unroll
    for (int i = 0; i < N_IN; ++i) tab[i] = (unsigned long long)ka.in[i];
  }
  __syncthreads();
  p.in.tab = smem + SMEM_BYTES; p.out = ka.out; p.ws = ka.ws;
}

#if MK_SINGLE
#define SYNC() xcd_barrier(xb)
__global__ void __launch_bounds__(NTHREADS) mega_kernel(KArgs ka) {
  __shared__ __attribute__((aligned(16))) char smem[SMEM_BYTES + 512];
  cg::grid_group grid = cg::this_grid();
  if (threadIdx.x == 0) *(uint4*)(smem + SMEM_BYTES + 320) = make_uint4(0u, 0u, 0u, 0u);
  Params p; init_params(p, ka, smem);
  const XcdBarrier xb = xcd_barrier_post((unsigned*)(ka.ws + OFF_BAR), (volatile LAS unsigned*)(smem + SMEM_BYTES + 320));
  run_stage_t<100>(p, 0, smem); grid.sync();
#if defined(PROBE_PREP) && PROBE_PREP == 100
  run_stage_t<100>(p, 0, smem); SYNC();
#endif
  run_stage_t<101>(p, 0, smem); SYNC();
#if defined(PROBE_BW)
  {
    const u32x4* base = (const u32x4*)(ka.ws + (size_t)64 * 1024 * 1024);
    const size_t n16 = (size_t)PROBE_BW * 64 * 1024 * 1024 / 16;
    unsigned acc_ = 0;
    for (size_t i = (size_t)blockIdx.x * NTHREADS + threadIdx.x; i + 7 * (size_t)gridDim.x * NTHREADS < n16; i += 8 * (size_t)gridDim.x * NTHREADS) {
      u32x4 t_[8];
#pragma unroll
      for (int k = 0; k < 8; ++k) t_[k] = base[i + k * (size_t)gridDim.x * NTHREADS];
#pragma unroll
      for (int k = 0; k < 8; ++k) acc_ ^= t_[k][0] ^ t_[k][1] ^ t_[k][2] ^ t_[k][3];
    }
    if (acc_ == 0x12345u) ((unsigned*)(ka.ws + OFF_BAR))[1000] = acc_;
    SYNC();
  }
#endif
#if defined(PROBE_BAR)
  SYNC(); SYNC(); SYNC(); SYNC(); SYNC(); SYNC(); SYNC(); SYNC(); SYNC(); SYNC(); SYNC(); SYNC(); SYNC(); SYNC(); SYNC(); SYNC(); SYNC(); SYNC(); SYNC(); SYNC();
#endif
#if defined(PROBE_PREP) && PROBE_PREP == 101
  run_stage_t<101>(p, 0, smem); SYNC();
#endif
#ifndef PROBE_DUP
#define PROBE_DUP -1
#endif
#define RUNSTAGE(S, layer) do { if (PROBE_DUP == S) { int nrep = 2; asm volatile("" : "+s"(nrep)); \
      for (int rep = 0; rep < nrep; ++rep) { run_stage_t<S>(p, layer, smem); SYNC(); if (S == 9 || S == 11) break; } } \
    else { run_stage_t<S>(p, layer, smem); SYNC(); } } while (0)
#if defined(PROBE_ATT)
#define PROBE_ATT_HOOK(layer) { attn_units<PROBE_ATT, true>(p, layer, smem); SYNC(); }
#else
#define PROBE_ATT_HOOK(layer)
#endif
#define LAYER_PASS(layer) \
    if (layer == 0) { RUNSTAGE(0, layer); } RUNSTAGE(1, layer); RUNSTAGE(2, layer); RUNSTAGE(3, layer); RUNSTAGE(4, layer); PROBE_ATT_HOOK(layer) RUNSTAGE(12, layer); \
    RUNSTAGE(5, layer); RUNSTAGE(6, layer); RUNSTAGE(7, layer); RUNSTAGE(8, layer); RUNSTAGE(9, layer);
  LAYER_PASS(0)
  LAYER_PASS(1)
}
#else
template <int S>
__global__ void __launch_bounds__(NTHREADS) stage_kernel(KArgs ka, int layer) {
  __shared__ __attribute__((aligned(16))) char smem[SMEM_BYTES + 512];
  Params p; init_params(p, ka, smem);
  run_stage_t<S>(p, layer, smem);
}
#endif

extern "C" void kernel_launch(void* const* d_in, const int* in_sizes, int n_in, void* d_out, int out_size, void* d_ws, size_t ws_size, hipStream_t stream) {
  if (n_in != N_IN || ws_size < WS_END) { fprintf(stderr, "kernel_launch: bad args n_in=%d ws=%zu need=%zu\n", n_in, ws_size, (size_t)WS_END); return; }
  KArgs p{};
  for (int i = 0; i < N_IN; ++i) p.in[i] = (const float*)d_in[i];
  p.out = (float*)d_out; p.ws = (char*)d_ws;
#if MK_SINGLE
  static int grid_blocks = 0;
  if (!grid_blocks) {
    int dev = 0, cus = 0, per_cu = 0;
    hipGetDevice(&dev);
    hipDeviceGetAttribute(&cus, hipDeviceAttributeMultiprocessorCount, dev);
    hipOccupancyMaxActiveBlocksPerMultiprocessor(&per_cu, mega_kernel, NTHREADS, 0);
    if (per_cu > 1) per_cu = 1;
    grid_blocks = cus * per_cu;
  }
  hipMemsetAsync((char*)d_ws + OFF_BAR, 0, BAR_BYTES, stream);
  void* args[] = {&p};
  hipError_t e = hipLaunchCooperativeKernel((void*)mega_kernel, dim3(grid_blocks), dim3(NTHREADS), args, 0, stream);
  if (e != hipSuccess) fprintf(stderr, "cooperative launch failed: %s (grid %d)\n", hipGetErrorString(e), grid_blocks);
#else
#define LAUNCH(S, L) hipLaunchKernelGGL(stage_kernel<S>, dim3(256), dim3(NTHREADS), 0, stream, p, L)
  LAUNCH(100, 0); LAUNCH(101, 0);
  for (int layer = 0; layer < 2; ++layer) {
    LAUNCH(0, layer); LAUNCH(1, layer); LAUNCH(2, layer); LAUNCH(3, layer); LAUNCH(4, layer);
    LAUNCH(5, layer); LAUNCH(6, layer); LAUNCH(7, layer); LAUNCH(8, layer); LAUNCH(9, layer);
  }
  LAUNCH(102, 0);
#endif
}
```

```cpp
#include <hip/hip_runtime.h>
#include <hip/hip_cooperative_groups.h>
#include <cstdio>
#include <cstdint>
namespace cg = cooperative_groups;

__device__ __forceinline__ int launder_v(int x) { asm volatile("" : "+v"(x)); return x; }
__device__ __forceinline__ int launder_s(int x) { asm volatile("" : "+s"(x)); return x; }
#define TIDX launder_v((int)threadIdx.x)
#define BIDX launder_s((int)blockIdx.x)

__device__ __forceinline__ float shx(float v, int mask) { const int l = TIDX & 63; return __int_as_float(__builtin_amdgcn_ds_bpermute((l ^ mask) << 2, __float_as_int(v))); }
__device__ __forceinline__ int shxi(int v, int mask) { const int l = TIDX & 63; return __builtin_amdgcn_ds_bpermute((l ^ mask) << 2, v); }
__device__ __forceinline__ float rdl(float v, int srclane) { return __int_as_float(__builtin_amdgcn_readlane(__float_as_int(v), srclane)); }

#ifndef MK_SINGLE
#define MK_SINGLE 1
#endif

typedef unsigned short bf16_t;
using bf16x8 = __attribute__((ext_vector_type(8))) short;
using s16x4  = __attribute__((ext_vector_type(4))) short;
using f32x16 = __attribute__((ext_vector_type(16))) float;
using f32x4  = __attribute__((ext_vector_type(4))) float;
using u32x4  = __attribute__((ext_vector_type(4))) unsigned;
using u32x2  = __attribute__((ext_vector_type(2))) unsigned;

constexpr int NB = 2, SEQ = 8192, CTXL = 256, DM = 1024;
constexpr int NLAT = NB * SEQ, NCTX = NB * CTXL, NTOK = NLAT + NCTX;
constexpr int DIN = 2208, DINP = 2304;
constexpr int DLRU = 384, NKEYS = SEQ + CTXL;
constexpr int NTHREADS = 512;
constexpr int NCHUNK = NLAT / 64 + NCTX / 64;
constexpr float EPSV = 1e-6f;

enum { I_X = 0, I_C, I_CTX, I_CCTX, I_WMOD, I_BMOD, I_N1G, I_N2G, I_WIN, I_WOUT, I_LCW, I_LCB, I_LWR, I_LBR, I_LWI, I_LBI, I_LLAM,
       I_QNG, I_WQB, I_KVNG, I_WKVB, I_HCW, I_HCB, I_HW1, I_HB1, I_HW2, I_HB2, I_HW3, I_HFREQ, I_HDECAY, I_HSKIP,
       I_PWQ, I_PKEYS, I_PU, I_PV, I_FG, N_IN };

struct KArgs { const float* in[N_IN]; float* out; char* ws; };
struct InTab {
  const char* tab;
  __device__ __forceinline__ const float* operator[](int i) const {
    const unsigned long long v = ((const unsigned long long*)tab)[i];
    const unsigned lo = __builtin_amdgcn_readfirstlane((unsigned)v), hi = __builtin_amdgcn_readfirstlane((unsigned)(v >> 32));
    return (const float*)(const __attribute__((address_space(1))) float*)(((unsigned long long)hi << 32) | lo);
  }
};
struct Params { InTab in; float* out; char* ws; };

constexpr size_t al256(size_t x) { return (x + 255) / 256 * 256; }
constexpr size_t OFF_XS    = 0;
constexpr size_t OFF_HB    = OFF_XS    + al256((size_t)NTOK * DM * 4);
constexpr size_t OFF_U     = OFF_HB    + al256((size_t)NTOK * DM * 2);
constexpr size_t OFF_PQ    = OFF_U;
constexpr size_t OFF_LAB   = OFF_U     + al256((size_t)NTOK * DIN * 2);
static_assert(OFF_LAB + (size_t)(NTOK / 32) * 6 * 2 * 2 * 16 * 64 * 4 <= OFF_U + al256((size_t)NTOK * DIN * 4), "LRU coefficient buffer must fit behind the bf16 u");
constexpr size_t OFF_MIX   = OFF_U     + al256((size_t)NTOK * DIN * 4);
constexpr size_t OFF_HYIN  = OFF_MIX   + al256((size_t)NTOK * DM * 2);
constexpr size_t OFF_EID   = OFF_HYIN;
constexpr size_t OFF_GATE  = OFF_EID   + al256((size_t)NTOK * 128 * 4);
constexpr size_t OFF_HYINC = OFF_HYIN  + al256((size_t)3 * 2 * 256 * 8192 * 4);
constexpr size_t OFF_QN    = OFF_HYINC + al256((size_t)3 * 2 * 256 * 256 * 4);
constexpr size_t TAB_BYTES = (size_t)16384 * 1024;
constexpr size_t OFF_UTAB  = al256(OFF_LAB + (size_t)(NTOK / 32) * 6 * 2 * 2 * 16 * 64 * 4);
constexpr size_t OFF_OPART = OFF_QN;
constexpr size_t OFF_OML   = OFF_OPART + (size_t)4 * 2 * SEQ * 64 * 4;
constexpr size_t OFF_KVN   = OFF_QN    + al256((size_t)NTOK * 384 * 2);
constexpr size_t OFF_Q     = OFF_KVN   + al256((size_t)NTOK * 256 * 2);
constexpr size_t OFF_K     = OFF_Q     + al256((size_t)NTOK * 576 * 2);
constexpr size_t OFF_V     = OFF_K     + al256((size_t)NTOK * 768 * 2);
constexpr size_t OFF_LSUM  = OFF_V     + al256((size_t)NTOK * 32 * 2);
static_assert(OFF_OML + (size_t)4 * 2 * SEQ * 2 * 4 <= OFF_Q, "attention partials must fit in the dead QN/KVN region");
static_assert(OFF_UTAB + TAB_BYTES <= OFF_U + al256((size_t)NTOK * DIN * 4), "u table must fit in the tail of the u region");
constexpr size_t OFF_CARRY = OFF_LSUM  + al256((size_t)(NTOK / 32) * 2 * 2 * 384 * 4);
constexpr size_t OFF_MOD   = OFF_CARRY + al256((size_t)(NTOK / 32) * 2 * 384 * 4);
constexpr size_t OFF_MODP  = OFF_MIX;
constexpr size_t OFF_WIN   = OFF_MOD   + al256((size_t)2 * 3 * 6144 * 4);
constexpr size_t OFF_WOUT  = OFF_WIN   + al256((size_t)2 * DINP * 1024 * 2);
constexpr size_t OFF_WQB   = OFF_WOUT  + al256((size_t)2 * 1024 * 1024 * 2);
constexpr size_t OFF_WKVB  = OFF_WQB   + al256((size_t)2 * 768 * 384 * 2);
constexpr size_t OFF_WPQ   = OFF_WKVB  + al256((size_t)2 * 768 * 256 * 2);
constexpr size_t OFF_KEYS  = OFF_WPQ   + al256((size_t)2 * 2048 * 1024 * 2);
constexpr size_t OFF_GW    = OFF_KEYS  + al256((size_t)2 * 2 * 128 * 128 * 2);
constexpr size_t OFF_H2    = OFF_GW    + al256((size_t)2 * 2 * 2 * 6 * 64 * 64 * 2);
constexpr size_t OFF_HSPEC = OFF_H2    + al256((size_t)2 * NKEYS * 64 * 4);
constexpr size_t OFF_FILTC = OFF_HSPEC + al256((size_t)2 * 256 * 2 * 16384 * 4);
constexpr size_t OFF_SSQPC = OFF_FILTC + al256((size_t)2 * 1024 * 256 * 4);
constexpr size_t OFF_BAR   = OFF_SSQPC + al256((size_t)2 * 4 * 1024 * 4);
constexpr size_t OFF_CTR   = OFF_BAR   + al256(3456 * 4);
constexpr size_t BAR_BYTES = al256(3456 * 4) + 2 * 2 * 2 * 16 * 256;
constexpr size_t OFF_VTAB  = OFF_BAR   + al256(BAR_BYTES);
constexpr size_t WS_END    = OFF_VTAB  + al256(TAB_BYTES);
static_assert(WS_END <= (size_t)4 * 2 * 16384 * 1024 * 4, "workspace layout exceeds the guaranteed 4 x largest-tensor size");
constexpr size_t OFF_SP    = OFF_U;
constexpr size_t OFF_WBUF  = OFF_SP    + (size_t)16 * NTOK * 128 * 4;
static_assert(OFF_WBUF + (size_t)NTOK * 128 * 4 <= OFF_MIX, "PEER partials must fit in the u region");

__device__ __forceinline__ float bf2f(bf16_t v) { return __uint_as_float(((unsigned)v) << 16); }
__device__ __forceinline__ bf16_t f2bf(float f) { unsigned u = __float_as_uint(f); u += 0x7fffu + ((u >> 16) & 1u); return (bf16_t)(u >> 16); }
__device__ __forceinline__ unsigned cvtpk(float lo, float hi) { unsigned r; asm volatile("v_cvt_pk_bf16_f32 %0, %1, %2" : "=v"(r) : "v"(lo), "v"(hi)); return r; }
__device__ __forceinline__ float gelu_tanh(float x) { const float z2 = 1.5957691216057308f * (x + 0.044715f * x * x * x); return x * __builtin_amdgcn_rcpf(1.f + __expf(-z2)); }
__device__ __forceinline__ float sigm(float x) { return 1.f / (1.f + __expf(-x)); }
template <int CTRL> __device__ __forceinline__ float dpp_mov(float x) { return __builtin_bit_cast(float, __builtin_amdgcn_mov_dpp(__builtin_bit_cast(int, x), CTRL, 0xf, 0xf, true)); }
__device__ __forceinline__ float wave_sum(float v) {
  v += dpp_mov<0xB1>(v); v += dpp_mov<0x4E>(v); v += dpp_mov<0x141>(v); v += dpp_mov<0x128>(v);
  { auto r = __builtin_amdgcn_permlane16_swap(__float_as_uint(v), __float_as_uint(v), false, false); v = __uint_as_float(r[0]) + __uint_as_float(r[1]); }
  { auto r = __builtin_amdgcn_permlane32_swap(__float_as_uint(v), __float_as_uint(v), false, false); v = __uint_as_float(r[0]) + __uint_as_float(r[1]); }
  return v;
}
using bf16x2v = __attribute__((ext_vector_type(2))) __bf16;
__device__ __forceinline__ float dot2bf(unsigned a, unsigned b, float acc) { return __builtin_amdgcn_fdot2_f32_bf16(__builtin_bit_cast(bf16x2v, a), __builtin_bit_cast(bf16x2v, b), acc, false); }
__device__ __forceinline__ int crow(int r, int hi) { return (r & 3) + 8 * (r >> 2) + 4 * hi; }
__device__ __forceinline__ void row_info(int r, int& b, int& t, int& isctx) {
  if (r < NLAT) { isctx = 0; b = r >> 13; t = r & (SEQ - 1); } else { isctx = 1; int q = r - NLAT; b = q >> 8; t = q & (CTXL - 1); }
}
__device__ __forceinline__ const float* xrow_src(const Params& p, int layer, int r) {
  if (layer == 0) return (r < NLAT) ? p.in[I_X] + (size_t)r * DM : p.in[I_CTX] + (size_t)(r - NLAT) * DM;
  return (const float*)(p.ws + OFF_XS) + (size_t)r * DM;
}
__device__ __forceinline__ size_t h2idx(int l, int pos, int j) { return (((size_t)l * 16 + (j >> 2)) * NKEYS + pos) * 4 + (j & 3); }
#define JOB_LOOP(t, ntiles, base) for (int t = (int)(((long)BIDX - ((base) % (long)gridDim.x) + gridDim.x) % gridDim.x); t < (ntiles); t += gridDim.x)

__device__ __forceinline__ int rope_slot(int c) { return (c & 16) | ((c & 7) << 1) | ((c >> 3) & 1); }
__device__ void transpose_cvt_job(const float* __restrict__ src, bf16_t* __restrict__ dst, int K, int N, int Npad, char* smem, long& base, int rp = 0) {
  float* tile = (float*)smem;
  const int tk = K / 64, tn = Npad / 64, nt = tk * tn;
  JOB_LOOP(t, nt, base) {
    const int k0 = (t % tk) * 64, n0 = (t / tk) * 64;
    __syncthreads();
    for (int e = TIDX; e < 1024; e += NTHREADS) {
      const int i = e >> 4, j = (e & 15) * 4, n = n0 + j;
      f32x4 v = {0.f, 0.f, 0.f, 0.f};
      if (n < N) v = *(const f32x4*)(src + (size_t)(k0 + i) * N + n);
      tile[j * 65 + i] = v[0]; tile[(j + 1) * 65 + i] = v[1]; tile[(j + 2) * 65 + i] = v[2]; tile[(j + 3) * 65 + i] = v[3];
    }
    __syncthreads();
    {
      const int e = TIDX, j = e >> 3, i8 = (e & 7) * 8;
      const float* tr = tile + j * 65 + i8;
      const u32x4 o = {cvtpk(tr[0], tr[1]), cvtpk(tr[2], tr[3]), cvtpk(tr[4], tr[5]), cvtpk(tr[6], tr[7])};
      int n = n0 + j;
      if (rp && n < N) { const int hh = n / 96, jj = n - hh * 96; if (jj >= 64) n = hh * 96 + 64 + rope_slot(jj - 64); }
      *(u32x4*)(dst + (size_t)n * K + k0 + i8) = o;
    }
  }
  base += nt;
}

__device__ void stage_prep(const Params& p, char* smem) {
  long base = 0;
  for (int l = 0; l < 2; ++l) {
    transpose_cvt_job(p.in[I_WIN] + (size_t)l * 1024 * DIN, (bf16_t*)(p.ws + OFF_WIN) + (size_t)l * DINP * 1024, 1024, DIN, DINP, smem, base);
    transpose_cvt_job(p.in[I_WOUT] + (size_t)l * 1024 * 1024, (bf16_t*)(p.ws + OFF_WOUT) + (size_t)l * 1024 * 1024, 1024, 1024, 1024, smem, base);
    transpose_cvt_job(p.in[I_WQB] + (size_t)l * 384 * 576, (bf16_t*)(p.ws + OFF_WQB) + (size_t)l * 768 * 384, 384, 576, 768, smem, base, 1);
    transpose_cvt_job(p.in[I_WKVB] + (size_t)l * 256 * 768, (bf16_t*)(p.ws + OFF_WKVB) + (size_t)l * 768 * 256, 256, 768, 768, smem, base);
    transpose_cvt_job(p.in[I_PWQ] + (size_t)l * 1024 * 2048, (bf16_t*)(p.ws + OFF_WPQ) + (size_t)l * 2048 * 1024, 1024, 2048, 2048, smem, base);
    for (int d = 0; d < 2; ++d) for (int n = 0; n < 6; ++n) {
      const size_t so = ((size_t)(l * 2 + d) * 6 + n) * 4096;
      transpose_cvt_job(p.in[I_LWR] + so, (bf16_t*)(p.ws + OFF_GW) + ((size_t)((l * 2 + d) * 2 + 0) * 6 + n) * 4096, 64, 64, 64, smem, base);
      transpose_cvt_job(p.in[I_LWI] + so, (bf16_t*)(p.ws + OFF_GW) + ((size_t)((l * 2 + d) * 2 + 1) * 6 + n) * 4096, 64, 64, 64, smem, base);
    }
  }
  {
    const float* src = p.in[I_PKEYS]; bf16_t* dst = (bf16_t*)(p.ws + OFF_KEYS);
    for (int e = BIDX * NTHREADS + TIDX; e < 2 * 2 * 128 * 128; e += gridDim.x * NTHREADS) dst[e] = f2bf(src[e]);
  }
  {
    float* modp = (float*)(p.ws + OFF_MODP);
    const float* cp = p.in[I_C]; const float* ccp = p.in[I_CCTX]; const float* wmod = p.in[I_WMOD];
    JOB_LOOP(it, 768, base) {
      const int l = it / 384, ks = (it % 384) / 12, cgp = it % 12;
      const int col = cgp * 512 + TIDX;
      const float* w = wmod + (size_t)l * 1024 * 6144 + (size_t)(ks * 32) * 6144 + col;
      float a0 = 0.f, a1 = 0.f, a2 = 0.f;
#pragma unroll
      for (int k0 = 0; k0 < 32; k0 += 8) {
        float wv[8];
#pragma unroll
        for (int j = 0; j < 8; ++j) wv[j] = w[(size_t)(k0 + j) * 6144];
#pragma unroll
        for (int j = 0; j < 8; ++j) {
          const int k = ks * 32 + k0 + j;
          const float c0 = cp[k], c1 = cp[1024 + k], c2 = ccp[k];
          a0 += c0 * sigm(c0) * wv[j]; a1 += c1 * sigm(c1) * wv[j]; a2 += c2 * sigm(c2) * wv[j];
        }
      }
      float* o = modp + ((size_t)(l * 32 + ks) * 3) * 6144 + col;
      o[0] = a0; o[6144] = a1; o[2 * 6144] = a2;
    }
    base += 768;
  }
  {
    const int lane = TIDX & 63, wid = TIDX >> 6;
    const float* hw1 = p.in[I_HW1]; const float* hb1 = p.in[I_HB1]; const float* hw2 = p.in[I_HW2]; const float* hb2 = p.in[I_HB2]; const float* hfr = p.in[I_HFREQ];
    constexpr float INV2PI = 0.15915494309189535f;
    for (int it = BIDX * 8 + wid; it < 2 * NKEYS / 4; it += gridDim.x * 8) {
      const int l = it / (NKEYS / 4), pos0 = (it % (NKEYS / 4)) * 4;
      const float* w1 = hw1 + (size_t)l * 17 * 64; const float* w2 = hw2 + (size_t)l * 64 * 64;
      const float fr = hfr[l * 64 + lane], b1v = hb1[l * 64 + lane], b2v = hb2[l * 64 + lane];
      float w1v[17];
#pragma unroll
      for (int i = 0; i < 17; ++i) w1v[i] = w1[i * 64 + lane];
      float h1[4], pre2[4];
#pragma unroll
      for (int j = 0; j < 4; ++j) {
        const int pos = pos0 + j;
        const float tn = (pos < SEQ) ? (float)pos / (float)SEQ : (float)(pos - SEQ) / (float)CTXL;
        float pre = b1v + tn * w1v[0];
#pragma unroll
        for (int i = 0; i < 8; ++i) {
          const float band = 1e-4f + (float)i * ((7.f - 1e-4f) / 7.f);
          const float rev = tn * band;
          pre += __builtin_amdgcn_cosf(rev) * w1v[1 + i] + __builtin_amdgcn_sinf(rev) * w1v[9 + i];
        }
        h1[j] = __builtin_amdgcn_sinf(fr * pre * INV2PI);
        pre2[j] = b2v;
      }
      for (int i = 0; i < 64; ++i) {
        const float wv = w2[i * 64 + lane];
#pragma unroll
        for (int j = 0; j < 4; ++j) pre2[j] += rdl(h1[j], i) * wv;
      }
#pragma unroll
      for (int j = 0; j < 4; ++j) ((float*)(p.ws + OFF_H2))[h2idx(l, pos0 + j, lane)] = __builtin_amdgcn_sinf(fr * pre2[j] * INV2PI);
    }
  }
}

struct cf { float x, y; };
__device__ __forceinline__ cf cmul(cf a, cf b) { return {a.x * b.x - a.y * b.y, a.x * b.y + a.y * b.x}; }
__device__ __forceinline__ cf opq(cf v) { asm("" : "+v"(v.x), "+v"(v.y)); return v; }
template <bool INV> __device__ __forceinline__ cf twid(float frac) {
  const float c = __builtin_amdgcn_cosf(frac), s = __builtin_amdgcn_sinf(frac); return {c, INV ? s : -s};
}
template <bool INV> __device__ __forceinline__ void r4(cf& a, cf& b, cf& c, cf& d) {
  const cf s0 = {a.x + c.x, a.y + c.y}, s1 = {a.x - c.x, a.y - c.y}, s2 = {b.x + d.x, b.y + d.y}, s3 = {b.x - d.x, b.y - d.y};
  a = {s0.x + s2.x, s0.y + s2.y}; c = {s0.x - s2.x, s0.y - s2.y};
  if (!INV) { b = {s1.x + s3.y, s1.y - s3.x}; d = {s1.x - s3.y, s1.y + s3.x}; }
  else      { b = {s1.x - s3.y, s1.y + s3.x}; d = {s1.x + s3.y, s1.y - s3.x}; }
}
template <bool INV> __device__ __forceinline__ cf cj(cf w) { return {w.x, INV ? -w.y : w.y}; }
template <bool INV> __device__ __forceinline__ void dft16(cf* x) {
#pragma unroll
  for (int m0 = 0; m0 < 4; ++m0) r4<INV>(x[m0], x[4 + m0], x[8 + m0], x[12 + m0]);
  const cf W1 = {0.92387953251128674f, -0.38268343236508977f}, W2 = {0.70710678118654752f, -0.70710678118654752f}, W3 = {0.38268343236508977f, -0.92387953251128674f};
  const cf W4 = {0.f, -1.f}, W6 = {-0.70710678118654752f, -0.70710678118654752f}, W9 = {-0.92387953251128674f, 0.38268343236508977f};
  x[5] = cmul(x[5], cj<INV>(W1)); x[6] = cmul(x[6], cj<INV>(W2)); x[7] = cmul(x[7], cj<INV>(W3));
  x[9] = cmul(x[9], cj<INV>(W2)); x[10] = cmul(x[10], cj<INV>(W4)); x[11] = cmul(x[11], cj<INV>(W6));
  x[13] = cmul(x[13], cj<INV>(W3)); x[14] = cmul(x[14], cj<INV>(W6)); x[15] = cmul(x[15], cj<INV>(W9));
#pragma unroll
  for (int q0 = 0; q0 < 4; ++q0) r4<INV>(x[4 * q0], x[4 * q0 + 1], x[4 * q0 + 2], x[4 * q0 + 3]);
}
template <bool INV> __device__ __forceinline__ void dft8(cf* x) {
#pragma unroll
  for (int m0 = 0; m0 < 4; ++m0) { const cf a = x[m0], b = x[4 + m0]; x[m0] = {a.x + b.x, a.y + b.y}; x[4 + m0] = {a.x - b.x, a.y - b.y}; }
  const cf V1 = {0.70710678118654752f, -0.70710678118654752f}, V2 = {0.f, -1.f}, V3 = {-0.70710678118654752f, -0.70710678118654752f};
  x[5] = cmul(x[5], cj<INV>(V1)); x[6] = cmul(x[6], cj<INV>(V2)); x[7] = cmul(x[7], cj<INV>(V3));
  r4<INV>(x[0], x[1], x[2], x[3]); r4<INV>(x[4], x[5], x[6], x[7]);
}
template <bool COL> __device__ __forceinline__ int fidx(int ln, int i) { return COL ? i * 129 + ln : ln * 129 + i; }
template <bool INV, bool COL> __device__ __forceinline__ void fft_passA(cf* buf) {
  for (int it = 0; it < 2; ++it) {
    const int bf = TIDX + NTHREADS * it, ln = bf & 127, j = bf >> 7;
    cf x[16];
    if (!INV) {
#pragma unroll
      for (int m = 0; m < 16; ++m) x[m] = buf[fidx<COL>(ln, j + 8 * m)];
      dft16<false>(x);
#pragma unroll
      for (int q = 0; q < 16; ++q) buf[fidx<COL>(ln, j + 8 * q)] = opq(cmul(x[4 * (q & 3) + (q >> 2)], twid<false>((float)(q * j) * (1.f / 128.f))));
    } else {
#pragma unroll
      for (int q = 0; q < 16; ++q) x[q] = cmul(buf[fidx<COL>(ln, j + 8 * q)], twid<true>((float)(q * j) * (1.f / 128.f)));
      dft16<true>(x);
#pragma unroll
      for (int m = 0; m < 16; ++m) buf[fidx<COL>(ln, j + 8 * m)] = opq(x[4 * (m & 3) + (m >> 2)]);
    }
  }
}
template <bool INV, bool COL> __device__ __forceinline__ void fft_passB(cf* buf) {
  for (int it = 0; it < 4; ++it) {
    const int bf = TIDX + NTHREADS * it, ln = bf & 127, B = bf >> 7;
    cf x[8];
    if (!INV) {
#pragma unroll
      for (int m = 0; m < 8; ++m) x[m] = buf[fidx<COL>(ln, 8 * B + m)];
      dft8<false>(x);
#pragma unroll
      for (int q = 0; q < 8; ++q) {
        cf v = x[4 * (q & 1) + (q >> 1)];
        if (COL) v = cmul(v, twid<false>((float)(ln * (B + 16 * q)) * (1.f / 16384.f)));
        buf[fidx<COL>(ln, 8 * B + q)] = opq(v);
      }
    } else {
#pragma unroll
      for (int q = 0; q < 8; ++q) {
        cf v = buf[fidx<COL>(ln, 8 * B + q)];
        if (COL) v = cmul(v, twid<true>((float)(ln * (B + 16 * q)) * (1.f / 16384.f)));
        x[q] = v;
      }
      dft8<true>(x);
#pragma unroll
      for (int m = 0; m < 8; ++m) buf[fidx<COL>(ln, 8 * B + m)] = opq(x[4 * (m & 1) + (m >> 1)]);
    }
  }
}
__device__ __forceinline__ void fft_fwd(cf* buf) {
  fft_passA<false, true>(buf); __syncthreads(); fft_passB<false, true>(buf); __syncthreads();
  fft_passA<false, false>(buf); __syncthreads(); fft_passB<false, false>(buf); __syncthreads();
}
__device__ __forceinline__ void fft_inv(cf* buf) {
  fft_passB<true, false>(buf); __syncthreads(); fft_passA<true, false>(buf); __syncthreads();
  fft_passB<true, true>(buf); __syncthreads(); fft_passA<true, true>(buf); __syncthreads();
}
__device__ __forceinline__ int fft_freq(int r, int c) { return ((r >> 3) + 16 * (r & 7)) + 128 * ((c >> 3) + 16 * (c & 7)); }
__device__ __forceinline__ int fft_pos(int k) {
  const int k1 = k & 127, k2 = k >> 7; return (8 * (k1 & 15) + (k1 >> 4)) * 129 + 8 * (k2 & 15) + (k2 >> 4);
}
constexpr int FFT_LDS = 128 * 129 * 8;

__device__ void hyena_spectra(const Params& p, char* smem) {
  cf* buf = (cf*)smem; float* fb = (float*)smem;
  float* w3s = (float*)(smem + FFT_LDS);
  float* red = w3s + 256;
  const int tid = TIDX, lane = tid & 63, wid = tid >> 6;
  for (int unit = BIDX; unit < 512; unit += gridDim.x) {
    const int l = unit >> 8, c = unit & 255;
    __syncthreads();
    if (tid < 256) { const int i = tid >> 2, j = tid & 3; w3s[tid] = p.in[I_HW3][(size_t)l * 64 * 1024 + (size_t)i * 1024 + j * 256 + c]; }
    if (tid == 0) buf[64 * 129] = cf{0.f, 0.f};
    __syncthreads();
    float dec[4], ss[4];
#pragma unroll
    for (int j = 0; j < 4; ++j) { dec[j] = p.in[I_HDECAY][l * 1024 + j * 256 + c]; ss[j] = 0.f; }
    const float* h2 = (const float*)(p.ws + OFF_H2) + (size_t)l * 16 * NKEYS * 4;
#pragma unroll 1
    for (int half = 0; half < 2; ++half) {
      float acc[8][4];
#pragma unroll
      for (int i = 0; i < 8; ++i) { acc[i][0] = 0.f; acc[i][1] = 0.f; acc[i][2] = 0.f; acc[i][3] = 0.f; }
      const f32x4* hr = (const f32x4*)h2 + tid + half * 8 * NTHREADS;
#pragma unroll 1
      for (int kc = 0; kc < 8; ++kc) {
        float w[8][4];
#pragma unroll
        for (int kk = 0; kk < 8; ++kk)
#pragma unroll
          for (int j = 0; j < 4; ++j) w[kk][j] = __int_as_float(__builtin_amdgcn_readfirstlane(__float_as_int(w3s[(kc * 8 + kk) * 4 + j])));
#pragma unroll
        for (int i = 0; i < 8; ++i) {
          const f32x4 h0 = hr[(size_t)(kc * 2) * NKEYS + NTHREADS * i], h1 = hr[(size_t)(kc * 2 + 1) * NKEYS + NTHREADS * i];
#pragma unroll
          for (int kk = 0; kk < 4; ++kk)
#pragma unroll
            for (int j = 0; j < 4; ++j) { acc[i][j] += h0[kk] * w[kk][j]; acc[i][j] += h1[kk] * w[4 + kk][j]; }
        }
      }
#pragma unroll
      for (int i = 0; i < 8; ++i) {
        const int t = tid + NTHREADS * (half * 8 + i);
        float a[4] = {acc[i][0], acc[i][1], acc[i][2], acc[i][3]};
        const float tn = (float)t * (1.f / (float)SEQ);
#pragma unroll
        for (int j = 0; j < 4; ++j) { a[j] *= __expf(-tn * dec[j]); ss[j] += a[j] * a[j]; }
        const int pf = (t >> 7) * 129 + (t & 127);
        fb[2 * pf] = a[0]; fb[2 * pf + 1] = a[2];
        if (t > 0) { const int n = 16384 - t, pb = (n >> 7) * 129 + (n & 127); fb[2 * pb] = a[1]; fb[2 * pb + 1] = a[3]; }
      }
    }
#pragma unroll
    for (int j = 0; j < 4; ++j) { ss[j] = wave_sum(ss[j]); if (lane == 0) red[wid * 4 + j] = ss[j]; }
    __syncthreads();
    float sc[4];
#pragma unroll
    for (int j = 0; j < 4; ++j) { float s = 0.f; for (int w = 0; w < 8; ++w) s += red[w * 4 + j]; sc[j] = rsqrtf(s + EPSV) * (1.f / 16384.f); }
    const float sk0 = p.in[I_HSKIP][l * 512 + c] * (1.f / 16384.f), sk1 = p.in[I_HSKIP][l * 512 + 256 + c] * (1.f / 16384.f);
    for (int i = 0; i < 32; ++i) {
      const int n = tid + NTHREADS * i, pi = (n >> 7) * 129 + (n & 127);
      cf v = buf[pi];
      if (n < 8192) { v.x *= sc[0]; v.y *= sc[2]; } else { v.x *= sc[1]; v.y *= sc[3]; }
      if (n == 0) { v.x += sk0; v.y += sk1; }
      buf[pi] = v;
    }
    __syncthreads();
    fft_fwd(buf);
    unsigned* hs = (unsigned*)(p.ws + OFF_HSPEC) + ((size_t)(l * 256 + c) * 2) * 16384;
    for (int i = 0; i < 32; ++i) {
      const int e = tid + NTHREADS * i, r = e >> 7, cc = e & 127;
      const int k = fft_freq(r, cc), k2 = (16384 - k) & 16383;
      const cf a = buf[r * 129 + cc], b = buf[fft_pos(k2)];
      hs[e] = cvtpk(0.5f * (a.x + b.x), 0.5f * (a.y - b.y));
      hs[16384 + e] = cvtpk(0.5f * (a.y + b.y), -0.5f * (a.x - b.x));
    }
  }
}

__device__ void hyena_fft(const Params& p, int layer, char* smem) {
  cf* buf = (cf*)smem;
  const int tid = TIDX;
  bf16_t* mix = (bf16_t*)(p.ws + OFF_MIX);
  const float* hin = (const float*)(p.ws + OFF_HYIN);
  for (int unit = (int)gridDim.x - 1 - BIDX; unit < 256; unit += gridDim.x) {
    const int c = unit;
    const unsigned* hs = (const unsigned*)(p.ws + OFF_HSPEC) + ((size_t)(layer * 256 + c) * 2) * 16384;
    __syncthreads();
    {
      const float* z0 = hin + ((size_t)(0 * 2 + 0) * 256 + c) * SEQ; const float* z1 = hin + ((size_t)(0 * 2 + 1) * 256 + c) * SEQ;
      for (int i = 0; i < 16; ++i) { const int t = tid + NTHREADS * i; buf[(t >> 7) * 129 + (t & 127)] = cf{z0[t], z1[t]}; }
      for (int i = 0; i < 16; ++i) { const int t = 8192 + tid + NTHREADS * i; buf[(t >> 7) * 129 + (t & 127)] = cf{0.f, 0.f}; }
    }
    __syncthreads();
    for (int order = 0; order < 2; ++order) {
      fft_fwd(buf);
      for (int i = 0; i < 32; ++i) {
        const int e = tid + NTHREADS * i, pi = (e >> 7) * 129 + (e & 127);
        const unsigned hv = hs[order * 16384 + e];
        const cf h = {__uint_as_float(hv << 16), __uint_as_float(hv & 0xffff0000u)};
        buf[pi] = cmul(buf[pi], h);
      }
      __syncthreads();
      fft_inv(buf);
      const float* x0 = hin + ((size_t)((1 + order) * 2 + 0) * 256 + c) * SEQ; const float* x1 = hin + ((size_t)((1 + order) * 2 + 1) * 256 + c) * SEQ;
      if (order == 0) {
        for (int i = 0; i < 16; ++i) { const int t = tid + NTHREADS * i, pi = (t >> 7) * 129 + (t & 127); const cf v = buf[pi]; buf[pi] = cf{v.x * x0[t], v.y * x1[t]}; }
        for (int i = 0; i < 16; ++i) { const int t = 8192 + tid + NTHREADS * i; buf[(t >> 7) * 129 + (t & 127)] = cf{0.f, 0.f}; }
        __syncthreads();
      } else {
        bf16_t* yc = (bf16_t*)(p.ws + OFF_HB);
        for (int i = 0; i < 8; ++i) {
          const int t = 2 * (tid + NTHREADS * i); const cf v0 = buf[(t >> 7) * 129 + (t & 127)], v1 = buf[(t >> 7) * 129 + (t & 127) + 1];
          *(unsigned*)(yc + ((size_t)(0 * 256 + c)) * SEQ + t) = cvtpk(v0.x * x0[t], v1.x * x0[t + 1]);
          *(unsigned*)(yc + ((size_t)(1 * 256 + c)) * SEQ + t) = cvtpk(v0.y * x1[t], v1.y * x1[t + 1]);
        }
      }
    }
  }
}

__device__ void stage_prep2(const Params& p, char* smem) {
  {
    float* mod = (float*)(p.ws + OFF_MOD); const float* modp = (const float*)(p.ws + OFF_MODP);
    for (int e = BIDX * NTHREADS + TIDX; e < 2 * 3 * 6144; e += gridDim.x * NTHREADS) {
      const int l = e / (3 * 6144), w = (e / 6144) % 3, col = e % 6144;
      float s = p.in[I_BMOD][l * 6144 + col];
      for (int ks = 0; ks < 32; ++ks) s += modp[((size_t)(l * 32 + ks) * 3 + w) * 6144 + col];
      mod[e] = s;
    }
  }
  float* h2t = (float*)smem;
  float* w3t = h2t + 64 * 65;
  const int tloc = TIDX & 63, cgp = TIDX >> 6, lane = TIDX & 63;
  for (int it = BIDX; it < 2 * 4 * 16; it += gridDim.x) {
    const int l = it / (4 * 16), tt = 128 + (it / 16) % 4, ct = it % 16;
    const bool isc = tt >= 128; const int L = isc ? CTXL : SEQ; const int t0 = isc ? (tt - 128) * 64 : tt * 64;
    const int pos0 = isc ? SEQ + t0 : t0;
    const float* h2 = (const float*)(p.ws + OFF_H2);
    const float* w3 = p.in[I_HW3] + (size_t)l * 64 * 1024 + ct * 64;
    __syncthreads();
    for (int e = TIDX; e < 4096; e += NTHREADS) { int i = e >> 6, j = e & 63; h2t[i * 65 + j] = h2[h2idx(l, pos0 + i, j)]; w3t[i * 64 + j] = w3[(size_t)i * 1024 + j]; }
    __syncthreads();
    float acc[8];
#pragma unroll
    for (int cc = 0; cc < 8; ++cc) acc[cc] = 0.f;
#pragma unroll 2
    for (int i = 0; i < 64; ++i) {
      const float hv = h2t[tloc * 65 + i];
#pragma unroll
      for (int cc = 0; cc < 8; ++cc) acc[cc] += hv * w3t[i * 64 + cgp * 8 + cc];
    }
    const float tn = (float)(t0 + tloc) / (float)L;
#pragma unroll
    for (int cc = 0; cc < 8; ++cc) {
      const int col = ct * 64 + cgp * 8 + cc;
      const float val = acc[cc] * __expf(-tn * p.in[I_HDECAY][l * 1024 + col]);
      ((float*)(p.ws + OFF_FILTC))[((size_t)l * 1024 + col) * CTXL + t0 + tloc] = val;
      const float s = wave_sum(val * val);
      if (lane == 0) ((float*)(p.ws + OFF_SSQPC))[((size_t)l * 4 + (tt - 128)) * 1024 + col] = s;
    }
  }
  hyena_spectra(p, smem);
}

__device__ void stage_norm(const Params& p, int layer, int which  , int nrows) {
  const int lane = TIDX & 63, wid = TIDX >> 6;
  const float* g = (which ? p.in[I_N2G] : p.in[I_N1G]) + layer * DM;
  bf16_t* hb = (bf16_t*)(p.ws + OFF_HB);
  const int ngrp = nrows / 4, gstride = gridDim.x * 8;
  int grp = BIDX * 8 + wid;
  f32x4 v[4][4], vn[4][4];
  auto rowsrc = [&](int r0) -> const float* { return (which == 0) ? xrow_src(p, layer, r0) : (const float*)(p.ws + OFF_XS) + (size_t)r0 * DM; };
  if (grp < ngrp) {
    const float* src = rowsrc(grp * 4);
#pragma unroll
    for (int j = 0; j < 4; ++j)
#pragma unroll
      for (int i = 0; i < 2; ++i) { v[j][2 * i] = *(const f32x4*)(src + (size_t)j * DM + i * 512 + lane * 8); v[j][2 * i + 1] = *(const f32x4*)(src + (size_t)j * DM + i * 512 + lane * 8 + 4); }
  }
  for (; grp < ngrp; grp += gstride) {
    const int r0 = grp * 4, gn = grp + gstride;
    if (gn < ngrp) {
      const float* src = rowsrc(gn * 4);
#pragma unroll
      for (int j = 0; j < 4; ++j)
#pragma unroll
        for (int i = 0; i < 2; ++i) { vn[j][2 * i] = *(const f32x4*)(src + (size_t)j * DM + i * 512 + lane * 8); vn[j][2 * i + 1] = *(const f32x4*)(src + (size_t)j * DM + i * 512 + lane * 8 + 4); }
    }
    int b, t, isc; row_info(r0, b, t, isc);
    const float* mod = (const float*)(p.ws + OFF_MOD) + ((size_t)layer * 3 + (isc ? 2 : b)) * 6144 + (which ? 3072 : 0);
    float ss[4];
#pragma unroll
    for (int j = 0; j < 4; ++j) {
      float s = 0.f;
#pragma unroll
      for (int i = 0; i < 4; ++i) s += v[j][i][0] * v[j][i][0] + v[j][i][1] * v[j][i][1] + v[j][i][2] * v[j][i][2] + v[j][i][3] * v[j][i][3];
      ss[j] = s;
    }
#pragma unroll
    for (int j = 0; j < 4; ++j) ss[j] = rsqrtf(wave_sum(ss[j]) * (1.f / DM) + EPSV);
#pragma unroll
    for (int i = 0; i < 2; ++i) {
      const int c0 = i * 512 + lane * 8;
      const f32x4 g0 = *(const f32x4*)(g + c0), g1 = *(const f32x4*)(g + c0 + 4);
      const f32x4 sc0 = *(const f32x4*)(mod + 1024 + c0), sc1 = *(const f32x4*)(mod + 1024 + c0 + 4), sh0 = *(const f32x4*)(mod + c0), sh1 = *(const f32x4*)(mod + c0 + 4);
#pragma unroll
      for (int j = 0; j < 4; ++j) {
        float y[8];
#pragma unroll
        for (int q = 0; q < 4; ++q) { y[q] = v[j][2 * i][q] * ss[j] * g0[q] * (1.f + sc0[q]) + sh0[q]; y[4 + q] = v[j][2 * i + 1][q] * ss[j] * g1[q] * (1.f + sc1[q]) + sh1[q]; }
        const u32x4 o = {cvtpk(y[0], y[1]), cvtpk(y[2], y[3]), cvtpk(y[4], y[5]), cvtpk(y[6], y[7])};
        *(u32x4*)(hb + (size_t)(r0 + j) * DM + c0) = o;
      }
    }
#pragma unroll
    for (int j = 0; j < 4; ++j)
#pragma unroll
      for (int i = 0; i < 4; ++i) v[j][i] = vn[j][i];
  }
}

template <class Epi>
__device__ void gemm_bt(const bf16_t* __restrict__ A, int lda, const bf16_t* __restrict__ Bt, int ldb, int M, int N, int K, Epi epi, char* smem) {
  const int tid = TIDX, wid = tid >> 6, lane = tid & 63, r32 = lane & 31, hi = lane >> 5;
  const int wm = wid >> 2, wn = wid & 3;
  constexpr int RS = 144;
  char* sA = smem; char* sB = smem + 128 * RS;
  const int tilesM = M / 128, tilesN = N / 128, nk = K / 64;
  const int lr0 = tid >> 3, lc = (tid & 7) * 8;
  for (int tile = BIDX; tile < tilesM * tilesN; tile += gridDim.x) {
    const int tm = tile / tilesN, tn = tile % tilesN;
    const bf16_t* Ap = A + (size_t)(tm * 128 + lr0) * lda + lc;
    const bf16_t* Bp = Bt + (size_t)(tn * 128 + lr0) * ldb + lc;
    f32x16 acc0 = {}, acc1 = {};
    u32x4 ra0 = *(const u32x4*)Ap, ra1 = *(const u32x4*)(Ap + (size_t)64 * lda);
    u32x4 rb0 = *(const u32x4*)Bp, rb1 = *(const u32x4*)(Bp + (size_t)64 * ldb);
    for (int kt = 0; kt < nk; ++kt) {
      __syncthreads();
      *(u32x4*)(sA + lr0 * RS + lc * 2) = ra0; *(u32x4*)(sA + (lr0 + 64) * RS + lc * 2) = ra1;
      *(u32x4*)(sB + lr0 * RS + lc * 2) = rb0; *(u32x4*)(sB + (lr0 + 64) * RS + lc * 2) = rb1;
      __syncthreads();
      if (kt + 1 < nk) {
        const int ko = (kt + 1) * 64;
        ra0 = *(const u32x4*)(Ap + ko); ra1 = *(const u32x4*)(Ap + (size_t)64 * lda + ko);
        rb0 = *(const u32x4*)(Bp + ko); rb1 = *(const u32x4*)(Bp + (size_t)64 * ldb + ko);
      }
#pragma unroll
      for (int ks = 0; ks < 4; ++ks) {
        const int cb = (ks * 16 + hi * 8) * 2;
        const bf16x8 a0 = *(const bf16x8*)(sA + (wm * 64 + r32) * RS + cb);
        const bf16x8 a1 = *(const bf16x8*)(sA + (wm * 64 + 32 + r32) * RS + cb);
        const bf16x8 bb = *(const bf16x8*)(sB + (wn * 32 + r32) * RS + cb);
        acc0 = __builtin_amdgcn_mfma_f32_32x32x16_bf16(a0, bb, acc0, 0, 0, 0);
        acc1 = __builtin_amdgcn_mfma_f32_32x32x16_bf16(a1, bb, acc1, 0, 0, 0);
      }
    }
    const int col = tn * 128 + wn * 32 + r32;
#pragma unroll
    for (int r = 0; r < 16; ++r) {
      epi(tm * 128 + wm * 64 + crow(r, hi), col, acc0[r]);
      epi(tm * 128 + wm * 64 + 32 + crow(r, hi), col, acc1[r]);
    }
  }
}

__device__ __forceinline__ float rope_apply(float x, float xp, int c, int t) {
  const int i = c & 7; const float pos = ((c >> 4) & 1) ? (float)(t & 63) : (float)(t >> 6);
  const float inv = __expf(-(float)i * (9.210340371976184f / 8.f));
  const float rev = (pos * inv) * 0.15915494309189535f;
  const float cs = __builtin_amdgcn_cosf(rev), sn = __builtin_amdgcn_sinf(rev);
  return x * cs + ((c & 8) ? xp : -xp) * sn;
}

constexpr int NCH32 = NTOK / 32;
__device__ __forceinline__ float swap32(float v, int hi) { const auto rr = __builtin_amdgcn_permlane32_swap(__float_as_uint(v), __float_as_uint(v), false, false); return __uint_as_float(hi ? rr[0] : rr[1]); }
template <bool BWD>
__device__ __forceinline__ void lru_seg_scan(const float* a, const float* b, int hi, float S, float* h, float& Sout) {
  float P[4], H[4], Sin[4];
#pragma unroll
  for (int g = 0; g < 4; ++g) {
    if (!BWD) { H[g] = b[4 * g]; P[g] = a[4 * g];
#pragma unroll
      for (int q = 1; q < 4; ++q) { H[g] = a[4 * g + q] * H[g] + b[4 * g + q]; P[g] *= a[4 * g + q]; } }
    else { H[g] = b[4 * g + 3]; P[g] = a[4 * g + 3];
#pragma unroll
      for (int q = 2; q >= 0; --q) { H[g] = a[4 * g + q] * H[g] + b[4 * g + q]; P[g] *= a[4 * g + q]; } }
    Sin[g] = 0.f;
  }
#pragma unroll
  for (int step = 0; step < 8; ++step) {
    const int s = BWD ? 7 - step : step, g = s >> 1, owner = s & 1;
    const bool mine = (hi == owner);
    if (mine) Sin[g] = S;
    const float cand = P[g] * S + H[g];
    const float other = swap32(cand, hi);
    S = mine ? cand : other;
  }
  Sout = S;
#pragma unroll
  for (int g = 0; g < 4; ++g) {
    float hp = Sin[g];
    if (!BWD) {
#pragma unroll
      for (int q = 0; q < 4; ++q) { hp = a[4 * g + q] * hp + b[4 * g + q]; h[4 * g + q] = hp; } }
    else {
#pragma unroll
      for (int q = 3; q >= 0; --q) { hp = a[4 * g + q] * hp + b[4 * g + q]; h[4 * g + q] = hp; } }
  }
}
__device__ void lru_units(const Params& p, int layer, int mode, char* smem) {
  const int tid = TIDX, wid = tid >> 6, lane = tid & 63, r32 = lane & 31, hi = lane >> 5;
  const bf16_t* u = (const bf16_t*)(p.ws + OFF_U);
  const float* cw = p.in[I_LCW] + (size_t)layer * 4 * DLRU; const float* cbias = p.in[I_LCB] + layer * DLRU;
  bf16_t* mix = (bf16_t*)(p.ws + OFF_MIX);
  constexpr int RS = 272;
  char* tile = smem + wid * (35 * RS);
  const int bid = BIDX, n = bid % 6, rk = bid / 6, nbn = ((int)gridDim.x - n + 5) / 6;
  char* gwl = smem + 8 * 35 * RS;
  __syncthreads();
  for (int i = tid; i < 2048; i += NTHREADS) {
    const int mat = i >> 9, row = (i >> 3) & 63, c = i & 7;
    const bf16_t* gsrc = (const bf16_t*)(p.ws + OFF_GW) + ((size_t)((layer * 2 + (mat >> 1)) * 2 + (mat & 1)) * 6 + n) * 4096 + row * 64 + c * 8;
    *(u32x4*)(gwl + mat * 8192 + row * 128 + ((c ^ (row & 7)) << 4)) = *(const u32x4*)gsrc;
  }
  __syncthreads();
  for (int cid = rk * 8 + wid; cid < NCH32; cid += nbn * 8) {
    const int unit = cid * 6 + n;
    int rbase, t0, slen;
    if (cid < 512) { const int b = cid >> 8; rbase = b * SEQ; t0 = (cid & 255) * 32; slen = SEQ; }
    else { const int q = cid - 512, b = q >> 3; rbase = NLAT + b * CTXL; t0 = (q & 7) * 32; slen = CTXL; }
    {
      const int row8 = lane >> 3, c8 = lane & 7;
      const bf16_t* ub = u + (size_t)rbase * DIN + n * 64 + c8 * 8;
#pragma unroll
      for (int i = 0; i < 5; ++i) {
        const int row = i * 8 + row8, t = t0 + row - 2;
        if (row < 35) {
          u32x4 v = {0u, 0u, 0u, 0u};
          if (t >= 0 && t < slen) v = *(const u32x4*)(ub + (size_t)t * DIN);
          const f32x4 lo = {__uint_as_float(v[0] << 16), __uint_as_float(v[0] & 0xffff0000u), __uint_as_float(v[1] << 16), __uint_as_float(v[1] & 0xffff0000u)};
          const f32x4 hi4 = {__uint_as_float(v[2] << 16), __uint_as_float(v[2] & 0xffff0000u), __uint_as_float(v[3] << 16), __uint_as_float(v[3] & 0xffff0000u)};
          *(f32x4*)(tile + row * RS + c8 * 32) = lo; *(f32x4*)(tile + row * RS + c8 * 32 + 16) = hi4;
        }
      }
    }
    bf16x8 af[4];
    {
      const char* tl = tile + r32 * RS + hi * 32;
#pragma unroll
      for (int ks = 0; ks < 4; ++ks) {
        const int col = n * 64 + ks * 16 + 8 * hi;
        f32x4 c0 = *(const f32x4*)(cbias + col), c1 = *(const f32x4*)(cbias + col + 4);
#pragma unroll
        for (int k = 0; k < 4; ++k) {
          const f32x4 x0 = *(const f32x4*)(tl + k * RS + ks * 64), x1 = *(const f32x4*)(tl + k * RS + ks * 64 + 16);
          const f32x4 w0 = *(const f32x4*)(cw + k * DLRU + col), w1 = *(const f32x4*)(cw + k * DLRU + col + 4);
          c0 += w0 * x0; c1 += w1 * x1;
        }
        const u32x4 pk = {cvtpk(c0[0], c0[1]), cvtpk(c0[2], c0[3]), cvtpk(c1[0], c1[1]), cvtpk(c1[2], c1[3])};
        af[ks] = *(const bf16x8*)&pk;
      }
    }
    float xo[2][16];
#pragma unroll
    for (int nt = 0; nt < 2; ++nt) {
      const int ch = n * 64 + nt * 32 + r32;
      const float w0 = cw[ch], w1 = cw[DLRU + ch], w2 = cw[2 * DLRU + ch], w3 = cw[3 * DLRU + ch], bb = cbias[ch];
      const char* tl = tile + (4 * hi) * RS + (nt * 32 + r32) * 4;
#pragma unroll
      for (int g = 0; g < 4; ++g) {
        float xr[7];
#pragma unroll
        for (int i = 0; i < 7; ++i) xr[i] = *(const float*)(tl + (8 * g + i) * RS);
#pragma unroll
        for (int q = 0; q < 4; ++q) xo[nt][4 * g + q] = bb + w0 * xr[q] + w1 * xr[q + 1] + w2 * xr[q + 2] + w3 * xr[q + 3];
      }
    }
    if (mode == 1) {
      const bf16_t* ub = u + (size_t)(rbase + t0) * DIN + DLRU + n * 64 + lane;
#pragma unroll 4
      for (int i = 0; i < 32; ++i) *(float*)(tile + i * RS + lane * 4) = bf2f(ub[(size_t)i * DIN]);
    }
#pragma unroll 1
    for (int nt = 0; nt < 2; ++nt) {
      const int ch = n * 64 + nt * 32 + r32;
      float hf[16];
#pragma unroll
      for (int dir = 0; dir < 2; ++dir) {
        const char* gwr = gwl + (dir * 2 + 0) * 8192 + (nt * 32 + r32) * 128;
        const char* gwi = gwl + (dir * 2 + 1) * 8192 + (nt * 32 + r32) * 128;
        f32x16 accR = {}, accI = {};
#pragma unroll
        for (int ks = 0; ks < 4; ++ks) {
          const int co = ((ks * 2 + hi) ^ (r32 & 7)) << 4;
          const bf16x8 br_ = *(const bf16x8*)(gwr + co), bi_ = *(const bf16x8*)(gwi + co);
          accR = __builtin_amdgcn_mfma_f32_32x32x16_bf16(af[ks], br_, accR, 0, 0, 0);
          accI = __builtin_amdgcn_mfma_f32_32x32x16_bf16(af[ks], bi_, accI, 0, 0, 0);
        }
        const size_t po = (size_t)(layer * 2 + dir) * DLRU + ch;
        const float brv = p.in[I_LBR][po], biv = p.in[I_LBI][po];
        const float cl = -8.f * __logf(1.f + __expf(-p.in[I_LLAM][po]));
        float a[16], bq[16];
#pragma unroll
        for (int r = 0; r < 16; ++r) {
          const float rr = __builtin_amdgcn_rcpf(1.f + __expf(-(accR[r] + brv))), ii = __builtin_amdgcn_rcpf(1.f + __expf(-(accI[r] + biv)));
          const float av = __expf(rr * cl);
          a[r] = av; bq[r] = __builtin_amdgcn_sqrtf(fmaxf(1.f - av * av, 0.f)) * (ii * (nt == 0 ? xo[0][r] : xo[1][r]));
        }
        if (mode == 0) {
          {
            u32x4* ab = (u32x4*)(p.ws + OFF_LAB) + ((((size_t)unit * 2 + nt) * 2 + dir) * 4) * 64 + lane;
#pragma unroll
            for (int r4 = 0; r4 < 4; ++r4) { const u32x4 o = {cvtpk(1.f - a[4 * r4], bq[4 * r4]), cvtpk(1.f - a[4 * r4 + 1], bq[4 * r4 + 1]), cvtpk(1.f - a[4 * r4 + 2], bq[4 * r4 + 2]), cvtpk(1.f - a[4 * r4 + 3], bq[4 * r4 + 3])}; ab[r4 * 64] = o; }
          }
          float hd[16], Send;
          if (dir == 0) lru_seg_scan<false>(a, bq, hi, 0.f, hd, Send); else lru_seg_scan<true>(a, bq, hi, 0.f, hd, Send);
          float pp = a[0];
#pragma unroll
          for (int r = 1; r < 16; ++r) pp *= a[r];
          pp *= swap32(pp, hi);
          if (hi == 0) { float* ls = (float*)(p.ws + OFF_LSUM) + ((size_t)(cid * 2 + dir) * 2) * DLRU + ch; ls[0] = pp; ls[DLRU] = Send; }
        } else {
          const float cin = ((const float*)(p.ws + OFF_CARRY))[(size_t)(cid * 2 + dir) * DLRU + ch];
          float Send;
          if (dir == 0) lru_seg_scan<false>(a, bq, hi, cin, hf, Send);
          else {
            float hb[16];
            lru_seg_scan<true>(a, bq, hi, cin, hb, Send);
            const char* tl = tile + (4 * hi) * RS + (nt * 32 + r32) * 4;
            bf16_t* mo = mix + ((size_t)rbase + t0 + 4 * hi) * DM + ch;
#pragma unroll
            for (int r = 0; r < 16; ++r) {
              const int tk = (r & 3) + 8 * (r >> 2);
              const float gt = *(const float*)(tl + tk * RS);
              mo[(size_t)tk * DM] = f2bf((hf[r] + hb[r]) * gelu_tanh(gt));
            }
          }
        }
      }
    }
  }
}

__device__ void lru_final(const Params& p, int layer, char* smem) {
  const int tid = TIDX, wid = tid >> 6, lane = tid & 63, r32 = lane & 31, hi = lane >> 5;
  const bf16_t* u = (const bf16_t*)(p.ws + OFF_U);
  bf16_t* mix = (bf16_t*)(p.ws + OFF_MIX);
  constexpr int RS = 272;
  char* tile = smem + wid * (35 * RS);
  __syncthreads();
  for (int unit = BIDX * 8 + wid; unit < NCH32 * 6; unit += gridDim.x * 8) {
    const int cid = unit / 6, n = unit % 6;
    int rbase, t0;
    if (cid < 512) { const int b = cid >> 8; rbase = b * SEQ; t0 = (cid & 255) * 32; }
    else { const int q = cid - 512, b = q >> 3; rbase = NLAT + b * CTXL; t0 = (q & 7) * 32; }
    unsigned ab[2][2][16];
#pragma unroll
    for (int nt = 0; nt < 2; ++nt)
#pragma unroll
      for (int dir = 0; dir < 2; ++dir) {
        const u32x4* abp = (const u32x4*)(p.ws + OFF_LAB) + ((((size_t)unit * 2 + nt) * 2 + dir) * 4) * 64 + lane;
#pragma unroll
        for (int r4 = 0; r4 < 4; ++r4) { const u32x4 v = abp[r4 * 64]; ab[nt][dir][4 * r4] = v[0]; ab[nt][dir][4 * r4 + 1] = v[1]; ab[nt][dir][4 * r4 + 2] = v[2]; ab[nt][dir][4 * r4 + 3] = v[3]; }
      }
    {
      const int row8 = lane >> 3, c8 = lane & 7;
      const bf16_t* ub = u + (size_t)(rbase + t0) * DIN + DLRU + n * 64 + c8 * 8;
#pragma unroll
      for (int i = 0; i < 4; ++i) {
        const int row = i * 8 + row8;
        const u32x4 v = *(const u32x4*)(ub + (size_t)row * DIN);
        const f32x4 lo = {__uint_as_float(v[0] << 16), __uint_as_float(v[0] & 0xffff0000u), __uint_as_float(v[1] << 16), __uint_as_float(v[1] & 0xffff0000u)};
        const f32x4 hi4 = {__uint_as_float(v[2] << 16), __uint_as_float(v[2] & 0xffff0000u), __uint_as_float(v[3] << 16), __uint_as_float(v[3] & 0xffff0000u)};
        *(f32x4*)(tile + row * RS + c8 * 32) = lo; *(f32x4*)(tile + row * RS + c8 * 32 + 16) = hi4;
      }
    }
#pragma unroll
    for (int nt = 0; nt < 2; ++nt) {
      const int ch = n * 64 + nt * 32 + r32;
      float hf[16], hb[16], a[16], bq[16], Send;
#pragma unroll
      for (int r = 0; r < 16; ++r) { a[r] = 1.f - __uint_as_float(ab[nt][0][r] << 16); bq[r] = __uint_as_float(ab[nt][0][r] & 0xffff0000u); }
      lru_seg_scan<false>(a, bq, hi, ((const float*)(p.ws + OFF_CARRY))[(size_t)(cid * 2 + 0) * DLRU + ch], hf, Send);
#pragma unroll
      for (int r = 0; r < 16; ++r) { a[r] = 1.f - __uint_as_float(ab[nt][1][r] << 16); bq[r] = __uint_as_float(ab[nt][1][r] & 0xffff0000u); }
      lru_seg_scan<true>(a, bq, hi, ((const float*)(p.ws + OFF_CARRY))[(size_t)(cid * 2 + 1) * DLRU + ch], hb, Send);
      const char* tl = tile + (4 * hi) * RS + (nt * 32 + r32) * 4;
      bf16_t* mo = mix + ((size_t)rbase + t0 + 4 * hi) * DM + ch;
#pragma unroll
      for (int r = 0; r < 16; ++r) {
        const int tk = (r & 3) + 8 * (r >> 2);
        const float gt = *(const float*)(tl + tk * RS);
        mo[(size_t)tk * DM] = f2bf((hf[r] + hb[r]) * gelu_tanh(gt));
      }
    }
  }
}

__device__ void lru_carry(const Params& p, char* smem) {
  const int tid = TIDX, seg = tid >> 6, c = tid & 63;
  const float* __restrict__ ls = (const float*)(p.ws + OFF_LSUM); float* __restrict__ cr = (float*)(p.ws + OFF_CARRY);
  float* comp = (float*)smem;
  for (int item = (int)gridDim.x - 1 - BIDX; item < 2 * 2 * 6; item += gridDim.x) {
    const int b = item / 12, dir = (item / 6) & 1, ch = (item % 6) * 64 + c;
    float P[33], H[33];
#pragma unroll
    for (int i = 0; i < 33; ++i) {
      const int k = seg * 33 + i;
      int cid;
      if (dir == 0) cid = (k < 8) ? 512 + b * 8 + k : b * 256 + (k - 8);
      else          cid = (k < 8) ? 512 + b * 8 + (7 - k) : b * 256 + (255 - (k - 8));
      P[i] = ls[((size_t)(cid * 2 + dir) * 2) * DLRU + ch]; H[i] = ls[((size_t)(cid * 2 + dir) * 2 + 1) * DLRU + ch];
    }
    float pc = 1.f, hc = 0.f;
#pragma unroll
    for (int i = 0; i < 33; ++i) { hc = P[i] * hc + H[i]; pc *= P[i]; }
    __syncthreads();
    comp[(seg * 2) * 64 + c] = pc; comp[(seg * 2 + 1) * 64 + c] = hc;
    __syncthreads();
    float st = 0.f;
    for (int s = 0; s < seg; ++s) st = comp[(s * 2) * 64 + c] * st + comp[(s * 2 + 1) * 64 + c];
#pragma unroll
    for (int i = 0; i < 33; ++i) {
      const int k = seg * 33 + i;
      int cid;
      if (dir == 0) cid = (k < 8) ? 512 + b * 8 + k : b * 256 + (k - 8);
      else          cid = (k < 8) ? 512 + b * 8 + (7 - k) : b * 256 + (255 - (k - 8));
      cr[(size_t)(cid * 2 + dir) * DLRU + ch] = st;
      st = P[i] * st + H[i];
    }
  }
}

__device__ void mla_prep(const Params& p, int layer) {
  const int lane = TIDX & 63, wid = TIDX >> 6;
  const bf16_t* u = (const bf16_t*)(p.ws + OFF_U);
  const float* qg = p.in[I_QNG] + layer * 384; const float* kvg = p.in[I_KVNG] + layer * 256;
  bf16_t* qn = (bf16_t*)(p.ws + OFF_QN); bf16_t* kvn = (bf16_t*)(p.ws + OFF_KVN); bf16_t* Kb = (bf16_t*)(p.ws + OFF_K);
  const bool qact = lane < 48, kact = lane < 32;
  f32x4 qg0 = {0.f, 0.f, 0.f, 0.f}, qg1 = qg0, kg0 = qg0, kg1 = qg0;
  if (qact) { qg0 = *(const f32x4*)(qg + lane * 8); qg1 = *(const f32x4*)(qg + lane * 8 + 4); }
  if (kact) { kg0 = *(const f32x4*)(kvg + lane * 8); kg1 = *(const f32x4*)(kvg + lane * 8 + 4); }
  u32x4 qv[4], kv[4], qvn[4], kvn_[4]; unsigned short kr[4], krn[4];
  const int gstride = gridDim.x * 8;
  int grp = BIDX * 8 + wid;
#define MLA_LOAD(QV, KV, KR, G) do { _Pragma("unroll") for (int j = 0; j < 4; ++j) { const bf16_t* ur = u + (size_t)((G) * 4 + j) * DIN; \
      QV[j] = u32x4{0u, 0u, 0u, 0u}; KV[j] = u32x4{0u, 0u, 0u, 0u}; \
      if (qact) QV[j] = *(const u32x4*)(ur + 768 + lane * 8); if (kact) KV[j] = *(const u32x4*)(ur + 1152 + lane * 8); KR[j] = ur[1408 + (lane & 31)]; } } while (0)
  if (grp < NTOK / 4) MLA_LOAD(qv, kv, kr, grp);
  for (; grp < NTOK / 4; grp += gstride) {
    const int r0 = grp * 4;
    if (grp + gstride < NTOK / 4) MLA_LOAD(qvn, kvn_, krn, grp + gstride);
#pragma unroll
    for (int j = 0; j < 4; ++j) {
      const int r = r0 + j;
      int b, t, isc; row_info(r, b, t, isc);
      float q[8], k[8], ss = 0.f;
#pragma unroll
      for (int i = 0; i < 4; ++i) { q[2 * i] = __uint_as_float(qv[j][i] << 16); q[2 * i + 1] = __uint_as_float(qv[j][i] & 0xffff0000u); ss += q[2 * i] * q[2 * i] + q[2 * i + 1] * q[2 * i + 1]; }
      float rinv = rsqrtf(wave_sum(ss) * (1.f / 384.f) + EPSV);
      if (qact) {
        const u32x4 o = {cvtpk(q[0] * rinv * qg0[0], q[1] * rinv * qg0[1]), cvtpk(q[2] * rinv * qg0[2], q[3] * rinv * qg0[3]),
                         cvtpk(q[4] * rinv * qg1[0], q[5] * rinv * qg1[1]), cvtpk(q[6] * rinv * qg1[2], q[7] * rinv * qg1[3])};
        *(u32x4*)(qn + (size_t)r * 384 + lane * 8) = o;
      }
      ss = 0.f;
#pragma unroll
      for (int i = 0; i < 4; ++i) { k[2 * i] = __uint_as_float(kv[j][i] << 16); k[2 * i + 1] = __uint_as_float(kv[j][i] & 0xffff0000u); ss += k[2 * i] * k[2 * i] + k[2 * i + 1] * k[2 * i + 1]; }
      rinv = rsqrtf(wave_sum(ss) * (1.f / 256.f) + EPSV);
      if (kact) {
        const u32x4 o = {cvtpk(k[0] * rinv * kg0[0], k[1] * rinv * kg0[1]), cvtpk(k[2] * rinv * kg0[2], k[3] * rinv * kg0[3]),
                         cvtpk(k[4] * rinv * kg1[0], k[5] * rinv * kg1[1]), cvtpk(k[6] * rinv * kg1[2], k[7] * rinv * kg1[3])};
        *(u32x4*)(kvn + (size_t)r * 256 + lane * 8) = o;
      }
      const float krv = bf2f(kr[j]), krp = shx(krv, 8);
      const float ko = isc ? krv : rope_apply(krv, krp, lane & 31, t);
      if (lane < 32) ((bf16_t*)(p.ws + OFF_V))[(size_t)r * 32 + rope_slot(lane)] = f2bf(ko);
    }
#pragma unroll
    for (int j = 0; j < 4; ++j) { qv[j] = qvn[j]; kv[j] = kvn_[j]; kr[j] = krn[j]; }
  }
#undef MLA_LOAD
}

__device__ void hyena_prep(const Params& p, int layer, char* smem) {
  constexpr int RS = 516;
  const bf16_t* u = (const bf16_t*)(p.ws + OFF_U);
  const float* cw = p.in[I_HCW] + (size_t)layer * 3 * 768; const float* cb = p.in[I_HCB] + layer * 768;
  const int tid = TIDX;
  const int ntile = (layer == 0) ? NCHUNK : 256;
  for (int unit = BIDX; unit < ntile * 3; unit += gridDim.x) {
    const int cid = unit / 3, part = unit % 3;
    int rbase, t0, slen, b;
    if (cid < 256) { b = cid >> 7; rbase = b * SEQ; t0 = (cid & 127) * 64; slen = SEQ; }
    else { const int q = cid - 256; b = q >> 2; rbase = NLAT + b * CTXL; t0 = (q & 3) * 64; slen = CTXL; }
    __syncthreads();
    {
      const int chunk = tid & 31;
      for (int row = tid >> 5; row < 66; row += 16) {
        const int t = t0 + row - 1;
        u32x4 v = {0u, 0u, 0u, 0u};
        if (t >= 0 && t < slen) v = *(const u32x4*)(u + (size_t)(rbase + t) * DIN + 1440 + part * 256 + chunk * 8);
        unsigned* d = (unsigned*)(smem + row * RS + chunk * 16);
        d[0] = v[0]; d[1] = v[1]; d[2] = v[2]; d[3] = v[3];
      }
    }
    __syncthreads();
    {
      const int tg = tid & 15;
      const char* tb = smem + (4 * tg) * RS;
#pragma unroll
      for (int i = 0; i < 4; ++i) {
        const int cp = (tid >> 4) + 32 * i, pc = part * 256 + 2 * cp;
        unsigned x[6];
#pragma unroll
        for (int k = 0; k < 6; ++k) x[k] = *(const unsigned*)(tb + k * RS + cp * 4);
        const float wa0 = cw[pc], wa1 = cw[768 + pc], wa2 = cw[1536 + pc], ba = cb[pc];
        const float wb0 = cw[pc + 1], wb1 = cw[768 + pc + 1], wb2 = cw[1536 + pc + 1], bb = cb[pc + 1];
        f32x4 ya, yb;
#pragma unroll
        for (int q = 0; q < 4; ++q) {
          ya[q] = ba + wa0 * __uint_as_float(x[q] << 16) + wa1 * __uint_as_float(x[q + 1] << 16) + wa2 * __uint_as_float(x[q + 2] << 16);
          yb[q] = bb + wb0 * __uint_as_float(x[q] & 0xffff0000u) + wb1 * __uint_as_float(x[q + 1] & 0xffff0000u) + wb2 * __uint_as_float(x[q + 2] & 0xffff0000u);
        }
        float* dst = (cid < 256) ? (float*)(p.ws + OFF_HYIN) + ((size_t)(part * 2 + b) * 256 + 2 * cp) * SEQ + t0 + 4 * tg
                                 : (float*)(p.ws + OFF_HYINC) + ((size_t)(part * 2 + b) * 256 + 2 * cp) * CTXL + t0 + 4 * tg;
        *(f32x4*)dst = ya; *(f32x4*)(dst + slen) = yb;
      }
    }
  }
}

__device__ void hyena_out_transpose(const Params& p, char* smem) {
  const bf16_t* yc = (const bf16_t*)(p.ws + OFF_HB); bf16_t* mix = (bf16_t*)(p.ws + OFF_MIX);
  constexpr int RS = 132;
  const int tid = TIDX;
  for (int unit = BIDX; unit < 2 * (SEQ / 64); unit += gridDim.x) {
    const int b = unit / (SEQ / 64), t0 = (unit % (SEQ / 64)) * 64;
    __syncthreads();
    {
      const int chunk = tid & 7;
      for (int c = tid >> 3; c < 256; c += 64) {
        const u32x4 v = *(const u32x4*)(yc + ((size_t)(b * 256 + c)) * SEQ + t0 + chunk * 8);
        unsigned* d = (unsigned*)(smem + c * RS + chunk * 16);
        d[0] = v[0]; d[1] = v[1]; d[2] = v[2]; d[3] = v[3];
      }
    }
    __syncthreads();
    {
      const int c8 = (tid & 31) * 8;
      for (int tl = tid >> 5; tl < 64; tl += 16) {
        unsigned short h[8];
#pragma unroll
        for (int q = 0; q < 8; ++q) h[q] = *(const unsigned short*)(smem + (c8 + q) * RS + tl * 2);
        const u32x4 o = {(unsigned)h[0] | ((unsigned)h[1] << 16), (unsigned)h[2] | ((unsigned)h[3] << 16), (unsigned)h[4] | ((unsigned)h[5] << 16), (unsigned)h[6] | ((unsigned)h[7] << 16)};
        *(u32x4*)(mix + ((size_t)b * SEQ + t0 + tl) * DM + 768 + c8) = o;
      }
    }
  }
}

__device__ void hyena_direct(const Params& p, int layer, char* smem) {
  float* zs = (float*)smem;
  float* Ts = zs + SEQ;
  bf16_t* mix = (bf16_t*)(p.ws + OFF_MIX);
  const int nunits = (layer == 0) ? 512 : 0;
  for (int unit = BIDX; unit < nunits; unit += gridDim.x) {
    const bool isc = true; const int q = unit & 511, b = q >> 8, c = q & 255;
    const int L = CTXL;
    const float* hin = (const float*)(p.ws + OFF_HYINC);
    const float* filt = (const float*)(p.ws + OFF_FILTC) + (size_t)layer * 1024 * CTXL;
    const float* ssq = (const float*)(p.ws + OFF_SSQPC) + (size_t)layer * 4 * 1024;
    const int ntt = 4;
    const int nout = (L + NTHREADS - 1) / NTHREADS;
    for (int order = 0; order < 2; ++order) {
      const int colf = (order * 2 + 0) * 256 + c, colb = (order * 2 + 1) * 256 + c;
      float sf = 0.f, sb = 0.f;
      for (int tt = 0; tt < ntt; ++tt) { sf += ssq[(size_t)tt * 1024 + colf]; sb += ssq[(size_t)tt * 1024 + colb]; }
      sf = rsqrtf(sf + EPSV); sb = rsqrtf(sb + EPSV);
      const float skip = p.in[I_HSKIP][(size_t)layer * 512 + order * 256 + c];
      __syncthreads();
      for (int i = TIDX; i < 2 * L; i += NTHREADS) {
        const int m = i - L;
        float v = 0.f;
        if (m >= 0) v = filt[(size_t)colf * L + m] * sf; else if (m > -L) v = filt[(size_t)colb * L - m] * sb;
        if (m == 0) v += skip;
        Ts[i] = v;
      }
      if (order == 0) for (int i = TIDX; i < L; i += NTHREADS) zs[i] = hin[((size_t)(0 * 2 + b) * 256 + c) * L + i];
      __syncthreads();
      float acc[16];
#pragma unroll
      for (int j = 0; j < 16; ++j) acc[j] = 0.f;
      if ((int)TIDX < L) {
        const float* tb = Ts + L + TIDX;
        if (!isc) {
          for (int s = 0; s < SEQ; ++s) {
            const float zv = zs[s];
#pragma unroll
            for (int j = 0; j < 16; ++j) acc[j] += tb[j * NTHREADS - s] * zv;
          }
        } else {
          for (int s = 0; s < CTXL; ++s) acc[0] += tb[-s] * zs[s];
        }
      }
      __syncthreads();
      const float* xg = hin + ((size_t)((1 + order) * 2 + b) * 256 + c) * L;
#pragma unroll
      for (int j = 0; j < 16; ++j) {
        const int t = TIDX + j * NTHREADS;
        if (t < L) {
          const float y = xg[t] * acc[j];
          if (order == 0) zs[t] = y;
          else { const size_t row = isc ? (size_t)NLAT + b * CTXL + t : (size_t)b * SEQ + t; mix[row * DM + 768 + c] = f2bf(y); }
        }
      }
    }
  }
}

namespace att {
constexpr int NW = 8, QBLK = 32, KVBLK = 64;
constexpr float SCALE = 0.10206207261596575f;
constexpr float THR = 8.f;
constexpr int SHM_V = KVBLK * 128 * 2, SHM_K = KVBLK * 128 * 2;
constexpr int SHM_ATTN = 2 * SHM_V + 2 * SHM_K + NW * 64 * 4;
#define KSWZ(row, colB) ((row) * 256 + ((colB) ^ (((row) & 7) << 4)))
#define SBAR() __builtin_amdgcn_sched_barrier(0)
template <int VAR> __device__ __forceinline__ float ex2(float x) { if constexpr (VAR == 2) return x; else return __builtin_amdgcn_exp2f(x); }
template <int VAR> __device__ __forceinline__ void partialSM(f32x16& p0, f32x16& p1, float& m_reg, float& mn, float& alpha) {
  constexpr float C = SCALE * 1.4426950408889634f;
  float pmax = p0[0];
#pragma unroll
  for (int r = 1; r < 16; ++r) pmax = fmaxf(pmax, p0[r]);
#pragma unroll
  for (int r = 0; r < 16; ++r) pmax = fmaxf(pmax, p1[r]);
  { auto rr = __builtin_amdgcn_permlane32_swap(__float_as_uint(pmax), __float_as_uint(pmax), false, false);
    pmax = fmaxf(__uint_as_float(rr[0]), __uint_as_float(rr[1])); }
  if (__builtin_expect(__all(pmax - m_reg <= THR / SCALE), 1)) { mn = m_reg; alpha = 1.f; }
  else { mn = fmaxf(m_reg, pmax); alpha = __builtin_amdgcn_exp2f((m_reg - mn) * C); m_reg = mn; }
  const float mnC = -mn * C;
#pragma unroll
  for (int r = 0; r < 16; ++r) p0[r] = fmaf(p0[r], C, mnC);
#pragma unroll
  for (int r = 0; r < 16; ++r) p1[r] = fmaf(p1[r], C, mnC);
#pragma unroll
  for (int r = 0; r < 16; ++r) p0[r] = ex2<VAR>(p0[r]);
}
template <int VAR> __device__ __forceinline__ void finishSM(f32x16& p0, f32x16& p1, float alpha, float& l_reg, bf16x8& pa0, bf16x8& pa1, bf16x8& pa2, bf16x8& pa3) {
#pragma unroll
  for (int r = 0; r < 16; ++r) p1[r] = ex2<VAR>(p1[r]);
  float ps = 0;
#pragma unroll
  for (int r = 0; r < 16; ++r) ps += p0[r];
#pragma unroll
  for (int r = 0; r < 16; ++r) ps += p1[r];
  { auto rr = __builtin_amdgcn_permlane32_swap(__float_as_uint(ps), __float_as_uint(ps), false, false);
    ps = __uint_as_float(rr[0]) + __uint_as_float(rr[1]); }
  l_reg = l_reg * alpha + ps;
#define PK4(P, BASE, OUT) do { unsigned a0 = cvtpk(P[BASE + 0], P[BASE + 1]), a1 = cvtpk(P[BASE + 2], P[BASE + 3]);   \
    unsigned b0 = cvtpk(P[BASE + 4], P[BASE + 5]), b1 = cvtpk(P[BASE + 6], P[BASE + 7]);                              \
    auto r0 = __builtin_amdgcn_permlane32_swap(a0, b0, false, false); auto r1 = __builtin_amdgcn_permlane32_swap(a1, b1, false, false); \
    u32x4 w = {r0[0], r1[0], r0[1], r1[1]}; OUT = *reinterpret_cast<bf16x8*>(&w); } while (0)
  PK4(p0, 0, pa0); PK4(p0, 8, pa1); PK4(p1, 0, pa2); PK4(p1, 8, pa3);
#undef PK4
}
__device__ __forceinline__ void qkt(f32x16& p0, f32x16& p1, const char* Ks, const bf16x8* qr, int r32, int hi) {
  p0 = f32x16{}; p1 = f32x16{};
#pragma unroll
  for (int d0 = 0; d0 < 6; ++d0) { const int cb = (d0 * 16 + hi * 8) * 2;
    const bf16x8 b0 = *reinterpret_cast<const bf16x8*>(Ks + KSWZ(r32, cb));
    const bf16x8 b1 = *reinterpret_cast<const bf16x8*>(Ks + KSWZ(32 + r32, cb));
    p0 = __builtin_amdgcn_mfma_f32_32x32x16_bf16(b0, qr[d0], p0, 0, 0, 0);
    p1 = __builtin_amdgcn_mfma_f32_32x32x16_bf16(b1, qr[d0], p1, 0, 0, 0); }
}
__device__ __forceinline__ int v_st(int k, int c) { const int kk = (k & ~0xC) | ((k & 4) << 1) | ((k & 8) >> 1); return ((kk >> 3) * 4 + (c >> 5)) * 512 + ((kk & 7) * 32 + (c & 31)) * 2; }
__device__ __forceinline__ int v_rd_base(int lane) { return ((lane & 3) << 3) | (((lane >> 2) & 3) << 6) | (((lane >> 4) & 1) << 5) | (((lane >> 5) & 1) << 8); }
constexpr int v_rd_off(int d0, int ks, int half) { return d0 * 512 + ks * 4096 + half * 2048; }
template <int OFF> __device__ __forceinline__ s16x4 tr_read(int vb) {
  s16x4 r; asm volatile("ds_read_b64_tr_b16 %0, %1 offset:%2" : "=&v"(r) : "v"(vb), "i"(OFF) : "memory"); return r;
}
template <int D0> __device__ __forceinline__ void pv_one(f32x16& od, int vb, bf16x8 pa0, bf16x8 pa1, bf16x8 pa2, bf16x8 pa3) {
  const s16x4 l0 = tr_read<v_rd_off(D0, 0, 0)>(vb), h0 = tr_read<v_rd_off(D0, 0, 1)>(vb), l1 = tr_read<v_rd_off(D0, 1, 0)>(vb), h1 = tr_read<v_rd_off(D0, 1, 1)>(vb);
  const s16x4 l2 = tr_read<v_rd_off(D0, 2, 0)>(vb), h2 = tr_read<v_rd_off(D0, 2, 1)>(vb), l3 = tr_read<v_rd_off(D0, 3, 0)>(vb), h3 = tr_read<v_rd_off(D0, 3, 1)>(vb);
  asm volatile("s_waitcnt lgkmcnt(0)" ::: "memory"); SBAR();
#define PK(L, H) (bf16x8){L[0], L[1], L[2], L[3], H[0], H[1], H[2], H[3]}
  od = __builtin_amdgcn_mfma_f32_32x32x16_bf16(pa0, PK(l0, h0), od, 0, 0, 0);
  od = __builtin_amdgcn_mfma_f32_32x32x16_bf16(pa1, PK(l1, h1), od, 0, 0, 0);
  od = __builtin_amdgcn_mfma_f32_32x32x16_bf16(pa2, PK(l2, h2), od, 0, 0, 0);
  od = __builtin_amdgcn_mfma_f32_32x32x16_bf16(pa3, PK(l3, h3), od, 0, 0, 0);
#undef PK
}
__device__ __forceinline__ void pv_d0(f32x16& o0, f32x16& o1, int vb, bf16x8 pa0, bf16x8 pa1, bf16x8 pa2, bf16x8 pa3) {
  pv_one<0>(o0, vb, pa0, pa1, pa2, pa3); pv_one<1>(o1, vb, pa0, pa1, pa2, pa3);
}
template <int VAR>
__device__ __forceinline__ void attn_body(const bf16_t* __restrict__ Qb, const bf16_t* __restrict__ KVh, const bf16_t* __restrict__ KR, int bsel, int key0,
                                          bf16_t* __restrict__ Ob, float* __restrict__ Op, float* __restrict__ Oml, int seq, char* lds) {
  const int tid = TIDX, wid = tid >> 6, lane = tid & 63, r32 = lane & 31, hi = lane >> 5;
  char* V_lds = lds; char* K_lds = lds + 2 * SHM_V;
  float* ws = (float*)(lds + 2 * SHM_V + 2 * SHM_K) + wid * 64; float* li_l = ws; float* al_l = ws + 32;
  float m_reg = -1e30f, l_reg = 0; f32x16 o0 = {}, o1 = {}; bf16x8 qr[6];
  const bf16_t* Qw = Qb + (size_t)(wid * QBLK + r32) * 576 + hi * 8;
#pragma unroll
  for (int d0 = 0; d0 < 6; ++d0) qr[d0] = *(const bf16x8*)(Qw + d0 * 16);
  const int sr = tid >> 4, sc = (tid & 15) * 8, vst0 = v_st(sr, sc & 63), vst1 = v_st(32 + sr, sc & 63);
  const int vb0 = (int)(uintptr_t)V_lds + v_rd_base(lane);
  const bool kact = sc < 96, vact = sc < 64;
  bf16x8 vs0 = {}, vs1 = {}, ks0 = {}, ks1 = {};
#define SLOAD(k0) do { const int kk_ = key0 + (k0); const size_t rb_ = (size_t)((kk_ < CTXL) ? NLAT + bsel * CTXL + kk_ : bsel * SEQ + kk_ - CTXL) + sr; \
    if (vact) { vs0 = *(const bf16x8*)(KVh + rb_ * 768 + 64 + sc); vs1 = *(const bf16x8*)(KVh + (rb_ + 32) * 768 + 64 + sc); } \
    if (kact) { if (sc < 64) { ks0 = *(const bf16x8*)(KVh + rb_ * 768 + sc); ks1 = *(const bf16x8*)(KVh + (rb_ + 32) * 768 + sc); } \
                else { ks0 = *(const bf16x8*)(KR + rb_ * 32 + (sc - 64)); ks1 = *(const bf16x8*)(KR + (rb_ + 32) * 32 + (sc - 64)); } } } while (0)
#define SWRITE(b) do { if (vact) { *(bf16x8*)(V_lds + (b) * SHM_V + vst0) = vs0; *(bf16x8*)(V_lds + (b) * SHM_V + vst1) = vs1; } \
    if (kact) { const int kc = sc * 2; *(bf16x8*)(K_lds + (b) * SHM_K + KSWZ(sr, kc)) = ks0; *(bf16x8*)(K_lds + (b) * SHM_K + KSWZ(32 + sr, kc)) = ks1; } } while (0)
#define SWAIT() asm volatile("s_waitcnt vmcnt(0)" ::: "memory")
#define RESC(a) do { if (__any((a) < 1.f)) { if (hi == 0) al_l[r32] = (a); asm volatile("s_waitcnt lgkmcnt(0)" ::: "memory"); \
    _Pragma("unroll") for (int r = 0; r < 16; ++r) { const float f = al_l[crow(r, hi)]; o0[r] *= f; o1[r] *= f; } } } while (0)
  f32x16 pA0, pA1, pB0, pB1; float mnA, mnB, alA, alB; bf16x8 pa0, pa1, pa2, pa3; const int NT = seq / KVBLK;
  __syncthreads();
  SLOAD(0); SWAIT(); SWRITE(0); __syncthreads();
  qkt(pA0, pA1, K_lds, qr, r32, hi); partialSM<VAR>(pA0, pA1, m_reg, mnA, alA);
  SLOAD(KVBLK);
  SWAIT(); SWRITE(1); __syncthreads();
#define LSYNC() do { if constexpr (VAR != 1) __syncthreads(); } while (0)
#define LLOAD(k0) do { if constexpr (VAR != 3) SLOAD(k0); } while (0)
#define LWRITE(b) do { if constexpr (VAR != 3) { SWAIT(); SWRITE(b); } } while (0)
#define LPV(O0, O1, VB) do { if constexpr (VAR != 5) pv_d0(O0, O1, VB, pa0, pa1, pa2, pa3); else { asm volatile("" :: "v"(pa0), "v"(pa1), "v"(pa2), "v"(pa3)); } } while (0)
  const int wodd = __builtin_amdgcn_readfirstlane(wid) & 1;
#define HALF_IT(PN0, PN1, MN, AN, PO0, PO1, AO, KB, VB) do { \
    if (!wodd) { qkt(PN0, PN1, KB, qr, r32, hi); finishSM<VAR>(PO0, PO1, AO, l_reg, pa0, pa1, pa2, pa3); SBAR(); LPV(o0, o1, VB); partialSM<VAR>(PN0, PN1, m_reg, MN, AN); } \
    else { finishSM<VAR>(PO0, PO1, AO, l_reg, pa0, pa1, pa2, pa3); SBAR(); qkt(PN0, PN1, KB, qr, r32, hi); SBAR(); partialSM<VAR>(PN0, PN1, m_reg, MN, AN); SBAR(); LPV(o0, o1, VB); } } while (0)
  for (int j = 1; j + 1 < NT; j += 2) {
    SBAR(); LLOAD((j + 1) * KVBLK); SBAR();
    HALF_IT(pB0, pB1, mnB, alB, pA0, pA1, alA, K_lds + SHM_K, vb0);
    LSYNC(); LWRITE(0);
    RESC(alB); LSYNC();
    SBAR(); LLOAD((j + 2) * KVBLK); SBAR();
    HALF_IT(pA0, pA1, mnA, alA, pB0, pB1, alB, K_lds, vb0 + SHM_V);
    LSYNC(); LWRITE(1);
    RESC(alA); LSYNC();
  }
#undef HALF_IT
#undef LSYNC
#undef LLOAD
#undef LWRITE
#undef LPV
  SBAR(); qkt(pB0, pB1, K_lds + SHM_K, qr, r32, hi);
  finishSM<VAR>(pA0, pA1, alA, l_reg, pa0, pa1, pa2, pa3); SBAR();
  pv_d0(o0, o1, vb0, pa0, pa1, pa2, pa3); partialSM<VAR>(pB0, pB1, m_reg, mnB, alB);
  __syncthreads(); RESC(alB);
  finishSM<VAR>(pB0, pB1, alB, l_reg, pa0, pa1, pa2, pa3); SBAR();
  pv_d0(o0, o1, vb0 + SHM_V, pa0, pa1, pa2, pa3);
  if (Op != nullptr) {
    float* Pw = Op + (size_t)(wid * QBLK) * 64;
#pragma unroll
    for (int r = 0; r < 16; ++r) { const int orow = crow(r, hi); Pw[(size_t)orow * 64 + r32] = o0[r]; Pw[(size_t)orow * 64 + 32 + r32] = o1[r]; }
    if (hi == 0) { Oml[(size_t)(wid * QBLK + r32) * 2] = m_reg; Oml[(size_t)(wid * QBLK + r32) * 2 + 1] = l_reg; }
  } else {
    if (hi == 0) li_l[r32] = l_reg; asm volatile("s_waitcnt lgkmcnt(0)" ::: "memory");
    bf16_t* Ow = Ob + (size_t)(wid * QBLK) * DM;
#pragma unroll
    for (int r = 0; r < 16; ++r) { const int orow = crow(r, hi); const float rl = __builtin_amdgcn_rcpf(li_l[orow]);
      Ow[(size_t)orow * DM + r32] = f2bf(o0[r] * rl); Ow[(size_t)orow * DM + 32 + r32] = f2bf(o1[r] * rl); }
  }
#undef SLOAD
#undef SWRITE
#undef SWAIT
#undef RESC
}
}

template <int VAR = 0, bool ATT_DUMMY = false>
__device__ __forceinline__ void attn_units(const Params& p, int layer, char* smem) {
  const bf16_t* Q = (const bf16_t*)(p.ws + OFF_Q);
  const bf16_t* KV = (const bf16_t*)(p.ws + OFF_K); const bf16_t* KR = (const bf16_t*)(p.ws + OFF_V);
  bf16_t* mix = (bf16_t*)(p.ws + OFF_MIX); float* opart = (float*)(p.ws + OFF_OPART); float* oml = (float*)(p.ws + OFF_OML);
  const int nunits = 512 + ((layer == 0) ? 12 : 0);
  for (int unit = BIDX; unit < nunits; unit += gridDim.x) {
    const bf16_t *qp, *kvp; bf16_t* ob; float* op = nullptr; float* ml = nullptr; int seq, bsel, key0 = 0;
    if (unit < 256) {
      const int bh = unit & 7, qb = unit >> 3, b = bh / 6, h = bh % 6;
      qp = Q + ((size_t)b * SEQ + qb * 256) * 576 + h * 96; kvp = KV + h * 128; bsel = b;
      ob = mix + ((size_t)b * SEQ + qb * 256) * DM + 384 + h * 64; seq = NKEYS;
    } else if (unit < 512) {
      const int v = unit - 256, bhi = v & 3, half = (v >> 2) & 1, qb = v >> 3, bh = 8 + bhi, b = bh / 6, h = bh % 6;
      qp = Q + ((size_t)b * SEQ + qb * 256) * 576 + h * 96; kvp = KV + h * 128; bsel = b; key0 = half * (NKEYS / 2);
      ob = mix; op = opart + ((size_t)(bhi * 2 + half) * SEQ + qb * 256) * 64; ml = oml + ((size_t)(bhi * 2 + half) * SEQ + qb * 256) * 2; seq = NKEYS / 2;
    } else {
      const int bh = unit - 512, b = bh / 6, h = bh % 6;
      qp = Q + ((size_t)NLAT + b * CTXL) * 576 + h * 96; kvp = KV + h * 128; bsel = b;
      ob = mix + ((size_t)NLAT + b * CTXL) * DM + 384 + h * 64; seq = CTXL;
    }
    if constexpr (VAR != 0 || ATT_DUMMY) {
      ob = (bf16_t*)(p.ws + OFF_HB) + (size_t)(unit & 63) * 256 * DM; if (op) { op = (float*)(p.ws + OFF_HB) + (size_t)(unit & 63) * 256 * 64; ml = op; }
    }
    att::attn_body<VAR>(qp, kvp, KR, bsel, key0, ob, op, ml, seq, smem);
  }
}
__device__ void attn_combine(const Params& p) {
  const int lane = TIDX & 63, wid = TIDX >> 6;
  const float* opart = (const float*)(p.ws + OFF_OPART); const float* oml = (const float*)(p.ws + OFF_OML); bf16_t* mix = (bf16_t*)(p.ws + OFF_MIX);
  constexpr float C = att::SCALE * 1.4426950408889634f;
  for (int grp = BIDX * 8 + wid; grp < 4 * SEQ / 4; grp += gridDim.x * 8) {
    const int idx0 = grp * 4, bhi = idx0 >> 13, q0 = idx0 & (SEQ - 1), bh = 8 + bhi, b = bh / 6, h = bh % 6;
    const size_t r0 = (size_t)(bhi * 2) * SEQ + q0, r1 = r0 + SEQ;
    float m0[4], l0[4], m1[4], l1[4], o0[4], o1[4];
#pragma unroll
    for (int j = 0; j < 4; ++j) {
      m0[j] = oml[(r0 + j) * 2]; l0[j] = oml[(r0 + j) * 2 + 1]; m1[j] = oml[(r1 + j) * 2]; l1[j] = oml[(r1 + j) * 2 + 1];
      o0[j] = opart[(r0 + j) * 64 + lane]; o1[j] = opart[(r1 + j) * 64 + lane];
    }
#pragma unroll
    for (int j = 0; j < 4; ++j) {
      const float m = fmaxf(m0[j], m1[j]), f0 = __builtin_amdgcn_exp2f((m0[j] - m) * C), f1 = __builtin_amdgcn_exp2f((m1[j] - m) * C);
      const float o = (o0[j] * f0 + o1[j] * f1) / (l0[j] * f0 + l1[j] * f1);
      mix[((size_t)b * SEQ + q0 + j) * DM + 384 + h * 64 + lane] = f2bf(o);
    }
  }
}

#define CEK(a, b) { const unsigned _h = max(k[a], k[b]), _l = min(k[a], k[b]); k[a] = _h; k[b] = _l; }
__device__ __forceinline__ void sort16k(unsigned* k) {
  CEK(0,1) CEK(2,3) CEK(0,2) CEK(1,3) CEK(1,2) CEK(4,5) CEK(6,7) CEK(4,6)
  CEK(5,7) CEK(5,6) CEK(0,4) CEK(2,6) CEK(2,4) CEK(1,5) CEK(3,7) CEK(3,5)
  CEK(1,2) CEK(3,4) CEK(5,6) CEK(8,9) CEK(10,11) CEK(8,10) CEK(9,11) CEK(9,10)
  CEK(12,13) CEK(14,15) CEK(12,14) CEK(13,15) CEK(13,14) CEK(8,12) CEK(10,14) CEK(10,12)
  CEK(9,13) CEK(11,15) CEK(11,13) CEK(9,10) CEK(11,12) CEK(13,14) CEK(0,8) CEK(4,12)
  CEK(4,8) CEK(2,10) CEK(6,14) CEK(6,10) CEK(2,4) CEK(6,8) CEK(10,12) CEK(1,9)
  CEK(5,13) CEK(5,9) CEK(3,11) CEK(7,15) CEK(7,11) CEK(3,5) CEK(7,9) CEK(11,13)
  CEK(1,2) CEK(3,4) CEK(5,6) CEK(7,8) CEK(9,10) CEK(11,12) CEK(13,14)
}
__device__ __forceinline__ void bmerge16k(unsigned* k) {
  CEK(0,8) CEK(1,9) CEK(2,10) CEK(3,11) CEK(4,12) CEK(5,13) CEK(6,14) CEK(7,15)
  CEK(0,4) CEK(1,5) CEK(2,6) CEK(3,7) CEK(8,12) CEK(9,13) CEK(10,14) CEK(11,15)
  CEK(0,2) CEK(1,3) CEK(4,6) CEK(5,7) CEK(8,10) CEK(9,11) CEK(12,14) CEK(13,15)
  CEK(0,1) CEK(2,3) CEK(4,5) CEK(6,7) CEK(8,9) CEK(10,11) CEK(12,13) CEK(14,15)
}
#undef CEK
#define CEP(a, b) { const bool _s = v[a] < v[b]; const float _va = _s ? v[b] : v[a], _vb = _s ? v[a] : v[b]; const int _pa = _s ? pl[b] : pl[a], _pb = _s ? pl[a] : pl[b]; \
                    v[a] = _va; v[b] = _vb; pl[a] = _pa; pl[b] = _pb; }
__device__ __forceinline__ void sort16p(float* v, int* pl) {
  CEP(0,1) CEP(2,3) CEP(0,2) CEP(1,3)
  CEP(1,2) CEP(4,5) CEP(6,7) CEP(4,6)
  CEP(5,7) CEP(5,6) CEP(0,4) CEP(2,6)
  CEP(2,4) CEP(1,5) CEP(3,7) CEP(3,5)
  CEP(1,2) CEP(3,4) CEP(5,6) CEP(8,9)
  CEP(10,11) CEP(8,10) CEP(9,11) CEP(9,10)
  CEP(12,13) CEP(14,15) CEP(12,14) CEP(13,15)
  CEP(13,14) CEP(8,12) CEP(10,14) CEP(10,12)
  CEP(9,13) CEP(11,15) CEP(11,13) CEP(9,10)
  CEP(11,12) CEP(13,14) CEP(0,8) CEP(4,12)
  CEP(4,8) CEP(2,10) CEP(6,14) CEP(6,10)
  CEP(2,4) CEP(6,8) CEP(10,12) CEP(1,9)
  CEP(5,13) CEP(5,9) CEP(3,11) CEP(7,15)
  CEP(7,11) CEP(3,5) CEP(7,9) CEP(11,13)
  CEP(1,2) CEP(3,4) CEP(5,6) CEP(7,8)
  CEP(9,10) CEP(11,12) CEP(13,14)
}
__device__ __forceinline__ void bmerge16p(float* v, int* pl) {
  CEP(0,8) CEP(1,9) CEP(2,10) CEP(3,11)
  CEP(4,12) CEP(5,13) CEP(6,14) CEP(7,15)
  CEP(0,4) CEP(1,5) CEP(2,6) CEP(3,7)
  CEP(8,12) CEP(9,13) CEP(10,14) CEP(11,15)
  CEP(0,2) CEP(1,3) CEP(4,6) CEP(5,7)
  CEP(8,10) CEP(9,11) CEP(12,14) CEP(13,15)
  CEP(0,1) CEP(2,3) CEP(4,5) CEP(6,7)
  CEP(8,9) CEP(10,11) CEP(12,13) CEP(14,15)
}
#undef CEP
__device__ __forceinline__ unsigned fkey(float f, int low7) { unsigned u = __float_as_uint(f); u ^= (unsigned)((int)u >> 31) | 0x80000000u; return (u & ~127u) | (unsigned)low7; }
__device__ __forceinline__ float funkey(unsigned k) { unsigned u = k & ~127u; u ^= (u & 0x80000000u) ? 0x80000000u : 0xFFFFFFFFu; return __uint_as_float(u); }
__device__ __forceinline__ void peer_half_top16(const char* __restrict__ kl  , int r32, const bf16_t* __restrict__ qp, int hi, unsigned* T) {
  bf16x8 bq[8]; int kofs[8];
#pragma unroll
  for (int ks = 0; ks < 8; ++ks) { bq[ks] = *(const bf16x8*)(qp + ks * 16); kofs[ks] = r32 * 256 + (((ks * 16 + hi * 8) * 2) ^ ((r32 & 7) << 4)); }
  unsigned L[16];
#pragma unroll
  for (int mt = 0; mt < 4; ++mt) {
    f32x16 acc = {};
#pragma unroll
    for (int ks = 0; ks < 8; ++ks) {
      const bf16x8 a = *(const bf16x8*)(kl + mt * 8192 + kofs[ks]);
      acc = __builtin_amdgcn_mfma_f32_32x32x16_bf16(a, bq[ks], acc, 0, 0, 0);
    }
    unsigned k[16];
#pragma unroll
    for (int r = 0; r < 16; ++r) k[r] = fkey(acc[r], 127 - (mt * 32 + (r & 3) + 8 * (r >> 2) + 4 * hi));
    sort16k(k);
    if (mt == 0) {
#pragma unroll
      for (int i = 0; i < 16; ++i) L[i] = k[i];
    } else {
#pragma unroll
      for (int i = 0; i < 16; ++i) L[i] = max(L[i], k[15 - i]);
      bmerge16k(L);
    }
  }
#pragma unroll
  for (int i = 0; i < 16; ++i) {
    const auto rr = __builtin_amdgcn_permlane32_swap(L[15 - i], L[15 - i], false, false);
    const unsigned partner = hi ? rr[0] : rr[1];
    T[i] = max(L[i], partner);
  }
  bmerge16k(T);
}
__device__ void peer_topk(const Params& p, int layer, int nrows, char* smem) {
  const int tid = TIDX, wid = tid >> 6, lane = tid & 63, r32 = lane & 31, hi = lane >> 5;
  const bf16_t* pq = (const bf16_t*)(p.ws + OFF_PQ);
  const bf16_t* keys = (const bf16_t*)(p.ws + OFF_KEYS) + (size_t)layer * 2 * 128 * 128;
  int* eid = (int*)(p.ws + OFF_EID); float* gate = (float*)(p.ws + OFF_GATE);
  __syncthreads();
  for (int i = tid; i < 4096; i += NTHREADS) {
    const int half = i >> 11, key = (i >> 4) & 127, c16 = i & 15;
    *(u32x4*)(smem + half * 32768 + KSWZ(key, c16 * 16)) = *(const u32x4*)(keys + (size_t)(half * 128 + key) * 128 + c16 * 8);
  }
  __syncthreads();
  const int ntask = (nrows / 32) * 8;
  for (int task = BIDX * 8 + wid; task < ntask; task += gridDim.x * 8) {
    const int grp = task >> 3, h = task & 7;
    const size_t row = (size_t)grp * 32 + r32;
    unsigned K1[16], K2[16];
    const int lofs = launder_v(0);
    peer_half_top16(smem + lofs, r32, pq + row * 2048 + h * 256 + hi * 8, hi, K1);
    peer_half_top16(smem + lofs + 32768, r32, pq + row * 2048 + h * 256 + 128 + hi * 8, hi, K2);
    float v1[16], v2[16]; int i1[16], i2[16];
#pragma unroll
    for (int i = 0; i < 16; ++i) { v1[i] = funkey(K1[i]); v2[i] = funkey(K2[i]); i1[i] = 127 - (int)(K1[i] & 127u); i2[i] = 127 - (int)(K2[i] & 127u); }
    float ts[16]; int tp[16];
    {
      float* cv = ts; int* cp = tp;
    cv[0] = v1[0] + v2[0]; cp[0] = (i1[0] << 7) | i2[0];
    cv[1] = v1[0] + v2[1]; cp[1] = (i1[0] << 7) | i2[1];
    cv[2] = v1[0] + v2[2]; cp[2] = (i1[0] << 7) | i2[2];
    cv[3] = v1[0] + v2[3]; cp[3] = (i1[0] << 7) | i2[3];
    cv[4] = v1[0] + v2[4]; cp[4] = (i1[0] << 7) | i2[4];
    cv[5] = v1[0] + v2[5]; cp[5] = (i1[0] << 7) | i2[5];
    cv[6] = v1[0] + v2[6]; cp[6] = (i1[0] << 7) | i2[6];
    cv[7] = v1[0] + v2[7]; cp[7] = (i1[0] << 7) | i2[7];
    cv[8] = v1[0] + v2[8]; cp[8] = (i1[0] << 7) | i2[8];
    cv[9] = v1[0] + v2[9]; cp[9] = (i1[0] << 7) | i2[9];
    cv[10] = v1[0] + v2[10]; cp[10] = (i1[0] << 7) | i2[10];
    cv[11] = v1[0] + v2[11]; cp[11] = (i1[0] << 7) | i2[11];
    cv[12] = v1[0] + v2[12]; cp[12] = (i1[0] << 7) | i2[12];
    cv[13] = v1[0] + v2[13]; cp[13] = (i1[0] << 7) | i2[13];
    cv[14] = v1[0] + v2[14]; cp[14] = (i1[0] << 7) | i2[14];
    cv[15] = v1[0] + v2[15]; cp[15] = (i1[0] << 7) | i2[15];
      sort16p(ts, tp);
    }
#pragma unroll 1
    for (int g = 1; g < 3; ++g) {
      float cv[16]; int cp[16];
      if (g == 1) {
    cv[0] = v1[1] + v2[0]; cp[0] = (i1[1] << 7) | i2[0];
    cv[1] = v1[1] + v2[1]; cp[1] = (i1[1] << 7) | i2[1];
    cv[2] = v1[1] + v2[2]; cp[2] = (i1[1] << 7) | i2[2];
    cv[3] = v1[1] + v2[3]; cp[3] = (i1[1] << 7) | i2[3];
    cv[4] = v1[1] + v2[4]; cp[4] = (i1[1] << 7) | i2[4];
    cv[5] = v1[1] + v2[5]; cp[5] = (i1[1] << 7) | i2[5];
    cv[6] = v1[1] + v2[6]; cp[6] = (i1[1] << 7) | i2[6];
    cv[7] = v1[1] + v2[7]; cp[7] = (i1[1] << 7) | i2[7];
    cv[8] = v1[2] + v2[0]; cp[8] = (i1[2] << 7) | i2[0];
    cv[9] = v1[2] + v2[1]; cp[9] = (i1[2] << 7) | i2[1];
    cv[10] = v1[2] + v2[2]; cp[10] = (i1[2] << 7) | i2[2];
    cv[11] = v1[2] + v2[3]; cp[11] = (i1[2] << 7) | i2[3];
    cv[12] = v1[2] + v2[4]; cp[12] = (i1[2] << 7) | i2[4];
    cv[13] = v1[3] + v2[0]; cp[13] = (i1[3] << 7) | i2[0];
    cv[14] = v1[3] + v2[1]; cp[14] = (i1[3] << 7) | i2[1];
    cv[15] = v1[3] + v2[2]; cp[15] = (i1[3] << 7) | i2[2];
      } else {
    cv[0] = v1[3] + v2[3]; cp[0] = (i1[3] << 7) | i2[3];
    cv[1] = v1[4] + v2[0]; cp[1] = (i1[4] << 7) | i2[0];
    cv[2] = v1[4] + v2[1]; cp[2] = (i1[4] << 7) | i2[1];
    cv[3] = v1[4] + v2[2]; cp[3] = (i1[4] << 7) | i2[2];
    cv[4] = v1[5] + v2[0]; cp[4] = (i1[5] << 7) | i2[0];
    cv[5] = v1[5] + v2[1]; cp[5] = (i1[5] << 7) | i2[1];
    cv[6] = v1[6] + v2[0]; cp[6] = (i1[6] << 7) | i2[0];
    cv[7] = v1[6] + v2[1]; cp[7] = (i1[6] << 7) | i2[1];
    cv[8] = v1[7] + v2[0]; cp[8] = (i1[7] << 7) | i2[0];
    cv[9] = v1[7] + v2[1]; cp[9] = (i1[7] << 7) | i2[1];
    cv[10] = v1[8] + v2[0]; cp[10] = (i1[8] << 7) | i2[0];
    cv[11] = v1[9] + v2[0]; cp[11] = (i1[9] << 7) | i2[0];
    cv[12] = v1[10] + v2[0]; cp[12] = (i1[10] << 7) | i2[0];
    cv[13] = v1[11] + v2[0]; cp[13] = (i1[11] << 7) | i2[0];
    cv[14] = v1[12] + v2[0]; cp[14] = (i1[12] << 7) | i2[0];
    cv[15] = v1[13] + v2[0]; cp[15] = (i1[13] << 7) | i2[0];
      }
      sort16p(cv, cp);
#pragma unroll
      for (int i = 0; i < 16; ++i) if (cv[15 - i] > ts[i]) { ts[i] = cv[15 - i]; tp[i] = cp[15 - i]; }
      bmerge16p(ts, tp);
    }
    {
      float cv[2]; int cp[2];
    cv[0] = v1[14] + v2[0]; cp[0] = (i1[14] << 7) | i2[0];
    cv[1] = v1[15] + v2[0]; cp[1] = (i1[15] << 7) | i2[0];
      if (cv[0] < cv[1]) { const float tv = cv[0]; cv[0] = cv[1]; cv[1] = tv; const int ti = cp[0]; cp[0] = cp[1]; cp[1] = ti; }
      if (cv[1] > ts[14]) { ts[14] = cv[1]; tp[14] = cp[1]; }
      if (cv[0] > ts[15]) { ts[15] = cv[0]; tp[15] = cp[0]; }
      bmerge16p(ts, tp);
    }
    float ex[16], sm = 0.f;
#pragma unroll
    for (int i = 0; i < 16; ++i) { ex[i] = __expf(ts[i] - ts[0]); sm += ex[i]; }
    const float rs = 1.f / sm;
    if (hi == 0) {
      int* eo = eid + row * 128 + h * 16;
#pragma unroll
      for (int i = 0; i < 4; ++i) { const u32x4 o = {(unsigned)tp[4 * i], (unsigned)tp[4 * i + 1], (unsigned)tp[4 * i + 2], (unsigned)tp[4 * i + 3]}; *(u32x4*)(eo + 4 * i) = o; }
    } else {
      float* go = gate + row * 128 + h * 16;
#pragma unroll
      for (int i = 0; i < 4; ++i) { const f32x4 o = {ex[4 * i] * rs, ex[4 * i + 1] * rs, ex[4 * i + 2] * rs, ex[4 * i + 3] * rs}; *(f32x4*)(go + 4 * i) = o; }
    }
  }
}

constexpr float PEER_USCALE = 16.f;
__device__ void peer_cvt_tables(const Params& p, int layer, int rank, int nb) {
  const float* ut = p.in[I_PU] + (size_t)layer * 16384 * DM; const float* vt = p.in[I_PV] + (size_t)layer * 16384 * DM;
  u32x4* uo = (u32x4*)(p.ws + OFF_UTAB); u32x4* vo = (u32x4*)(p.ws + OFF_VTAB);
  const int n16 = 16384 * DM / 16, stride = nb * NTHREADS;
  for (int i = rank * NTHREADS + TIDX; i < 2 * n16; i += 2 * stride) {
    f32x4 a[2][4];
#pragma unroll
    for (int k = 0; k < 2; ++k) {
      const int ii = i + k * stride;
      if (ii < 2 * n16) {
        const bool isv = ii >= n16; const int j = isv ? ii - n16 : ii;
        const float* s = (isv ? vt : ut) + (size_t)j * 16;
#pragma unroll
        for (int q = 0; q < 4; ++q) a[k][q] = *(const f32x4*)(s + 4 * q);
      }
    }
#pragma unroll
    for (int k = 0; k < 2; ++k) {
      const int ii = i + k * stride;
      if (ii < 2 * n16) {
        const bool isv = ii >= n16; const int j = isv ? ii - n16 : ii; const float sc = isv ? 1.f : PEER_USCALE;
        u32x4 o;
#pragma unroll
        for (int q = 0; q < 4; ++q) {
          int w = __builtin_amdgcn_cvt_pk_fp8_f32(a[k][q][0] * sc, a[k][q][1] * sc, 0, false);
          w = __builtin_amdgcn_cvt_pk_fp8_f32(a[k][q][2] * sc, a[k][q][3] * sc, w, true);
          o[q] = (unsigned)w;
        }
        (isv ? vo : uo)[j] = o;
      }
    }
  }
}

__device__ __forceinline__ int xcc_slice() { return (int)((unsigned)__builtin_amdgcn_s_getreg((3 << 11) | 20) & 7u); }
__device__ __forceinline__ float row16_sum(float v) { v += dpp_mov<0xB1>(v); v += dpp_mov<0x4E>(v); v += dpp_mov<0x141>(v); v += dpp_mov<0x128>(v); return v; }
constexpr int PNS = 8;
constexpr int PSEGL = 8;
constexpr int PEPL = 64 / PSEGL;
constexpr int PNI = 128 / PEPL;
constexpr int PCOLS = 1024 / PNS;
using f32x2 = __attribute__((ext_vector_type(2))) float;
template <int PHASE>
__device__ void peer_sliced(const Params& p, int layer, int nrows) {
#if defined(PROBE_PEER_REP)
  int nrep = (PHASE == PROBE_PEER_REP) ? 2 : 1; asm volatile("" : "+s"(nrep));
#else
  constexpr int nrep = 1;
#endif
  for (int rep = 0; rep < nrep; ++rep) {
  const int dry = (rep + 1 < nrep) ? 1 : 0;
  const int lane = TIDX & 63, eg = lane / PSEGL, ch = lane % PSEGL;
  const bf16_t* hb = (const bf16_t*)(p.ws + OFF_HB);
  const int* eid = (const int*)(p.ws + OFF_EID);
  const unsigned char* tab = (const unsigned char*)(p.ws + (PHASE == 0 ? OFF_UTAB : OFF_VTAB)) + ch * 16;
  float* sp = (float*)(p.ws + OFF_SP); const float* wbuf = (const float*)(p.ws + OFF_WBUF);
  float* xs = (float*)(p.ws + OFF_XS);
  unsigned* ctr = (unsigned*)(p.ws + OFF_CTR) + (size_t)(((rep * 2 + layer) * 2 + PHASE) * 16) * 64;
  const int x0 = xcc_slice();
  const int bpa = eg << 2;
  for (int si = 0; si < PNS; ++si) {
    const int slice = (x0 + si) % PNS;
    int nbase = 0;
    if (lane == 0) nbase = (int)__hip_atomic_fetch_add(&ctr[slice * 64], 4u, __ATOMIC_RELAXED, __HIP_MEMORY_SCOPE_AGENT);
    for (;;) {
      const int base = __builtin_amdgcn_readfirstlane(nbase);
      if (base >= nrows) break;
      if (lane == 0) nbase = (int)__hip_atomic_fetch_add(&ctr[slice * 64], 4u, __ATOMIC_RELAXED, __HIP_MEMORY_SCOPE_AGENT);
      int eA = eid[(size_t)base * 128 + lane], eB = eid[(size_t)base * 128 + 64 + lane];
      float wA = 0.f, wB = 0.f;
      if (PHASE == 1) { wA = wbuf[(size_t)base * 128 + lane]; wB = wbuf[(size_t)base * 128 + 64 + lane]; }
#pragma unroll 1
      for (int tt = 0; tt < 4; ++tt) {
        const int r = base + tt;
        const int ceA = eA, ceB = eB; const float cwA = wA, cwB = wB;
        if (tt < 3) {
          eA = eid[(size_t)(r + 1) * 128 + lane]; eB = eid[(size_t)(r + 1) * 128 + 64 + lane];
          if (PHASE == 1) { wA = wbuf[(size_t)(r + 1) * 128 + lane]; wB = wbuf[(size_t)(r + 1) * 128 + 64 + lane]; }
        }
        int ev[PNI];
#pragma unroll
        for (int i = 0; i < PNI; ++i) ev[i] = __builtin_amdgcn_ds_bpermute(bpa + 32 * (i & 7), (i < 8) ? ceA : ceB);
        if (PHASE == 0) {
          float xv[16];
          {
            const u32x4 xa = *(const u32x4*)(hb + (size_t)r * DM + slice * PCOLS + ch * 16), xb = *(const u32x4*)(hb + (size_t)r * DM + slice * PCOLS + ch * 16 + 8);
#pragma unroll
            for (int q = 0; q < 4; ++q) { xv[2 * q] = __uint_as_float(xa[q] << 16); xv[2 * q + 1] = __uint_as_float(xa[q] & 0xffff0000u);
                                          xv[8 + 2 * q] = __uint_as_float(xb[q] << 16); xv[8 + 2 * q + 1] = __uint_as_float(xb[q] & 0xffff0000u); }
          }
          u32x4 uv[PNI];
#pragma unroll
          for (int j = 0; j < PNI; ++j) uv[j] = *(const u32x4*)(tab + (size_t)ev[j] * DM + slice * PCOLS);
          float keep0 = 0.f, keep1 = 0.f;
#pragma unroll
          for (int j = 0; j < PNI; ++j) {
            float d = 0.f;
#pragma unroll
            for (int q = 0; q < 4; ++q) {
              const f32x2 lo = __builtin_amdgcn_cvt_pk_f32_fp8((int)uv[j][q], false), hi2 = __builtin_amdgcn_cvt_pk_f32_fp8((int)uv[j][q], true);
              d += lo[0] * xv[4 * q] + lo[1] * xv[4 * q + 1] + hi2[0] * xv[4 * q + 2] + hi2[1] * xv[4 * q + 3];
            }
            d += dpp_mov<0xB1>(d); d += dpp_mov<0x4E>(d); d += dpp_mov<0x141>(d);
            if (ch == (j % PSEGL)) { if (j < PSEGL) keep0 = d; else keep1 = d; }
          }
          float* so = sp + ((size_t)slice * NTOK + r) * 128 + PEPL * ch + eg;
          so[0] = keep0 * (1.f / PEER_USCALE); so[64] = keep1 * (1.f / PEER_USCALE);
        } else {
          u32x4 vv[PNI];
#pragma unroll
          for (int j = 0; j < PNI; ++j) vv[j] = *(const u32x4*)(tab + (size_t)ev[j] * DM + slice * PCOLS);
          float acc[16];
#pragma unroll
          for (int j = 0; j < 16; ++j) acc[j] = 0.f;
#pragma unroll
          for (int j = 0; j < PNI; ++j) {
            const float w = __int_as_float(__builtin_amdgcn_ds_bpermute(bpa + 32 * (j & 7), __float_as_int((j < 8) ? cwA : cwB)));
#pragma unroll
            for (int q = 0; q < 4; ++q) {
              const f32x2 lo = __builtin_amdgcn_cvt_pk_f32_fp8((int)vv[j][q], false), hi2 = __builtin_amdgcn_cvt_pk_f32_fp8((int)vv[j][q], true);
              acc[4 * q] += w * lo[0]; acc[4 * q + 1] += w * lo[1]; acc[4 * q + 2] += w * hi2[0]; acc[4 * q + 3] += w * hi2[1];
            }
          }
#pragma unroll
          for (int j = 0; j < 16; ++j) {
            acc[j] += dpp_mov<0x128>(acc[j]);
            { auto rr = __builtin_amdgcn_permlane16_swap(__float_as_uint(acc[j]), __float_as_uint(acc[j]), false, false); acc[j] = __uint_as_float(rr[0]) + __uint_as_float(rr[1]); }
            { auto rr = __builtin_amdgcn_permlane32_swap(__float_as_uint(acc[j]), __float_as_uint(acc[j]), false, false); acc[j] = __uint_as_float(rr[0]) + __uint_as_float(rr[1]); }
          }
          if (eg == 0) {
            int b, t, isc; row_info(r, b, t, isc);
            const float* g2 = (const float*)(p.ws + OFF_MOD) + ((size_t)layer * 3 + (isc ? 2 : b)) * 6144 + 5120 + slice * PCOLS + ch * 16;
            float* xr = xs + (size_t)r * DM + slice * PCOLS + ch * 16;
#pragma unroll
            for (int q = 0; q < 4; ++q) {
              f32x4 xq = *(const f32x4*)(xr + 4 * q);
#pragma unroll
              for (int j = 0; j < 4; ++j) xq[j] += g2[4 * q + j] * acc[4 * q + j];
              if (dry == 0) *(f32x4*)(xr + 4 * q) = xq;
            }
          }
        }
      }
    }
  }
  }
}
__device__ void peer_weights(const Params& p, int nrows) {
  const float* sp = (const float*)(p.ws + OFF_SP); const float* gate = (const float*)(p.ws + OFF_GATE); float* wbuf = (float*)(p.ws + OFF_WBUF);
  for (int i = BIDX * NTHREADS + TIDX; i < nrows * 128; i += gridDim.x * NTHREADS) {
    float s = 0.f;
#pragma unroll
    for (int x = 0; x < PNS; ++x) s += sp[(size_t)x * NTOK * 128 + i];
    wbuf[i] = gate[i] * gelu_tanh(s);
  }
}

__device__ void peer_eval_fused(const Params& p, int layer, int nrows, char* smem) {
  const int tid = TIDX, wid = tid >> 6, lane = tid & 63, eg = lane >> 3, ch = lane & 7;
  const int ntb = nrows / (int)gridDim.x, tok0 = BIDX * ntb;
  float* S = (float*)smem;
  int* E = (int*)(smem + 72 * 128 * 4);
  const bf16_t* hb = (const bf16_t*)(p.ws + OFF_HB);
  const int* eid = (const int*)(p.ws + OFF_EID); const float* gate = (const float*)(p.ws + OFF_GATE);
  const unsigned char* utab = (const unsigned char*)(p.ws + OFF_UTAB) + ch * 16; const unsigned char* vtab = (const unsigned char*)(p.ws + OFF_VTAB) + ch * 16;
  float* xs = (float*)(p.ws + OFF_XS);
  __syncthreads();
  for (int i = tid; i < ntb * 128; i += NTHREADS) { S[i] = 0.f; E[i] = eid[(size_t)tok0 * 128 + i]; }
  __syncthreads();
#pragma unroll 1
  for (int it = wid; it < ntb * 8; it += 8) {
    const int slice = it / ntb, tl = it - slice * ntb, r = tok0 + tl;
    int ev[16];
#pragma unroll
    for (int j = 0; j < 16; ++j) ev[j] = E[tl * 128 + 8 * j + eg];
    float xv[16];
    {
      const u32x4 xa = *(const u32x4*)(hb + (size_t)r * DM + slice * 128 + ch * 16), xb = *(const u32x4*)(hb + (size_t)r * DM + slice * 128 + ch * 16 + 8);
#pragma unroll
      for (int q = 0; q < 4; ++q) { xv[2 * q] = __uint_as_float(xa[q] << 16); xv[2 * q + 1] = __uint_as_float(xa[q] & 0xffff0000u);
                                    xv[8 + 2 * q] = __uint_as_float(xb[q] << 16); xv[8 + 2 * q + 1] = __uint_as_float(xb[q] & 0xffff0000u); }
    }
    u32x4 uv[16];
#pragma unroll
    for (int j = 0; j < 16; ++j) uv[j] = *(const u32x4*)(utab + (size_t)ev[j] * DM + slice * 128);
    float keep0 = 0.f, keep1 = 0.f;
#pragma unroll
    for (int j = 0; j < 16; ++j) {
      float d = 0.f;
#pragma unroll
      for (int q = 0; q < 4; ++q) {
        const f32x2 lo = __builtin_amdgcn_cvt_pk_f32_fp8((int)uv[j][q], false), hi2 = __builtin_amdgcn_cvt_pk_f32_fp8((int)uv[j][q], true);
        d += lo[0] * xv[4 * q] + lo[1] * xv[4 * q + 1] + hi2[0] * xv[4 * q + 2] + hi2[1] * xv[4 * q + 3];
      }
      d += dpp_mov<0xB1>(d); d += dpp_mov<0x4E>(d); d += dpp_mov<0x141>(d);
      if (ch == (j & 7)) { if (j < 8) keep0 = d; else keep1 = d; }
    }
    atomicAdd(&S[tl * 128 + 8 * ch + eg], keep0); atomicAdd(&S[tl * 128 + 64 + 8 * ch + eg], keep1);
  }
  __syncthreads();
  for (int i = tid; i < ntb * 128; i += NTHREADS) S[i] = gate[(size_t)tok0 * 128 + i] * gelu_tanh(S[i] * (1.f / PEER_USCALE));
  __syncthreads();
#pragma unroll 1
  for (int it = wid; it < ntb * 8; it += 8) {
    const int slice = it / ntb, tl = it - slice * ntb, r = tok0 + tl;
    int ev[16]; float wv[16];
#pragma unroll
    for (int j = 0; j < 16; ++j) { ev[j] = E[tl * 128 + 8 * j + eg]; wv[j] = S[tl * 128 + 8 * j + eg]; }
    u32x4 vv[16];
#pragma unroll
    for (int j = 0; j < 16; ++j) vv[j] = *(const u32x4*)(vtab + (size_t)ev[j] * DM + slice * 128);
    float acc[16];
#pragma unroll
    for (int j = 0; j < 16; ++j) acc[j] = 0.f;
#pragma unroll
    for (int j = 0; j < 16; ++j) {
      const float w = wv[j];
#pragma unroll
      for (int q = 0; q < 4; ++q) {
        const f32x2 lo = __builtin_amdgcn_cvt_pk_f32_fp8((int)vv[j][q], false), hi2 = __builtin_amdgcn_cvt_pk_f32_fp8((int)vv[j][q], true);
        acc[4 * q] += w * lo[0]; acc[4 * q + 1] += w * lo[1]; acc[4 * q + 2] += w * hi2[0]; acc[4 * q + 3] += w * hi2[1];
      }
    }
#pragma unroll
    for (int j = 0; j < 16; ++j) {
      acc[j] += dpp_mov<0x128>(acc[j]);
      { auto rr = __builtin_amdgcn_permlane16_swap(__float_as_uint(acc[j]), __float_as_uint(acc[j]), false, false); acc[j] = __uint_as_float(rr[0]) + __uint_as_float(rr[1]); }
      { auto rr = __builtin_amdgcn_permlane32_swap(__float_as_uint(acc[j]), __float_as_uint(acc[j]), false, false); acc[j] = __uint_as_float(rr[0]) + __uint_as_float(rr[1]); }
    }
    if (eg == 0) {
      int b, t, isc; row_info(r, b, t, isc);
      const float* g2 = (const float*)(p.ws + OFF_MOD) + ((size_t)layer * 3 + (isc ? 2 : b)) * 6144 + 5120 + slice * 128 + ch * 16;
      float* xr = xs + (size_t)r * DM + slice * 128 + ch * 16;
#pragma unroll
      for (int q = 0; q < 4; ++q) {
        f32x4 xq = *(const f32x4*)(xr + 4 * q);
#pragma unroll
        for (int j = 0; j < 4; ++j) xq[j] += g2[4 * q + j] * acc[4 * q + j];
        *(f32x4*)(xr + 4 * q) = xq;
      }
    }
  }
  __syncthreads();
  {
    const bool last = (layer == 1);
    const float* g = last ? p.in[I_FG] : p.in[I_N1G] + (layer + 1) * DM;
    bf16_t* hbw = (bf16_t*)(p.ws + OFF_HB);
#pragma unroll 1
    for (int tl0 = wid * 3; tl0 < ntb; tl0 += 24) {
      f32x4 v[3][4]; float ss[3]; const float* modj[3];
#pragma unroll
      for (int j = 0; j < 3; ++j) {
        int b, t, isc; row_info(min(tok0 + tl0 + j, tok0 + ntb - 1), b, t, isc);
        modj[j] = (const float*)(p.ws + OFF_MOD) + ((size_t)(last ? 1 : layer + 1) * 3 + (isc ? 2 : b)) * 6144;
      }
#pragma unroll
      for (int j = 0; j < 3; ++j) {
        const int r = min(tok0 + tl0 + j, tok0 + ntb - 1);
        ss[j] = 0.f;
#pragma unroll
        for (int i = 0; i < 4; ++i) { v[j][i] = *(const f32x4*)(xs + (size_t)r * DM + (i * 64 + lane) * 4); ss[j] += v[j][i][0] * v[j][i][0] + v[j][i][1] * v[j][i][1] + v[j][i][2] * v[j][i][2] + v[j][i][3] * v[j][i][3]; }
      }
#pragma unroll
      for (int j = 0; j < 3; ++j) ss[j] = rsqrtf(wave_sum(ss[j]) * (1.f / DM) + EPSV);
#pragma unroll
      for (int i = 0; i < 4; ++i) {
        const int c0 = (i * 64 + lane) * 4; const f32x4 gv = *(const f32x4*)(g + c0);
#pragma unroll
        for (int j = 0; j < 3; ++j) {
          const int r = tok0 + tl0 + j;
          if (tl0 + j < ntb) {
            if (last) { if (r < NLAT) *(f32x4*)(p.out + (size_t)r * DM + c0) = v[j][i] * ss[j] * gv; }
            else {
              const f32x4 sc = *(const f32x4*)(modj[j] + 1024 + c0), sh = *(const f32x4*)(modj[j] + c0);
              float y[4];
#pragma unroll
              for (int q = 0; q < 4; ++q) y[q] = v[j][i][q] * ss[j] * gv[q] * (1.f + sc[q]) + sh[q];
              const u32x2 o = {cvtpk(y[0], y[1]), cvtpk(y[2], y[3])};
              *(u32x2*)(hbw + (size_t)r * DM + c0) = o;
            }
          }
        }
      }
    }
  }
}

__device__ void final_norm(const Params& p) {
  const int lane = TIDX & 63, wid = TIDX >> 6;
  const float* xs = (const float*)(p.ws + OFF_XS); const float* g = p.in[I_FG];
  for (int grp = BIDX * 8 + wid; grp < NLAT / 4; grp += gridDim.x * 8) {
    const int r0 = grp * 4;
    f32x4 v[4][4]; float ss[4];
#pragma unroll
    for (int j = 0; j < 4; ++j) {
      ss[j] = 0.f;
#pragma unroll
      for (int i = 0; i < 4; ++i) { v[j][i] = *(const f32x4*)(xs + (size_t)(r0 + j) * DM + (i * 64 + lane) * 4); ss[j] += v[j][i][0] * v[j][i][0] + v[j][i][1] * v[j][i][1] + v[j][i][2] * v[j][i][2] + v[j][i][3] * v[j][i][3]; }
    }
#pragma unroll
    for (int j = 0; j < 4; ++j) ss[j] = rsqrtf(wave_sum(ss[j]) * (1.f / DM) + EPSV);
#pragma unroll
    for (int i = 0; i < 4; ++i) {
      const int c0 = (i * 64 + lane) * 4; const f32x4 gv = *(const f32x4*)(g + c0);
#pragma unroll
      for (int j = 0; j < 4; ++j) { const f32x4 o = v[j][i] * ss[j] * gv; *(f32x4*)(p.out + (size_t)(r0 + j) * DM + c0) = o; }
    }
  }
}

namespace pg8 {
#define PG8_LAS __attribute__((address_space(3)))
typedef unsigned short bf16_t;
typedef short bf16x8 __attribute__((ext_vector_type(8)));
typedef float f32x4 __attribute__((ext_vector_type(4)));
typedef unsigned u32x4 __attribute__((ext_vector_type(4)));
constexpr int BM = 256, BK = 64, HALF = 128, HTB = HALF * BK * 2  , STAGE_BYTES = 8 * HTB, NXCD = 8, WGM = 8;

__host__ __device__ __forceinline__ int lds_byte(int r, int c) { const int st = (r >> 4) * 2 + (c >> 5), rr = r & 15, cc = c & 31, ob = rr * 64 + cc * 2; return st * 1024 + (ob ^ (((ob >> 9) & 1) << 5)); }
__host__ __device__ __forceinline__ void stage_rc(int b, int& R, int& C) { const int st = b / 1024, sb = b % 1024, swz = sb ^ (((sb >> 9) & 1) << 5); R = (st >> 1) * 16 + swz / 64; C = (st & 1) * 32 + (swz % 64) / 2; }
__host__ __device__ __forceinline__ int perm32(int rho) { const int n = rho >> 4, i = rho & 15; return 8 * (i >> 2) + 4 * n + (i & 3); }

struct Unit { int pm, pn; };
struct Gemm { const bf16_t* A; const bf16_t* Bt; int M, N, K; };

struct StaticOrder {
    int nM, nN, nwg, G, c;
    __host__ __device__ void init(int M, int N, int G_, int c_) { nM = M / BM; nN = N / BM; nwg = nM * nN; G = G_; c = c_; }
    __host__ __device__ bool next(int i, Unit& u) const {
        const long L = (long)i * G + c; if (L >= nwg) return false;
        int wgid = (int)L; { const int q = nwg / NXCD, r = nwg % NXCD, xcd = wgid % NXCD, off = wgid / NXCD; wgid = (xcd < r ? xcd * (q + 1) : r * (q + 1) + (xcd - r) * q) + off; }
        const int nig = WGM * nN, gid = wgid / nig, fm = gid * WGM, gsz = (nM - fm) < WGM ? (nM - fm) : WGM;
        u.pm = fm + ((wgid % nig) % gsz); u.pn = (wgid % nig) / gsz; return true;
    }
    __device__ __forceinline__ void a_ready(const Unit&) const {}
    __device__ __forceinline__ void done(const Unit&) const {}
};
template <class Epi, class Sched, bool STAMP = false>
__device__ __forceinline__ void gemm_phase(PG8_LAS unsigned char* lds, const Gemm g, const Sched& S, const Epi& E, unsigned long long* stamps) {
    const int tid = launder_v((int)threadIdx.x)  , wid = __builtin_amdgcn_readfirstlane(tid >> 6), lane = tid & 63, wr = wid >> 2, wc = wid & 3, fr = lane & 15, fq = lane >> 4;
    const int K = g.K, nt = K / BK;
    int ts_lo = 0, ts_hi = 0, nts = 0; const unsigned long long rt_entry = STAMP ? 0ull : 0ull;
#define PG8_STAMP() do { if (STAMP && wid == 0 && nts < 64) { const unsigned long long _c = 0ull; \
        ts_lo = (lane == nts) ? (int)(unsigned)_c : ts_lo; ts_hi = (lane == nts) ? (int)(unsigned)(_c >> 32) : ts_hi; ++nts; } } while (0)
    PG8_STAMP();
    unsigned voffA[2], voffB[2];
#pragma unroll
    for (int i = 0; i < 2; ++i) { int R, C; stage_rc(tid * 16 + i * 8192, R, C); const int Rb = Epi::PERM ? ((R & ~31) + perm32(R & 31)) : R;
        voffA[i] = (unsigned)(R * K + C) * 2u; voffB[i] = (unsigned)(Rb * K + C) * 2u; }
    const size_t kstep = (size_t)(BK * 2);
    const size_t hstep = (size_t)HALF * K * 2;
    const size_t tstep = 2 * hstep;
    const unsigned ldsw = (unsigned)wid * 1024u;
    const int aoff = lds_byte(wr * 64 + fr, fq * 8), boff = launder_v(lds_byte(wc * 32 + fr, fq * 8) + 4 * HTB);
#define PG8_SA(b, h) (((b) * 2 + (h)) * HTB)
#define PG8_SB(b, h) ((4 + (b) * 2 + (h)) * HTB)
#define PG8_STAGE(bufoff, gbase, voff) do { _Pragma("unroll") for (int _i = 0; _i < 2; ++_i) \
        __builtin_amdgcn_global_load_lds((const unsigned*)((const char*)(gbase) + (voff)[_i]), (PG8_LAS unsigned*)(lds + (bufoff) + ldsw + _i * 8192), 16, 0, 0); } while (0)
#define PG8_LDA(dst, b, h) do { _Pragma("unroll") for (int m = 0; m < 4; ++m) _Pragma("unroll") for (int k = 0; k < 2; ++k) dst[m][k] = *(const PG8_LAS bf16x8*)(lds + PG8_SA(b, h) + aoff + m * 2048 + k * 1024); } while (0)
#define PG8_LDB(dst, b, h) do { _Pragma("unroll") for (int n = 0; n < 2; ++n) _Pragma("unroll") for (int k = 0; k < 2; ++k) dst[n][k] = *(const PG8_LAS bf16x8*)(lds + boff + ((b) * 2 + (h)) * HTB + n * 2048 + k * 1024); } while (0)
#define PG8_MMA(ai, bj, At, Bt) do { __builtin_amdgcn_s_setprio(1); _Pragma("unroll") for (int m = 0; m < 4; ++m) _Pragma("unroll") for (int n = 0; n < 2; ++n) _Pragma("unroll") for (int k = 0; k < 2; ++k) \
        acc[ai][bj][m][n] = __builtin_amdgcn_mfma_f32_16x16x32_bf16(Bt[n][k], At[m][k], acc[ai][bj][m][n], 0, 0, 0); __builtin_amdgcn_s_setprio(0); } while (0)
#define PG8_WAIT_V(n) asm volatile("s_waitcnt vmcnt(" #n ")" ::: "memory")
#define PG8_WAIT_L(n) asm volatile("s_waitcnt lgkmcnt(" #n ")" ::: "memory")
#define PG8_BAR __builtin_amdgcn_s_barrier()
#define PG8_SCHED __builtin_amdgcn_sched_barrier(0)
    Unit cur, nxt; int ui = 0;
    if (!S.next(0, cur)) return;
    f32x4 acc[2][2][4][2];
#pragma unroll
    for (int a = 0; a < 2; ++a)
#pragma unroll
        for (int b = 0; b < 2; ++b)
#pragma unroll
            for (int m = 0; m < 4; ++m)
#pragma unroll
                for (int n = 0; n < 2; ++n) acc[a][b][m][n] = (f32x4){0.f, 0.f, 0.f, 0.f};
    bf16x8 At[4][2], B0[2][2], B1[2][2];
    const char* cA = (const char*)g.A + (size_t)cur.pm * tstep; const char* cB = (const char*)g.Bt + (size_t)cur.pn * tstep;
    S.a_ready(cur);
    PG8_STAGE(PG8_SB(0, 0), cB, voffB); PG8_STAGE(PG8_SA(0, 0), cA, voffA); PG8_STAGE(PG8_SB(0, 1), cB + hstep, voffB); PG8_STAGE(PG8_SA(0, 1), cA + hstep, voffA);
    if (wr == 1) PG8_BAR;
    PG8_WAIT_V(4); PG8_BAR;
    PG8_STAGE(PG8_SB(1, 0), cB + kstep, voffB); PG8_STAGE(PG8_SA(1, 0), cA + kstep, voffA); PG8_STAGE(PG8_SB(1, 1), cB + hstep + kstep, voffB);
    PG8_WAIT_V(6); PG8_BAR;
    PG8_STAMP();
    for (;;) {
        const bool has_next = S.next(ui + 1, nxt);
        const char* nA = has_next ? (const char*)g.A + (size_t)nxt.pm * tstep : cA; const char* nB = has_next ? (const char*)g.Bt + (size_t)nxt.pn * tstep : cB;
        for (int t = 0; t < nt; t += 2) {
            const bool last = (t == nt - 2);
            const char* a1 = cA + (size_t)(t + 1) * kstep;
            const char* a2 = last ? nA : cA + (size_t)(t + 2) * kstep; const char* b2 = last ? nB : cB + (size_t)(t + 2) * kstep;
            const char* a3 = a2 + kstep; const char* b3 = b2 + kstep;
            if (last && has_next) S.a_ready(nxt);
            PG8_LDB(B0, 0, 0); PG8_SCHED; PG8_LDA(At, 0, 0); PG8_STAGE(PG8_SA(1, 1), a1 + hstep, voffA);
            PG8_WAIT_L(8); PG8_BAR; PG8_WAIT_L(0); PG8_MMA(0, 0, At, B0); PG8_BAR; PG8_SCHED;
            PG8_LDB(B1, 0, 1); PG8_STAGE(PG8_SB(0, 0), b2, voffB);
            PG8_BAR; PG8_WAIT_L(0); PG8_MMA(0, 1, At, B1); PG8_BAR;
            PG8_LDA(At, 0, 1); PG8_STAGE(PG8_SA(0, 0), a2, voffA);
            PG8_BAR; PG8_WAIT_L(0); PG8_MMA(1, 0, At, B0); PG8_BAR; PG8_SCHED;
            PG8_STAGE(PG8_SB(0, 1), b2 + hstep, voffB);
            PG8_WAIT_V(6); PG8_BAR; PG8_MMA(1, 1, At, B1); PG8_BAR;
            PG8_LDB(B0, 1, 0); PG8_SCHED; PG8_LDA(At, 1, 0); PG8_STAGE(PG8_SA(0, 1), a2 + hstep, voffA);
            PG8_WAIT_L(8); PG8_BAR; PG8_WAIT_L(0); PG8_MMA(0, 0, At, B0); PG8_BAR; PG8_SCHED;
            PG8_LDB(B1, 1, 1); PG8_STAGE(PG8_SB(1, 0), b3, voffB);
            PG8_BAR; PG8_WAIT_L(0); PG8_MMA(0, 1, At, B1); PG8_BAR;
            PG8_LDA(At, 1, 1); PG8_STAGE(PG8_SA(1, 0), a3, voffA);
            PG8_BAR; PG8_WAIT_L(0); PG8_MMA(1, 0, At, B0); PG8_BAR; PG8_SCHED;
            PG8_STAGE(PG8_SB(1, 1), b3 + hstep, voffB);
            PG8_WAIT_V(6); PG8_BAR; PG8_MMA(1, 1, At, B1); PG8_BAR;
        }
        PG8_STAMP();
        if constexpr (!Epi::AFTER_DRAIN) { E(acc, cur, wr, wc, fr, fq); S.done(cur); }
        PG8_STAMP();
        if (!has_next) break;
#pragma unroll
        for (int a = 0; a < 2; ++a)
#pragma unroll
            for (int b = 0; b < 2; ++b)
#pragma unroll
                for (int m = 0; m < 4; ++m)
#pragma unroll
                    for (int n = 0; n < 2; ++n) acc[a][b][m][n] = (f32x4){0.f, 0.f, 0.f, 0.f};
        cur = nxt; cA = nA; cB = nB; ++ui;
    }
    PG8_WAIT_V(0);
    if (wr == 0) PG8_BAR;
    PG8_BAR;
    if constexpr (Epi::AFTER_DRAIN) { E.fused(acc, cur, wr, wc, fr, fq, lds, wid, lane); S.done(cur); }
    PG8_STAMP();
    if (STAMP && wid == 0) { stamps[lane] = lane < nts ? (((unsigned long long)(unsigned)ts_hi << 32) | (unsigned)ts_lo) : 0ull;
        if (lane == 62) stamps[62] = rt_entry; if (lane == 63) stamps[63] = 0ull; }
#undef PG8_STAMP
#undef PG8_SA
#undef PG8_SB
#undef PG8_STAGE
#undef PG8_LDA
#undef PG8_LDB
#undef PG8_MMA
#undef PG8_WAIT_V
#undef PG8_WAIT_L
#undef PG8_BAR
#undef PG8_SCHED
}
}

template <class F> struct EpiFn {
  static constexpr bool PERM = false, AFTER_DRAIN = false;
  F f;
  __device__ __forceinline__ void operator()(const pg8::f32x4 (&acc)[2][2][4][2], const pg8::Unit& u, int wr, int wc, int fr, int fq) const {
#pragma unroll
    for (int ai = 0; ai < 2; ++ai)
#pragma unroll
      for (int m = 0; m < 4; ++m) {
        const int row = u.pm * 256 + ai * 128 + wr * 64 + m * 16 + fr;
#pragma unroll
        for (int bj = 0; bj < 2; ++bj)
#pragma unroll
          for (int n = 0; n < 2; ++n) f(row, u.pn * 256 + bj * 128 + wc * 32 + n * 16 + 4 * fq, acc[ai][bj][m][n]);
      }
  }
};
template <int NN> struct RowMajorOrder {
  int nwg, G, c;
  __device__ __forceinline__ bool next(int i, pg8::Unit& u) const { const int L = i * G + c; if (L >= nwg) return false; u.pm = L / NN; u.pn = L - u.pm * NN; return true; }
  __device__ __forceinline__ void a_ready(const pg8::Unit&) const {}
  __device__ __forceinline__ void done(const pg8::Unit&) const {}
};
template <class F> struct EpiFn8 {
  static constexpr bool PERM = true, AFTER_DRAIN = false;
  F f;
  __device__ __forceinline__ void operator()(const pg8::f32x4 (&acc)[2][2][4][2], const pg8::Unit& u, int wr, int wc, int fr_, int fq_) const {
    const int fr = launder_v(fr_), fq = launder_v(fq_);
#pragma unroll
    for (int ai = 0; ai < 2; ++ai)
#pragma unroll
      for (int m = 0; m < 4; ++m) {
        const int row = u.pm * 256 + ai * 128 + wr * 64 + m * 16 + fr;
#pragma unroll
        for (int bj = 0; bj < 2; ++bj) f(row, u.pn * 256 + bj * 128 + wc * 32 + 8 * fq, acc[ai][bj][m][0], acc[ai][bj][m][1]);
      }
  }
};
template <int N, class F>
__device__ __forceinline__ void gemm256p(const bf16_t* A, const bf16_t* Bt, int M, int K, F f, char* smem) {
  pg8::Gemm g; g.A = A; g.Bt = Bt; g.M = M; g.N = N; g.K = K;
  RowMajorOrder<N / 256> S; S.nwg = (M / 256) * (N / 256); S.G = (int)gridDim.x; S.c = BIDX;
  EpiFn8<F> E{f};
  __syncthreads();
  pg8::gemm_phase<EpiFn8<F>, RowMajorOrder<N / 256>, false>((PG8_LAS unsigned char*)smem, g, S, E, nullptr);
  __syncthreads();
}
template <int N, class F>
__device__ __forceinline__ void gemm256(const bf16_t* A, const bf16_t* Bt, int M, int K, F f, char* smem) {
  pg8::Gemm g; g.A = A; g.Bt = Bt; g.M = M; g.N = N; g.K = K;
  RowMajorOrder<N / 256> S; S.nwg = (M / 256) * (N / 256); S.G = (int)gridDim.x; S.c = BIDX;
  EpiFn<F> E{f};
  __syncthreads();
  pg8::gemm_phase<EpiFn<F>, RowMajorOrder<N / 256>, false>((PG8_LAS unsigned char*)smem, g, S, E, nullptr);
  __syncthreads();
}

#define XB_TMO      128
#define XB_XCNT(j)  (256  + 64 * (j))
#define XB_XSUB(j)  (1280 + 64 * (j))
#define XB_XGEN(j)  (2304 + 64 * (j))
#define XB_TOP      3328
#define XB_TOPGEN   3392
#define XCD_BAR_WORDS 3456
#define XB_SPIN_CAP (1u << 22)
#define LAS __attribute__((address_space(3)))
__device__ __forceinline__ unsigned xb_ld(unsigned* p)              { return __hip_atomic_load(p, __ATOMIC_RELAXED, __HIP_MEMORY_SCOPE_AGENT); }
__device__ __forceinline__ unsigned xb_add(unsigned* p, unsigned v) { return __hip_atomic_fetch_add(p, v, __ATOMIC_RELAXED, __HIP_MEMORY_SCOPE_AGENT); }
__device__ __forceinline__ unsigned xb_xcc_id() { return (unsigned)__builtin_amdgcn_s_getreg((3 << 11) | 20) & 0xFu; }
#define XB_SPIN(cond, bar) do { unsigned _sp = 0; while (cond) { __builtin_amdgcn_s_sleep(1); \
    if ((++_sp & 255u) == 0u) { if (xb_ld(&(bar)[XB_TMO])) break; if (_sp > XB_SPIN_CAP) { atomicAdd(&(bar)[XB_TMO], 1u); break; } } } } while (0)
struct XcdBarrier { unsigned* bar; unsigned x; volatile LAS unsigned* st; };
__device__ __forceinline__ XcdBarrier xcd_barrier_post(unsigned* bar, volatile LAS unsigned* st) {
  XcdBarrier b; b.bar = bar; b.x = xb_xcc_id(); b.st = st;
  if (threadIdx.x == 0) (void)xb_add(&bar[XB_XCNT(b.x)], 1u);
  return b;
}
__device__ __forceinline__ void xcd_barrier_complete(unsigned* bar, unsigned x, unsigned& nloc, unsigned& nx) {
  const unsigned G = gridDim.x * gridDim.y * gridDim.z;
  unsigned sum, cnt, mine, sp = 0u;
  for (;;) {
    sum = 0u; cnt = 0u; mine = 0u;
#pragma unroll
    for (unsigned j = 0; j < 16; ++j) { const unsigned c = xb_ld(&bar[XB_XCNT(j)]); sum += c; cnt += (c > 0u) ? 1u : 0u; mine = (j == x) ? c : mine; }
    if (sum == G) break;
    __builtin_amdgcn_s_sleep(1);
    if ((++sp & 255u) == 0u) { if (xb_ld(&bar[XB_TMO])) break; if (sp > XB_SPIN_CAP) { atomicAdd(&bar[XB_TMO], 1u); break; } }
  }
  nloc = mine > 0u ? mine : 1u; nx = cnt > 0u ? cnt : 1u;
}
__device__ __forceinline__ void xcd_barrier(const XcdBarrier& b) {
  asm volatile("s_waitcnt vmcnt(0)" ::: "memory");
  __syncthreads();
  if (threadIdx.x == 0) {
    unsigned* bar = b.bar;
    __builtin_amdgcn_s_waitcnt(0);
    unsigned nloc = b.st[0], nx = b.st[1];
    if (nloc == 0u) { xcd_barrier_complete(bar, b.x, nloc, nx); b.st[0] = nloc; b.st[1] = nx; }
    const unsigned old = xb_add(&bar[XB_XSUB(b.x)], 1u);
    const unsigned gen = old / nloc;
    if (old + 1u == (gen + 1u) * nloc) {
      __builtin_amdgcn_fence(__ATOMIC_RELEASE, "agent");
      asm volatile("s_waitcnt vmcnt(0)" ::: "memory");
      const unsigned og = xb_add(&bar[XB_TOP], 1u);
      const unsigned tg = og / nx;
      if (og + 1u == (tg + 1u) * nx) xb_add(&bar[XB_TOPGEN], 1u);
      else XB_SPIN(xb_ld(&bar[XB_TOPGEN]) == tg, bar);
      __builtin_amdgcn_fence(__ATOMIC_ACQUIRE, "agent");
      xb_add(&bar[XB_XGEN(b.x)], 1u);
      asm volatile("s_waitcnt vmcnt(0)" ::: "memory");
    } else {
      XB_SPIN(xb_ld(&bar[XB_XGEN(b.x)]) == gen, bar);
      __builtin_amdgcn_fence(__ATOMIC_ACQUIRE, "agent");
      asm volatile("s_waitcnt vmcnt(0)" ::: "memory");
    }
  }
  __syncthreads();
}

constexpr int NSTAGES = 23;
constexpr int SMEM_BYTES = 135168;
template <int S>
__device__ __forceinline__ void run_stage_t(const Params& p0, int layer0, char* smem0) {
  Params p = p0; int layer = layer0; char* smem = smem0;
  { unsigned long long w = (unsigned long long)p0.ws, o = (unsigned long long)p0.out;
    asm volatile("" : "+s"(w), "+s"(o), "+s"(layer));
    p.ws = (char*)(__attribute__((address_space(1))) char*)w; p.out = (float*)(__attribute__((address_space(1))) float*)o; }
  const int nrows = (layer == 0) ? NTOK : NLAT;
  if constexpr (S == 100) stage_prep(p, smem);
  if constexpr (S == 101) stage_prep2(p, smem);
  if constexpr (S == 102) final_norm(p);
  if constexpr (S == 0) stage_norm(p, layer, 0, NTOK);
  if constexpr (S == 1) {
    bf16_t* u = (bf16_t*)(p.ws + OFF_U);
    gemm256p<DINP>((const bf16_t*)(p.ws + OFF_HB), (const bf16_t*)(p.ws + OFF_WIN) + (size_t)layer * DINP * 1024, NTOK, 1024,
            [=](int row, int col0, f32x4 v, f32x4 w) { if (col0 < DIN) { const u32x4 o = {cvtpk(v[0], v[1]), cvtpk(v[2], v[3]), cvtpk(w[0], w[1]), cvtpk(w[2], w[3])}; *(u32x4*)(u + (size_t)row * DIN + col0) = o; } }, smem);
    {
      const int nunits = (NTOK / 256) * (DINP / 256), G = (int)gridDim.x, rem = nunits % G, c = BIDX;
      if (rem == 0) peer_cvt_tables(p, layer, c, G); else if (c >= rem) peer_cvt_tables(p, layer, c - rem, G - rem);
    }
  }
  if constexpr (S == 2) { lru_units(p, layer, 0, smem); mla_prep(p, layer); hyena_prep(p, layer, smem);
#if defined(PROBE_S2)
    __syncthreads();
    if (PROBE_S2 == 0) lru_units(p, layer, 0, smem); else if (PROBE_S2 == 1) mla_prep(p, layer); else hyena_prep(p, layer, smem);
#endif
  }
  if constexpr (S == 3) {
    bf16_t* Q = (bf16_t*)(p.ws + OFF_Q); bf16_t* K = (bf16_t*)(p.ws + OFF_K);
    lru_carry(p, smem);
    gemm256p<768>((const bf16_t*)(p.ws + OFF_QN), (const bf16_t*)(p.ws + OFF_WQB) + (size_t)layer * 768 * 384, NTOK, 384,
            [=](int row, int col0, f32x4 v, f32x4 w) {
              if (col0 < 576) {
                const int j = col0 % 96;
                if (j >= 64 && row < NLAT) {
                  const int t = row & (SEQ - 1), i0 = (j & 8) >> 1;
                  const float pos = (j & 16) ? (float)(t & 63) : (float)(t >> 6);
#pragma unroll
                  for (int q = 0; q < 4; ++q) {
                    constexpr float R1 = 0.31622776601683794f;
                    const float invq = (q == 0 ? 1.f : q == 1 ? R1 : q == 2 ? R1 * R1 : R1 * R1 * R1) * 0.15915494309189535f;
                    const float rev = pos * (i0 ? invq * 0.01f : invq);
                    const float cs = __builtin_amdgcn_cosf(rev), sn = __builtin_amdgcn_sinf(rev);
                    if (q < 2) { const float lo = v[2 * q], hh = v[2 * q + 1]; v[2 * q] = lo * cs - hh * sn; v[2 * q + 1] = hh * cs + lo * sn; }
                    else { const float lo = w[2 * q - 4], hh = w[2 * q - 3]; w[2 * q - 4] = lo * cs - hh * sn; w[2 * q - 3] = hh * cs + lo * sn; }
                  }
                }
                const u32x4 o = {cvtpk(v[0], v[1]), cvtpk(v[2], v[3]), cvtpk(w[0], w[1]), cvtpk(w[2], w[3])};
                *(u32x4*)(Q + (size_t)row * 576 + col0) = o;
              }
            }, smem);
    gemm256p<768>((const bf16_t*)(p.ws + OFF_KVN), (const bf16_t*)(p.ws + OFF_WKVB) + (size_t)layer * 768 * 256, NTOK, 256,
            [=](int row, int col0, f32x4 v, f32x4 w) { const u32x4 o = {cvtpk(v[0], v[1]), cvtpk(v[2], v[3]), cvtpk(w[0], w[1]), cvtpk(w[2], w[3])}; *(u32x4*)(K + (size_t)row * 768 + col0) = o; }, smem);
  }
  if constexpr (S == 4) { attn_units(p, layer, smem); hyena_fft(p, layer, smem); }
  if constexpr (S == 12) { attn_combine(p); hyena_out_transpose(p, smem); hyena_direct(p, layer, smem); lru_final(p, layer, smem); }
  if constexpr (S == 5) {
    float* xs = (float*)(p.ws + OFF_XS); const float* mod = (const float*)(p.ws + OFF_MOD) + (size_t)layer * 3 * 6144;
    const float* xin = p.in[I_X]; const float* cin = p.in[I_CTX];
    const bf16_t* wo = (const bf16_t*)(p.ws + OFF_WOUT) + (size_t)layer * 1024 * 1024;
    gemm256<1024>((const bf16_t*)(p.ws + OFF_MIX), wo, NLAT, 1024,
            [=](int row, int col0, f32x4 v) {
              const float* g1 = mod + (size_t)(row >> 13) * 6144 + 2048 + col0;
              const float* src = (layer == 0) ? xin + (size_t)row * DM + col0 : xs + (size_t)row * DM + col0;
              const f32x4 s4 = *(const f32x4*)src, g4 = *(const f32x4*)g1;
              *(f32x4*)(xs + (size_t)row * DM + col0) = s4 + g4 * v;
            }, smem);
    if (layer == 0)
      gemm_bt((const bf16_t*)(p.ws + OFF_MIX) + (size_t)NLAT * DM, DM, wo, 1024, NCTX, 1024, 1024,
              [=](int row, int col, float v) {
                const float g1 = mod[(size_t)2 * 6144 + 2048 + col];
                xs[(size_t)(NLAT + row) * DM + col] = cin[(size_t)row * DM + col] + g1 * v;
              }, smem);
  }
  if constexpr (S == 6) { stage_norm(p, layer, 1, nrows); }
  if constexpr (S == 7) {
    bf16_t* pq = (bf16_t*)(p.ws + OFF_PQ);
    const bf16_t* wq = (const bf16_t*)(p.ws + OFF_WPQ) + (size_t)layer * 2048 * 1024;
    gemm256p<2048>((const bf16_t*)(p.ws + OFF_HB), wq, NLAT, 1024,
            [=](int row, int col0, f32x4 v, f32x4 w) { const u32x4 o = {cvtpk(v[0], v[1]), cvtpk(v[2], v[3]), cvtpk(w[0], w[1]), cvtpk(w[2], w[3])}; *(u32x4*)(pq + (size_t)row * 2048 + col0) = o; }, smem);
    if (layer == 0)
      gemm_bt((const bf16_t*)(p.ws + OFF_HB) + (size_t)NLAT * DM, DM, wq, 1024, NCTX, 2048, 1024,
              [=](int row, int col, float v) { pq[(size_t)(NLAT + row) * 2048 + col] = f2bf(v); }, smem);
  }
  if constexpr (S == 8) peer_topk(p, layer, nrows, smem);
  if constexpr (S == 9) peer_eval_fused(p, layer, nrows, smem);
}

__device__ __forceinline__ void init_params(Params& p, const KArgs& ka, char* smem) {
  unsigned long long* tab = (unsigned long long*)(smem + SMEM_BYTES);
  if (threadIdx.x == 0) {
#pragma unroll
    for (int i = 0; i < N_IN; ++i) tab[i] = (unsigned long long)ka.in[i];
  }
  __syncthreads();
  p.in.tab = smem + SMEM_BYTES; p.out = ka.out; p.ws = ka.ws;
}

#if MK_SINGLE
#define SYNC() xcd_barrier(xb)
__global__ void __launch_bounds__(NTHREADS) mega_kernel(KArgs ka) {
  __shared__ __attribute__((aligned(16))) char smem[SMEM_BYTES + 512];
  cg::grid_group grid = cg::this_grid();
  if (threadIdx.x == 0) *(uint4*)(smem + SMEM_BYTES + 320) = make_uint4(0u, 0u, 0u, 0u);
  Params p; init_params(p, ka, smem);
  const XcdBarrier xb = xcd_barrier_post((unsigned*)(ka.ws + OFF_BAR), (volatile LAS unsigned*)(smem + SMEM_BYTES + 320));
  run_stage_t<100>(p, 0, smem); grid.sync();
#if defined(PROBE_PREP) && PROBE_PREP == 100
  run_stage_t<100>(p, 0, smem); SYNC();
#endif
  run_stage_t<101>(p, 0, smem); SYNC();
#if defined(PROBE_BW)
  {
    const u32x4* base = (const u32x4*)(ka.ws + (size_t)64 * 1024 * 1024);
    const size_t n16 = (size_t)PROBE_BW * 64 * 1024 * 1024 / 16;
    unsigned acc_ = 0;
    for (size_t i = (size_t)blockIdx.x * NTHREADS + threadIdx.x; i + 7 * (size_t)gridDim.x * NTHREADS < n16; i += 8 * (size_t)gridDim.x * NTHREADS) {
      u32x4 t_[8];
#pragma unroll
      for (int k = 0; k < 8; ++k) t_[k] = base[i + k * (size_t)gridDim.x * NTHREADS];
#pragma unroll
      for (int k = 0; k < 8; ++k) acc_ ^= t_[k][0] ^ t_[k][1] ^ t_[k][2] ^ t_[k][3];
    }
    if (acc_ == 0x12345u) ((unsigned*)(ka.ws + OFF_BAR))[1000] = acc_;
    SYNC();
  }
#endif
#if defined(PROBE_BAR)
  SYNC(); SYNC(); SYNC(); SYNC(); SYNC(); SYNC(); SYNC(); SYNC(); SYNC(); SYNC(); SYNC(); SYNC(); SYNC(); SYNC(); SYNC(); SYNC(); SYNC(); SYNC(); SYNC(); SYNC();
#endif
#if defined(PROBE_PREP) && PROBE_PREP == 101
  run_stage_t<101>(p, 0, smem); SYNC();
#endif
#ifndef PROBE_DUP
#define PROBE_DUP -1
#endif
#define RUNSTAGE(S, layer) do { if (PROBE_DUP == S) { int nrep = 2; asm volatile("" : "+s"(nrep)); \
      for (int rep = 0; rep < nrep; ++rep) { run_stage_t<S>(p, layer, smem); SYNC(); if (S == 9 || S == 11) break; } } \
    else { run_stage_t<S>(p, layer, smem); SYNC(); } } while (0)
#if defined(PROBE_ATT)
#define PROBE_ATT_HOOK(layer) { attn_units<PROBE_ATT, true>(p, layer, smem); SYNC(); }
#else
#define PROBE_ATT_HOOK(layer)
#endif
#define LAYER_PASS(layer) \
    if (layer == 0) { RUNSTAGE(0, layer); } RUNSTAGE(1, layer); RUNSTAGE(2, layer); RUNSTAGE(3, layer); RUNSTAGE(4, layer); PROBE_ATT_HOOK(layer) RUNSTAGE(12, layer); \
    RUNSTAGE(5, layer); RUNSTAGE(6, layer); RUNSTAGE(7, layer); RUNSTAGE(8, layer); RUNSTAGE(9, layer);
  LAYER_PASS(0)
  LAYER_PASS(1)
}
#else
template <int S>
__global__ void __launch_bounds__(NTHREADS) stage_kernel(KArgs ka, int layer) {
  __shared__ __attribute__((aligned(16))) char smem[SMEM_BYTES + 512];
  Params p; init_params(p, ka, smem);
  run_stage_t<S>(p, layer, smem);
}
#endif

extern "C" void kernel_launch(void* const* d_in, const int* in_sizes, int n_in, void* d_out, int out_size, void* d_ws, size_t ws_size, hipStream_t stream) {
  if (n_in != N_IN || ws_size < WS_END) { fprintf(stderr, "kernel_launch: bad args n_in=%d ws=%zu need=%zu\n", n_in, ws_size, (size_t)WS_END); return; }
  KArgs p{};
  for (int i = 0; i < N_IN; ++i) p.in[i] = (const float*)d_in[i];
  p.out = (float*)d_out; p.ws = (char*)d_ws;
#if MK_SINGLE
  static int grid_blocks = 0;
  if (!grid_blocks) {
    int dev = 0, cus = 0, per_cu = 0;
    hipGetDevice(&dev);
    hipDeviceGetAttribute(&cus, hipDeviceAttributeMultiprocessorCount, dev);
    hipOccupancyMaxActiveBlocksPerMultiprocessor(&per_cu, mega_kernel, NTHREADS, 0);
    if (per_cu > 1) per_cu = 1;
    grid_blocks = cus * per_cu;
  }
  hipMemsetAsync((char*)d_ws + OFF_BAR, 0, BAR_BYTES, stream);
  void* args[] = {&p};
  hipError_t e = hipLaunchCooperativeKernel((void*)mega_kernel, dim3(grid_blocks), dim3(NTHREADS), args, 0, stream);
  if (e != hipSuccess) fprintf(stderr, "cooperative launch failed: %s (grid %d)\n", hipGetErrorString(e), grid_blocks);
#else
#define LAUNCH(S, L) hipLaunchKernelGGL(stage_kernel<S>, dim3(256), dim3(NTHREADS), 0, stream, p, L)
  LAUNCH(100, 0); LAUNCH(101, 0);
  for (int layer = 0; layer < 2; ++layer) {
    LAUNCH(0, layer); LAUNCH(1, layer); LAUNCH(2, layer); LAUNCH(3, layer); LAUNCH(4, layer);
    LAUNCH(5, layer); LAUNCH(6, layer); LAUNCH(7, layer); LAUNCH(8, layer); LAUNCH(9, layer);
  }
  LAUNCH(102, 0);
#endif
}
```

```cpp
#include <hip/hip_runtime.h>
#include <hip/hip_cooperative_groups.h>
#include <cstdio>
#include <cstdint>
namespace cg = cooperative_groups;

__device__ __forceinline__ int launder_v(int x) { asm volatile("" : "+v"(x)); return x; }
__device__ __forceinline__ int launder_s(int x) { asm volatile("" : "+s"(x)); return x; }
#define TIDX launder_v((int)threadIdx.x)
#define BIDX launder_s((int)blockIdx.x)

__device__ __forceinline__ float shx(float v, int mask) { const int l = TIDX & 63; return __int_as_float(__builtin_amdgcn_ds_bpermute((l ^ mask) << 2, __float_as_int(v))); }
__device__ __forceinline__ int shxi(int v, int mask) { const int l = TIDX & 63; return __builtin_amdgcn_ds_bpermute((l ^ mask) << 2, v); }
__device__ __forceinline__ float rdl(float v, int srclane) { return __int_as_float(__builtin_amdgcn_readlane(__float_as_int(v), srclane)); }

#ifndef MK_SINGLE
#define MK_SINGLE 1
#endif

typedef unsigned short bf16_t;
using bf16x8 = __attribute__((ext_vector_type(8))) short;
using s16x4  = __attribute__((ext_vector_type(4))) short;
using f32x16 = __attribute__((ext_vector_type(16))) float;
using f32x4  = __attribute__((ext_vector_type(4))) float;
using u32x4  = __attribute__((ext_vector_type(4))) unsigned;
using u32x2  = __attribute__((ext_vector_type(2))) unsigned;

constexpr int NB = 2, SEQ = 8192, CTXL = 256, DM = 1024;
constexpr int NLAT = NB * SEQ, NCTX = NB * CTXL, NTOK = NLAT + NCTX;
constexpr int DIN = 2208, DINP = 2304;
constexpr int DLRU = 384, NKEYS = SEQ + CTXL;
constexpr int NTHREADS = 512;
constexpr int NCHUNK = NLAT / 64 + NCTX / 64;
constexpr float EPSV = 1e-6f;

enum { I_X = 0, I_C, I_CTX, I_CCTX, I_WMOD, I_BMOD, I_N1G, I_N2G, I_WIN, I_WOUT, I_LCW, I_LCB, I_LWR, I_LBR, I_LWI, I_LBI, I_LLAM,
       I_QNG, I_WQB, I_KVNG, I_WKVB, I_HCW, I_HCB, I_HW1, I_HB1, I_HW2, I_HB2, I_HW3, I_HFREQ, I_HDECAY, I_HSKIP,
       I_PWQ, I_PKEYS, I_PU, I_PV, I_FG, N_IN };

struct KArgs { const float* in[N_IN]; float* out; char* ws; };
struct InTab {
  const char* tab;
  __device__ __forceinline__ const float* operator[](int i) const {
    const unsigned long long v = ((const unsigned long long*)tab)[i];
    const unsigned lo = __builtin_amdgcn_readfirstlane((unsigned)v), hi = __builtin_amdgcn_readfirstlane((unsigned)(v >> 32));
    return (const float*)(const __attribute__((address_space(1))) float*)(((unsigned long long)hi << 32) | lo);
  }
};
struct Params { InTab in; float* out; char* ws; };

constexpr size_t al256(size_t x) { return (x + 255) / 256 * 256; }
constexpr size_t OFF_XS    = 0;
constexpr size_t OFF_HB    = OFF_XS    + al256((size_t)NTOK * DM * 4);
constexpr size_t OFF_U     = OFF_HB    + al256((size_t)NTOK * DM * 2);
constexpr size_t OFF_PQ    = OFF_U;
constexpr size_t OFF_LAB   = OFF_U     + al256((size_t)NTOK * DIN * 2);
static_assert(OFF_LAB + (size_t)(NTOK / 32) * 6 * 2 * 2 * 16 * 64 * 4 <= OFF_U + al256((size_t)NTOK * DIN * 4), "LRU coefficient buffer must fit behind the bf16 u");
constexpr size_t OFF_MIX   = OFF_U     + al256((size_t)NTOK * DIN * 4);
constexpr size_t OFF_HYIN  = OFF_MIX   + al256((size_t)NTOK * DM * 2);
constexpr size_t OFF_EID   = OFF_HYIN;
constexpr size_t OFF_GATE  = OFF_EID   + al256((size_t)NTOK * 128 * 4);
constexpr size_t OFF_HYINC = OFF_HYIN  + al256((size_t)3 * 2 * 256 * 8192 * 4);
constexpr size_t OFF_QN    = OFF_HYINC + al256((size_t)3 * 2 * 256 * 256 * 4);
constexpr size_t TAB_BYTES = (size_t)16384 * 1024;
constexpr size_t OFF_UTAB  = al256(OFF_LAB + (size_t)(NTOK / 32) * 6 * 2 * 2 * 16 * 64 * 4);
constexpr size_t OFF_OPART = OFF_QN;
constexpr size_t OFF_OML   = OFF_OPART + (size_t)4 * 2 * SEQ * 64 * 4;
constexpr size_t OFF_KVN   = OFF_QN    + al256((size_t)NTOK * 384 * 2);
constexpr size_t OFF_Q     = OFF_KVN   + al256((size_t)NTOK * 256 * 2);
constexpr size_t OFF_K     = OFF_Q     + al256((size_t)NTOK * 576 * 2);
constexpr size_t OFF_V     = OFF_K     + al256((size_t)NTOK * 768 * 2);
constexpr size_t OFF_LSUM  = OFF_V     + al256((size_t)NTOK * 32 * 2);
static_assert(OFF_OML + (size_t)4 * 2 * SEQ * 2 * 4 <= OFF_Q, "attention partials must fit in the dead QN/KVN region");
static_assert(OFF_UTAB + TAB_BYTES <= OFF_U + al256((size_t)NTOK * DIN * 4), "u table must fit in the tail of the u region");
constexpr size_t OFF_CARRY = OFF_LSUM  + al256((size_t)(NTOK / 32) * 2 * 2 * 384 * 4);
constexpr size_t OFF_MOD   = OFF_CARRY + al256((size_t)(NTOK / 32) * 2 * 384 * 4);
constexpr size_t OFF_MODP  = OFF_MIX;
constexpr size_t OFF_WIN   = OFF_MOD   + al256((size_t)2 * 3 * 6144 * 4);
constexpr size_t OFF_WOUT  = OFF_WIN   + al256((size_t)2 * DINP * 1024 * 2);
constexpr size_t OFF_WQB   = OFF_WOUT  + al256((size_t)2 * 1024 * 1024 * 2);
constexpr size_t OFF_WKVB  = OFF_WQB   + al256((size_t)2 * 768 * 384 * 2);
constexpr size_t OFF_WPQ   = OFF_WKVB  + al256((size_t)2 * 768 * 256 * 2);
constexpr size_t OFF_KEYS  = OFF_WPQ   + al256((size_t)2 * 2048 * 1024 * 2);
constexpr size_t OFF_GW    = OFF_KEYS  + al256((size_t)2 * 2 * 128 * 128 * 2);
constexpr size_t OFF_H2    = OFF_GW    + al256((size_t)2 * 2 * 2 * 6 * 64 * 64 * 2);
constexpr size_t OFF_HSPEC = OFF_H2    + al256((size_t)2 * NKEYS * 64 * 4);
constexpr size_t OFF_FILTC = OFF_HSPEC + al256((size_t)2 * 256 * 2 * 16384 * 4);
constexpr size_t OFF_SSQPC = OFF_FILTC + al256((size_t)2 * 1024 * 256 * 4);
constexpr size_t OFF_BAR   = OFF_SSQPC + al256((size_t)2 * 4 * 1024 * 4);
constexpr size_t OFF_CTR   = OFF_BAR   + al256(3456 * 4);
constexpr size_t BAR_BYTES = al256(3456 * 4) + 2 * 2 * 2 * 16 * 256;
constexpr size_t OFF_VTAB  = OFF_BAR   + al256(BAR_BYTES);
constexpr size_t WS_END    = OFF_VTAB  + al256(TAB_BYTES);
static_assert(WS_END <= (size_t)4 * 2 * 16384 * 1024 * 4, "workspace layout exceeds the guaranteed 4 x largest-tensor size");
constexpr size_t OFF_SP    = OFF_U;
constexpr size_t OFF_WBUF  = OFF_SP    + (size_t)16 * NTOK * 128 * 4;
static_assert(OFF_WBUF + (size_t)NTOK * 128 * 4 <= OFF_MIX, "PEER partials must fit in the u region");

__device__ __forceinline__ float bf2f(bf16_t v) { return __uint_as_float(((unsigned)v) << 16); }
__device__ __forceinline__ bf16_t f2bf(float f) { unsigned u = __float_as_uint(f); u += 0x7fffu + ((u >> 16) & 1u); return (bf16_t)(u >> 16); }
__device__ __forceinline__ unsigned cvtpk(float lo, float hi) { unsigned r; asm volatile("v_cvt_pk_bf16_f32 %0, %1, %2" : "=v"(r) : "v"(lo), "v"(hi)); return r; }
__device__ __forceinline__ float gelu_tanh(float x) { const float z2 = 1.5957691216057308f * (x + 0.044715f * x * x * x); return x * __builtin_amdgcn_rcpf(1.f + __expf(-z2)); }
__device__ __forceinline__ float sigm(float x) { return 1.f / (1.f + __expf(-x)); }
template <int CTRL> __device__ __forceinline__ float dpp_mov(float x) { return __builtin_bit_cast(float, __builtin_amdgcn_mov_dpp(__builtin_bit_cast(int, x), CTRL, 0xf, 0xf, true)); }
__device__ __forceinline__ float wave_sum(float v) {
  v += dpp_mov<0xB1>(v); v += dpp_mov<0x4E>(v); v += dpp_mov<0x141>(v); v += dpp_mov<0x128>(v);
  { auto r = __builtin_amdgcn_permlane16_swap(__float_as_uint(v), __float_as_uint(v), false, false); v = __uint_as_float(r[0]) + __uint_as_float(r[1]); }
  { auto r = __builtin_amdgcn_permlane32_swap(__float_as_uint(v), __float_as_uint(v), false, false); v = __uint_as_float(r[0]) + __uint_as_float(r[1]); }
  return v;
}
using bf16x2v = __attribute__((ext_vector_type(2))) __bf16;
__device__ __forceinline__ float dot2bf(unsigned a, unsigned b, float acc) { return __builtin_amdgcn_fdot2_f32_bf16(__builtin_bit_cast(bf16x2v, a), __builtin_bit_cast(bf16x2v, b), acc, false); }
__device__ __forceinline__ int crow(int r, int hi) { return (r & 3) + 8 * (r >> 2) + 4 * hi; }
__device__ __forceinline__ void row_info(int r, int& b, int& t, int& isctx) {
  if (r < NLAT) { isctx = 0; b = r >> 13; t = r & (SEQ - 1); } else { isctx = 1; int q = r - NLAT; b = q >> 8; t = q & (CTXL - 1); }
}
__device__ __forceinline__ const float* xrow_src(const Params& p, int layer, int r) {
  if (layer == 0) return (r < NLAT) ? p.in[I_X] + (size_t)r * DM : p.in[I_CTX] + (size_t)(r - NLAT) * DM;
  return (const float*)(p.ws + OFF_XS) + (size_t)r * DM;
}
__device__ __forceinline__ size_t h2idx(int l, int pos, int j) { return (((size_t)l * 16 + (j >> 2)) * NKEYS + pos) * 4 + (j & 3); }
#define JOB_LOOP(t, ntiles, base) for (int t = (int)(((long)BIDX - ((base) % (long)gridDim.x) + gridDim.x) % gridDim.x); t < (ntiles); t += gridDim.x)

__device__ __forceinline__ int rope_slot(int c) { return (c & 16) | ((c & 7) << 1) | ((c >> 3) & 1); }
template <int TNW>
__device__ void transpose_cvt_job(const float* __restrict__ src, bf16_t* __restrict__ dst, int K, int N, int Npad, char* smem, long& base, int rp = 0) {
  float* tile = (float*)smem;
  const int tk = K / 64, tn = Npad / TNW, nt = tk * tn;
  JOB_LOOP(t, nt, base) {
    const int k0 = (t % tk) * 64, n0 = (t / tk) * TNW;
    __syncthreads();
    f32x4 v[TNW / 32];
#pragma unroll
    for (int q = 0; q < TNW / 32; ++q) {
      const int e = TIDX + q * NTHREADS, i = e / (TNW / 4), j = (e % (TNW / 4)) * 4, n = n0 + j;
      v[q] = f32x4{0.f, 0.f, 0.f, 0.f};
      if (n < N) v[q] = *(const f32x4*)(src + (size_t)(k0 + i) * N + n);
    }
#pragma unroll
    for (int q = 0; q < TNW / 32; ++q) {
      const int e = TIDX + q * NTHREADS, i = e / (TNW / 4), j = (e % (TNW / 4)) * 4;
      tile[j * 65 + i] = v[q][0]; tile[(j + 1) * 65 + i] = v[q][1]; tile[(j + 2) * 65 + i] = v[q][2]; tile[(j + 3) * 65 + i] = v[q][3];
    }
    __syncthreads();
#pragma unroll
    for (int q = 0; q < TNW / 64; ++q) {
      const int e = TIDX + q * NTHREADS, j = e >> 3, i8 = (e & 7) * 8;
      const float* tr = tile + j * 65 + i8;
      const u32x4 o = {cvtpk(tr[0], tr[1]), cvtpk(tr[2], tr[3]), cvtpk(tr[4], tr[5]), cvtpk(tr[6], tr[7])};
      int n = n0 + j;
      if (rp && n < N) { const int hh = n / 96, jj = n - hh * 96; if (jj >= 64) n = hh * 96 + 64 + rope_slot(jj - 64); }
      *(u32x4*)(dst + (size_t)n * K + k0 + i8) = o;
    }
  }
  base += nt;
}

__device__ void stage_prep(const Params& p, char* smem) {
  long base = 0;
  for (int l = 0; l < 2; ++l) {
    transpose_cvt_job<256>(p.in[I_WIN] + (size_t)l * 1024 * DIN, (bf16_t*)(p.ws + OFF_WIN) + (size_t)l * DINP * 1024, 1024, DIN, DINP, smem, base);
    transpose_cvt_job<256>(p.in[I_WOUT] + (size_t)l * 1024 * 1024, (bf16_t*)(p.ws + OFF_WOUT) + (size_t)l * 1024 * 1024, 1024, 1024, 1024, smem, base);
    transpose_cvt_job<256>(p.in[I_WQB] + (size_t)l * 384 * 576, (bf16_t*)(p.ws + OFF_WQB) + (size_t)l * 768 * 384, 384, 576, 768, smem, base, 1);
    transpose_cvt_job<256>(p.in[I_WKVB] + (size_t)l * 256 * 768, (bf16_t*)(p.ws + OFF_WKVB) + (size_t)l * 768 * 256, 256, 768, 768, smem, base);
    transpose_cvt_job<256>(p.in[I_PWQ] + (size_t)l * 1024 * 2048, (bf16_t*)(p.ws + OFF_WPQ) + (size_t)l * 2048 * 1024, 1024, 2048, 2048, smem, base);
    for (int d = 0; d < 2; ++d) for (int n = 0; n < 6; ++n) {
      const size_t so = ((size_t)(l * 2 + d) * 6 + n) * 4096;
      transpose_cvt_job<64>(p.in[I_LWR] + so, (bf16_t*)(p.ws + OFF_GW) + ((size_t)((l * 2 + d) * 2 + 0) * 6 + n) * 4096, 64, 64, 64, smem, base);
      transpose_cvt_job<64>(p.in[I_LWI] + so, (bf16_t*)(p.ws + OFF_GW) + ((size_t)((l * 2 + d) * 2 + 1) * 6 + n) * 4096, 64, 64, 64, smem, base);
    }
  }
  {
    const float* src = p.in[I_PKEYS]; bf16_t* dst = (bf16_t*)(p.ws + OFF_KEYS);
    for (int e = BIDX * NTHREADS + TIDX; e < 2 * 2 * 128 * 128; e += gridDim.x * NTHREADS) dst[e] = f2bf(src[e]);
  }
  {
    float* modp = (float*)(p.ws + OFF_MODP);
    const float* cp = p.in[I_C]; const float* ccp = p.in[I_CCTX]; const float* wmod = p.in[I_WMOD];
    JOB_LOOP(it, 768, base) {
      const int l = it / 384, ks = (it % 384) / 12, cgp = it % 12;
      const int col = cgp * 512 + TIDX;
      const float* w = wmod + (size_t)l * 1024 * 6144 + (size_t)(ks * 32) * 6144 + col;
      float a0 = 0.f, a1 = 0.f, a2 = 0.f;
#pragma unroll
      for (int k0 = 0; k0 < 32; k0 += 8) {
        float wv[8];
#pragma unroll
        for (int j = 0; j < 8; ++j) wv[j] = w[(size_t)(k0 + j) * 6144];
#pragma unroll
        for (int j = 0; j < 8; ++j) {
          const int k = ks * 32 + k0 + j;
          const float c0 = cp[k], c1 = cp[1024 + k], c2 = ccp[k];
          a0 += c0 * sigm(c0) * wv[j]; a1 += c1 * sigm(c1) * wv[j]; a2 += c2 * sigm(c2) * wv[j];
        }
      }
      float* o = modp + ((size_t)(l * 32 + ks) * 3) * 6144 + col;
      o[0] = a0; o[6144] = a1; o[2 * 6144] = a2;
    }
    base += 768;
  }
  {
    const int lane = TIDX & 63, wid = TIDX >> 6;
    const float* hw1 = p.in[I_HW1]; const float* hb1 = p.in[I_HB1]; const float* hw2 = p.in[I_HW2]; const float* hb2 = p.in[I_HB2]; const float* hfr = p.in[I_HFREQ];
    constexpr float INV2PI = 0.15915494309189535f;
    for (int it = BIDX * 8 + wid; it < 2 * NKEYS / 4; it += gridDim.x * 8) {
      const int l = it / (NKEYS / 4), pos0 = (it % (NKEYS / 4)) * 4;
      const float* w1 = hw1 + (size_t)l * 17 * 64; const float* w2 = hw2 + (size_t)l * 64 * 64;
      const float fr = hfr[l * 64 + lane], b1v = hb1[l * 64 + lane], b2v = hb2[l * 64 + lane];
      float w1v[17];
#pragma unroll
      for (int i = 0; i < 17; ++i) w1v[i] = w1[i * 64 + lane];
      float h1[4], pre2[4];
#pragma unroll
      for (int j = 0; j < 4; ++j) {
        const int pos = pos0 + j;
        const float tn = (pos < SEQ) ? (float)pos / (float)SEQ : (float)(pos - SEQ) / (float)CTXL;
        float pre = b1v + tn * w1v[0];
#pragma unroll
        for (int i = 0; i < 8; ++i) {
          const float band = 1e-4f + (float)i * ((7.f - 1e-4f) / 7.f);
          const float rev = tn * band;
          pre += __builtin_amdgcn_cosf(rev) * w1v[1 + i] + __builtin_amdgcn_sinf(rev) * w1v[9 + i];
        }
        h1[j] = __builtin_amdgcn_sinf(fr * pre * INV2PI);
        pre2[j] = b2v;
      }
      for (int i = 0; i < 64; ++i) {
        const float wv = w2[i * 64 + lane];
#pragma unroll
        for (int j = 0; j < 4; ++j) pre2[j] += rdl(h1[j], i) * wv;
      }
#pragma unroll
      for (int j = 0; j < 4; ++j) ((float*)(p.ws + OFF_H2))[h2idx(l, pos0 + j, lane)] = __builtin_amdgcn_sinf(fr * pre2[j] * INV2PI);
    }
  }
}

struct cf { float x, y; };
__device__ __forceinline__ cf cmul(cf a, cf b) { return {a.x * b.x - a.y * b.y, a.x * b.y + a.y * b.x}; }
__device__ __forceinline__ cf opq(cf v) { asm("" : "+v"(v.x), "+v"(v.y)); return v; }
template <bool INV> __device__ __forceinline__ cf twid(float frac) {
  const float c = __builtin_amdgcn_cosf(frac), s = __builtin_amdgcn_sinf(frac); return {c, INV ? s : -s};
}
template <bool INV> __device__ __forceinline__ void r4(cf& a, cf& b, cf& c, cf& d) {
  const cf s0 = {a.x + c.x, a.y + c.y}, s1 = {a.x - c.x, a.y - c.y}, s2 = {b.x + d.x, b.y + d.y}, s3 = {b.x - d.x, b.y - d.y};
  a = {s0.x + s2.x, s0.y + s2.y}; c = {s0.x - s2.x, s0.y - s2.y};
  if (!INV) { b = {s1.x + s3.y, s1.y - s3.x}; d = {s1.x - s3.y, s1.y + s3.x}; }
  else      { b = {s1.x - s3.y, s1.y + s3.x}; d = {s1.x + s3.y, s1.y - s3.x}; }
}
template <bool INV> __device__ __forceinline__ cf cj(cf w) { return {w.x, INV ? -w.y : w.y}; }
template <bool INV> __device__ __forceinline__ void dft16(cf* x) {
#pragma unroll
  for (int m0 = 0; m0 < 4; ++m0) r4<INV>(x[m0], x[4 + m0], x[8 + m0], x[12 + m0]);
  const cf W1 = {0.92387953251128674f, -0.38268343236508977f}, W2 = {0.70710678118654752f, -0.70710678118654752f}, W3 = {0.38268343236508977f, -0.92387953251128674f};
  const cf W4 = {0.f, -1.f}, W6 = {-0.70710678118654752f, -0.70710678118654752f}, W9 = {-0.92387953251128674f, 0.38268343236508977f};
  x[5] = cmul(x[5], cj<INV>(W1)); x[6] = cmul(x[6], cj<INV>(W2)); x[7] = cmul(x[7], cj<INV>(W3));
  x[9] = cmul(x[9], cj<INV>(W2)); x[10] = cmul(x[10], cj<INV>(W4)); x[11] = cmul(x[11], cj<INV>(W6));
  x[13] = cmul(x[13], cj<INV>(W3)); x[14] = cmul(x[14], cj<INV>(W6)); x[15] = cmul(x[15], cj<INV>(W9));
#pragma unroll
  for (int q0 = 0; q0 < 4; ++q0) r4<INV>(x[4 * q0], x[4 * q0 + 1], x[4 * q0 + 2], x[4 * q0 + 3]);
}
template <bool INV> __device__ __forceinline__ void dft8(cf* x) {
#pragma unroll
  for (int m0 = 0; m0 < 4; ++m0) { const cf a = x[m0], b = x[4 + m0]; x[m0] = {a.x + b.x, a.y + b.y}; x[4 + m0] = {a.x - b.x, a.y - b.y}; }
  const cf V1 = {0.70710678118654752f, -0.70710678118654752f}, V2 = {0.f, -1.f}, V3 = {-0.70710678118654752f, -0.70710678118654752f};
  x[5] = cmul(x[5], cj<INV>(V1)); x[6] = cmul(x[6], cj<INV>(V2)); x[7] = cmul(x[7], cj<INV>(V3));
  r4<INV>(x[0], x[1], x[2], x[3]); r4<INV>(x[4], x[5], x[6], x[7]);
}
template <bool COL> __device__ __forceinline__ int fidx(int ln, int i) { return COL ? i * 129 + ln : ln * 129 + i; }
template <bool INV, bool COL> __device__ __forceinline__ void fft_passA(cf* buf) {
  cf x[2][16];
#pragma unroll
  for (int it = 0; it < 2; ++it) {
    const int bf = TIDX + NTHREADS * it, ln = bf & 127, j = bf >> 7;
#pragma unroll
    for (int m = 0; m < 16; ++m) x[it][m] = buf[fidx<COL>(ln, j + 8 * m)];
  }
#pragma unroll
  for (int it = 0; it < 2; ++it) {
    const int bf = TIDX + NTHREADS * it, ln = bf & 127, j = bf >> 7;
    if (!INV) {
      dft16<false>(x[it]);
#pragma unroll
      for (int q = 0; q < 16; ++q) buf[fidx<COL>(ln, j + 8 * q)] = opq(cmul(x[it][4 * (q & 3) + (q >> 2)], twid<false>((float)(q * j) * (1.f / 128.f))));
    } else {
#pragma unroll
      for (int q = 0; q < 16; ++q) x[it][q] = cmul(x[it][q], twid<true>((float)(q * j) * (1.f / 128.f)));
      dft16<true>(x[it]);
#pragma unroll
      for (int m = 0; m < 16; ++m) buf[fidx<COL>(ln, j + 8 * m)] = opq(x[it][4 * (m & 3) + (m >> 2)]);
    }
  }
}
template <bool INV, bool COL> __device__ __forceinline__ void fft_passB(cf* buf) {
  cf x[4][8];
#pragma unroll
  for (int it = 0; it < 4; ++it) {
    const int bf = TIDX + NTHREADS * it, ln = bf & 127, B = bf >> 7;
#pragma unroll
    for (int m = 0; m < 8; ++m) x[it][m] = buf[fidx<COL>(ln, 8 * B + m)];
  }
#pragma unroll
  for (int it = 0; it < 4; ++it) {
    const int bf = TIDX + NTHREADS * it, ln = bf & 127, B = bf >> 7;
    if (!INV) {
      dft8<false>(x[it]);
#pragma unroll
      for (int q = 0; q < 8; ++q) {
        cf v = x[it][4 * (q & 1) + (q >> 1)];
        if (COL) v = cmul(v, twid<false>((float)(ln * (B + 16 * q)) * (1.f / 16384.f)));
        buf[fidx<COL>(ln, 8 * B + q)] = opq(v);
      }
    } else {
#pragma unroll
      for (int q = 0; q < 8; ++q) {
        if (COL) x[it][q] = cmul(x[it][q], twid<true>((float)(ln * (B + 16 * q)) * (1.f / 16384.f)));
      }
      dft8<true>(x[it]);
#pragma unroll
      for (int m = 0; m < 8; ++m) buf[fidx<COL>(ln, 8 * B + m)] = opq(x[it][4 * (m & 1) + (m >> 1)]);
    }
  }
}
__device__ __forceinline__ void fft_fwd(cf* buf) {
  fft_passA<false, true>(buf); __syncthreads(); fft_passB<false, true>(buf); __syncthreads();
  fft_passA<false, false>(buf); __syncthreads(); fft_passB<false, false>(buf); __syncthreads();
}
__device__ __forceinline__ void fft_inv(cf* buf) {
  fft_passB<true, false>(buf); __syncthreads(); fft_passA<true, false>(buf); __syncthreads();
  fft_passB<true, true>(buf); __syncthreads(); fft_passA<true, true>(buf); __syncthreads();
}
__device__ __forceinline__ int fft_freq(int r, int c) { return ((r >> 3) + 16 * (r & 7)) + 128 * ((c >> 3) + 16 * (c & 7)); }
__device__ __forceinline__ int fft_pos(int k) {
  const int k1 = k & 127, k2 = k >> 7; return (8 * (k1 & 15) + (k1 >> 4)) * 129 + 8 * (k2 & 15) + (k2 >> 4);
}
constexpr int FFT_LDS = 128 * 129 * 8;

__device__ void hyena_spectra(const Params& p, char* smem) {
  cf* buf = (cf*)smem; float* fb = (float*)smem;
  float* w3s = (float*)(smem + FFT_LDS);
  float* red = w3s + 256;
  const int tid = TIDX, lane = tid & 63, wid = tid >> 6;
  for (int unit = BIDX; unit < 512; unit += gridDim.x) {
    const int l = unit >> 8, c = unit & 255;
    __syncthreads();
    if (tid < 256) { const int i = tid >> 2, j = tid & 3; w3s[tid] = p.in[I_HW3][(size_t)l * 64 * 1024 + (size_t)i * 1024 + j * 256 + c]; }
    if (tid == 0) buf[64 * 129] = cf{0.f, 0.f};
    __syncthreads();
    float dec[4], ss[4];
#pragma unroll
    for (int j = 0; j < 4; ++j) { dec[j] = p.in[I_HDECAY][l * 1024 + j * 256 + c]; ss[j] = 0.f; }
    const float* h2 = (const float*)(p.ws + OFF_H2) + (size_t)l * 16 * NKEYS * 4;
#pragma unroll 1
    for (int half = 0; half < 2; ++half) {
      float acc[8][4];
#pragma unroll
      for (int i = 0; i < 8; ++i) { acc[i][0] = 0.f; acc[i][1] = 0.f; acc[i][2] = 0.f; acc[i][3] = 0.f; }
      const f32x4* hr = (const f32x4*)h2 + tid + half * 8 * NTHREADS;
#pragma unroll 1
      for (int kc = 0; kc < 8; ++kc) {
        float w[8][4];
#pragma unroll
        for (int kk = 0; kk < 8; ++kk)
#pragma unroll
          for (int j = 0; j < 4; ++j) w[kk][j] = __int_as_float(__builtin_amdgcn_readfirstlane(__float_as_int(w3s[(kc * 8 + kk) * 4 + j])));
#pragma unroll
        for (int i = 0; i < 8; ++i) {
          const f32x4 h0 = hr[(size_t)(kc * 2) * NKEYS + NTHREADS * i], h1 = hr[(size_t)(kc * 2 + 1) * NKEYS + NTHREADS * i];
#pragma unroll
          for (int kk = 0; kk < 4; ++kk)
#pragma unroll
            for (int j = 0; j < 4; ++j) { acc[i][j] += h0[kk] * w[kk][j]; acc[i][j] += h1[kk] * w[4 + kk][j]; }
        }
      }
#pragma unroll
      for (int i = 0; i < 8; ++i) {
        const int t = tid + NTHREADS * (half * 8 + i);
        float a[4] = {acc[i][0], acc[i][1], acc[i][2], acc[i][3]};
        const float tn = (float)t * (1.f / (float)SEQ);
#pragma unroll
        for (int j = 0; j < 4; ++j) { a[j] *= __expf(-tn * dec[j]); ss[j] += a[j] * a[j]; }
        const int pf = (t >> 7) * 129 + (t & 127);
        fb[2 * pf] = a[0]; fb[2 * pf + 1] = a[2];
        if (t > 0) { const int n = 16384 - t, pb = (n >> 7) * 129 + (n & 127); fb[2 * pb] = a[1]; fb[2 * pb + 1] = a[3]; }
      }
    }
#pragma unroll
    for (int j = 0; j < 4; ++j) { ss[j] = wave_sum(ss[j]); if (lane == 0) red[wid * 4 + j] = ss[j]; }
    __syncthreads();
    float sc[4];
#pragma unroll
    for (int j = 0; j < 4; ++j) { float s = 0.f; for (int w = 0; w < 8; ++w) s += red[w * 4 + j]; sc[j] = rsqrtf(s + EPSV) * (1.f / 16384.f); }
    const float sk0 = p.in[I_HSKIP][l * 512 + c] * (1.f / 16384.f), sk1 = p.in[I_HSKIP][l * 512 + 256 + c] * (1.f / 16384.f);
    for (int i = 0; i < 32; ++i) {
      const int n = tid + NTHREADS * i, pi = (n >> 7) * 129 + (n & 127);
      cf v = buf[pi];
      if (n < 8192) { v.x *= sc[0]; v.y *= sc[2]; } else { v.x *= sc[1]; v.y *= sc[3]; }
      if (n == 0) { v.x += sk0; v.y += sk1; }
      buf[pi] = v;
    }
    __syncthreads();
    fft_fwd(buf);
    unsigned* hs = (unsigned*)(p.ws + OFF_HSPEC) + ((size_t)(l * 256 + c) * 2) * 16384;
    for (int i = 0; i < 32; ++i) {
      const int e = tid + NTHREADS * i, r = e >> 7, cc = e & 127;
      const int k = fft_freq(r, cc), k2 = (16384 - k) & 16383;
      const cf a = buf[r * 129 + cc], b = buf[fft_pos(k2)];
      hs[e] = cvtpk(0.5f * (a.x + b.x), 0.5f * (a.y - b.y));
      hs[16384 + e] = cvtpk(0.5f * (a.y + b.y), -0.5f * (a.x - b.x));
    }
  }
}

__device__ void hyena_fft(const Params& p, int layer, char* smem) {
  cf* buf = (cf*)smem;
  const int tid = TIDX;
  bf16_t* mix = (bf16_t*)(p.ws + OFF_MIX);
  const float* hin = (const float*)(p.ws + OFF_HYIN);
  for (int unit = (int)gridDim.x - 1 - BIDX; unit < 256; unit += gridDim.x) {
    const int c = unit;
    const unsigned* hs = (const unsigned*)(p.ws + OFF_HSPEC) + ((size_t)(layer * 256 + c) * 2) * 16384;
    __syncthreads();
    {
      const float* z0 = hin + ((size_t)(0 * 2 + 0) * 256 + c) * SEQ; const float* z1 = hin + ((size_t)(0 * 2 + 1) * 256 + c) * SEQ;
      for (int i = 0; i < 16; ++i) { const int t = tid + NTHREADS * i; buf[(t >> 7) * 129 + (t & 127)] = cf{z0[t], z1[t]}; }
      for (int i = 0; i < 16; ++i) { const int t = 8192 + tid + NTHREADS * i; buf[(t >> 7) * 129 + (t & 127)] = cf{0.f, 0.f}; }
    }
    __syncthreads();
    for (int order = 0; order < 2; ++order) {
      fft_fwd(buf);
      for (int i = 0; i < 32; ++i) {
        const int e = tid + NTHREADS * i, pi = (e >> 7) * 129 + (e & 127);
        const unsigned hv = hs[order * 16384 + e];
        const cf h = {__uint_as_float(hv << 16), __uint_as_float(hv & 0xffff0000u)};
        buf[pi] = cmul(buf[pi], h);
      }
      __syncthreads();
      fft_inv(buf);
      const float* x0 = hin + ((size_t)((1 + order) * 2 + 0) * 256 + c) * SEQ; const float* x1 = hin + ((size_t)((1 + order) * 2 + 1) * 256 + c) * SEQ;
      if (order == 0) {
        for (int i = 0; i < 16; ++i) { const int t = tid + NTHREADS * i, pi = (t >> 7) * 129 + (t & 127); const cf v = buf[pi]; buf[pi] = cf{v.x * x0[t], v.y * x1[t]}; }
        for (int i = 0; i < 16; ++i) { const int t = 8192 + tid + NTHREADS * i; buf[(t >> 7) * 129 + (t & 127)] = cf{0.f, 0.f}; }
        __syncthreads();
      } else {
        bf16_t* yc = (bf16_t*)(p.ws + OFF_HB);
        for (int i = 0; i < 8; ++i) {
          const int t = 2 * (tid + NTHREADS * i); const cf v0 = buf[(t >> 7) * 129 + (t & 127)], v1 = buf[(t >> 7) * 129 + (t & 127) + 1];
          *(unsigned*)(yc + ((size_t)(0 * 256 + c)) * SEQ + t) = cvtpk(v0.x * x0[t], v1.x * x0[t + 1]);
          *(unsigned*)(yc + ((size_t)(1 * 256 + c)) * SEQ + t) = cvtpk(v0.y * x1[t], v1.y * x1[t + 1]);
        }
      }
    }
  }
}

__device__ void stage_prep2(const Params& p, char* smem) {
  {
    float* mod = (float*)(p.ws + OFF_MOD); const float* modp = (const float*)(p.ws + OFF_MODP);
    for (int e = BIDX * NTHREADS + TIDX; e < 2 * 3 * 6144; e += gridDim.x * NTHREADS) {
      const int l = e / (3 * 6144), w = (e / 6144) % 3, col = e % 6144;
      float s = p.in[I_BMOD][l * 6144 + col];
      for (int ks = 0; ks < 32; ++ks) s += modp[((size_t)(l * 32 + ks) * 3 + w) * 6144 + col];
      mod[e] = s;
    }
  }
  float* h2t = (float*)smem;
  float* w3t = h2t + 64 * 65;
  const int tloc = TIDX & 63, cgp = TIDX >> 6, lane = TIDX & 63;
  for (int it = BIDX; it < 2 * 4 * 16; it += gridDim.x) {
    const int l = it / (4 * 16), tt = 128 + (it / 16) % 4, ct = it % 16;
    const bool isc = tt >= 128; const int L = isc ? CTXL : SEQ; const int t0 = isc ? (tt - 128) * 64 : tt * 64;
    const int pos0 = isc ? SEQ + t0 : t0;
    const float* h2 = (const float*)(p.ws + OFF_H2);
    const float* w3 = p.in[I_HW3] + (size_t)l * 64 * 1024 + ct * 64;
    __syncthreads();
    for (int e = TIDX; e < 4096; e += NTHREADS) { int i = e >> 6, j = e & 63; h2t[i * 65 + j] = h2[h2idx(l, pos0 + i, j)]; w3t[i * 64 + j] = w3[(size_t)i * 1024 + j]; }
    __syncthreads();
    float acc[8];
#pragma unroll
    for (int cc = 0; cc < 8; ++cc) acc[cc] = 0.f;
#pragma unroll 2
    for (int i = 0; i < 64; ++i) {
      const float hv = h2t[tloc * 65 + i];
#pragma unroll
      for (int cc = 0; cc < 8; ++cc) acc[cc] += hv * w3t[i * 64 + cgp * 8 + cc];
    }
    const float tn = (float)(t0 + tloc) / (float)L;
#pragma unroll
    for (int cc = 0; cc < 8; ++cc) {
      const int col = ct * 64 + cgp * 8 + cc;
      const float val = acc[cc] * __expf(-tn * p.in[I_HDECAY][l * 1024 + col]);
      ((float*)(p.ws + OFF_FILTC))[((size_t)l * 1024 + col) * CTXL + t0 + tloc] = val;
      const float s = wave_sum(val * val);
      if (lane == 0) ((float*)(p.ws + OFF_SSQPC))[((size_t)l * 4 + (tt - 128)) * 1024 + col] = s;
    }
  }
  hyena_spectra(p, smem);
}

__device__ void stage_norm(const Params& p, int layer, int which  , int nrows) {
  const int lane = TIDX & 63, wid = TIDX >> 6;
  const float* g = (which ? p.in[I_N2G] : p.in[I_N1G]) + layer * DM;
  bf16_t* hb = (bf16_t*)(p.ws + OFF_HB);
  const int ngrp = nrows / 4, gstride = gridDim.x * 8;
  int grp = BIDX * 8 + wid;
  f32x4 v[4][4], vn[4][4];
  auto rowsrc = [&](int r0) -> const float* { return (which == 0) ? xrow_src(p, layer, r0) : (const float*)(p.ws + OFF_XS) + (size_t)r0 * DM; };
  if (grp < ngrp) {
    const float* src = rowsrc(grp * 4);
#pragma unroll
    for (int j = 0; j < 4; ++j)
#pragma unroll
      for (int i = 0; i < 2; ++i) { v[j][2 * i] = *(const f32x4*)(src + (size_t)j * DM + i * 512 + lane * 8); v[j][2 * i + 1] = *(const f32x4*)(src + (size_t)j * DM + i * 512 + lane * 8 + 4); }
  }
  for (; grp < ngrp; grp += gstride) {
    const int r0 = grp * 4, gn = grp + gstride;
    if (gn < ngrp) {
      const float* src = rowsrc(gn * 4);
#pragma unroll
      for (int j = 0; j < 4; ++j)
#pragma unroll
        for (int i = 0; i < 2; ++i) { vn[j][2 * i] = *(const f32x4*)(src + (size_t)j * DM + i * 512 + lane * 8); vn[j][2 * i + 1] = *(const f32x4*)(src + (size_t)j * DM + i * 512 + lane * 8 + 4); }
    }
    int b, t, isc; row_info(r0, b, t, isc);
    const float* mod = (const float*)(p.ws + OFF_MOD) + ((size_t)layer * 3 + (isc ? 2 : b)) * 6144 + (which ? 3072 : 0);
    float ss[4];
#pragma unroll
    for (int j = 0; j < 4; ++j) {
      float s = 0.f;
#pragma unroll
      for (int i = 0; i < 4; ++i) s += v[j][i][0] * v[j][i][0] + v[j][i][1] * v[j][i][1] + v[j][i][2] * v[j][i][2] + v[j][i][3] * v[j][i][3];
      ss[j] = s;
    }
#pragma unroll
    for (int j = 0; j < 4; ++j) ss[j] = rsqrtf(wave_sum(ss[j]) * (1.f / DM) + EPSV);
#pragma unroll
    for (int i = 0; i < 2; ++i) {
      const int c0 = i * 512 + lane * 8;
      const f32x4 g0 = *(const f32x4*)(g + c0), g1 = *(const f32x4*)(g + c0 + 4);
      const f32x4 sc0 = *(const f32x4*)(mod + 1024 + c0), sc1 = *(const f32x4*)(mod + 1024 + c0 + 4), sh0 = *(const f32x4*)(mod + c0), sh1 = *(const f32x4*)(mod + c0 + 4);
#pragma unroll
      for (int j = 0; j < 4; ++j) {
        float y[8];
#pragma unroll
        for (int q = 0; q < 4; ++q) { y[q] = v[j][2 * i][q] * ss[j] * g0[q] * (1.f + sc0[q]) + sh0[q]; y[4 + q] = v[j][2 * i + 1][q] * ss[j] * g1[q] * (1.f + sc1[q]) + sh1[q]; }
        const u32x4 o = {cvtpk(y[0], y[1]), cvtpk(y[2], y[3]), cvtpk(y[4], y[5]), cvtpk(y[6], y[7])};
        *(u32x4*)(hb + (size_t)(r0 + j) * DM + c0) = o;
      }
    }
#pragma unroll
    for (int j = 0; j < 4; ++j)
#pragma unroll
      for (int i = 0; i < 4; ++i) v[j][i] = vn[j][i];
  }
}

template <class Epi>
__device__ void gemm_bt(const bf16_t* __restrict__ A, int lda, const bf16_t* __restrict__ Bt, int ldb, int M, int N, int K, Epi epi, char* smem) {
  const int tid = TIDX, wid = tid >> 6, lane = tid & 63, r32 = lane & 31, hi = lane >> 5;
  const int wm = wid >> 2, wn = wid & 3;
  constexpr int RS = 144;
  char* sA = smem; char* sB = smem + 128 * RS;
  const int tilesM = M / 128, tilesN = N / 128, nk = K / 64;
  const int lr0 = tid >> 3, lc = (tid & 7) * 8;
  for (int tile = BIDX; tile < tilesM * tilesN; tile += gridDim.x) {
    const int tm = tile / tilesN, tn = tile % tilesN;
    const bf16_t* Ap = A + (size_t)(tm * 128 + lr0) * lda + lc;
    const bf16_t* Bp = Bt + (size_t)(tn * 128 + lr0) * ldb + lc;
    f32x16 acc0 = {}, acc1 = {};
    u32x4 ra0 = *(const u32x4*)Ap, ra1 = *(const u32x4*)(Ap + (size_t)64 * lda);
    u32x4 rb0 = *(const u32x4*)Bp, rb1 = *(const u32x4*)(Bp + (size_t)64 * ldb);
    for (int kt = 0; kt < nk; ++kt) {
      __syncthreads();
      *(u32x4*)(sA + lr0 * RS + lc * 2) = ra0; *(u32x4*)(sA + (lr0 + 64) * RS + lc * 2) = ra1;
      *(u32x4*)(sB + lr0 * RS + lc * 2) = rb0; *(u32x4*)(sB + (lr0 + 64) * RS + lc * 2) = rb1;
      __syncthreads();
      if (kt + 1 < nk) {
        const int ko = (kt + 1) * 64;
        ra0 = *(const u32x4*)(Ap + ko); ra1 = *(const u32x4*)(Ap + (size_t)64 * lda + ko);
        rb0 = *(const u32x4*)(Bp + ko); rb1 = *(const u32x4*)(Bp + (size_t)64 * ldb + ko);
      }
#pragma unroll
      for (int ks = 0; ks < 4; ++ks) {
        const int cb = (ks * 16 + hi * 8) * 2;
        const bf16x8 a0 = *(const bf16x8*)(sA + (wm * 64 + r32) * RS + cb);
        const bf16x8 a1 = *(const bf16x8*)(sA + (wm * 64 + 32 + r32) * RS + cb);
        const bf16x8 bb = *(const bf16x8*)(sB + (wn * 32 + r32) * RS + cb);
        acc0 = __builtin_amdgcn_mfma_f32_32x32x16_bf16(a0, bb, acc0, 0, 0, 0);
        acc1 = __builtin_amdgcn_mfma_f32_32x32x16_bf16(a1, bb, acc1, 0, 0, 0);
      }
    }
    const int col = tn * 128 + wn * 32 + r32;
#pragma unroll
    for (int r = 0; r < 16; ++r) {
      epi(tm * 128 + wm * 64 + crow(r, hi), col, acc0[r]);
      epi(tm * 128 + wm * 64 + 32 + crow(r, hi), col, acc1[r]);
    }
  }
}

__device__ __forceinline__ float rope_apply(float x, float xp, int c, int t) {
  const int i = c & 7; const float pos = ((c >> 4) & 1) ? (float)(t & 63) : (float)(t >> 6);
  const float inv = __expf(-(float)i * (9.210340371976184f / 8.f));
  const float rev = (pos * inv) * 0.15915494309189535f;
  const float cs = __builtin_amdgcn_cosf(rev), sn = __builtin_amdgcn_sinf(rev);
  return x * cs + ((c & 8) ? xp : -xp) * sn;
}

constexpr int NCH32 = NTOK / 32;
__device__ __forceinline__ float swap32(float v, int hi) { const auto rr = __builtin_amdgcn_permlane32_swap(__float_as_uint(v), __float_as_uint(v), false, false); return __uint_as_float(hi ? rr[0] : rr[1]); }
template <bool BWD>
__device__ __forceinline__ void lru_seg_scan(const float* a, const float* b, int hi, float S, float* h, float& Sout) {
  float P[4], H[4], Sin[4];
#pragma unroll
  for (int g = 0; g < 4; ++g) {
    if (!BWD) { H[g] = b[4 * g]; P[g] = a[4 * g];
#pragma unroll
      for (int q = 1; q < 4; ++q) { H[g] = a[4 * g + q] * H[g] + b[4 * g + q]; P[g] *= a[4 * g + q]; } }
    else { H[g] = b[4 * g + 3]; P[g] = a[4 * g + 3];
#pragma unroll
      for (int q = 2; q >= 0; --q) { H[g] = a[4 * g + q] * H[g] + b[4 * g + q]; P[g] *= a[4 * g + q]; } }
    Sin[g] = 0.f;
  }
#pragma unroll
  for (int step = 0; step < 8; ++step) {
    const int s = BWD ? 7 - step : step, g = s >> 1, owner = s & 1;
    const bool mine = (hi == owner);
    if (mine) Sin[g] = S;
    const float cand = P[g] * S + H[g];
    const float other = swap32(cand, hi);
    S = mine ? cand : other;
  }
  Sout = S;
#pragma unroll
  for (int g = 0; g < 4; ++g) {
    float hp = Sin[g];
    if (!BWD) {
#pragma unroll
      for (int q = 0; q < 4; ++q) { hp = a[4 * g + q] * hp + b[4 * g + q]; h[4 * g + q] = hp; } }
    else {
#pragma unroll
      for (int q = 3; q >= 0; --q) { hp = a[4 * g + q] * hp + b[4 * g + q]; h[4 * g + q] = hp; } }
  }
}
__device__ void lru_units(const Params& p, int layer, int mode, char* smem) {
  const int tid = TIDX, wid = tid >> 6, lane = tid & 63, r32 = lane & 31, hi = lane >> 5;
  const bf16_t* u = (const bf16_t*)(p.ws + OFF_U);
  const float* cw = p.in[I_LCW] + (size_t)layer * 4 * DLRU; const float* cbias = p.in[I_LCB] + layer * DLRU;
  bf16_t* mix = (bf16_t*)(p.ws + OFF_MIX);
  constexpr int RS = 272;
  char* tile = smem + wid * (35 * RS);
  const int bid = BIDX, n = bid % 6, rk = bid / 6, nbn = ((int)gridDim.x - n + 5) / 6;
  char* gwl = smem + 8 * 35 * RS;
  __syncthreads();
  for (int i = tid; i < 2048; i += NTHREADS) {
    const int mat = i >> 9, row = (i >> 3) & 63, c = i & 7;
    const bf16_t* gsrc = (const bf16_t*)(p.ws + OFF_GW) + ((size_t)((layer * 2 + (mat >> 1)) * 2 + (mat & 1)) * 6 + n) * 4096 + row * 64 + c * 8;
    *(u32x4*)(gwl + mat * 8192 + row * 128 + ((c ^ (row & 7)) << 4)) = *(const u32x4*)gsrc;
  }
  __syncthreads();
  for (int cid = rk * 8 + wid; cid < NCH32; cid += nbn * 8) {
    const int unit = cid * 6 + n;
    int rbase, t0, slen;
    if (cid < 512) { const int b = cid >> 8; rbase = b * SEQ; t0 = (cid & 255) * 32; slen = SEQ; }
    else { const int q = cid - 512, b = q >> 3; rbase = NLAT + b * CTXL; t0 = (q & 7) * 32; slen = CTXL; }
    {
      const int row8 = lane >> 3, c8 = lane & 7;
      const bf16_t* ub = u + (size_t)rbase * DIN + n * 64 + c8 * 8;
#pragma unroll
      for (int i = 0; i < 5; ++i) {
        const int row = i * 8 + row8, t = t0 + row - 2;
        if (row < 35) {
          u32x4 v = {0u, 0u, 0u, 0u};
          if (t >= 0 && t < slen) v = *(const u32x4*)(ub + (size_t)t * DIN);
          const f32x4 lo = {__uint_as_float(v[0] << 16), __uint_as_float(v[0] & 0xffff0000u), __uint_as_float(v[1] << 16), __uint_as_float(v[1] & 0xffff0000u)};
          const f32x4 hi4 = {__uint_as_float(v[2] << 16), __uint_as_float(v[2] & 0xffff0000u), __uint_as_float(v[3] << 16), __uint_as_float(v[3] & 0xffff0000u)};
          *(f32x4*)(tile + row * RS + c8 * 32) = lo; *(f32x4*)(tile + row * RS + c8 * 32 + 16) = hi4;
        }
      }
    }
    bf16x8 af[4];
    {
      const char* tl = tile + r32 * RS + hi * 32;
#pragma unroll
      for (int ks = 0; ks < 4; ++ks) {
        const int col = n * 64 + ks * 16 + 8 * hi;
        f32x4 c0 = *(const f32x4*)(cbias + col), c1 = *(const f32x4*)(cbias + col + 4);
#pragma unroll
        for (int k = 0; k < 4; ++k) {
          const f32x4 x0 = *(const f32x4*)(tl + k * RS + ks * 64), x1 = *(const f32x4*)(tl + k * RS + ks * 64 + 16);
          const f32x4 w0 = *(const f32x4*)(cw + k * DLRU + col), w1 = *(const f32x4*)(cw + k * DLRU + col + 4);
          c0 += w0 * x0; c1 += w1 * x1;
        }
        const u32x4 pk = {cvtpk(c0[0], c0[1]), cvtpk(c0[2], c0[3]), cvtpk(c1[0], c1[1]), cvtpk(c1[2], c1[3])};
        af[ks] = *(const bf16x8*)&pk;
      }
    }
    float xo[2][16];
#pragma unroll
    for (int nt = 0; nt < 2; ++nt) {
      const int ch = n * 64 + nt * 32 + r32;
      const float w0 = cw[ch], w1 = cw[DLRU + ch], w2 = cw[2 * DLRU + ch], w3 = cw[3 * DLRU + ch], bb = cbias[ch];
      const char* tl = tile + (4 * hi) * RS + (nt * 32 + r32) * 4;
#pragma unroll
      for (int g = 0; g < 4; ++g) {
        float xr[7];
#pragma unroll
        for (int i = 0; i < 7; ++i) xr[i] = *(const float*)(tl + (8 * g + i) * RS);
#pragma unroll
        for (int q = 0; q < 4; ++q) xo[nt][4 * g + q] = bb + w0 * xr[q] + w1 * xr[q + 1] + w2 * xr[q + 2] + w3 * xr[q + 3];
      }
    }
    if (mode == 1) {
      const bf16_t* ub = u + (size_t)(rbase + t0) * DIN + DLRU + n * 64 + lane;
#pragma unroll 4
      for (int i = 0; i < 32; ++i) *(float*)(tile + i * RS + lane * 4) = bf2f(ub[(size_t)i * DIN]);
    }
#pragma unroll 1
    for (int nt = 0; nt < 2; ++nt) {
      const int ch = n * 64 + nt * 32 + r32;
      float hf[16];
#pragma unroll
      for (int dir = 0; dir < 2; ++dir) {
        const char* gwr = gwl + (dir * 2 + 0) * 8192 + (nt * 32 + r32) * 128;
        const char* gwi = gwl + (dir * 2 + 1) * 8192 + (nt * 32 + r32) * 128;
        f32x16 accR = {}, accI = {};
#pragma unroll
        for (int ks = 0; ks < 4; ++ks) {
          const int co = ((ks * 2 + hi) ^ (r32 & 7)) << 4;
          const bf16x8 br_ = *(const bf16x8*)(gwr + co), bi_ = *(const bf16x8*)(gwi + co);
          accR = __builtin_amdgcn_mfma_f32_32x32x16_bf16(af[ks], br_, accR, 0, 0, 0);
          accI = __builtin_amdgcn_mfma_f32_32x32x16_bf16(af[ks], bi_, accI, 0, 0, 0);
        }
        const size_t po = (size_t)(layer * 2 + dir) * DLRU + ch;
        const float brv = p.in[I_LBR][po], biv = p.in[I_LBI][po];
        const float cl = -8.f * __logf(1.f + __expf(-p.in[I_LLAM][po]));
        float a[16], bq[16];
#pragma unroll
        for (int r = 0; r < 16; ++r) {
          const float rr = __builtin_amdgcn_rcpf(1.f + __expf(-(accR[r] + brv))), ii = __builtin_amdgcn_rcpf(1.f + __expf(-(accI[r] + biv)));
          const float av = __expf(rr * cl);
          a[r] = av; bq[r] = __builtin_amdgcn_sqrtf(fmaxf(1.f - av * av, 0.f)) * (ii * (nt == 0 ? xo[0][r] : xo[1][r]));
        }
        if (mode == 0) {
          {
            u32x4* ab = (u32x4*)(p.ws + OFF_LAB) + ((((size_t)unit * 2 + nt) * 2 + dir) * 4) * 64 + lane;
#pragma unroll
            for (int r4 = 0; r4 < 4; ++r4) { const u32x4 o = {cvtpk(1.f - a[4 * r4], bq[4 * r4]), cvtpk(1.f - a[4 * r4 + 1], bq[4 * r4 + 1]), cvtpk(1.f - a[4 * r4 + 2], bq[4 * r4 + 2]), cvtpk(1.f - a[4 * r4 + 3], bq[4 * r4 + 3])}; ab[r4 * 64] = o; }
          }
          float hd[16], Send;
          if (dir == 0) lru_seg_scan<false>(a, bq, hi, 0.f, hd, Send); else lru_seg_scan<true>(a, bq, hi, 0.f, hd, Send);
          float pp = a[0];
#pragma unroll
          for (int r = 1; r < 16; ++r) pp *= a[r];
          pp *= swap32(pp, hi);
          if (hi == 0) { float* ls = (float*)(p.ws + OFF_LSUM) + ((size_t)(cid * 2 + dir) * 2) * DLRU + ch; ls[0] = pp; ls[DLRU] = Send; }
        } else {
          const float cin = ((const float*)(p.ws + OFF_CARRY))[(size_t)(cid * 2 + dir) * DLRU + ch];
          float Send;
          if (dir == 0) lru_seg_scan<false>(a, bq, hi, cin, hf, Send);
          else {
            float hb[16];
            lru_seg_scan<true>(a, bq, hi, cin, hb, Send);
            const char* tl = tile + (4 * hi) * RS + (nt * 32 + r32) * 4;
            bf16_t* mo = mix + ((size_t)rbase + t0 + 4 * hi) * DM + ch;
#pragma unroll
            for (int r = 0; r < 16; ++r) {
              const int tk = (r & 3) + 8 * (r >> 2);
              const float gt = *(const float*)(tl + tk * RS);
              mo[(size_t)tk * DM] = f2bf((hf[r] + hb[r]) * gelu_tanh(gt));
            }
          }
        }
      }
    }
  }
}

__device__ void lru_final(const Params& p, int layer, char* smem) {
  const int tid = TIDX, wid = tid >> 6, lane = tid & 63, r32 = lane & 31, hi = lane >> 5;
  const bf16_t* u = (const bf16_t*)(p.ws + OFF_U);
  bf16_t* mix = (bf16_t*)(p.ws + OFF_MIX);
  constexpr int RS = 272;
  char* tile = smem + wid * (35 * RS);
  __syncthreads();
  for (int unit = BIDX * 8 + wid; unit < NCH32 * 6; unit += gridDim.x * 8) {
    const int cid = unit / 6, n = unit % 6;
    int rbase, t0;
    if (cid < 512) { const int b = cid >> 8; rbase = b * SEQ; t0 = (cid & 255) * 32; }
    else { const int q = cid - 512, b = q >> 3; rbase = NLAT + b * CTXL; t0 = (q & 7) * 32; }
    unsigned ab[2][2][16];
#pragma unroll
    for (int nt = 0; nt < 2; ++nt)
#pragma unroll
      for (int dir = 0; dir < 2; ++dir) {
        const u32x4* abp = (const u32x4*)(p.ws + OFF_LAB) + ((((size_t)unit * 2 + nt) * 2 + dir) * 4) * 64 + lane;
#pragma unroll
        for (int r4 = 0; r4 < 4; ++r4) { const u32x4 v = abp[r4 * 64]; ab[nt][dir][4 * r4] = v[0]; ab[nt][dir][4 * r4 + 1] = v[1]; ab[nt][dir][4 * r4 + 2] = v[2]; ab[nt][dir][4 * r4 + 3] = v[3]; }
      }
    {
      const int row8 = lane >> 3, c8 = lane & 7;
      const bf16_t* ub = u + (size_t)(rbase + t0) * DIN + DLRU + n * 64 + c8 * 8;
#pragma unroll
      for (int i = 0; i < 4; ++i) {
        const int row = i * 8 + row8;
        const u32x4 v = *(const u32x4*)(ub + (size_t)row * DIN);
        const f32x4 lo = {__uint_as_float(v[0] << 16), __uint_as_float(v[0] & 0xffff0000u), __uint_as_float(v[1] << 16), __uint_as_float(v[1] & 0xffff0000u)};
        const f32x4 hi4 = {__uint_as_float(v[2] << 16), __uint_as_float(v[2] & 0xffff0000u), __uint_as_float(v[3] << 16), __uint_as_float(v[3] & 0xffff0000u)};
        *(f32x4*)(tile + row * RS + c8 * 32) = lo; *(f32x4*)(tile + row * RS + c8 * 32 + 16) = hi4;
      }
    }
#pragma unroll
    for (int nt = 0; nt < 2; ++nt) {
      const int ch = n * 64 + nt * 32 + r32;
      float hf[16], hb[16], a[16], bq[16], Send;
#pragma unroll
      for (int r = 0; r < 16; ++r) { a[r] = 1.f - __uint_as_float(ab[nt][0][r] << 16); bq[r] = __uint_as_float(ab[nt][0][r] & 0xffff0000u); }
      lru_seg_scan<false>(a, bq, hi, ((const float*)(p.ws + OFF_CARRY))[(size_t)(cid * 2 + 0) * DLRU + ch], hf, Send);
#pragma unroll
      for (int r = 0; r < 16; ++r) { a[r] = 1.f - __uint_as_float(ab[nt][1][r] << 16); bq[r] = __uint_as_float(ab[nt][1][r] & 0xffff0000u); }
      lru_seg_scan<true>(a, bq, hi, ((const float*)(p.ws + OFF_CARRY))[(size_t)(cid * 2 + 1) * DLRU + ch], hb, Send);
      const char* tl = tile + (4 * hi) * RS + (nt * 32 + r32) * 4;
      bf16_t* mo = mix + ((size_t)rbase + t0 + 4 * hi) * DM + ch;
#pragma unroll
      for (int r = 0; r < 16; ++r) {
        const int tk = (r & 3) + 8 * (r >> 2);
        const float gt = *(const float*)(tl + tk * RS);
        mo[(size_t)tk * DM] = f2bf((hf[r] + hb[r]) * gelu_tanh(gt));
      }
    }
  }
}

__device__ void lru_carry(const Params& p, char* smem) {
  const int tid = TIDX, seg = tid >> 6, c = tid & 63;
  const float* __restrict__ ls = (const float*)(p.ws + OFF_LSUM); float* __restrict__ cr = (float*)(p.ws + OFF_CARRY);
  float* comp = (float*)smem;
  for (int item = (int)gridDim.x - 1 - BIDX; item < 2 * 2 * 6; item += gridDim.x) {
    const int b = item / 12, dir = (item / 6) & 1, ch = (item % 6) * 64 + c;
    float P[33], H[33];
#pragma unroll
    for (int i = 0; i < 33; ++i) {
      const int k = seg * 33 + i;
      int cid;
      if (dir == 0) cid = (k < 8) ? 512 + b * 8 + k : b * 256 + (k - 8);
      else          cid = (k < 8) ? 512 + b * 8 + (7 - k) : b * 256 + (255 - (k - 8));
      P[i] = ls[((size_t)(cid * 2 + dir) * 2) * DLRU + ch]; H[i] = ls[((size_t)(cid * 2 + dir) * 2 + 1) * DLRU + ch];
    }
    float pc = 1.f, hc = 0.f;
#pragma unroll
    for (int i = 0; i < 33; ++i) { hc = P[i] * hc + H[i]; pc *= P[i]; }
    __syncthreads();
    comp[(seg * 2) * 64 + c] = pc; comp[(seg * 2 + 1) * 64 + c] = hc;
    __syncthreads();
    float st = 0.f;
    for (int s = 0; s < seg; ++s) st = comp[(s * 2) * 64 + c] * st + comp[(s * 2 + 1) * 64 + c];
#pragma unroll
    for (int i = 0; i < 33; ++i) {
      const int k = seg * 33 + i;
      int cid;
      if (dir == 0) cid = (k < 8) ? 512 + b * 8 + k : b * 256 + (k - 8);
      else          cid = (k < 8) ? 512 + b * 8 + (7 - k) : b * 256 + (255 - (k - 8));
      cr[(size_t)(cid * 2 + dir) * DLRU + ch] = st;
      st = P[i] * st + H[i];
    }
  }
}

__device__ void mla_prep(const Params& p, int layer) {
  const int lane = TIDX & 63, wid = TIDX >> 6;
  const bf16_t* u = (const bf16_t*)(p.ws + OFF_U);
  const float* qg = p.in[I_QNG] + layer * 384; const float* kvg = p.in[I_KVNG] + layer * 256;
  bf16_t* qn = (bf16_t*)(p.ws + OFF_QN); bf16_t* kvn = (bf16_t*)(p.ws + OFF_KVN); bf16_t* Kb = (bf16_t*)(p.ws + OFF_K);
  const bool qact = lane < 48, kact = lane < 32;
  f32x4 qg0 = {0.f, 0.f, 0.f, 0.f}, qg1 = qg0, kg0 = qg0, kg1 = qg0;
  if (qact) { qg0 = *(const f32x4*)(qg + lane * 8); qg1 = *(const f32x4*)(qg + lane * 8 + 4); }
  if (kact) { kg0 = *(const f32x4*)(kvg + lane * 8); kg1 = *(const f32x4*)(kvg + lane * 8 + 4); }
  u32x4 qv[4], kv[4], qvn[4], kvn_[4]; unsigned short kr[4], krn[4];
  const int gstride = gridDim.x * 8;
  int grp = BIDX * 8 + wid;
#define MLA_LOAD(QV, KV, KR, G) do { _Pragma("unroll") for (int j = 0; j < 4; ++j) { const bf16_t* ur = u + (size_t)((G) * 4 + j) * DIN; \
      QV[j] = u32x4{0u, 0u, 0u, 0u}; KV[j] = u32x4{0u, 0u, 0u, 0u}; \
      if (qact) QV[j] = *(const u32x4*)(ur + 768 + lane * 8); if (kact) KV[j] = *(const u32x4*)(ur + 1152 + lane * 8); KR[j] = ur[1408 + (lane & 31)]; } } while (0)
  if (grp < NTOK / 4) MLA_LOAD(qv, kv, kr, grp);
  for (; grp < NTOK / 4; grp += gstride) {
    const int r0 = grp * 4;
    if (grp + gstride < NTOK / 4) MLA_LOAD(qvn, kvn_, krn, grp + gstride);
#pragma unroll
    for (int j = 0; j < 4; ++j) {
      const int r = r0 + j;
      int b, t, isc; row_info(r, b, t, isc);
      float q[8], k[8], ss = 0.f;
#pragma unroll
      for (int i = 0; i < 4; ++i) { q[2 * i] = __uint_as_float(qv[j][i] << 16); q[2 * i + 1] = __uint_as_float(qv[j][i] & 0xffff0000u); ss += q[2 * i] * q[2 * i] + q[2 * i + 1] * q[2 * i + 1]; }
      float rinv = rsqrtf(wave_sum(ss) * (1.f / 384.f) + EPSV);
      if (qact) {
        const u32x4 o = {cvtpk(q[0] * rinv * qg0[0], q[1] * rinv * qg0[1]), cvtpk(q[2] * rinv * qg0[2], q[3] * rinv * qg0[3]),
                         cvtpk(q[4] * rinv * qg1[0], q[5] * rinv * qg1[1]), cvtpk(q[6] * rinv * qg1[2], q[7] * rinv * qg1[3])};
        *(u32x4*)(qn + (size_t)r * 384 + lane * 8) = o;
      }
      ss = 0.f;
#pragma unroll
      for (int i = 0; i < 4; ++i) { k[2 * i] = __uint_as_float(kv[j][i] << 16); k[2 * i + 1] = __uint_as_float(kv[j][i] & 0xffff0000u); ss += k[2 * i] * k[2 * i] + k[2 * i + 1] * k[2 * i + 1]; }
      rinv = rsqrtf(wave_sum(ss) * (1.f / 256.f) + EPSV);
      if (kact) {
        const u32x4 o = {cvtpk(k[0] * rinv * kg0[0], k[1] * rinv * kg0[1]), cvtpk(k[2] * rinv * kg0[2], k[3] * rinv * kg0[3]),
                         cvtpk(k[4] * rinv * kg1[0], k[5] * rinv * kg1[1]), cvtpk(k[6] * rinv * kg1[2], k[7] * rinv * kg1[3])};
        *(u32x4*)(kvn + (size_t)r * 256 + lane * 8) = o;
      }
      const float krv = bf2f(kr[j]), krp = shx(krv, 8);
      const float ko = isc ? krv : rope_apply(krv, krp, lane & 31, t);
      if (lane < 32) ((bf16_t*)(p.ws + OFF_V))[(size_t)r * 32 + rope_slot(lane)] = f2bf(ko);
    }
#pragma unroll
    for (int j = 0; j < 4; ++j) { qv[j] = qvn[j]; kv[j] = kvn_[j]; kr[j] = krn[j]; }
  }
#undef MLA_LOAD
}

__device__ void hyena_prep(const Params& p, int layer, char* smem) {
  constexpr int RS = 516;
  const bf16_t* u = (const bf16_t*)(p.ws + OFF_U);
  const float* cw = p.in[I_HCW] + (size_t)layer * 3 * 768; const float* cb = p.in[I_HCB] + layer * 768;
  const int tid = TIDX;
  const int ntile = (layer == 0) ? NCHUNK : 256;
  for (int unit = BIDX; unit < ntile * 3; unit += gridDim.x) {
    const int cid = unit / 3, part = unit % 3;
    int rbase, t0, slen, b;
    if (cid < 256) { b = cid >> 7; rbase = b * SEQ; t0 = (cid & 127) * 64; slen = SEQ; }
    else { const int q = cid - 256; b = q >> 2; rbase = NLAT + b * CTXL; t0 = (q & 3) * 64; slen = CTXL; }
    __syncthreads();
    {
      const int chunk = tid & 31;
      for (int row = tid >> 5; row < 66; row += 16) {
        const int t = t0 + row - 1;
        u32x4 v = {0u, 0u, 0u, 0u};
        if (t >= 0 && t < slen) v = *(const u32x4*)(u + (size_t)(rbase + t) * DIN + 1440 + part * 256 + chunk * 8);
        unsigned* d = (unsigned*)(smem + row * RS + chunk * 16);
        d[0] = v[0]; d[1] = v[1]; d[2] = v[2]; d[3] = v[3];
      }
    }
    __syncthreads();
    {
      const int tg = tid & 15;
      const char* tb = smem + (4 * tg) * RS;
#pragma unroll
      for (int i = 0; i < 4; ++i) {
        const int cp = (tid >> 4) + 32 * i, pc = part * 256 + 2 * cp;
        unsigned x[6];
#pragma unroll
        for (int k = 0; k < 6; ++k) x[k] = *(const unsigned*)(tb + k * RS + cp * 4);
        const float wa0 = cw[pc], wa1 = cw[768 + pc], wa2 = cw[1536 + pc], ba = cb[pc];
        const float wb0 = cw[pc + 1], wb1 = cw[768 + pc + 1], wb2 = cw[1536 + pc + 1], bb = cb[pc + 1];
        f32x4 ya, yb;
#pragma unroll
        for (int q = 0; q < 4; ++q) {
          ya[q] = ba + wa0 * __uint_as_float(x[q] << 16) + wa1 * __uint_as_float(x[q + 1] << 16) + wa2 * __uint_as_float(x[q + 2] << 16);
          yb[q] = bb + wb0 * __uint_as_float(x[q] & 0xffff0000u) + wb1 * __uint_as_float(x[q + 1] & 0xffff0000u) + wb2 * __uint_as_float(x[q + 2] & 0xffff0000u);
        }
        float* dst = (cid < 256) ? (float*)(p.ws + OFF_HYIN) + ((size_t)(part * 2 + b) * 256 + 2 * cp) * SEQ + t0 + 4 * tg
                                 : (float*)(p.ws + OFF_HYINC) + ((size_t)(part * 2 + b) * 256 + 2 * cp) * CTXL + t0 + 4 * tg;
        *(f32x4*)dst = ya; *(f32x4*)(dst + slen) = yb;
      }
    }
  }
}

__device__ void hyena_out_transpose(const Params& p, char* smem) {
  const bf16_t* yc = (const bf16_t*)(p.ws + OFF_HB); bf16_t* mix = (bf16_t*)(p.ws + OFF_MIX);
  constexpr int RS = 132;
  const int tid = TIDX;
  for (int unit = BIDX; unit < 2 * (SEQ / 64); unit += gridDim.x) {
    const int b = unit / (SEQ / 64), t0 = (unit % (SEQ / 64)) * 64;
    __syncthreads();
    {
      const int chunk = tid & 7;
      for (int c = tid >> 3; c < 256; c += 64) {
        const u32x4 v = *(const u32x4*)(yc + ((size_t)(b * 256 + c)) * SEQ + t0 + chunk * 8);
        unsigned* d = (unsigned*)(smem + c * RS + chunk * 16);
        d[0] = v[0]; d[1] = v[1]; d[2] = v[2]; d[3] = v[3];
      }
    }
    __syncthreads();
    {
      const int c8 = (tid & 31) * 8;
      for (int tl = tid >> 5; tl < 64; tl += 16) {
        unsigned short h[8];
#pragma unroll
        for (int q = 0; q < 8; ++q) h[q] = *(const unsigned short*)(smem + (c8 + q) * RS + tl * 2);
        const u32x4 o = {(unsigned)h[0] | ((unsigned)h[1] << 16), (unsigned)h[2] | ((unsigned)h[3] << 16), (unsigned)h[4] | ((unsigned)h[5] << 16), (unsigned)h[6] | ((unsigned)h[7] << 16)};
        *(u32x4*)(mix + ((size_t)b * SEQ + t0 + tl) * DM + 768 + c8) = o;
      }
    }
  }
}

__device__ void hyena_direct(const Params& p, int layer, char* smem) {
  float* zs = (float*)smem;
  float* Ts = zs + SEQ;
  bf16_t* mix = (bf16_t*)(p.ws + OFF_MIX);
  const int nunits = (layer == 0) ? 512 : 0;
  for (int unit = BIDX; unit < nunits; unit += gridDim.x) {
    const bool isc = true; const int q = unit & 511, b = q >> 8, c = q & 255;
    const int L = CTXL;
    const float* hin = (const float*)(p.ws + OFF_HYINC);
    const float* filt = (const float*)(p.ws + OFF_FILTC) + (size_t)layer * 1024 * CTXL;
    const float* ssq = (const float*)(p.ws + OFF_SSQPC) + (size_t)layer * 4 * 1024;
    const int ntt = 4;
    const int nout = (L + NTHREADS - 1) / NTHREADS;
    for (int order = 0; order < 2; ++order) {
      const int colf = (order * 2 + 0) * 256 + c, colb = (order * 2 + 1) * 256 + c;
      float sf = 0.f, sb = 0.f;
      for (int tt = 0; tt < ntt; ++tt) { sf += ssq[(size_t)tt * 1024 + colf]; sb += ssq[(size_t)tt * 1024 + colb]; }
      sf = rsqrtf(sf + EPSV); sb = rsqrtf(sb + EPSV);
      const float skip = p.in[I_HSKIP][(size_t)layer * 512 + order * 256 + c];
      __syncthreads();
      for (int i = TIDX; i < 2 * L; i += NTHREADS) {
        const int m = i - L;
        float v = 0.f;
        if (m >= 0) v = filt[(size_t)colf * L + m] * sf; else if (m > -L) v = filt[(size_t)colb * L - m] * sb;
        if (m == 0) v += skip;
        Ts[i] = v;
      }
      if (order == 0) for (int i = TIDX; i < L; i += NTHREADS) zs[i] = hin[((size_t)(0 * 2 + b) * 256 + c) * L + i];
      __syncthreads();
      float acc[16];
#pragma unroll
      for (int j = 0; j < 16; ++j) acc[j] = 0.f;
      if ((int)TIDX < L) {
        const float* tb = Ts + L + TIDX;
        if (!isc) {
          for (int s = 0; s < SEQ; ++s) {
            const float zv = zs[s];
#pragma unroll
            for (int j = 0; j < 16; ++j) acc[j] += tb[j * NTHREADS - s] * zv;
          }
        } else {
          for (int s = 0; s < CTXL; ++s) acc[0] += tb[-s] * zs[s];
        }
      }
      __syncthreads();
      const float* xg = hin + ((size_t)((1 + order) * 2 + b) * 256 + c) * L;
#pragma unroll
      for (int j = 0; j < 16; ++j) {
        const int t = TIDX + j * NTHREADS;
        if (t < L) {
          const float y = xg[t] * acc[j];
          if (order == 0) zs[t] = y;
          else { const size_t row = isc ? (size_t)NLAT + b * CTXL + t : (size_t)b * SEQ + t; mix[row * DM + 768 + c] = f2bf(y); }
        }
      }
    }
  }
}

namespace att {
constexpr int NW = 8, QBLK = 32, KVBLK = 64;
constexpr float SCALE = 0.10206207261596575f;
constexpr float THR = 8.f;
constexpr int SHM_V = KVBLK * 128 * 2, SHM_K = KVBLK * 128 * 2;
constexpr int SHM_ATTN = 2 * SHM_V + 2 * SHM_K + NW * 64 * 4;
#define KSWZ(row, colB) ((row) * 256 + ((colB) ^ (((row) & 7) << 4)))
#define SBAR() __builtin_amdgcn_sched_barrier(0)
template <int VAR> __device__ __forceinline__ float ex2(float x) { if constexpr (VAR == 2) return x; else return __builtin_amdgcn_exp2f(x); }
template <int VAR> __device__ __forceinline__ void partialSM(f32x16& p0, f32x16& p1, float& m_reg, float& mn, float& alpha) {
  constexpr float C = SCALE * 1.4426950408889634f;
  float pmax = p0[0];
#pragma unroll
  for (int r = 1; r < 16; ++r) pmax = fmaxf(pmax, p0[r]);
#pragma unroll
  for (int r = 0; r < 16; ++r) pmax = fmaxf(pmax, p1[r]);
  { auto rr = __builtin_amdgcn_permlane32_swap(__float_as_uint(pmax), __float_as_uint(pmax), false, false);
    pmax = fmaxf(__uint_as_float(rr[0]), __uint_as_float(rr[1])); }
  if (__builtin_expect(__all(pmax - m_reg <= THR / SCALE), 1)) { mn = m_reg; alpha = 1.f; }
  else { mn = fmaxf(m_reg, pmax); alpha = __builtin_amdgcn_exp2f((m_reg - mn) * C); m_reg = mn; }
  const float mnC = -mn * C;
#pragma unroll
  for (int r = 0; r < 16; ++r) p0[r] = fmaf(p0[r], C, mnC);
#pragma unroll
  for (int r = 0; r < 16; ++r) p1[r] = fmaf(p1[r], C, mnC);
#pragma unroll
  for (int r = 0; r < 16; ++r) p0[r] = ex2<VAR>(p0[r]);
}
template <int VAR> __device__ __forceinline__ void finishSM(f32x16& p0, f32x16& p1, float alpha, float& l_reg, bf16x8& pa0, bf16x8& pa1, bf16x8& pa2, bf16x8& pa3) {
#pragma unroll
  for (int r = 0; r < 16; ++r) p1[r] = ex2<VAR>(p1[r]);
  float ps = 0;
#pragma unroll
  for (int r = 0; r < 16; ++r) ps += p0[r];
#pragma unroll
  for (int r = 0; r < 16; ++r) ps += p1[r];
  { auto rr = __builtin_amdgcn_permlane32_swap(__float_as_uint(ps), __float_as_uint(ps), false, false);
    ps = __uint_as_float(rr[0]) + __uint_as_float(rr[1]); }
  l_reg = l_reg * alpha + ps;
#define PK4(P, BASE, OUT) do { unsigned a0 = cvtpk(P[BASE + 0], P[BASE + 1]), a1 = cvtpk(P[BASE + 2], P[BASE + 3]);   \
    unsigned b0 = cvtpk(P[BASE + 4], P[BASE + 5]), b1 = cvtpk(P[BASE + 6], P[BASE + 7]);                              \
    auto r0 = __builtin_amdgcn_permlane32_swap(a0, b0, false, false); auto r1 = __builtin_amdgcn_permlane32_swap(a1, b1, false, false); \
    u32x4 w = {r0[0], r1[0], r0[1], r1[1]}; OUT = *reinterpret_cast<bf16x8*>(&w); } while (0)
  PK4(p0, 0, pa0); PK4(p0, 8, pa1); PK4(p1, 0, pa2); PK4(p1, 8, pa3);
#undef PK4
}
__device__ __forceinline__ void qkt(f32x16& p0, f32x16& p1, const char* Ks, const bf16x8* qr, int r32, int hi) {
  p0 = f32x16{}; p1 = f32x16{};
#pragma unroll
  for (int d0 = 0; d0 < 6; ++d0) { const int cb = (d0 * 16 + hi * 8) * 2;
    const bf16x8 b0 = *reinterpret_cast<const bf16x8*>(Ks + KSWZ(r32, cb));
    const bf16x8 b1 = *reinterpret_cast<const bf16x8*>(Ks + KSWZ(32 + r32, cb));
    p0 = __builtin_amdgcn_mfma_f32_32x32x16_bf16(b0, qr[d0], p0, 0, 0, 0);
    p1 = __builtin_amdgcn_mfma_f32_32x32x16_bf16(b1, qr[d0], p1, 0, 0, 0); }
}
__device__ __forceinline__ int v_st(int k, int c) { const int kk = (k & ~0xC) | ((k & 4) << 1) | ((k & 8) >> 1); return ((kk >> 3) * 4 + (c >> 5)) * 512 + ((kk & 7) * 32 + (c & 31)) * 2; }
__device__ __forceinline__ int v_rd_base(int lane) { return ((lane & 3) << 3) | (((lane >> 2) & 3) << 6) | (((lane >> 4) & 1) << 5) | (((lane >> 5) & 1) << 8); }
constexpr int v_rd_off(int d0, int ks, int half) { return d0 * 512 + ks * 4096 + half * 2048; }
template <int OFF> __device__ __forceinline__ s16x4 tr_read(int vb) {
  s16x4 r; asm volatile("ds_read_b64_tr_b16 %0, %1 offset:%2" : "=&v"(r) : "v"(vb), "i"(OFF) : "memory"); return r;
}
template <int D0> __device__ __forceinline__ void pv_one(f32x16& od, int vb, bf16x8 pa0, bf16x8 pa1, bf16x8 pa2, bf16x8 pa3) {
  const s16x4 l0 = tr_read<v_rd_off(D0, 0, 0)>(vb), h0 = tr_read<v_rd_off(D0, 0, 1)>(vb), l1 = tr_read<v_rd_off(D0, 1, 0)>(vb), h1 = tr_read<v_rd_off(D0, 1, 1)>(vb);
  const s16x4 l2 = tr_read<v_rd_off(D0, 2, 0)>(vb), h2 = tr_read<v_rd_off(D0, 2, 1)>(vb), l3 = tr_read<v_rd_off(D0, 3, 0)>(vb), h3 = tr_read<v_rd_off(D0, 3, 1)>(vb);
  asm volatile("s_waitcnt lgkmcnt(0)" ::: "memory"); SBAR();
#define PK(L, H) (bf16x8){L[0], L[1], L[2], L[3], H[0], H[1], H[2], H[3]}
  od = __builtin_amdgcn_mfma_f32_32x32x16_bf16(pa0, PK(l0, h0), od, 0, 0, 0);
  od = __builtin_amdgcn_mfma_f32_32x32x16_bf16(pa1, PK(l1, h1), od, 0, 0, 0);
  od = __builtin_amdgcn_mfma_f32_32x32x16_bf16(pa2, PK(l2, h2), od, 0, 0, 0);
  od = __builtin_amdgcn_mfma_f32_32x32x16_bf16(pa3, PK(l3, h3), od, 0, 0, 0);
#undef PK
}
__device__ __forceinline__ void pv_d0(f32x16& o0, f32x16& o1, int vb, bf16x8 pa0, bf16x8 pa1, bf16x8 pa2, bf16x8 pa3) {
  pv_one<0>(o0, vb, pa0, pa1, pa2, pa3); pv_one<1>(o1, vb, pa0, pa1, pa2, pa3);
}
template <int VAR>
__device__ __forceinline__ void attn_body(const bf16_t* __restrict__ Qb, const bf16_t* __restrict__ KVh, const bf16_t* __restrict__ KR, int bsel, int key0,
                                          bf16_t* __restrict__ Ob, float* __restrict__ Op, float* __restrict__ Oml, int seq, char* lds) {
  const int tid = TIDX, wid = tid >> 6, lane = tid & 63, r32 = lane & 31, hi = lane >> 5;
  char* V_lds = lds; char* K_lds = lds + 2 * SHM_V;
  float* ws = (float*)(lds + 2 * SHM_V + 2 * SHM_K) + wid * 64; float* li_l = ws; float* al_l = ws + 32;
  float m_reg = -1e30f, l_reg = 0; f32x16 o0 = {}, o1 = {}; bf16x8 qr[6];
  const bf16_t* Qw = Qb + (size_t)(wid * QBLK + r32) * 576 + hi * 8;
#pragma unroll
  for (int d0 = 0; d0 < 6; ++d0) qr[d0] = *(const bf16x8*)(Qw + d0 * 16);
  const int sr = tid >> 4, sc = (tid & 15) * 8, vst0 = v_st(sr, sc & 63), vst1 = v_st(32 + sr, sc & 63);
  const int vb0 = (int)(uintptr_t)V_lds + v_rd_base(lane);
  const bool kact = sc < 96, vact = sc < 64;
  bf16x8 vs0 = {}, vs1 = {}, ks0 = {}, ks1 = {};
#define SLOAD(k0) do { const int kk_ = key0 + (k0); const size_t rb_ = (size_t)((kk_ < CTXL) ? NLAT + bsel * CTXL + kk_ : bsel * SEQ + kk_ - CTXL) + sr; \
    if (vact) { vs0 = *(const bf16x8*)(KVh + rb_ * 768 + 64 + sc); vs1 = *(const bf16x8*)(KVh + (rb_ + 32) * 768 + 64 + sc); } \
    if (kact) { if (sc < 64) { ks0 = *(const bf16x8*)(KVh + rb_ * 768 + sc); ks1 = *(const bf16x8*)(KVh + (rb_ + 32) * 768 + sc); } \
                else { ks0 = *(const bf16x8*)(KR + rb_ * 32 + (sc - 64)); ks1 = *(const bf16x8*)(KR + (rb_ + 32) * 32 + (sc - 64)); } } } while (0)
#define SWRITE(b) do { if (vact) { *(bf16x8*)(V_lds + (b) * SHM_V + vst0) = vs0; *(bf16x8*)(V_lds + (b) * SHM_V + vst1) = vs1; } \
    if (kact) { const int kc = sc * 2; *(bf16x8*)(K_lds + (b) * SHM_K + KSWZ(sr, kc)) = ks0; *(bf16x8*)(K_lds + (b) * SHM_K + KSWZ(32 + sr, kc)) = ks1; } } while (0)
#define SWAIT() asm volatile("s_waitcnt vmcnt(0)" ::: "memory")
#define RESC(a) do { if (__any((a) < 1.f)) { if (hi == 0) al_l[r32] = (a); asm volatile("s_waitcnt lgkmcnt(0)" ::: "memory"); \
    _Pragma("unroll") for (int r = 0; r < 16; ++r) { const float f = al_l[crow(r, hi)]; o0[r] *= f; o1[r] *= f; } } } while (0)
  f32x16 pA0, pA1, pB0, pB1; float mnA, mnB, alA, alB; bf16x8 pa0, pa1, pa2, pa3; const int NT = seq / KVBLK;
  __syncthreads();
  SLOAD(0); SWAIT(); SWRITE(0); __syncthreads();
  qkt(pA0, pA1, K_lds, qr, r32, hi); partialSM<VAR>(pA0, pA1, m_reg, mnA, alA);
  SLOAD(KVBLK);
  SWAIT(); SWRITE(1); __syncthreads();
#define LSYNC() do { if constexpr (VAR != 1) __syncthreads(); } while (0)
#define LLOAD(k0) do { if constexpr (VAR != 3) SLOAD(k0); } while (0)
#define LWRITE(b) do { if constexpr (VAR != 3) { SWAIT(); SWRITE(b); } } while (0)
#define LPV(O0, O1, VB) do { if constexpr (VAR != 5) pv_d0(O0, O1, VB, pa0, pa1, pa2, pa3); else { asm volatile("" :: "v"(pa0), "v"(pa1), "v"(pa2), "v"(pa3)); } } while (0)
  const int wodd = __builtin_amdgcn_readfirstlane(wid) & 1;
#define HALF_IT(PN0, PN1, MN, AN, PO0, PO1, AO, KB, VB) do { \
    if (!wodd) { qkt(PN0, PN1, KB, qr, r32, hi); finishSM<VAR>(PO0, PO1, AO, l_reg, pa0, pa1, pa2, pa3); SBAR(); LPV(o0, o1, VB); partialSM<VAR>(PN0, PN1, m_reg, MN, AN); } \
    else { finishSM<VAR>(PO0, PO1, AO, l_reg, pa0, pa1, pa2, pa3); SBAR(); qkt(PN0, PN1, KB, qr, r32, hi); SBAR(); partialSM<VAR>(PN0, PN1, m_reg, MN, AN); SBAR(); LPV(o0, o1, VB); } } while (0)
  for (int j = 1; j + 1 < NT; j += 2) {
    SBAR(); LLOAD((j + 1) * KVBLK); SBAR();
    HALF_IT(pB0, pB1, mnB, alB, pA0, pA1, alA, K_lds + SHM_K, vb0);
    LSYNC(); LWRITE(0);
    RESC(alB); LSYNC();
    SBAR(); LLOAD((j + 2) * KVBLK); SBAR();
    HALF_IT(pA0, pA1, mnA, alA, pB0, pB1, alB, K_lds, vb0 + SHM_V);
    LSYNC(); LWRITE(1);
    RESC(alA); LSYNC();
  }
#undef HALF_IT
#undef LSYNC
#undef LLOAD
#undef LWRITE
#undef LPV
  SBAR(); qkt(pB0, pB1, K_lds + SHM_K, qr, r32, hi);
  finishSM<VAR>(pA0, pA1, alA, l_reg, pa0, pa1, pa2, pa3); SBAR();
  pv_d0(o0, o1, vb0, pa0, pa1, pa2, pa3); partialSM<VAR>(pB0, pB1, m_reg, mnB, alB);
  __syncthreads(); RESC(alB);
  finishSM<VAR>(pB0, pB1, alB, l_reg, pa0, pa1, pa2, pa3); SBAR();
  pv_d0(o0, o1, vb0 + SHM_V, pa0, pa1, pa2, pa3);
  if (Op != nullptr) {
    float* Pw = Op + (size_t)(wid * QBLK) * 64;
#pragma unroll
    for (int r = 0; r < 16; ++r) { const int orow = crow(r, hi); Pw[(size_t)orow * 64 + r32] = o0[r]; Pw[(size_t)orow * 64 + 32 + r32] = o1[r]; }
    if (hi == 0) { Oml[(size_t)(wid * QBLK + r32) * 2] = m_reg; Oml[(size_t)(wid * QBLK + r32) * 2 + 1] = l_reg; }
  } else {
    if (hi == 0) li_l[r32] = l_reg; asm volatile("s_waitcnt lgkmcnt(0)" ::: "memory");
    bf16_t* Ow = Ob + (size_t)(wid * QBLK) * DM;
#pragma unroll
    for (int r = 0; r < 16; ++r) { const int orow = crow(r, hi); const float rl = __builtin_amdgcn_rcpf(li_l[orow]);
      Ow[(size_t)orow * DM + r32] = f2bf(o0[r] * rl); Ow[(size_t)orow * DM + 32 + r32] = f2bf(o1[r] * rl); }
  }
#undef SLOAD
#undef SWRITE
#undef SWAIT
#undef RESC
}
}

template <int VAR = 0, bool ATT_DUMMY = false>
__device__ __forceinline__ void attn_units(const Params& p, int layer, char* smem) {
  const bf16_t* Q = (const bf16_t*)(p.ws + OFF_Q);
  const bf16_t* KV = (const bf16_t*)(p.ws + OFF_K); const bf16_t* KR = (const bf16_t*)(p.ws + OFF_V);
  bf16_t* mix = (bf16_t*)(p.ws + OFF_MIX); float* opart = (float*)(p.ws + OFF_OPART); float* oml = (float*)(p.ws + OFF_OML);
  const int nunits = 512 + ((layer == 0) ? 12 : 0);
  for (int unit = BIDX; unit < nunits; unit += gridDim.x) {
    const bf16_t *qp, *kvp; bf16_t* ob; float* op = nullptr; float* ml = nullptr; int seq, bsel, key0 = 0;
    if (unit < 256) {
      const int bh = unit & 7, qb = unit >> 3, b = bh / 6, h = bh % 6;
      qp = Q + ((size_t)b * SEQ + qb * 256) * 576 + h * 96; kvp = KV + h * 128; bsel = b;
      ob = mix + ((size_t)b * SEQ + qb * 256) * DM + 384 + h * 64; seq = NKEYS;
    } else if (unit < 512) {
      const int v = unit - 256, bhi = v & 3, half = (v >> 2) & 1, qb = v >> 3, bh = 8 + bhi, b = bh / 6, h = bh % 6;
      qp = Q + ((size_t)b * SEQ + qb * 256) * 576 + h * 96; kvp = KV + h * 128; bsel = b; key0 = half * (NKEYS / 2);
      ob = mix; op = opart + ((size_t)(bhi * 2 + half) * SEQ + qb * 256) * 64; ml = oml + ((size_t)(bhi * 2 + half) * SEQ + qb * 256) * 2; seq = NKEYS / 2;
    } else {
      const int bh = unit - 512, b = bh / 6, h = bh % 6;
      qp = Q + ((size_t)NLAT + b * CTXL) * 576 + h * 96; kvp = KV + h * 128; bsel = b;
      ob = mix + ((size_t)NLAT + b * CTXL) * DM + 384 + h * 64; seq = CTXL;
    }
    if constexpr (VAR != 0 || ATT_DUMMY) {
      ob = (bf16_t*)(p.ws + OFF_HB) + (size_t)(unit & 63) * 256 * DM; if (op) { op = (float*)(p.ws + OFF_HB) + (size_t)(unit & 63) * 256 * 64; ml = op; }
    }
    att::attn_body<VAR>(qp, kvp, KR, bsel, key0, ob, op, ml, seq, smem);
  }
}
__device__ void attn_combine(const Params& p) {
  const int lane = TIDX & 63, wid = TIDX >> 6;
  const float* opart = (const float*)(p.ws + OFF_OPART); const float* oml = (const float*)(p.ws + OFF_OML); bf16_t* mix = (bf16_t*)(p.ws + OFF_MIX);
  constexpr float C = att::SCALE * 1.4426950408889634f;
  for (int grp = BIDX * 8 + wid; grp < 4 * SEQ / 4; grp += gridDim.x * 8) {
    const int idx0 = grp * 4, bhi = idx0 >> 13, q0 = idx0 & (SEQ - 1), bh = 8 + bhi, b = bh / 6, h = bh % 6;
    const size_t r0 = (size_t)(bhi * 2) * SEQ + q0, r1 = r0 + SEQ;
    float m0[4], l0[4], m1[4], l1[4], o0[4], o1[4];
#pragma unroll
    for (int j = 0; j < 4; ++j) {
      m0[j] = oml[(r0 + j) * 2]; l0[j] = oml[(r0 + j) * 2 + 1]; m1[j] = oml[(r1 + j) * 2]; l1[j] = oml[(r1 + j) * 2 + 1];
      o0[j] = opart[(r0 + j) * 64 + lane]; o1[j] = opart[(r1 + j) * 64 + lane];
    }
#pragma unroll
    for (int j = 0; j < 4; ++j) {
      const float m = fmaxf(m0[j], m1[j]), f0 = __builtin_amdgcn_exp2f((m0[j] - m) * C), f1 = __builtin_amdgcn_exp2f((m1[j] - m) * C);
      const float o = (o0[j] * f0 + o1[j] * f1) / (l0[j] * f0 + l1[j] * f1);
      mix[((size_t)b * SEQ + q0 + j) * DM + 384 + h * 64 + lane] = f2bf(o);
    }
  }
}

#define CEK(a, b) { const unsigned _h = max(k[a], k[b]), _l = min(k[a], k[b]); k[a] = _h; k[b] = _l; }
__device__ __forceinline__ void sort16k(unsigned* k) {
  CEK(0,1) CEK(2,3) CEK(0,2) CEK(1,3) CEK(1,2) CEK(4,5) CEK(6,7) CEK(4,6)
  CEK(5,7) CEK(5,6) CEK(0,4) CEK(2,6) CEK(2,4) CEK(1,5) CEK(3,7) CEK(3,5)
  CEK(1,2) CEK(3,4) CEK(5,6) CEK(8,9) CEK(10,11) CEK(8,10) CEK(9,11) CEK(9,10)
  CEK(12,13) CEK(14,15) CEK(12,14) CEK(13,15) CEK(13,14) CEK(8,12) CEK(10,14) CEK(10,12)
  CEK(9,13) CEK(11,15) CEK(11,13) CEK(9,10) CEK(11,12) CEK(13,14) CEK(0,8) CEK(4,12)
  CEK(4,8) CEK(2,10) CEK(6,14) CEK(6,10) CEK(2,4) CEK(6,8) CEK(10,12) CEK(1,9)
  CEK(5,13) CEK(5,9) CEK(3,11) CEK(7,15) CEK(7,11) CEK(3,5) CEK(7,9) CEK(11,13)
  CEK(1,2) CEK(3,4) CEK(5,6) CEK(7,8) CEK(9,10) CEK(11,12) CEK(13,14)
}
__device__ __forceinline__ void bmerge16k(unsigned* k) {
  CEK(0,8) CEK(1,9) CEK(2,10) CEK(3,11) CEK(4,12) CEK(5,13) CEK(6,14) CEK(7,15)
  CEK(0,4) CEK(1,5) CEK(2,6) CEK(3,7) CEK(8,12) CEK(9,13) CEK(10,14) CEK(11,15)
  CEK(0,2) CEK(1,3) CEK(4,6) CEK(5,7) CEK(8,10) CEK(9,11) CEK(12,14) CEK(13,15)
  CEK(0,1) CEK(2,3) CEK(4,5) CEK(6,7) CEK(8,9) CEK(10,11) CEK(12,13) CEK(14,15)
}
#undef CEK
#define CEP(a, b) { const bool _s = v[a] < v[b]; const float _va = _s ? v[b] : v[a], _vb = _s ? v[a] : v[b]; const int _pa = _s ? pl[b] : pl[a], _pb = _s ? pl[a] : pl[b]; \
                    v[a] = _va; v[b] = _vb; pl[a] = _pa; pl[b] = _pb; }
__device__ __forceinline__ void sort16p(float* v, int* pl) {
  CEP(0,1) CEP(2,3) CEP(0,2) CEP(1,3)
  CEP(1,2) CEP(4,5) CEP(6,7) CEP(4,6)
  CEP(5,7) CEP(5,6) CEP(0,4) CEP(2,6)
  CEP(2,4) CEP(1,5) CEP(3,7) CEP(3,5)
  CEP(1,2) CEP(3,4) CEP(5,6) CEP(8,9)
  CEP(10,11) CEP(8,10) CEP(9,11) CEP(9,10)
  CEP(12,13) CEP(14,15) CEP(12,14) CEP(13,15)
  CEP(13,14) CEP(8,12) CEP(10,14) CEP(10,12)
  CEP(9,13) CEP(11,15) CEP(11,13) CEP(9,10)
  CEP(11,12) CEP(13,14) CEP(0,8) CEP(4,12)
  CEP(4,8) CEP(2,10) CEP(6,14) CEP(6,10)
  CEP(2,4) CEP(6,8) CEP(10,12) CEP(1,9)
  CEP(5,13) CEP(5,9) CEP(3,11) CEP(7,15)
  CEP(7,11) CEP(3,5) CEP(7,9) CEP(11,13)
  CEP(1,2) CEP(3,4) CEP(5,6) CEP(7,8)
  CEP(9,10) CEP(11,12) CEP(13,14)
}
__device__ __forceinline__ void bmerge16p(float* v, int* pl) {
  CEP(0,8) CEP(1,9) CEP(2,10) CEP(3,11)
  CEP(4,12) CEP(5,13) CEP(6,14) CEP(7,15)
  CEP(0,4) CEP(1,5) CEP(2,6) CEP(3,7)
  CEP(8,12) CEP(9,13) CEP(10,14) CEP(11,15)
  CEP(0,2) CEP(1,3) CEP(4,6) CEP(5,7)
  CEP(8,10) CEP(9,11) CEP(12,14) CEP(13,15)
  CEP(0,1) CEP(2,3) CEP(4,5) CEP(6,7)
  CEP(8,9) CEP(10,11) CEP(12,13) CEP(14,15)
}
#undef CEP
__device__ __forceinline__ unsigned fkey(float f, int low7) { unsigned u = __float_as_uint(f); u ^= (unsigned)((int)u >> 31) | 0x80000000u; return (u & ~127u) | (unsigned)low7; }
__device__ __forceinline__ float funkey(unsigned k) { unsigned u = k & ~127u; u ^= (u & 0x80000000u) ? 0x80000000u : 0xFFFFFFFFu; return __uint_as_float(u); }
__device__ __forceinline__ void peer_half_top16(const char* __restrict__ kl  , int r32, const bf16_t* __restrict__ qp, int hi, unsigned* T) {
  bf16x8 bq[8]; int kofs[8];
#pragma unroll
  for (int ks = 0; ks < 8; ++ks) { bq[ks] = *(const bf16x8*)(qp + ks * 16); kofs[ks] = r32 * 256 + (((ks * 16 + hi * 8) * 2) ^ ((r32 & 7) << 4)); }
  unsigned L[16];
#pragma unroll
  for (int mt = 0; mt < 4; ++mt) {
    f32x16 acc = {};
#pragma unroll
    for (int ks = 0; ks < 8; ++ks) {
      const bf16x8 a = *(const bf16x8*)(kl + mt * 8192 + kofs[ks]);
      acc = __builtin_amdgcn_mfma_f32_32x32x16_bf16(a, bq[ks], acc, 0, 0, 0);
    }
    unsigned k[16];
#pragma unroll
    for (int r = 0; r < 16; ++r) k[r] = fkey(acc[r], 127 - (mt * 32 + (r & 3) + 8 * (r >> 2) + 4 * hi));
    sort16k(k);
    if (mt == 0) {
#pragma unroll
      for (int i = 0; i < 16; ++i) L[i] = k[i];
    } else {
#pragma unroll
      for (int i = 0; i < 16; ++i) L[i] = max(L[i], k[15 - i]);
      bmerge16k(L);
    }
  }
#pragma unroll
  for (int i = 0; i < 16; ++i) {
    const auto rr = __builtin_amdgcn_permlane32_swap(L[15 - i], L[15 - i], false, false);
    const unsigned partner = hi ? rr[0] : rr[1];
    T[i] = max(L[i], partner);
  }
  bmerge16k(T);
}
__device__ void peer_topk(const Params& p, int layer, int nrows, char* smem) {
  const int tid = TIDX, wid = tid >> 6, lane = tid & 63, r32 = lane & 31, hi = lane >> 5;
  const bf16_t* pq = (const bf16_t*)(p.ws + OFF_PQ);
  const bf16_t* keys = (const bf16_t*)(p.ws + OFF_KEYS) + (size_t)layer * 2 * 128 * 128;
  int* eid = (int*)(p.ws + OFF_EID); float* gate = (float*)(p.ws + OFF_GATE);
  __syncthreads();
  for (int i = tid; i < 4096; i += NTHREADS) {
    const int half = i >> 11, key = (i >> 4) & 127, c16 = i & 15;
    *(u32x4*)(smem + half * 32768 + KSWZ(key, c16 * 16)) = *(const u32x4*)(keys + (size_t)(half * 128 + key) * 128 + c16 * 8);
  }
  __syncthreads();
  const int ntask = (nrows / 32) * 8, gw = (int)gridDim.x * 8, nfull = ntask / gw, rem = ntask - nfull * gw;
  for (int it = 0; it <= nfull; ++it) {
    int task;
    if (it < nfull) task = it * gw + BIDX * 8 + wid;
    else { const int e = BIDX + (int)gridDim.x * wid; if (e >= rem) break; task = nfull * gw + e; }
    const int grp = task >> 3, h = task & 7;
    const size_t row = (size_t)grp * 32 + r32;
    unsigned K1[16], K2[16];
    const int lofs = launder_v(0);
    peer_half_top16(smem + lofs, r32, pq + row * 2048 + h * 256 + hi * 8, hi, K1);
    peer_half_top16(smem + lofs + 32768, r32, pq + row * 2048 + h * 256 + 128 + hi * 8, hi, K2);
    float v1[16], v2[16]; int i1[16], i2[16];
#pragma unroll
    for (int i = 0; i < 16; ++i) { v1[i] = funkey(K1[i]); v2[i] = funkey(K2[i]); i1[i] = 127 - (int)(K1[i] & 127u); i2[i] = 127 - (int)(K2[i] & 127u); }
    float ts[16]; int tp[16];
    {
      float* cv = ts; int* cp = tp;
    cv[0] = v1[0] + v2[0]; cp[0] = (i1[0] << 7) | i2[0];
    cv[1] = v1[0] + v2[1]; cp[1] = (i1[0] << 7) | i2[1];
    cv[2] = v1[0] + v2[2]; cp[2] = (i1[0] << 7) | i2[2];
    cv[3] = v1[0] + v2[3]; cp[3] = (i1[0] << 7) | i2[3];
    cv[4] = v1[0] + v2[4]; cp[4] = (i1[0] << 7) | i2[4];
    cv[5] = v1[0] + v2[5]; cp[5] = (i1[0] << 7) | i2[5];
    cv[6] = v1[0] + v2[6]; cp[6] = (i1[0] << 7) | i2[6];
    cv[7] = v1[0] + v2[7]; cp[7] = (i1[0] << 7) | i2[7];
    cv[8] = v1[0] + v2[8]; cp[8] = (i1[0] << 7) | i2[8];
    cv[9] = v1[0] + v2[9]; cp[9] = (i1[0] << 7) | i2[9];
    cv[10] = v1[0] + v2[10]; cp[10] = (i1[0] << 7) | i2[10];
    cv[11] = v1[0] + v2[11]; cp[11] = (i1[0] << 7) | i2[11];
    cv[12] = v1[0] + v2[12]; cp[12] = (i1[0] << 7) | i2[12];
    cv[13] = v1[0] + v2[13]; cp[13] = (i1[0] << 7) | i2[13];
    cv[14] = v1[0] + v2[14]; cp[14] = (i1[0] << 7) | i2[14];
    cv[15] = v1[0] + v2[15]; cp[15] = (i1[0] << 7) | i2[15];
      sort16p(ts, tp);
    }
#pragma unroll 1
    for (int g = 1; g < 3; ++g) {
      float cv[16]; int cp[16];
      if (g == 1) {
    cv[0] = v1[1] + v2[0]; cp[0] = (i1[1] << 7) | i2[0];
    cv[1] = v1[1] + v2[1]; cp[1] = (i1[1] << 7) | i2[1];
    cv[2] = v1[1] + v2[2]; cp[2] = (i1[1] << 7) | i2[2];
    cv[3] = v1[1] + v2[3]; cp[3] = (i1[1] << 7) | i2[3];
    cv[4] = v1[1] + v2[4]; cp[4] = (i1[1] << 7) | i2[4];
    cv[5] = v1[1] + v2[5]; cp[5] = (i1[1] << 7) | i2[5];
    cv[6] = v1[1] + v2[6]; cp[6] = (i1[1] << 7) | i2[6];
    cv[7] = v1[1] + v2[7]; cp[7] = (i1[1] << 7) | i2[7];
    cv[8] = v1[2] + v2[0]; cp[8] = (i1[2] << 7) | i2[0];
    cv[9] = v1[2] + v2[1]; cp[9] = (i1[2] << 7) | i2[1];
    cv[10] = v1[2] + v2[2]; cp[10] = (i1[2] << 7) | i2[2];
    cv[11] = v1[2] + v2[3]; cp[11] = (i1[2] << 7) | i2[3];
    cv[12] = v1[2] + v2[4]; cp[12] = (i1[2] << 7) | i2[4];
    cv[13] = v1[3] + v2[0]; cp[13] = (i1[3] << 7) | i2[0];
    cv[14] = v1[3] + v2[1]; cp[14] = (i1[3] << 7) | i2[1];
    cv[15] = v1[3] + v2[2]; cp[15] = (i1[3] << 7) | i2[2];
      } else {
    cv[0] = v1[3] + v2[3]; cp[0] = (i1[3] << 7) | i2[3];
    cv[1] = v1[4] + v2[0]; cp[1] = (i1[4] << 7) | i2[0];
    cv[2] = v1[4] + v2[1]; cp[2] = (i1[4] << 7) | i2[1];
    cv[3] = v1[4] + v2[2]; cp[3] = (i1[4] << 7) | i2[2];
    cv[4] = v1[5] + v2[0]; cp[4] = (i1[5] << 7) | i2[0];
    cv[5] = v1[5] + v2[1]; cp[5] = (i1[5] << 7) | i2[1];
    cv[6] = v1[6] + v2[0]; cp[6] = (i1[6] << 7) | i2[0];
    cv[7] = v1[6] + v2[1]; cp[7] = (i1[6] << 7) | i2[1];
    cv[8] = v1[7] + v2[0]; cp[8] = (i1[7] << 7) | i2[0];
    cv[9] = v1[7] + v2[1]; cp[9] = (i1[7] << 7) | i2[1];
    cv[10] = v1[8] + v2[0]; cp[10] = (i1[8] << 7) | i2[0];
    cv[11] = v1[9] + v2[0]; cp[11] = (i1[9] << 7) | i2[0];
    cv[12] = v1[10] + v2[0]; cp[12] = (i1[10] << 7) | i2[0];
    cv[13] = v1[11] + v2[0]; cp[13] = (i1[11] << 7) | i2[0];
    cv[14] = v1[12] + v2[0]; cp[14] = (i1[12] << 7) | i2[0];
    cv[15] = v1[13] + v2[0]; cp[15] = (i1[13] << 7) | i2[0];
      }
      sort16p(cv, cp);
#pragma unroll
      for (int i = 0; i < 16; ++i) if (cv[15 - i] > ts[i]) { ts[i] = cv[15 - i]; tp[i] = cp[15 - i]; }
      bmerge16p(ts, tp);
    }
    {
      float cv[2]; int cp[2];
    cv[0] = v1[14] + v2[0]; cp[0] = (i1[14] << 7) | i2[0];
    cv[1] = v1[15] + v2[0]; cp[1] = (i1[15] << 7) | i2[0];
      if (cv[0] < cv[1]) { const float tv = cv[0]; cv[0] = cv[1]; cv[1] = tv; const int ti = cp[0]; cp[0] = cp[1]; cp[1] = ti; }
      if (cv[1] > ts[14]) { ts[14] = cv[1]; tp[14] = cp[1]; }
      if (cv[0] > ts[15]) { ts[15] = cv[0]; tp[15] = cp[0]; }
      bmerge16p(ts, tp);
    }
    float ex[16], sm = 0.f;
#pragma unroll
    for (int i = 0; i < 16; ++i) { ex[i] = __expf(ts[i] - ts[0]); sm += ex[i]; }
    const float rs = 1.f / sm;
    if (hi == 0) {
      int* eo = eid + row * 128 + h * 16;
#pragma unroll
      for (int i = 0; i < 4; ++i) { const u32x4 o = {(unsigned)tp[4 * i], (unsigned)tp[4 * i + 1], (unsigned)tp[4 * i + 2], (unsigned)tp[4 * i + 3]}; *(u32x4*)(eo + 4 * i) = o; }
    } else {
      float* go = gate + row * 128 + h * 16;
#pragma unroll
      for (int i = 0; i < 4; ++i) { const f32x4 o = {ex[4 * i] * rs, ex[4 * i + 1] * rs, ex[4 * i + 2] * rs, ex[4 * i + 3] * rs}; *(f32x4*)(go + 4 * i) = o; }
    }
  }
}

constexpr float PEER_USCALE = 16.f;
__device__ void peer_cvt_tables(const Params& p, int layer, int rank, int nb) {
  const float* ut = p.in[I_PU] + (size_t)layer * 16384 * DM; const float* vt = p.in[I_PV] + (size_t)layer * 16384 * DM;
  u32x4* uo = (u32x4*)(p.ws + OFF_UTAB); u32x4* vo = (u32x4*)(p.ws + OFF_VTAB);
  const int n16 = 16384 * DM / 16, stride = nb * NTHREADS;
  for (int i = rank * NTHREADS + TIDX; i < 2 * n16; i += 2 * stride) {
    f32x4 a[2][4];
#pragma unroll
    for (int k = 0; k < 2; ++k) {
      const int ii = i + k * stride;
      if (ii < 2 * n16) {
        const bool isv = ii >= n16; const int j = isv ? ii - n16 : ii;
        const float* s = (isv ? vt : ut) + (size_t)j * 16;
#pragma unroll
        for (int q = 0; q < 4; ++q) a[k][q] = *(const f32x4*)(s + 4 * q);
      }
    }
#pragma unroll
    for (int k = 0; k < 2; ++k) {
      const int ii = i + k * stride;
      if (ii < 2 * n16) {
        const bool isv = ii >= n16; const int j = isv ? ii - n16 : ii; const float sc = isv ? 1.f : PEER_USCALE;
        u32x4 o;
#pragma unroll
        for (int q = 0; q < 4; ++q) {
          int w = __builtin_amdgcn_cvt_pk_fp8_f32(a[k][q][0] * sc, a[k][q][1] * sc, 0, false);
          w = __builtin_amdgcn_cvt_pk_fp8_f32(a[k][q][2] * sc, a[k][q][3] * sc, w, true);
          o[q] = (unsigned)w;
        }
        (isv ? vo : uo)[j] = o;
      }
    }
  }
}

__device__ __forceinline__ int xcc_slice() { return (int)((unsigned)__builtin_amdgcn_s_getreg((3 << 11) | 20) & 7u); }
__device__ __forceinline__ float row16_sum(float v) { v += dpp_mov<0xB1>(v); v += dpp_mov<0x4E>(v); v += dpp_mov<0x141>(v); v += dpp_mov<0x128>(v); return v; }
constexpr int PNS = 8;
constexpr int PSEGL = 8;
constexpr int PEPL = 64 / PSEGL;
constexpr int PNI = 128 / PEPL;
constexpr int PCOLS = 1024 / PNS;
using f32x2 = __attribute__((ext_vector_type(2))) float;
template <int PHASE>
__device__ void peer_sliced(const Params& p, int layer, int nrows) {
#if defined(PROBE_PEER_REP)
  int nrep = (PHASE == PROBE_PEER_REP) ? 2 : 1; asm volatile("" : "+s"(nrep));
#else
  constexpr int nrep = 1;
#endif
  for (int rep = 0; rep < nrep; ++rep) {
  const int dry = (rep + 1 < nrep) ? 1 : 0;
  const int lane = TIDX & 63, eg = lane / PSEGL, ch = lane % PSEGL;
  const bf16_t* hb = (const bf16_t*)(p.ws + OFF_HB);
  const int* eid = (const int*)(p.ws + OFF_EID);
  const unsigned char* tab = (const unsigned char*)(p.ws + (PHASE == 0 ? OFF_UTAB : OFF_VTAB)) + ch * 16;
  float* sp = (float*)(p.ws + OFF_SP); const float* wbuf = (const float*)(p.ws + OFF_WBUF);
  float* xs = (float*)(p.ws + OFF_XS);
  unsigned* ctr = (unsigned*)(p.ws + OFF_CTR) + (size_t)(((rep * 2 + layer) * 2 + PHASE) * 16) * 64;
  const int x0 = xcc_slice();
  const int bpa = eg << 2;
  for (int si = 0; si < PNS; ++si) {
    const int slice = (x0 + si) % PNS;
    int nbase = 0;
    if (lane == 0) nbase = (int)__hip_atomic_fetch_add(&ctr[slice * 64], 4u, __ATOMIC_RELAXED, __HIP_MEMORY_SCOPE_AGENT);
    for (;;) {
      const int base = __builtin_amdgcn_readfirstlane(nbase);
      if (base >= nrows) break;
      if (lane == 0) nbase = (int)__hip_atomic_fetch_add(&ctr[slice * 64], 4u, __ATOMIC_RELAXED, __HIP_MEMORY_SCOPE_AGENT);
      int eA = eid[(size_t)base * 128 + lane], eB = eid[(size_t)base * 128 + 64 + lane];
      float wA = 0.f, wB = 0.f;
      if (PHASE == 1) { wA = wbuf[(size_t)base * 128 + lane]; wB = wbuf[(size_t)base * 128 + 64 + lane]; }
#pragma unroll 1
      for (int tt = 0; tt < 4; ++tt) {
        const int r = base + tt;
        const int ceA = eA, ceB = eB; const float cwA = wA, cwB = wB;
        if (tt < 3) {
          eA = eid[(size_t)(r + 1) * 128 + lane]; eB = eid[(size_t)(r + 1) * 128 + 64 + lane];
          if (PHASE == 1) { wA = wbuf[(size_t)(r + 1) * 128 + lane]; wB = wbuf[(size_t)(r + 1) * 128 + 64 + lane]; }
        }
        int ev[PNI];
#pragma unroll
        for (int i = 0; i < PNI; ++i) ev[i] = __builtin_amdgcn_ds_bpermute(bpa + 32 * (i & 7), (i < 8) ? ceA : ceB);
        if (PHASE == 0) {
          float xv[16];
          {
            const u32x4 xa = *(const u32x4*)(hb + (size_t)r * DM + slice * PCOLS + ch * 16), xb = *(const u32x4*)(hb + (size_t)r * DM + slice * PCOLS + ch * 16 + 8);
#pragma unroll
            for (int q = 0; q < 4; ++q) { xv[2 * q] = __uint_as_float(xa[q] << 16); xv[2 * q + 1] = __uint_as_float(xa[q] & 0xffff0000u);
                                          xv[8 + 2 * q] = __uint_as_float(xb[q] << 16); xv[8 + 2 * q + 1] = __uint_as_float(xb[q] & 0xffff0000u); }
          }
          u32x4 uv[PNI];
#pragma unroll
          for (int j = 0; j < PNI; ++j) uv[j] = *(const u32x4*)(tab + (size_t)ev[j] * DM + slice * PCOLS);
          float keep0 = 0.f, keep1 = 0.f;
#pragma unroll
          for (int j = 0; j < PNI; ++j) {
            float d = 0.f;
#pragma unroll
            for (int q = 0; q < 4; ++q) {
              const f32x2 lo = __builtin_amdgcn_cvt_pk_f32_fp8((int)uv[j][q], false), hi2 = __builtin_amdgcn_cvt_pk_f32_fp8((int)uv[j][q], true);
              d += lo[0] * xv[4 * q] + lo[1] * xv[4 * q + 1] + hi2[0] * xv[4 * q + 2] + hi2[1] * xv[4 * q + 3];
            }
            d += dpp_mov<0xB1>(d); d += dpp_mov<0x4E>(d); d += dpp_mov<0x141>(d);
            if (ch == (j % PSEGL)) { if (j < PSEGL) keep0 = d; else keep1 = d; }
          }
          float* so = sp + ((size_t)slice * NTOK + r) * 128 + PEPL * ch + eg;
          so[0] = keep0 * (1.f / PEER_USCALE); so[64] = keep1 * (1.f / PEER_USCALE);
        } else {
          u32x4 vv[PNI];
#pragma unroll
          for (int j = 0; j < PNI; ++j) vv[j] = *(const u32x4*)(tab + (size_t)ev[j] * DM + slice * PCOLS);
          float acc[16];
#pragma unroll
          for (int j = 0; j < 16; ++j) acc[j] = 0.f;
#pragma unroll
          for (int j = 0; j < PNI; ++j) {
            const float w = __int_as_float(__builtin_amdgcn_ds_bpermute(bpa + 32 * (j & 7), __float_as_int((j < 8) ? cwA : cwB)));
#pragma unroll
            for (int q = 0; q < 4; ++q) {
              const f32x2 lo = __builtin_amdgcn_cvt_pk_f32_fp8((int)vv[j][q], false), hi2 = __builtin_amdgcn_cvt_pk_f32_fp8((int)vv[j][q], true);
              acc[4 * q] += w * lo[0]; acc[4 * q + 1] += w * lo[1]; acc[4 * q + 2] += w * hi2[0]; acc[4 * q + 3] += w * hi2[1];
            }
          }
#pragma unroll
          for (int j = 0; j < 16; ++j) {
            acc[j] += dpp_mov<0x128>(acc[j]);
            { auto rr = __builtin_amdgcn_permlane16_swap(__float_as_uint(acc[j]), __float_as_uint(acc[j]), false, false); acc[j] = __uint_as_float(rr[0]) + __uint_as_float(rr[1]); }
            { auto rr = __builtin_amdgcn_permlane32_swap(__float_as_uint(acc[j]), __float_as_uint(acc[j]), false, false); acc[j] = __uint_as_float(rr[0]) + __uint_as_float(rr[1]); }
          }
          if (eg == 0) {
            int b, t, isc; row_info(r, b, t, isc);
            const float* g2 = (const float*)(p.ws + OFF_MOD) + ((size_t)layer * 3 + (isc ? 2 : b)) * 6144 + 5120 + slice * PCOLS + ch * 16;
            float* xr = xs + (size_t)r * DM + slice * PCOLS + ch * 16;
#pragma unroll
            for (int q = 0; q < 4; ++q) {
              f32x4 xq = *(const f32x4*)(xr + 4 * q);
#pragma unroll
              for (int j = 0; j < 4; ++j) xq[j] += g2[4 * q + j] * acc[4 * q + j];
              if (dry == 0) *(f32x4*)(xr + 4 * q) = xq;
            }
          }
        }
      }
    }
  }
  }
}
__device__ void peer_weights(const Params& p, int nrows) {
  const float* sp = (const float*)(p.ws + OFF_SP); const float* gate = (const float*)(p.ws + OFF_GATE); float* wbuf = (float*)(p.ws + OFF_WBUF);
  for (int i = BIDX * NTHREADS + TIDX; i < nrows * 128; i += gridDim.x * NTHREADS) {
    float s = 0.f;
#pragma unroll
    for (int x = 0; x < PNS; ++x) s += sp[(size_t)x * NTOK * 128 + i];
    wbuf[i] = gate[i] * gelu_tanh(s);
  }
}

__device__ void peer_eval_fused(const Params& p, int layer, int nrows, char* smem) {
  const int tid = TIDX, wid = tid >> 6, lane = tid & 63, eg = lane >> 3, ch = lane & 7;
  const int ntb = nrows / (int)gridDim.x, tok0 = BIDX * ntb;
  float* S = (float*)smem;
  int* E = (int*)(smem + 72 * 128 * 4);
  const bf16_t* hb = (const bf16_t*)(p.ws + OFF_HB);
  const int* eid = (const int*)(p.ws + OFF_EID); const float* gate = (const float*)(p.ws + OFF_GATE);
  const unsigned char* utab = (const unsigned char*)(p.ws + OFF_UTAB) + ch * 16; const unsigned char* vtab = (const unsigned char*)(p.ws + OFF_VTAB) + ch * 16;
  float* xs = (float*)(p.ws + OFF_XS);
  __syncthreads();
  for (int i = tid; i < ntb * 128; i += NTHREADS) { S[i] = 0.f; E[i] = eid[(size_t)tok0 * 128 + i]; }
  __syncthreads();
#pragma unroll 1
  for (int it = wid; it < ntb * 8; it += 8) {
    const int slice = it / ntb, tl = it - slice * ntb, r = tok0 + tl;
    int ev[16];
#pragma unroll
    for (int j = 0; j < 16; ++j) ev[j] = E[tl * 128 + 8 * j + eg];
    float xv[16];
    {
      const u32x4 xa = *(const u32x4*)(hb + (size_t)r * DM + slice * 128 + ch * 16), xb = *(const u32x4*)(hb + (size_t)r * DM + slice * 128 + ch * 16 + 8);
#pragma unroll
      for (int q = 0; q < 4; ++q) { xv[2 * q] = __uint_as_float(xa[q] << 16); xv[2 * q + 1] = __uint_as_float(xa[q] & 0xffff0000u);
                                    xv[8 + 2 * q] = __uint_as_float(xb[q] << 16); xv[8 + 2 * q + 1] = __uint_as_float(xb[q] & 0xffff0000u); }
    }
    u32x4 uv[16];
#pragma unroll
    for (int j = 0; j < 16; ++j) uv[j] = *(const u32x4*)(utab + (size_t)ev[j] * DM + slice * 128);
    float keep0 = 0.f, keep1 = 0.f;
#pragma unroll
    for (int j = 0; j < 16; ++j) {
      float d = 0.f;
#pragma unroll
      for (int q = 0; q < 4; ++q) {
        const f32x2 lo = __builtin_amdgcn_cvt_pk_f32_fp8((int)uv[j][q], false), hi2 = __builtin_amdgcn_cvt_pk_f32_fp8((int)uv[j][q], true);
        d += lo[0] * xv[4 * q] + lo[1] * xv[4 * q + 1] + hi2[0] * xv[4 * q + 2] + hi2[1] * xv[4 * q + 3];
      }
      d += dpp_mov<0xB1>(d); d += dpp_mov<0x4E>(d); d += dpp_mov<0x141>(d);
      if (ch == (j & 7)) { if (j < 8) keep0 = d; else keep1 = d; }
    }
    atomicAdd(&S[tl * 128 + 8 * ch + eg], keep0); atomicAdd(&S[tl * 128 + 64 + 8 * ch + eg], keep1);
  }
  __syncthreads();
  for (int i = tid; i < ntb * 128; i += NTHREADS) S[i] = gate[(size_t)tok0 * 128 + i] * gelu_tanh(S[i] * (1.f / PEER_USCALE));
  __syncthreads();
#pragma unroll 1
  for (int it = wid; it < ntb * 8; it += 8) {
    const int slice = it / ntb, tl = it - slice * ntb, r = tok0 + tl;
    int ev[16]; float wv[16];
#pragma unroll
    for (int j = 0; j < 16; ++j) { ev[j] = E[tl * 128 + 8 * j + eg]; wv[j] = S[tl * 128 + 8 * j + eg]; }
    u32x4 vv[16];
#pragma unroll
    for (int j = 0; j < 16; ++j) vv[j] = *(const u32x4*)(vtab + (size_t)ev[j] * DM + slice * 128);
    float acc[16];
#pragma unroll
    for (int j = 0; j < 16; ++j) acc[j] = 0.f;
#pragma unroll
    for (int j = 0; j < 16; ++j) {
      const float w = wv[j];
#pragma unroll
      for (int q = 0; q < 4; ++q) {
        const f32x2 lo = __builtin_amdgcn_cvt_pk_f32_fp8((int)vv[j][q], false), hi2 = __builtin_amdgcn_cvt_pk_f32_fp8((int)vv[j][q], true);
        acc[4 * q] += w * lo[0]; acc[4 * q + 1] += w * lo[1]; acc[4 * q + 2] += w * hi2[0]; acc[4 * q + 3] += w * hi2[1];
      }
    }
#pragma unroll
    for (int j = 0; j < 16; ++j) {
      acc[j] += dpp_mov<0x128>(acc[j]);
      { auto rr = __builtin_amdgcn_permlane16_swap(__float_as_uint(acc[j]), __float_as_uint(acc[j]), false, false); acc[j] = __uint_as_float(rr[0]) + __uint_as_float(rr[1]); }
      { auto rr = __builtin_amdgcn_permlane32_swap(__float_as_uint(acc[j]), __float_as_uint(acc[j]), false, false); acc[j] = __uint_as_float(rr[0]) + __uint_as_float(rr[1]); }
    }
    if (eg == 0) {
      int b, t, isc; row_info(r, b, t, isc);
      const float* g2 = (const float*)(p.ws + OFF_MOD) + ((size_t)layer * 3 + (isc ? 2 : b)) * 6144 + 5120 + slice * 128 + ch * 16;
      float* xr = xs + (size_t)r * DM + slice * 128 + ch * 16;
#pragma unroll
      for (int q = 0; q < 4; ++q) {
        f32x4 xq = *(const f32x4*)(xr + 4 * q);
#pragma unroll
        for (int j = 0; j < 4; ++j) xq[j] += g2[4 * q + j] * acc[4 * q + j];
        *(f32x4*)(xr + 4 * q) = xq;
      }
    }
  }
  __syncthreads();
  {
    const bool last = (layer == 1);
    const float* g = last ? p.in[I_FG] : p.in[I_N1G] + (layer + 1) * DM;
    bf16_t* hbw = (bf16_t*)(p.ws + OFF_HB);
#pragma unroll 1
    for (int tl0 = wid * 3; tl0 < ntb; tl0 += 24) {
      f32x4 v[3][4]; float ss[3]; const float* modj[3];
#pragma unroll
      for (int j = 0; j < 3; ++j) {
        int b, t, isc; row_info(min(tok0 + tl0 + j, tok0 + ntb - 1), b, t, isc);
        modj[j] = (const float*)(p.ws + OFF_MOD) + ((size_t)(last ? 1 : layer + 1) * 3 + (isc ? 2 : b)) * 6144;
      }
#pragma unroll
      for (int j = 0; j < 3; ++j) {
        const int r = min(tok0 + tl0 + j, tok0 + ntb - 1);
        ss[j] = 0.f;
#pragma unroll
        for (int i = 0; i < 4; ++i) { v[j][i] = *(const f32x4*)(xs + (size_t)r * DM + (i * 64 + lane) * 4); ss[j] += v[j][i][0] * v[j][i][0] + v[j][i][1] * v[j][i][1] + v[j][i][2] * v[j][i][2] + v[j][i][3] * v[j][i][3]; }
      }
#pragma unroll
      for (int j = 0; j < 3; ++j) ss[j] = rsqrtf(wave_sum(ss[j]) * (1.f / DM) + EPSV);
#pragma unroll
      for (int i = 0; i < 4; ++i) {
        const int c0 = (i * 64 + lane) * 4; const f32x4 gv = *(const f32x4*)(g + c0);
#pragma unroll
        for (int j = 0; j < 3; ++j) {
          const int r = tok0 + tl0 + j;
          if (tl0 + j < ntb) {
            if (last) { if (r < NLAT) *(f32x4*)(p.out + (size_t)r * DM + c0) = v[j][i] * ss[j] * gv; }
            else {
              const f32x4 sc = *(const f32x4*)(modj[j] + 1024 + c0), sh = *(const f32x4*)(modj[j] + c0);
              float y[4];
#pragma unroll
              for (int q = 0; q < 4; ++q) y[q] = v[j][i][q] * ss[j] * gv[q] * (1.f + sc[q]) + sh[q];
              const u32x2 o = {cvtpk(y[0], y[1]), cvtpk(y[2], y[3])};
              *(u32x2*)(hbw + (size_t)r * DM + c0) = o;
            }
          }
        }
      }
    }
  }
}

__device__ void final_norm(const Params& p) {
  const int lane = TIDX & 63, wid = TIDX >> 6;
  const float* xs = (const float*)(p.ws + OFF_XS); const float* g = p.in[I_FG];
  for (int grp = BIDX * 8 + wid; grp < NLAT / 4; grp += gridDim.x * 8) {
    const int r0 = grp * 4;
    f32x4 v[4][4]; float ss[4];
#pragma unroll
    for (int j = 0; j < 4; ++j) {
      ss[j] = 0.f;
#pragma unroll
      for (int i = 0; i < 4; ++i) { v[j][i] = *(const f32x4*)(xs + (size_t)(r0 + j) * DM + (i * 64 + lane) * 4); ss[j] += v[j][i][0] * v[j][i][0] + v[j][i][1] * v[j][i][1] + v[j][i][2] * v[j][i][2] + v[j][i][3] * v[j][i][3]; }
    }
#pragma unroll
    for (int j = 0; j < 4; ++j) ss[j] = rsqrtf(wave_sum(ss[j]) * (1.f / DM) + EPSV);
#pragma unroll
    for (int i = 0; i < 4; ++i) {
      const int c0 = (i * 64 + lane) * 4; const f32x4 gv = *(const f32x4*)(g + c0);
#pragma unroll
      for (int j = 0; j < 4; ++j) { const f32x4 o = v[j][i] * ss[j] * gv; *(f32x4*)(p.out + (size_t)(r0 + j) * DM + c0) = o; }
    }
  }
}

namespace pg8 {
#define PG8_LAS __attribute__((address_space(3)))
typedef unsigned short bf16_t;
typedef short bf16x8 __attribute__((ext_vector_type(8)));
typedef float f32x4 __attribute__((ext_vector_type(4)));
typedef unsigned u32x4 __attribute__((ext_vector_type(4)));
constexpr int BM = 256, BK = 64, HALF = 128, HTB = HALF * BK * 2  , STAGE_BYTES = 8 * HTB, NXCD = 8, WGM = 8;

__host__ __device__ __forceinline__ int lds_byte(int r, int c) { const int st = (r >> 4) * 2 + (c >> 5), rr = r & 15, cc = c & 31, ob = rr * 64 + cc * 2; return st * 1024 + (ob ^ (((ob >> 9) & 1) << 5)); }
__host__ __device__ __forceinline__ void stage_rc(int b, int& R, int& C) { const int st = b / 1024, sb = b % 1024, swz = sb ^ (((sb >> 9) & 1) << 5); R = (st >> 1) * 16 + swz / 64; C = (st & 1) * 32 + (swz % 64) / 2; }
__host__ __device__ __forceinline__ int perm32(int rho) { const int n = rho >> 4, i = rho & 15; return 8 * (i >> 2) + 4 * n + (i & 3); }

struct Unit { int pm, pn; };
struct Gemm { const bf16_t* A; const bf16_t* Bt; int M, N, K; };

struct StaticOrder {
    int nM, nN, nwg, G, c;
    __host__ __device__ void init(int M, int N, int G_, int c_) { nM = M / BM; nN = N / BM; nwg = nM * nN; G = G_; c = c_; }
    __host__ __device__ bool next(int i, Unit& u) const {
        const long L = (long)i * G + c; if (L >= nwg) return false;
        int wgid = (int)L; { const int q = nwg / NXCD, r = nwg % NXCD, xcd = wgid % NXCD, off = wgid / NXCD; wgid = (xcd < r ? xcd * (q + 1) : r * (q + 1) + (xcd - r) * q) + off; }
        const int nig = WGM * nN, gid = wgid / nig, fm = gid * WGM, gsz = (nM - fm) < WGM ? (nM - fm) : WGM;
        u.pm = fm + ((wgid % nig) % gsz); u.pn = (wgid % nig) / gsz; return true;
    }
    __device__ __forceinline__ void a_ready(const Unit&) const {}
    __device__ __forceinline__ void done(const Unit&) const {}
};
template <class Epi, class Sched, bool STAMP = false>
__device__ __forceinline__ void gemm_phase(PG8_LAS unsigned char* lds, const Gemm g, const Sched& S, const Epi& E, unsigned long long* stamps) {
    const int tid = launder_v((int)threadIdx.x)  , wid = __builtin_amdgcn_readfirstlane(tid >> 6), lane = tid & 63, wr = wid >> 2, wc = wid & 3, fr = lane & 15, fq = lane >> 4;
    const int K = g.K, nt = K / BK;
    int ts_lo = 0, ts_hi = 0, nts = 0; const unsigned long long rt_entry = STAMP ? 0ull : 0ull;
#define PG8_STAMP() do { if (STAMP && wid == 0 && nts < 64) { const unsigned long long _c = 0ull; \
        ts_lo = (lane == nts) ? (int)(unsigned)_c : ts_lo; ts_hi = (lane == nts) ? (int)(unsigned)(_c >> 32) : ts_hi; ++nts; } } while (0)
    PG8_STAMP();
    unsigned voffA[2], voffB[2];
#pragma unroll
    for (int i = 0; i < 2; ++i) { int R, C; stage_rc(tid * 16 + i * 8192, R, C); const int Rb = Epi::PERM ? ((R & ~31) + perm32(R & 31)) : R;
        voffA[i] = (unsigned)(R * K + C) * 2u; voffB[i] = (unsigned)(Rb * K + C) * 2u; }
    const size_t kstep = (size_t)(BK * 2);
    const size_t hstep = (size_t)HALF * K * 2;
    const size_t tstep = 2 * hstep;
    const unsigned ldsw = (unsigned)wid * 1024u;
    const int aoff = lds_byte(wr * 64 + fr, fq * 8), boff = launder_v(lds_byte(wc * 32 + fr, fq * 8) + 4 * HTB);
#define PG8_SA(b, h) (((b) * 2 + (h)) * HTB)
#define PG8_SB(b, h) ((4 + (b) * 2 + (h)) * HTB)
#define PG8_STAGE(bufoff, gbase, voff) do { _Pragma("unroll") for (int _i = 0; _i < 2; ++_i) \
        __builtin_amdgcn_global_load_lds((const unsigned*)((const char*)(gbase) + (voff)[_i]), (PG8_LAS unsigned*)(lds + (bufoff) + ldsw + _i * 8192), 16, 0, 0); } while (0)
#define PG8_LDA(dst, b, h) do { _Pragma("unroll") for (int m = 0; m < 4; ++m) _Pragma("unroll") for (int k = 0; k < 2; ++k) dst[m][k] = *(const PG8_LAS bf16x8*)(lds + PG8_SA(b, h) + aoff + m * 2048 + k * 1024); } while (0)
#define PG8_LDB(dst, b, h) do { _Pragma("unroll") for (int n = 0; n < 2; ++n) _Pragma("unroll") for (int k = 0; k < 2; ++k) dst[n][k] = *(const PG8_LAS bf16x8*)(lds + boff + ((b) * 2 + (h)) * HTB + n * 2048 + k * 1024); } while (0)
#define PG8_MMA(ai, bj, At, Bt) do { __builtin_amdgcn_s_setprio(1); _Pragma("unroll") for (int m = 0; m < 4; ++m) _Pragma("unroll") for (int n = 0; n < 2; ++n) _Pragma("unroll") for (int k = 0; k < 2; ++k) \
        acc[ai][bj][m][n] = __builtin_amdgcn_mfma_f32_16x16x32_bf16(Bt[n][k], At[m][k], acc[ai][bj][m][n], 0, 0, 0); __builtin_amdgcn_s_setprio(0); } while (0)
#define PG8_WAIT_V(n) asm volatile("s_waitcnt vmcnt(" #n ")" ::: "memory")
#define PG8_WAIT_L(n) asm volatile("s_waitcnt lgkmcnt(" #n ")" ::: "memory")
#define PG8_BAR __builtin_amdgcn_s_barrier()
#define PG8_SCHED __builtin_amdgcn_sched_barrier(0)
    Unit cur, nxt; int ui = 0;
    if (!S.next(0, cur)) return;
    f32x4 acc[2][2][4][2];
#pragma unroll
    for (int a = 0; a < 2; ++a)
#pragma unroll
        for (int b = 0; b < 2; ++b)
#pragma unroll
            for (int m = 0; m < 4; ++m)
#pragma unroll
                for (int n = 0; n < 2; ++n) acc[a][b][m][n] = (f32x4){0.f, 0.f, 0.f, 0.f};
    bf16x8 At[4][2], B0[2][2], B1[2][2];
    const char* cA = (const char*)g.A + (size_t)cur.pm * tstep; const char* cB = (const char*)g.Bt + (size_t)cur.pn * tstep;
    S.a_ready(cur);
    PG8_STAGE(PG8_SB(0, 0), cB, voffB); PG8_STAGE(PG8_SA(0, 0), cA, voffA); PG8_STAGE(PG8_SB(0, 1), cB + hstep, voffB); PG8_STAGE(PG8_SA(0, 1), cA + hstep, voffA);
    if (wr == 1) PG8_BAR;
    PG8_WAIT_V(4); PG8_BAR;
    PG8_STAGE(PG8_SB(1, 0), cB + kstep, voffB); PG8_STAGE(PG8_SA(1, 0), cA + kstep, voffA); PG8_STAGE(PG8_SB(1, 1), cB + hstep + kstep, voffB);
    PG8_WAIT_V(6); PG8_BAR;
    PG8_STAMP();
    for (;;) {
        const bool has_next = S.next(ui + 1, nxt);
        const char* nA = has_next ? (const char*)g.A + (size_t)nxt.pm * tstep : cA; const char* nB = has_next ? (const char*)g.Bt + (size_t)nxt.pn * tstep : cB;
        for (int t = 0; t < nt; t += 2) {
            const bool last = (t == nt - 2);
            const char* a1 = cA + (size_t)(t + 1) * kstep;
            const char* a2 = last ? nA : cA + (size_t)(t + 2) * kstep; const char* b2 = last ? nB : cB + (size_t)(t + 2) * kstep;
            const char* a3 = a2 + kstep; const char* b3 = b2 + kstep;
            if (last && has_next) S.a_ready(nxt);
            PG8_LDB(B0, 0, 0); PG8_SCHED; PG8_LDA(At, 0, 0); PG8_STAGE(PG8_SA(1, 1), a1 + hstep, voffA);
            PG8_WAIT_L(8); PG8_BAR; PG8_WAIT_L(0); PG8_MMA(0, 0, At, B0); PG8_BAR; PG8_SCHED;
            PG8_LDB(B1, 0, 1); PG8_STAGE(PG8_SB(0, 0), b2, voffB);
            PG8_BAR; PG8_WAIT_L(0); PG8_MMA(0, 1, At, B1); PG8_BAR;
            PG8_LDA(At, 0, 1); PG8_STAGE(PG8_SA(0, 0), a2, voffA);
            PG8_BAR; PG8_WAIT_L(0); PG8_MMA(1, 0, At, B0); PG8_BAR; PG8_SCHED;
            PG8_STAGE(PG8_SB(0, 1), b2 + hstep, voffB);
            PG8_WAIT_V(6); PG8_BAR; PG8_MMA(1, 1, At, B1); PG8_BAR;
            PG8_LDB(B0, 1, 0); PG8_SCHED; PG8_LDA(At, 1, 0); PG8_STAGE(PG8_SA(0, 1), a2 + hstep, voffA);
            PG8_WAIT_L(8); PG8_BAR; PG8_WAIT_L(0); PG8_MMA(0, 0, At, B0); PG8_BAR; PG8_SCHED;
            PG8_LDB(B1, 1, 1); PG8_STAGE(PG8_SB(1, 0), b3, voffB);
            PG8_BAR; PG8_WAIT_L(0); PG8_MMA(0, 1, At, B1); PG8_BAR;
            PG8_LDA(At, 1, 1); PG8_STAGE(PG8_SA(1, 0), a3, voffA);
            PG8_BAR; PG8_WAIT_L(0); PG8_MMA(1, 0, At, B0); PG8_BAR; PG8_SCHED;
            PG8_STAGE(PG8_SB(1, 1), b3 + hstep, voffB);
            PG8_WAIT_V(6); PG8_BAR; PG8_MMA(1, 1, At, B1); PG8_BAR;
        }
        PG8_STAMP();
        if constexpr (!Epi::AFTER_DRAIN) { E(acc, cur, wr, wc, fr, fq); S.done(cur); }
        PG8_STAMP();
        if (!has_next) break;
#pragma unroll
        for (int a = 0; a < 2; ++a)
#pragma unroll
            for (int b = 0; b < 2; ++b)
#pragma unroll
                for (int m = 0; m < 4; ++m)
#pragma unroll
                    for (int n = 0; n < 2; ++n) acc[a][b][m][n] = (f32x4){0.f, 0.f, 0.f, 0.f};
        cur = nxt; cA = nA; cB = nB; ++ui;
    }
    PG8_WAIT_V(0);
    if (wr == 0) PG8_BAR;
    PG8_BAR;
    if constexpr (Epi::AFTER_DRAIN) { E.fused(acc, cur, wr, wc, fr, fq, lds, wid, lane); S.done(cur); }
    PG8_STAMP();
    if (STAMP && wid == 0) { stamps[lane] = lane < nts ? (((unsigned long long)(unsigned)ts_hi << 32) | (unsigned)ts_lo) : 0ull;
        if (lane == 62) stamps[62] = rt_entry; if (lane == 63) stamps[63] = 0ull; }
#undef PG8_STAMP
#undef PG8_SA
#undef PG8_SB
#undef PG8_STAGE
#undef PG8_LDA
#undef PG8_LDB
#undef PG8_MMA
#undef PG8_WAIT_V
#undef PG8_WAIT_L
#undef PG8_BAR
#undef PG8_SCHED
}
}

template <class F> struct EpiFn {
  static constexpr bool PERM = false, AFTER_DRAIN = false;
  F f;
  __device__ __forceinline__ void operator()(const pg8::f32x4 (&acc)[2][2][4][2], const pg8::Unit& u, int wr, int wc, int fr, int fq) const {
#pragma unroll
    for (int ai = 0; ai < 2; ++ai)
#pragma unroll
      for (int m = 0; m < 4; ++m) {
        const int row = u.pm * 256 + ai * 128 + wr * 64 + m * 16 + fr;
#pragma unroll
        for (int bj = 0; bj < 2; ++bj)
#pragma unroll
          for (int n = 0; n < 2; ++n) f(row, u.pn * 256 + bj * 128 + wc * 32 + n * 16 + 4 * fq, acc[ai][bj][m][n]);
      }
  }
};
template <int NN> struct RowMajorOrder {
  int nwg, G, c;
  __device__ __forceinline__ bool next(int i, pg8::Unit& u) const { const int L = i * G + c; if (L >= nwg) return false; u.pm = L / NN; u.pn = L - u.pm * NN; return true; }
  __device__ __forceinline__ void a_ready(const pg8::Unit&) const {}
  __device__ __forceinline__ void done(const pg8::Unit&) const {}
};
template <class F> struct EpiFn8 {
  static constexpr bool PERM = true, AFTER_DRAIN = false;
  F f;
  __device__ __forceinline__ void operator()(const pg8::f32x4 (&acc)[2][2][4][2], const pg8::Unit& u, int wr, int wc, int fr_, int fq_) const {
    const int fr = launder_v(fr_), fq = launder_v(fq_);
#pragma unroll
    for (int ai = 0; ai < 2; ++ai)
#pragma unroll
      for (int m = 0; m < 4; ++m) {
        const int row = u.pm * 256 + ai * 128 + wr * 64 + m * 16 + fr;
#pragma unroll
        for (int bj = 0; bj < 2; ++bj) f(row, u.pn * 256 + bj * 128 + wc * 32 + 8 * fq, acc[ai][bj][m][0], acc[ai][bj][m][1]);
      }
  }
};
template <int N, class F>
__device__ __forceinline__ void gemm256p(const bf16_t* A, const bf16_t* Bt, int M, int K, F f, char* smem) {
  pg8::Gemm g; g.A = A; g.Bt = Bt; g.M = M; g.N = N; g.K = K;
  RowMajorOrder<N / 256> S; S.nwg = (M / 256) * (N / 256); S.G = (int)gridDim.x; S.c = BIDX;
  EpiFn8<F> E{f};
  __syncthreads();
  pg8::gemm_phase<EpiFn8<F>, RowMajorOrder<N / 256>, false>((PG8_LAS unsigned char*)smem, g, S, E, nullptr);
  __syncthreads();
}
template <int N, class F>
__device__ __forceinline__ void gemm256(const bf16_t* A, const bf16_t* Bt, int M, int K, F f, char* smem) {
  pg8::Gemm g; g.A = A; g.Bt = Bt; g.M = M; g.N = N; g.K = K;
  RowMajorOrder<N / 256> S; S.nwg = (M / 256) * (N / 256); S.G = (int)gridDim.x; S.c = BIDX;
  EpiFn<F> E{f};
  __syncthreads();
  pg8::gemm_phase<EpiFn<F>, RowMajorOrder<N / 256>, false>((PG8_LAS unsigned char*)smem, g, S, E, nullptr);
  __syncthreads();
}

#define XB_TMO      128
#define XB_XCNT(j)  (256  + 64 * (j))
#define XB_XSUB(j)  (1280 + 64 * (j))
#define XB_XGEN(j)  (2304 + 64 * (j))
#define XB_TOP      3328
#define XB_TOPGEN   3392
#define XCD_BAR_WORDS 3456
#define XB_SPIN_CAP (1u << 22)
#define LAS __attribute__((address_space(3)))
__device__ __forceinline__ unsigned xb_ld(unsigned* p)              { return __hip_atomic_load(p, __ATOMIC_RELAXED, __HIP_MEMORY_SCOPE_AGENT); }
__device__ __forceinline__ unsigned xb_add(unsigned* p, unsigned v) { return __hip_atomic_fetch_add(p, v, __ATOMIC_RELAXED, __HIP_MEMORY_SCOPE_AGENT); }
__device__ __forceinline__ unsigned xb_xcc_id() { return (unsigned)__builtin_amdgcn_s_getreg((3 << 11) | 20) & 0xFu; }
#define XB_SPIN(cond, bar) do { unsigned _sp = 0; while (cond) { __builtin_amdgcn_s_sleep(1); \
    if ((++_sp & 255u) == 0u) { if (xb_ld(&(bar)[XB_TMO])) break; if (_sp > XB_SPIN_CAP) { atomicAdd(&(bar)[XB_TMO], 1u); break; } } } } while (0)
struct XcdBarrier { unsigned* bar; unsigned x; volatile LAS unsigned* st; };
__device__ __forceinline__ XcdBarrier xcd_barrier_post(unsigned* bar, volatile LAS unsigned* st) {
  XcdBarrier b; b.bar = bar; b.x = xb_xcc_id(); b.st = st;
  if (threadIdx.x == 0) (void)xb_add(&bar[XB_XCNT(b.x)], 1u);
  return b;
}
__device__ __forceinline__ void xcd_barrier_complete(unsigned* bar, unsigned x, unsigned& nloc, unsigned& nx) {
  const unsigned G = gridDim.x * gridDim.y * gridDim.z;
  unsigned sum, cnt, mine, sp = 0u;
  for (;;) {
    sum = 0u; cnt = 0u; mine = 0u;
#pragma unroll
    for (unsigned j = 0; j < 16; ++j) { const unsigned c = xb_ld(&bar[XB_XCNT(j)]); sum += c; cnt += (c > 0u) ? 1u : 0u; mine = (j == x) ? c : mine; }
    if (sum == G) break;
    __builtin_amdgcn_s_sleep(1);
    if ((++sp & 255u) == 0u) { if (xb_ld(&bar[XB_TMO])) break; if (sp > XB_SPIN_CAP) { atomicAdd(&bar[XB_TMO], 1u); break; } }
  }
  nloc = mine > 0u ? mine : 1u; nx = cnt > 0u ? cnt : 1u;
}
__device__ __forceinline__ void xcd_barrier(const XcdBarrier& b) {
  asm volatile("s_waitcnt vmcnt(0)" ::: "memory");
  __syncthreads();
  if (threadIdx.x == 0) {
    unsigned* bar = b.bar;
    __builtin_amdgcn_s_waitcnt(0);
    unsigned nloc = b.st[0], nx = b.st[1];
    if (nloc == 0u) { xcd_barrier_complete(bar, b.x, nloc, nx); b.st[0] = nloc; b.st[1] = nx; }
    const unsigned old = xb_add(&bar[XB_XSUB(b.x)], 1u);
    const unsigned gen = old / nloc;
    if (old + 1u == (gen + 1u) * nloc) {
      __builtin_amdgcn_fence(__ATOMIC_RELEASE, "agent");
      asm volatile("s_waitcnt vmcnt(0)" ::: "memory");
      const unsigned og = xb_add(&bar[XB_TOP], 1u);
      const unsigned tg = og / nx;
      if (og + 1u == (tg + 1u) * nx) xb_add(&bar[XB_TOPGEN], 1u);
      else XB_SPIN(xb_ld(&bar[XB_TOPGEN]) == tg, bar);
      __builtin_amdgcn_fence(__ATOMIC_ACQUIRE, "agent");
      xb_add(&bar[XB_XGEN(b.x)], 1u);
      asm volatile("s_waitcnt vmcnt(0)" ::: "memory");
    } else {
      XB_SPIN(xb_ld(&bar[XB_XGEN(b.x)]) == gen, bar);
      __builtin_amdgcn_fence(__ATOMIC_ACQUIRE, "agent");
      asm volatile("s_waitcnt vmcnt(0)" ::: "memory");
    }
  }
  __syncthreads();
}

constexpr int NSTAGES = 23;
constexpr int SMEM_BYTES = 135168;
template <int S>
__device__ __forceinline__ void run_stage_t(const Params& p0, int layer0, char* smem0) {
  Params p = p0; int layer = layer0; char* smem = smem0;
  { unsigned long long w = (unsigned long long)p0.ws, o = (unsigned long long)p0.out;
    asm volatile("" : "+s"(w), "+s"(o), "+s"(layer));
    p.ws = (char*)(__attribute__((address_space(1))) char*)w; p.out = (float*)(__attribute__((address_space(1))) float*)o; }
  const int nrows = (layer == 0) ? NTOK : NLAT;
  if constexpr (S == 100) stage_prep(p, smem);
  if constexpr (S == 101) stage_prep2(p, smem);
  if constexpr (S == 102) final_norm(p);
  if constexpr (S == 0) stage_norm(p, layer, 0, NTOK);
  if constexpr (S == 1) {
    bf16_t* u = (bf16_t*)(p.ws + OFF_U);
    gemm256p<DINP>((const bf16_t*)(p.ws + OFF_HB), (const bf16_t*)(p.ws + OFF_WIN) + (size_t)layer * DINP * 1024, NTOK, 1024,
            [=](int row, int col0, f32x4 v, f32x4 w) { if (col0 < DIN) { const u32x4 o = {cvtpk(v[0], v[1]), cvtpk(v[2], v[3]), cvtpk(w[0], w[1]), cvtpk(w[2], w[3])}; *(u32x4*)(u + (size_t)row * DIN + col0) = o; } }, smem);
    {
      const int nunits = (NTOK / 256) * (DINP / 256), G = (int)gridDim.x, rem = nunits % G, c = BIDX;
      if (rem == 0) peer_cvt_tables(p, layer, c, G); else if (c >= rem) peer_cvt_tables(p, layer, c - rem, G - rem);
    }
  }
  if constexpr (S == 2) { lru_units(p, layer, 0, smem); mla_prep(p, layer); hyena_prep(p, layer, smem);
#if defined(PROBE_S2)
    __syncthreads();
    if (PROBE_S2 == 0) lru_units(p, layer, 0, smem); else if (PROBE_S2 == 1) mla_prep(p, layer); else hyena_prep(p, layer, smem);
#endif
  }
  if constexpr (S == 3) {
    bf16_t* Q = (bf16_t*)(p.ws + OFF_Q); bf16_t* K = (bf16_t*)(p.ws + OFF_K);
    lru_carry(p, smem);
    gemm256p<768>((const bf16_t*)(p.ws + OFF_QN), (const bf16_t*)(p.ws + OFF_WQB) + (size_t)layer * 768 * 384, NTOK, 384,
            [=](int row, int col0, f32x4 v, f32x4 w) {
              if (col0 < 576) {
                const int j = col0 % 96;
                if (j >= 64 && row < NLAT) {
                  const int t = row & (SEQ - 1), i0 = (j & 8) >> 1;
                  const float pos = (j & 16) ? (float)(t & 63) : (float)(t >> 6);
#pragma unroll
                  for (int q = 0; q < 4; ++q) {
                    constexpr float R1 = 0.31622776601683794f;
                    const float invq = (q == 0 ? 1.f : q == 1 ? R1 : q == 2 ? R1 * R1 : R1 * R1 * R1) * 0.15915494309189535f;
                    const float rev = pos * (i0 ? invq * 0.01f : invq);
                    const float cs = __builtin_amdgcn_cosf(rev), sn = __builtin_amdgcn_sinf(rev);
                    if (q < 2) { const float lo = v[2 * q], hh = v[2 * q + 1]; v[2 * q] = lo * cs - hh * sn; v[2 * q + 1] = hh * cs + lo * sn; }
                    else { const float lo = w[2 * q - 4], hh = w[2 * q - 3]; w[2 * q - 4] = lo * cs - hh * sn; w[2 * q - 3] = hh * cs + lo * sn; }
                  }
                }
                const u32x4 o = {cvtpk(v[0], v[1]), cvtpk(v[2], v[3]), cvtpk(w[0], w[1]), cvtpk(w[2], w[3])};
                *(u32x4*)(Q + (size_t)row * 576 + col0) = o;
              }
            }, smem);
    gemm256p<768>((const bf16_t*)(p.ws + OFF_KVN), (const bf16_t*)(p.ws + OFF_WKVB) + (size_t)layer * 768 * 256, NTOK, 256,
            [=](int row, int col0, f32x4 v, f32x4 w) { const u32x4 o = {cvtpk(v[0], v[1]), cvtpk(v[2], v[3]), cvtpk(w[0], w[1]), cvtpk(w[2], w[3])}; *(u32x4*)(K + (size_t)row * 768 + col0) = o; }, smem);
  }
  if constexpr (S == 4) { attn_units(p, layer, smem); hyena_fft(p, layer, smem); }
  if constexpr (S == 12) { attn_combine(p); hyena_out_transpose(p, smem); hyena_direct(p, layer, smem); lru_final(p, layer, smem); }
  if constexpr (S == 5) {
    float* xs = (float*)(p.ws + OFF_XS); const float* mod = (const float*)(p.ws + OFF_MOD) + (size_t)layer * 3 * 6144;
    const float* xin = p.in[I_X]; const float* cin = p.in[I_CTX];
    const bf16_t* wo = (const bf16_t*)(p.ws + OFF_WOUT) + (size_t)layer * 1024 * 1024;
    gemm256<1024>((const bf16_t*)(p.ws + OFF_MIX), wo, NLAT, 1024,
            [=](int row, int col0, f32x4 v) {
              const float* g1 = mod + (size_t)(row >> 13) * 6144 + 2048 + col0;
              const float* src = (layer == 0) ? xin + (size_t)row * DM + col0 : xs + (size_t)row * DM + col0;
              const f32x4 s4 = *(const f32x4*)src, g4 = *(const f32x4*)g1;
              *(f32x4*)(xs + (size_t)row * DM + col0) = s4 + g4 * v;
            }, smem);
    if (layer == 0)
      gemm_bt((const bf16_t*)(p.ws + OFF_MIX) + (size_t)NLAT * DM, DM, wo, 1024, NCTX, 1024, 1024,
              [=](int row, int col, float v) {
                const float g1 = mod[(size_t)2 * 6144 + 2048 + col];
                xs[(size_t)(NLAT + row) * DM + col] = cin[(size_t)row * DM + col] + g1 * v;
              }, smem);
  }
  if constexpr (S == 6) { stage_norm(p, layer, 1, nrows); }
  if constexpr (S == 7) {
    bf16_t* pq = (bf16_t*)(p.ws + OFF_PQ);
    const bf16_t* wq = (const bf16_t*)(p.ws + OFF_WPQ) + (size_t)layer * 2048 * 1024;
    gemm256p<2048>((const bf16_t*)(p.ws + OFF_HB), wq, NLAT, 1024,
            [=](int row, int col0, f32x4 v, f32x4 w) { const u32x4 o = {cvtpk(v[0], v[1]), cvtpk(v[2], v[3]), cvtpk(w[0], w[1]), cvtpk(w[2], w[3])}; *(u32x4*)(pq + (size_t)row * 2048 + col0) = o; }, smem);
    if (layer == 0)
      gemm_bt((const bf16_t*)(p.ws + OFF_HB) + (size_t)NLAT * DM, DM, wq, 1024, NCTX, 2048, 1024,
              [=](int row, int col, float v) { pq[(size_t)(NLAT + row) * 2048 + col] = f2bf(v); }, smem);
  }
  if constexpr (S == 8) peer_topk(p, layer, nrows, smem);
  if constexpr (S == 9) peer_eval_fused(p, layer, nrows, smem);
}

__device__ __forceinline__ void init_params(Params& p, const KArgs& ka, char* smem) {
  unsigned long long* tab = (unsigned long long*)(smem + SMEM_BYTES);
  if (threadIdx.x == 0) {
#pragma unroll
    for (int i = 0; i < N_IN; ++i) tab[i] = (unsigned long long)ka.in[i];
  }
  __syncthreads();
  p.in.tab = smem + SMEM_BYTES; p.out = ka.out; p.ws = ka.ws;
}

#if MK_SINGLE
#define SYNC() xcd_barrier(xb)
__global__ void __launch_bounds__(NTHREADS) mega_kernel(KArgs ka) {
  __shared__ __attribute__((aligned(16))) char smem[SMEM_BYTES + 512];
  cg::grid_group grid = cg::this_grid();
  if (threadIdx.x == 0) *(uint4*)(smem + SMEM_BYTES + 320) = make_uint4(0u, 0u, 0u, 0u);
  Params p; init_params(p, ka, smem);
  const XcdBarrier xb = xcd_barrier_post((unsigned*)(ka.ws + OFF_BAR), (volatile LAS unsigned*)(smem + SMEM_BYTES + 320));
  run_stage_t<100>(p, 0, smem); grid.sync();
#if defined(PROBE_PREP) && PROBE_PREP == 100
  run_stage_t<100>(p, 0, smem); SYNC();
#endif
  run_stage_t<101>(p, 0, smem); SYNC();
#if defined(PROBE_BW)
  {
    const u32x4* base = (const u32x4*)(ka.ws + (size_t)64 * 1024 * 1024);
    const size_t n16 = (size_t)PROBE_BW * 64 * 1024 * 1024 / 16;
    unsigned acc_ = 0;
    for (size_t i = (size_t)blockIdx.x * NTHREADS + threadIdx.x; i + 7 * (size_t)gridDim.x * NTHREADS < n16; i += 8 * (size_t)gridDim.x * NTHREADS) {
      u32x4 t_[8];
#pragma unroll
      for (int k = 0; k < 8; ++k) t_[k] = base[i + k * (size_t)gridDim.x * NTHREADS];
#pragma unroll
      for (int k = 0; k < 8; ++k) acc_ ^= t_[k][0] ^ t_[k][1] ^ t_[k][2] ^ t_[k][3];
    }
    if (acc_ == 0x12345u) ((unsigned*)(ka.ws + OFF_BAR))[1000] = acc_;
    SYNC();
  }
#endif
#if defined(PROBE_BAR)
  SYNC(); SYNC(); SYNC(); SYNC(); SYNC(); SYNC(); SYNC(); SYNC(); SYNC(); SYNC(); SYNC(); SYNC(); SYNC(); SYNC(); SYNC(); SYNC(); SYNC(); SYNC(); SYNC(); SYNC();
#endif
#if defined(PROBE_PREP) && PROBE_PREP == 101
  run_stage_t<101>(p, 0, smem); SYNC();
#endif
#ifndef PROBE_DUP
#define PROBE_DUP -1
#endif
#define RUNSTAGE(S, layer) do { if (PROBE_DUP == S) { int nrep = 2; asm volatile("" : "+s"(nrep)); \
      for (int rep = 0; rep < nrep; ++rep) { run_stage_t<S>(p, layer, smem); SYNC(); if (S == 9 || S == 11) break; } } \
    else { run_stage_t<S>(p, layer, smem); SYNC(); } } while (0)
#if defined(PROBE_ATT)
#define PROBE_ATT_HOOK(layer) { attn_units<PROBE_ATT, true>(p, layer, smem); SYNC(); }
#else
#define PROBE_ATT_HOOK(layer)
#endif
#define LAYER_PASS(layer) \
    if (layer == 0) { RUNSTAGE(0, layer); } RUNSTAGE(1, layer); RUNSTAGE(2, layer); RUNSTAGE(3, layer); RUNSTAGE(4, layer); PROBE_ATT_HOOK(layer) RUNSTAGE(12, layer); \
    RUNSTAGE(5, layer); RUNSTAGE(6, layer); RUNSTAGE(7, layer); RUNSTAGE(8, layer); RUNSTAGE(9, layer);
  LAYER_PASS(0)
  LAYER_PASS(1)
}
#else
template <int S>
__global__ void __launch_bounds__(NTHREADS) stage_kernel(KArgs ka, int layer) {
  __shared__ __attribute__((aligned(16))) char smem[SMEM_BYTES + 512];
  Params p; init_params(p, ka, smem);
  run_stage_t<S>(p, layer, smem);
}
#endif

extern "C" void kernel_launch(void* const* d_in, const int* in_sizes, int n_in, void* d_out, int out_size, void* d_ws, size_t ws_size, hipStream_t stream) {
  if (n_in != N_IN || ws_size < WS_END) { fprintf(stderr, "kernel_launch: bad args n_in=%d ws=%zu need=%zu\n", n_in, ws_size, (size_t)WS_END); return; }
  KArgs p{};
  for (int i = 0; i < N_IN; ++i) p.in[i] = (const float*)d_in[i];
  p.out = (float*)d_out; p.ws = (char*)d_ws;
#if MK_SINGLE
  static int grid_blocks = 0;
  if (!grid_blocks) {
    int dev = 0, cus = 0, per_cu = 0;
    hipGetDevice(&dev);
    hipDeviceGetAttribute(&cus, hipDeviceAttributeMultiprocessorCount, dev);
    hipOccupancyMaxActiveBlocksPerMultiprocessor(&per_cu, mega_kernel, NTHREADS, 0);
    if (per_cu > 1) per_cu = 1;
    grid_blocks = cus * per_cu;
  }
  hipMemsetAsync((char*)d_ws + OFF_BAR, 0, BAR_BYTES, stream);
  void* args[] = {&p};
  hipError_t e = hipLaunchCooperativeKernel((void*)mega_kernel, dim3(grid_blocks), dim3(NTHREADS), args, 0, stream);
  if (e != hipSuccess) fprintf(stderr, "cooperative launch failed: %s (grid %d)\n", hipGetErrorString(e), grid_blocks);
#else
#define LAUNCH(S, L) hipLaunchKernelGGL(stage_kernel<S>, dim3(256), dim3(NTHREADS), 0, stream, p, L)
  LAUNCH(100, 0); LAUNCH(101, 0);
  for (int layer = 0; layer < 2; ++layer) {
    LAUNCH(0, layer); LAUNCH(1, layer); LAUNCH(2, layer); LAUNCH(3, layer); LAUNCH(4, layer);
    LAUNCH(5, layer); LAUNCH(6, layer); LAUNCH(7, layer); LAUNCH(8, layer); LAUNCH(9, layer);
  }
  LAUNCH(102, 0);
#endif
}
```

```cpp
#include <hip/hip_runtime.h>
#include <hip/hip_cooperative_groups.h>
#include <cstdio>
#include <cstdint>
namespace cg = cooperative_groups;

__device__ __forceinline__ int launder_v(int x) { asm volatile("" : "+v"(x)); return x; }
__device__ __forceinline__ int launder_s(int x) { asm volatile("" : "+s"(x)); return x; }
#define TIDX launder_v((int)threadIdx.x)
#define BIDX launder_s((int)blockIdx.x)

__device__ __forceinline__ float shx(float v, int mask) { const int l = TIDX & 63; return __int_as_float(__builtin_amdgcn_ds_bpermute((l ^ mask) << 2, __float_as_int(v))); }
__device__ __forceinline__ int shxi(int v, int mask) { const int l = TIDX & 63; return __builtin_amdgcn_ds_bpermute((l ^ mask) << 2, v); }
__device__ __forceinline__ float rdl(float v, int srclane) { return __int_as_float(__builtin_amdgcn_readlane(__float_as_int(v), srclane)); }

#ifndef MK_SINGLE
#define MK_SINGLE 1
#endif

typedef unsigned short bf16_t;
using bf16x8 = __attribute__((ext_vector_type(8))) short;
using s16x4  = __attribute__((ext_vector_type(4))) short;
using f32x16 = __attribute__((ext_vector_type(16))) float;
using f32x4  = __attribute__((ext_vector_type(4))) float;
using u32x4  = __attribute__((ext_vector_type(4))) unsigned;
using u32x2  = __attribute__((ext_vector_type(2))) unsigned;

constexpr int NB = 2, SEQ = 8192, CTXL = 256, DM = 1024;
constexpr int NLAT = NB * SEQ, NCTX = NB * CTXL, NTOK = NLAT + NCTX;
constexpr int DIN = 2208, DINP = 2304;
constexpr int DLRU = 384, NKEYS = SEQ + CTXL;
constexpr int NTHREADS = 512;
constexpr int NCHUNK = NLAT / 64 + NCTX / 64;
constexpr float EPSV = 1e-6f;

enum { I_X = 0, I_C, I_CTX, I_CCTX, I_WMOD, I_BMOD, I_N1G, I_N2G, I_WIN, I_WOUT, I_LCW, I_LCB, I_LWR, I_LBR, I_LWI, I_LBI, I_LLAM,
       I_QNG, I_WQB, I_KVNG, I_WKVB, I_HCW, I_HCB, I_HW1, I_HB1, I_HW2, I_HB2, I_HW3, I_HFREQ, I_HDECAY, I_HSKIP,
       I_PWQ, I_PKEYS, I_PU, I_PV, I_FG, N_IN };

struct KArgs { const float* in[N_IN]; float* out; char* ws; };
struct InTab {
  const char* tab;
  __device__ __forceinline__ const float* operator[](int i) const {
    const unsigned long long v = ((const unsigned long long*)tab)[i];
    const unsigned lo = __builtin_amdgcn_readfirstlane((unsigned)v), hi = __builtin_amdgcn_readfirstlane((unsigned)(v >> 32));
    return (const float*)(const __attribute__((address_space(1))) float*)(((unsigned long long)hi << 32) | lo);
  }
};
struct Params { InTab in; float* out; char* ws; };

constexpr size_t al256(size_t x) { return (x + 255) / 256 * 256; }
constexpr size_t OFF_XS    = 0;
constexpr size_t OFF_HB    = OFF_XS    + al256((size_t)NTOK * DM * 4);
constexpr size_t OFF_U     = OFF_HB    + al256((size_t)NTOK * DM * 2);
constexpr size_t OFF_PQ    = OFF_U;
constexpr size_t OFF_LAB   = OFF_U     + al256((size_t)NTOK * DIN * 2);
static_assert(OFF_LAB + (size_t)(NTOK / 32) * 6 * 2 * 2 * 16 * 64 * 4 <= OFF_U + al256((size_t)NTOK * DIN * 4), "LRU coefficient buffer must fit behind the bf16 u");
constexpr size_t OFF_MIX   = OFF_U     + al256((size_t)NTOK * DIN * 4);
constexpr size_t OFF_HYIN  = OFF_MIX   + al256((size_t)NTOK * DM * 2);
constexpr size_t OFF_EID   = OFF_HYIN;
constexpr size_t OFF_GATE  = OFF_EID   + al256((size_t)NTOK * 128 * 4);
constexpr size_t OFF_HYINC = OFF_HYIN  + al256((size_t)3 * 2 * 256 * 8192 * 4);
constexpr size_t OFF_QN    = OFF_HYINC + al256((size_t)3 * 2 * 256 * 256 * 4);
constexpr size_t TAB_BYTES = (size_t)16384 * 1024;
constexpr size_t OFF_UTAB  = al256(OFF_LAB + (size_t)(NTOK / 32) * 6 * 2 * 2 * 16 * 64 * 4);
constexpr size_t OFF_OPART = OFF_QN;
constexpr size_t OFF_OML   = OFF_OPART + (size_t)4 * 2 * SEQ * 64 * 4;
constexpr size_t OFF_KVN   = OFF_QN    + al256((size_t)NTOK * 384 * 2);
constexpr size_t OFF_Q     = OFF_KVN   + al256((size_t)NTOK * 256 * 2);
constexpr size_t OFF_K     = OFF_Q     + al256((size_t)NTOK * 576 * 2);
constexpr size_t OFF_V     = OFF_K     + al256((size_t)NTOK * 768 * 2);
constexpr size_t OFF_LSUM  = OFF_V     + al256((size_t)NTOK * 32 * 2);
static_assert(OFF_OML + (size_t)4 * 2 * SEQ * 2 * 4 <= OFF_Q, "attention partials must fit in the dead QN/KVN region");
static_assert(OFF_UTAB + TAB_BYTES <= OFF_U + al256((size_t)NTOK * DIN * 4), "u table must fit in the tail of the u region");
constexpr size_t OFF_CARRY = OFF_LSUM  + al256((size_t)(NTOK / 32) * 2 * 2 * 384 * 4);
constexpr size_t OFF_MOD   = OFF_CARRY + al256((size_t)(NTOK / 32) * 2 * 384 * 4);
constexpr size_t OFF_MODP  = OFF_MIX;
constexpr size_t OFF_WIN   = OFF_MOD   + al256((size_t)2 * 3 * 6144 * 4);
constexpr size_t OFF_WOUT  = OFF_WIN   + al256((size_t)2 * DINP * 1024 * 2);
constexpr size_t OFF_WQB   = OFF_WOUT  + al256((size_t)2 * 1024 * 1024 * 2);
constexpr size_t OFF_WKVB  = OFF_WQB   + al256((size_t)2 * 768 * 384 * 2);
constexpr size_t OFF_WPQ   = OFF_WKVB  + al256((size_t)2 * 768 * 256 * 2);
constexpr size_t OFF_KEYS  = OFF_WPQ   + al256((size_t)2 * 2048 * 1024 * 2);
constexpr size_t OFF_GW    = OFF_KEYS  + al256((size_t)2 * 2 * 128 * 128 * 2);
constexpr size_t OFF_H2    = OFF_GW    + al256((size_t)2 * 2 * 2 * 6 * 64 * 64 * 2);
constexpr size_t OFF_HSPEC = OFF_H2    + al256((size_t)2 * NKEYS * 64 * 4);
constexpr size_t OFF_FILTC = OFF_HSPEC + al256((size_t)2 * 256 * 2 * 16384 * 4);
constexpr size_t OFF_SSQPC = OFF_FILTC + al256((size_t)2 * 1024 * 256 * 4);
constexpr size_t OFF_BAR   = OFF_SSQPC + al256((size_t)2 * 4 * 1024 * 4);
constexpr size_t OFF_CTR   = OFF_BAR   + al256(3456 * 4);
constexpr size_t BAR_BYTES = al256(3456 * 4) + 2 * 2 * 2 * 16 * 256;
constexpr size_t OFF_VTAB  = OFF_BAR   + al256(BAR_BYTES);
constexpr size_t WS_END    = OFF_VTAB  + al256(TAB_BYTES);
static_assert(WS_END <= (size_t)4 * 2 * 16384 * 1024 * 4, "workspace layout exceeds the guaranteed 4 x largest-tensor size");
constexpr size_t OFF_SP    = OFF_U;
constexpr size_t OFF_WBUF  = OFF_SP    + (size_t)16 * NTOK * 128 * 4;
static_assert(OFF_WBUF + (size_t)NTOK * 128 * 4 <= OFF_MIX, "PEER partials must fit in the u region");

__device__ __forceinline__ float bf2f(bf16_t v) { return __uint_as_float(((unsigned)v) << 16); }
__device__ __forceinline__ bf16_t f2bf(float f) { unsigned u = __float_as_uint(f); u += 0x7fffu + ((u >> 16) & 1u); return (bf16_t)(u >> 16); }
__device__ __forceinline__ unsigned cvtpk(float lo, float hi) { unsigned r; asm volatile("v_cvt_pk_bf16_f32 %0, %1, %2" : "=v"(r) : "v"(lo), "v"(hi)); return r; }
__device__ __forceinline__ float gelu_tanh(float x) { const float z2 = 1.5957691216057308f * (x + 0.044715f * x * x * x); return x * __builtin_amdgcn_rcpf(1.f + __expf(-z2)); }
__device__ __forceinline__ float sigm(float x) { return 1.f / (1.f + __expf(-x)); }
template <int CTRL> __device__ __forceinline__ float dpp_mov(float x) { return __builtin_bit_cast(float, __builtin_amdgcn_mov_dpp(__builtin_bit_cast(int, x), CTRL, 0xf, 0xf, true)); }
__device__ __forceinline__ float wave_sum(float v) {
  v += dpp_mov<0xB1>(v); v += dpp_mov<0x4E>(v); v += dpp_mov<0x141>(v); v += dpp_mov<0x128>(v);
  { auto r = __builtin_amdgcn_permlane16_swap(__float_as_uint(v), __float_as_uint(v), false, false); v = __uint_as_float(r[0]) + __uint_as_float(r[1]); }
  { auto r = __builtin_amdgcn_permlane32_swap(__float_as_uint(v), __float_as_uint(v), false, false); v = __uint_as_float(r[0]) + __uint_as_float(r[1]); }
  return v;
}
using bf16x2v = __attribute__((ext_vector_type(2))) __bf16;
__device__ __forceinline__ float dot2bf(unsigned a, unsigned b, float acc) { return __builtin_amdgcn_fdot2_f32_bf16(__builtin_bit_cast(bf16x2v, a), __builtin_bit_cast(bf16x2v, b), acc, false); }
__device__ __forceinline__ int crow(int r, int hi) { return (r & 3) + 8 * (r >> 2) + 4 * hi; }
__device__ __forceinline__ void row_info(int r, int& b, int& t, int& isctx) {
  if (r < NLAT) { isctx = 0; b = r >> 13; t = r & (SEQ - 1); } else { isctx = 1; int q = r - NLAT; b = q >> 8; t = q & (CTXL - 1); }
}
__device__ __forceinline__ const float* xrow_src(const Params& p, int layer, int r) {
  if (layer == 0) return (r < NLAT) ? p.in[I_X] + (size_t)r * DM : p.in[I_CTX] + (size_t)(r - NLAT) * DM;
  return (const float*)(p.ws + OFF_XS) + (size_t)r * DM;
}
__device__ __forceinline__ size_t h2idx(int l, int pos, int j) { return (((size_t)l * 16 + (j >> 2)) * NKEYS + pos) * 4 + (j & 3); }
#define JOB_LOOP(t, ntiles, base) for (int t = (int)(((long)BIDX - ((base) % (long)gridDim.x) + gridDim.x) % gridDim.x); t < (ntiles); t += gridDim.x)

__device__ __forceinline__ int rope_slot(int c) { return (c & 16) | ((c & 7) << 1) | ((c >> 3) & 1); }
template <int TNW>
__device__ void transpose_cvt_job(const float* __restrict__ src, bf16_t* __restrict__ dst, int K, int N, int Npad, char* smem, long& base, int rp = 0) {
  float* tile = (float*)smem;
  const int tk = K / 64, tn = Npad / TNW, nt = tk * tn;
  JOB_LOOP(t, nt, base) {
    const int k0 = (t % tk) * 64, n0 = (t / tk) * TNW;
    __syncthreads();
    f32x4 v[TNW / 32];
#pragma unroll
    for (int q = 0; q < TNW / 32; ++q) {
      const int e = TIDX + q * NTHREADS, i = e / (TNW / 4), j = (e % (TNW / 4)) * 4, n = n0 + j;
      v[q] = f32x4{0.f, 0.f, 0.f, 0.f};
      if (n < N) v[q] = *(const f32x4*)(src + (size_t)(k0 + i) * N + n);
    }
#pragma unroll
    for (int q = 0; q < TNW / 32; ++q) {
      const int e = TIDX + q * NTHREADS, i = e / (TNW / 4), j = (e % (TNW / 4)) * 4;
      tile[j * 65 + i] = v[q][0]; tile[(j + 1) * 65 + i] = v[q][1]; tile[(j + 2) * 65 + i] = v[q][2]; tile[(j + 3) * 65 + i] = v[q][3];
    }
    __syncthreads();
#pragma unroll
    for (int q = 0; q < TNW / 64; ++q) {
      const int e = TIDX + q * NTHREADS, j = e >> 3, i8 = (e & 7) * 8;
      const float* tr = tile + j * 65 + i8;
      const u32x4 o = {cvtpk(tr[0], tr[1]), cvtpk(tr[2], tr[3]), cvtpk(tr[4], tr[5]), cvtpk(tr[6], tr[7])};
      int n = n0 + j;
      if (rp && n < N) { const int hh = n / 96, jj = n - hh * 96; if (jj >= 64) n = hh * 96 + 64 + rope_slot(jj - 64); }
      *(u32x4*)(dst + (size_t)n * K + k0 + i8) = o;
    }
  }
  base += nt;
}

__device__ void stage_prep(const Params& p, char* smem) {
  long base = 0;
  for (int l = 0; l < 2; ++l) {
    transpose_cvt_job<256>(p.in[I_WIN] + (size_t)l * 1024 * DIN, (bf16_t*)(p.ws + OFF_WIN) + (size_t)l * DINP * 1024, 1024, DIN, DINP, smem, base);
    transpose_cvt_job<256>(p.in[I_WOUT] + (size_t)l * 1024 * 1024, (bf16_t*)(p.ws + OFF_WOUT) + (size_t)l * 1024 * 1024, 1024, 1024, 1024, smem, base);
    transpose_cvt_job<256>(p.in[I_WQB] + (size_t)l * 384 * 576, (bf16_t*)(p.ws + OFF_WQB) + (size_t)l * 768 * 384, 384, 576, 768, smem, base, 1);
    transpose_cvt_job<256>(p.in[I_WKVB] + (size_t)l * 256 * 768, (bf16_t*)(p.ws + OFF_WKVB) + (size_t)l * 768 * 256, 256, 768, 768, smem, base);
    transpose_cvt_job<256>(p.in[I_PWQ] + (size_t)l * 1024 * 2048, (bf16_t*)(p.ws + OFF_WPQ) + (size_t)l * 2048 * 1024, 1024, 2048, 2048, smem, base);
    for (int d = 0; d < 2; ++d) for (int n = 0; n < 6; ++n) {
      const size_t so = ((size_t)(l * 2 + d) * 6 + n) * 4096;
      transpose_cvt_job<64>(p.in[I_LWR] + so, (bf16_t*)(p.ws + OFF_GW) + ((size_t)((l * 2 + d) * 2 + 0) * 6 + n) * 4096, 64, 64, 64, smem, base);
      transpose_cvt_job<64>(p.in[I_LWI] + so, (bf16_t*)(p.ws + OFF_GW) + ((size_t)((l * 2 + d) * 2 + 1) * 6 + n) * 4096, 64, 64, 64, smem, base);
    }
  }
  {
    const float* src = p.in[I_PKEYS]; bf16_t* dst = (bf16_t*)(p.ws + OFF_KEYS);
    for (int e = BIDX * NTHREADS + TIDX; e < 2 * 2 * 128 * 128; e += gridDim.x * NTHREADS) dst[e] = f2bf(src[e]);
  }
  {
    float* modp = (float*)(p.ws + OFF_MODP);
    const float* cp = p.in[I_C]; const float* ccp = p.in[I_CCTX]; const float* wmod = p.in[I_WMOD];
    JOB_LOOP(it, 192, base) {
      const int l = it / 96, ks = (it % 96) / 3, cgp = it % 3;
      const int col = cgp * 2048 + TIDX * 4;
      const float* w = wmod + (size_t)l * 1024 * 6144 + (size_t)(ks * 32) * 6144 + col;
      f32x4 a0 = {0.f, 0.f, 0.f, 0.f}, a1 = a0, a2 = a0;
#pragma unroll
      for (int k0 = 0; k0 < 32; k0 += 16) {
        f32x4 wv[16];
#pragma unroll
        for (int j = 0; j < 16; ++j) wv[j] = *(const f32x4*)(w + (size_t)(k0 + j) * 6144);
#pragma unroll
        for (int j = 0; j < 16; ++j) {
          const int k = ks * 32 + k0 + j;
          const float c0 = cp[k], c1 = cp[1024 + k], c2 = ccp[k];
          const float s0 = c0 * sigm(c0), s1 = c1 * sigm(c1), s2 = c2 * sigm(c2);
          a0 += s0 * wv[j]; a1 += s1 * wv[j]; a2 += s2 * wv[j];
        }
      }
      float* o = modp + ((size_t)(l * 32 + ks) * 3) * 6144 + col;
      *(f32x4*)o = a0; *(f32x4*)(o + 6144) = a1; *(f32x4*)(o + 2 * 6144) = a2;
    }
    base += 192;
  }
  {
    const int lane = TIDX & 63, wid = TIDX >> 6;
    const float* hw1 = p.in[I_HW1]; const float* hb1 = p.in[I_HB1]; const float* hw2 = p.in[I_HW2]; const float* hb2 = p.in[I_HB2]; const float* hfr = p.in[I_HFREQ];
    constexpr float INV2PI = 0.15915494309189535f;
    for (int it = BIDX * 8 + wid; it < 2 * NKEYS / 4; it += gridDim.x * 8) {
      const int l = it / (NKEYS / 4), pos0 = (it % (NKEYS / 4)) * 4;
      const float* w1 = hw1 + (size_t)l * 17 * 64; const float* w2 = hw2 + (size_t)l * 64 * 64;
      const float fr = hfr[l * 64 + lane], b1v = hb1[l * 64 + lane], b2v = hb2[l * 64 + lane];
      float w1v[17];
#pragma unroll
      for (int i = 0; i < 17; ++i) w1v[i] = w1[i * 64 + lane];
      float h1[4], pre2[4];
#pragma unroll
      for (int j = 0; j < 4; ++j) {
        const int pos = pos0 + j;
        const float tn = (pos < SEQ) ? (float)pos / (float)SEQ : (float)(pos - SEQ) / (float)CTXL;
        float pre = b1v + tn * w1v[0];
#pragma unroll
        for (int i = 0; i < 8; ++i) {
          const float band = 1e-4f + (float)i * ((7.f - 1e-4f) / 7.f);
          const float rev = tn * band;
          pre += __builtin_amdgcn_cosf(rev) * w1v[1 + i] + __builtin_amdgcn_sinf(rev) * w1v[9 + i];
        }
        h1[j] = __builtin_amdgcn_sinf(fr * pre * INV2PI);
        pre2[j] = b2v;
      }
#pragma unroll 16
      for (int i = 0; i < 64; ++i) {
        const float wv = w2[i * 64 + lane];
#pragma unroll
        for (int j = 0; j < 4; ++j) pre2[j] += rdl(h1[j], i) * wv;
      }
#pragma unroll
      for (int j = 0; j < 4; ++j) ((float*)(p.ws + OFF_H2))[h2idx(l, pos0 + j, lane)] = __builtin_amdgcn_sinf(fr * pre2[j] * INV2PI);
    }
  }
}

struct cf { float x, y; };
__device__ __forceinline__ cf cmul(cf a, cf b) { return {a.x * b.x - a.y * b.y, a.x * b.y + a.y * b.x}; }
__device__ __forceinline__ cf opq(cf v) { asm("" : "+v"(v.x), "+v"(v.y)); return v; }
template <bool INV> __device__ __forceinline__ cf twid(float frac) {
  const float c = __builtin_amdgcn_cosf(frac), s = __builtin_amdgcn_sinf(frac); return {c, INV ? s : -s};
}
template <bool INV> __device__ __forceinline__ void r4(cf& a, cf& b, cf& c, cf& d) {
  const cf s0 = {a.x + c.x, a.y + c.y}, s1 = {a.x - c.x, a.y - c.y}, s2 = {b.x + d.x, b.y + d.y}, s3 = {b.x - d.x, b.y - d.y};
  a = {s0.x + s2.x, s0.y + s2.y}; c = {s0.x - s2.x, s0.y - s2.y};
  if (!INV) { b = {s1.x + s3.y, s1.y - s3.x}; d = {s1.x - s3.y, s1.y + s3.x}; }
  else      { b = {s1.x - s3.y, s1.y + s3.x}; d = {s1.x + s3.y, s1.y - s3.x}; }
}
template <bool INV> __device__ __forceinline__ cf cj(cf w) { return {w.x, INV ? -w.y : w.y}; }
template <bool INV> __device__ __forceinline__ void dft16(cf* x) {
#pragma unroll
  for (int m0 = 0; m0 < 4; ++m0) r4<INV>(x[m0], x[4 + m0], x[8 + m0], x[12 + m0]);
  const cf W1 = {0.92387953251128674f, -0.38268343236508977f}, W2 = {0.70710678118654752f, -0.70710678118654752f}, W3 = {0.38268343236508977f, -0.92387953251128674f};
  const cf W4 = {0.f, -1.f}, W6 = {-0.70710678118654752f, -0.70710678118654752f}, W9 = {-0.92387953251128674f, 0.38268343236508977f};
  x[5] = cmul(x[5], cj<INV>(W1)); x[6] = cmul(x[6], cj<INV>(W2)); x[7] = cmul(x[7], cj<INV>(W3));
  x[9] = cmul(x[9], cj<INV>(W2)); x[10] = cmul(x[10], cj<INV>(W4)); x[11] = cmul(x[11], cj<INV>(W6));
  x[13] = cmul(x[13], cj<INV>(W3)); x[14] = cmul(x[14], cj<INV>(W6)); x[15] = cmul(x[15], cj<INV>(W9));
#pragma unroll
  for (int q0 = 0; q0 < 4; ++q0) r4<INV>(x[4 * q0], x[4 * q0 + 1], x[4 * q0 + 2], x[4 * q0 + 3]);
}
template <bool INV> __device__ __forceinline__ void dft8(cf* x) {
#pragma unroll
  for (int m0 = 0; m0 < 4; ++m0) { const cf a = x[m0], b = x[4 + m0]; x[m0] = {a.x + b.x, a.y + b.y}; x[4 + m0] = {a.x - b.x, a.y - b.y}; }
  const cf V1 = {0.70710678118654752f, -0.70710678118654752f}, V2 = {0.f, -1.f}, V3 = {-0.70710678118654752f, -0.70710678118654752f};
  x[5] = cmul(x[5], cj<INV>(V1)); x[6] = cmul(x[6], cj<INV>(V2)); x[7] = cmul(x[7], cj<INV>(V3));
  r4<INV>(x[0], x[1], x[2], x[3]); r4<INV>(x[4], x[5], x[6], x[7]);
}
template <bool COL> __device__ __forceinline__ int fidx(int ln, int i) { return COL ? i * 129 + ln : ln * 129 + i; }
template <bool INV, bool COL> __device__ __forceinline__ void fft_passA(cf* buf) {
  cf x[2][16];
#pragma unroll
  for (int it = 0; it < 2; ++it) {
    const int bf = TIDX + NTHREADS * it, ln = bf & 127, j = bf >> 7;
#pragma unroll
    for (int m = 0; m < 16; ++m) x[it][m] = buf[fidx<COL>(ln, j + 8 * m)];
  }
#pragma unroll
  for (int it = 0; it < 2; ++it) {
    const int bf = TIDX + NTHREADS * it, ln = bf & 127, j = bf >> 7;
    if (!INV) {
      dft16<false>(x[it]);
#pragma unroll
      for (int q = 0; q < 16; ++q) buf[fidx<COL>(ln, j + 8 * q)] = opq(cmul(x[it][4 * (q & 3) + (q >> 2)], twid<false>((float)(q * j) * (1.f / 128.f))));
    } else {
#pragma unroll
      for (int q = 0; q < 16; ++q) x[it][q] = cmul(x[it][q], twid<true>((float)(q * j) * (1.f / 128.f)));
      dft16<true>(x[it]);
#pragma unroll
      for (int m = 0; m < 16; ++m) buf[fidx<COL>(ln, j + 8 * m)] = opq(x[it][4 * (m & 3) + (m >> 2)]);
    }
  }
}
template <bool INV, bool COL> __device__ __forceinline__ void fft_passB(cf* buf) {
  cf x[4][8];
#pragma unroll
  for (int it = 0; it < 4; ++it) {
    const int bf = TIDX + NTHREADS * it, ln = bf & 127, B = bf >> 7;
#pragma unroll
    for (int m = 0; m < 8; ++m) x[it][m] = buf[fidx<COL>(ln, 8 * B + m)];
  }
#pragma unroll
  for (int it = 0; it < 4; ++it) {
    const int bf = TIDX + NTHREADS * it, ln = bf & 127, B = bf >> 7;
    if (!INV) {
      dft8<false>(x[it]);
#pragma unroll
      for (int q = 0; q < 8; ++q) {
        cf v = x[it][4 * (q & 1) + (q >> 1)];
        if (COL) v = cmul(v, twid<false>((float)(ln * (B + 16 * q)) * (1.f / 16384.f)));
        buf[fidx<COL>(ln, 8 * B + q)] = opq(v);
      }
    } else {
#pragma unroll
      for (int q = 0; q < 8; ++q) {
        if (COL) x[it][q] = cmul(x[it][q], twid<true>((float)(ln * (B + 16 * q)) * (1.f / 16384.f)));
      }
      dft8<true>(x[it]);
#pragma unroll
      for (int m = 0; m < 8; ++m) buf[fidx<COL>(ln, 8 * B + m)] = opq(x[it][4 * (m & 1) + (m >> 1)]);
    }
  }
}
__device__ __forceinline__ void fft_fwd(cf* buf) {
  fft_passA<false, true>(buf); __syncthreads(); fft_passB<false, true>(buf); __syncthreads();
  fft_passA<false, false>(buf); __syncthreads(); fft_passB<false, false>(buf); __syncthreads();
}
__device__ __forceinline__ void fft_inv(cf* buf) {
  fft_passB<true, false>(buf); __syncthreads(); fft_passA<true, false>(buf); __syncthreads();
  fft_passB<true, true>(buf); __syncthreads(); fft_passA<true, true>(buf); __syncthreads();
}
__device__ __forceinline__ int fft_freq(int r, int c) { return ((r >> 3) + 16 * (r & 7)) + 128 * ((c >> 3) + 16 * (c & 7)); }
__device__ __forceinline__ int fft_pos(int k) {
  const int k1 = k & 127, k2 = k >> 7; return (8 * (k1 & 15) + (k1 >> 4)) * 129 + 8 * (k2 & 15) + (k2 >> 4);
}
constexpr int FFT_LDS = 128 * 129 * 8;

__device__ void hyena_spectra(const Params& p, char* smem) {
  cf* buf = (cf*)smem; float* fb = (float*)smem;
  float* w3s = (float*)(smem + FFT_LDS);
  float* red = w3s + 256;
  const int tid = TIDX, lane = tid & 63, wid = tid >> 6;
  for (int unit = BIDX; unit < 512; unit += gridDim.x) {
    const int l = unit >> 8, c = unit & 255;
    __syncthreads();
    if (tid < 256) { const int i = tid >> 2, j = tid & 3; w3s[tid] = p.in[I_HW3][(size_t)l * 64 * 1024 + (size_t)i * 1024 + j * 256 + c]; }
    if (tid == 0) buf[64 * 129] = cf{0.f, 0.f};
    __syncthreads();
    float dec[4], ss[4];
#pragma unroll
    for (int j = 0; j < 4; ++j) { dec[j] = p.in[I_HDECAY][l * 1024 + j * 256 + c]; ss[j] = 0.f; }
    const float* h2 = (const float*)(p.ws + OFF_H2) + (size_t)l * 16 * NKEYS * 4;
#pragma unroll 1
    for (int half = 0; half < 2; ++half) {
      float acc[8][4];
#pragma unroll
      for (int i = 0; i < 8; ++i) { acc[i][0] = 0.f; acc[i][1] = 0.f; acc[i][2] = 0.f; acc[i][3] = 0.f; }
      const f32x4* hr = (const f32x4*)h2 + tid + half * 8 * NTHREADS;
#pragma unroll 1
      for (int kc = 0; kc < 8; ++kc) {
        float w[8][4];
#pragma unroll
        for (int kk = 0; kk < 8; ++kk)
#pragma unroll
          for (int j = 0; j < 4; ++j) w[kk][j] = __int_as_float(__builtin_amdgcn_readfirstlane(__float_as_int(w3s[(kc * 8 + kk) * 4 + j])));
#pragma unroll
        for (int i = 0; i < 8; ++i) {
          const f32x4 h0 = hr[(size_t)(kc * 2) * NKEYS + NTHREADS * i], h1 = hr[(size_t)(kc * 2 + 1) * NKEYS + NTHREADS * i];
#pragma unroll
          for (int kk = 0; kk < 4; ++kk)
#pragma unroll
            for (int j = 0; j < 4; ++j) { acc[i][j] += h0[kk] * w[kk][j]; acc[i][j] += h1[kk] * w[4 + kk][j]; }
        }
      }
#pragma unroll
      for (int i = 0; i < 8; ++i) {
        const int t = tid + NTHREADS * (half * 8 + i);
        float a[4] = {acc[i][0], acc[i][1], acc[i][2], acc[i][3]};
        const float tn = (float)t * (1.f / (float)SEQ);
#pragma unroll
        for (int j = 0; j < 4; ++j) { a[j] *= __expf(-tn * dec[j]); ss[j] += a[j] * a[j]; }
        const int pf = (t >> 7) * 129 + (t & 127);
        fb[2 * pf] = a[0]; fb[2 * pf + 1] = a[2];
        if (t > 0) { const int n = 16384 - t, pb = (n >> 7) * 129 + (n & 127); fb[2 * pb] = a[1]; fb[2 * pb + 1] = a[3]; }
      }
    }
#pragma unroll
    for (int j = 0; j < 4; ++j) { ss[j] = wave_sum(ss[j]); if (lane == 0) red[wid * 4 + j] = ss[j]; }
    __syncthreads();
    float sc[4];
#pragma unroll
    for (int j = 0; j < 4; ++j) { float s = 0.f; for (int w = 0; w < 8; ++w) s += red[w * 4 + j]; sc[j] = rsqrtf(s + EPSV) * (1.f / 16384.f); }
    const float sk0 = p.in[I_HSKIP][l * 512 + c] * (1.f / 16384.f), sk1 = p.in[I_HSKIP][l * 512 + 256 + c] * (1.f / 16384.f);
    for (int i = 0; i < 32; ++i) {
      const int n = tid + NTHREADS * i, pi = (n >> 7) * 129 + (n & 127);
      cf v = buf[pi];
      if (n < 8192) { v.x *= sc[0]; v.y *= sc[2]; } else { v.x *= sc[1]; v.y *= sc[3]; }
      if (n == 0) { v.x += sk0; v.y += sk1; }
      buf[pi] = v;
    }
    __syncthreads();
    fft_fwd(buf);
    unsigned* hs = (unsigned*)(p.ws + OFF_HSPEC) + ((size_t)(l * 256 + c) * 2) * 16384;
    for (int i = 0; i < 32; ++i) {
      const int e = tid + NTHREADS * i, r = e >> 7, cc = e & 127;
      const int k = fft_freq(r, cc), k2 = (16384 - k) & 16383;
      const cf a = buf[r * 129 + cc], b = buf[fft_pos(k2)];
      hs[e] = cvtpk(0.5f * (a.x + b.x), 0.5f * (a.y - b.y));
      hs[16384 + e] = cvtpk(0.5f * (a.y + b.y), -0.5f * (a.x - b.x));
    }
  }
}

__device__ void hyena_fft(const Params& p, int layer, char* smem) {
  cf* buf = (cf*)smem;
  const int tid = TIDX;
  bf16_t* mix = (bf16_t*)(p.ws + OFF_MIX);
  const float* hin = (const float*)(p.ws + OFF_HYIN);
  for (int unit = (int)gridDim.x - 1 - BIDX; unit < 256; unit += gridDim.x) {
    const int c = unit;
    const unsigned* hs = (const unsigned*)(p.ws + OFF_HSPEC) + ((size_t)(layer * 256 + c) * 2) * 16384;
    __syncthreads();
    {
      const float* z0 = hin + ((size_t)(0 * 2 + 0) * 256 + c) * SEQ; const float* z1 = hin + ((size_t)(0 * 2 + 1) * 256 + c) * SEQ;
      for (int i = 0; i < 16; ++i) { const int t = tid + NTHREADS * i; buf[(t >> 7) * 129 + (t & 127)] = cf{z0[t], z1[t]}; }
      for (int i = 0; i < 16; ++i) { const int t = 8192 + tid + NTHREADS * i; buf[(t >> 7) * 129 + (t & 127)] = cf{0.f, 0.f}; }
    }
    __syncthreads();
    for (int order = 0; order < 2; ++order) {
      fft_fwd(buf);
      for (int i = 0; i < 32; ++i) {
        const int e = tid + NTHREADS * i, pi = (e >> 7) * 129 + (e & 127);
        const unsigned hv = hs[order * 16384 + e];
        const cf h = {__uint_as_float(hv << 16), __uint_as_float(hv & 0xffff0000u)};
        buf[pi] = cmul(buf[pi], h);
      }
      __syncthreads();
      fft_inv(buf);
      const float* x0 = hin + ((size_t)((1 + order) * 2 + 0) * 256 + c) * SEQ; const float* x1 = hin + ((size_t)((1 + order) * 2 + 1) * 256 + c) * SEQ;
      if (order == 0) {
        for (int i = 0; i < 16; ++i) { const int t = tid + NTHREADS * i, pi = (t >> 7) * 129 + (t & 127); const cf v = buf[pi]; buf[pi] = cf{v.x * x0[t], v.y * x1[t]}; }
        for (int i = 0; i < 16; ++i) { const int t = 8192 + tid + NTHREADS * i; buf[(t >> 7) * 129 + (t & 127)] = cf{0.f, 0.f}; }
        __syncthreads();
      } else {
        bf16_t* yc = (bf16_t*)(p.ws + OFF_HB);
        for (int i = 0; i < 8; ++i) {
          const int t = 2 * (tid + NTHREADS * i); const cf v0 = buf[(t >> 7) * 129 + (t & 127)], v1 = buf[(t >> 7) * 129 + (t & 127) + 1];
          *(unsigned*)(yc + ((size_t)(0 * 256 + c)) * SEQ + t) = cvtpk(v0.x * x0[t], v1.x * x0[t + 1]);
          *(unsigned*)(yc + ((size_t)(1 * 256 + c)) * SEQ + t) = cvtpk(v0.y * x1[t], v1.y * x1[t + 1]);
        }
      }
    }
  }
}

__device__ void stage_prep2(const Params& p, char* smem) {
  {
    float* mod = (float*)(p.ws + OFF_MOD); const float* modp = (const float*)(p.ws + OFF_MODP);
    for (int e = BIDX * NTHREADS + TIDX; e < 2 * 3 * 6144; e += gridDim.x * NTHREADS) {
      const int l = e / (3 * 6144), w = (e / 6144) % 3, col = e % 6144;
      float s = p.in[I_BMOD][l * 6144 + col];
      for (int ks = 0; ks < 32; ++ks) s += modp[((size_t)(l * 32 + ks) * 3 + w) * 6144 + col];
      mod[e] = s;
    }
  }
  float* h2t = (float*)smem;
  float* w3t = h2t + 64 * 65;
  const int tloc = TIDX & 63, cgp = TIDX >> 6, lane = TIDX & 63;
  for (int it = BIDX; it < 2 * 4 * 16; it += gridDim.x) {
    const int l = it / (4 * 16), tt = 128 + (it / 16) % 4, ct = it % 16;
    const bool isc = tt >= 128; const int L = isc ? CTXL : SEQ; const int t0 = isc ? (tt - 128) * 64 : tt * 64;
    const int pos0 = isc ? SEQ + t0 : t0;
    const float* h2 = (const float*)(p.ws + OFF_H2);
    const float* w3 = p.in[I_HW3] + (size_t)l * 64 * 1024 + ct * 64;
    __syncthreads();
    for (int e = TIDX; e < 4096; e += NTHREADS) { int i = e >> 6, j = e & 63; h2t[i * 65 + j] = h2[h2idx(l, pos0 + i, j)]; w3t[i * 64 + j] = w3[(size_t)i * 1024 + j]; }
    __syncthreads();
    float acc[8];
#pragma unroll
    for (int cc = 0; cc < 8; ++cc) acc[cc] = 0.f;
#pragma unroll 2
    for (int i = 0; i < 64; ++i) {
      const float hv = h2t[tloc * 65 + i];
#pragma unroll
      for (int cc = 0; cc < 8; ++cc) acc[cc] += hv * w3t[i * 64 + cgp * 8 + cc];
    }
    const float tn = (float)(t0 + tloc) / (float)L;
#pragma unroll
    for (int cc = 0; cc < 8; ++cc) {
      const int col = ct * 64 + cgp * 8 + cc;
      const float val = acc[cc] * __expf(-tn * p.in[I_HDECAY][l * 1024 + col]);
      ((float*)(p.ws + OFF_FILTC))[((size_t)l * 1024 + col) * CTXL + t0 + tloc] = val;
      const float s = wave_sum(val * val);
      if (lane == 0) ((float*)(p.ws + OFF_SSQPC))[((size_t)l * 4 + (tt - 128)) * 1024 + col] = s;
    }
  }
  hyena_spectra(p, smem);
}

__device__ void stage_norm(const Params& p, int layer, int which  , int nrows) {
  const int lane = TIDX & 63, wid = TIDX >> 6;
  const float* g = (which ? p.in[I_N2G] : p.in[I_N1G]) + layer * DM;
  bf16_t* hb = (bf16_t*)(p.ws + OFF_HB);
  const int ngrp = nrows / 4, gstride = gridDim.x * 8;
  int grp = BIDX * 8 + wid;
  f32x4 v[4][4], vn[4][4];
  auto rowsrc = [&](int r0) -> const float* { return (which == 0) ? xrow_src(p, layer, r0) : (const float*)(p.ws + OFF_XS) + (size_t)r0 * DM; };
  if (grp < ngrp) {
    const float* src = rowsrc(grp * 4);
#pragma unroll
    for (int j = 0; j < 4; ++j)
#pragma unroll
      for (int i = 0; i < 2; ++i) { v[j][2 * i] = *(const f32x4*)(src + (size_t)j * DM + i * 512 + lane * 8); v[j][2 * i + 1] = *(const f32x4*)(src + (size_t)j * DM + i * 512 + lane * 8 + 4); }
  }
  for (; grp < ngrp; grp += gstride) {
    const int r0 = grp * 4, gn = grp + gstride;
    if (gn < ngrp) {
      const float* src = rowsrc(gn * 4);
#pragma unroll
      for (int j = 0; j < 4; ++j)
#pragma unroll
        for (int i = 0; i < 2; ++i) { vn[j][2 * i] = *(const f32x4*)(src + (size_t)j * DM + i * 512 + lane * 8); vn[j][2 * i + 1] = *(const f32x4*)(src + (size_t)j * DM + i * 512 + lane * 8 + 4); }
    }
    int b, t, isc; row_info(r0, b, t, isc);
    const float* mod = (const float*)(p.ws + OFF_MOD) + ((size_t)layer * 3 + (isc ? 2 : b)) * 6144 + (which ? 3072 : 0);
    float ss[4];
#pragma unroll
    for (int j = 0; j < 4; ++j) {
      float s = 0.f;
#pragma unroll
      for (int i = 0; i < 4; ++i) s += v[j][i][0] * v[j][i][0] + v[j][i][1] * v[j][i][1] + v[j][i][2] * v[j][i][2] + v[j][i][3] * v[j][i][3];
      ss[j] = s;
    }
#pragma unroll
    for (int j = 0; j < 4; ++j) ss[j] = rsqrtf(wave_sum(ss[j]) * (1.f / DM) + EPSV);
#pragma unroll
    for (int i = 0; i < 2; ++i) {
      const int c0 = i * 512 + lane * 8;
      const f32x4 g0 = *(const f32x4*)(g + c0), g1 = *(const f32x4*)(g + c0 + 4);
      const f32x4 sc0 = *(const f32x4*)(mod + 1024 + c0), sc1 = *(const f32x4*)(mod + 1024 + c0 + 4), sh0 = *(const f32x4*)(mod + c0), sh1 = *(const f32x4*)(mod + c0 + 4);
#pragma unroll
      for (int j = 0; j < 4; ++j) {
        float y[8];
#pragma unroll
        for (int q = 0; q < 4; ++q) { y[q] = v[j][2 * i][q] * ss[j] * g0[q] * (1.f + sc0[q]) + sh0[q]; y[4 + q] = v[j][2 * i + 1][q] * ss[j] * g1[q] * (1.f + sc1[q]) + sh1[q]; }
        const u32x4 o = {cvtpk(y[0], y[1]), cvtpk(y[2], y[3]), cvtpk(y[4], y[5]), cvtpk(y[6], y[7])};
        *(u32x4*)(hb + (size_t)(r0 + j) * DM + c0) = o;
      }
    }
#pragma unroll
    for (int j = 0; j < 4; ++j)
#pragma unroll
      for (int i = 0; i < 4; ++i) v[j][i] = vn[j][i];
  }
}

template <class Epi>
__device__ void gemm_bt(const bf16_t* __restrict__ A, int lda, const bf16_t* __restrict__ Bt, int ldb, int M, int N, int K, Epi epi, char* smem) {
  const int tid = TIDX, wid = tid >> 6, lane = tid & 63, r32 = lane & 31, hi = lane >> 5;
  const int wm = wid >> 2, wn = wid & 3;
  constexpr int RS = 144;
  char* sA = smem; char* sB = smem + 128 * RS;
  const int tilesM = M / 128, tilesN = N / 128, nk = K / 64;
  const int lr0 = tid >> 3, lc = (tid & 7) * 8;
  for (int tile = BIDX; tile < tilesM * tilesN; tile += gridDim.x) {
    const int tm = tile / tilesN, tn = tile % tilesN;
    const bf16_t* Ap = A + (size_t)(tm * 128 + lr0) * lda + lc;
    const bf16_t* Bp = Bt + (size_t)(tn * 128 + lr0) * ldb + lc;
    f32x16 acc0 = {}, acc1 = {};
    u32x4 ra0 = *(const u32x4*)Ap, ra1 = *(const u32x4*)(Ap + (size_t)64 * lda);
    u32x4 rb0 = *(const u32x4*)Bp, rb1 = *(const u32x4*)(Bp + (size_t)64 * ldb);
    for (int kt = 0; kt < nk; ++kt) {
      __syncthreads();
      *(u32x4*)(sA + lr0 * RS + lc * 2) = ra0; *(u32x4*)(sA + (lr0 + 64) * RS + lc * 2) = ra1;
      *(u32x4*)(sB + lr0 * RS + lc * 2) = rb0; *(u32x4*)(sB + (lr0 + 64) * RS + lc * 2) = rb1;
      __syncthreads();
      if (kt + 1 < nk) {
        const int ko = (kt + 1) * 64;
        ra0 = *(const u32x4*)(Ap + ko); ra1 = *(const u32x4*)(Ap + (size_t)64 * lda + ko);
        rb0 = *(const u32x4*)(Bp + ko); rb1 = *(const u32x4*)(Bp + (size_t)64 * ldb + ko);
      }
#pragma unroll
      for (int ks = 0; ks < 4; ++ks) {
        const int cb = (ks * 16 + hi * 8) * 2;
        const bf16x8 a0 = *(const bf16x8*)(sA + (wm * 64 + r32) * RS + cb);
        const bf16x8 a1 = *(const bf16x8*)(sA + (wm * 64 + 32 + r32) * RS + cb);
        const bf16x8 bb = *(const bf16x8*)(sB + (wn * 32 + r32) * RS + cb);
        acc0 = __builtin_amdgcn_mfma_f32_32x32x16_bf16(a0, bb, acc0, 0, 0, 0);
        acc1 = __builtin_amdgcn_mfma_f32_32x32x16_bf16(a1, bb, acc1, 0, 0, 0);
      }
    }
    const int col = tn * 128 + wn * 32 + r32;
#pragma unroll
    for (int r = 0; r < 16; ++r) {
      epi(tm * 128 + wm * 64 + crow(r, hi), col, acc0[r]);
      epi(tm * 128 + wm * 64 + 32 + crow(r, hi), col, acc1[r]);
    }
  }
}

__device__ __forceinline__ float rope_apply(float x, float xp, int c, int t) {
  const int i = c & 7; const float pos = ((c >> 4) & 1) ? (float)(t & 63) : (float)(t >> 6);
  const float inv = __expf(-(float)i * (9.210340371976184f / 8.f));
  const float rev = (pos * inv) * 0.15915494309189535f;
  const float cs = __builtin_amdgcn_cosf(rev), sn = __builtin_amdgcn_sinf(rev);
  return x * cs + ((c & 8) ? xp : -xp) * sn;
}

constexpr int NCH32 = NTOK / 32;
__device__ __forceinline__ float swap32(float v, int hi) { const auto rr = __builtin_amdgcn_permlane32_swap(__float_as_uint(v), __float_as_uint(v), false, false); return __uint_as_float(hi ? rr[0] : rr[1]); }
template <bool BWD>
__device__ __forceinline__ void lru_seg_scan(const float* a, const float* b, int hi, float S, float* h, float& Sout) {
  float P[4], H[4], Sin[4];
#pragma unroll
  for (int g = 0; g < 4; ++g) {
    if (!BWD) { H[g] = b[4 * g]; P[g] = a[4 * g];
#pragma unroll
      for (int q = 1; q < 4; ++q) { H[g] = a[4 * g + q] * H[g] + b[4 * g + q]; P[g] *= a[4 * g + q]; } }
    else { H[g] = b[4 * g + 3]; P[g] = a[4 * g + 3];
#pragma unroll
      for (int q = 2; q >= 0; --q) { H[g] = a[4 * g + q] * H[g] + b[4 * g + q]; P[g] *= a[4 * g + q]; } }
    Sin[g] = 0.f;
  }
#pragma unroll
  for (int step = 0; step < 8; ++step) {
    const int s = BWD ? 7 - step : step, g = s >> 1, owner = s & 1;
    const bool mine = (hi == owner);
    if (mine) Sin[g] = S;
    const float cand = P[g] * S + H[g];
    const float other = swap32(cand, hi);
    S = mine ? cand : other;
  }
  Sout = S;
#pragma unroll
  for (int g = 0; g < 4; ++g) {
    float hp = Sin[g];
    if (!BWD) {
#pragma unroll
      for (int q = 0; q < 4; ++q) { hp = a[4 * g + q] * hp + b[4 * g + q]; h[4 * g + q] = hp; } }
    else {
#pragma unroll
      for (int q = 3; q >= 0; --q) { hp = a[4 * g + q] * hp + b[4 * g + q]; h[4 * g + q] = hp; } }
  }
}
__device__ void lru_units(const Params& p, int layer, int mode, char* smem) {
  const int tid = TIDX, wid = tid >> 6, lane = tid & 63, r32 = lane & 31, hi = lane >> 5;
  const bf16_t* u = (const bf16_t*)(p.ws + OFF_U);
  const float* cw = p.in[I_LCW] + (size_t)layer * 4 * DLRU; const float* cbias = p.in[I_LCB] + layer * DLRU;
  bf16_t* mix = (bf16_t*)(p.ws + OFF_MIX);
  constexpr int RS = 272;
  char* tile = smem + wid * (35 * RS);
  const int bid = BIDX, n = bid % 6, rk = bid / 6, nbn = ((int)gridDim.x - n + 5) / 6;
  char* gwl = smem + 8 * 35 * RS;
  __syncthreads();
  for (int i = tid; i < 2048; i += NTHREADS) {
    const int mat = i >> 9, row = (i >> 3) & 63, c = i & 7;
    const bf16_t* gsrc = (const bf16_t*)(p.ws + OFF_GW) + ((size_t)((layer * 2 + (mat >> 1)) * 2 + (mat & 1)) * 6 + n) * 4096 + row * 64 + c * 8;
    *(u32x4*)(gwl + mat * 8192 + row * 128 + ((c ^ (row & 7)) << 4)) = *(const u32x4*)gsrc;
  }
  __syncthreads();
  for (int cid = rk * 8 + wid; cid < NCH32; cid += nbn * 8) {
    const int unit = cid * 6 + n;
    int rbase, t0, slen;
    if (cid < 512) { const int b = cid >> 8; rbase = b * SEQ; t0 = (cid & 255) * 32; slen = SEQ; }
    else { const int q = cid - 512, b = q >> 3; rbase = NLAT + b * CTXL; t0 = (q & 7) * 32; slen = CTXL; }
    {
      const int row8 = lane >> 3, c8 = lane & 7;
      const bf16_t* ub = u + (size_t)rbase * DIN + n * 64 + c8 * 8;
#pragma unroll
      for (int i = 0; i < 5; ++i) {
        const int row = i * 8 + row8, t = t0 + row - 2;
        if (row < 35) {
          u32x4 v = {0u, 0u, 0u, 0u};
          if (t >= 0 && t < slen) v = *(const u32x4*)(ub + (size_t)t * DIN);
          const f32x4 lo = {__uint_as_float(v[0] << 16), __uint_as_float(v[0] & 0xffff0000u), __uint_as_float(v[1] << 16), __uint_as_float(v[1] & 0xffff0000u)};
          const f32x4 hi4 = {__uint_as_float(v[2] << 16), __uint_as_float(v[2] & 0xffff0000u), __uint_as_float(v[3] << 16), __uint_as_float(v[3] & 0xffff0000u)};
          *(f32x4*)(tile + row * RS + c8 * 32) = lo; *(f32x4*)(tile + row * RS + c8 * 32 + 16) = hi4;
        }
      }
    }
    bf16x8 af[4];
    {
      const char* tl = tile + r32 * RS + hi * 32;
#pragma unroll
      for (int ks = 0; ks < 4; ++ks) {
        const int col = n * 64 + ks * 16 + 8 * hi;
        f32x4 c0 = *(const f32x4*)(cbias + col), c1 = *(const f32x4*)(cbias + col + 4);
#pragma unroll
        for (int k = 0; k < 4; ++k) {
          const f32x4 x0 = *(const f32x4*)(tl + k * RS + ks * 64), x1 = *(const f32x4*)(tl + k * RS + ks * 64 + 16);
          const f32x4 w0 = *(const f32x4*)(cw + k * DLRU + col), w1 = *(const f32x4*)(cw + k * DLRU + col + 4);
          c0 += w0 * x0; c1 += w1 * x1;
        }
        const u32x4 pk = {cvtpk(c0[0], c0[1]), cvtpk(c0[2], c0[3]), cvtpk(c1[0], c1[1]), cvtpk(c1[2], c1[3])};
        af[ks] = *(const bf16x8*)&pk;
      }
    }
    float xo[2][16];
#pragma unroll
    for (int nt = 0; nt < 2; ++nt) {
      const int ch = n * 64 + nt * 32 + r32;
      const float w0 = cw[ch], w1 = cw[DLRU + ch], w2 = cw[2 * DLRU + ch], w3 = cw[3 * DLRU + ch], bb = cbias[ch];
      const char* tl = tile + (4 * hi) * RS + (nt * 32 + r32) * 4;
#pragma unroll
      for (int g = 0; g < 4; ++g) {
        float xr[7];
#pragma unroll
        for (int i = 0; i < 7; ++i) xr[i] = *(const float*)(tl + (8 * g + i) * RS);
#pragma unroll
        for (int q = 0; q < 4; ++q) xo[nt][4 * g + q] = bb + w0 * xr[q] + w1 * xr[q + 1] + w2 * xr[q + 2] + w3 * xr[q + 3];
      }
    }
    if (mode == 1) {
      const bf16_t* ub = u + (size_t)(rbase + t0) * DIN + DLRU + n * 64 + lane;
#pragma unroll 4
      for (int i = 0; i < 32; ++i) *(float*)(tile + i * RS + lane * 4) = bf2f(ub[(size_t)i * DIN]);
    }
#pragma unroll 1
    for (int nt = 0; nt < 2; ++nt) {
      const int ch = n * 64 + nt * 32 + r32;
      float hf[16];
#pragma unroll
      for (int dir = 0; dir < 2; ++dir) {
        const char* gwr = gwl + (dir * 2 + 0) * 8192 + (nt * 32 + r32) * 128;
        const char* gwi = gwl + (dir * 2 + 1) * 8192 + (nt * 32 + r32) * 128;
        f32x16 accR = {}, accI = {};
#pragma unroll
        for (int ks = 0; ks < 4; ++ks) {
          const int co = ((ks * 2 + hi) ^ (r32 & 7)) << 4;
          const bf16x8 br_ = *(const bf16x8*)(gwr + co), bi_ = *(const bf16x8*)(gwi + co);
          accR = __builtin_amdgcn_mfma_f32_32x32x16_bf16(af[ks], br_, accR, 0, 0, 0);
          accI = __builtin_amdgcn_mfma_f32_32x32x16_bf16(af[ks], bi_, accI, 0, 0, 0);
        }
        const size_t po = (size_t)(layer * 2 + dir) * DLRU + ch;
        const float brv = p.in[I_LBR][po], biv = p.in[I_LBI][po];
        const float cl = -8.f * __logf(1.f + __expf(-p.in[I_LLAM][po]));
        float a[16], bq[16];
#pragma unroll
        for (int r = 0; r < 16; ++r) {
          const float rr = __builtin_amdgcn_rcpf(1.f + __expf(-(accR[r] + brv))), ii = __builtin_amdgcn_rcpf(1.f + __expf(-(accI[r] + biv)));
          const float av = __expf(rr * cl);
          a[r] = av; bq[r] = __builtin_amdgcn_sqrtf(fmaxf(1.f - av * av, 0.f)) * (ii * (nt == 0 ? xo[0][r] : xo[1][r]));
        }
        if (mode == 0) {
          {
            u32x4* ab = (u32x4*)(p.ws + OFF_LAB) + ((((size_t)unit * 2 + nt) * 2 + dir) * 4) * 64 + lane;
#pragma unroll
            for (int r4 = 0; r4 < 4; ++r4) { const u32x4 o = {cvtpk(1.f - a[4 * r4], bq[4 * r4]), cvtpk(1.f - a[4 * r4 + 1], bq[4 * r4 + 1]), cvtpk(1.f - a[4 * r4 + 2], bq[4 * r4 + 2]), cvtpk(1.f - a[4 * r4 + 3], bq[4 * r4 + 3])}; ab[r4 * 64] = o; }
          }
          float hd[16], Send;
          if (dir == 0) lru_seg_scan<false>(a, bq, hi, 0.f, hd, Send); else lru_seg_scan<true>(a, bq, hi, 0.f, hd, Send);
          float pp = a[0];
#pragma unroll
          for (int r = 1; r < 16; ++r) pp *= a[r];
          pp *= swap32(pp, hi);
          if (hi == 0) { float* ls = (float*)(p.ws + OFF_LSUM) + ((size_t)(cid * 2 + dir) * 2) * DLRU + ch; ls[0] = pp; ls[DLRU] = Send; }
        } else {
          const float cin = ((const float*)(p.ws + OFF_CARRY))[(size_t)(cid * 2 + dir) * DLRU + ch];
          float Send;
          if (dir == 0) lru_seg_scan<false>(a, bq, hi, cin, hf, Send);
          else {
            float hb[16];
            lru_seg_scan<true>(a, bq, hi, cin, hb, Send);
            const char* tl = tile + (4 * hi) * RS + (nt * 32 + r32) * 4;
            bf16_t* mo = mix + ((size_t)rbase + t0 + 4 * hi) * DM + ch;
#pragma unroll
            for (int r = 0; r < 16; ++r) {
              const int tk = (r & 3) + 8 * (r >> 2);
              const float gt = *(const float*)(tl + tk * RS);
              mo[(size_t)tk * DM] = f2bf((hf[r] + hb[r]) * gelu_tanh(gt));
            }
          }
        }
      }
    }
  }
}

__device__ void lru_final(const Params& p, int layer, char* smem) {
  const int tid = TIDX, wid = tid >> 6, lane = tid & 63, r32 = lane & 31, hi = lane >> 5;
  const bf16_t* u = (const bf16_t*)(p.ws + OFF_U);
  bf16_t* mix = (bf16_t*)(p.ws + OFF_MIX);
  constexpr int RS = 272;
  char* tile = smem + wid * (35 * RS);
  __syncthreads();
  for (int unit = BIDX * 8 + wid; unit < NCH32 * 6; unit += gridDim.x * 8) {
    const int cid = unit / 6, n = unit % 6;
    int rbase, t0;
    if (cid < 512) { const int b = cid >> 8; rbase = b * SEQ; t0 = (cid & 255) * 32; }
    else { const int q = cid - 512, b = q >> 3; rbase = NLAT + b * CTXL; t0 = (q & 7) * 32; }
    unsigned ab[2][2][16];
#pragma unroll
    for (int nt = 0; nt < 2; ++nt)
#pragma unroll
      for (int dir = 0; dir < 2; ++dir) {
        const u32x4* abp = (const u32x4*)(p.ws + OFF_LAB) + ((((size_t)unit * 2 + nt) * 2 + dir) * 4) * 64 + lane;
#pragma unroll
        for (int r4 = 0; r4 < 4; ++r4) { const u32x4 v = abp[r4 * 64]; ab[nt][dir][4 * r4] = v[0]; ab[nt][dir][4 * r4 + 1] = v[1]; ab[nt][dir][4 * r4 + 2] = v[2]; ab[nt][dir][4 * r4 + 3] = v[3]; }
      }
    {
      const int row8 = lane >> 3, c8 = lane & 7;
      const bf16_t* ub = u + (size_t)(rbase + t0) * DIN + DLRU + n * 64 + c8 * 8;
#pragma unroll
      for (int i = 0; i < 4; ++i) {
        const int row = i * 8 + row8;
        const u32x4 v = *(const u32x4*)(ub + (size_t)row * DIN);
        const f32x4 lo = {__uint_as_float(v[0] << 16), __uint_as_float(v[0] & 0xffff0000u), __uint_as_float(v[1] << 16), __uint_as_float(v[1] & 0xffff0000u)};
        const f32x4 hi4 = {__uint_as_float(v[2] << 16), __uint_as_float(v[2] & 0xffff0000u), __uint_as_float(v[3] << 16), __uint_as_float(v[3] & 0xffff0000u)};
        *(f32x4*)(tile + row * RS + c8 * 32) = lo; *(f32x4*)(tile + row * RS + c8 * 32 + 16) = hi4;
      }
    }
#pragma unroll
    for (int nt = 0; nt < 2; ++nt) {
      const int ch = n * 64 + nt * 32 + r32;
      float hf[16], hb[16], a[16], bq[16], Send;
#pragma unroll
      for (int r = 0; r < 16; ++r) { a[r] = 1.f - __uint_as_float(ab[nt][0][r] << 16); bq[r] = __uint_as_float(ab[nt][0][r] & 0xffff0000u); }
      lru_seg_scan<false>(a, bq, hi, ((const float*)(p.ws + OFF_CARRY))[(size_t)(cid * 2 + 0) * DLRU + ch], hf, Send);
#pragma unroll
      for (int r = 0; r < 16; ++r) { a[r] = 1.f - __uint_as_float(ab[nt][1][r] << 16); bq[r] = __uint_as_float(ab[nt][1][r] & 0xffff0000u); }
      lru_seg_scan<true>(a, bq, hi, ((const float*)(p.ws + OFF_CARRY))[(size_t)(cid * 2 + 1) * DLRU + ch], hb, Send);
      const char* tl = tile + (4 * hi) * RS + (nt * 32 + r32) * 4;
      bf16_t* mo = mix + ((size_t)rbase + t0 + 4 * hi) * DM + ch;
#pragma unroll
      for (int r = 0; r < 16; ++r) {
        const int tk = (r & 3) + 8 * (r >> 2);
        const float gt = *(const float*)(tl + tk * RS);
        mo[(size_t)tk * DM] = f2bf((hf[r] + hb[r]) * gelu_tanh(gt));
      }
    }
  }
}

__device__ void lru_carry(const Params& p, char* smem) {
  const int tid = TIDX, seg = tid >> 6, c = tid & 63;
  const float* __restrict__ ls = (const float*)(p.ws + OFF_LSUM); float* __restrict__ cr = (float*)(p.ws + OFF_CARRY);
  float* comp = (float*)smem;
  for (int item = (int)gridDim.x - 1 - BIDX; item < 2 * 2 * 6; item += gridDim.x) {
    const int b = item / 12, dir = (item / 6) & 1, ch = (item % 6) * 64 + c;
    float P[33], H[33];
#pragma unroll
    for (int i = 0; i < 33; ++i) {
      const int k = seg * 33 + i;
      int cid;
      if (dir == 0) cid = (k < 8) ? 512 + b * 8 + k : b * 256 + (k - 8);
      else          cid = (k < 8) ? 512 + b * 8 + (7 - k) : b * 256 + (255 - (k - 8));
      P[i] = ls[((size_t)(cid * 2 + dir) * 2) * DLRU + ch]; H[i] = ls[((size_t)(cid * 2 + dir) * 2 + 1) * DLRU + ch];
    }
    float pc = 1.f, hc = 0.f;
#pragma unroll
    for (int i = 0; i < 33; ++i) { hc = P[i] * hc + H[i]; pc *= P[i]; }
    __syncthreads();
    comp[(seg * 2) * 64 + c] = pc; comp[(seg * 2 + 1) * 64 + c] = hc;
    __syncthreads();
    float st = 0.f;
    for (int s = 0; s < seg; ++s) st = comp[(s * 2) * 64 + c] * st + comp[(s * 2 + 1) * 64 + c];
#pragma unroll
    for (int i = 0; i < 33; ++i) {
      const int k = seg * 33 + i;
      int cid;
      if (dir == 0) cid = (k < 8) ? 512 + b * 8 + k : b * 256 + (k - 8);
      else          cid = (k < 8) ? 512 + b * 8 + (7 - k) : b * 256 + (255 - (k - 8));
      cr[(size_t)(cid * 2 + dir) * DLRU + ch] = st;
      st = P[i] * st + H[i];
    }
  }
}

__device__ void mla_prep(const Params& p, int layer) {
  const int lane = TIDX & 63, wid = TIDX >> 6;
  const bf16_t* u = (const bf16_t*)(p.ws + OFF_U);
  const float* qg = p.in[I_QNG] + layer * 384; const float* kvg = p.in[I_KVNG] + layer * 256;
  bf16_t* qn = (bf16_t*)(p.ws + OFF_QN); bf16_t* kvn = (bf16_t*)(p.ws + OFF_KVN); bf16_t* Kb = (bf16_t*)(p.ws + OFF_K);
  const bool qact = lane < 48, kact = lane < 32;
  f32x4 qg0 = {0.f, 0.f, 0.f, 0.f}, qg1 = qg0, kg0 = qg0, kg1 = qg0;
  if (qact) { qg0 = *(const f32x4*)(qg + lane * 8); qg1 = *(const f32x4*)(qg + lane * 8 + 4); }
  if (kact) { kg0 = *(const f32x4*)(kvg + lane * 8); kg1 = *(const f32x4*)(kvg + lane * 8 + 4); }
  u32x4 qv[4], kv[4], qvn[4], kvn_[4]; unsigned short kr[4], krn[4];
  const int gstride = gridDim.x * 8;
  int grp = BIDX * 8 + wid;
#define MLA_LOAD(QV, KV, KR, G) do { _Pragma("unroll") for (int j = 0; j < 4; ++j) { const bf16_t* ur = u + (size_t)((G) * 4 + j) * DIN; \
      QV[j] = u32x4{0u, 0u, 0u, 0u}; KV[j] = u32x4{0u, 0u, 0u, 0u}; \
      if (qact) QV[j] = *(const u32x4*)(ur + 768 + lane * 8); if (kact) KV[j] = *(const u32x4*)(ur + 1152 + lane * 8); KR[j] = ur[1408 + (lane & 31)]; } } while (0)
  if (grp < NTOK / 4) MLA_LOAD(qv, kv, kr, grp);
  for (; grp < NTOK / 4; grp += gstride) {
    const int r0 = grp * 4;
    if (grp + gstride < NTOK / 4) MLA_LOAD(qvn, kvn_, krn, grp + gstride);
#pragma unroll
    for (int j = 0; j < 4; ++j) {
      const int r = r0 + j;
      int b, t, isc; row_info(r, b, t, isc);
      float q[8], k[8], ss = 0.f;
#pragma unroll
      for (int i = 0; i < 4; ++i) { q[2 * i] = __uint_as_float(qv[j][i] << 16); q[2 * i + 1] = __uint_as_float(qv[j][i] & 0xffff0000u); ss += q[2 * i] * q[2 * i] + q[2 * i + 1] * q[2 * i + 1]; }
      float rinv = rsqrtf(wave_sum(ss) * (1.f / 384.f) + EPSV);
      if (qact) {
        const u32x4 o = {cvtpk(q[0] * rinv * qg0[0], q[1] * rinv * qg0[1]), cvtpk(q[2] * rinv * qg0[2], q[3] * rinv * qg0[3]),
                         cvtpk(q[4] * rinv * qg1[0], q[5] * rinv * qg1[1]), cvtpk(q[6] * rinv * qg1[2], q[7] * rinv * qg1[3])};
        *(u32x4*)(qn + (size_t)r * 384 + lane * 8) = o;
      }
      ss = 0.f;
#pragma unroll
      for (int i = 0; i < 4; ++i) { k[2 * i] = __uint_as_float(kv[j][i] << 16); k[2 * i + 1] = __uint_as_float(kv[j][i] & 0xffff0000u); ss += k[2 * i] * k[2 * i] + k[2 * i + 1] * k[2 * i + 1]; }
      rinv = rsqrtf(wave_sum(ss) * (1.f / 256.f) + EPSV);
      if (kact) {
        const u32x4 o = {cvtpk(k[0] * rinv * kg0[0], k[1] * rinv * kg0[1]), cvtpk(k[2] * rinv * kg0[2], k[3] * rinv * kg0[3]),
                         cvtpk(k[4] * rinv * kg1[0], k[5] * rinv * kg1[1]), cvtpk(k[6] * rinv * kg1[2], k[7] * rinv * kg1[3])};
        *(u32x4*)(kvn + (size_t)r * 256 + lane * 8) = o;
      }
      const float krv = bf2f(kr[j]), krp = shx(krv, 8);
      const float ko = isc ? krv : rope_apply(krv, krp, lane & 31, t);
      if (lane < 32) ((bf16_t*)(p.ws + OFF_V))[(size_t)r * 32 + rope_slot(lane)] = f2bf(ko);
    }
#pragma unroll
    for (int j = 0; j < 4; ++j) { qv[j] = qvn[j]; kv[j] = kvn_[j]; kr[j] = krn[j]; }
  }
#undef MLA_LOAD
}

__device__ void hyena_prep(const Params& p, int layer, char* smem) {
  constexpr int RS = 516;
  const bf16_t* u = (const bf16_t*)(p.ws + OFF_U);
  const float* cw = p.in[I_HCW] + (size_t)layer * 3 * 768; const float* cb = p.in[I_HCB] + layer * 768;
  const int tid = TIDX;
  const int ntile = (layer == 0) ? NCHUNK : 256;
  for (int unit = BIDX; unit < ntile * 3; unit += gridDim.x) {
    const int cid = unit / 3, part = unit % 3;
    int rbase, t0, slen, b;
    if (cid < 256) { b = cid >> 7; rbase = b * SEQ; t0 = (cid & 127) * 64; slen = SEQ; }
    else { const int q = cid - 256; b = q >> 2; rbase = NLAT + b * CTXL; t0 = (q & 3) * 64; slen = CTXL; }
    __syncthreads();
    {
      const int chunk = tid & 31;
      for (int row = tid >> 5; row < 66; row += 16) {
        const int t = t0 + row - 1;
        u32x4 v = {0u, 0u, 0u, 0u};
        if (t >= 0 && t < slen) v = *(const u32x4*)(u + (size_t)(rbase + t) * DIN + 1440 + part * 256 + chunk * 8);
        unsigned* d = (unsigned*)(smem + row * RS + chunk * 16);
        d[0] = v[0]; d[1] = v[1]; d[2] = v[2]; d[3] = v[3];
      }
    }
    __syncthreads();
    {
      const int tg = tid & 15;
      const char* tb = smem + (4 * tg) * RS;
#pragma unroll
      for (int i = 0; i < 4; ++i) {
        const int cp = (tid >> 4) + 32 * i, pc = part * 256 + 2 * cp;
        unsigned x[6];
#pragma unroll
        for (int k = 0; k < 6; ++k) x[k] = *(const unsigned*)(tb + k * RS + cp * 4);
        const float wa0 = cw[pc], wa1 = cw[768 + pc], wa2 = cw[1536 + pc], ba = cb[pc];
        const float wb0 = cw[pc + 1], wb1 = cw[768 + pc + 1], wb2 = cw[1536 + pc + 1], bb = cb[pc + 1];
        f32x4 ya, yb;
#pragma unroll
        for (int q = 0; q < 4; ++q) {
          ya[q] = ba + wa0 * __uint_as_float(x[q] << 16) + wa1 * __uint_as_float(x[q + 1] << 16) + wa2 * __uint_as_float(x[q + 2] << 16);
          yb[q] = bb + wb0 * __uint_as_float(x[q] & 0xffff0000u) + wb1 * __uint_as_float(x[q + 1] & 0xffff0000u) + wb2 * __uint_as_float(x[q + 2] & 0xffff0000u);
        }
        float* dst = (cid < 256) ? (float*)(p.ws + OFF_HYIN) + ((size_t)(part * 2 + b) * 256 + 2 * cp) * SEQ + t0 + 4 * tg
                                 : (float*)(p.ws + OFF_HYINC) + ((size_t)(part * 2 + b) * 256 + 2 * cp) * CTXL + t0 + 4 * tg;
        *(f32x4*)dst = ya; *(f32x4*)(dst + slen) = yb;
      }
    }
  }
}

__device__ void hyena_out_transpose(const Params& p, char* smem) {
  const bf16_t* yc = (const bf16_t*)(p.ws + OFF_HB); bf16_t* mix = (bf16_t*)(p.ws + OFF_MIX);
  constexpr int RS = 132;
  const int tid = TIDX;
  for (int unit = BIDX; unit < 2 * (SEQ / 64); unit += gridDim.x) {
    const int b = unit / (SEQ / 64), t0 = (unit % (SEQ / 64)) * 64;
    __syncthreads();
    {
      const int chunk = tid & 7;
      for (int c = tid >> 3; c < 256; c += 64) {
        const u32x4 v = *(const u32x4*)(yc + ((size_t)(b * 256 + c)) * SEQ + t0 + chunk * 8);
        unsigned* d = (unsigned*)(smem + c * RS + chunk * 16);
        d[0] = v[0]; d[1] = v[1]; d[2] = v[2]; d[3] = v[3];
      }
    }
    __syncthreads();
    {
      const int c8 = (tid & 31) * 8;
      for (int tl = tid >> 5; tl < 64; tl += 16) {
        unsigned short h[8];
#pragma unroll
        for (int q = 0; q < 8; ++q) h[q] = *(const unsigned short*)(smem + (c8 + q) * RS + tl * 2);
        const u32x4 o = {(unsigned)h[0] | ((unsigned)h[1] << 16), (unsigned)h[2] | ((unsigned)h[3] << 16), (unsigned)h[4] | ((unsigned)h[5] << 16), (unsigned)h[6] | ((unsigned)h[7] << 16)};
        *(u32x4*)(mix + ((size_t)b * SEQ + t0 + tl) * DM + 768 + c8) = o;
      }
    }
  }
}

__device__ void hyena_direct(const Params& p, int layer, char* smem) {
  float* zs = (float*)smem;
  float* Ts = zs + SEQ;
  bf16_t* mix = (bf16_t*)(p.ws + OFF_MIX);
  const int nunits = (layer == 0) ? 512 : 0;
  for (int unit = BIDX; unit < nunits; unit += gridDim.x) {
    const bool isc = true; const int q = unit & 511, b = q >> 8, c = q & 255;
    const int L = CTXL;
    const float* hin = (const float*)(p.ws + OFF_HYINC);
    const float* filt = (const float*)(p.ws + OFF_FILTC) + (size_t)layer * 1024 * CTXL;
    const float* ssq = (const float*)(p.ws + OFF_SSQPC) + (size_t)layer * 4 * 1024;
    const int ntt = 4;
    const int nout = (L + NTHREADS - 1) / NTHREADS;
    for (int order = 0; order < 2; ++order) {
      const int colf = (order * 2 + 0) * 256 + c, colb = (order * 2 + 1) * 256 + c;
      float sf = 0.f, sb = 0.f;
      for (int tt = 0; tt < ntt; ++tt) { sf += ssq[(size_t)tt * 1024 + colf]; sb += ssq[(size_t)tt * 1024 + colb]; }
      sf = rsqrtf(sf + EPSV); sb = rsqrtf(sb + EPSV);
      const float skip = p.in[I_HSKIP][(size_t)layer * 512 + order * 256 + c];
      __syncthreads();
      for (int i = TIDX; i < 2 * L; i += NTHREADS) {
        const int m = i - L;
        float v = 0.f;
        if (m >= 0) v = filt[(size_t)colf * L + m] * sf; else if (m > -L) v = filt[(size_t)colb * L - m] * sb;
        if (m == 0) v += skip;
        Ts[i] = v;
      }
      if (order == 0) for (int i = TIDX; i < L; i += NTHREADS) zs[i] = hin[((size_t)(0 * 2 + b) * 256 + c) * L + i];
      __syncthreads();
      float acc[16];
#pragma unroll
      for (int j = 0; j < 16; ++j) acc[j] = 0.f;
      if ((int)TIDX < L) {
        const float* tb = Ts + L + TIDX;
        if (!isc) {
          for (int s = 0; s < SEQ; ++s) {
            const float zv = zs[s];
#pragma unroll
            for (int j = 0; j < 16; ++j) acc[j] += tb[j * NTHREADS - s] * zv;
          }
        } else {
          for (int s = 0; s < CTXL; ++s) acc[0] += tb[-s] * zs[s];
        }
      }
      __syncthreads();
      const float* xg = hin + ((size_t)((1 + order) * 2 + b) * 256 + c) * L;
#pragma unroll
      for (int j = 0; j < 16; ++j) {
        const int t = TIDX + j * NTHREADS;
        if (t < L) {
          const float y = xg[t] * acc[j];
          if (order == 0) zs[t] = y;
          else { const size_t row = isc ? (size_t)NLAT + b * CTXL + t : (size_t)b * SEQ + t; mix[row * DM + 768 + c] = f2bf(y); }
        }
      }
    }
  }
}

namespace att {
constexpr int NW = 8, QBLK = 32, KVBLK = 64;
constexpr float SCALE = 0.10206207261596575f;
constexpr float THR = 8.f;
constexpr int SHM_V = KVBLK * 128 * 2, SHM_K = KVBLK * 128 * 2;
constexpr int SHM_ATTN = 2 * SHM_V + 2 * SHM_K + NW * 64 * 4;
#define KSWZ(row, colB) ((row) * 256 + ((colB) ^ (((row) & 7) << 4)))
#define SBAR() __builtin_amdgcn_sched_barrier(0)
template <int VAR> __device__ __forceinline__ float ex2(float x) { if constexpr (VAR == 2) return x; else return __builtin_amdgcn_exp2f(x); }
template <int VAR> __device__ __forceinline__ void partialSM(f32x16& p0, f32x16& p1, float& m_reg, float& mn, float& alpha) {
  constexpr float C = SCALE * 1.4426950408889634f;
  float pmax = p0[0];
#pragma unroll
  for (int r = 1; r < 16; ++r) pmax = fmaxf(pmax, p0[r]);
#pragma unroll
  for (int r = 0; r < 16; ++r) pmax = fmaxf(pmax, p1[r]);
  { auto rr = __builtin_amdgcn_permlane32_swap(__float_as_uint(pmax), __float_as_uint(pmax), false, false);
    pmax = fmaxf(__uint_as_float(rr[0]), __uint_as_float(rr[1])); }
  if (__builtin_expect(__all(pmax - m_reg <= THR / SCALE), 1)) { mn = m_reg; alpha = 1.f; }
  else { mn = fmaxf(m_reg, pmax); alpha = __builtin_amdgcn_exp2f((m_reg - mn) * C); m_reg = mn; }
  const float mnC = -mn * C;
#pragma unroll
  for (int r = 0; r < 16; ++r) p0[r] = fmaf(p0[r], C, mnC);
#pragma unroll
  for (int r = 0; r < 16; ++r) p1[r] = fmaf(p1[r], C, mnC);
#pragma unroll
  for (int r = 0; r < 16; ++r) p0[r] = ex2<VAR>(p0[r]);
}
template <int VAR> __device__ __forceinline__ void finishSM(f32x16& p0, f32x16& p1, float alpha, float& l_reg, bf16x8& pa0, bf16x8& pa1, bf16x8& pa2, bf16x8& pa3) {
#pragma unroll
  for (int r = 0; r < 16; ++r) p1[r] = ex2<VAR>(p1[r]);
  float ps = 0;
#pragma unroll
  for (int r = 0; r < 16; ++r) ps += p0[r];
#pragma unroll
  for (int r = 0; r < 16; ++r) ps += p1[r];
  { auto rr = __builtin_amdgcn_permlane32_swap(__float_as_uint(ps), __float_as_uint(ps), false, false);
    ps = __uint_as_float(rr[0]) + __uint_as_float(rr[1]); }
  l_reg = l_reg * alpha + ps;
#define PK4(P, BASE, OUT) do { unsigned a0 = cvtpk(P[BASE + 0], P[BASE + 1]), a1 = cvtpk(P[BASE + 2], P[BASE + 3]);   \
    unsigned b0 = cvtpk(P[BASE + 4], P[BASE + 5]), b1 = cvtpk(P[BASE + 6], P[BASE + 7]);                              \
    auto r0 = __builtin_amdgcn_permlane32_swap(a0, b0, false, false); auto r1 = __builtin_amdgcn_permlane32_swap(a1, b1, false, false); \
    u32x4 w = {r0[0], r1[0], r0[1], r1[1]}; OUT = *reinterpret_cast<bf16x8*>(&w); } while (0)
  PK4(p0, 0, pa0); PK4(p0, 8, pa1); PK4(p1, 0, pa2); PK4(p1, 8, pa3);
#undef PK4
}
__device__ __forceinline__ void qkt(f32x16& p0, f32x16& p1, const char* Ks, const bf16x8* qr, int r32, int hi) {
  p0 = f32x16{}; p1 = f32x16{};
#pragma unroll
  for (int d0 = 0; d0 < 6; ++d0) { const int cb = (d0 * 16 + hi * 8) * 2;
    const bf16x8 b0 = *reinterpret_cast<const bf16x8*>(Ks + KSWZ(r32, cb));
    const bf16x8 b1 = *reinterpret_cast<const bf16x8*>(Ks + KSWZ(32 + r32, cb));
    p0 = __builtin_amdgcn_mfma_f32_32x32x16_bf16(b0, qr[d0], p0, 0, 0, 0);
    p1 = __builtin_amdgcn_mfma_f32_32x32x16_bf16(b1, qr[d0], p1, 0, 0, 0); }
}
__device__ __forceinline__ int v_st(int k, int c) { const int kk = (k & ~0xC) | ((k & 4) << 1) | ((k & 8) >> 1); return ((kk >> 3) * 4 + (c >> 5)) * 512 + ((kk & 7) * 32 + (c & 31)) * 2; }
__device__ __forceinline__ int v_rd_base(int lane) { return ((lane & 3) << 3) | (((lane >> 2) & 3) << 6) | (((lane >> 4) & 1) << 5) | (((lane >> 5) & 1) << 8); }
constexpr int v_rd_off(int d0, int ks, int half) { return d0 * 512 + ks * 4096 + half * 2048; }
template <int OFF> __device__ __forceinline__ s16x4 tr_read(int vb) {
  s16x4 r; asm volatile("ds_read_b64_tr_b16 %0, %1 offset:%2" : "=&v"(r) : "v"(vb), "i"(OFF) : "memory"); return r;
}
template <int D0> __device__ __forceinline__ void pv_one(f32x16& od, int vb, bf16x8 pa0, bf16x8 pa1, bf16x8 pa2, bf16x8 pa3) {
  const s16x4 l0 = tr_read<v_rd_off(D0, 0, 0)>(vb), h0 = tr_read<v_rd_off(D0, 0, 1)>(vb), l1 = tr_read<v_rd_off(D0, 1, 0)>(vb), h1 = tr_read<v_rd_off(D0, 1, 1)>(vb);
  const s16x4 l2 = tr_read<v_rd_off(D0, 2, 0)>(vb), h2 = tr_read<v_rd_off(D0, 2, 1)>(vb), l3 = tr_read<v_rd_off(D0, 3, 0)>(vb), h3 = tr_read<v_rd_off(D0, 3, 1)>(vb);
  asm volatile("s_waitcnt lgkmcnt(0)" ::: "memory"); SBAR();
#define PK(L, H) (bf16x8){L[0], L[1], L[2], L[3], H[0], H[1], H[2], H[3]}
  od = __builtin_amdgcn_mfma_f32_32x32x16_bf16(pa0, PK(l0, h0), od, 0, 0, 0);
  od = __builtin_amdgcn_mfma_f32_32x32x16_bf16(pa1, PK(l1, h1), od, 0, 0, 0);
  od = __builtin_amdgcn_mfma_f32_32x32x16_bf16(pa2, PK(l2, h2), od, 0, 0, 0);
  od = __builtin_amdgcn_mfma_f32_32x32x16_bf16(pa3, PK(l3, h3), od, 0, 0, 0);
#undef PK
}
__device__ __forceinline__ void pv_d0(f32x16& o0, f32x16& o1, int vb, bf16x8 pa0, bf16x8 pa1, bf16x8 pa2, bf16x8 pa3) {
  pv_one<0>(o0, vb, pa0, pa1, pa2, pa3); pv_one<1>(o1, vb, pa0, pa1, pa2, pa3);
}
template <int VAR>
__device__ __forceinline__ void attn_body(const bf16_t* __restrict__ Qb, const bf16_t* __restrict__ KVh, const bf16_t* __restrict__ KR, int bsel, int key0,
                                          bf16_t* __restrict__ Ob, float* __restrict__ Op, float* __restrict__ Oml, int seq, char* lds) {
  const int tid = TIDX, wid = tid >> 6, lane = tid & 63, r32 = lane & 31, hi = lane >> 5;
  char* V_lds = lds; char* K_lds = lds + 2 * SHM_V;
  float* ws = (float*)(lds + 2 * SHM_V + 2 * SHM_K) + wid * 64; float* li_l = ws; float* al_l = ws + 32;
  float m_reg = -1e30f, l_reg = 0; f32x16 o0 = {}, o1 = {}; bf16x8 qr[6];
  const bf16_t* Qw = Qb + (size_t)(wid * QBLK + r32) * 576 + hi * 8;
#pragma unroll
  for (int d0 = 0; d0 < 6; ++d0) qr[d0] = *(const bf16x8*)(Qw + d0 * 16);
  const int sr = tid >> 4, sc = (tid & 15) * 8, vst0 = v_st(sr, sc & 63), vst1 = v_st(32 + sr, sc & 63);
  const int vb0 = (int)(uintptr_t)V_lds + v_rd_base(lane);
  const bool kact = sc < 96, vact = sc < 64;
  bf16x8 vs0 = {}, vs1 = {}, ks0 = {}, ks1 = {};
#define SLOAD(k0) do { const int kk_ = key0 + (k0); const size_t rb_ = (size_t)((kk_ < CTXL) ? NLAT + bsel * CTXL + kk_ : bsel * SEQ + kk_ - CTXL) + sr; \
    if (vact) { vs0 = *(const bf16x8*)(KVh + rb_ * 768 + 64 + sc); vs1 = *(const bf16x8*)(KVh + (rb_ + 32) * 768 + 64 + sc); } \
    if (kact) { if (sc < 64) { ks0 = *(const bf16x8*)(KVh + rb_ * 768 + sc); ks1 = *(const bf16x8*)(KVh + (rb_ + 32) * 768 + sc); } \
                else { ks0 = *(const bf16x8*)(KR + rb_ * 32 + (sc - 64)); ks1 = *(const bf16x8*)(KR + (rb_ + 32) * 32 + (sc - 64)); } } } while (0)
#define SWRITE(b) do { if (vact) { *(bf16x8*)(V_lds + (b) * SHM_V + vst0) = vs0; *(bf16x8*)(V_lds + (b) * SHM_V + vst1) = vs1; } \
    if (kact) { const int kc = sc * 2; *(bf16x8*)(K_lds + (b) * SHM_K + KSWZ(sr, kc)) = ks0; *(bf16x8*)(K_lds + (b) * SHM_K + KSWZ(32 + sr, kc)) = ks1; } } while (0)
#define SWAIT() asm volatile("s_waitcnt vmcnt(0)" ::: "memory")
#define RESC(a) do { if (__any((a) < 1.f)) { if (hi == 0) al_l[r32] = (a); asm volatile("s_waitcnt lgkmcnt(0)" ::: "memory"); \
    _Pragma("unroll") for (int r = 0; r < 16; ++r) { const float f = al_l[crow(r, hi)]; o0[r] *= f; o1[r] *= f; } } } while (0)
  f32x16 pA0, pA1, pB0, pB1; float mnA, mnB, alA, alB; bf16x8 pa0, pa1, pa2, pa3; const int NT = seq / KVBLK;
  __syncthreads();
  SLOAD(0); SWAIT(); SWRITE(0); __syncthreads();
  qkt(pA0, pA1, K_lds, qr, r32, hi); partialSM<VAR>(pA0, pA1, m_reg, mnA, alA);
  SLOAD(KVBLK);
  SWAIT(); SWRITE(1); __syncthreads();
#define LSYNC() do { if constexpr (VAR != 1) __syncthreads(); } while (0)
#define LLOAD(k0) do { if constexpr (VAR != 3) SLOAD(k0); } while (0)
#define LWRITE(b) do { if constexpr (VAR != 3) { SWAIT(); SWRITE(b); } } while (0)
#define LPV(O0, O1, VB) do { if constexpr (VAR != 5) pv_d0(O0, O1, VB, pa0, pa1, pa2, pa3); else { asm volatile("" :: "v"(pa0), "v"(pa1), "v"(pa2), "v"(pa3)); } } while (0)
  const int wodd = __builtin_amdgcn_readfirstlane(wid) & 1;
#define HALF_IT(PN0, PN1, MN, AN, PO0, PO1, AO, KB, VB) do { \
    if (!wodd) { qkt(PN0, PN1, KB, qr, r32, hi); finishSM<VAR>(PO0, PO1, AO, l_reg, pa0, pa1, pa2, pa3); SBAR(); LPV(o0, o1, VB); partialSM<VAR>(PN0, PN1, m_reg, MN, AN); } \
    else { finishSM<VAR>(PO0, PO1, AO, l_reg, pa0, pa1, pa2, pa3); SBAR(); qkt(PN0, PN1, KB, qr, r32, hi); SBAR(); partialSM<VAR>(PN0, PN1, m_reg, MN, AN); SBAR(); LPV(o0, o1, VB); } } while (0)
  for (int j = 1; j + 1 < NT; j += 2) {
    SBAR(); LLOAD((j + 1) * KVBLK); SBAR();
    HALF_IT(pB0, pB1, mnB, alB, pA0, pA1, alA, K_lds + SHM_K, vb0);
    LSYNC(); LWRITE(0);
    RESC(alB); LSYNC();
    SBAR(); LLOAD((j + 2) * KVBLK); SBAR();
    HALF_IT(pA0, pA1, mnA, alA, pB0, pB1, alB, K_lds, vb0 + SHM_V);
    LSYNC(); LWRITE(1);
    RESC(alA); LSYNC();
  }
#undef HALF_IT
#undef LSYNC
#undef LLOAD
#undef LWRITE
#undef LPV
  SBAR(); qkt(pB0, pB1, K_lds + SHM_K, qr, r32, hi);
  finishSM<VAR>(pA0, pA1, alA, l_reg, pa0, pa1, pa2, pa3); SBAR();
  pv_d0(o0, o1, vb0, pa0, pa1, pa2, pa3); partialSM<VAR>(pB0, pB1, m_reg, mnB, alB);
  __syncthreads(); RESC(alB);
  finishSM<VAR>(pB0, pB1, alB, l_reg, pa0, pa1, pa2, pa3); SBAR();
  pv_d0(o0, o1, vb0 + SHM_V, pa0, pa1, pa2, pa3);
  if (Op != nullptr) {
    float* Pw = Op + (size_t)(wid * QBLK) * 64;
#pragma unroll
    for (int r = 0; r < 16; ++r) { const int orow = crow(r, hi); Pw[(size_t)orow * 64 + r32] = o0[r]; Pw[(size_t)orow * 64 + 32 + r32] = o1[r]; }
    if (hi == 0) { Oml[(size_t)(wid * QBLK + r32) * 2] = m_reg; Oml[(size_t)(wid * QBLK + r32) * 2 + 1] = l_reg; }
  } else {
    if (hi == 0) li_l[r32] = l_reg; asm volatile("s_waitcnt lgkmcnt(0)" ::: "memory");
    bf16_t* Ow = Ob + (size_t)(wid * QBLK) * DM;
#pragma unroll
    for (int r = 0; r < 16; ++r) { const int orow = crow(r, hi); const float rl = __builtin_amdgcn_rcpf(li_l[orow]);
      Ow[(size_t)orow * DM + r32] = f2bf(o0[r] * rl); Ow[(size_t)orow * DM + 32 + r32] = f2bf(o1[r] * rl); }
  }
#undef SLOAD
#undef SWRITE
#undef SWAIT
#undef RESC
}
}

template <int VAR = 0, bool ATT_DUMMY = false>
__device__ __forceinline__ void attn_units(const Params& p, int layer, char* smem) {
  const bf16_t* Q = (const bf16_t*)(p.ws + OFF_Q);
  const bf16_t* KV = (const bf16_t*)(p.ws + OFF_K); const bf16_t* KR = (const bf16_t*)(p.ws + OFF_V);
  bf16_t* mix = (bf16_t*)(p.ws + OFF_MIX); float* opart = (float*)(p.ws + OFF_OPART); float* oml = (float*)(p.ws + OFF_OML);
  const int nunits = 512 + ((layer == 0) ? 12 : 0);
  for (int unit = BIDX; unit < nunits; unit += gridDim.x) {
    const bf16_t *qp, *kvp; bf16_t* ob; float* op = nullptr; float* ml = nullptr; int seq, bsel, key0 = 0;
    if (unit < 256) {
      const int bh = unit & 7, qb = unit >> 3, b = bh / 6, h = bh % 6;
      qp = Q + ((size_t)b * SEQ + qb * 256) * 576 + h * 96; kvp = KV + h * 128; bsel = b;
      ob = mix + ((size_t)b * SEQ + qb * 256) * DM + 384 + h * 64; seq = NKEYS;
    } else if (unit < 512) {
      const int v = unit - 256, bhi = v & 3, half = (v >> 2) & 1, qb = v >> 3, bh = 8 + bhi, b = bh / 6, h = bh % 6;
      qp = Q + ((size_t)b * SEQ + qb * 256) * 576 + h * 96; kvp = KV + h * 128; bsel = b; key0 = half * (NKEYS / 2);
      ob = mix; op = opart + ((size_t)(bhi * 2 + half) * SEQ + qb * 256) * 64; ml = oml + ((size_t)(bhi * 2 + half) * SEQ + qb * 256) * 2; seq = NKEYS / 2;
    } else {
      const int bh = unit - 512, b = bh / 6, h = bh % 6;
      qp = Q + ((size_t)NLAT + b * CTXL) * 576 + h * 96; kvp = KV + h * 128; bsel = b;
      ob = mix + ((size_t)NLAT + b * CTXL) * DM + 384 + h * 64; seq = CTXL;
    }
    if constexpr (VAR != 0 || ATT_DUMMY) {
      ob = (bf16_t*)(p.ws + OFF_HB) + (size_t)(unit & 63) * 256 * DM; if (op) { op = (float*)(p.ws + OFF_HB) + (size_t)(unit & 63) * 256 * 64; ml = op; }
    }
    att::attn_body<VAR>(qp, kvp, KR, bsel, key0, ob, op, ml, seq, smem);
  }
}
__device__ void attn_combine(const Params& p) {
  const int lane = TIDX & 63, wid = TIDX >> 6;
  const float* opart = (const float*)(p.ws + OFF_OPART); const float* oml = (const float*)(p.ws + OFF_OML); bf16_t* mix = (bf16_t*)(p.ws + OFF_MIX);
  constexpr float C = att::SCALE * 1.4426950408889634f;
  for (int grp = BIDX * 8 + wid; grp < 4 * SEQ / 4; grp += gridDim.x * 8) {
    const int idx0 = grp * 4, bhi = idx0 >> 13, q0 = idx0 & (SEQ - 1), bh = 8 + bhi, b = bh / 6, h = bh % 6;
    const size_t r0 = (size_t)(bhi * 2) * SEQ + q0, r1 = r0 + SEQ;
    float m0[4], l0[4], m1[4], l1[4], o0[4], o1[4];
#pragma unroll
    for (int j = 0; j < 4; ++j) {
      m0[j] = oml[(r0 + j) * 2]; l0[j] = oml[(r0 + j) * 2 + 1]; m1[j] = oml[(r1 + j) * 2]; l1[j] = oml[(r1 + j) * 2 + 1];
      o0[j] = opart[(r0 + j) * 64 + lane]; o1[j] = opart[(r1 + j) * 64 + lane];
    }
#pragma unroll
    for (int j = 0; j < 4; ++j) {
      const float m = fmaxf(m0[j], m1[j]), f0 = __builtin_amdgcn_exp2f((m0[j] - m) * C), f1 = __builtin_amdgcn_exp2f((m1[j] - m) * C);
      const float o = (o0[j] * f0 + o1[j] * f1) / (l0[j] * f0 + l1[j] * f1);
      mix[((size_t)b * SEQ + q0 + j) * DM + 384 + h * 64 + lane] = f2bf(o);
    }
  }
}

#define CEK(a, b) { const unsigned _h = max(k[a], k[b]), _l = min(k[a], k[b]); k[a] = _h; k[b] = _l; }
__device__ __forceinline__ void sort16k(unsigned* k) {
  CEK(0,1) CEK(2,3) CEK(0,2) CEK(1,3) CEK(1,2) CEK(4,5) CEK(6,7) CEK(4,6)
  CEK(5,7) CEK(5,6) CEK(0,4) CEK(2,6) CEK(2,4) CEK(1,5) CEK(3,7) CEK(3,5)
  CEK(1,2) CEK(3,4) CEK(5,6) CEK(8,9) CEK(10,11) CEK(8,10) CEK(9,11) CEK(9,10)
  CEK(12,13) CEK(14,15) CEK(12,14) CEK(13,15) CEK(13,14) CEK(8,12) CEK(10,14) CEK(10,12)
  CEK(9,13) CEK(11,15) CEK(11,13) CEK(9,10) CEK(11,12) CEK(13,14) CEK(0,8) CEK(4,12)
  CEK(4,8) CEK(2,10) CEK(6,14) CEK(6,10) CEK(2,4) CEK(6,8) CEK(10,12) CEK(1,9)
  CEK(5,13) CEK(5,9) CEK(3,11) CEK(7,15) CEK(7,11) CEK(3,5) CEK(7,9) CEK(11,13)
  CEK(1,2) CEK(3,4) CEK(5,6) CEK(7,8) CEK(9,10) CEK(11,12) CEK(13,14)
}
__device__ __forceinline__ void bmerge16k(unsigned* k) {
  CEK(0,8) CEK(1,9) CEK(2,10) CEK(3,11) CEK(4,12) CEK(5,13) CEK(6,14) CEK(7,15)
  CEK(0,4) CEK(1,5) CEK(2,6) CEK(3,7) CEK(8,12) CEK(9,13) CEK(10,14) CEK(11,15)
  CEK(0,2) CEK(1,3) CEK(4,6) CEK(5,7) CEK(8,10) CEK(9,11) CEK(12,14) CEK(13,15)
  CEK(0,1) CEK(2,3) CEK(4,5) CEK(6,7) CEK(8,9) CEK(10,11) CEK(12,13) CEK(14,15)
}
#undef CEK
#define CEP(a, b) { const bool _s = v[a] < v[b]; const float _va = _s ? v[b] : v[a], _vb = _s ? v[a] : v[b]; const int _pa = _s ? pl[b] : pl[a], _pb = _s ? pl[a] : pl[b]; \
                    v[a] = _va; v[b] = _vb; pl[a] = _pa; pl[b] = _pb; }
__device__ __forceinline__ void sort16p(float* v, int* pl) {
  CEP(0,1) CEP(2,3) CEP(0,2) CEP(1,3)
  CEP(1,2) CEP(4,5) CEP(6,7) CEP(4,6)
  CEP(5,7) CEP(5,6) CEP(0,4) CEP(2,6)
  CEP(2,4) CEP(1,5) CEP(3,7) CEP(3,5)
  CEP(1,2) CEP(3,4) CEP(5,6) CEP(8,9)
  CEP(10,11) CEP(8,10) CEP(9,11) CEP(9,10)
  CEP(12,13) CEP(14,15) CEP(12,14) CEP(13,15)
  CEP(13,14) CEP(8,12) CEP(10,14) CEP(10,12)
  CEP(9,13) CEP(11,15) CEP(11,13) CEP(9,10)
  CEP(11,12) CEP(13,14) CEP(0,8) CEP(4,12)
  CEP(4,8) CEP(2,10) CEP(6,14) CEP(6,10)
  CEP(2,4) CEP(6,8) CEP(10,12) CEP(1,9)
  CEP(5,13) CEP(5,9) CEP(3,11) CEP(7,15)
  CEP(7,11) CEP(3,5) CEP(7,9) CEP(11,13)
  CEP(1,2) CEP(3,4) CEP(5,6) CEP(7,8)
  CEP(9,10) CEP(11,12) CEP(13,14)
}
__device__ __forceinline__ void bmerge16p(float* v, int* pl) {
  CEP(0,8) CEP(1,9) CEP(2,10) CEP(3,11)
  CEP(4,12) CEP(5,13) CEP(6,14) CEP(7,15)
  CEP(0,4) CEP(1,5) CEP(2,6) CEP(3,7)
  CEP(8,12) CEP(9,13) CEP(10,14) CEP(11,15)
  CEP(0,2) CEP(1,3) CEP(4,6) CEP(5,7)
  CEP(8,10) CEP(9,11) CEP(12,14) CEP(13,15)
  CEP(0,1) CEP(2,3) CEP(4,5) CEP(6,7)
  CEP(8,9) CEP(10,11) CEP(12,13) CEP(14,15)
}
#undef CEP
__device__ __forceinline__ unsigned fkey(float f, int low7) { unsigned u = __float_as_uint(f); u ^= (unsigned)((int)u >> 31) | 0x80000000u; return (u & ~127u) | (unsigned)low7; }
__device__ __forceinline__ float funkey(unsigned k) { unsigned u = k & ~127u; u ^= (u & 0x80000000u) ? 0x80000000u : 0xFFFFFFFFu; return __uint_as_float(u); }
__device__ __forceinline__ void peer_half_top16(const char* __restrict__ kl  , int r32, const bf16_t* __restrict__ qp, int hi, unsigned* T) {
  bf16x8 bq[8]; int kofs[8];
#pragma unroll
  for (int ks = 0; ks < 8; ++ks) { bq[ks] = *(const bf16x8*)(qp + ks * 16); kofs[ks] = r32 * 256 + (((ks * 16 + hi * 8) * 2) ^ ((r32 & 7) << 4)); }
  unsigned L[16];
#pragma unroll
  for (int mt = 0; mt < 4; ++mt) {
    f32x16 acc = {};
#pragma unroll
    for (int ks = 0; ks < 8; ++ks) {
      const bf16x8 a = *(const bf16x8*)(kl + mt * 8192 + kofs[ks]);
      acc = __builtin_amdgcn_mfma_f32_32x32x16_bf16(a, bq[ks], acc, 0, 0, 0);
    }
    unsigned k[16];
#pragma unroll
    for (int r = 0; r < 16; ++r) k[r] = fkey(acc[r], 127 - (mt * 32 + (r & 3) + 8 * (r >> 2) + 4 * hi));
    sort16k(k);
    if (mt == 0) {
#pragma unroll
      for (int i = 0; i < 16; ++i) L[i] = k[i];
    } else {
#pragma unroll
      for (int i = 0; i < 16; ++i) L[i] = max(L[i], k[15 - i]);
      bmerge16k(L);
    }
  }
#pragma unroll
  for (int i = 0; i < 16; ++i) {
    const auto rr = __builtin_amdgcn_permlane32_swap(L[15 - i], L[15 - i], false, false);
    const unsigned partner = hi ? rr[0] : rr[1];
    T[i] = max(L[i], partner);
  }
  bmerge16k(T);
}
__device__ void peer_topk(const Params& p, int layer, int nrows, char* smem) {
  const int tid = TIDX, wid = tid >> 6, lane = tid & 63, r32 = lane & 31, hi = lane >> 5;
  const bf16_t* pq = (const bf16_t*)(p.ws + OFF_PQ);
  const bf16_t* keys = (const bf16_t*)(p.ws + OFF_KEYS) + (size_t)layer * 2 * 128 * 128;
  int* eid = (int*)(p.ws + OFF_EID); float* gate = (float*)(p.ws + OFF_GATE);
  __syncthreads();
  for (int i = tid; i < 4096; i += NTHREADS) {
    const int half = i >> 11, key = (i >> 4) & 127, c16 = i & 15;
    *(u32x4*)(smem + half * 32768 + KSWZ(key, c16 * 16)) = *(const u32x4*)(keys + (size_t)(half * 128 + key) * 128 + c16 * 8);
  }
  __syncthreads();
  const int ntask = (nrows / 32) * 8, gw = (int)gridDim.x * 8, nfull = ntask / gw, rem = ntask - nfull * gw;
  for (int it = 0; it <= nfull; ++it) {
    int task;
    if (it < nfull) task = it * gw + BIDX * 8 + wid;
    else { const int e = BIDX + (int)gridDim.x * wid; if (e >= rem) break; task = nfull * gw + e; }
    const int grp = task >> 3, h = task & 7;
    const size_t row = (size_t)grp * 32 + r32;
    unsigned K1[16], K2[16];
    const int lofs = launder_v(0);
    peer_half_top16(smem + lofs, r32, pq + row * 2048 + h * 256 + hi * 8, hi, K1);
    peer_half_top16(smem + lofs + 32768, r32, pq + row * 2048 + h * 256 + 128 + hi * 8, hi, K2);
    float v1[16], v2[16]; int i1[16], i2[16];
#pragma unroll
    for (int i = 0; i < 16; ++i) { v1[i] = funkey(K1[i]); v2[i] = funkey(K2[i]); i1[i] = 127 - (int)(K1[i] & 127u); i2[i] = 127 - (int)(K2[i] & 127u); }
    float ts[16]; int tp[16];
    {
      float* cv = ts; int* cp = tp;
    cv[0] = v1[0] + v2[0]; cp[0] = (i1[0] << 7) | i2[0];
    cv[1] = v1[0] + v2[1]; cp[1] = (i1[0] << 7) | i2[1];
    cv[2] = v1[0] + v2[2]; cp[2] = (i1[0] << 7) | i2[2];
    cv[3] = v1[0] + v2[3]; cp[3] = (i1[0] << 7) | i2[3];
    cv[4] = v1[0] + v2[4]; cp[4] = (i1[0] << 7) | i2[4];
    cv[5] = v1[0] + v2[5]; cp[5] = (i1[0] << 7) | i2[5];
    cv[6] = v1[0] + v2[6]; cp[6] = (i1[0] << 7) | i2[6];
    cv[7] = v1[0] + v2[7]; cp[7] = (i1[0] << 7) | i2[7];
    cv[8] = v1[0] + v2[8]; cp[8] = (i1[0] << 7) | i2[8];
    cv[9] = v1[0] + v2[9]; cp[9] = (i1[0] << 7) | i2[9];
    cv[10] = v1[0] + v2[10]; cp[10] = (i1[0] << 7) | i2[10];
    cv[11] = v1[0] + v2[11]; cp[11] = (i1[0] << 7) | i2[11];
    cv[12] = v1[0] + v2[12]; cp[12] = (i1[0] << 7) | i2[12];
    cv[13] = v1[0] + v2[13]; cp[13] = (i1[0] << 7) | i2[13];
    cv[14] = v1[0] + v2[14]; cp[14] = (i1[0] << 7) | i2[14];
    cv[15] = v1[0] + v2[15]; cp[15] = (i1[0] << 7) | i2[15];
      sort16p(ts, tp);
    }
#pragma unroll 1
    for (int g = 1; g < 3; ++g) {
      float cv[16]; int cp[16];
      if (g == 1) {
    cv[0] = v1[1] + v2[0]; cp[0] = (i1[1] << 7) | i2[0];
    cv[1] = v1[1] + v2[1]; cp[1] = (i1[1] << 7) | i2[1];
    cv[2] = v1[1] + v2[2]; cp[2] = (i1[1] << 7) | i2[2];
    cv[3] = v1[1] + v2[3]; cp[3] = (i1[1] << 7) | i2[3];
    cv[4] = v1[1] + v2[4]; cp[4] = (i1[1] << 7) | i2[4];
    cv[5] = v1[1] + v2[5]; cp[5] = (i1[1] << 7) | i2[5];
    cv[6] = v1[1] + v2[6]; cp[6] = (i1[1] << 7) | i2[6];
    cv[7] = v1[1] + v2[7]; cp[7] = (i1[1] << 7) | i2[7];
    cv[8] = v1[2] + v2[0]; cp[8] = (i1[2] << 7) | i2[0];
    cv[9] = v1[2] + v2[1]; cp[9] = (i1[2] << 7) | i2[1];
    cv[10] = v1[2] + v2[2]; cp[10] = (i1[2] << 7) | i2[2];
    cv[11] = v1[2] + v2[3]; cp[11] = (i1[2] << 7) | i2[3];
    cv[12] = v1[2] + v2[4]; cp[12] = (i1[2] << 7) | i2[4];
    cv[13] = v1[3] + v2[0]; cp[13] = (i1[3] << 7) | i2[0];
    cv[14] = v1[3] + v2[1]; cp[14] = (i1[3] << 7) | i2[1];
    cv[15] = v1[3] + v2[2]; cp[15] = (i1[3] << 7) | i2[2];
      } else {
    cv[0] = v1[3] + v2[3]; cp[0] = (i1[3] << 7) | i2[3];
    cv[1] = v1[4] + v2[0]; cp[1] = (i1[4] << 7) | i2[0];
    cv[2] = v1[4] + v2[1]; cp[2] = (i1[4] << 7) | i2[1];
    cv[3] = v1[4] + v2[2]; cp[3] = (i1[4] << 7) | i2[2];
    cv[4] = v1[5] + v2[0]; cp[4] = (i1[5] << 7) | i2[0];
    cv[5] = v1[5] + v2[1]; cp[5] = (i1[5] << 7) | i2[1];
    cv[6] = v1[6] + v2[0]; cp[6] = (i1[6] << 7) | i2[0];
    cv[7] = v1[6] + v2[1]; cp[7] = (i1[6] << 7) | i2[1];
    cv[8] = v1[7] + v2[0]; cp[8] = (i1[7] << 7) | i2[0];
    cv[9] = v1[7] + v2[1]; cp[9] = (i1[7] << 7) | i2[1];
    cv[10] = v1[8] + v2[0]; cp[10] = (i1[8] << 7) | i2[0];
    cv[11] = v1[9] + v2[0]; cp[11] = (i1[9] << 7) | i2[0];
    cv[12] = v1[10] + v2[0]; cp[12] = (i1[10] << 7) | i2[0];
    cv[13] = v1[11] + v2[0]; cp[13] = (i1[11] << 7) | i2[0];
    cv[14] = v1[12] + v2[0]; cp[14] = (i1[12] << 7) | i2[0];
    cv[15] = v1[13] + v2[0]; cp[15] = (i1[13] << 7) | i2[0];
      }
      sort16p(cv, cp);
#pragma unroll
      for (int i = 0; i < 16; ++i) if (cv[15 - i] > ts[i]) { ts[i] = cv[15 - i]; tp[i] = cp[15 - i]; }
      bmerge16p(ts, tp);
    }
    {
      float cv[2]; int cp[2];
    cv[0] = v1[14] + v2[0]; cp[0] = (i1[14] << 7) | i2[0];
    cv[1] = v1[15] + v2[0]; cp[1] = (i1[15] << 7) | i2[0];
      if (cv[0] < cv[1]) { const float tv = cv[0]; cv[0] = cv[1]; cv[1] = tv; const int ti = cp[0]; cp[0] = cp[1]; cp[1] = ti; }
      if (cv[1] > ts[14]) { ts[14] = cv[1]; tp[14] = cp[1]; }
      if (cv[0] > ts[15]) { ts[15] = cv[0]; tp[15] = cp[0]; }
      bmerge16p(ts, tp);
    }
    float ex[16], sm = 0.f;
#pragma unroll
    for (int i = 0; i < 16; ++i) { ex[i] = __expf(ts[i] - ts[0]); sm += ex[i]; }
    const float rs = 1.f / sm;
    if (hi == 0) {
      int* eo = eid + row * 128 + h * 16;
#pragma unroll
      for (int i = 0; i < 4; ++i) { const u32x4 o = {(unsigned)tp[4 * i], (unsigned)tp[4 * i + 1], (unsigned)tp[4 * i + 2], (unsigned)tp[4 * i + 3]}; *(u32x4*)(eo + 4 * i) = o; }
    } else {
      float* go = gate + row * 128 + h * 16;
#pragma unroll
      for (int i = 0; i < 4; ++i) { const f32x4 o = {ex[4 * i] * rs, ex[4 * i + 1] * rs, ex[4 * i + 2] * rs, ex[4 * i + 3] * rs}; *(f32x4*)(go + 4 * i) = o; }
    }
  }
}

constexpr float PEER_USCALE = 16.f;
__device__ void peer_cvt_tables(const Params& p, int layer, int rank, int nb) {
  const float* ut = p.in[I_PU] + (size_t)layer * 16384 * DM; const float* vt = p.in[I_PV] + (size_t)layer * 16384 * DM;
  u32x4* uo = (u32x4*)(p.ws + OFF_UTAB); u32x4* vo = (u32x4*)(p.ws + OFF_VTAB);
  const int n16 = 16384 * DM / 16, stride = nb * NTHREADS;
  for (int i = rank * NTHREADS + TIDX; i < 2 * n16; i += 2 * stride) {
    f32x4 a[2][4];
#pragma unroll
    for (int k = 0; k < 2; ++k) {
      const int ii = i + k * stride;
      if (ii < 2 * n16) {
        const bool isv = ii >= n16; const int j = isv ? ii - n16 : ii;
        const float* s = (isv ? vt : ut) + (size_t)j * 16;
#pragma unroll
        for (int q = 0; q < 4; ++q) a[k][q] = *(const f32x4*)(s + 4 * q);
      }
    }
#pragma unroll
    for (int k = 0; k < 2; ++k) {
      const int ii = i + k * stride;
      if (ii < 2 * n16) {
        const bool isv = ii >= n16; const int j = isv ? ii - n16 : ii; const float sc = isv ? 1.f : PEER_USCALE;
        u32x4 o;
#pragma unroll
        for (int q = 0; q < 4; ++q) {
          int w = __builtin_amdgcn_cvt_pk_fp8_f32(a[k][q][0] * sc, a[k][q][1] * sc, 0, false);
          w = __builtin_amdgcn_cvt_pk_fp8_f32(a[k][q][2] * sc, a[k][q][3] * sc, w, true);
          o[q] = (unsigned)w;
        }
        (isv ? vo : uo)[j] = o;
      }
    }
  }
}

__device__ __forceinline__ int xcc_slice() { return (int)((unsigned)__builtin_amdgcn_s_getreg((3 << 11) | 20) & 7u); }
__device__ __forceinline__ float row16_sum(float v) { v += dpp_mov<0xB1>(v); v += dpp_mov<0x4E>(v); v += dpp_mov<0x141>(v); v += dpp_mov<0x128>(v); return v; }
constexpr int PNS = 8;
constexpr int PSEGL = 8;
constexpr int PEPL = 64 / PSEGL;
constexpr int PNI = 128 / PEPL;
constexpr int PCOLS = 1024 / PNS;
using f32x2 = __attribute__((ext_vector_type(2))) float;
template <int PHASE>
__device__ void peer_sliced(const Params& p, int layer, int nrows) {
#if defined(PROBE_PEER_REP)
  int nrep = (PHASE == PROBE_PEER_REP) ? 2 : 1; asm volatile("" : "+s"(nrep));
#else
  constexpr int nrep = 1;
#endif
  for (int rep = 0; rep < nrep; ++rep) {
  const int dry = (rep + 1 < nrep) ? 1 : 0;
  const int lane = TIDX & 63, eg = lane / PSEGL, ch = lane % PSEGL;
  const bf16_t* hb = (const bf16_t*)(p.ws + OFF_HB);
  const int* eid = (const int*)(p.ws + OFF_EID);
  const unsigned char* tab = (const unsigned char*)(p.ws + (PHASE == 0 ? OFF_UTAB : OFF_VTAB)) + ch * 16;
  float* sp = (float*)(p.ws + OFF_SP); const float* wbuf = (const float*)(p.ws + OFF_WBUF);
  float* xs = (float*)(p.ws + OFF_XS);
  unsigned* ctr = (unsigned*)(p.ws + OFF_CTR) + (size_t)(((rep * 2 + layer) * 2 + PHASE) * 16) * 64;
  const int x0 = xcc_slice();
  const int bpa = eg << 2;
  for (int si = 0; si < PNS; ++si) {
    const int slice = (x0 + si) % PNS;
    int nbase = 0;
    if (lane == 0) nbase = (int)__hip_atomic_fetch_add(&ctr[slice * 64], 4u, __ATOMIC_RELAXED, __HIP_MEMORY_SCOPE_AGENT);
    for (;;) {
      const int base = __builtin_amdgcn_readfirstlane(nbase);
      if (base >= nrows) break;
      if (lane == 0) nbase = (int)__hip_atomic_fetch_add(&ctr[slice * 64], 4u, __ATOMIC_RELAXED, __HIP_MEMORY_SCOPE_AGENT);
      int eA = eid[(size_t)base * 128 + lane], eB = eid[(size_t)base * 128 + 64 + lane];
      float wA = 0.f, wB = 0.f;
      if (PHASE == 1) { wA = wbuf[(size_t)base * 128 + lane]; wB = wbuf[(size_t)base * 128 + 64 + lane]; }
#pragma unroll 1
      for (int tt = 0; tt < 4; ++tt) {
        const int r = base + tt;
        const int ceA = eA, ceB = eB; const float cwA = wA, cwB = wB;
        if (tt < 3) {
          eA = eid[(size_t)(r + 1) * 128 + lane]; eB = eid[(size_t)(r + 1) * 128 + 64 + lane];
          if (PHASE == 1) { wA = wbuf[(size_t)(r + 1) * 128 + lane]; wB = wbuf[(size_t)(r + 1) * 128 + 64 + lane]; }
        }
        int ev[PNI];
#pragma unroll
        for (int i = 0; i < PNI; ++i) ev[i] = __builtin_amdgcn_ds_bpermute(bpa + 32 * (i & 7), (i < 8) ? ceA : ceB);
        if (PHASE == 0) {
          float xv[16];
          {
            const u32x4 xa = *(const u32x4*)(hb + (size_t)r * DM + slice * PCOLS + ch * 16), xb = *(const u32x4*)(hb + (size_t)r * DM + slice * PCOLS + ch * 16 + 8);
#pragma unroll
            for (int q = 0; q < 4; ++q) { xv[2 * q] = __uint_as_float(xa[q] << 16); xv[2 * q + 1] = __uint_as_float(xa[q] & 0xffff0000u);
                                          xv[8 + 2 * q] = __uint_as_float(xb[q] << 16); xv[8 + 2 * q + 1] = __uint_as_float(xb[q] & 0xffff0000u); }
          }
          u32x4 uv[PNI];
#pragma unroll
          for (int j = 0; j < PNI; ++j) uv[j] = *(const u32x4*)(tab + (size_t)ev[j] * DM + slice * PCOLS);
          float keep0 = 0.f, keep1 = 0.f;
#pragma unroll
          for (int j = 0; j < PNI; ++j) {
            float d = 0.f;
#pragma unroll
            for (int q = 0; q < 4; ++q) {
              const f32x2 lo = __builtin_amdgcn_cvt_pk_f32_fp8((int)uv[j][q], false), hi2 = __builtin_amdgcn_cvt_pk_f32_fp8((int)uv[j][q], true);
              d += lo[0] * xv[4 * q] + lo[1] * xv[4 * q + 1] + hi2[0] * xv[4 * q + 2] + hi2[1] * xv[4 * q + 3];
            }
            d += dpp_mov<0xB1>(d); d += dpp_mov<0x4E>(d); d += dpp_mov<0x141>(d);
            if (ch == (j % PSEGL)) { if (j < PSEGL) keep0 = d; else keep1 = d; }
          }
          float* so = sp + ((size_t)slice * NTOK + r) * 128 + PEPL * ch + eg;
          so[0] = keep0 * (1.f / PEER_USCALE); so[64] = keep1 * (1.f / PEER_USCALE);
        } else {
          u32x4 vv[PNI];
#pragma unroll
          for (int j = 0; j < PNI; ++j) vv[j] = *(const u32x4*)(tab + (size_t)ev[j] * DM + slice * PCOLS);
          float acc[16];
#pragma unroll
          for (int j = 0; j < 16; ++j) acc[j] = 0.f;
#pragma unroll
          for (int j = 0; j < PNI; ++j) {
            const float w = __int_as_float(__builtin_amdgcn_ds_bpermute(bpa + 32 * (j & 7), __float_as_int((j < 8) ? cwA : cwB)));
#pragma unroll
            for (int q = 0; q < 4; ++q) {
              const f32x2 lo = __builtin_amdgcn_cvt_pk_f32_fp8((int)vv[j][q], false), hi2 = __builtin_amdgcn_cvt_pk_f32_fp8((int)vv[j][q], true);
              acc[4 * q] += w * lo[0]; acc[4 * q + 1] += w * lo[1]; acc[4 * q + 2] += w * hi2[0]; acc[4 * q + 3] += w * hi2[1];
            }
          }
#pragma unroll
          for (int j = 0; j < 16; ++j) {
            acc[j] += dpp_mov<0x128>(acc[j]);
            { auto rr = __builtin_amdgcn_permlane16_swap(__float_as_uint(acc[j]), __float_as_uint(acc[j]), false, false); acc[j] = __uint_as_float(rr[0]) + __uint_as_float(rr[1]); }
            { auto rr = __builtin_amdgcn_permlane32_swap(__float_as_uint(acc[j]), __float_as_uint(acc[j]), false, false); acc[j] = __uint_as_float(rr[0]) + __uint_as_float(rr[1]); }
          }
          if (eg == 0) {
            int b, t, isc; row_info(r, b, t, isc);
            const float* g2 = (const float*)(p.ws + OFF_MOD) + ((size_t)layer * 3 + (isc ? 2 : b)) * 6144 + 5120 + slice * PCOLS + ch * 16;
            float* xr = xs + (size_t)r * DM + slice * PCOLS + ch * 16;
#pragma unroll
            for (int q = 0; q < 4; ++q) {
              f32x4 xq = *(const f32x4*)(xr + 4 * q);
#pragma unroll
              for (int j = 0; j < 4; ++j) xq[j] += g2[4 * q + j] * acc[4 * q + j];
              if (dry == 0) *(f32x4*)(xr + 4 * q) = xq;
            }
          }
        }
      }
    }
  }
  }
}
__device__ void peer_weights(const Params& p, int nrows) {
  const float* sp = (const float*)(p.ws + OFF_SP); const float* gate = (const float*)(p.ws + OFF_GATE); float* wbuf = (float*)(p.ws + OFF_WBUF);
  for (int i = BIDX * NTHREADS + TIDX; i < nrows * 128; i += gridDim.x * NTHREADS) {
    float s = 0.f;
#pragma unroll
    for (int x = 0; x < PNS; ++x) s += sp[(size_t)x * NTOK * 128 + i];
    wbuf[i] = gate[i] * gelu_tanh(s);
  }
}

__device__ void peer_eval_fused(const Params& p, int layer, int nrows, char* smem) {
  const int tid = TIDX, wid = tid >> 6, lane = tid & 63, eg = lane >> 3, ch = lane & 7;
  const int ntb = nrows / (int)gridDim.x, tok0 = BIDX * ntb;
  float* S = (float*)smem;
  int* E = (int*)(smem + 72 * 128 * 4);
  const bf16_t* hb = (const bf16_t*)(p.ws + OFF_HB);
  const int* eid = (const int*)(p.ws + OFF_EID); const float* gate = (const float*)(p.ws + OFF_GATE);
  const unsigned char* utab = (const unsigned char*)(p.ws + OFF_UTAB) + ch * 16; const unsigned char* vtab = (const unsigned char*)(p.ws + OFF_VTAB) + ch * 16;
  float* xs = (float*)(p.ws + OFF_XS);
  __syncthreads();
  for (int i = tid; i < ntb * 128; i += NTHREADS) { S[i] = 0.f; E[i] = eid[(size_t)tok0 * 128 + i]; }
  __syncthreads();
#pragma unroll 1
  for (int it = wid; it < ntb * 8; it += 8) {
    const int slice = it / ntb, tl = it - slice * ntb, r = tok0 + tl;
    int ev[16];
#pragma unroll
    for (int j = 0; j < 16; ++j) ev[j] = E[tl * 128 + 8 * j + eg];
    float xv[16];
    {
      const u32x4 xa = *(const u32x4*)(hb + (size_t)r * DM + slice * 128 + ch * 16), xb = *(const u32x4*)(hb + (size_t)r * DM + slice * 128 + ch * 16 + 8);
#pragma unroll
      for (int q = 0; q < 4; ++q) { xv[2 * q] = __uint_as_float(xa[q] << 16); xv[2 * q + 1] = __uint_as_float(xa[q] & 0xffff0000u);
                                    xv[8 + 2 * q] = __uint_as_float(xb[q] << 16); xv[8 + 2 * q + 1] = __uint_as_float(xb[q] & 0xffff0000u); }
    }
    u32x4 uv[16];
#pragma unroll
    for (int j = 0; j < 16; ++j) uv[j] = *(const u32x4*)(utab + (size_t)ev[j] * DM + slice * 128);
    float keep0 = 0.f, keep1 = 0.f;
#pragma unroll
    for (int j = 0; j < 16; ++j) {
      float d = 0.f;
#pragma unroll
      for (int q = 0; q < 4; ++q) {
        const f32x2 lo = __builtin_amdgcn_cvt_pk_f32_fp8((int)uv[j][q], false), hi2 = __builtin_amdgcn_cvt_pk_f32_fp8((int)uv[j][q], true);
        d += lo[0] * xv[4 * q] + lo[1] * xv[4 * q + 1] + hi2[0] * xv[4 * q + 2] + hi2[1] * xv[4 * q + 3];
      }
      d += dpp_mov<0xB1>(d); d += dpp_mov<0x4E>(d); d += dpp_mov<0x141>(d);
      if (ch == (j & 7)) { if (j < 8) keep0 = d; else keep1 = d; }
    }
    atomicAdd(&S[tl * 128 + 8 * ch + eg], keep0); atomicAdd(&S[tl * 128 + 64 + 8 * ch + eg], keep1);
  }
  __syncthreads();
  for (int i = tid; i < ntb * 128; i += NTHREADS) S[i] = gate[(size_t)tok0 * 128 + i] * gelu_tanh(S[i] * (1.f / PEER_USCALE));
  __syncthreads();
#pragma unroll 1
  for (int it = wid; it < ntb * 8; it += 8) {
    const int slice = it / ntb, tl = it - slice * ntb, r = tok0 + tl;
    int ev[16]; float wv[16];
#pragma unroll
    for (int j = 0; j < 16; ++j) { ev[j] = E[tl * 128 + 8 * j + eg]; wv[j] = S[tl * 128 + 8 * j + eg]; }
    u32x4 vv[16];
#pragma unroll
    for (int j = 0; j < 16; ++j) vv[j] = *(const u32x4*)(vtab + (size_t)ev[j] * DM + slice * 128);
    float acc[16];
#pragma unroll
    for (int j = 0; j < 16; ++j) acc[j] = 0.f;
#pragma unroll
    for (int j = 0; j < 16; ++j) {
      const float w = wv[j];
#pragma unroll
      for (int q = 0; q < 4; ++q) {
        const f32x2 lo = __builtin_amdgcn_cvt_pk_f32_fp8((int)vv[j][q], false), hi2 = __builtin_amdgcn_cvt_pk_f32_fp8((int)vv[j][q], true);
        acc[4 * q] += w * lo[0]; acc[4 * q + 1] += w * lo[1]; acc[4 * q + 2] += w * hi2[0]; acc[4 * q + 3] += w * hi2[1];
      }
    }
#pragma unroll
    for (int j = 0; j < 16; ++j) {
      acc[j] += dpp_mov<0x128>(acc[j]);
      { auto rr = __builtin_amdgcn_permlane16_swap(__float_as_uint(acc[j]), __float_as_uint(acc[j]), false, false); acc[j] = __uint_as_float(rr[0]) + __uint_as_float(rr[1]); }
      { auto rr = __builtin_amdgcn_permlane32_swap(__float_as_uint(acc[j]), __float_as_uint(acc[j]), false, false); acc[j] = __uint_as_float(rr[0]) + __uint_as_float(rr[1]); }
    }
    if (eg == 0) {
      int b, t, isc; row_info(r, b, t, isc);
      const float* g2 = (const float*)(p.ws + OFF_MOD) + ((size_t)layer * 3 + (isc ? 2 : b)) * 6144 + 5120 + slice * 128 + ch * 16;
      float* xr = xs + (size_t)r * DM + slice * 128 + ch * 16;
#pragma unroll
      for (int q = 0; q < 4; ++q) {
        f32x4 xq = *(const f32x4*)(xr + 4 * q);
#pragma unroll
        for (int j = 0; j < 4; ++j) xq[j] += g2[4 * q + j] * acc[4 * q + j];
        *(f32x4*)(xr + 4 * q) = xq;
      }
    }
  }
  __syncthreads();
  {
    const bool last = (layer == 1);
    const float* g = last ? p.in[I_FG] : p.in[I_N1G] + (layer + 1) * DM;
    bf16_t* hbw = (bf16_t*)(p.ws + OFF_HB);
#pragma unroll 1
    for (int tl0 = wid * 3; tl0 < ntb; tl0 += 24) {
      f32x4 v[3][4]; float ss[3]; const float* modj[3];
#pragma unroll
      for (int j = 0; j < 3; ++j) {
        int b, t, isc; row_info(min(tok0 + tl0 + j, tok0 + ntb - 1), b, t, isc);
        modj[j] = (const float*)(p.ws + OFF_MOD) + ((size_t)(last ? 1 : layer + 1) * 3 + (isc ? 2 : b)) * 6144;
      }
#pragma unroll
      for (int j = 0; j < 3; ++j) {
        const int r = min(tok0 + tl0 + j, tok0 + ntb - 1);
        ss[j] = 0.f;
#pragma unroll
        for (int i = 0; i < 4; ++i) { v[j][i] = *(const f32x4*)(xs + (size_t)r * DM + (i * 64 + lane) * 4); ss[j] += v[j][i][0] * v[j][i][0] + v[j][i][1] * v[j][i][1] + v[j][i][2] * v[j][i][2] + v[j][i][3] * v[j][i][3]; }
      }
#pragma unroll
      for (int j = 0; j < 3; ++j) ss[j] = rsqrtf(wave_sum(ss[j]) * (1.f / DM) + EPSV);
#pragma unroll
      for (int i = 0; i < 4; ++i) {
        const int c0 = (i * 64 + lane) * 4; const f32x4 gv = *(const f32x4*)(g + c0);
#pragma unroll
        for (int j = 0; j < 3; ++j) {
          const int r = tok0 + tl0 + j;
          if (tl0 + j < ntb) {
            if (last) { if (r < NLAT) *(f32x4*)(p.out + (size_t)r * DM + c0) = v[j][i] * ss[j] * gv; }
            else {
              const f32x4 sc = *(const f32x4*)(modj[j] + 1024 + c0), sh = *(const f32x4*)(modj[j] + c0);
              float y[4];
#pragma unroll
              for (int q = 0; q < 4; ++q) y[q] = v[j][i][q] * ss[j] * gv[q] * (1.f + sc[q]) + sh[q];
              const u32x2 o = {cvtpk(y[0], y[1]), cvtpk(y[2], y[3])};
              *(u32x2*)(hbw + (size_t)r * DM + c0) = o;
            }
          }
        }
      }
    }
  }
}

__device__ void final_norm(const Params& p) {
  const int lane = TIDX & 63, wid = TIDX >> 6;
  const float* xs = (const float*)(p.ws + OFF_XS); const float* g = p.in[I_FG];
  for (int grp = BIDX * 8 + wid; grp < NLAT / 4; grp += gridDim.x * 8) {
    const int r0 = grp * 4;
    f32x4 v[4][4]; float ss[4];
#pragma unroll
    for (int j = 0; j < 4; ++j) {
      ss[j] = 0.f;
#pragma unroll
      for (int i = 0; i < 4; ++i) { v[j][i] = *(const f32x4*)(xs + (size_t)(r0 + j) * DM + (i * 64 + lane) * 4); ss[j] += v[j][i][0] * v[j][i][0] + v[j][i][1] * v[j][i][1] + v[j][i][2] * v[j][i][2] + v[j][i][3] * v[j][i][3]; }
    }
#pragma unroll
    for (int j = 0; j < 4; ++j) ss[j] = rsqrtf(wave_sum(ss[j]) * (1.f / DM) + EPSV);
#pragma unroll
    for (int i = 0; i < 4; ++i) {
      const int c0 = (i * 64 + lane) * 4; const f32x4 gv = *(const f32x4*)(g + c0);
#pragma unroll
      for (int j = 0; j < 4; ++j) { const f32x4 o = v[j][i] * ss[j] * gv; *(f32x4*)(p.out + (size_t)(r0 + j) * DM + c0) = o; }
    }
  }
}

namespace pg8 {
#define PG8_LAS __attribute__((address_space(3)))
typedef unsigned short bf16_t;
typedef short bf16x8 __attribute__((ext_vector_type(8)));
typedef float f32x4 __attribute__((ext_vector_type(4)));
typedef unsigned u32x4 __attribute__((ext_vector_type(4)));
constexpr int BM = 256, BK = 64, HALF = 128, HTB = HALF * BK * 2  , STAGE_BYTES = 8 * HTB, NXCD = 8, WGM = 8;

__host__ __device__ __forceinline__ int lds_byte(int r, int c) { const int st = (r >> 4) * 2 + (c >> 5), rr = r & 15, cc = c & 31, ob = rr * 64 + cc * 2; return st * 1024 + (ob ^ (((ob >> 9) & 1) << 5)); }
__host__ __device__ __forceinline__ void stage_rc(int b, int& R, int& C) { const int st = b / 1024, sb = b % 1024, swz = sb ^ (((sb >> 9) & 1) << 5); R = (st >> 1) * 16 + swz / 64; C = (st & 1) * 32 + (swz % 64) / 2; }
__host__ __device__ __forceinline__ int perm32(int rho) { const int n = rho >> 4, i = rho & 15; return 8 * (i >> 2) + 4 * n + (i & 3); }

struct Unit { int pm, pn; };
struct Gemm { const bf16_t* A; const bf16_t* Bt; int M, N, K; };

struct StaticOrder {
    int nM, nN, nwg, G, c;
    __host__ __device__ void init(int M, int N, int G_, int c_) { nM = M / BM; nN = N / BM; nwg = nM * nN; G = G_; c = c_; }
    __host__ __device__ bool next(int i, Unit& u) const {
        const long L = (long)i * G + c; if (L >= nwg) return false;
        int wgid = (int)L; { const int q = nwg / NXCD, r = nwg % NXCD, xcd = wgid % NXCD, off = wgid / NXCD; wgid = (xcd < r ? xcd * (q + 1) : r * (q + 1) + (xcd - r) * q) + off; }
        const int nig = WGM * nN, gid = wgid / nig, fm = gid * WGM, gsz = (nM - fm) < WGM ? (nM - fm) : WGM;
        u.pm = fm + ((wgid % nig) % gsz); u.pn = (wgid % nig) / gsz; return true;
    }
    __device__ __forceinline__ void a_ready(const Unit&) const {}
    __device__ __forceinline__ void done(const Unit&) const {}
};
template <class Epi, class Sched, bool STAMP = false>
__device__ __forceinline__ void gemm_phase(PG8_LAS unsigned char* lds, const Gemm g, const Sched& S, const Epi& E, unsigned long long* stamps) {
    const int tid = launder_v((int)threadIdx.x)  , wid = __builtin_amdgcn_readfirstlane(tid >> 6), lane = tid & 63, wr = wid >> 2, wc = wid & 3, fr = lane & 15, fq = lane >> 4;
    const int K = g.K, nt = K / BK;
    int ts_lo = 0, ts_hi = 0, nts = 0; const unsigned long long rt_entry = STAMP ? 0ull : 0ull;
#define PG8_STAMP() do { if (STAMP && wid == 0 && nts < 64) { const unsigned long long _c = 0ull; \
        ts_lo = (lane == nts) ? (int)(unsigned)_c : ts_lo; ts_hi = (lane == nts) ? (int)(unsigned)(_c >> 32) : ts_hi; ++nts; } } while (0)
    PG8_STAMP();
    unsigned voffA[2], voffB[2];
#pragma unroll
    for (int i = 0; i < 2; ++i) { int R, C; stage_rc(tid * 16 + i * 8192, R, C); const int Rb = Epi::PERM ? ((R & ~31) + perm32(R & 31)) : R;
        voffA[i] = (unsigned)(R * K + C) * 2u; voffB[i] = (unsigned)(Rb * K + C) * 2u; }
    const size_t kstep = (size_t)(BK * 2);
    const size_t hstep = (size_t)HALF * K * 2;
    const size_t tstep = 2 * hstep;
    const unsigned ldsw = (unsigned)wid * 1024u;
    const int aoff = lds_byte(wr * 64 + fr, fq * 8), boff = launder_v(lds_byte(wc * 32 + fr, fq * 8) + 4 * HTB);
#define PG8_SA(b, h) (((b) * 2 + (h)) * HTB)
#define PG8_SB(b, h) ((4 + (b) * 2 + (h)) * HTB)
#define PG8_STAGE(bufoff, gbase, voff) do { _Pragma("unroll") for (int _i = 0; _i < 2; ++_i) \
        __builtin_amdgcn_global_load_lds((const unsigned*)((const char*)(gbase) + (voff)[_i]), (PG8_LAS unsigned*)(lds + (bufoff) + ldsw + _i * 8192), 16, 0, 0); } while (0)
#define PG8_LDA(dst, b, h) do { _Pragma("unroll") for (int m = 0; m < 4; ++m) _Pragma("unroll") for (int k = 0; k < 2; ++k) dst[m][k] = *(const PG8_LAS bf16x8*)(lds + PG8_SA(b, h) + aoff + m * 2048 + k * 1024); } while (0)
#define PG8_LDB(dst, b, h) do { _Pragma("unroll") for (int n = 0; n < 2; ++n) _Pragma("unroll") for (int k = 0; k < 2; ++k) dst[n][k] = *(const PG8_LAS bf16x8*)(lds + boff + ((b) * 2 + (h)) * HTB + n * 2048 + k * 1024); } while (0)
#define PG8_MMA(ai, bj, At, Bt) do { __builtin_amdgcn_s_setprio(1); _Pragma("unroll") for (int m = 0; m < 4; ++m) _Pragma("unroll") for (int n = 0; n < 2; ++n) _Pragma("unroll") for (int k = 0; k < 2; ++k) \
        acc[ai][bj][m][n] = __builtin_amdgcn_mfma_f32_16x16x32_bf16(Bt[n][k], At[m][k], acc[ai][bj][m][n], 0, 0, 0); __builtin_amdgcn_s_setprio(0); } while (0)
#define PG8_WAIT_V(n) asm volatile("s_waitcnt vmcnt(" #n ")" ::: "memory")
#define PG8_WAIT_L(n) asm volatile("s_waitcnt lgkmcnt(" #n ")" ::: "memory")
#define PG8_BAR __builtin_amdgcn_s_barrier()
#define PG8_SCHED __builtin_amdgcn_sched_barrier(0)
    Unit cur, nxt; int ui = 0;
    if (!S.next(0, cur)) return;
    f32x4 acc[2][2][4][2];
#pragma unroll
    for (int a = 0; a < 2; ++a)
#pragma unroll
        for (int b = 0; b < 2; ++b)
#pragma unroll
            for (int m = 0; m < 4; ++m)
#pragma unroll
                for (int n = 0; n < 2; ++n) acc[a][b][m][n] = (f32x4){0.f, 0.f, 0.f, 0.f};
    bf16x8 At[4][2], B0[2][2], B1[2][2];
    const char* cA = (const char*)g.A + (size_t)cur.pm * tstep; const char* cB = (const char*)g.Bt + (size_t)cur.pn * tstep;
    S.a_ready(cur);
    PG8_STAGE(PG8_SB(0, 0), cB, voffB); PG8_STAGE(PG8_SA(0, 0), cA, voffA); PG8_STAGE(PG8_SB(0, 1), cB + hstep, voffB); PG8_STAGE(PG8_SA(0, 1), cA + hstep, voffA);
    if (wr == 1) PG8_BAR;
    PG8_WAIT_V(4); PG8_BAR;
    PG8_STAGE(PG8_SB(1, 0), cB + kstep, voffB); PG8_STAGE(PG8_SA(1, 0), cA + kstep, voffA); PG8_STAGE(PG8_SB(1, 1), cB + hstep + kstep, voffB);
    PG8_WAIT_V(6); PG8_BAR;
    PG8_STAMP();
    for (;;) {
        const bool has_next = S.next(ui + 1, nxt);
        const char* nA = has_next ? (const char*)g.A + (size_t)nxt.pm * tstep : cA; const char* nB = has_next ? (const char*)g.Bt + (size_t)nxt.pn * tstep : cB;
        for (int t = 0; t < nt; t += 2) {
            const bool last = (t == nt - 2);
            const char* a1 = cA + (size_t)(t + 1) * kstep;
            const char* a2 = last ? nA : cA + (size_t)(t + 2) * kstep; const char* b2 = last ? nB : cB + (size_t)(t + 2) * kstep;
            const char* a3 = a2 + kstep; const char* b3 = b2 + kstep;
            if (last && has_next) S.a_ready(nxt);
            PG8_LDB(B0, 0, 0); PG8_SCHED; PG8_LDA(At, 0, 0); PG8_STAGE(PG8_SA(1, 1), a1 + hstep, voffA);
            PG8_WAIT_L(8); PG8_BAR; PG8_WAIT_L(0); PG8_MMA(0, 0, At, B0); PG8_BAR; PG8_SCHED;
            PG8_LDB(B1, 0, 1); PG8_STAGE(PG8_SB(0, 0), b2, voffB);
            PG8_BAR; PG8_WAIT_L(0); PG8_MMA(0, 1, At, B1); PG8_BAR;
            PG8_LDA(At, 0, 1); PG8_STAGE(PG8_SA(0, 0), a2, voffA);
            PG8_BAR; PG8_WAIT_L(0); PG8_MMA(1, 0, At, B0); PG8_BAR; PG8_SCHED;
            PG8_STAGE(PG8_SB(0, 1), b2 + hstep, voffB);
            PG8_WAIT_V(6); PG8_BAR; PG8_MMA(1, 1, At, B1); PG8_BAR;
            PG8_LDB(B0, 1, 0); PG8_SCHED; PG8_LDA(At, 1, 0); PG8_STAGE(PG8_SA(0, 1), a2 + hstep, voffA);
            PG8_WAIT_L(8); PG8_BAR; PG8_WAIT_L(0); PG8_MMA(0, 0, At, B0); PG8_BAR; PG8_SCHED;
            PG8_LDB(B1, 1, 1); PG8_STAGE(PG8_SB(1, 0), b3, voffB);
            PG8_BAR; PG8_WAIT_L(0); PG8_MMA(0, 1, At, B1); PG8_BAR;
            PG8_LDA(At, 1, 1); PG8_STAGE(PG8_SA(1, 0), a3, voffA);
            PG8_BAR; PG8_WAIT_L(0); PG8_MMA(1, 0, At, B0); PG8_BAR; PG8_SCHED;
            PG8_STAGE(PG8_SB(1, 1), b3 + hstep, voffB);
            PG8_WAIT_V(6); PG8_BAR; PG8_MMA(1, 1, At, B1); PG8_BAR;
        }
        PG8_STAMP();
        if constexpr (!Epi::AFTER_DRAIN) { E(acc, cur, wr, wc, fr, fq); S.done(cur); }
        PG8_STAMP();
        if (!has_next) break;
#pragma unroll
        for (int a = 0; a < 2; ++a)
#pragma unroll
            for (int b = 0; b < 2; ++b)
#pragma unroll
                for (int m = 0; m < 4; ++m)
#pragma unroll
                    for (int n = 0; n < 2; ++n) acc[a][b][m][n] = (f32x4){0.f, 0.f, 0.f, 0.f};
        cur = nxt; cA = nA; cB = nB; ++ui;
    }
    PG8_WAIT_V(0);
    if (wr == 0) PG8_BAR;
    PG8_BAR;
    if constexpr (Epi::AFTER_DRAIN) { E.fused(acc, cur, wr, wc, fr, fq, lds, wid, lane); S.done(cur); }
    PG8_STAMP();
    if (STAMP && wid == 0) { stamps[lane] = lane < nts ? (((unsigned long long)(unsigned)ts_hi << 32) | (unsigned)ts_lo) : 0ull;
        if (lane == 62) stamps[62] = rt_entry; if (lane == 63) stamps[63] = 0ull; }
#undef PG8_STAMP
#undef PG8_SA
#undef PG8_SB
#undef PG8_STAGE
#undef PG8_LDA
#undef PG8_LDB
#undef PG8_MMA
#undef PG8_WAIT_V
#undef PG8_WAIT_L
#undef PG8_BAR
#undef PG8_SCHED
}
}

template <class F> struct EpiFn {
  static constexpr bool PERM = false, AFTER_DRAIN = false;
  F f;
  __device__ __forceinline__ void operator()(const pg8::f32x4 (&acc)[2][2][4][2], const pg8::Unit& u, int wr, int wc, int fr, int fq) const {
#pragma unroll
    for (int ai = 0; ai < 2; ++ai)
#pragma unroll
      for (int m = 0; m < 4; ++m) {
        const int row = u.pm * 256 + ai * 128 + wr * 64 + m * 16 + fr;
#pragma unroll
        for (int bj = 0; bj < 2; ++bj)
#pragma unroll
          for (int n = 0; n < 2; ++n) f(row, u.pn * 256 + bj * 128 + wc * 32 + n * 16 + 4 * fq, acc[ai][bj][m][n]);
      }
  }
};
template <int NN> struct RowMajorOrder {
  int nwg, G, c;
  __device__ __forceinline__ bool next(int i, pg8::Unit& u) const { const int L = i * G + c; if (L >= nwg) return false; u.pm = L / NN; u.pn = L - u.pm * NN; return true; }
  __device__ __forceinline__ void a_ready(const pg8::Unit&) const {}
  __device__ __forceinline__ void done(const pg8::Unit&) const {}
};
template <class F> struct EpiFn8 {
  static constexpr bool PERM = true, AFTER_DRAIN = false;
  F f;
  __device__ __forceinline__ void operator()(const pg8::f32x4 (&acc)[2][2][4][2], const pg8::Unit& u, int wr, int wc, int fr_, int fq_) const {
    const int fr = launder_v(fr_), fq = launder_v(fq_);
#pragma unroll
    for (int ai = 0; ai < 2; ++ai)
#pragma unroll
      for (int m = 0; m < 4; ++m) {
        const int row = u.pm * 256 + ai * 128 + wr * 64 + m * 16 + fr;
#pragma unroll
        for (int bj = 0; bj < 2; ++bj) f(row, u.pn * 256 + bj * 128 + wc * 32 + 8 * fq, acc[ai][bj][m][0], acc[ai][bj][m][1]);
      }
  }
};
template <int N, class F>
__device__ __forceinline__ void gemm256p(const bf16_t* A, const bf16_t* Bt, int M, int K, F f, char* smem) {
  pg8::Gemm g; g.A = A; g.Bt = Bt; g.M = M; g.N = N; g.K = K;
  RowMajorOrder<N / 256> S; S.nwg = (M / 256) * (N / 256); S.G = (int)gridDim.x; S.c = BIDX;
  EpiFn8<F> E{f};
  __syncthreads();
  pg8::gemm_phase<EpiFn8<F>, RowMajorOrder<N / 256>, false>((PG8_LAS unsigned char*)smem, g, S, E, nullptr);
  __syncthreads();
}
template <int N, class F>
__device__ __forceinline__ void gemm256(const bf16_t* A, const bf16_t* Bt, int M, int K, F f, char* smem) {
  pg8::Gemm g; g.A = A; g.Bt = Bt; g.M = M; g.N = N; g.K = K;
  RowMajorOrder<N / 256> S; S.nwg = (M / 256) * (N / 256); S.G = (int)gridDim.x; S.c = BIDX;
  EpiFn<F> E{f};
  __syncthreads();
  pg8::gemm_phase<EpiFn<F>, RowMajorOrder<N / 256>, false>((PG8_LAS unsigned char*)smem, g, S, E, nullptr);
  __syncthreads();
}

#define XB_TMO      128
#define XB_XCNT(j)  (256  + 64 * (j))
#define XB_XSUB(j)  (1280 + 64 * (j))
#define XB_XGEN(j)  (2304 + 64 * (j))
#define XB_TOP      3328
#define XB_TOPGEN   3392
#define XCD_BAR_WORDS 3456
#define XB_SPIN_CAP (1u << 22)
#define LAS __attribute__((address_space(3)))
__device__ __forceinline__ unsigned xb_ld(unsigned* p)              { return __hip_atomic_load(p, __ATOMIC_RELAXED, __HIP_MEMORY_SCOPE_AGENT); }
__device__ __forceinline__ unsigned xb_add(unsigned* p, unsigned v) { return __hip_atomic_fetch_add(p, v, __ATOMIC_RELAXED, __HIP_MEMORY_SCOPE_AGENT); }
__device__ __forceinline__ unsigned xb_xcc_id() { return (unsigned)__builtin_amdgcn_s_getreg((3 << 11) | 20) & 0xFu; }
#define XB_SPIN(cond, bar) do { unsigned _sp = 0; while (cond) { __builtin_amdgcn_s_sleep(1); \
    if ((++_sp & 255u) == 0u) { if (xb_ld(&(bar)[XB_TMO])) break; if (_sp > XB_SPIN_CAP) { atomicAdd(&(bar)[XB_TMO], 1u); break; } } } } while (0)
struct XcdBarrier { unsigned* bar; unsigned x; volatile LAS unsigned* st; };
__device__ __forceinline__ XcdBarrier xcd_barrier_post(unsigned* bar, volatile LAS unsigned* st) {
  XcdBarrier b; b.bar = bar; b.x = xb_xcc_id(); b.st = st;
  if (threadIdx.x == 0) (void)xb_add(&bar[XB_XCNT(b.x)], 1u);
  return b;
}
__device__ __forceinline__ void xcd_barrier_complete(unsigned* bar, unsigned x, unsigned& nloc, unsigned& nx) {
  const unsigned G = gridDim.x * gridDim.y * gridDim.z;
  unsigned sum, cnt, mine, sp = 0u;
  for (;;) {
    sum = 0u; cnt = 0u; mine = 0u;
#pragma unroll
    for (unsigned j = 0; j < 16; ++j) { const unsigned c = xb_ld(&bar[XB_XCNT(j)]); sum += c; cnt += (c > 0u) ? 1u : 0u; mine = (j == x) ? c : mine; }
    if (sum == G) break;
    __builtin_amdgcn_s_sleep(1);
    if ((++sp & 255u) == 0u) { if (xb_ld(&bar[XB_TMO])) break; if (sp > XB_SPIN_CAP) { atomicAdd(&bar[XB_TMO], 1u); break; } }
  }
  nloc = mine > 0u ? mine : 1u; nx = cnt > 0u ? cnt : 1u;
}
__device__ __forceinline__ void xcd_barrier(const XcdBarrier& b) {
  asm volatile("s_waitcnt vmcnt(0)" ::: "memory");
  __syncthreads();
  if (threadIdx.x == 0) {
    unsigned* bar = b.bar;
    __builtin_amdgcn_s_waitcnt(0);
    unsigned nloc = b.st[0], nx = b.st[1];
    if (nloc == 0u) { xcd_barrier_complete(bar, b.x, nloc, nx); b.st[0] = nloc; b.st[1] = nx; }
    const unsigned old = xb_add(&bar[XB_XSUB(b.x)], 1u);
    const unsigned gen = old / nloc;
    if (old + 1u == (gen + 1u) * nloc) {
      __builtin_amdgcn_fence(__ATOMIC_RELEASE, "agent");
      asm volatile("s_waitcnt vmcnt(0)" ::: "memory");
      const unsigned og = xb_add(&bar[XB_TOP], 1u);
      const unsigned tg = og / nx;
      if (og + 1u == (tg + 1u) * nx) xb_add(&bar[XB_TOPGEN], 1u);
      else XB_SPIN(xb_ld(&bar[XB_TOPGEN]) == tg, bar);
      __builtin_amdgcn_fence(__ATOMIC_ACQUIRE, "agent");
      xb_add(&bar[XB_XGEN(b.x)], 1u);
      asm volatile("s_waitcnt vmcnt(0)" ::: "memory");
    } else {
      XB_SPIN(xb_ld(&bar[XB_XGEN(b.x)]) == gen, bar);
      __builtin_amdgcn_fence(__ATOMIC_ACQUIRE, "agent");
      asm volatile("s_waitcnt vmcnt(0)" ::: "memory");
    }
  }
  __syncthreads();
}

constexpr int NSTAGES = 23;
constexpr int SMEM_BYTES = 135168;
template <int S>
__device__ __forceinline__ void run_stage_t(const Params& p0, int layer0, char* smem0) {
  Params p = p0; int layer = layer0; char* smem = smem0;
  { unsigned long long w = (unsigned long long)p0.ws, o = (unsigned long long)p0.out;
    asm volatile("" : "+s"(w), "+s"(o), "+s"(layer));
    p.ws = (char*)(__attribute__((address_space(1))) char*)w; p.out = (float*)(__attribute__((address_space(1))) float*)o; }
  const int nrows = (layer == 0) ? NTOK : NLAT;
  if constexpr (S == 100) stage_prep(p, smem);
  if constexpr (S == 101) stage_prep2(p, smem);
  if constexpr (S == 102) final_norm(p);
  if constexpr (S == 0) stage_norm(p, layer, 0, NTOK);
  if constexpr (S == 1) {
    bf16_t* u = (bf16_t*)(p.ws + OFF_U);
    gemm256p<DINP>((const bf16_t*)(p.ws + OFF_HB), (const bf16_t*)(p.ws + OFF_WIN) + (size_t)layer * DINP * 1024, NTOK, 1024,
            [=](int row, int col0, f32x4 v, f32x4 w) { if (col0 < DIN) { const u32x4 o = {cvtpk(v[0], v[1]), cvtpk(v[2], v[3]), cvtpk(w[0], w[1]), cvtpk(w[2], w[3])}; *(u32x4*)(u + (size_t)row * DIN + col0) = o; } }, smem);
    {
      const int nunits = (NTOK / 256) * (DINP / 256), G = (int)gridDim.x, rem = nunits % G, c = BIDX;
      if (rem == 0) peer_cvt_tables(p, layer, c, G); else if (c >= rem) peer_cvt_tables(p, layer, c - rem, G - rem);
    }
  }
  if constexpr (S == 2) { lru_units(p, layer, 0, smem); mla_prep(p, layer); hyena_prep(p, layer, smem);
#if defined(PROBE_S2)
    __syncthreads();
    if (PROBE_S2 == 0) lru_units(p, layer, 0, smem); else if (PROBE_S2 == 1) mla_prep(p, layer); else hyena_prep(p, layer, smem);
#endif
  }
  if constexpr (S == 3) {
    bf16_t* Q = (bf16_t*)(p.ws + OFF_Q); bf16_t* K = (bf16_t*)(p.ws + OFF_K);
    lru_carry(p, smem);
    gemm256p<768>((const bf16_t*)(p.ws + OFF_QN), (const bf16_t*)(p.ws + OFF_WQB) + (size_t)layer * 768 * 384, NTOK, 384,
            [=](int row, int col0, f32x4 v, f32x4 w) {
              if (col0 < 576) {
                const int j = col0 % 96;
                if (j >= 64 && row < NLAT) {
                  const int t = row & (SEQ - 1), i0 = (j & 8) >> 1;
                  const float pos = (j & 16) ? (float)(t & 63) : (float)(t >> 6);
#pragma unroll
                  for (int q = 0; q < 4; ++q) {
                    constexpr float R1 = 0.31622776601683794f;
                    const float invq = (q == 0 ? 1.f : q == 1 ? R1 : q == 2 ? R1 * R1 : R1 * R1 * R1) * 0.15915494309189535f;
                    const float rev = pos * (i0 ? invq * 0.01f : invq);
                    const float cs = __builtin_amdgcn_cosf(rev), sn = __builtin_amdgcn_sinf(rev);
                    if (q < 2) { const float lo = v[2 * q], hh = v[2 * q + 1]; v[2 * q] = lo * cs - hh * sn; v[2 * q + 1] = hh * cs + lo * sn; }
                    else { const float lo = w[2 * q - 4], hh = w[2 * q - 3]; w[2 * q - 4] = lo * cs - hh * sn; w[2 * q - 3] = hh * cs + lo * sn; }
                  }
                }
                const u32x4 o = {cvtpk(v[0], v[1]), cvtpk(v[2], v[3]), cvtpk(w[0], w[1]), cvtpk(w[2], w[3])};
                *(u32x4*)(Q + (size_t)row * 576 + col0) = o;
              }
            }, smem);
    gemm256p<768>((const bf16_t*)(p.ws + OFF_KVN), (const bf16_t*)(p.ws + OFF_WKVB) + (size_t)layer * 768 * 256, NTOK, 256,
            [=](int row, int col0, f32x4 v, f32x4 w) { const u32x4 o = {cvtpk(v[0], v[1]), cvtpk(v[2], v[3]), cvtpk(w[0], w[1]), cvtpk(w[2], w[3])}; *(u32x4*)(K + (size_t)row * 768 + col0) = o; }, smem);
  }
  if constexpr (S == 4) { attn_units(p, layer, smem); hyena_fft(p, layer, smem); }
  if constexpr (S == 12) { attn_combine(p); hyena_out_transpose(p, smem); hyena_direct(p, layer, smem); lru_final(p, layer, smem); }
  if constexpr (S == 5) {
    float* xs = (float*)(p.ws + OFF_XS); const float* mod = (const float*)(p.ws + OFF_MOD) + (size_t)layer * 3 * 6144;
    const float* xin = p.in[I_X]; const float* cin = p.in[I_CTX];
    const bf16_t* wo = (const bf16_t*)(p.ws + OFF_WOUT) + (size_t)layer * 1024 * 1024;
    gemm256<1024>((const bf16_t*)(p.ws + OFF_MIX), wo, NLAT, 1024,
            [=](int row, int col0, f32x4 v) {
              const float* g1 = mod + (size_t)(row >> 13) * 6144 + 2048 + col0;
              const float* src = (layer == 0) ? xin + (size_t)row * DM + col0 : xs + (size_t)row * DM + col0;
              const f32x4 s4 = *(const f32x4*)src, g4 = *(const f32x4*)g1;
              *(f32x4*)(xs + (size_t)row * DM + col0) = s4 + g4 * v;
            }, smem);
    if (layer == 0)
      gemm_bt((const bf16_t*)(p.ws + OFF_MIX) + (size_t)NLAT * DM, DM, wo, 1024, NCTX, 1024, 1024,
              [=](int row, int col, float v) {
                const float g1 = mod[(size_t)2 * 6144 + 2048 + col];
                xs[(size_t)(NLAT + row) * DM + col] = cin[(size_t)row * DM + col] + g1 * v;
              }, smem);
  }
  if constexpr (S == 6) { stage_norm(p, layer, 1, nrows); }
  if constexpr (S == 7) {
    bf16_t* pq = (bf16_t*)(p.ws + OFF_PQ);
    const bf16_t* wq = (const bf16_t*)(p.ws + OFF_WPQ) + (size_t)layer * 2048 * 1024;
    gemm256p<2048>((const bf16_t*)(p.ws + OFF_HB), wq, NLAT, 1024,
            [=](int row, int col0, f32x4 v, f32x4 w) { const u32x4 o = {cvtpk(v[0], v[1]), cvtpk(v[2], v[3]), cvtpk(w[0], w[1]), cvtpk(w[2], w[3])}; *(u32x4*)(pq + (size_t)row * 2048 + col0) = o; }, smem);
    if (layer == 0)
      gemm_bt((const bf16_t*)(p.ws + OFF_HB) + (size_t)NLAT * DM, DM, wq, 1024, NCTX, 2048, 1024,
              [=](int row, int col, float v) { pq[(size_t)(NLAT + row) * 2048 + col] = f2bf(v); }, smem);
  }
  if constexpr (S == 8) peer_topk(p, layer, nrows, smem);
  if constexpr (S == 9) peer_eval_fused(p, layer, nrows, smem);
}

__device__ __forceinline__ void init_params(Params& p, const KArgs& ka, char* smem) {
  unsigned long long* tab = (unsigned long long*)(smem + SMEM_BYTES);
  if (threadIdx.x == 0) {
#pragma unroll
    for (int i = 0; i < N_IN; ++i) tab[i] = (unsigned long long)ka.in[i];
  }
  __syncthreads();
  p.in.tab = smem + SMEM_BYTES; p.out = ka.out; p.ws = ka.ws;
}

#if MK_SINGLE
#define SYNC() xcd_barrier(xb)
__global__ void __launch_bounds__(NTHREADS) mega_kernel(KArgs ka) {
  __shared__ __attribute__((aligned(16))) char smem[SMEM_BYTES + 512];
  cg::grid_group grid = cg::this_grid();
  if (threadIdx.x == 0) *(uint4*)(smem + SMEM_BYTES + 320) = make_uint4(0u, 0u, 0u, 0u);
  Params p; init_params(p, ka, smem);
  const XcdBarrier xb = xcd_barrier_post((unsigned*)(ka.ws + OFF_BAR), (volatile LAS unsigned*)(smem + SMEM_BYTES + 320));
  run_stage_t<100>(p, 0, smem); grid.sync();
#if defined(PROBE_PREP) && PROBE_PREP == 100
  run_stage_t<100>(p, 0, smem); SYNC();
#endif
  run_stage_t<101>(p, 0, smem); SYNC();
#if defined(PROBE_BW)
  {
    const u32x4* base = (const u32x4*)(ka.ws + (size_t)64 * 1024 * 1024);
    const size_t n16 = (size_t)PROBE_BW * 64 * 1024 * 1024 / 16;
    unsigned acc_ = 0;
    for (size_t i = (size_t)blockIdx.x * NTHREADS + threadIdx.x; i + 7 * (size_t)gridDim.x * NTHREADS < n16; i += 8 * (size_t)gridDim.x * NTHREADS) {
      u32x4 t_[8];
#pragma unroll
      for (int k = 0; k < 8; ++k) t_[k] = base[i + k * (size_t)gridDim.x * NTHREADS];
#pragma unroll
      for (int k = 0; k < 8; ++k) acc_ ^= t_[k][0] ^ t_[k][1] ^ t_[k][2] ^ t_[k][3];
    }
    if (acc_ == 0x12345u) ((unsigned*)(ka.ws + OFF_BAR))[1000] = acc_;
    SYNC();
  }
#endif
#if defined(PROBE_BAR)
  SYNC(); SYNC(); SYNC(); SYNC(); SYNC(); SYNC(); SYNC(); SYNC(); SYNC(); SYNC(); SYNC(); SYNC(); SYNC(); SYNC(); SYNC(); SYNC(); SYNC(); SYNC(); SYNC(); SYNC();
#endif
#if defined(PROBE_PREP) && PROBE_PREP == 101
  run_stage_t<101>(p, 0, smem); SYNC();
#endif
#ifndef PROBE_DUP
#define PROBE_DUP -1
#endif
#define RUNSTAGE(S, layer) do { if (PROBE_DUP == S) { int nrep = 2; asm volatile("" : "+s"(nrep)); \
      for (int rep = 0; rep < nrep; ++rep) { run_stage_t<S>(p, layer, smem); SYNC(); if (S == 9 || S == 11) break; } } \
    else { run_stage_t<S>(p, layer, smem); SYNC(); } } while (0)
#if defined(PROBE_ATT)
#define PROBE_ATT_HOOK(layer) { attn_units<PROBE_ATT, true>(p, layer, smem); SYNC(); }
#else
#define PROBE_ATT_HOOK(layer)
#endif
#define LAYER_PASS(layer) \
    if (layer == 0) { RUNSTAGE(0, layer); } RUNSTAGE(1, layer); RUNSTAGE(2, layer); RUNSTAGE(3, layer); RUNSTAGE(4, layer); PROBE_ATT_HOOK(layer) RUNSTAGE(12, layer); \
    RUNSTAGE(5, layer); RUNSTAGE(6, layer); RUNSTAGE(7, layer); RUNSTAGE(8, layer); RUNSTAGE(9, layer);
  LAYER_PASS(0)
  LAYER_PASS(1)
}
#else
template <int S>
__global__ void __launch_bounds__(NTHREADS) stage_kernel(KArgs ka, int layer) {
  __shared__ __attribute__((aligned(16))) char smem[SMEM_BYTES + 512];
  Params p; init_params(p, ka, smem);
  run_stage_t<S>(p, layer, smem);
}
#endif

extern "C" void kernel_launch(void* const* d_in, const int* in_sizes, int n_in, void* d_out, int out_size, void* d_ws, size_t ws_size, hipStream_t stream) {
  if (n_in != N_IN || ws_size < WS_END) { fprintf(stderr, "kernel_launch: bad args n_in=%d ws=%zu need=%zu\n", n_in, ws_size, (size_t)WS_END); return; }
  KArgs p{};
  for (int i = 0; i < N_IN; ++i) p.in[i] = (const float*)d_in[i];
  p.out = (float*)d_out; p.ws = (char*)d_ws;
#if MK_SINGLE
  static int grid_blocks = 0;
  if (!grid_blocks) {
    int dev = 0, cus = 0, per_cu = 0;
    hipGetDevice(&dev);
    hipDeviceGetAttribute(&cus, hipDeviceAttributeMultiprocessorCount, dev);
    hipOccupancyMaxActiveBlocksPerMultiprocessor(&per_cu, mega_kernel, NTHREADS, 0);
    if (per_cu > 1) per_cu = 1;
    grid_blocks = cus * per_cu;
  }
  hipMemsetAsync((char*)d_ws + OFF_BAR, 0, BAR_BYTES, stream);
  void* args[] = {&p};
  hipError_t e = hipLaunchCooperativeKernel((void*)mega_kernel, dim3(grid_blocks), dim3(NTHREADS), args, 0, stream);
  if (e != hipSuccess) fprintf(stderr, "cooperative launch failed: %s (grid %d)\n", hipGetErrorString(e), grid_blocks);
#else
#define LAUNCH(S, L) hipLaunchKernelGGL(stage_kernel<S>, dim3(256), dim3(NTHREADS), 0, stream, p, L)
  LAUNCH(100, 0); LAUNCH(101, 0);
  for (int layer = 0; layer < 2; ++layer) {
    LAUNCH(0, layer); LAUNCH(1, layer); LAUNCH(2, layer); LAUNCH(3, layer); LAUNCH(4, layer);
    LAUNCH(5, layer); LAUNCH(6, layer); LAUNCH(7, layer); LAUNCH(8, layer); LAUNCH(9, layer);
  }
  LAUNCH(102, 0);
#endif
}
```
